# Optimizing an MI355X kernel written in HIP

```python
import math
import jax, jax.numpy as jnp
from jax import lax
import numpy as np


D_MODEL = 2048
BATCH = 8
SEQ = 2048
DEPTH = 2

HEAD_DIM = 128
FOX_HEADS = 8
DIFF_HEADS = 4
DIFF_V_DIM = 2 * HEAD_DIM
DIL_HEADS = D_MODEL // HEAD_DIM
DIL_PATTERNS = ((128, 1), (512, 4), (2048, 16))
Q_BLOCK = 128
N_BUCKETS = 32
BUCKET_MAX_EXACT = 16
BUCKET_MAX_DIST = 2048
N_BIAS_HEADS = DIL_HEADS
PEER_HEADS = 8
PEER_NKEYS = 128
PEER_EXPERTS = PEER_NKEYS * PEER_NKEYS
PEER_DKEY = 256
PEER_TOPK = 16
PEER_CHUNK = 128
NORM_EPS = 1e-6
FORGET_BIAS_INIT = 3.0

FOX_W = FOX_HEADS * HEAD_DIM
DIFF_QK_W = DIFF_HEADS * 2 * HEAD_DIM
DIFF_V_W = DIFF_HEADS * DIFF_V_DIM
EVEN_IN_W = 3 * FOX_W + FOX_HEADS + 2 * DIFF_QK_W + DIFF_V_W
EVEN_SPLITS = [int(v) for v in np.cumsum([FOX_W, FOX_W, FOX_W, FOX_HEADS, DIFF_QK_W, DIFF_QK_W])]
EVEN_OUT_W = FOX_W + DIFF_V_W

kernel_name = "hybrid_fox_diff_dilated_peer_adaln"


def rms_norm(x, gain):
    xf = x.astype(jnp.float32)
    y = xf * lax.rsqrt(jnp.mean(xf * xf, axis=-1, keepdims=True) + NORM_EPS)
    return (y * gain.astype(jnp.float32)).astype(x.dtype)


def t5_bucket(dist):
    n = jnp.maximum(dist, 0)
    nf = jnp.maximum(n, 1).astype(jnp.float32)
    large = BUCKET_MAX_EXACT + (jnp.log(nf / BUCKET_MAX_EXACT)
                                / math.log(BUCKET_MAX_DIST / BUCKET_MAX_EXACT)
                                * (N_BUCKETS - BUCKET_MAX_EXACT)).astype(jnp.int32)
    large = jnp.minimum(large, N_BUCKETS - 1)
    return jnp.where(n < BUCKET_MAX_EXACT, n, large)


def fox_attention(q, k, v, log_f_cum):
    b, s, h, dh = q.shape
    scale = dh ** -0.5
    kpos = jnp.arange(s)
    f_keys = log_f_cum.transpose(0, 2, 1)

    def block(i):
        t0 = i * Q_BLOCK
        qb = lax.dynamic_slice_in_dim(q, t0, Q_BLOCK, axis=1)
        fq = lax.dynamic_slice_in_dim(f_keys, t0, Q_BLOCK, axis=2)
        qpos = t0 + jnp.arange(Q_BLOCK)
        logits = jnp.einsum('bqhd,bkhd->bhqk', qb, k, preferred_element_type=jnp.float32) * scale
        logits = logits + fq[..., :, None] - f_keys[..., None, :]
        logits = jnp.where((qpos[:, None] >= kpos[None, :])[None, None], logits, -jnp.inf)
        p = jax.nn.softmax(logits, axis=-1)
        return jnp.einsum('bhqk,bkhd->bqhd', p.astype(v.dtype), v)

    out = lax.map(block, jnp.arange(s // Q_BLOCK))
    return out.transpose(1, 0, 2, 3, 4).reshape(b, s, h, dh)


def diff_attention(q, k, v, lam, bias_table):
    b, s, h, _, dh = q.shape
    scale = dh ** -0.5
    kpos = jnp.arange(s)

    def block(i):
        t0 = i * Q_BLOCK
        qb = lax.dynamic_slice_in_dim(q, t0, Q_BLOCK, axis=1)
        qpos = t0 + jnp.arange(Q_BLOCK)
        dist = qpos[:, None] - kpos[None, :]
        bias = bias_table[t5_bucket(dist)].astype(jnp.float32).transpose(2, 0, 1)
        logits = jnp.einsum('bqhmd,bkhmd->bhmqk', qb, k, preferred_element_type=jnp.float32) * scale
        logits = logits + bias[None, :, None]
        logits = jnp.where((dist >= 0)[None, None, None], logits, -jnp.inf)
        p = jax.nn.softmax(logits, axis=-1)
        attn = p[:, :, 0] - lam * p[:, :, 1]
        return jnp.einsum('bhqk,bkhe->bqhe', attn.astype(v.dtype), v)

    out = lax.map(block, jnp.arange(s // Q_BLOCK))
    return out.transpose(1, 0, 2, 3, 4).reshape(b, s, h, 2 * dh)


def dilated_attention(q, k, v, bias_table):
    b, s, h, dh = q.shape
    scale = dh ** -0.5
    outs, lses = [], []
    for window, dil in DIL_PATTERNS:
        span = window // dil
        n_sub = s // dil
        qb_len = math.gcd(Q_BLOCK, n_sub)
        nblk = n_sub // qb_len
        qs = q.reshape(b, nblk, qb_len, dil, h, dh)
        pad = ((0, 0), (span, 0), (0, 0), (0, 0), (0, 0))
        ks = jnp.pad(k.reshape(b, n_sub, dil, h, dh), pad)
        vs = jnp.pad(v.reshape(b, n_sub, dil, h, dh), pad)
        kidx = jnp.arange(nblk)[:, None] * qb_len + jnp.arange(qb_len + span)[None, :]
        kb = ks[:, kidx]
        vb = vs[:, kidx]
        step = jnp.arange(qb_len)[:, None] + span - jnp.arange(qb_len + span)[None, :]
        valid = ((step >= 0) & (step <= span))[None] & ((kidx - span) >= 0)[:, None, :]
        bias = bias_table[t5_bucket(step * dil)].astype(jnp.float32).transpose(2, 0, 1)
        logits = jnp.einsum('bnqrhd,bnkrhd->bnrhqk', qs, kb, preferred_element_type=jnp.float32) * scale
        logits = logits + bias[None, None, None]
        logits = jnp.where(valid[None, :, None, None], logits, -jnp.inf)
        lse = jax.nn.logsumexp(logits, axis=-1)
        probs = jnp.exp(logits - lse[..., None])
        o = jnp.einsum('bnrhqk,bnkrhd->bnqrhd', probs.astype(v.dtype), vb)
        outs.append(o.reshape(b, s, h, dh))
        lses.append(lse.transpose(0, 1, 4, 2, 3).reshape(b, s, h))
    w = jax.nn.softmax(jnp.stack(lses, axis=-1), axis=-1)
    return jnp.einsum('bshp,pbshd->bshd', w.astype(v.dtype), jnp.stack(outs))


def even_mixer(h, w_in, b_forget, fox_qk_gain, diff_qk_gain, diff_lambda,
               diff_subln_gain, w_out, diff_bias, lam_init):
    b, s, _ = h.shape
    proj = h @ w_in
    fq, fk, fv, ff, dq, dk, dv = jnp.split(proj, EVEN_SPLITS, axis=-1)
    fq = rms_norm(fq.reshape(b, s, FOX_HEADS, HEAD_DIM), fox_qk_gain[0])
    fk = rms_norm(fk.reshape(b, s, FOX_HEADS, HEAD_DIM), fox_qk_gain[1])
    fv = fv.reshape(b, s, FOX_HEADS, HEAD_DIM)
    log_f = jax.nn.log_sigmoid(ff.astype(jnp.float32) + b_forget.astype(jnp.float32))
    log_f_cum = jnp.cumsum(log_f, axis=1)
    fox_o = fox_attention(fq, fk, fv, log_f_cum)
    dq = rms_norm(dq.reshape(b, s, DIFF_HEADS, 2, HEAD_DIM), diff_qk_gain[0])
    dk = rms_norm(dk.reshape(b, s, DIFF_HEADS, 2, HEAD_DIM), diff_qk_gain[1])
    dv = dv.reshape(b, s, DIFF_HEADS, DIFF_V_DIM)
    lam_f = diff_lambda.astype(jnp.float32)
    lam = (jnp.exp(jnp.sum(lam_f[0] * lam_f[1])) - jnp.exp(jnp.sum(lam_f[2] * lam_f[3]))
           + lam_init)
    diff_o = diff_attention(dq, dk, dv, lam, diff_bias)
    diff_o = rms_norm(diff_o, diff_subln_gain) * (1.0 - lam_init)
    mixed = jnp.concatenate([fox_o.reshape(b, s, FOX_W),
                             diff_o.reshape(b, s, DIFF_V_W).astype(fox_o.dtype)], axis=-1)
    return mixed @ w_out


def odd_mixer(h, w_qkv, qk_gain, w_out, bias_table):
    b, s, _ = h.shape
    qkv = (h @ w_qkv).reshape(b, s, 3, DIL_HEADS, HEAD_DIM)
    q = rms_norm(qkv[:, :, 0], qk_gain[0])
    k = rms_norm(qkv[:, :, 1], qk_gain[1])
    o = dilated_attention(q, k, qkv[:, :, 2], bias_table)
    return o.reshape(b, s, DIL_HEADS * HEAD_DIM) @ w_out


def peer_ffn(h, w_query, sub_keys, expert_u, expert_v):
    b, s, d = h.shape
    t = b * s
    hf = h.reshape(t, d)
    q = (hf @ w_query).reshape(t, PEER_HEADS, 2, PEER_DKEY // 2)
    scores = jnp.einsum('thpd,pnd->thpn', q, sub_keys, preferred_element_type=jnp.float32)
    top_s, top_i = lax.top_k(scores, PEER_TOPK)
    cand_s = (top_s[:, :, 0, :, None] + top_s[:, :, 1, None, :]).reshape(t, PEER_HEADS, -1)
    cand_i = (top_i[:, :, 0, :, None] * PEER_NKEYS + top_i[:, :, 1, None, :]).reshape(t, PEER_HEADS, -1)
    best_s, best_pos = lax.top_k(cand_s, PEER_TOPK)
    expert_idx = jnp.take_along_axis(cand_i, best_pos, axis=-1)
    gates = jax.nn.softmax(best_s, axis=-1).astype(h.dtype)
    n_chunk = t // PEER_CHUNK

    def chunk(args):
        x_c, idx_c, g_c = args
        act = jax.nn.gelu(jnp.einsum('cd,chkd->chk', x_c, expert_u[idx_c]), approximate=False)
        return jnp.einsum('chk,chkd->cd', g_c * act, expert_v[idx_c])

    y = lax.map(chunk, (hf.reshape(n_chunk, PEER_CHUNK, d),
                        expert_idx.reshape(n_chunk, PEER_CHUNK, PEER_HEADS, PEER_TOPK),
                        gates.reshape(n_chunk, PEER_CHUNK, PEER_HEADS, PEER_TOPK)))
    return y.reshape(b, s, d)


def modulate(h, shift, scale):
    return h * (1.0 + scale[:, None, :]) + shift[:, None, :]


def setup_inputs(seed: int = 0) -> dict:
    key = jax.random.key(seed)
    ks = jax.random.split(key, 20)
    n_even = (DEPTH + 1) // 2
    n_odd = DEPTH // 2
    nrm = jax.random.normal
    f32 = jnp.float32
    sd = D_MODEL ** -0.5
    return {
        "x": nrm(ks[0], (BATCH, SEQ, D_MODEL), f32),
        "c": nrm(ks[1], (BATCH, D_MODEL), f32),
        "rel_bias": 0.3 * nrm(ks[2], (N_BUCKETS, N_BIAS_HEADS), f32),
        "norm_gain": 1.0 + 0.1 * nrm(ks[3], (DEPTH, 2, D_MODEL), f32),
        "w_ada": 0.5 * sd * nrm(ks[4], (DEPTH, D_MODEL, 6 * D_MODEL), f32),
        "b_ada": 0.02 * nrm(ks[5], (DEPTH, 6 * D_MODEL), f32),
        "even_w_in": sd * nrm(ks[6], (n_even, D_MODEL, EVEN_IN_W), f32),
        "even_b_forget": FORGET_BIAS_INIT + 0.5 * nrm(ks[7], (n_even, FOX_HEADS), f32),
        "even_fox_qk_gain": 1.0 + 0.1 * nrm(ks[8], (n_even, 2, HEAD_DIM), f32),
        "even_diff_qk_gain": 1.0 + 0.1 * nrm(ks[9], (n_even, 2, HEAD_DIM), f32),
        "even_diff_lambda": 0.1 * nrm(ks[10], (n_even, 4, HEAD_DIM), f32),
        "even_diff_subln_gain": 1.0 + 0.1 * nrm(ks[11], (n_even, DIFF_V_DIM), f32),
        "even_w_out": EVEN_OUT_W ** -0.5 * nrm(ks[12], (n_even, EVEN_OUT_W, D_MODEL), f32),
        "odd_w_qkv": sd * nrm(ks[13], (n_odd, D_MODEL, 3 * DIL_HEADS * HEAD_DIM), f32),
        "odd_qk_gain": 1.0 + 0.1 * nrm(ks[14], (n_odd, 2, HEAD_DIM), f32),
        "odd_w_out": sd * nrm(ks[15], (n_odd, DIL_HEADS * HEAD_DIM, D_MODEL), f32),
        "peer_w_query": sd * nrm(ks[16], (DEPTH, D_MODEL, PEER_HEADS * PEER_DKEY), f32),
        "peer_sub_keys": (PEER_DKEY // 2) ** -0.5 * nrm(ks[17], (DEPTH, 2, PEER_NKEYS, PEER_DKEY // 2), f32),
        "peer_u": sd * nrm(ks[18], (DEPTH, PEER_EXPERTS, D_MODEL), f32),
        "peer_v": PEER_TOPK ** -0.5 * nrm(ks[19], (DEPTH, PEER_EXPERTS, D_MODEL), f32),
    }


def reference(x, c, rel_bias, norm_gain, w_ada, b_ada,
              even_w_in, even_b_forget, even_fox_qk_gain, even_diff_qk_gain,
              even_diff_lambda, even_diff_subln_gain, even_w_out,
              odd_w_qkv, odd_qk_gain, odd_w_out,
              peer_w_query, peer_sub_keys, peer_u, peer_v):
    cond = jax.nn.silu(c)
    for i in range(DEPTH):
        mod = cond @ w_ada[i] + b_ada[i]
        sh1, sc1, g1, sh2, sc2, g2 = jnp.split(mod, 6, axis=-1)
        h = modulate(rms_norm(x, norm_gain[i, 0]), sh1, sc1)
        j = i // 2
        if i % 2 == 0:
            lam_init = 0.8 - 0.6 * math.exp(-0.3 * i)
            y = even_mixer(h, even_w_in[j], even_b_forget[j], even_fox_qk_gain[j],
                           even_diff_qk_gain[j], even_diff_lambda[j], even_diff_subln_gain[j],
                           even_w_out[j], rel_bias[:, :DIFF_HEADS], lam_init)
        else:
            y = odd_mixer(h, odd_w_qkv[j], odd_qk_gain[j], odd_w_out[j], rel_bias)
        x = x + g1[:, None, :] * y.astype(x.dtype)
        h = modulate(rms_norm(x, norm_gain[i, 1]), sh2, sc2)
        y = peer_ffn(h, peer_w_query[i], peer_sub_keys[i], peer_u[i], peer_v[i])
        x = x + g2[:, None, :] * y.astype(x.dtype)
    return x
```

```cpp
#include <hip/hip_runtime.h>
#include <hip/hip_cooperative_groups.h>
#include <stdint.h>
#include <stdio.h>
namespace cg = cooperative_groups;

#ifndef FUSED
#define FUSED 0
#endif

#define DI __device__ __forceinline__
typedef unsigned short bf16_t;
typedef __attribute__((ext_vector_type(8))) short bf16x8;
typedef __attribute__((ext_vector_type(4))) short bf16x4;
typedef __attribute__((ext_vector_type(16))) float f32x16;
typedef __attribute__((ext_vector_type(2))) __bf16 bf2_t;
typedef __attribute__((ext_vector_type(2))) float f2_t;
#define MFMA32(a, b, c) __builtin_amdgcn_mfma_f32_32x32x16_bf16((a), (b), (c), 0, 0, 0)

constexpr int T_ = 16384;
constexpr int D_ = 2048;
constexpr int S_ = 2048;
constexpr int NB_ = 8;
constexpr int NEXP = 16384;
constexpr float LOG2E = 1.4426950408889634f;
constexpr int NTHREADS = 256;
constexpr int SMEM_BYTES = 75776;

constexpr size_t MiB = 1048576;
constexpr size_t WS_PEERU = 0;
constexpr size_t WS_PEERV = WS_PEERU + 128 * MiB;
constexpr size_t WS_WQK0 = WS_PEERV + 128 * MiB;
constexpr size_t WS_WV0 = WS_WQK0 + 16 * MiB;
constexpr size_t WS_WQK1 = WS_WV0 + 8 * MiB;
constexpr size_t WS_WV1 = WS_WQK1 + 16 * MiB;
constexpr size_t WS_WO0 = WS_WV1 + 8 * MiB;
constexpr size_t WS_WO1 = WS_WO0 + 8 * MiB;
constexpr size_t WS_WQ0 = WS_WO1 + 8 * MiB;
constexpr size_t WS_WQ1 = WS_WQ0 + 8 * MiB;
constexpr size_t WS_SK = WS_WQ1 + 8 * MiB;
constexpr size_t WS_WFF = WS_SK + 131072;
constexpr size_t WS_MOD = WS_WFF + 65536;
constexpr size_t WS_LOGF = WS_MOD + 786432;
constexpr size_t WS_FCUM = WS_LOGF + 524288;
constexpr size_t WS_MISC = WS_FCUM + 524288;
constexpr size_t WS_H = WS_MISC + 65536;
constexpr size_t WS_QK = WS_H + 64 * MiB;
constexpr size_t WS_VT = WS_QK + 128 * MiB;
constexpr size_t WS_ATT = WS_VT + 64 * MiB;
constexpr size_t WS_SC = WS_ATT + 64 * MiB;
constexpr size_t WS_END = WS_SC + 128 * MiB;

struct Params {
  const float* x; const float* c; const float* rel_bias; const float* norm_gain; const float* w_ada; const float* b_ada;
  const float* even_w_in; const float* even_b_forget; const float* even_fox_qk_gain; const float* even_diff_qk_gain;
  const float* even_diff_lambda; const float* even_diff_subln_gain; const float* even_w_out;
  const float* odd_w_qkv; const float* odd_qk_gain; const float* odd_w_out;
  const float* peer_w_query; const float* peer_sub_keys; const float* peer_u; const float* peer_v;
  float* out; char* ws;
};

DI unsigned pack_bf2(float a, float b) { f2_t v = {a, b}; return __builtin_bit_cast(unsigned, __builtin_convertvector(v, bf2_t)); }
DI bf16_t f2bf(float a) { return (bf16_t)(pack_bf2(a, 0.f) & 0xffffu); }
DI float bf_lo(unsigned u) { return __uint_as_float(u << 16); }
DI float bf_hi(unsigned u) { return __uint_as_float(u & 0xffff0000u); }
DI int crow(int reg, int h) { return (reg & 3) + 8 * (reg >> 2) + 4 * h; }
DI float wave_sum(float v) {
#pragma unroll
  for (int o = 32; o >= 1; o >>= 1) v += __shfl_xor(v, o);
  return v;
}
DI float wave_max(float v) {
#pragma unroll
  for (int o = 32; o >= 1; o >>= 1) v = fmaxf(v, __shfl_xor(v, o));
  return v;
}

DI void transpose_tile(const float* __restrict__ src, int ld, int c0, int k0, bf16_t* __restrict__ dst_row0, char* smem) {
  float* tile = (float*)smem;
  const int tid = threadIdx.x;
  const int ty = tid >> 4, tx = tid & 15;
#pragma unroll
  for (int i = 0; i < 4; ++i) {
    const int k = ty + 16 * i;
    const float4 v = *(const float4*)(src + (size_t)(k0 + k) * ld + c0 + 4 * tx);
    float* t = tile + k * 65 + 4 * tx;
    t[0] = v.x; t[1] = v.y; t[2] = v.z; t[3] = v.w;
  }
  __syncthreads();
  const int cc = tid >> 2, kc = (tid & 3) * 16;
  unsigned pk[8];
#pragma unroll
  for (int j = 0; j < 8; ++j) pk[j] = pack_bf2(tile[(kc + 2 * j) * 65 + cc], tile[(kc + 2 * j + 1) * 65 + cc]);
  uint4* d = (uint4*)(dst_row0 + (size_t)cc * 2048 + k0 + kc);
  d[0] = make_uint4(pk[0], pk[1], pk[2], pk[3]);
  d[1] = make_uint4(pk[4], pk[5], pk[6], pk[7]);
  __syncthreads();
}

DI void phase_prep(const Params& p, char* smem) {
  const int tid = threadIdx.x, bid = blockIdx.x, G = gridDim.x;
  char* ws = p.ws;
  {
    float* cond = (float*)smem;
    bool have_cond = false;
    for (int item = bid; item < 384; item += G) {
      if (!have_cond) {
        for (int e = tid; e < NB_ * D_; e += NTHREADS) {
          const int b = e >> 11, d = e & 2047;
          const float v = p.c[e];
          cond[d * 8 + b] = v / (1.f + __expf(-v));
        }
        have_cond = true;
        __syncthreads();
      }
      const int i = item / 192, n = (item % 192) * 64 + (tid & 63);
      const int w = tid >> 6;
      const float* wp = p.w_ada + (size_t)i * D_ * 12288 + n;
      float acc[8];
#pragma unroll
      for (int b = 0; b < 8; ++b) acc[b] = 0.f;
#pragma unroll 8
      for (int d = w; d < D_; d += 4) {
        const float wv = wp[(size_t)d * 12288];
        const float4 c0 = *(const float4*)(cond + d * 8), c1 = *(const float4*)(cond + d * 8 + 4);
        acc[0] += c0.x * wv; acc[1] += c0.y * wv; acc[2] += c0.z * wv; acc[3] += c0.w * wv;
        acc[4] += c1.x * wv; acc[5] += c1.y * wv; acc[6] += c1.z * wv; acc[7] += c1.w * wv;
      }
      float* red = (float*)(smem + 65536);
#pragma unroll
      for (int b = 0; b < 8; ++b) red[(w * 64 + (tid & 63)) * 8 + b] = acc[b];
      __syncthreads();
      if (tid < 64) {
        float* mod = (float*)(ws + WS_MOD);
#pragma unroll
        for (int b = 0; b < 8; ++b) {
          const float s = red[(0 * 64 + tid) * 8 + b] + red[(1 * 64 + tid) * 8 + b] + red[(2 * 64 + tid) * 8 + b] + red[(3 * 64 + tid) * 8 + b];
          mod[((size_t)i * 8 + b) * 12288 + n] = s + p.b_ada[i * 12288 + n];
        }
      }
      __syncthreads();
    }
    __syncthreads();
  }
  {
    bf16_t* wqk0 = (bf16_t*)(ws + WS_WQK0); bf16_t* wv0 = (bf16_t*)(ws + WS_WV0);
    bf16_t* wqk1 = (bf16_t*)(ws + WS_WQK1); bf16_t* wv1 = (bf16_t*)(ws + WS_WV1);
    for (int item = bid; item < 320 * 32; item += G) {
      const int ct = item >> 5, kt = item & 31;
      const float* src; int ld, c0; bf16_t* dst;
      if (ct < 96) {
        const int seg = ct >> 4, cl = (ct & 15) * 64;
        src = p.even_w_in; ld = 6152;
        c0 = (seg < 3 ? seg * 1024 : 3080 + (seg - 3) * 1024) + cl;
        if (seg == 0) dst = wqk0 + (size_t)cl * 2048;
        else if (seg == 1) dst = wqk0 + (size_t)(1024 + cl) * 2048;
        else if (seg == 2) dst = wv0 + (size_t)cl * 2048;
        else if (seg == 3) dst = wqk0 + (size_t)(2048 + cl) * 2048;
        else if (seg == 4) dst = wqk0 + (size_t)(3072 + cl) * 2048;
        else dst = wv0 + (size_t)(1024 + cl) * 2048;
      } else if (ct < 192) {
        const int cl = (ct - 96) * 64;
        src = p.odd_w_qkv; ld = 6144; c0 = cl;
        dst = cl < 4096 ? wqk1 + (size_t)cl * 2048 : wv1 + (size_t)(cl - 4096) * 2048;
      } else {
        const int mi = (ct - 192) >> 5, cl = ((ct - 192) & 31) * 64;
        ld = 2048; c0 = cl;
        if (mi == 0) { src = p.even_w_out; dst = (bf16_t*)(ws + WS_WO0); }
        else if (mi == 1) { src = p.odd_w_out; dst = (bf16_t*)(ws + WS_WO1); }
        else if (mi == 2) { src = p.peer_w_query; dst = (bf16_t*)(ws + WS_WQ0); }
        else { src = p.peer_w_query + (size_t)2048 * 2048; dst = (bf16_t*)(ws + WS_WQ1); }
        dst += (size_t)cl * 2048;
      }
      transpose_tile(src, ld, c0, kt * 64, dst, smem);
    }
  }
  {
    const size_t n_peer = (size_t)2 * NEXP * D_;
    const size_t nchunks = n_peer / 2048;
    for (size_t item = bid; item < 2 * nchunks + 32; item += G) {
      const float* src; bf16_t* dst; size_t off;
      if (item < nchunks) { src = p.peer_u; dst = (bf16_t*)(ws + WS_PEERU); off = item * 2048; }
      else if (item < 2 * nchunks) { src = p.peer_v; dst = (bf16_t*)(ws + WS_PEERV); off = (item - nchunks) * 2048; }
      else { src = p.peer_sub_keys; dst = (bf16_t*)(ws + WS_SK); off = (item - 2 * nchunks) * 2048; }
      const float4 a = *(const float4*)(src + off + tid * 8), b = *(const float4*)(src + off + tid * 8 + 4);
      *(uint4*)(dst + off + tid * 8) = make_uint4(pack_bf2(a.x, a.y), pack_bf2(a.z, a.w), pack_bf2(b.x, b.y), pack_bf2(b.z, b.w));
    }
  }
  if (bid == G - 1) {
    float* wff = (float*)(ws + WS_WFF);
    for (int e = tid; e < 2048 * 8; e += NTHREADS) wff[e] = p.even_w_in[(size_t)(e >> 3) * 6152 + 3072 + (e & 7)];
    if (tid < 64) {
      const float* l = p.even_diff_lambda;
      float s1 = l[tid] * l[128 + tid] + l[64 + tid] * l[128 + 64 + tid];
      float s2 = l[256 + tid] * l[384 + tid] + l[256 + 64 + tid] * l[384 + 64 + tid];
      s1 = wave_sum(s1); s2 = wave_sum(s2);
      if (tid == 0) ((float*)(ws + WS_MISC))[0] = expf(s1) - expf(s2) + 0.2f;
    }
  }
}

template <bool FF>
DI void phase_norm(const Params& p, const float* __restrict__ xin, const float* __restrict__ gain,
                   const float* __restrict__ sh, const float* __restrict__ sc  ) {
  const int lane = threadIdx.x & 63;
  const int gw = (blockIdx.x * NTHREADS + threadIdx.x) >> 6, nw = (gridDim.x * NTHREADS) >> 6;
  bf16_t* H = (bf16_t*)(p.ws + WS_H);
  for (int t = gw; t < T_; t += nw) {
    const int b = t >> 11;
    const float* xr = xin + (size_t)t * D_;
    float4 v[8];
    float ss = 0.f;
#pragma unroll
    for (int i = 0; i < 8; ++i) { v[i] = *(const float4*)(xr + lane * 4 + 256 * i); ss += v[i].x * v[i].x + v[i].y * v[i].y + v[i].z * v[i].z + v[i].w * v[i].w; }
    ss = wave_sum(ss);
    const float rstd = rsqrtf(ss * (1.f / 2048.f) + 1e-6f);
    float ff[8];
    if (FF) {
#pragma unroll
      for (int j = 0; j < 8; ++j) ff[j] = 0.f;
    }
#pragma unroll
    for (int i = 0; i < 8; ++i) {
      const int c = lane * 4 + 256 * i;
      const float4 g = *(const float4*)(gain + c);
      const float4 s1 = *(const float4*)(sc + (size_t)b * 12288 + c);
      const float4 s0 = *(const float4*)(sh + (size_t)b * 12288 + c);
      float4 h;
      h.x = v[i].x * rstd * g.x * (1.f + s1.x) + s0.x;
      h.y = v[i].y * rstd * g.y * (1.f + s1.y) + s0.y;
      h.z = v[i].z * rstd * g.z * (1.f + s1.z) + s0.z;
      h.w = v[i].w * rstd * g.w * (1.f + s1.w) + s0.w;
      *(uint2*)(H + (size_t)t * D_ + c) = make_uint2(pack_bf2(h.x, h.y), pack_bf2(h.z, h.w));
      if (FF) {
        const float* wff = (const float*)(p.ws + WS_WFF) + c * 8;
        const float hv[4] = {h.x, h.y, h.z, h.w};
#pragma unroll
        for (int e = 0; e < 4; ++e) {
          const float4 w0 = *(const float4*)(wff + e * 8), w1 = *(const float4*)(wff + e * 8 + 4);
          ff[0] += hv[e] * w0.x; ff[1] += hv[e] * w0.y; ff[2] += hv[e] * w0.z; ff[3] += hv[e] * w0.w;
          ff[4] += hv[e] * w1.x; ff[5] += hv[e] * w1.y; ff[6] += hv[e] * w1.z; ff[7] += hv[e] * w1.w;
        }
      }
    }
    if (FF) {
#pragma unroll
      for (int j = 0; j < 8; ++j) ff[j] = wave_sum(ff[j]);
      if (lane < 8) {
        float z = ff[0];
#pragma unroll
        for (int j = 1; j < 8; ++j) z = (lane == j) ? ff[j] : z;
        z += p.even_b_forget[lane];
        const float lf = fminf(z, 0.f) - log1pf(__expf(-fabsf(z)));
        ((float*)(p.ws + WS_LOGF))[(size_t)t * 8 + lane] = lf;
      }
    }
  }
}

DI void fox_cumsum(const Params& p) {
  const int lane = threadIdx.x & 63;
  const int gw = (blockIdx.x * NTHREADS + threadIdx.x) >> 6, nw = (gridDim.x * NTHREADS) >> 6;
  const float* lf = (const float*)(p.ws + WS_LOGF);
  float* fc = (float*)(p.ws + WS_FCUM);
  for (int it = gw; it < 64; it += nw) {
    const int b = it >> 3, hh = it & 7;
    float v[32];
    float tot = 0.f;
#pragma unroll
    for (int j = 0; j < 32; ++j) { tot += lf[(size_t)(b * S_ + lane * 32 + j) * 8 + hh]; v[j] = tot; }
    float inc = tot;
#pragma unroll
    for (int o = 1; o < 64; o <<= 1) { const float n = __shfl_up(inc, o); if (lane >= o) inc += n; }
    const float base = inc - tot;
#pragma unroll
    for (int j = 0; j < 32; ++j) fc[(size_t)it * S_ + lane * 32 + j] = v[j] + base;
  }
}

DI void gemm_tile_compute(const bf16_t* __restrict__ A, int lda, const bf16_t* __restrict__ B, int ldb, int K,
                          char* smem, f32x16 (&acc)[2][2]) {
  const int tid = threadIdx.x, lane = tid & 63, wave = tid >> 6;
  const int r = lane & 31, h = lane >> 5;
  const int wm = wave >> 1, wn = wave & 1;
  const int srow = tid >> 3, sc = tid & 7;
  const bf16_t* ga = A + (size_t)srow * lda + sc * 8;
  const bf16_t* gb = B + (size_t)srow * ldb + sc * 8;
  uint4 ra[4], rb[4];
#pragma unroll
  for (int i = 0; i < 4; ++i) {
    ra[i] = *(const uint4*)(ga + (size_t)(32 * i) * lda);
    rb[i] = *(const uint4*)(gb + (size_t)(32 * i) * ldb);
  }
  const int woff = srow * 128 + ((sc ^ ((srow >> 1) & 7)) << 4);
  const int rsw = (r >> 1) & 7;
  const int aoff = (wm * 64 + r) * 128, boff = 16384 + (wn * 64 + r) * 128;
#pragma unroll
  for (int i = 0; i < 2; ++i)
#pragma unroll
    for (int j = 0; j < 2; ++j)
#pragma unroll
      for (int e = 0; e < 16; ++e) acc[i][j][e] = 0.f;
#pragma unroll
  for (int i = 0; i < 4; ++i) {
    *(uint4*)(smem + woff + i * 4096) = ra[i];
    *(uint4*)(smem + 16384 + woff + i * 4096) = rb[i];
  }
  __syncthreads();
  const int KT = K >> 6;
  for (int kt = 0; kt < KT; ++kt) {
    char* st = smem + (kt & 1) * 32768;
    if (kt + 1 < KT) {
#pragma unroll
      for (int i = 0; i < 4; ++i) {
        ra[i] = *(const uint4*)(ga + (size_t)(32 * i) * lda + (kt + 1) * 64);
        rb[i] = *(const uint4*)(gb + (size_t)(32 * i) * ldb + (kt + 1) * 64);
      }
    }
#pragma unroll
    for (int s = 0; s < 4; ++s) {
      const int co = ((2 * s + h) ^ rsw) << 4;
      bf16x8 af[2], bfr[2];
      af[0] = *(const bf16x8*)(st + aoff + co);
      af[1] = *(const bf16x8*)(st + aoff + 32 * 128 + co);
      bfr[0] = *(const bf16x8*)(st + boff + co);
      bfr[1] = *(const bf16x8*)(st + boff + 32 * 128 + co);
#pragma unroll
      for (int i = 0; i < 2; ++i)
#pragma unroll
        for (int j = 0; j < 2; ++j) acc[i][j] = MFMA32(af[i], bfr[j], acc[i][j]);
    }
    if (kt + 1 < KT) {
      char* sn = smem + ((kt + 1) & 1) * 32768;
#pragma unroll
      for (int i = 0; i < 4; ++i) {
        *(uint4*)(sn + woff + i * 4096) = ra[i];
        *(uint4*)(sn + 16384 + woff + i * 4096) = rb[i];
      }
    }
    __syncthreads();
  }
}

enum { EPI_BF16 = 0, EPI_NORM_BF16 = 1, EPI_RES_F32 = 2, EPI_F32 = 3 };
struct EpiArgs {
  void* out; int ldc;
  const float* gainA; const float* gainB; int gshift;
  const float* xin; const float* gate;
};

template <int EPI>
DI void gemm_epilogue(f32x16 (&acc)[2][2], int m0, int n0, int tn, const EpiArgs& ea, char* smem) {
  const int tid = threadIdx.x, lane = tid & 63, wave = tid >> 6;
  const int r = lane & 31, h = lane >> 5;
  const int wm = wave >> 1, wn = wave & 1;
  if (EPI == EPI_NORM_BF16) {
    float* red = (float*)smem;
    float ss[2][16];
#pragma unroll
    for (int i = 0; i < 2; ++i)
#pragma unroll
      for (int e = 0; e < 16; ++e) {
        float v = acc[i][0][e] * acc[i][0][e] + acc[i][1][e] * acc[i][1][e];
#pragma unroll
        for (int o = 16; o >= 1; o >>= 1) v += __shfl_xor(v, o);
        ss[i][e] = v;
      }
    if (r == 0) {
#pragma unroll
      for (int i = 0; i < 2; ++i)
#pragma unroll
        for (int e = 0; e < 16; ++e) red[wn * 128 + wm * 64 + i * 32 + crow(e, h)] = ss[i][e];
    }
    __syncthreads();
    const int grp = tn >> ea.gshift;
    const float* gain = ((grp & 2) ? ea.gainB : ea.gainA) + (grp & 1) * 128;
    bf16_t* out = (bf16_t*)ea.out;
#pragma unroll
    for (int i = 0; i < 2; ++i)
#pragma unroll
      for (int e = 0; e < 16; ++e) {
        const int rl = wm * 64 + i * 32 + crow(e, h);
        const float rstd = rsqrtf((red[rl] + red[128 + rl]) * (1.f / 128.f) + 1e-6f);
#pragma unroll
        for (int j = 0; j < 2; ++j) {
          const int cl = wn * 64 + j * 32 + r;
          out[(size_t)(m0 + rl) * ea.ldc + n0 + cl] = f2bf(acc[i][j][e] * rstd * gain[cl]);
        }
      }
    __syncthreads();
  } else {
#pragma unroll
    for (int i = 0; i < 2; ++i)
#pragma unroll
      for (int e = 0; e < 16; ++e) {
        const int row = m0 + wm * 64 + i * 32 + crow(e, h);
#pragma unroll
        for (int j = 0; j < 2; ++j) {
          const int col = n0 + wn * 64 + j * 32 + r;
          const float v = acc[i][j][e];
          if (EPI == EPI_BF16) ((bf16_t*)ea.out)[(size_t)row * ea.ldc + col] = f2bf(v);
          else if (EPI == EPI_F32) ((float*)ea.out)[(size_t)row * ea.ldc + col] = v;
          else {
            const float g = ea.gate[(size_t)(row >> 11) * 12288 + col];
            ((float*)ea.out)[(size_t)row * ea.ldc + col] = ea.xin[(size_t)row * ea.ldc + col] + g * v;
          }
        }
      }
  }
}

template <int EPI>
DI void gemm_phase(const bf16_t* A, int lda, const bf16_t* B, int ldb, int K, int mt, int nt, const EpiArgs& ea, char* smem) {
  const int bid = blockIdx.x, G = gridDim.x;
  const int xcd = bid & 7, slot = bid >> 3, nslots = G >> 3;
  const int nsn = nt >> 3, nsup = (mt >> 3) * nsn;
  const int cnt = (nsup - xcd + 7) >> 3;
  for (int j = slot; j < cnt * 64; j += nslots) {
    const int sup = xcd + 8 * (j >> 6), within = j & 63;
    const int sm = sup / nsn, sn = sup - sm * nsn;
    const int tm = sm * 8 + (within >> 3), tn = sn * 8 + (within & 7);
    f32x16 acc[2][2];
    gemm_tile_compute(A + (size_t)tm * 128 * lda, lda, B + (size_t)tn * 128 * ldb, ldb, K, smem, acc);
    gemm_epilogue<EPI>(acc, tm * 128, tn * 128, tn, ea, smem);
  }
}

template <int MODE>
DI void attn_wave(const bf16_t* __restrict__ Qp, int ldq, const bf16_t* __restrict__ Kp, int ldk,
                  const bf16_t* __restrict__ Vt, int ldv, const float* __restrict__ kbias, const float* tbl,
                  int q0, f32x16 (&o)[4], float& l_out) {
  const int lane = threadIdx.x & 63, r = lane & 31, h = lane >> 5;
  const float scale2 = 0.08838834764831845f * LOG2E;
  bf16x8 qf[8];
#pragma unroll
  for (int s = 0; s < 8; ++s) qf[s] = *(const bf16x8*)(Qp + (size_t)(q0 + r) * ldq + 16 * s + 8 * h);
#pragma unroll
  for (int dt = 0; dt < 4; ++dt)
#pragma unroll
    for (int e = 0; e < 16; ++e) o[dt][e] = 0.f;
  float m = -1e30f, l = 0.f;
  const int nkt = (q0 >> 5) + 1;
  for (int kt = 0; kt < nkt; ++kt) {
    const int k0 = kt << 5;
    bf16x8 kf[8];
#pragma unroll
    for (int s = 0; s < 8; ++s) kf[s] = *(const bf16x8*)(Kp + (size_t)(k0 + r) * ldk + 16 * s + 8 * h);
    bf16x4 vf[4][2][2];
#pragma unroll
    for (int dt = 0; dt < 4; ++dt)
#pragma unroll
      for (int s = 0; s < 2; ++s) {
        const bf16_t* vp = Vt + (size_t)(32 * dt + r) * ldv + k0 + 16 * s + 4 * h;
        vf[dt][s][0] = *(const bf16x4*)(vp);
        vf[dt][s][1] = *(const bf16x4*)(vp + 8);
      }
    f32x16 sa;
#pragma unroll
    for (int e = 0; e < 16; ++e) sa[e] = 0.f;
#pragma unroll
    for (int s = 0; s < 8; ++s) sa = MFMA32(kf[s], qf[s], sa);
    float v[16];
    if (MODE == 0) {
#pragma unroll
      for (int c = 0; c < 4; ++c) {
        const float4 kb = *(const float4*)(kbias + k0 + 8 * c + 4 * h);
        v[4 * c + 0] = sa[4 * c + 0] * scale2 - kb.x * LOG2E;
        v[4 * c + 1] = sa[4 * c + 1] * scale2 - kb.y * LOG2E;
        v[4 * c + 2] = sa[4 * c + 2] * scale2 - kb.z * LOG2E;
        v[4 * c + 3] = sa[4 * c + 3] * scale2 - kb.w * LOG2E;
      }
      if (kt == nkt - 1) {
#pragma unroll
        for (int e = 0; e < 16; ++e) if (crow(e, h) > r) v[e] = -INFINITY;
      }
    } else {
      const float* tp = tbl + (q0 - k0) + r + 32 - 4 * h - 27;
#pragma unroll
      for (int e = 0; e < 16; ++e) v[e] = sa[e] * scale2 + tp[27 - ((e & 3) + 8 * (e >> 2))];
    }
    float mx = v[0];
#pragma unroll
    for (int e = 1; e < 16; ++e) mx = fmaxf(mx, v[e]);
    mx = fmaxf(mx, __shfl_xor(mx, 32));
    const float mn = fmaxf(m, mx);
    const float alpha = exp2f(m - mn);
    m = mn;
    float ps = 0.f;
#pragma unroll
    for (int e = 0; e < 16; ++e) { v[e] = exp2f(v[e] - mn); ps += v[e]; }
    l = l * alpha + ps;
#pragma unroll
    for (int dt = 0; dt < 4; ++dt)
#pragma unroll
      for (int e = 0; e < 16; ++e) o[dt][e] *= alpha;
    bf16x8 pb[2];
#pragma unroll
    for (int s = 0; s < 2; ++s) {
      const uint4 u = make_uint4(pack_bf2(v[8 * s + 0], v[8 * s + 1]), pack_bf2(v[8 * s + 2], v[8 * s + 3]),
                                 pack_bf2(v[8 * s + 4], v[8 * s + 5]), pack_bf2(v[8 * s + 6], v[8 * s + 7]));
      pb[s] = __builtin_bit_cast(bf16x8, u);
    }
#pragma unroll
    for (int dt = 0; dt < 4; ++dt)
#pragma unroll
      for (int s = 0; s < 2; ++s) {
        const bf16x8 va = __builtin_shufflevector(vf[dt][s][0], vf[dt][s][1], 0, 1, 2, 3, 4, 5, 6, 7);
        o[dt] = MFMA32(va, pb[s], o[dt]);
      }
  }
  l_out = l + __shfl_xor(l, 32);
}

DI void attn_store_bf16(const f32x16 (&o)[4], float linv, bf16_t* __restrict__ out_row  , int ldo) {
  const int lane = threadIdx.x & 63, r = lane & 31, h = lane >> 5;
  bf16_t* op = out_row + (size_t)r * ldo + 4 * h;
#pragma unroll
  for (int dt = 0; dt < 4; ++dt)
#pragma unroll
    for (int c = 0; c < 4; ++c)
      *(uint2*)(op + 32 * dt + 8 * c) = make_uint2(pack_bf2(o[dt][4 * c] * linv, o[dt][4 * c + 1] * linv),
                                                    pack_bf2(o[dt][4 * c + 2] * linv, o[dt][4 * c + 3] * linv));
}

DI int t5_bucket(int n) {
  if (n < 16) return n;
  int lg = 16 + (int)(logf((float)n / 16.f) / 4.852030263919617f * 16.f);
  return lg < 31 ? lg : 31;
}

DI void phase_attn_even(const Params& p, char* smem) {
  const int tid = threadIdx.x, wave = tid >> 6, bid = blockIdx.x, G = gridDim.x;
  const bf16_t* QK = (const bf16_t*)(p.ws + WS_QK);
  const bf16_t* VT = (const bf16_t*)(p.ws + WS_VT);
  bf16_t* ATT = (bf16_t*)(p.ws + WS_ATT);
  float* pieces = (float*)smem;
  float* tbl = (float*)(smem + 66048);
  const float lam = ((const float*)(p.ws + WS_MISC))[0];
  for (int item = bid; item < 3072; item += G) {
    const int g = item / 192; int rem = item - g * 192;
    const int qb = 15 - g;
    if (rem < 64) {
      const int b = rem >> 3, hh = rem & 7;
      const int q0 = qb * 128 + 32 * wave;
      const bf16_t* Qp = QK + (size_t)b * S_ * 4096 + hh * 128;
      f32x16 o[4]; float l;
      attn_wave<0>(Qp, 4096, Qp + 1024, 4096, VT + (size_t)(hh * 128) * T_ + b * S_, T_,
                   (const float*)(p.ws + WS_FCUM) + (size_t)(b * 8 + hh) * S_, nullptr, q0, o, l);
      attn_store_bf16(o, 1.f / l, ATT + (size_t)(b * S_ + q0) * D_ + hh * 128, D_);
    } else {
      rem -= 64;
      const int qt = 4 * qb + 3 - (rem >> 5);
      const int bh = rem & 31, b = bh >> 2, hh = bh & 3;
      const int q0 = qt * 32;
      for (int e = tid; e < 2080; e += NTHREADS) {
        const int dist = e - 32;
        tbl[e] = dist >= 0 ? p.rel_bias[t5_bucket(dist) * 16 + hh] * LOG2E : -INFINITY;
      }
      __syncthreads();
      const int mm = wave >> 1, half = wave & 1;
      const bf16_t* Qp = QK + (size_t)b * S_ * 4096 + 2048 + hh * 256 + mm * 128;
      f32x16 o[4]; float l;
      attn_wave<1>(Qp, 4096, Qp + 1024, 4096, VT + (size_t)(1024 + hh * 256 + half * 128) * T_ + b * S_, T_,
                   nullptr, tbl, q0, o, l);
      {
        const int lane = tid & 63, r = lane & 31, h = lane >> 5;
        const float linv = 1.f / l;
        float* pw = pieces + (wave * 32 + r) * 129;
#pragma unroll
        for (int dt = 0; dt < 4; ++dt)
#pragma unroll
          for (int e = 0; e < 16; ++e) pw[32 * dt + crow(e, h)] = o[dt][e] * linv;
      }
      __syncthreads();
      {
        const int q = tid >> 3, d0 = (tid & 7) * 32;
        const int half2 = d0 >> 7, dl = d0 & 127;
        const float* p0 = pieces + ((0 * 2 + half2) * 32 + q) * 129 + dl;
        const float* p1 = pieces + ((1 * 2 + half2) * 32 + q) * 129 + dl;
        float val[32]; float ss = 0.f;
#pragma unroll
        for (int j = 0; j < 32; ++j) { val[j] = p0[j] - lam * p1[j]; ss += val[j] * val[j]; }
        ss += __shfl_xor(ss, 1); ss += __shfl_xor(ss, 2); ss += __shfl_xor(ss, 4);
        const float rstd = rsqrtf(ss * (1.f / 256.f) + 1e-6f) * 0.8f;
        const float* sg = p.even_diff_subln_gain + d0;
        bf16_t* op = ATT + (size_t)(b * S_ + q0 + q) * D_ + 1024 + hh * 256 + d0;
#pragma unroll
        for (int j = 0; j < 32; j += 8) {
          *(uint4*)(op + j) = make_uint4(pack_bf2(val[j] * rstd * sg[j], val[j + 1] * rstd * sg[j + 1]),
                                         pack_bf2(val[j + 2] * rstd * sg[j + 2], val[j + 3] * rstd * sg[j + 3]),
                                         pack_bf2(val[j + 4] * rstd * sg[j + 4], val[j + 5] * rstd * sg[j + 5]),
                                         pack_bf2(val[j + 6] * rstd * sg[j + 6], val[j + 7] * rstd * sg[j + 7]));
        }
      }
      __syncthreads();
    }
  }
}

DI void phase_attn_odd(const Params& p, char* smem) {
  const int tid = threadIdx.x, wave = tid >> 6, bid = blockIdx.x, G = gridDim.x;
  const bf16_t* QK = (const bf16_t*)(p.ws + WS_QK);
  const bf16_t* VT = (const bf16_t*)(p.ws + WS_VT);
  bf16_t* ATT = (bf16_t*)(p.ws + WS_ATT);
  float* tbl = (float*)(smem + 66048);
  int cur_head = -1;
  for (int item = bid; item < 2048; item += G) {
    const int g = item >> 7, rem = item & 127;
    const int qb = 15 - g, b = rem >> 4, hd = rem & 15;
    if (hd != cur_head) {
      __syncthreads();
      for (int e = tid; e < 2080; e += NTHREADS) {
        const int dist = e - 32;
        float val = -INFINITY;
        if (dist >= 0) {
          int cnt = 0;
          if (dist <= 128) cnt += 1;
          if (dist <= 512 && (dist & 3) == 0) cnt += 1;
          if ((dist & 15) == 0) cnt += 1;
          if (cnt > 0) val = (p.rel_bias[t5_bucket(dist) * 16 + hd] + __logf((float)cnt)) * LOG2E;
        }
        tbl[e] = val;
      }
      cur_head = hd;
      __syncthreads();
    }
    const int q0 = qb * 128 + 32 * wave;
    const bf16_t* Qp = QK + (size_t)b * S_ * 4096 + hd * 128;
    f32x16 o[4]; float l;
    attn_wave<1>(Qp, 4096, Qp + 2048, 4096, VT + (size_t)(hd * 128) * T_ + b * S_, T_, nullptr, tbl, q0, o, l);
    attn_store_bf16(o, 1.f / l, ATT + (size_t)(b * S_ + q0) * D_ + hd * 128, D_);
  }
}

DI unsigned fkey(float f) { const unsigned u = __float_as_uint(f); return (u & 0x80000000u) ? ~u : (u | 0x80000000u); }
DI int popc64(unsigned long long m) { return __popcll(m); }
DI int mbcnt(unsigned long long m) { return __builtin_amdgcn_mbcnt_hi((unsigned)(m >> 32), __builtin_amdgcn_mbcnt_lo((unsigned)m, 0)); }

template <int NV>
DI void select16(const unsigned (&key)[NV], bool (&sel)[NV], int (&pos)[NV]) {
  unsigned thr = 0;
#pragma unroll 1
  for (int bit = 31; bit >= 0; --bit) {
    const unsigned cand = thr | (1u << bit);
    int cnt = 0;
#pragma unroll
    for (int a = 0; a < NV; ++a) cnt += popc64(__ballot(key[a] >= cand));
    if (cnt >= 16) thr = cand;
  }
  int cgt = 0;
#pragma unroll
  for (int a = 0; a < NV; ++a) cgt += popc64(__ballot(key[a] > thr));
  const int need = 16 - cgt;
  int eqbase = 0, sbase = 0;
#pragma unroll
  for (int a = 0; a < NV; ++a) {
    const bool eq = key[a] == thr;
    const unsigned long long em = __ballot(eq);
    const bool s = (key[a] > thr) || (eq && (eqbase + mbcnt(em)) < need);
    eqbase += popc64(em);
    const unsigned long long sm = __ballot(s);
    sel[a] = s; pos[a] = sbase + mbcnt(sm);
    sbase += popc64(sm);
  }
}

DI float gelu_erf(float x) { return 0.5f * x * (1.f + erff(x * 0.7071067811865476f)); }

DI void phase_peer(const Params& p, int layer, const float* __restrict__ gate2  , char* smem) {
  const int tid = threadIdx.x, lane = tid & 63, wave = tid >> 6;
  const int gw = (blockIdx.x * NTHREADS + tid) >> 6, nw = (gridDim.x * NTHREADS) >> 6;
  float* wl_s = (float*)(smem + wave * 2048);
  int* wl_i = (int*)(smem + wave * 2048 + 128);
  int* ex_i = (int*)(smem + wave * 2048 + 256);
  float* ex_g = (float*)(smem + wave * 2048 + 768);
  const float* SC = (const float*)(p.ws + WS_SC);
  const bf16_t* H = (const bf16_t*)(p.ws + WS_H);
  const bf16_t* PU = (const bf16_t*)(p.ws + WS_PEERU) + (size_t)layer * NEXP * D_;
  const bf16_t* PV = (const bf16_t*)(p.ws + WS_PEERV) + (size_t)layer * NEXP * D_;
  for (int t = gw; t < T_; t += nw) {
#pragma unroll 1
    for (int hh = 0; hh < 8; ++hh) {
      const float* sr = SC + ((size_t)t * 8 + hh) * 256;
      float sv[4];
#pragma unroll
      for (int a = 0; a < 4; ++a) sv[a] = sr[a * 64 + lane];
#pragma unroll
      for (int pp = 0; pp < 2; ++pp) {
        unsigned key[2] = {fkey(sv[2 * pp]), fkey(sv[2 * pp + 1])};
        bool sel[2]; int pos[2];
        select16<2>(key, sel, pos);
#pragma unroll
        for (int a = 0; a < 2; ++a) if (sel[a]) { wl_s[pp * 16 + pos[a]] = sv[2 * pp + a]; wl_i[pp * 16 + pos[a]] = a * 64 + lane; }
      }
      const float sa = wl_s[lane >> 2];
      const int ia = wl_i[lane >> 2];
      float cs[4]; int ci[4]; unsigned key[4];
#pragma unroll
      for (int j = 0; j < 4; ++j) {
        cs[j] = sa + wl_s[16 + (lane & 3) * 4 + j];
        ci[j] = ia * 128 + wl_i[16 + (lane & 3) * 4 + j];
        key[j] = fkey(cs[j]);
      }
      bool sel[4]; int pos[4];
      select16<4>(key, sel, pos);
      float mx = -INFINITY;
#pragma unroll
      for (int j = 0; j < 4; ++j) if (sel[j]) mx = fmaxf(mx, cs[j]);
      mx = wave_max(mx);
      float e[4]; float es = 0.f;
#pragma unroll
      for (int j = 0; j < 4; ++j) { e[j] = sel[j] ? __expf(cs[j] - mx) : 0.f; es += e[j]; }
      es = wave_sum(es);
      const float inv = 1.f / es;
#pragma unroll
      for (int j = 0; j < 4; ++j) if (sel[j]) { ex_i[hh * 16 + pos[j]] = ci[j]; ex_g[hh * 16 + pos[j]] = e[j] * inv; }
    }
    unsigned xr[16];
    {
      const bf16_t* hr = H + (size_t)t * D_ + lane * 8;
#pragma unroll
      for (int i = 0; i < 4; ++i) {
        const uint4 u = *(const uint4*)(hr + 512 * i);
        xr[4 * i] = u.x; xr[4 * i + 1] = u.y; xr[4 * i + 2] = u.z; xr[4 * i + 3] = u.w;
      }
    }
    float y[32];
#pragma unroll
    for (int j = 0; j < 32; ++j) y[j] = 0.f;
#pragma unroll 1
    for (int eb = 0; eb < 128; eb += 4) {
      uint4 ur[4][4], vr[4][4];
      float gt[4];
#pragma unroll
      for (int q = 0; q < 4; ++q) {
        const int id = __builtin_amdgcn_readfirstlane(ex_i[eb + q]);
        gt[q] = ex_g[eb + q];
        const bf16_t* up = PU + (size_t)id * D_ + lane * 8;
        const bf16_t* vp = PV + (size_t)id * D_ + lane * 8;
#pragma unroll
        for (int i = 0; i < 4; ++i) { ur[q][i] = *(const uint4*)(up + 512 * i); vr[q][i] = *(const uint4*)(vp + 512 * i); }
      }
      float dt[4];
#pragma unroll
      for (int q = 0; q < 4; ++q) {
        float a = 0.f;
#pragma unroll
        for (int i = 0; i < 4; ++i) {
          a = __builtin_amdgcn_fdot2_f32_bf16(__builtin_bit_cast(bf2_t, ur[q][i].x), __builtin_bit_cast(bf2_t, xr[4 * i]), a, false);
          a = __builtin_amdgcn_fdot2_f32_bf16(__builtin_bit_cast(bf2_t, ur[q][i].y), __builtin_bit_cast(bf2_t, xr[4 * i + 1]), a, false);
          a = __builtin_amdgcn_fdot2_f32_bf16(__builtin_bit_cast(bf2_t, ur[q][i].z), __builtin_bit_cast(bf2_t, xr[4 * i + 2]), a, false);
          a = __builtin_amdgcn_fdot2_f32_bf16(__builtin_bit_cast(bf2_t, ur[q][i].w), __builtin_bit_cast(bf2_t, xr[4 * i + 3]), a, false);
        }
        dt[q] = a;
      }
#pragma unroll
      for (int o = 32; o >= 1; o >>= 1) {
#pragma unroll
        for (int q = 0; q < 4; ++q) dt[q] += __shfl_xor(dt[q], o);
      }
#pragma unroll
      for (int q = 0; q < 4; ++q) {
        const float cf = gt[q] * gelu_erf(dt[q]);
#pragma unroll
        for (int i = 0; i < 4; ++i) {
          const unsigned w[4] = {vr[q][i].x, vr[q][i].y, vr[q][i].z, vr[q][i].w};
#pragma unroll
          for (int k = 0; k < 4; ++k) {
            y[8 * i + 2 * k] += cf * bf_lo(w[k]);
            y[8 * i + 2 * k + 1] += cf * bf_hi(w[k]);
          }
        }
      }
    }
    {
      const int b = t >> 11;
      float* orow = p.out + (size_t)t * D_ + lane * 8;
      const float* grow = gate2 + (size_t)b * 12288 + lane * 8;
#pragma unroll
      for (int i = 0; i < 4; ++i) {
        float4 a0 = *(const float4*)(orow + 512 * i), a1 = *(const float4*)(orow + 512 * i + 4);
        const float4 g0 = *(const float4*)(grow + 512 * i), g1 = *(const float4*)(grow + 512 * i + 4);
        a0.x += g0.x * y[8 * i]; a0.y += g0.y * y[8 * i + 1]; a0.z += g0.z * y[8 * i + 2]; a0.w += g0.w * y[8 * i + 3];
        a1.x += g1.x * y[8 * i + 4]; a1.y += g1.y * y[8 * i + 5]; a1.z += g1.z * y[8 * i + 6]; a1.w += g1.w * y[8 * i + 7];
        *(float4*)(orow + 512 * i) = a0; *(float4*)(orow + 512 * i + 4) = a1;
      }
    }
  }
}

DI void phase_peer_scores(const Params& p, int layer, char* smem) {
  const bf16_t* QP = (const bf16_t*)(p.ws + WS_QK);
  const bf16_t* SK = (const bf16_t*)(p.ws + WS_SK) + (size_t)layer * 2 * 128 * 128;
  EpiArgs ea{}; ea.out = nullptr; ea.ldc = 256;
  for (int L = blockIdx.x; L < 2048; L += gridDim.x) {
    const int pp = L & 1, tm = L >> 1;
    f32x16 acc[2][2];
    gemm_tile_compute(QP + (size_t)tm * 128 * 256 + pp * 128, 256, SK + (size_t)pp * 128 * 128, 128, 128, smem, acc);
    ea.out = (float*)(p.ws + WS_SC) + pp * 128;
    gemm_epilogue<EPI_F32>(acc, tm * 128, 0, 0, ea, smem);
  }
}

constexpr int N_PHASES = 17;
DI void run_phase(const Params& p, int ph, char* smem) {
  char* ws = p.ws;
  const float* mod = (const float*)(ws + WS_MOD);
  const bf16_t* H = (const bf16_t*)(ws + WS_H);
  if (ph == 0) { phase_prep(p, smem); return; }
  const int layer = (ph - 1) >> 3, sub = (ph - 1) & 7;
  const float* modl = mod + (size_t)layer * 8 * 12288;
  switch (sub) {
    case 0:
      if (layer == 0) phase_norm<true>(p, p.x, p.norm_gain, modl, modl + 2048);
      else phase_norm<false>(p, p.out, p.norm_gain + 2 * 2048, modl, modl + 2048);
      break;
    case 1: {
      if (layer == 0) fox_cumsum(p);
      EpiArgs ea{}; ea.out = ws + WS_QK; ea.ldc = 4096;
      if (layer == 0) {
        ea.gainA = p.even_fox_qk_gain; ea.gainB = p.even_diff_qk_gain; ea.gshift = 3;
      } else { ea.gainA = p.odd_qk_gain; ea.gainB = p.odd_qk_gain; ea.gshift = 4; }
      gemm_phase<EPI_NORM_BF16>(H, 2048, (const bf16_t*)(ws + (layer ? WS_WQK1 : WS_WQK0)), 2048, 2048, 128, 32, ea, smem);
      EpiArgs ev{}; ev.out = ws + WS_VT; ev.ldc = T_;
      gemm_phase<EPI_BF16>((const bf16_t*)(ws + (layer ? WS_WV1 : WS_WV0)), 2048, H, 2048, 2048, 16, 128, ev, smem);
    } break;
    case 2:
      if (layer == 0) phase_attn_even(p, smem); else phase_attn_odd(p, smem);
      break;
    case 3: {
      EpiArgs ea{}; ea.out = p.out; ea.ldc = 2048; ea.xin = layer ? p.out : p.x; ea.gate = modl + 2 * 2048;
      gemm_phase<EPI_RES_F32>((const bf16_t*)(ws + WS_ATT), 2048, (const bf16_t*)(ws + (layer ? WS_WO1 : WS_WO0)), 2048, 2048, 128, 16, ea, smem);
    } break;
    case 4:
      phase_norm<false>(p, p.out, p.norm_gain + (layer * 2 + 1) * 2048, modl + 3 * 2048, modl + 4 * 2048);
      break;
    case 5: {
      EpiArgs ea{}; ea.out = ws + WS_QK; ea.ldc = 2048;
      gemm_phase<EPI_BF16>(H, 2048, (const bf16_t*)(ws + (layer ? WS_WQ1 : WS_WQ0)), 2048, 2048, 128, 16, ea, smem);
    } break;
    case 6: phase_peer_scores(p, layer, smem); break;
    case 7: phase_peer(p, layer, modl + 5 * 2048, smem); break;
  }
}

#if FUSED
__global__ void __launch_bounds__(NTHREADS, 2) mega_kernel(Params p) {
  extern __shared__ __attribute__((aligned(16))) char smem[];
  cg::grid_group grid = cg::this_grid();
  for (int ph = 0; ph < N_PHASES; ++ph) {
    run_phase(p, ph, smem);
    if (ph + 1 < N_PHASES) grid.sync();
  }
}
#else
template <int PH>
__global__ void __launch_bounds__(NTHREADS, 2) phase_kernel(Params p) {
  extern __shared__ __attribute__((aligned(16))) char smem[];
  run_phase(p, PH, smem);
}
template <int PH>
static void launch_phases(const Params& p, int grid, hipStream_t stream) {
  if constexpr (PH < N_PHASES) {
    (void)hipFuncSetAttribute((const void*)phase_kernel<PH>, hipFuncAttributeMaxDynamicSharedMemorySize, SMEM_BYTES);
    phase_kernel<PH><<<grid, NTHREADS, SMEM_BYTES, stream>>>(p);
    launch_phases<PH + 1>(p, grid, stream);
  }
}
#endif

extern "C" void kernel_launch(void* const* d_in, const int* in_sizes, int n_in, void* d_out, int out_size, void* d_ws,
                              size_t ws_size, hipStream_t stream) {
  Params p{};
  p.x = (const float*)d_in[0]; p.c = (const float*)d_in[1]; p.rel_bias = (const float*)d_in[2];
  p.norm_gain = (const float*)d_in[3]; p.w_ada = (const float*)d_in[4]; p.b_ada = (const float*)d_in[5];
  p.even_w_in = (const float*)d_in[6]; p.even_b_forget = (const float*)d_in[7]; p.even_fox_qk_gain = (const float*)d_in[8];
  p.even_diff_qk_gain = (const float*)d_in[9]; p.even_diff_lambda = (const float*)d_in[10];
  p.even_diff_subln_gain = (const float*)d_in[11]; p.even_w_out = (const float*)d_in[12];
  p.odd_w_qkv = (const float*)d_in[13]; p.odd_qk_gain = (const float*)d_in[14]; p.odd_w_out = (const float*)d_in[15];
  p.peer_w_query = (const float*)d_in[16]; p.peer_sub_keys = (const float*)d_in[17];
  p.peer_u = (const float*)d_in[18]; p.peer_v = (const float*)d_in[19];
  p.out = (float*)d_out; p.ws = (char*)d_ws;
  if (ws_size < WS_END) { fprintf(stderr, "workspace too small: %zu < %zu\n", ws_size, (size_t)WS_END); return; }
#if FUSED
  static int grid_blocks = 0;
  if (!grid_blocks) {
    int dev = 0, cus = 0, per_cu = 0;
    hipGetDevice(&dev);
    hipDeviceGetAttribute(&cus, hipDeviceAttributeMultiprocessorCount, dev);
    hipFuncSetAttribute((const void*)mega_kernel, hipFuncAttributeMaxDynamicSharedMemorySize, SMEM_BYTES);
    hipOccupancyMaxActiveBlocksPerMultiprocessor(&per_cu, mega_kernel, NTHREADS, SMEM_BYTES);
    if (per_cu > 2) per_cu = 2;
    grid_blocks = cus * per_cu;
  }
  void* args[] = {&p};
  hipError_t e = hipLaunchCooperativeKernel((void*)mega_kernel, dim3(grid_blocks), dim3(NTHREADS), args, SMEM_BYTES, stream);
  if (e != hipSuccess) fprintf(stderr, "cooperative launch failed: %s (grid %d)\n", hipGetErrorString(e), grid_blocks);
#else
  launch_phases<0>(p, 512, stream);
#endif
}
```

```cpp
#include <hip/hip_runtime.h>
#include <hip/hip_cooperative_groups.h>
#include <stdint.h>
#include <stdio.h>
namespace cg = cooperative_groups;

#ifndef FUSED
#define FUSED 1
#endif

#define DI __device__ __forceinline__
typedef unsigned short bf16_t;
typedef __attribute__((ext_vector_type(8))) short bf16x8;
typedef __attribute__((ext_vector_type(4))) short bf16x4;
typedef __attribute__((ext_vector_type(16))) float f32x16;
typedef __attribute__((ext_vector_type(2))) __bf16 bf2_t;
typedef __attribute__((ext_vector_type(2))) float f2_t;
#define MFMA32(a, b, c) __builtin_amdgcn_mfma_f32_32x32x16_bf16((a), (b), (c), 0, 0, 0)

constexpr int T_ = 16384;
constexpr int D_ = 2048;
constexpr int S_ = 2048;
constexpr int NB_ = 8;
constexpr int NEXP = 16384;
constexpr float LOG2E = 1.4426950408889634f;
constexpr int NTHREADS = 256;
constexpr int SMEM_BYTES = 75776;

constexpr size_t MiB = 1048576;
constexpr size_t WS_PEERU = 0;
constexpr size_t WS_PEERV = WS_PEERU + 128 * MiB;
constexpr size_t WS_WQK0 = WS_PEERV + 128 * MiB;
constexpr size_t WS_WV0 = WS_WQK0 + 16 * MiB;
constexpr size_t WS_WQK1 = WS_WV0 + 8 * MiB;
constexpr size_t WS_WV1 = WS_WQK1 + 16 * MiB;
constexpr size_t WS_WO0 = WS_WV1 + 8 * MiB;
constexpr size_t WS_WO1 = WS_WO0 + 8 * MiB;
constexpr size_t WS_WQ0 = WS_WO1 + 8 * MiB;
constexpr size_t WS_WQ1 = WS_WQ0 + 8 * MiB;
constexpr size_t WS_SK = WS_WQ1 + 8 * MiB;
constexpr size_t WS_WFF = WS_SK + 131072;
constexpr size_t WS_MOD = WS_WFF + 65536;
constexpr size_t WS_LOGF = WS_MOD + 786432;
constexpr size_t WS_FCUM = WS_LOGF + 524288;
constexpr size_t WS_MISC = WS_FCUM + 524288;
constexpr size_t WS_H = WS_MISC + 65536;
constexpr size_t WS_QK = WS_H + 64 * MiB;
constexpr size_t WS_VT = WS_QK + 128 * MiB;
constexpr size_t WS_ATT = WS_VT + 64 * MiB;
constexpr size_t WS_SC = WS_ATT + 64 * MiB;
constexpr size_t WS_END = WS_SC + 128 * MiB;

struct Params {
  const float* x; const float* c; const float* rel_bias; const float* norm_gain; const float* w_ada; const float* b_ada;
  const float* even_w_in; const float* even_b_forget; const float* even_fox_qk_gain; const float* even_diff_qk_gain;
  const float* even_diff_lambda; const float* even_diff_subln_gain; const float* even_w_out;
  const float* odd_w_qkv; const float* odd_qk_gain; const float* odd_w_out;
  const float* peer_w_query; const float* peer_sub_keys; const float* peer_u; const float* peer_v;
  float* out; char* ws;
};

DI unsigned pack_bf2(float a, float b) { f2_t v = {a, b}; return __builtin_bit_cast(unsigned, __builtin_convertvector(v, bf2_t)); }
DI bf16_t f2bf(float a) { return (bf16_t)(pack_bf2(a, 0.f) & 0xffffu); }
DI float bf_lo(unsigned u) { return __uint_as_float(u << 16); }
DI float bf_hi(unsigned u) { return __uint_as_float(u & 0xffff0000u); }
DI int TID() { int t = threadIdx.x; asm volatile("" : "+v"(t)); return t; }
DI int crow(int reg, int h) { return (reg & 3) + 8 * (reg >> 2) + 4 * h; }
DI float wave_sum(float v) {
#pragma unroll
  for (int o = 32; o >= 1; o >>= 1) v += __shfl_xor(v, o);
  return v;
}
DI float wave_max(float v) {
#pragma unroll
  for (int o = 32; o >= 1; o >>= 1) v = fmaxf(v, __shfl_xor(v, o));
  return v;
}

DI void transpose_tile(const float* __restrict__ src, int ld, int c0, int k0, bf16_t* __restrict__ dst_row0, char* smem) {
  float* tile = (float*)smem;
  const int tid = TID();
  const int ty = tid >> 4, tx = tid & 15;
#pragma unroll
  for (int i = 0; i < 4; ++i) {
    const int k = ty + 16 * i;
    const float4 v = *(const float4*)(src + (size_t)(k0 + k) * ld + c0 + 4 * tx);
    float* t = tile + k * 65 + 4 * tx;
    t[0] = v.x; t[1] = v.y; t[2] = v.z; t[3] = v.w;
  }
  __syncthreads();
  const int cc = tid >> 2, kc = (tid & 3) * 16;
  unsigned pk[8];
#pragma unroll
  for (int j = 0; j < 8; ++j) pk[j] = pack_bf2(tile[(kc + 2 * j) * 65 + cc], tile[(kc + 2 * j + 1) * 65 + cc]);
  uint4* d = (uint4*)(dst_row0 + (size_t)cc * 2048 + k0 + kc);
  d[0] = make_uint4(pk[0], pk[1], pk[2], pk[3]);
  d[1] = make_uint4(pk[4], pk[5], pk[6], pk[7]);
  __syncthreads();
}

DI void phase_prep(const Params& p, char* smem) {
  const int tid = TID(), bid = blockIdx.x, G = gridDim.x;
  char* ws = p.ws;
  {
    float* cond = (float*)smem;
    bool have_cond = false;
    for (int item = bid; item < 384; item += G) {
      if (!have_cond) {
        for (int e = tid; e < NB_ * D_; e += NTHREADS) {
          const int b = e >> 11, d = e & 2047;
          const float v = p.c[e];
          cond[d * 8 + b] = v / (1.f + __expf(-v));
        }
        have_cond = true;
        __syncthreads();
      }
      const int i = item / 192, n = (item % 192) * 64 + (tid & 63);
      const int w = tid >> 6;
      const float* wp = p.w_ada + (size_t)i * D_ * 12288 + n;
      float acc[8];
#pragma unroll
      for (int b = 0; b < 8; ++b) acc[b] = 0.f;
#pragma unroll 8
      for (int d = w; d < D_; d += 4) {
        const float wv = wp[(size_t)d * 12288];
        const float4 c0 = *(const float4*)(cond + d * 8), c1 = *(const float4*)(cond + d * 8 + 4);
        acc[0] += c0.x * wv; acc[1] += c0.y * wv; acc[2] += c0.z * wv; acc[3] += c0.w * wv;
        acc[4] += c1.x * wv; acc[5] += c1.y * wv; acc[6] += c1.z * wv; acc[7] += c1.w * wv;
      }
      float* red = (float*)(smem + 65536);
#pragma unroll
      for (int b = 0; b < 8; ++b) red[(w * 64 + (tid & 63)) * 8 + b] = acc[b];
      __syncthreads();
      if (tid < 64) {
        float* mod = (float*)(ws + WS_MOD);
#pragma unroll
        for (int b = 0; b < 8; ++b) {
          const float s = red[(0 * 64 + tid) * 8 + b] + red[(1 * 64 + tid) * 8 + b] + red[(2 * 64 + tid) * 8 + b] + red[(3 * 64 + tid) * 8 + b];
          mod[((size_t)i * 8 + b) * 12288 + n] = s + p.b_ada[i * 12288 + n];
        }
      }
      __syncthreads();
    }
    __syncthreads();
  }
  {
    bf16_t* wqk0 = (bf16_t*)(ws + WS_WQK0); bf16_t* wv0 = (bf16_t*)(ws + WS_WV0);
    bf16_t* wqk1 = (bf16_t*)(ws + WS_WQK1); bf16_t* wv1 = (bf16_t*)(ws + WS_WV1);
    for (int item = bid; item < 320 * 32; item += G) {
      const int ct = item >> 5, kt = item & 31;
      const float* src; int ld, c0; bf16_t* dst;
      if (ct < 96) {
        const int seg = ct >> 4, cl = (ct & 15) * 64;
        src = p.even_w_in; ld = 6152;
        c0 = (seg < 3 ? seg * 1024 : 3080 + (seg - 3) * 1024) + cl;
        if (seg == 0) dst = wqk0 + (size_t)cl * 2048;
        else if (seg == 1) dst = wqk0 + (size_t)(1024 + cl) * 2048;
        else if (seg == 2) dst = wv0 + (size_t)cl * 2048;
        else if (seg == 3) dst = wqk0 + (size_t)(2048 + cl) * 2048;
        else if (seg == 4) dst = wqk0 + (size_t)(3072 + cl) * 2048;
        else dst = wv0 + (size_t)(1024 + cl) * 2048;
      } else if (ct < 192) {
        const int cl = (ct - 96) * 64;
        src = p.odd_w_qkv; ld = 6144; c0 = cl;
        dst = cl < 4096 ? wqk1 + (size_t)cl * 2048 : wv1 + (size_t)(cl - 4096) * 2048;
      } else {
        const int mi = (ct - 192) >> 5, cl = ((ct - 192) & 31) * 64;
        ld = 2048; c0 = cl;
        if (mi == 0) { src = p.even_w_out; dst = (bf16_t*)(ws + WS_WO0); }
        else if (mi == 1) { src = p.odd_w_out; dst = (bf16_t*)(ws + WS_WO1); }
        else if (mi == 2) { src = p.peer_w_query; dst = (bf16_t*)(ws + WS_WQ0); }
        else { src = p.peer_w_query + (size_t)2048 * 2048; dst = (bf16_t*)(ws + WS_WQ1); }
        dst += (size_t)cl * 2048;
      }
      transpose_tile(src, ld, c0, kt * 64, dst, smem);
    }
  }
  {
    const size_t n_peer = (size_t)2 * NEXP * D_;
    const size_t nchunks = n_peer / 2048;
    for (size_t item = bid; item < 2 * nchunks + 32; item += G) {
      const float* src; bf16_t* dst; size_t off;
      if (item < nchunks) { src = p.peer_u; dst = (bf16_t*)(ws + WS_PEERU); off = item * 2048; }
      else if (item < 2 * nchunks) { src = p.peer_v; dst = (bf16_t*)(ws + WS_PEERV); off = (item - nchunks) * 2048; }
      else { src = p.peer_sub_keys; dst = (bf16_t*)(ws + WS_SK); off = (item - 2 * nchunks) * 2048; }
      const float4 a = *(const float4*)(src + off + tid * 8), b = *(const float4*)(src + off + tid * 8 + 4);
      *(uint4*)(dst + off + tid * 8) = make_uint4(pack_bf2(a.x, a.y), pack_bf2(a.z, a.w), pack_bf2(b.x, b.y), pack_bf2(b.z, b.w));
    }
  }
  if (bid == G - 1) {
    float* wff = (float*)(ws + WS_WFF);
    for (int e = tid; e < 2048 * 8; e += NTHREADS) wff[e] = p.even_w_in[(size_t)(e >> 3) * 6152 + 3072 + (e & 7)];
    if (tid < 64) {
      const float* l = p.even_diff_lambda;
      float s1 = l[tid] * l[128 + tid] + l[64 + tid] * l[128 + 64 + tid];
      float s2 = l[256 + tid] * l[384 + tid] + l[256 + 64 + tid] * l[384 + 64 + tid];
      s1 = wave_sum(s1); s2 = wave_sum(s2);
      if (tid == 0) ((float*)(ws + WS_MISC))[0] = expf(s1) - expf(s2) + 0.2f;
    }
  }
}

template <bool FF>
DI void phase_norm(const Params& p, const float* __restrict__ xin, const float* __restrict__ gain,
                   const float* __restrict__ sh, const float* __restrict__ sc  ) {
  const int lane = TID() & 63;
  const int gw = __builtin_amdgcn_readfirstlane((blockIdx.x * NTHREADS + TID()) >> 6), nw = (gridDim.x * NTHREADS) >> 6;
  bf16_t* H = (bf16_t*)(p.ws + WS_H);
  for (int t = gw; t < T_; t += nw) {
    const int b = t >> 11;
    const float* xr = xin + (size_t)t * D_;
    float4 v[8];
    float ss = 0.f;
#pragma unroll
    for (int i = 0; i < 8; ++i) { v[i] = *(const float4*)(xr + lane * 4 + 256 * i); ss += v[i].x * v[i].x + v[i].y * v[i].y + v[i].z * v[i].z + v[i].w * v[i].w; }
    ss = wave_sum(ss);
    const float rstd = rsqrtf(ss * (1.f / 2048.f) + 1e-6f);
    float ff[8];
    if (FF) {
#pragma unroll
      for (int j = 0; j < 8; ++j) ff[j] = 0.f;
    }
#pragma unroll
    for (int i = 0; i < 8; ++i) {
      const int c = lane * 4 + 256 * i;
      const float4 g = *(const float4*)(gain + c);
      const float4 s1 = *(const float4*)(sc + (size_t)b * 12288 + c);
      const float4 s0 = *(const float4*)(sh + (size_t)b * 12288 + c);
      float4 h;
      h.x = v[i].x * rstd * g.x * (1.f + s1.x) + s0.x;
      h.y = v[i].y * rstd * g.y * (1.f + s1.y) + s0.y;
      h.z = v[i].z * rstd * g.z * (1.f + s1.z) + s0.z;
      h.w = v[i].w * rstd * g.w * (1.f + s1.w) + s0.w;
      *(uint2*)(H + (size_t)t * D_ + c) = make_uint2(pack_bf2(h.x, h.y), pack_bf2(h.z, h.w));
      if (FF) {
        const float* wff = (const float*)(p.ws + WS_WFF) + c * 8;
        const float hv[4] = {h.x, h.y, h.z, h.w};
#pragma unroll
        for (int e = 0; e < 4; ++e) {
          const float4 w0 = *(const float4*)(wff + e * 8), w1 = *(const float4*)(wff + e * 8 + 4);
          ff[0] += hv[e] * w0.x; ff[1] += hv[e] * w0.y; ff[2] += hv[e] * w0.z; ff[3] += hv[e] * w0.w;
          ff[4] += hv[e] * w1.x; ff[5] += hv[e] * w1.y; ff[6] += hv[e] * w1.z; ff[7] += hv[e] * w1.w;
        }
      }
    }
    if (FF) {
#pragma unroll
      for (int j = 0; j < 8; ++j) ff[j] = wave_sum(ff[j]);
      if (lane < 8) {
        float z = ff[0];
#pragma unroll
        for (int j = 1; j < 8; ++j) z = (lane == j) ? ff[j] : z;
        z += p.even_b_forget[lane];
        const float lf = fminf(z, 0.f) - log1pf(__expf(-fabsf(z)));
        ((float*)(p.ws + WS_LOGF))[(size_t)t * 8 + lane] = lf;
      }
    }
  }
}

DI void fox_cumsum(const Params& p) {
  const int lane = TID() & 63;
  const int gw = __builtin_amdgcn_readfirstlane((blockIdx.x * NTHREADS + TID()) >> 6), nw = (gridDim.x * NTHREADS) >> 6;
  const float* lf = (const float*)(p.ws + WS_LOGF);
  float* fc = (float*)(p.ws + WS_FCUM);
  for (int it = gw; it < 64; it += nw) {
    const int b = it >> 3, hh = it & 7;
    float v[32];
    float tot = 0.f;
#pragma unroll
    for (int j = 0; j < 32; ++j) { tot += lf[(size_t)(b * S_ + lane * 32 + j) * 8 + hh]; v[j] = tot; }
    float inc = tot;
#pragma unroll
    for (int o = 1; o < 64; o <<= 1) { const float n = __shfl_up(inc, o); if (lane >= o) inc += n; }
    const float base = inc - tot;
#pragma unroll
    for (int j = 0; j < 32; ++j) fc[(size_t)it * S_ + lane * 32 + j] = v[j] + base;
  }
}

DI void gemm_tile_compute(const bf16_t* __restrict__ A, int lda, const bf16_t* __restrict__ B, int ldb, int K,
                          char* smem, f32x16 (&acc)[2][2]) {
  const int tid = TID(), lane = tid & 63, wave = __builtin_amdgcn_readfirstlane(tid >> 6);
  const int r = lane & 31, h = lane >> 5;
  const int wm = wave >> 1, wn = wave & 1;
  const int srow = tid >> 3, sc = tid & 7;
  const bf16_t* ga = A + (size_t)srow * lda + sc * 8;
  const bf16_t* gb = B + (size_t)srow * ldb + sc * 8;
  uint4 ra[4], rb[4];
#pragma unroll
  for (int i = 0; i < 4; ++i) {
    ra[i] = *(const uint4*)(ga + (size_t)(32 * i) * lda);
    rb[i] = *(const uint4*)(gb + (size_t)(32 * i) * ldb);
  }
  const int woff = srow * 128 + ((sc ^ ((srow >> 1) & 7)) << 4);
  const int rsw = (r >> 1) & 7;
  const int aoff = (wm * 64 + r) * 128, boff = 16384 + (wn * 64 + r) * 128;
#pragma unroll
  for (int i = 0; i < 2; ++i)
#pragma unroll
    for (int j = 0; j < 2; ++j)
#pragma unroll
      for (int e = 0; e < 16; ++e) acc[i][j][e] = 0.f;
#pragma unroll
  for (int i = 0; i < 4; ++i) {
    *(uint4*)(smem + woff + i * 4096) = ra[i];
    *(uint4*)(smem + 16384 + woff + i * 4096) = rb[i];
  }
  __syncthreads();
  const int KT = K >> 6;
  for (int kt = 0; kt < KT; ++kt) {
    char* st = smem + (kt & 1) * 32768;
    if (kt + 1 < KT) {
#pragma unroll
      for (int i = 0; i < 4; ++i) {
        ra[i] = *(const uint4*)(ga + (size_t)(32 * i) * lda + (kt + 1) * 64);
        rb[i] = *(const uint4*)(gb + (size_t)(32 * i) * ldb + (kt + 1) * 64);
      }
    }
#pragma unroll
    for (int s = 0; s < 4; ++s) {
      const int co = ((2 * s + h) ^ rsw) << 4;
      bf16x8 af[2], bfr[2];
      af[0] = *(const bf16x8*)(st + aoff + co);
      af[1] = *(const bf16x8*)(st + aoff + 32 * 128 + co);
      bfr[0] = *(const bf16x8*)(st + boff + co);
      bfr[1] = *(const bf16x8*)(st + boff + 32 * 128 + co);
#pragma unroll
      for (int i = 0; i < 2; ++i)
#pragma unroll
        for (int j = 0; j < 2; ++j) acc[i][j] = MFMA32(af[i], bfr[j], acc[i][j]);
    }
    if (kt + 1 < KT) {
      char* sn = smem + ((kt + 1) & 1) * 32768;
#pragma unroll
      for (int i = 0; i < 4; ++i) {
        *(uint4*)(sn + woff + i * 4096) = ra[i];
        *(uint4*)(sn + 16384 + woff + i * 4096) = rb[i];
      }
    }
    __syncthreads();
  }
}

enum { EPI_BF16 = 0, EPI_NORM_BF16 = 1, EPI_RES_F32 = 2, EPI_F32 = 3 };
struct EpiArgs {
  void* out; int ldc;
  const float* gainA; const float* gainB; int gshift;
  const float* xin; const float* gate;
};

template <int EPI>
DI void gemm_epilogue(f32x16 (&acc)[2][2], int m0, int n0, int tn, const EpiArgs& ea, char* smem) {
  const int tid = TID(), lane = tid & 63, wave = __builtin_amdgcn_readfirstlane(tid >> 6);
  const int r = lane & 31, h = lane >> 5;
  const int wm = wave >> 1, wn = wave & 1;
  if (EPI == EPI_NORM_BF16) {
    float* red = (float*)smem;
    float ss[2][16];
#pragma unroll
    for (int i = 0; i < 2; ++i)
#pragma unroll
      for (int e = 0; e < 16; ++e) {
        float v = acc[i][0][e] * acc[i][0][e] + acc[i][1][e] * acc[i][1][e];
#pragma unroll
        for (int o = 16; o >= 1; o >>= 1) v += __shfl_xor(v, o);
        ss[i][e] = v;
      }
    if (r == 0) {
#pragma unroll
      for (int i = 0; i < 2; ++i)
#pragma unroll
        for (int e = 0; e < 16; ++e) red[wn * 128 + wm * 64 + i * 32 + crow(e, h)] = ss[i][e];
    }
    __syncthreads();
    const int grp = tn >> ea.gshift;
    const float* gain = ((grp & 2) ? ea.gainB : ea.gainA) + (grp & 1) * 128;
    bf16_t* out = (bf16_t*)ea.out;
#pragma unroll
    for (int i = 0; i < 2; ++i)
#pragma unroll
      for (int e = 0; e < 16; ++e) {
        const int rl = wm * 64 + i * 32 + crow(e, h);
        const float rstd = rsqrtf((red[rl] + red[128 + rl]) * (1.f / 128.f) + 1e-6f);
#pragma unroll
        for (int j = 0; j < 2; ++j) {
          const int cl = wn * 64 + j * 32 + r;
          out[(size_t)(m0 + rl) * ea.ldc + n0 + cl] = f2bf(acc[i][j][e] * rstd * gain[cl]);
        }
      }
    __syncthreads();
  } else {
#pragma unroll
    for (int i = 0; i < 2; ++i)
#pragma unroll
      for (int e = 0; e < 16; ++e) {
        const int row = m0 + wm * 64 + i * 32 + crow(e, h);
#pragma unroll
        for (int j = 0; j < 2; ++j) {
          const int col = n0 + wn * 64 + j * 32 + r;
          const float v = acc[i][j][e];
          if (EPI == EPI_BF16) ((bf16_t*)ea.out)[(size_t)row * ea.ldc + col] = f2bf(v);
          else if (EPI == EPI_F32) ((float*)ea.out)[(size_t)row * ea.ldc + col] = v;
          else {
            const float g = ea.gate[(size_t)(row >> 11) * 12288 + col];
            ((float*)ea.out)[(size_t)row * ea.ldc + col] = ea.xin[(size_t)row * ea.ldc + col] + g * v;
          }
        }
      }
  }
}

template <int EPI>
DI void gemm_phase(const bf16_t* A, int lda, const bf16_t* B, int ldb, int K, int mt, int nt, const EpiArgs& ea, char* smem) {
  const int bid = blockIdx.x, G = gridDim.x;
  const int xcd = bid & 7, slot = bid >> 3, nslots = G >> 3;
  const int nsn = nt >> 3, nsup = (mt >> 3) * nsn;
  const int cnt = (nsup - xcd + 7) >> 3;
  for (int j = slot; j < cnt * 64; j += nslots) {
    const int sup = xcd + 8 * (j >> 6), within = j & 63;
    const int sm = sup / nsn, sn = sup - sm * nsn;
    const int tm = sm * 8 + (within >> 3), tn = sn * 8 + (within & 7);
    f32x16 acc[2][2];
    gemm_tile_compute(A + (size_t)tm * 128 * lda, lda, B + (size_t)tn * 128 * ldb, ldb, K, smem, acc);
    gemm_epilogue<EPI>(acc, tm * 128, tn * 128, tn, ea, smem);
  }
}

template <int MODE>
DI void attn_wave(const bf16_t* __restrict__ Qp, int ldq, const bf16_t* __restrict__ Kp, int ldk,
                  const bf16_t* __restrict__ Vt, int ldv, const float* __restrict__ kbias, const float* tbl,
                  int q0, f32x16 (&o)[4], float& l_out) {
  const int lane = TID() & 63, r = lane & 31, h = lane >> 5;
  const float scale2 = 0.08838834764831845f * LOG2E;
  bf16x8 qf[8];
#pragma unroll
  for (int s = 0; s < 8; ++s) qf[s] = *(const bf16x8*)(Qp + (size_t)(q0 + r) * ldq + 16 * s + 8 * h);
#pragma unroll
  for (int dt = 0; dt < 4; ++dt)
#pragma unroll
    for (int e = 0; e < 16; ++e) o[dt][e] = 0.f;
  float m = -1e30f, l = 0.f;
  const int nkt = (q0 >> 5) + 1;
  for (int kt = 0; kt < nkt; ++kt) {
    const int k0 = kt << 5;
    bf16x8 kf[8];
#pragma unroll
    for (int s = 0; s < 8; ++s) kf[s] = *(const bf16x8*)(Kp + (size_t)(k0 + r) * ldk + 16 * s + 8 * h);
    bf16x4 vf[4][2][2];
#pragma unroll
    for (int dt = 0; dt < 4; ++dt)
#pragma unroll
      for (int s = 0; s < 2; ++s) {
        const bf16_t* vp = Vt + (size_t)(32 * dt + r) * ldv + k0 + 16 * s + 4 * h;
        vf[dt][s][0] = *(const bf16x4*)(vp);
        vf[dt][s][1] = *(const bf16x4*)(vp + 8);
      }
    f32x16 sa;
#pragma unroll
    for (int e = 0; e < 16; ++e) sa[e] = 0.f;
#pragma unroll
    for (int s = 0; s < 8; ++s) sa = MFMA32(kf[s], qf[s], sa);
    float v[16];
    if (MODE == 0) {
#pragma unroll
      for (int c = 0; c < 4; ++c) {
        const float4 kb = *(const float4*)(kbias + k0 + 8 * c + 4 * h);
        v[4 * c + 0] = sa[4 * c + 0] * scale2 - kb.x * LOG2E;
        v[4 * c + 1] = sa[4 * c + 1] * scale2 - kb.y * LOG2E;
        v[4 * c + 2] = sa[4 * c + 2] * scale2 - kb.z * LOG2E;
        v[4 * c + 3] = sa[4 * c + 3] * scale2 - kb.w * LOG2E;
      }
      if (kt == nkt - 1) {
#pragma unroll
        for (int e = 0; e < 16; ++e) if (crow(e, h) > r) v[e] = -INFINITY;
      }
    } else {
      const float* tp = tbl + (q0 - k0) + r + 32 - 4 * h - 27;
#pragma unroll
      for (int e = 0; e < 16; ++e) v[e] = sa[e] * scale2 + tp[27 - ((e & 3) + 8 * (e >> 2))];
    }
    float mx = v[0];
#pragma unroll
    for (int e = 1; e < 16; ++e) mx = fmaxf(mx, v[e]);
    mx = fmaxf(mx, __shfl_xor(mx, 32));
    const float mn = fmaxf(m, mx);
    const float alpha = exp2f(m - mn);
    m = mn;
    float ps = 0.f;
#pragma unroll
    for (int e = 0; e < 16; ++e) { v[e] = exp2f(v[e] - mn); ps += v[e]; }
    l = l * alpha + ps;
#pragma unroll
    for (int dt = 0; dt < 4; ++dt)
#pragma unroll
      for (int e = 0; e < 16; ++e) o[dt][e] *= alpha;
    bf16x8 pb[2];
#pragma unroll
    for (int s = 0; s < 2; ++s) {
      const uint4 u = make_uint4(pack_bf2(v[8 * s + 0], v[8 * s + 1]), pack_bf2(v[8 * s + 2], v[8 * s + 3]),
                                 pack_bf2(v[8 * s + 4], v[8 * s + 5]), pack_bf2(v[8 * s + 6], v[8 * s + 7]));
      pb[s] = __builtin_bit_cast(bf16x8, u);
    }
#pragma unroll
    for (int dt = 0; dt < 4; ++dt)
#pragma unroll
      for (int s = 0; s < 2; ++s) {
        const bf16x8 va = __builtin_shufflevector(vf[dt][s][0], vf[dt][s][1], 0, 1, 2, 3, 4, 5, 6, 7);
        o[dt] = MFMA32(va, pb[s], o[dt]);
      }
  }
  l_out = l + __shfl_xor(l, 32);
}

DI void attn_store_bf16(const f32x16 (&o)[4], float linv, bf16_t* __restrict__ out_row  , int ldo) {
  const int lane = TID() & 63, r = lane & 31, h = lane >> 5;
  bf16_t* op = out_row + (size_t)r * ldo + 4 * h;
#pragma unroll
  for (int dt = 0; dt < 4; ++dt)
#pragma unroll
    for (int c = 0; c < 4; ++c)
      *(uint2*)(op + 32 * dt + 8 * c) = make_uint2(pack_bf2(o[dt][4 * c] * linv, o[dt][4 * c + 1] * linv),
                                                    pack_bf2(o[dt][4 * c + 2] * linv, o[dt][4 * c + 3] * linv));
}

DI int t5_bucket(int n) {
  if (n < 16) return n;
  int lg = 16 + (int)(logf((float)n / 16.f) / 4.852030263919617f * 16.f);
  return lg < 31 ? lg : 31;
}

DI void phase_attn_even(const Params& p, char* smem) {
  const int tid = TID(), wave = __builtin_amdgcn_readfirstlane(tid >> 6), bid = blockIdx.x, G = gridDim.x;
  const bf16_t* QK = (const bf16_t*)(p.ws + WS_QK);
  const bf16_t* VT = (const bf16_t*)(p.ws + WS_VT);
  bf16_t* ATT = (bf16_t*)(p.ws + WS_ATT);
  float* pieces = (float*)smem;
  float* tbl = (float*)(smem + 66048);
  const float lam = ((const float*)(p.ws + WS_MISC))[0];
  for (int item = bid; item < 3072; item += G) {
    const int g = item / 192; int rem = item - g * 192;
    const int qb = 15 - g;
    if (rem < 64) {
      const int b = rem >> 3, hh = rem & 7;
      const int q0 = qb * 128 + 32 * wave;
      const bf16_t* Qp = QK + (size_t)b * S_ * 4096 + hh * 128;
      f32x16 o[4]; float l;
      attn_wave<0>(Qp, 4096, Qp + 1024, 4096, VT + (size_t)(hh * 128) * T_ + b * S_, T_,
                   (const float*)(p.ws + WS_FCUM) + (size_t)(b * 8 + hh) * S_, nullptr, q0, o, l);
      attn_store_bf16(o, 1.f / l, ATT + (size_t)(b * S_ + q0) * D_ + hh * 128, D_);
    } else {
      rem -= 64;
      const int qt = 4 * qb + 3 - (rem >> 5);
      const int bh = rem & 31, b = bh >> 2, hh = bh & 3;
      const int q0 = qt * 32;
      for (int e = tid; e < 2080; e += NTHREADS) {
        const int dist = e - 32;
        tbl[e] = dist >= 0 ? p.rel_bias[t5_bucket(dist) * 16 + hh] * LOG2E : -INFINITY;
      }
      __syncthreads();
      const int mm = wave >> 1, half = wave & 1;
      const bf16_t* Qp = QK + (size_t)b * S_ * 4096 + 2048 + hh * 256 + mm * 128;
      f32x16 o[4]; float l;
      attn_wave<1>(Qp, 4096, Qp + 1024, 4096, VT + (size_t)(1024 + hh * 256 + half * 128) * T_ + b * S_, T_,
                   nullptr, tbl, q0, o, l);
      {
        const int lane = tid & 63, r = lane & 31, h = lane >> 5;
        const float linv = 1.f / l;
        float* pw = pieces + (wave * 32 + r) * 129;
#pragma unroll
        for (int dt = 0; dt < 4; ++dt)
#pragma unroll
          for (int e = 0; e < 16; ++e) pw[32 * dt + crow(e, h)] = o[dt][e] * linv;
      }
      __syncthreads();
      {
        const int q = tid >> 3, d0 = (tid & 7) * 32;
        const int half2 = d0 >> 7, dl = d0 & 127;
        const float* p0 = pieces + ((0 * 2 + half2) * 32 + q) * 129 + dl;
        const float* p1 = pieces + ((1 * 2 + half2) * 32 + q) * 129 + dl;
        float val[32]; float ss = 0.f;
#pragma unroll
        for (int j = 0; j < 32; ++j) { val[j] = p0[j] - lam * p1[j]; ss += val[j] * val[j]; }
        ss += __shfl_xor(ss, 1); ss += __shfl_xor(ss, 2); ss += __shfl_xor(ss, 4);
        const float rstd = rsqrtf(ss * (1.f / 256.f) + 1e-6f) * 0.8f;
        const float* sg = p.even_diff_subln_gain + d0;
        bf16_t* op = ATT + (size_t)(b * S_ + q0 + q) * D_ + 1024 + hh * 256 + d0;
#pragma unroll
        for (int j = 0; j < 32; j += 8) {
          *(uint4*)(op + j) = make_uint4(pack_bf2(val[j] * rstd * sg[j], val[j + 1] * rstd * sg[j + 1]),
                                         pack_bf2(val[j + 2] * rstd * sg[j + 2], val[j + 3] * rstd * sg[j + 3]),
                                         pack_bf2(val[j + 4] * rstd * sg[j + 4], val[j + 5] * rstd * sg[j + 5]),
                                         pack_bf2(val[j + 6] * rstd * sg[j + 6], val[j + 7] * rstd * sg[j + 7]));
        }
      }
      __syncthreads();
    }
  }
}

DI void phase_attn_odd(const Params& p, char* smem) {
  const int tid = TID(), wave = __builtin_amdgcn_readfirstlane(tid >> 6), bid = blockIdx.x, G = gridDim.x;
  const bf16_t* QK = (const bf16_t*)(p.ws + WS_QK);
  const bf16_t* VT = (const bf16_t*)(p.ws + WS_VT);
  bf16_t* ATT = (bf16_t*)(p.ws + WS_ATT);
  float* tbl = (float*)(smem + 66048);
  int cur_head = -1;
  for (int item = bid; item < 2048; item += G) {
    const int g = item >> 7, rem = item & 127;
    const int qb = 15 - g, b = rem >> 4, hd = rem & 15;
    if (hd != cur_head) {
      __syncthreads();
      for (int e = tid; e < 2080; e += NTHREADS) {
        const int dist = e - 32;
        float val = -INFINITY;
        if (dist >= 0) {
          int cnt = 0;
          if (dist <= 128) cnt += 1;
          if (dist <= 512 && (dist & 3) == 0) cnt += 1;
          if ((dist & 15) == 0) cnt += 1;
          if (cnt > 0) val = (p.rel_bias[t5_bucket(dist) * 16 + hd] + __logf((float)cnt)) * LOG2E;
        }
        tbl[e] = val;
      }
      cur_head = hd;
      __syncthreads();
    }
    const int q0 = qb * 128 + 32 * wave;
    const bf16_t* Qp = QK + (size_t)b * S_ * 4096 + hd * 128;
    f32x16 o[4]; float l;
    attn_wave<1>(Qp, 4096, Qp + 2048, 4096, VT + (size_t)(hd * 128) * T_ + b * S_, T_, nullptr, tbl, q0, o, l);
    attn_store_bf16(o, 1.f / l, ATT + (size_t)(b * S_ + q0) * D_ + hd * 128, D_);
  }
}

DI unsigned fkey(float f) { const unsigned u = __float_as_uint(f); return (u & 0x80000000u) ? ~u : (u | 0x80000000u); }
DI int popc64(unsigned long long m) { return __popcll(m); }
DI int mbcnt(unsigned long long m) { return __builtin_amdgcn_mbcnt_hi((unsigned)(m >> 32), __builtin_amdgcn_mbcnt_lo((unsigned)m, 0)); }

template <int NV>
DI void select16(const unsigned (&key)[NV], bool (&sel)[NV], int (&pos)[NV]) {
  unsigned thr = 0;
#pragma unroll 1
  for (int bit = 31; bit >= 0; --bit) {
    const unsigned cand = thr | (1u << bit);
    int cnt = 0;
#pragma unroll
    for (int a = 0; a < NV; ++a) cnt += popc64(__ballot(key[a] >= cand));
    if (cnt >= 16) thr = cand;
  }
  int cgt = 0;
#pragma unroll
  for (int a = 0; a < NV; ++a) cgt += popc64(__ballot(key[a] > thr));
  const int need = 16 - cgt;
  int eqbase = 0, sbase = 0;
#pragma unroll
  for (int a = 0; a < NV; ++a) {
    const bool eq = key[a] == thr;
    const unsigned long long em = __ballot(eq);
    const bool s = (key[a] > thr) || (eq && (eqbase + mbcnt(em)) < need);
    eqbase += popc64(em);
    const unsigned long long sm = __ballot(s);
    sel[a] = s; pos[a] = sbase + mbcnt(sm);
    sbase += popc64(sm);
  }
}

DI float gelu_erf(float x) { return 0.5f * x * (1.f + erff(x * 0.7071067811865476f)); }

DI void phase_peer(const Params& p, int layer, const float* __restrict__ gate2  , char* smem) {
  const int tid = TID(), lane = tid & 63, wave = __builtin_amdgcn_readfirstlane(tid >> 6);
  const int gw = __builtin_amdgcn_readfirstlane((blockIdx.x * NTHREADS + tid) >> 6), nw = (gridDim.x * NTHREADS) >> 6;
  float* wl_s = (float*)(smem + wave * 2048);
  int* wl_i = (int*)(smem + wave * 2048 + 128);
  int* ex_i = (int*)(smem + wave * 2048 + 256);
  float* ex_g = (float*)(smem + wave * 2048 + 768);
  const float* SC = (const float*)(p.ws + WS_SC);
  const bf16_t* H = (const bf16_t*)(p.ws + WS_H);
  const bf16_t* PU = (const bf16_t*)(p.ws + WS_PEERU) + (size_t)layer * NEXP * D_;
  const bf16_t* PV = (const bf16_t*)(p.ws + WS_PEERV) + (size_t)layer * NEXP * D_;
  for (int t = gw; t < T_; t += nw) {
#pragma unroll 1
    for (int hh = 0; hh < 8; ++hh) {
      const float* sr = SC + ((size_t)t * 8 + hh) * 256;
      float sv[4];
#pragma unroll
      for (int a = 0; a < 4; ++a) sv[a] = sr[a * 64 + lane];
#pragma unroll
      for (int pp = 0; pp < 2; ++pp) {
        unsigned key[2] = {fkey(sv[2 * pp]), fkey(sv[2 * pp + 1])};
        bool sel[2]; int pos[2];
        select16<2>(key, sel, pos);
#pragma unroll
        for (int a = 0; a < 2; ++a) if (sel[a]) { wl_s[pp * 16 + pos[a]] = sv[2 * pp + a]; wl_i[pp * 16 + pos[a]] = a * 64 + lane; }
      }
      const float sa = wl_s[lane >> 2];
      const int ia = wl_i[lane >> 2];
      float cs[4]; int ci[4]; unsigned key[4];
#pragma unroll
      for (int j = 0; j < 4; ++j) {
        cs[j] = sa + wl_s[16 + (lane & 3) * 4 + j];
        ci[j] = ia * 128 + wl_i[16 + (lane & 3) * 4 + j];
        key[j] = fkey(cs[j]);
      }
      bool sel[4]; int pos[4];
      select16<4>(key, sel, pos);
      float mx = -INFINITY;
#pragma unroll
      for (int j = 0; j < 4; ++j) if (sel[j]) mx = fmaxf(mx, cs[j]);
      mx = wave_max(mx);
      float e[4]; float es = 0.f;
#pragma unroll
      for (int j = 0; j < 4; ++j) { e[j] = sel[j] ? __expf(cs[j] - mx) : 0.f; es += e[j]; }
      es = wave_sum(es);
      const float inv = 1.f / es;
#pragma unroll
      for (int j = 0; j < 4; ++j) if (sel[j]) { ex_i[hh * 16 + pos[j]] = ci[j]; ex_g[hh * 16 + pos[j]] = e[j] * inv; }
    }
    unsigned xr[16];
    {
      const bf16_t* hr = H + (size_t)t * D_ + lane * 8;
#pragma unroll
      for (int i = 0; i < 4; ++i) {
        const uint4 u = *(const uint4*)(hr + 512 * i);
        xr[4 * i] = u.x; xr[4 * i + 1] = u.y; xr[4 * i + 2] = u.z; xr[4 * i + 3] = u.w;
      }
    }
    float y[32];
#pragma unroll
    for (int j = 0; j < 32; ++j) y[j] = 0.f;
#pragma unroll 1
    for (int eb = 0; eb < 128; eb += 4) {
      uint4 ur[4][4], vr[4][4];
      float gt[4];
#pragma unroll
      for (int q = 0; q < 4; ++q) {
        const int id = __builtin_amdgcn_readfirstlane(ex_i[eb + q]);
        gt[q] = ex_g[eb + q];
        const bf16_t* up = PU + (size_t)id * D_ + lane * 8;
        const bf16_t* vp = PV + (size_t)id * D_ + lane * 8;
#pragma unroll
        for (int i = 0; i < 4; ++i) { ur[q][i] = *(const uint4*)(up + 512 * i); vr[q][i] = *(const uint4*)(vp + 512 * i); }
      }
      float dt[4];
#pragma unroll
      for (int q = 0; q < 4; ++q) {
        float a = 0.f;
#pragma unroll
        for (int i = 0; i < 4; ++i) {
          a = __builtin_amdgcn_fdot2_f32_bf16(__builtin_bit_cast(bf2_t, ur[q][i].x), __builtin_bit_cast(bf2_t, xr[4 * i]), a, false);
          a = __builtin_amdgcn_fdot2_f32_bf16(__builtin_bit_cast(bf2_t, ur[q][i].y), __builtin_bit_cast(bf2_t, xr[4 * i + 1]), a, false);
          a = __builtin_amdgcn_fdot2_f32_bf16(__builtin_bit_cast(bf2_t, ur[q][i].z), __builtin_bit_cast(bf2_t, xr[4 * i + 2]), a, false);
          a = __builtin_amdgcn_fdot2_f32_bf16(__builtin_bit_cast(bf2_t, ur[q][i].w), __builtin_bit_cast(bf2_t, xr[4 * i + 3]), a, false);
        }
        dt[q] = a;
      }
#pragma unroll
      for (int o = 32; o >= 1; o >>= 1) {
#pragma unroll
        for (int q = 0; q < 4; ++q) dt[q] += __shfl_xor(dt[q], o);
      }
#pragma unroll
      for (int q = 0; q < 4; ++q) {
        const float cf = gt[q] * gelu_erf(dt[q]);
#pragma unroll
        for (int i = 0; i < 4; ++i) {
          const unsigned w[4] = {vr[q][i].x, vr[q][i].y, vr[q][i].z, vr[q][i].w};
#pragma unroll
          for (int k = 0; k < 4; ++k) {
            y[8 * i + 2 * k] += cf * bf_lo(w[k]);
            y[8 * i + 2 * k + 1] += cf * bf_hi(w[k]);
          }
        }
      }
    }
    {
      const int b = t >> 11;
      float* orow = p.out + (size_t)t * D_ + lane * 8;
      const float* grow = gate2 + (size_t)b * 12288 + lane * 8;
#pragma unroll
      for (int i = 0; i < 4; ++i) {
        float4 a0 = *(const float4*)(orow + 512 * i), a1 = *(const float4*)(orow + 512 * i + 4);
        const float4 g0 = *(const float4*)(grow + 512 * i), g1 = *(const float4*)(grow + 512 * i + 4);
        a0.x += g0.x * y[8 * i]; a0.y += g0.y * y[8 * i + 1]; a0.z += g0.z * y[8 * i + 2]; a0.w += g0.w * y[8 * i + 3];
        a1.x += g1.x * y[8 * i + 4]; a1.y += g1.y * y[8 * i + 5]; a1.z += g1.z * y[8 * i + 6]; a1.w += g1.w * y[8 * i + 7];
        *(float4*)(orow + 512 * i) = a0; *(float4*)(orow + 512 * i + 4) = a1;
      }
    }
  }
}

DI void phase_peer_scores(const Params& p, int layer, char* smem) {
  const bf16_t* QP = (const bf16_t*)(p.ws + WS_QK);
  const bf16_t* SK = (const bf16_t*)(p.ws + WS_SK) + (size_t)layer * 2 * 128 * 128;
  EpiArgs ea{}; ea.out = nullptr; ea.ldc = 256;
  for (int L = blockIdx.x; L < 2048; L += gridDim.x) {
    const int pp = L & 1, tm = L >> 1;
    f32x16 acc[2][2];
    gemm_tile_compute(QP + (size_t)tm * 128 * 256 + pp * 128, 256, SK + (size_t)pp * 128 * 128, 128, 128, smem, acc);
    ea.out = (float*)(p.ws + WS_SC) + pp * 128;
    gemm_epilogue<EPI_F32>(acc, tm * 128, 0, 0, ea, smem);
  }
}

constexpr int N_PHASES = 17;
DI void run_phase(const Params& p, int ph, char* smem) {
  char* ws = p.ws;
  const float* mod = (const float*)(ws + WS_MOD);
  const bf16_t* H = (const bf16_t*)(ws + WS_H);
  if (ph == 0) { phase_prep(p, smem); return; }
  const int layer = (ph - 1) >> 3, sub = (ph - 1) & 7;
  const float* modl = mod + (size_t)layer * 8 * 12288;
  switch (sub) {
    case 0:
      if (layer == 0) phase_norm<true>(p, p.x, p.norm_gain, modl, modl + 2048);
      else phase_norm<false>(p, p.out, p.norm_gain + 2 * 2048, modl, modl + 2048);
      break;
    case 1: {
      if (layer == 0) fox_cumsum(p);
      EpiArgs ea{}; ea.out = ws + WS_QK; ea.ldc = 4096;
      if (layer == 0) {
        ea.gainA = p.even_fox_qk_gain; ea.gainB = p.even_diff_qk_gain; ea.gshift = 3;
      } else { ea.gainA = p.odd_qk_gain; ea.gainB = p.odd_qk_gain; ea.gshift = 4; }
      gemm_phase<EPI_NORM_BF16>(H, 2048, (const bf16_t*)(ws + (layer ? WS_WQK1 : WS_WQK0)), 2048, 2048, 128, 32, ea, smem);
      EpiArgs ev{}; ev.out = ws + WS_VT; ev.ldc = T_;
      gemm_phase<EPI_BF16>((const bf16_t*)(ws + (layer ? WS_WV1 : WS_WV0)), 2048, H, 2048, 2048, 16, 128, ev, smem);
    } break;
    case 2:
      if (layer == 0) phase_attn_even(p, smem); else phase_attn_odd(p, smem);
      break;
    case 3: {
      EpiArgs ea{}; ea.out = p.out; ea.ldc = 2048; ea.xin = layer ? p.out : p.x; ea.gate = modl + 2 * 2048;
      gemm_phase<EPI_RES_F32>((const bf16_t*)(ws + WS_ATT), 2048, (const bf16_t*)(ws + (layer ? WS_WO1 : WS_WO0)), 2048, 2048, 128, 16, ea, smem);
    } break;
    case 4:
      phase_norm<false>(p, p.out, p.norm_gain + (layer * 2 + 1) * 2048, modl + 3 * 2048, modl + 4 * 2048);
      break;
    case 5: {
      EpiArgs ea{}; ea.out = ws + WS_QK; ea.ldc = 2048;
      gemm_phase<EPI_BF16>(H, 2048, (const bf16_t*)(ws + (layer ? WS_WQ1 : WS_WQ0)), 2048, 2048, 128, 16, ea, smem);
    } break;
    case 6: phase_peer_scores(p, layer, smem); break;
    case 7: phase_peer(p, layer, modl + 5 * 2048, smem); break;
  }
}

#if FUSED
__global__ void __launch_bounds__(NTHREADS, 2) mega_kernel(Params p) {
  extern __shared__ __attribute__((aligned(16))) char smem[];
  cg::grid_group grid = cg::this_grid();
#pragma unroll
  for (int ph = 0; ph < N_PHASES; ++ph) {
    run_phase(p, ph, smem);
    if (ph + 1 < N_PHASES) grid.sync();
  }
}
#else
template <int PH>
__global__ void __launch_bounds__(NTHREADS, 2) phase_kernel(Params p) {
  extern __shared__ __attribute__((aligned(16))) char smem[];
  run_phase(p, PH, smem);
}
template <int PH>
static void launch_phases(const Params& p, int grid, hipStream_t stream) {
  if constexpr (PH < N_PHASES) {
    (void)hipFuncSetAttribute((const void*)phase_kernel<PH>, hipFuncAttributeMaxDynamicSharedMemorySize, SMEM_BYTES);
    phase_kernel<PH><<<grid, NTHREADS, SMEM_BYTES, stream>>>(p);
    launch_phases<PH + 1>(p, grid, stream);
  }
}
#endif

extern "C" void kernel_launch(void* const* d_in, const int* in_sizes, int n_in, void* d_out, int out_size, void* d_ws,
                              size_t ws_size, hipStream_t stream) {
  Params p{};
  p.x = (const float*)d_in[0]; p.c = (const float*)d_in[1]; p.rel_bias = (const float*)d_in[2];
  p.norm_gain = (const float*)d_in[3]; p.w_ada = (const float*)d_in[4]; p.b_ada = (const float*)d_in[5];
  p.even_w_in = (const float*)d_in[6]; p.even_b_forget = (const float*)d_in[7]; p.even_fox_qk_gain = (const float*)d_in[8];
  p.even_diff_qk_gain = (const float*)d_in[9]; p.even_diff_lambda = (const float*)d_in[10];
  p.even_diff_subln_gain = (const float*)d_in[11]; p.even_w_out = (const float*)d_in[12];
  p.odd_w_qkv = (const float*)d_in[13]; p.odd_qk_gain = (const float*)d_in[14]; p.odd_w_out = (const float*)d_in[15];
  p.peer_w_query = (const float*)d_in[16]; p.peer_sub_keys = (const float*)d_in[17];
  p.peer_u = (const float*)d_in[18]; p.peer_v = (const float*)d_in[19];
  p.out = (float*)d_out; p.ws = (char*)d_ws;
  if (ws_size < WS_END) { fprintf(stderr, "workspace too small: %zu < %zu\n", ws_size, (size_t)WS_END); return; }
#if FUSED
  static int grid_blocks = 0;
  if (!grid_blocks) {
    int dev = 0, cus = 0, per_cu = 0;
    hipGetDevice(&dev);
    hipDeviceGetAttribute(&cus, hipDeviceAttributeMultiprocessorCount, dev);
    hipFuncSetAttribute((const void*)mega_kernel, hipFuncAttributeMaxDynamicSharedMemorySize, SMEM_BYTES);
    hipOccupancyMaxActiveBlocksPerMultiprocessor(&per_cu, mega_kernel, NTHREADS, SMEM_BYTES);
    if (per_cu > 2) per_cu = 2;
    grid_blocks = cus * per_cu;
  }
  void* args[] = {&p};
  hipError_t e = hipLaunchCooperativeKernel((void*)mega_kernel, dim3(grid_blocks), dim3(NTHREADS), args, SMEM_BYTES, stream);
  if (e != hipSuccess) fprintf(stderr, "cooperative launch failed: %s (grid %d)\n", hipGetErrorString(e), grid_blocks);
#else
  launch_phases<0>(p, 512, stream);
#endif
}
```

```cpp
#include <hip/hip_runtime.h>
#include <hip/hip_cooperative_groups.h>
#include <stdint.h>
#include <stdio.h>
namespace cg = cooperative_groups;

#ifndef FUSED
#define FUSED 1
#endif

#define DI __device__ __forceinline__
typedef unsigned short bf16_t;
typedef __attribute__((ext_vector_type(8))) short bf16x8;
typedef __attribute__((ext_vector_type(4))) short bf16x4;
typedef __attribute__((ext_vector_type(16))) float f32x16;
typedef __attribute__((ext_vector_type(2))) __bf16 bf2_t;
typedef __attribute__((ext_vector_type(2))) float f2_t;
#define MFMA32(a, b, c) __builtin_amdgcn_mfma_f32_32x32x16_bf16((a), (b), (c), 0, 0, 0)

constexpr int T_ = 16384;
constexpr int D_ = 2048;
constexpr int S_ = 2048;
constexpr int NB_ = 8;
constexpr int NEXP = 16384;
constexpr float LOG2E = 1.4426950408889634f;
constexpr int NTHREADS = 256;
constexpr int SMEM_BYTES = 75776;

constexpr size_t MiB = 1048576;
constexpr size_t WS_PEERU = 0;
constexpr size_t WS_PEERV8 = WS_PEERU + 64 * MiB;
constexpr size_t WS_PEERV = WS_PEERU + 128 * MiB;
constexpr size_t WS_WQK0 = WS_PEERV + 128 * MiB;
constexpr size_t WS_WV0 = WS_WQK0 + 16 * MiB;
constexpr size_t WS_WQK1 = WS_WV0 + 8 * MiB;
constexpr size_t WS_WV1 = WS_WQK1 + 16 * MiB;
constexpr size_t WS_WO0 = WS_WV1 + 8 * MiB;
constexpr size_t WS_WO1 = WS_WO0 + 8 * MiB;
constexpr size_t WS_WQ0 = WS_WO1 + 8 * MiB;
constexpr size_t WS_WQ1 = WS_WQ0 + 8 * MiB;
constexpr size_t WS_SK = WS_WQ1 + 8 * MiB;
constexpr size_t WS_WFF = WS_SK + 131072;
constexpr size_t WS_MOD = WS_WFF + 65536;
constexpr size_t WS_LOGF = WS_MOD + 786432;
constexpr size_t WS_FCUM = WS_LOGF + 524288;
constexpr size_t WS_MISC = WS_FCUM + 524288;
constexpr size_t WS_H = WS_MISC + 65536;
constexpr size_t WS_QK = WS_H + 64 * MiB;
constexpr size_t WS_VT = WS_QK + 128 * MiB;
constexpr size_t WS_ATT = WS_VT + 64 * MiB;
constexpr size_t WS_SC = WS_ATT + 64 * MiB;
constexpr size_t WS_END = WS_SC + 128 * MiB;

struct Params {
  const float* x; const float* c; const float* rel_bias; const float* norm_gain; const float* w_ada; const float* b_ada;
  const float* even_w_in; const float* even_b_forget; const float* even_fox_qk_gain; const float* even_diff_qk_gain;
  const float* even_diff_lambda; const float* even_diff_subln_gain; const float* even_w_out;
  const float* odd_w_qkv; const float* odd_qk_gain; const float* odd_w_out;
  const float* peer_w_query; const float* peer_sub_keys; const float* peer_u; const float* peer_v;
  float* out; char* ws;
};

DI unsigned pack_bf2(float a, float b) { f2_t v = {a, b}; return __builtin_bit_cast(unsigned, __builtin_convertvector(v, bf2_t)); }
DI bf16_t f2bf(float a) { return (bf16_t)(pack_bf2(a, 0.f) & 0xffffu); }
DI float bf_lo(unsigned u) { return __uint_as_float(u << 16); }
DI float bf_hi(unsigned u) { return __uint_as_float(u & 0xffff0000u); }
DI int TID() { int t = threadIdx.x; asm volatile("" : "+v"(t)); return t; }
DI int crow(int reg, int h) { return (reg & 3) + 8 * (reg >> 2) + 4 * h; }
DI float wave_sum(float v) {
#pragma unroll
  for (int o = 32; o >= 1; o >>= 1) v += __shfl_xor(v, o);
  return v;
}
DI float wave_max(float v) {
#pragma unroll
  for (int o = 32; o >= 1; o >>= 1) v = fmaxf(v, __shfl_xor(v, o));
  return v;
}

DI void transpose_tile(const float* __restrict__ src, int ld, int c0, int k0, bf16_t* __restrict__ dst_row0, char* smem) {
  float* tile = (float*)smem;
  const int tid = TID();
  const int ty = tid >> 4, tx = tid & 15;
#pragma unroll
  for (int i = 0; i < 4; ++i) {
    const int k = ty + 16 * i;
    const float4 v = *(const float4*)(src + (size_t)(k0 + k) * ld + c0 + 4 * tx);
    float* t = tile + k * 65 + 4 * tx;
    t[0] = v.x; t[1] = v.y; t[2] = v.z; t[3] = v.w;
  }
  __syncthreads();
  const int cc = tid >> 2, kc = (tid & 3) * 16;
  unsigned pk[8];
#pragma unroll
  for (int j = 0; j < 8; ++j) pk[j] = pack_bf2(tile[(kc + 2 * j) * 65 + cc], tile[(kc + 2 * j + 1) * 65 + cc]);
  uint4* d = (uint4*)(dst_row0 + (size_t)cc * 2048 + k0 + kc);
  d[0] = make_uint4(pk[0], pk[1], pk[2], pk[3]);
  d[1] = make_uint4(pk[4], pk[5], pk[6], pk[7]);
  __syncthreads();
}

DI void phase_prep(const Params& p, char* smem) {
  const int tid = TID(), bid = blockIdx.x, G = gridDim.x;
  char* ws = p.ws;
  {
    float* cond = (float*)smem;
    bool have_cond = false;
    for (int item = bid; item < 384; item += G) {
      if (!have_cond) {
        for (int e = tid; e < NB_ * D_; e += NTHREADS) {
          const int b = e >> 11, d = e & 2047;
          const float v = p.c[e];
          cond[d * 8 + b] = v / (1.f + __expf(-v));
        }
        have_cond = true;
        __syncthreads();
      }
      const int i = item / 192, n = (item % 192) * 64 + (tid & 63);
      const int w = tid >> 6;
      const float* wp = p.w_ada + (size_t)i * D_ * 12288 + n;
      float acc[8];
#pragma unroll
      for (int b = 0; b < 8; ++b) acc[b] = 0.f;
#pragma unroll 8
      for (int d = w; d < D_; d += 4) {
        const float wv = wp[(size_t)d * 12288];
        const float4 c0 = *(const float4*)(cond + d * 8), c1 = *(const float4*)(cond + d * 8 + 4);
        acc[0] += c0.x * wv; acc[1] += c0.y * wv; acc[2] += c0.z * wv; acc[3] += c0.w * wv;
        acc[4] += c1.x * wv; acc[5] += c1.y * wv; acc[6] += c1.z * wv; acc[7] += c1.w * wv;
      }
      float* red = (float*)(smem + 65536);
#pragma unroll
      for (int b = 0; b < 8; ++b) red[(w * 64 + (tid & 63)) * 8 + b] = acc[b];
      __syncthreads();
      if (tid < 64) {
        float* mod = (float*)(ws + WS_MOD);
#pragma unroll
        for (int b = 0; b < 8; ++b) {
          const float s = red[(0 * 64 + tid) * 8 + b] + red[(1 * 64 + tid) * 8 + b] + red[(2 * 64 + tid) * 8 + b] + red[(3 * 64 + tid) * 8 + b];
          mod[((size_t)i * 8 + b) * 12288 + n] = s + p.b_ada[i * 12288 + n];
        }
      }
      __syncthreads();
    }
    __syncthreads();
  }
  {
    bf16_t* wqk0 = (bf16_t*)(ws + WS_WQK0); bf16_t* wv0 = (bf16_t*)(ws + WS_WV0);
    bf16_t* wqk1 = (bf16_t*)(ws + WS_WQK1); bf16_t* wv1 = (bf16_t*)(ws + WS_WV1);
    for (int item = bid; item < 320 * 32; item += G) {
      const int ct = item >> 5, kt = item & 31;
      const float* src; int ld, c0; bf16_t* dst;
      if (ct < 96) {
        const int seg = ct >> 4, cl = (ct & 15) * 64;
        src = p.even_w_in; ld = 6152;
        c0 = (seg < 3 ? seg * 1024 : 3080 + (seg - 3) * 1024) + cl;
        if (seg == 0) dst = wqk0 + (size_t)cl * 2048;
        else if (seg == 1) dst = wqk0 + (size_t)(1024 + cl) * 2048;
        else if (seg == 2) dst = wv0 + (size_t)cl * 2048;
        else if (seg == 3) dst = wqk0 + (size_t)(2048 + cl) * 2048;
        else if (seg == 4) dst = wqk0 + (size_t)(3072 + cl) * 2048;
        else dst = wv0 + (size_t)(1024 + cl) * 2048;
      } else if (ct < 192) {
        const int cl = (ct - 96) * 64;
        src = p.odd_w_qkv; ld = 6144; c0 = cl;
        dst = cl < 4096 ? wqk1 + (size_t)cl * 2048 : wv1 + (size_t)(cl - 4096) * 2048;
      } else {
        const int mi = (ct - 192) >> 5, cl = ((ct - 192) & 31) * 64;
        ld = 2048; c0 = cl;
        if (mi == 0) { src = p.even_w_out; dst = (bf16_t*)(ws + WS_WO0); }
        else if (mi == 1) { src = p.odd_w_out; dst = (bf16_t*)(ws + WS_WO1); }
        else if (mi == 2) { src = p.peer_w_query; dst = (bf16_t*)(ws + WS_WQ0); }
        else { src = p.peer_w_query + (size_t)2048 * 2048; dst = (bf16_t*)(ws + WS_WQ1); }
        dst += (size_t)cl * 2048;
      }
      transpose_tile(src, ld, c0, kt * 64, dst, smem);
    }
  }
  {
    const int lane = tid & 63;
    const int gw = __builtin_amdgcn_readfirstlane((bid * NTHREADS + tid) >> 6), nw = (G * NTHREADS) >> 6;
    float* scl = (float*)(ws + WS_PEERV);
    for (int row = gw; row < 4 * NEXP; row += nw) {
      const int tab = row >> 15, rr = row & 32767;
      const float* src = (tab ? p.peer_v : p.peer_u) + (size_t)rr * D_;
      unsigned char* dst = (unsigned char*)(ws + (tab ? WS_PEERV8 : WS_PEERU)) + (size_t)rr * D_;
      float4 v[8];
      float am = 0.f;
#pragma unroll
      for (int i = 0; i < 2; ++i)
#pragma unroll
        for (int j = 0; j < 4; ++j) {
          v[4 * i + j] = *(const float4*)(src + lane * 16 + 1024 * i + 4 * j);
          am = fmaxf(am, fmaxf(fmaxf(fabsf(v[4 * i + j].x), fabsf(v[4 * i + j].y)), fmaxf(fabsf(v[4 * i + j].z), fabsf(v[4 * i + j].w))));
        }
      am = wave_max(am);
      const float sc = am > 0.f ? 432.f / am : 1.f;
      if (lane == 0) scl[row] = am > 0.f ? am / 432.f : 1.f;
#pragma unroll
      for (int i = 0; i < 2; ++i) {
        unsigned w[4];
#pragma unroll
        for (int j = 0; j < 4; ++j) {
          int d = __builtin_amdgcn_cvt_pk_fp8_f32(v[4 * i + j].x * sc, v[4 * i + j].y * sc, 0, false);
          d = __builtin_amdgcn_cvt_pk_fp8_f32(v[4 * i + j].z * sc, v[4 * i + j].w * sc, d, true);
          w[j] = (unsigned)d;
        }
        *(uint4*)(dst + lane * 16 + 1024 * i) = make_uint4(w[0], w[1], w[2], w[3]);
      }
    }
    for (int item = bid; item < 32; item += G) {
      const size_t off = (size_t)item * 2048;
      const float4 a = *(const float4*)(p.peer_sub_keys + off + tid * 8), b = *(const float4*)(p.peer_sub_keys + off + tid * 8 + 4);
      *(uint4*)((bf16_t*)(ws + WS_SK) + off + tid * 8) = make_uint4(pack_bf2(a.x, a.y), pack_bf2(a.z, a.w), pack_bf2(b.x, b.y), pack_bf2(b.z, b.w));
    }
  }
  if (bid == G - 1) {
    float* wff = (float*)(ws + WS_WFF);
    for (int e = tid; e < 2048 * 8; e += NTHREADS) wff[e] = p.even_w_in[(size_t)(e >> 3) * 6152 + 3072 + (e & 7)];
    if (tid < 64) {
      const float* l = p.even_diff_lambda;
      float s1 = l[tid] * l[128 + tid] + l[64 + tid] * l[128 + 64 + tid];
      float s2 = l[256 + tid] * l[384 + tid] + l[256 + 64 + tid] * l[384 + 64 + tid];
      s1 = wave_sum(s1); s2 = wave_sum(s2);
      if (tid == 0) ((float*)(ws + WS_MISC))[0] = expf(s1) - expf(s2) + 0.2f;
    }
  }
}

template <bool FF>
DI void phase_norm(const Params& p, const float* __restrict__ xin, const float* __restrict__ gain,
                   const float* __restrict__ sh, const float* __restrict__ sc  ) {
  const int lane = TID() & 63;
  const int gw = __builtin_amdgcn_readfirstlane((blockIdx.x * NTHREADS + TID()) >> 6), nw = (gridDim.x * NTHREADS) >> 6;
  bf16_t* H = (bf16_t*)(p.ws + WS_H);
  for (int t = gw; t < T_; t += nw) {
    const int b = t >> 11;
    const float* xr = xin + (size_t)t * D_;
    float4 v[8];
    float ss = 0.f;
#pragma unroll
    for (int i = 0; i < 8; ++i) { v[i] = *(const float4*)(xr + lane * 4 + 256 * i); ss += v[i].x * v[i].x + v[i].y * v[i].y + v[i].z * v[i].z + v[i].w * v[i].w; }
    ss = wave_sum(ss);
    const float rstd = rsqrtf(ss * (1.f / 2048.f) + 1e-6f);
    float ff[8];
    if (FF) {
#pragma unroll
      for (int j = 0; j < 8; ++j) ff[j] = 0.f;
    }
#pragma unroll
    for (int i = 0; i < 8; ++i) {
      const int c = lane * 4 + 256 * i;
      const float4 g = *(const float4*)(gain + c);
      const float4 s1 = *(const float4*)(sc + (size_t)b * 12288 + c);
      const float4 s0 = *(const float4*)(sh + (size_t)b * 12288 + c);
      float4 h;
      h.x = v[i].x * rstd * g.x * (1.f + s1.x) + s0.x;
      h.y = v[i].y * rstd * g.y * (1.f + s1.y) + s0.y;
      h.z = v[i].z * rstd * g.z * (1.f + s1.z) + s0.z;
      h.w = v[i].w * rstd * g.w * (1.f + s1.w) + s0.w;
      *(uint2*)(H + (size_t)t * D_ + c) = make_uint2(pack_bf2(h.x, h.y), pack_bf2(h.z, h.w));
      if (FF) {
        const float* wff = (const float*)(p.ws + WS_WFF) + c * 8;
        const float hv[4] = {h.x, h.y, h.z, h.w};
#pragma unroll
        for (int e = 0; e < 4; ++e) {
          const float4 w0 = *(const float4*)(wff + e * 8), w1 = *(const float4*)(wff + e * 8 + 4);
          ff[0] += hv[e] * w0.x; ff[1] += hv[e] * w0.y; ff[2] += hv[e] * w0.z; ff[3] += hv[e] * w0.w;
          ff[4] += hv[e] * w1.x; ff[5] += hv[e] * w1.y; ff[6] += hv[e] * w1.z; ff[7] += hv[e] * w1.w;
        }
      }
    }
    if (FF) {
#pragma unroll
      for (int j = 0; j < 8; ++j) ff[j] = wave_sum(ff[j]);
      if (lane < 8) {
        float z = ff[0];
#pragma unroll
        for (int j = 1; j < 8; ++j) z = (lane == j) ? ff[j] : z;
        z += p.even_b_forget[lane];
        const float lf = fminf(z, 0.f) - log1pf(__expf(-fabsf(z)));
        ((float*)(p.ws + WS_LOGF))[(size_t)t * 8 + lane] = lf;
      }
    }
  }
}

DI void fox_cumsum(const Params& p) {
  const int lane = TID() & 63;
  const int gw = __builtin_amdgcn_readfirstlane((blockIdx.x * NTHREADS + TID()) >> 6), nw = (gridDim.x * NTHREADS) >> 6;
  const float* lf = (const float*)(p.ws + WS_LOGF);
  float* fc = (float*)(p.ws + WS_FCUM);
  for (int it = gw; it < 64; it += nw) {
    const int b = it >> 3, hh = it & 7;
    float v[32];
    float tot = 0.f;
#pragma unroll
    for (int j = 0; j < 32; ++j) { tot += lf[(size_t)(b * S_ + lane * 32 + j) * 8 + hh]; v[j] = tot; }
    float inc = tot;
#pragma unroll
    for (int o = 1; o < 64; o <<= 1) { const float n = __shfl_up(inc, o); if (lane >= o) inc += n; }
    const float base = inc - tot;
#pragma unroll
    for (int j = 0; j < 32; ++j) fc[(size_t)it * S_ + lane * 32 + j] = v[j] + base;
  }
}

DI void gemm_tile_compute(const bf16_t* __restrict__ A, int lda, const bf16_t* __restrict__ B, int ldb, int K,
                          char* smem, f32x16 (&acc)[2][2]) {
  const int tid = TID(), lane = tid & 63, wave = __builtin_amdgcn_readfirstlane(tid >> 6);
  const int r = lane & 31, h = lane >> 5;
  const int wm = wave >> 1, wn = wave & 1;
  const int srow = tid >> 3, sc = tid & 7;
  const bf16_t* ga = A + (size_t)srow * lda + sc * 8;
  const bf16_t* gb = B + (size_t)srow * ldb + sc * 8;
  uint4 ra[4], rb[4];
#pragma unroll
  for (int i = 0; i < 4; ++i) {
    ra[i] = *(const uint4*)(ga + (size_t)(32 * i) * lda);
    rb[i] = *(const uint4*)(gb + (size_t)(32 * i) * ldb);
  }
  const int woff = srow * 128 + ((sc ^ ((srow >> 1) & 7)) << 4);
  const int rsw = (r >> 1) & 7;
  const int aoff = (wm * 64 + r) * 128, boff = 16384 + (wn * 64 + r) * 128;
#pragma unroll
  for (int i = 0; i < 2; ++i)
#pragma unroll
    for (int j = 0; j < 2; ++j)
#pragma unroll
      for (int e = 0; e < 16; ++e) acc[i][j][e] = 0.f;
#pragma unroll
  for (int i = 0; i < 4; ++i) {
    *(uint4*)(smem + woff + i * 4096) = ra[i];
    *(uint4*)(smem + 16384 + woff + i * 4096) = rb[i];
  }
  __syncthreads();
  const int KT = K >> 6;
  for (int kt = 0; kt < KT; ++kt) {
    char* st = smem + (kt & 1) * 32768;
    if (kt + 1 < KT) {
#pragma unroll
      for (int i = 0; i < 4; ++i) {
        ra[i] = *(const uint4*)(ga + (size_t)(32 * i) * lda + (kt + 1) * 64);
        rb[i] = *(const uint4*)(gb + (size_t)(32 * i) * ldb + (kt + 1) * 64);
      }
    }
#pragma unroll
    for (int s = 0; s < 4; ++s) {
      const int co = ((2 * s + h) ^ rsw) << 4;
      bf16x8 af[2], bfr[2];
      af[0] = *(const bf16x8*)(st + aoff + co);
      af[1] = *(const bf16x8*)(st + aoff + 32 * 128 + co);
      bfr[0] = *(const bf16x8*)(st + boff + co);
      bfr[1] = *(const bf16x8*)(st + boff + 32 * 128 + co);
#pragma unroll
      for (int i = 0; i < 2; ++i)
#pragma unroll
        for (int j = 0; j < 2; ++j) acc[i][j] = MFMA32(af[i], bfr[j], acc[i][j]);
    }
    if (kt + 1 < KT) {
      char* sn = smem + ((kt + 1) & 1) * 32768;
#pragma unroll
      for (int i = 0; i < 4; ++i) {
        *(uint4*)(sn + woff + i * 4096) = ra[i];
        *(uint4*)(sn + 16384 + woff + i * 4096) = rb[i];
      }
    }
    __syncthreads();
  }
}

enum { EPI_BF16 = 0, EPI_NORM_BF16 = 1, EPI_RES_F32 = 2, EPI_F32 = 3 };
struct EpiArgs {
  void* out; int ldc;
  const float* gainA; const float* gainB; int gshift;
  const float* xin; const float* gate;
};

template <int EPI>
DI void gemm_epilogue(f32x16 (&acc)[2][2], int m0, int n0, int tn, const EpiArgs& ea, char* smem) {
  const int tid = TID(), lane = tid & 63, wave = __builtin_amdgcn_readfirstlane(tid >> 6);
  const int r = lane & 31, h = lane >> 5;
  const int wm = wave >> 1, wn = wave & 1;
  if (EPI == EPI_NORM_BF16) {
    float* red = (float*)smem;
    float ss[2][16];
#pragma unroll
    for (int i = 0; i < 2; ++i)
#pragma unroll
      for (int e = 0; e < 16; ++e) {
        float v = acc[i][0][e] * acc[i][0][e] + acc[i][1][e] * acc[i][1][e];
#pragma unroll
        for (int o = 16; o >= 1; o >>= 1) v += __shfl_xor(v, o);
        ss[i][e] = v;
      }
    if (r == 0) {
#pragma unroll
      for (int i = 0; i < 2; ++i)
#pragma unroll
        for (int e = 0; e < 16; ++e) red[wn * 128 + wm * 64 + i * 32 + crow(e, h)] = ss[i][e];
    }
    __syncthreads();
    const int grp = tn >> ea.gshift;
    const float* gain = ((grp & 2) ? ea.gainB : ea.gainA) + (grp & 1) * 128;
    bf16_t* out = (bf16_t*)ea.out;
#pragma unroll
    for (int i = 0; i < 2; ++i)
#pragma unroll
      for (int e = 0; e < 16; ++e) {
        const int rl = wm * 64 + i * 32 + crow(e, h);
        const float rstd = rsqrtf((red[rl] + red[128 + rl]) * (1.f / 128.f) + 1e-6f);
#pragma unroll
        for (int j = 0; j < 2; ++j) {
          const int cl = wn * 64 + j * 32 + r;
          out[(size_t)(m0 + rl) * ea.ldc + n0 + cl] = f2bf(acc[i][j][e] * rstd * gain[cl]);
        }
      }
    __syncthreads();
  } else {
#pragma unroll
    for (int i = 0; i < 2; ++i)
#pragma unroll
      for (int e = 0; e < 16; ++e) {
        const int row = m0 + wm * 64 + i * 32 + crow(e, h);
#pragma unroll
        for (int j = 0; j < 2; ++j) {
          const int col = n0 + wn * 64 + j * 32 + r;
          const float v = acc[i][j][e];
          if (EPI == EPI_BF16) ((bf16_t*)ea.out)[(size_t)row * ea.ldc + col] = f2bf(v);
          else if (EPI == EPI_F32) ((float*)ea.out)[(size_t)row * ea.ldc + col] = v;
          else {
            const float g = ea.gate[(size_t)(row >> 11) * 12288 + col];
            ((float*)ea.out)[(size_t)row * ea.ldc + col] = ea.xin[(size_t)row * ea.ldc + col] + g * v;
          }
        }
      }
  }
}

template <int EPI>
DI void gemm_phase(const bf16_t* A, int lda, const bf16_t* B, int ldb, int K, int mt, int nt, const EpiArgs& ea, char* smem) {
  const int bid = blockIdx.x, G = gridDim.x;
  const int xcd = bid & 7, slot = bid >> 3, nslots = G >> 3;
  const int nsn = nt >> 3, nsup = (mt >> 3) * nsn;
  const int cnt = (nsup - xcd + 7) >> 3;
  for (int j = slot; j < cnt * 64; j += nslots) {
    const int sup = xcd + 8 * (j >> 6), within = j & 63;
    const int sm = sup / nsn, sn = sup - sm * nsn;
    const int tm = sm * 8 + (within >> 3), tn = sn * 8 + (within & 7);
    f32x16 acc[2][2];
    gemm_tile_compute(A + (size_t)tm * 128 * lda, lda, B + (size_t)tn * 128 * ldb, ldb, K, smem, acc);
    gemm_epilogue<EPI>(acc, tm * 128, tn * 128, tn, ea, smem);
  }
}

template <int MODE>
DI void attn_wave(const bf16_t* __restrict__ Qp, int ldq, const bf16_t* __restrict__ Kp, int ldk,
                  const bf16_t* __restrict__ Vt, int ldv, const float* __restrict__ kbias, const float* tbl,
                  int q0, f32x16 (&o)[4], float& l_out) {
  const int lane = TID() & 63, r = lane & 31, h = lane >> 5;
  const float scale2 = 0.08838834764831845f * LOG2E;
  bf16x8 qf[8];
#pragma unroll
  for (int s = 0; s < 8; ++s) qf[s] = *(const bf16x8*)(Qp + (size_t)(q0 + r) * ldq + 16 * s + 8 * h);
#pragma unroll
  for (int dt = 0; dt < 4; ++dt)
#pragma unroll
    for (int e = 0; e < 16; ++e) o[dt][e] = 0.f;
  float m = -1e30f, l = 0.f;
  const int nkt = (q0 >> 5) + 1;
  for (int kt = 0; kt < nkt; ++kt) {
    const int k0 = kt << 5;
    bf16x8 kf[8];
#pragma unroll
    for (int s = 0; s < 8; ++s) kf[s] = *(const bf16x8*)(Kp + (size_t)(k0 + r) * ldk + 16 * s + 8 * h);
    bf16x4 vf[4][2][2];
#pragma unroll
    for (int dt = 0; dt < 4; ++dt)
#pragma unroll
      for (int s = 0; s < 2; ++s) {
        const bf16_t* vp = Vt + (size_t)(32 * dt + r) * ldv + k0 + 16 * s + 4 * h;
        vf[dt][s][0] = *(const bf16x4*)(vp);
        vf[dt][s][1] = *(const bf16x4*)(vp + 8);
      }
    f32x16 sa;
#pragma unroll
    for (int e = 0; e < 16; ++e) sa[e] = 0.f;
#pragma unroll
    for (int s = 0; s < 8; ++s) sa = MFMA32(kf[s], qf[s], sa);
    float v[16];
    if (MODE == 0) {
#pragma unroll
      for (int c = 0; c < 4; ++c) {
        const float4 kb = *(const float4*)(kbias + k0 + 8 * c + 4 * h);
        v[4 * c + 0] = sa[4 * c + 0] * scale2 - kb.x * LOG2E;
        v[4 * c + 1] = sa[4 * c + 1] * scale2 - kb.y * LOG2E;
        v[4 * c + 2] = sa[4 * c + 2] * scale2 - kb.z * LOG2E;
        v[4 * c + 3] = sa[4 * c + 3] * scale2 - kb.w * LOG2E;
      }
      if (kt == nkt - 1) {
#pragma unroll
        for (int e = 0; e < 16; ++e) if (crow(e, h) > r) v[e] = -INFINITY;
      }
    } else {
      const float* tp = tbl + (q0 - k0) + r + 32 - 4 * h - 27;
#pragma unroll
      for (int e = 0; e < 16; ++e) v[e] = sa[e] * scale2 + tp[27 - ((e & 3) + 8 * (e >> 2))];
    }
    float mx = v[0];
#pragma unroll
    for (int e = 1; e < 16; ++e) mx = fmaxf(mx, v[e]);
    mx = fmaxf(mx, __shfl_xor(mx, 32));
    const float mn = fmaxf(m, mx);
    const float alpha = exp2f(m - mn);
    m = mn;
    float ps = 0.f;
#pragma unroll
    for (int e = 0; e < 16; ++e) { v[e] = exp2f(v[e] - mn); ps += v[e]; }
    l = l * alpha + ps;
#pragma unroll
    for (int dt = 0; dt < 4; ++dt)
#pragma unroll
      for (int e = 0; e < 16; ++e) o[dt][e] *= alpha;
    bf16x8 pb[2];
#pragma unroll
    for (int s = 0; s < 2; ++s) {
      const uint4 u = make_uint4(pack_bf2(v[8 * s + 0], v[8 * s + 1]), pack_bf2(v[8 * s + 2], v[8 * s + 3]),
                                 pack_bf2(v[8 * s + 4], v[8 * s + 5]), pack_bf2(v[8 * s + 6], v[8 * s + 7]));
      pb[s] = __builtin_bit_cast(bf16x8, u);
    }
#pragma unroll
    for (int dt = 0; dt < 4; ++dt)
#pragma unroll
      for (int s = 0; s < 2; ++s) {
        const bf16x8 va = __builtin_shufflevector(vf[dt][s][0], vf[dt][s][1], 0, 1, 2, 3, 4, 5, 6, 7);
        o[dt] = MFMA32(va, pb[s], o[dt]);
      }
  }
  l_out = l + __shfl_xor(l, 32);
}

DI void attn_store_bf16(const f32x16 (&o)[4], float linv, bf16_t* __restrict__ out_row  , int ldo) {
  const int lane = TID() & 63, r = lane & 31, h = lane >> 5;
  bf16_t* op = out_row + (size_t)r * ldo + 4 * h;
#pragma unroll
  for (int dt = 0; dt < 4; ++dt)
#pragma unroll
    for (int c = 0; c < 4; ++c)
      *(uint2*)(op + 32 * dt + 8 * c) = make_uint2(pack_bf2(o[dt][4 * c] * linv, o[dt][4 * c + 1] * linv),
                                                    pack_bf2(o[dt][4 * c + 2] * linv, o[dt][4 * c + 3] * linv));
}

DI int t5_bucket(int n) {
  if (n < 16) return n;
  int lg = 16 + (int)(logf((float)n / 16.f) / 4.852030263919617f * 16.f);
  return lg < 31 ? lg : 31;
}

DI void phase_attn_even(const Params& p, char* smem) {
  const int tid = TID(), wave = __builtin_amdgcn_readfirstlane(tid >> 6), bid = blockIdx.x, G = gridDim.x;
  const bf16_t* QK = (const bf16_t*)(p.ws + WS_QK);
  const bf16_t* VT = (const bf16_t*)(p.ws + WS_VT);
  bf16_t* ATT = (bf16_t*)(p.ws + WS_ATT);
  float* pieces = (float*)smem;
  float* tbl = (float*)(smem + 66048);
  const float lam = ((const float*)(p.ws + WS_MISC))[0];
  for (int item = bid; item < 3072; item += G) {
    const int g = item / 192; int rem = item - g * 192;
    const int qb = 15 - g;
    if (rem < 64) {
      const int b = rem >> 3, hh = rem & 7;
      const int q0 = qb * 128 + 32 * wave;
      const bf16_t* Qp = QK + (size_t)b * S_ * 4096 + hh * 128;
      f32x16 o[4]; float l;
      attn_wave<0>(Qp, 4096, Qp + 1024, 4096, VT + (size_t)(hh * 128) * T_ + b * S_, T_,
                   (const float*)(p.ws + WS_FCUM) + (size_t)(b * 8 + hh) * S_, nullptr, q0, o, l);
      attn_store_bf16(o, 1.f / l, ATT + (size_t)(b * S_ + q0) * D_ + hh * 128, D_);
    } else {
      rem -= 64;
      const int qt = 4 * qb + 3 - (rem >> 5);
      const int bh = rem & 31, b = bh >> 2, hh = bh & 3;
      const int q0 = qt * 32;
      for (int e = tid; e < 2080; e += NTHREADS) {
        const int dist = e - 32;
        tbl[e] = dist >= 0 ? p.rel_bias[t5_bucket(dist) * 16 + hh] * LOG2E : -INFINITY;
      }
      __syncthreads();
      const int mm = wave >> 1, half = wave & 1;
      const bf16_t* Qp = QK + (size_t)b * S_ * 4096 + 2048 + hh * 256 + mm * 128;
      f32x16 o[4]; float l;
      attn_wave<1>(Qp, 4096, Qp + 1024, 4096, VT + (size_t)(1024 + hh * 256 + half * 128) * T_ + b * S_, T_,
                   nullptr, tbl, q0, o, l);
      {
        const int lane = tid & 63, r = lane & 31, h = lane >> 5;
        const float linv = 1.f / l;
        float* pw = pieces + (wave * 32 + r) * 129;
#pragma unroll
        for (int dt = 0; dt < 4; ++dt)
#pragma unroll
          for (int e = 0; e < 16; ++e) pw[32 * dt + crow(e, h)] = o[dt][e] * linv;
      }
      __syncthreads();
      {
        const int q = tid >> 3, d0 = (tid & 7) * 32;
        const int half2 = d0 >> 7, dl = d0 & 127;
        const float* p0 = pieces + ((0 * 2 + half2) * 32 + q) * 129 + dl;
        const float* p1 = pieces + ((1 * 2 + half2) * 32 + q) * 129 + dl;
        float val[32]; float ss = 0.f;
#pragma unroll
        for (int j = 0; j < 32; ++j) { val[j] = p0[j] - lam * p1[j]; ss += val[j] * val[j]; }
        ss += __shfl_xor(ss, 1); ss += __shfl_xor(ss, 2); ss += __shfl_xor(ss, 4);
        const float rstd = rsqrtf(ss * (1.f / 256.f) + 1e-6f) * 0.8f;
        const float* sg = p.even_diff_subln_gain + d0;
        bf16_t* op = ATT + (size_t)(b * S_ + q0 + q) * D_ + 1024 + hh * 256 + d0;
#pragma unroll
        for (int j = 0; j < 32; j += 8) {
          *(uint4*)(op + j) = make_uint4(pack_bf2(val[j] * rstd * sg[j], val[j + 1] * rstd * sg[j + 1]),
                                         pack_bf2(val[j + 2] * rstd * sg[j + 2], val[j + 3] * rstd * sg[j + 3]),
                                         pack_bf2(val[j + 4] * rstd * sg[j + 4], val[j + 5] * rstd * sg[j + 5]),
                                         pack_bf2(val[j + 6] * rstd * sg[j + 6], val[j + 7] * rstd * sg[j + 7]));
        }
      }
      __syncthreads();
    }
  }
}

DI void phase_attn_odd(const Params& p, char* smem) {
  const int tid = TID(), wave = __builtin_amdgcn_readfirstlane(tid >> 6), bid = blockIdx.x, G = gridDim.x;
  const bf16_t* QK = (const bf16_t*)(p.ws + WS_QK);
  const bf16_t* VT = (const bf16_t*)(p.ws + WS_VT);
  bf16_t* ATT = (bf16_t*)(p.ws + WS_ATT);
  float* tbl = (float*)(smem + 66048);
  int cur_head = -1;
  for (int item = bid; item < 2048; item += G) {
    const int g = item >> 7, rem = item & 127;
    const int qb = 15 - g, b = rem >> 4, hd = rem & 15;
    if (hd != cur_head) {
      __syncthreads();
      for (int e = tid; e < 2080; e += NTHREADS) {
        const int dist = e - 32;
        float val = -INFINITY;
        if (dist >= 0) {
          int cnt = 0;
          if (dist <= 128) cnt += 1;
          if (dist <= 512 && (dist & 3) == 0) cnt += 1;
          if ((dist & 15) == 0) cnt += 1;
          if (cnt > 0) val = (p.rel_bias[t5_bucket(dist) * 16 + hd] + __logf((float)cnt)) * LOG2E;
        }
        tbl[e] = val;
      }
      cur_head = hd;
      __syncthreads();
    }
    const int q0 = qb * 128 + 32 * wave;
    const bf16_t* Qp = QK + (size_t)b * S_ * 4096 + hd * 128;
    f32x16 o[4]; float l;
    attn_wave<1>(Qp, 4096, Qp + 2048, 4096, VT + (size_t)(hd * 128) * T_ + b * S_, T_, nullptr, tbl, q0, o, l);
    attn_store_bf16(o, 1.f / l, ATT + (size_t)(b * S_ + q0) * D_ + hd * 128, D_);
  }
}

DI unsigned fkey(float f) { const unsigned u = __float_as_uint(f); return (u & 0x80000000u) ? ~u : (u | 0x80000000u); }
DI int popc64(unsigned long long m) { return __popcll(m); }
DI int mbcnt(unsigned long long m) { return __builtin_amdgcn_mbcnt_hi((unsigned)(m >> 32), __builtin_amdgcn_mbcnt_lo((unsigned)m, 0)); }

template <int NV>
DI void select16(const unsigned (&key)[NV], bool (&sel)[NV], int (&pos)[NV]) {
  unsigned thr = 0;
#pragma unroll 1
  for (int bit = 31; bit >= 0; --bit) {
    const unsigned cand = thr | (1u << bit);
    int cnt = 0;
#pragma unroll
    for (int a = 0; a < NV; ++a) cnt += popc64(__ballot(key[a] >= cand));
    if (cnt >= 16) thr = cand;
  }
  int cgt = 0;
#pragma unroll
  for (int a = 0; a < NV; ++a) cgt += popc64(__ballot(key[a] > thr));
  const int need = 16 - cgt;
  int eqbase = 0, sbase = 0;
#pragma unroll
  for (int a = 0; a < NV; ++a) {
    const bool eq = key[a] == thr;
    const unsigned long long em = __ballot(eq);
    const bool s = (key[a] > thr) || (eq && (eqbase + mbcnt(em)) < need);
    eqbase += popc64(em);
    const unsigned long long sm = __ballot(s);
    sel[a] = s; pos[a] = sbase + mbcnt(sm);
    sbase += popc64(sm);
  }
}

DI float gelu_erf(float x) { return 0.5f * x * (1.f + erff(x * 0.7071067811865476f)); }

DI void phase_peer(const Params& p, int layer, const float* __restrict__ gate2  , char* smem) {
  const int tid = TID(), lane = tid & 63, wave = __builtin_amdgcn_readfirstlane(tid >> 6);
  const int gw = __builtin_amdgcn_readfirstlane((blockIdx.x * NTHREADS + tid) >> 6), nw = (gridDim.x * NTHREADS) >> 6;
  float* wl_s = (float*)(smem + wave * 2048);
  int* wl_i = (int*)(smem + wave * 2048 + 128);
  int* ex_i = (int*)(smem + wave * 2048 + 256);
  float* ex_g = (float*)(smem + wave * 2048 + 768);
  const float* SC = (const float*)(p.ws + WS_SC);
  const bf16_t* H = (const bf16_t*)(p.ws + WS_H);
  const unsigned char* PU = (const unsigned char*)(p.ws + WS_PEERU) + (size_t)layer * NEXP * D_;
  const unsigned char* PV = (const unsigned char*)(p.ws + WS_PEERV8) + (size_t)layer * NEXP * D_;
  const float* USC = (const float*)(p.ws + WS_PEERV) + (size_t)layer * NEXP;
  const float* VSC = (const float*)(p.ws + WS_PEERV) + (size_t)(2 + layer) * NEXP;
  for (int t = gw; t < T_; t += nw) {
#pragma unroll 1
    for (int hh = 0; hh < 8; ++hh) {
      const float* sr = SC + ((size_t)t * 8 + hh) * 256;
      float sv[4];
#pragma unroll
      for (int a = 0; a < 4; ++a) sv[a] = sr[a * 64 + lane];
#pragma unroll
      for (int pp = 0; pp < 2; ++pp) {
        unsigned key[2] = {fkey(sv[2 * pp]), fkey(sv[2 * pp + 1])};
        bool sel[2]; int pos[2];
        select16<2>(key, sel, pos);
#pragma unroll
        for (int a = 0; a < 2; ++a) if (sel[a]) { wl_s[pp * 16 + pos[a]] = sv[2 * pp + a]; wl_i[pp * 16 + pos[a]] = a * 64 + lane; }
      }
      const float sa = wl_s[lane >> 2];
      const int ia = wl_i[lane >> 2];
      float cs[4]; int ci[4]; unsigned key[4];
#pragma unroll
      for (int j = 0; j < 4; ++j) {
        cs[j] = sa + wl_s[16 + (lane & 3) * 4 + j];
        ci[j] = ia * 128 + wl_i[16 + (lane & 3) * 4 + j];
        key[j] = fkey(cs[j]);
      }
      bool sel[4]; int pos[4];
      select16<4>(key, sel, pos);
      float mx = -INFINITY;
#pragma unroll
      for (int j = 0; j < 4; ++j) if (sel[j]) mx = fmaxf(mx, cs[j]);
      mx = wave_max(mx);
      float e[4]; float es = 0.f;
#pragma unroll
      for (int j = 0; j < 4; ++j) { e[j] = sel[j] ? __expf(cs[j] - mx) : 0.f; es += e[j]; }
      es = wave_sum(es);
      const float inv = 1.f / es;
#pragma unroll
      for (int j = 0; j < 4; ++j) if (sel[j]) { ex_i[hh * 16 + pos[j]] = ci[j]; ex_g[hh * 16 + pos[j]] = e[j] * inv; }
    }
    float xf[32];
    {
      const bf16_t* hr = H + (size_t)t * D_ + lane * 16;
#pragma unroll
      for (int i = 0; i < 2; ++i)
#pragma unroll
        for (int hq = 0; hq < 2; ++hq) {
          const uint4 u = *(const uint4*)(hr + 1024 * i + 8 * hq);
          const unsigned w[4] = {u.x, u.y, u.z, u.w};
#pragma unroll
          for (int k = 0; k < 4; ++k) { xf[16 * i + 8 * hq + 2 * k] = bf_lo(w[k]); xf[16 * i + 8 * hq + 2 * k + 1] = bf_hi(w[k]); }
        }
    }
    float y[32];
#pragma unroll
    for (int j = 0; j < 32; ++j) y[j] = 0.f;
    uint4 ua[2][2], va[2][2], ub[2][2], vb[2][2];
    float sua[2], sva[2], sub_[2], svb[2];
#define PEER_LOAD(UR, VR, SU, SV, EB)                                                                   \
    _Pragma("unroll") for (int q = 0; q < 2; ++q) {                                                     \
      const int id = __builtin_amdgcn_readfirstlane(ex_i[(EB) + q]);                                   \
      const unsigned char* up = PU + (size_t)id * D_ + lane * 16;                                      \
      const unsigned char* vp = PV + (size_t)id * D_ + lane * 16;                                      \
      UR[q][0] = *(const uint4*)(up); UR[q][1] = *(const uint4*)(up + 1024);                           \
      VR[q][0] = *(const uint4*)(vp); VR[q][1] = *(const uint4*)(vp + 1024);                           \
      SU[q] = USC[id]; SV[q] = VSC[id];                                                                 \
    }
#define PEER_COMPUTE(UR, VR, SU, SV, EB)                                                                \
    {                                                                                                   \
      float dq[2];                                                                                      \
      _Pragma("unroll") for (int q = 0; q < 2; ++q) {                                                   \
        float a0 = 0.f, a1 = 0.f;                                                                       \
        _Pragma("unroll") for (int i = 0; i < 2; ++i) {                                                 \
          const unsigned w[4] = {UR[q][i].x, UR[q][i].y, UR[q][i].z, UR[q][i].w};                      \
          _Pragma("unroll") for (int k = 0; k < 4; ++k) {                                               \
            const f2_t lo = __builtin_amdgcn_cvt_pk_f32_fp8((int)w[k], false);                         \
            const f2_t hi = __builtin_amdgcn_cvt_pk_f32_fp8((int)w[k], true);                          \
            a0 += lo.x * xf[16 * i + 4 * k] + hi.x * xf[16 * i + 4 * k + 2];                            \
            a1 += lo.y * xf[16 * i + 4 * k + 1] + hi.y * xf[16 * i + 4 * k + 3];                        \
          }                                                                                             \
        }                                                                                               \
        dq[q] = a0 + a1;                                                                                \
      }                                                                                                 \
                            \
      const bool hb = lane >= 32;                                                                       \
      float kk = hb ? dq[1] : dq[0];                                                                    \
      const float ss = hb ? dq[0] : dq[1];                                                              \
      kk += __shfl_xor(ss, 32);                                                                         \
      kk += __shfl_xor(kk, 16); kk += __shfl_xor(kk, 8); kk += __shfl_xor(kk, 4); kk += __shfl_xor(kk, 2); kk += __shfl_xor(kk, 1); \
      const float cfl = (hb ? ex_g[(EB) + 1] : ex_g[(EB)]) * gelu_erf(kk * (hb ? SU[1] : SU[0])) * (hb ? SV[1] : SV[0]); \
      _Pragma("unroll") for (int q = 0; q < 2; ++q) {                                                   \
        const float cf = __builtin_bit_cast(float, __builtin_amdgcn_readlane(__builtin_bit_cast(int, cfl), 32 * q)); \
        _Pragma("unroll") for (int i = 0; i < 2; ++i) {                                                 \
          const unsigned w[4] = {VR[q][i].x, VR[q][i].y, VR[q][i].z, VR[q][i].w};                      \
          _Pragma("unroll") for (int k = 0; k < 4; ++k) {                                               \
            const f2_t lo = __builtin_amdgcn_cvt_pk_f32_fp8((int)w[k], false);                         \
            const f2_t hi = __builtin_amdgcn_cvt_pk_f32_fp8((int)w[k], true);                          \
            y[16 * i + 4 * k] += cf * lo.x; y[16 * i + 4 * k + 1] += cf * lo.y;                          \
            y[16 * i + 4 * k + 2] += cf * hi.x; y[16 * i + 4 * k + 3] += cf * hi.y;                      \
          }                                                                                             \
        }                                                                                               \
      }                                                                                                 \
    }
    PEER_LOAD(ua, va, sua, sva, 0)
#pragma unroll 1
    for (int eb = 0; eb < 128; eb += 4) {
      PEER_LOAD(ub, vb, sub_, svb, eb + 2)
      PEER_COMPUTE(ua, va, sua, sva, eb)
      if (eb + 4 < 128) { PEER_LOAD(ua, va, sua, sva, eb + 4) }
      PEER_COMPUTE(ub, vb, sub_, svb, eb + 2)
    }
#undef PEER_LOAD
#undef PEER_COMPUTE
    {
      const int b = t >> 11;
      float* orow = p.out + (size_t)t * D_ + lane * 16;
      const float* grow = gate2 + (size_t)b * 12288 + lane * 16;
#pragma unroll
      for (int i = 0; i < 2; ++i)
#pragma unroll
        for (int j = 0; j < 4; ++j) {
          float4 a0 = *(const float4*)(orow + 1024 * i + 4 * j);
          const float4 g0 = *(const float4*)(grow + 1024 * i + 4 * j);
          a0.x += g0.x * y[16 * i + 4 * j]; a0.y += g0.y * y[16 * i + 4 * j + 1];
          a0.z += g0.z * y[16 * i + 4 * j + 2]; a0.w += g0.w * y[16 * i + 4 * j + 3];
          *(float4*)(orow + 1024 * i + 4 * j) = a0;
        }
    }
  }
}

DI void phase_peer_scores(const Params& p, int layer, char* smem) {
  const bf16_t* QP = (const bf16_t*)(p.ws + WS_QK);
  const bf16_t* SK = (const bf16_t*)(p.ws + WS_SK) + (size_t)layer * 2 * 128 * 128;
  EpiArgs ea{}; ea.out = nullptr; ea.ldc = 256;
  for (int L = blockIdx.x; L < 2048; L += gridDim.x) {
    const int pp = L & 1, tm = L >> 1;
    f32x16 acc[2][2];
    gemm_tile_compute(QP + (size_t)tm * 128 * 256 + pp * 128, 256, SK + (size_t)pp * 128 * 128, 128, 128, smem, acc);
    ea.out = (float*)(p.ws + WS_SC) + pp * 128;
    gemm_epilogue<EPI_F32>(acc, tm * 128, 0, 0, ea, smem);
  }
}

constexpr int N_PHASES = 17;
DI void run_phase(const Params& p, int ph, char* smem) {
  char* ws = p.ws;
  const float* mod = (const float*)(ws + WS_MOD);
  const bf16_t* H = (const bf16_t*)(ws + WS_H);
  if (ph == 0) { phase_prep(p, smem); return; }
  const int layer = (ph - 1) >> 3, sub = (ph - 1) & 7;
  const float* modl = mod + (size_t)layer * 8 * 12288;
  switch (sub) {
    case 0:
      if (layer == 0) phase_norm<true>(p, p.x, p.norm_gain, modl, modl + 2048);
      else phase_norm<false>(p, p.out, p.norm_gain + 2 * 2048, modl, modl + 2048);
      break;
    case 1: {
      if (layer == 0) fox_cumsum(p);
      EpiArgs ea{}; ea.out = ws + WS_QK; ea.ldc = 4096;
      if (layer == 0) {
        ea.gainA = p.even_fox_qk_gain; ea.gainB = p.even_diff_qk_gain; ea.gshift = 3;
      } else { ea.gainA = p.odd_qk_gain; ea.gainB = p.odd_qk_gain; ea.gshift = 4; }
      gemm_phase<EPI_NORM_BF16>(H, 2048, (const bf16_t*)(ws + (layer ? WS_WQK1 : WS_WQK0)), 2048, 2048, 128, 32, ea, smem);
      EpiArgs ev{}; ev.out = ws + WS_VT; ev.ldc = T_;
      gemm_phase<EPI_BF16>((const bf16_t*)(ws + (layer ? WS_WV1 : WS_WV0)), 2048, H, 2048, 2048, 16, 128, ev, smem);
    } break;
    case 2:
      if (layer == 0) phase_attn_even(p, smem); else phase_attn_odd(p, smem);
      break;
    case 3: {
      EpiArgs ea{}; ea.out = p.out; ea.ldc = 2048; ea.xin = layer ? p.out : p.x; ea.gate = modl + 2 * 2048;
      gemm_phase<EPI_RES_F32>((const bf16_t*)(ws + WS_ATT), 2048, (const bf16_t*)(ws + (layer ? WS_WO1 : WS_WO0)), 2048, 2048, 128, 16, ea, smem);
    } break;
    case 4:
      phase_norm<false>(p, p.out, p.norm_gain + (layer * 2 + 1) * 2048, modl + 3 * 2048, modl + 4 * 2048);
      break;
    case 5: {
      EpiArgs ea{}; ea.out = ws + WS_QK; ea.ldc = 2048;
      gemm_phase<EPI_BF16>(H, 2048, (const bf16_t*)(ws + (layer ? WS_WQ1 : WS_WQ0)), 2048, 2048, 128, 16, ea, smem);
    } break;
    case 6: phase_peer_scores(p, layer, smem); break;
    case 7: phase_peer(p, layer, modl + 5 * 2048, smem); break;
  }
}

#if FUSED
__global__ void __launch_bounds__(NTHREADS, 2) mega_kernel(Params p) {
  extern __shared__ __attribute__((aligned(16))) char smem[];
  cg::grid_group grid = cg::this_grid();
#pragma unroll
  for (int ph = 0; ph < N_PHASES; ++ph) {
    run_phase(p, ph, smem);
#ifdef REPMASK
    if ((REPMASK >> ph) & 1) run_phase(p, ph, smem);
#endif
    if (ph + 1 < N_PHASES) grid.sync();
  }
}
#else
template <int PH>
__global__ void __launch_bounds__(NTHREADS, 2) phase_kernel(Params p) {
  extern __shared__ __attribute__((aligned(16))) char smem[];
  run_phase(p, PH, smem);
}
template <int PH>
static void launch_phases(const Params& p, int grid, hipStream_t stream) {
  if constexpr (PH < N_PHASES) {
    (void)hipFuncSetAttribute((const void*)phase_kernel<PH>, hipFuncAttributeMaxDynamicSharedMemorySize, SMEM_BYTES);
    phase_kernel<PH><<<grid, NTHREADS, SMEM_BYTES, stream>>>(p);
    launch_phases<PH + 1>(p, grid, stream);
  }
}
#endif

extern "C" void kernel_launch(void* const* d_in, const int* in_sizes, int n_in, void* d_out, int out_size, void* d_ws,
                              size_t ws_size, hipStream_t stream) {
  Params p{};
  p.x = (const float*)d_in[0]; p.c = (const float*)d_in[1]; p.rel_bias = (const float*)d_in[2];
  p.norm_gain = (const float*)d_in[3]; p.w_ada = (const float*)d_in[4]; p.b_ada = (const float*)d_in[5];
  p.even_w_in = (const float*)d_in[6]; p.even_b_forget = (const float*)d_in[7]; p.even_fox_qk_gain = (const float*)d_in[8];
  p.even_diff_qk_gain = (const float*)d_in[9]; p.even_diff_lambda = (const float*)d_in[10];
  p.even_diff_subln_gain = (const float*)d_in[11]; p.even_w_out = (const float*)d_in[12];
  p.odd_w_qkv = (const float*)d_in[13]; p.odd_qk_gain = (const float*)d_in[14]; p.odd_w_out = (const float*)d_in[15];
  p.peer_w_query = (const float*)d_in[16]; p.peer_sub_keys = (const float*)d_in[17];
  p.peer_u = (const float*)d_in[18]; p.peer_v = (const float*)d_in[19];
  p.out = (float*)d_out; p.ws = (char*)d_ws;
  if (ws_size < WS_END) { fprintf(stderr, "workspace too small: %zu < %zu\n", ws_size, (size_t)WS_END); return; }
#if FUSED
  static int grid_blocks = 0;
  if (!grid_blocks) {
    int dev = 0, cus = 0, per_cu = 0;
    hipGetDevice(&dev);
    hipDeviceGetAttribute(&cus, hipDeviceAttributeMultiprocessorCount, dev);
    hipFuncSetAttribute((const void*)mega_kernel, hipFuncAttributeMaxDynamicSharedMemorySize, SMEM_BYTES);
    hipOccupancyMaxActiveBlocksPerMultiprocessor(&per_cu, mega_kernel, NTHREADS, SMEM_BYTES);
    if (per_cu > 2) per_cu = 2;
    grid_blocks = cus * per_cu;
  }
  void* args[] = {&p};
  hipError_t e = hipLaunchCooperativeKernel((void*)mega_kernel, dim3(grid_blocks), dim3(NTHREADS), args, SMEM_BYTES, stream);
  if (e != hipSuccess) fprintf(stderr, "cooperative launch failed: %s (grid %d)\n", hipGetErrorString(e), grid_blocks);
#else
  launch_phases<0>(p, 512, stream);
#endif
}
```

```cpp
#include <hip/hip_runtime.h>
#include <hip/hip_cooperative_groups.h>
#include <stdint.h>
#include <stdio.h>
namespace cg = cooperative_groups;

#ifndef FUSED
#define FUSED 1
#endif

#define DI __device__ __forceinline__
typedef unsigned short bf16_t;
typedef __attribute__((ext_vector_type(8))) short bf16x8;
typedef __attribute__((ext_vector_type(4))) short bf16x4;
typedef __attribute__((ext_vector_type(16))) float f32x16;
typedef __attribute__((ext_vector_type(2))) __bf16 bf2_t;
typedef __attribute__((ext_vector_type(2))) float f2_t;
#define MFMA32(a, b, c) __builtin_amdgcn_mfma_f32_32x32x16_bf16((a), (b), (c), 0, 0, 0)

constexpr int T_ = 16384;
constexpr int D_ = 2048;
constexpr int S_ = 2048;
constexpr int NB_ = 8;
constexpr int NEXP = 16384;
constexpr float LOG2E = 1.4426950408889634f;
constexpr int NTHREADS = 256;
constexpr int SMEM_BYTES = 75776 + 16;

constexpr size_t MiB = 1048576;
constexpr size_t WS_PEERU = 0;
constexpr size_t WS_PEERV8 = WS_PEERU + 64 * MiB;
constexpr size_t WS_PEERV = WS_PEERU + 128 * MiB;
constexpr size_t WS_WQK0 = WS_PEERV + 128 * MiB;
constexpr size_t WS_WV0 = WS_WQK0 + 16 * MiB;
constexpr size_t WS_WQK1 = WS_WV0 + 8 * MiB;
constexpr size_t WS_WV1 = WS_WQK1 + 16 * MiB;
constexpr size_t WS_WO0 = WS_WV1 + 8 * MiB;
constexpr size_t WS_WO1 = WS_WO0 + 8 * MiB;
constexpr size_t WS_WQ0 = WS_WO1 + 8 * MiB;
constexpr size_t WS_WQ1 = WS_WQ0 + 8 * MiB;
constexpr size_t WS_SK = WS_WQ1 + 8 * MiB;
constexpr size_t WS_WFF = WS_SK + 131072;
constexpr size_t WS_MOD = WS_WFF + 65536;
constexpr size_t WS_LOGF = WS_MOD + 786432;
constexpr size_t WS_FCUM = WS_LOGF + 524288;
constexpr size_t WS_MISC = WS_FCUM + 524288;
constexpr size_t WS_H = WS_MISC + 65536;
constexpr size_t WS_QK = WS_H + 64 * MiB;
constexpr size_t WS_VT = WS_QK + 128 * MiB;
constexpr size_t WS_ATT = WS_VT + 64 * MiB;
constexpr size_t WS_SC = WS_ATT + 64 * MiB;
constexpr size_t WS_BAR = WS_SC + 128 * MiB;
constexpr size_t WS_END = WS_BAR + 65536;

struct Params {
  const float* x; const float* c; const float* rel_bias; const float* norm_gain; const float* w_ada; const float* b_ada;
  const float* even_w_in; const float* even_b_forget; const float* even_fox_qk_gain; const float* even_diff_qk_gain;
  const float* even_diff_lambda; const float* even_diff_subln_gain; const float* even_w_out;
  const float* odd_w_qkv; const float* odd_qk_gain; const float* odd_w_out;
  const float* peer_w_query; const float* peer_sub_keys; const float* peer_u; const float* peer_v;
  float* out; char* ws;
};

DI unsigned pack_bf2(float a, float b) { f2_t v = {a, b}; return __builtin_bit_cast(unsigned, __builtin_convertvector(v, bf2_t)); }
DI bf16_t f2bf(float a) { return (bf16_t)(pack_bf2(a, 0.f) & 0xffffu); }
DI float bf_lo(unsigned u) { return __uint_as_float(u << 16); }
DI float bf_hi(unsigned u) { return __uint_as_float(u & 0xffff0000u); }
DI int TID() { int t = threadIdx.x; asm volatile("" : "+v"(t)); return t; }
DI int crow(int reg, int h) { return (reg & 3) + 8 * (reg >> 2) + 4 * h; }
DI float wave_sum(float v) {
#pragma unroll
  for (int o = 32; o >= 1; o >>= 1) v += __shfl_xor(v, o);
  return v;
}
DI float wave_max(float v) {
#pragma unroll
  for (int o = 32; o >= 1; o >>= 1) v = fmaxf(v, __shfl_xor(v, o));
  return v;
}

DI void transpose_tile(const float* __restrict__ src, int ld, int c0, int k0, bf16_t* __restrict__ dst_row0, char* smem) {
  float* tile = (float*)smem;
  const int tid = TID();
  const int ty = tid >> 4, tx = tid & 15;
#pragma unroll
  for (int i = 0; i < 4; ++i) {
    const int k = ty + 16 * i;
    const float4 v = *(const float4*)(src + (size_t)(k0 + k) * ld + c0 + 4 * tx);
    float* t = tile + k * 65 + 4 * tx;
    t[0] = v.x; t[1] = v.y; t[2] = v.z; t[3] = v.w;
  }
  __syncthreads();
  const int cc = tid >> 2, kc = (tid & 3) * 16;
  unsigned pk[8];
#pragma unroll
  for (int j = 0; j < 8; ++j) pk[j] = pack_bf2(tile[(kc + 2 * j) * 65 + cc], tile[(kc + 2 * j + 1) * 65 + cc]);
  uint4* d = (uint4*)(dst_row0 + (size_t)cc * 2048 + k0 + kc);
  d[0] = make_uint4(pk[0], pk[1], pk[2], pk[3]);
  d[1] = make_uint4(pk[4], pk[5], pk[6], pk[7]);
  __syncthreads();
}

DI void phase_prep(const Params& p, char* smem) {
  const int tid = TID(), bid = blockIdx.x, G = gridDim.x;
  char* ws = p.ws;
  {
    float* cond = (float*)smem;
    bool have_cond = false;
    for (int item = bid; item < 384; item += G) {
      if (!have_cond) {
        for (int e = tid; e < NB_ * D_; e += NTHREADS) {
          const int b = e >> 11, d = e & 2047;
          const float v = p.c[e];
          cond[d * 8 + b] = v / (1.f + __expf(-v));
        }
        have_cond = true;
        __syncthreads();
      }
      const int i = item / 192, n = (item % 192) * 64 + (tid & 63);
      const int w = tid >> 6;
      const float* wp = p.w_ada + (size_t)i * D_ * 12288 + n;
      float acc[8];
#pragma unroll
      for (int b = 0; b < 8; ++b) acc[b] = 0.f;
#pragma unroll 8
      for (int d = w; d < D_; d += 4) {
        const float wv = wp[(size_t)d * 12288];
        const float4 c0 = *(const float4*)(cond + d * 8), c1 = *(const float4*)(cond + d * 8 + 4);
        acc[0] += c0.x * wv; acc[1] += c0.y * wv; acc[2] += c0.z * wv; acc[3] += c0.w * wv;
        acc[4] += c1.x * wv; acc[5] += c1.y * wv; acc[6] += c1.z * wv; acc[7] += c1.w * wv;
      }
      float* red = (float*)(smem + 65536);
#pragma unroll
      for (int b = 0; b < 8; ++b) red[(w * 64 + (tid & 63)) * 8 + b] = acc[b];
      __syncthreads();
      if (tid < 64) {
        float* mod = (float*)(ws + WS_MOD);
#pragma unroll
        for (int b = 0; b < 8; ++b) {
          const float s = red[(0 * 64 + tid) * 8 + b] + red[(1 * 64 + tid) * 8 + b] + red[(2 * 64 + tid) * 8 + b] + red[(3 * 64 + tid) * 8 + b];
          mod[((size_t)i * 8 + b) * 12288 + n] = s + p.b_ada[i * 12288 + n];
        }
      }
      __syncthreads();
    }
    __syncthreads();
  }
  {
    bf16_t* wqk0 = (bf16_t*)(ws + WS_WQK0); bf16_t* wv0 = (bf16_t*)(ws + WS_WV0);
    bf16_t* wqk1 = (bf16_t*)(ws + WS_WQK1); bf16_t* wv1 = (bf16_t*)(ws + WS_WV1);
    for (int item = bid; item < 320 * 32; item += G) {
      const int ct = item >> 5, kt = item & 31;
      const float* src; int ld, c0; bf16_t* dst;
      if (ct < 96) {
        const int seg = ct >> 4, cl = (ct & 15) * 64;
        src = p.even_w_in; ld = 6152;
        c0 = (seg < 3 ? seg * 1024 : 3080 + (seg - 3) * 1024) + cl;
        if (seg == 0) dst = wqk0 + (size_t)cl * 2048;
        else if (seg == 1) dst = wqk0 + (size_t)(1024 + cl) * 2048;
        else if (seg == 2) dst = wv0 + (size_t)cl * 2048;
        else if (seg == 3) dst = wqk0 + (size_t)(2048 + cl) * 2048;
        else if (seg == 4) dst = wqk0 + (size_t)(3072 + cl) * 2048;
        else dst = wv0 + (size_t)(1024 + cl) * 2048;
      } else if (ct < 192) {
        const int cl = (ct - 96) * 64;
        src = p.odd_w_qkv; ld = 6144; c0 = cl;
        dst = cl < 4096 ? wqk1 + (size_t)cl * 2048 : wv1 + (size_t)(cl - 4096) * 2048;
      } else {
        const int mi = (ct - 192) >> 5, cl = ((ct - 192) & 31) * 64;
        ld = 2048; c0 = cl;
        if (mi == 0) { src = p.even_w_out; dst = (bf16_t*)(ws + WS_WO0); }
        else if (mi == 1) { src = p.odd_w_out; dst = (bf16_t*)(ws + WS_WO1); }
        else if (mi == 2) { src = p.peer_w_query; dst = (bf16_t*)(ws + WS_WQ0); }
        else { src = p.peer_w_query + (size_t)2048 * 2048; dst = (bf16_t*)(ws + WS_WQ1); }
        dst += (size_t)cl * 2048;
      }
      transpose_tile(src, ld, c0, kt * 64, dst, smem);
    }
  }
  {
    const int lane = tid & 63;
    const int gw = __builtin_amdgcn_readfirstlane((bid * NTHREADS + tid) >> 6), nw = (G * NTHREADS) >> 6;
    float* scl = (float*)(ws + WS_PEERV);
    for (int row = gw; row < 4 * NEXP; row += nw) {
      const int tab = row >> 15, rr = row & 32767;
      const float* src = (tab ? p.peer_v : p.peer_u) + (size_t)rr * D_;
      unsigned char* dst = (unsigned char*)(ws + (tab ? WS_PEERV8 : WS_PEERU)) + (size_t)rr * D_;
      float4 v[8];
      float am = 0.f;
#pragma unroll
      for (int i = 0; i < 2; ++i)
#pragma unroll
        for (int j = 0; j < 4; ++j) {
          v[4 * i + j] = *(const float4*)(src + lane * 16 + 1024 * i + 4 * j);
          am = fmaxf(am, fmaxf(fmaxf(fabsf(v[4 * i + j].x), fabsf(v[4 * i + j].y)), fmaxf(fabsf(v[4 * i + j].z), fabsf(v[4 * i + j].w))));
        }
      am = wave_max(am);
      const float sc = am > 0.f ? 432.f / am : 1.f;
      if (lane == 0) scl[row] = am > 0.f ? am / 432.f : 1.f;
#pragma unroll
      for (int i = 0; i < 2; ++i) {
        unsigned w[4];
#pragma unroll
        for (int j = 0; j < 4; ++j) {
          int d = __builtin_amdgcn_cvt_pk_fp8_f32(v[4 * i + j].x * sc, v[4 * i + j].y * sc, 0, false);
          d = __builtin_amdgcn_cvt_pk_fp8_f32(v[4 * i + j].z * sc, v[4 * i + j].w * sc, d, true);
          w[j] = (unsigned)d;
        }
        *(uint4*)(dst + lane * 16 + 1024 * i) = make_uint4(w[0], w[1], w[2], w[3]);
      }
    }
    for (int item = bid; item < 32; item += G) {
      const size_t off = (size_t)item * 2048;
      const float4 a = *(const float4*)(p.peer_sub_keys + off + tid * 8), b = *(const float4*)(p.peer_sub_keys + off + tid * 8 + 4);
      *(uint4*)((bf16_t*)(ws + WS_SK) + off + tid * 8) = make_uint4(pack_bf2(a.x, a.y), pack_bf2(a.z, a.w), pack_bf2(b.x, b.y), pack_bf2(b.z, b.w));
    }
  }
  if (bid == G - 1) {
    float* wff = (float*)(ws + WS_WFF);
    for (int e = tid; e < 2048 * 8; e += NTHREADS) wff[e] = p.even_w_in[(size_t)(e >> 3) * 6152 + 3072 + (e & 7)];
    if (tid < 64) {
      const float* l = p.even_diff_lambda;
      float s1 = l[tid] * l[128 + tid] + l[64 + tid] * l[128 + 64 + tid];
      float s2 = l[256 + tid] * l[384 + tid] + l[256 + 64 + tid] * l[384 + 64 + tid];
      s1 = wave_sum(s1); s2 = wave_sum(s2);
      if (tid == 0) ((float*)(ws + WS_MISC))[0] = expf(s1) - expf(s2) + 0.2f;
    }
  }
}

template <bool FF>
DI void phase_norm(const Params& p, const float* __restrict__ xin, const float* __restrict__ gain,
                   const float* __restrict__ sh, const float* __restrict__ sc  ) {
  const int lane = TID() & 63;
  const int gw = __builtin_amdgcn_readfirstlane((blockIdx.x * NTHREADS + TID()) >> 6), nw = (gridDim.x * NTHREADS) >> 6;
  bf16_t* H = (bf16_t*)(p.ws + WS_H);
  for (int t = gw; t < T_; t += nw) {
    const int b = t >> 11;
    const float* xr = xin + (size_t)t * D_;
    float4 v[8];
    float ss = 0.f;
#pragma unroll
    for (int i = 0; i < 8; ++i) { v[i] = *(const float4*)(xr + lane * 4 + 256 * i); ss += v[i].x * v[i].x + v[i].y * v[i].y + v[i].z * v[i].z + v[i].w * v[i].w; }
    ss = wave_sum(ss);
    const float rstd = rsqrtf(ss * (1.f / 2048.f) + 1e-6f);
    float ff[8];
    if (FF) {
#pragma unroll
      for (int j = 0; j < 8; ++j) ff[j] = 0.f;
    }
#pragma unroll
    for (int i = 0; i < 8; ++i) {
      const int c = lane * 4 + 256 * i;
      const float4 g = *(const float4*)(gain + c);
      const float4 s1 = *(const float4*)(sc + (size_t)b * 12288 + c);
      const float4 s0 = *(const float4*)(sh + (size_t)b * 12288 + c);
      float4 h;
      h.x = v[i].x * rstd * g.x * (1.f + s1.x) + s0.x;
      h.y = v[i].y * rstd * g.y * (1.f + s1.y) + s0.y;
      h.z = v[i].z * rstd * g.z * (1.f + s1.z) + s0.z;
      h.w = v[i].w * rstd * g.w * (1.f + s1.w) + s0.w;
      *(uint2*)(H + (size_t)t * D_ + c) = make_uint2(pack_bf2(h.x, h.y), pack_bf2(h.z, h.w));
      if (FF) {
        const float* wff = (const float*)(p.ws + WS_WFF) + c * 8;
        const float hv[4] = {h.x, h.y, h.z, h.w};
#pragma unroll
        for (int e = 0; e < 4; ++e) {
          const float4 w0 = *(const float4*)(wff + e * 8), w1 = *(const float4*)(wff + e * 8 + 4);
          ff[0] += hv[e] * w0.x; ff[1] += hv[e] * w0.y; ff[2] += hv[e] * w0.z; ff[3] += hv[e] * w0.w;
          ff[4] += hv[e] * w1.x; ff[5] += hv[e] * w1.y; ff[6] += hv[e] * w1.z; ff[7] += hv[e] * w1.w;
        }
      }
    }
    if (FF) {
#pragma unroll
      for (int j = 0; j < 8; ++j) ff[j] = wave_sum(ff[j]);
      if (lane < 8) {
        float z = ff[0];
#pragma unroll
        for (int j = 1; j < 8; ++j) z = (lane == j) ? ff[j] : z;
        z += p.even_b_forget[lane];
        const float lf = fminf(z, 0.f) - log1pf(__expf(-fabsf(z)));
        ((float*)(p.ws + WS_LOGF))[(size_t)t * 8 + lane] = lf;
      }
    }
  }
}

DI void fox_cumsum(const Params& p) {
  const int lane = TID() & 63;
  const int gw = __builtin_amdgcn_readfirstlane((blockIdx.x * NTHREADS + TID()) >> 6), nw = (gridDim.x * NTHREADS) >> 6;
  const float* lf = (const float*)(p.ws + WS_LOGF);
  float* fc = (float*)(p.ws + WS_FCUM);
  for (int it = gw; it < 64; it += nw) {
    const int b = it >> 3, hh = it & 7;
    float v[32];
    float tot = 0.f;
#pragma unroll
    for (int j = 0; j < 32; ++j) { tot += lf[(size_t)(b * S_ + lane * 32 + j) * 8 + hh]; v[j] = tot; }
    float inc = tot;
#pragma unroll
    for (int o = 1; o < 64; o <<= 1) { const float n = __shfl_up(inc, o); if (lane >= o) inc += n; }
    const float base = inc - tot;
#pragma unroll
    for (int j = 0; j < 32; ++j) fc[(size_t)it * S_ + lane * 32 + j] = v[j] + base;
  }
}

DI void gemm_tile_compute(const bf16_t* __restrict__ A, int lda, const bf16_t* __restrict__ B, int ldb, int K,
                          char* smem, f32x16 (&acc)[2][2]) {
  const int tid = TID(), lane = tid & 63, wave = __builtin_amdgcn_readfirstlane(tid >> 6);
  const int r = lane & 31, h = lane >> 5;
  const int wm = wave >> 1, wn = wave & 1;
  const int srow = tid >> 3, sc = tid & 7;
  const bf16_t* ga = A + (size_t)srow * lda + sc * 8;
  const bf16_t* gb = B + (size_t)srow * ldb + sc * 8;
  uint4 ra[4], rb[4];
#pragma unroll
  for (int i = 0; i < 4; ++i) {
    ra[i] = *(const uint4*)(ga + (size_t)(32 * i) * lda);
    rb[i] = *(const uint4*)(gb + (size_t)(32 * i) * ldb);
  }
  const int woff = srow * 128 + ((sc ^ ((srow >> 1) & 7)) << 4);
  const int rsw = (r >> 1) & 7;
  const int aoff = (wm * 64 + r) * 128, boff = 16384 + (wn * 64 + r) * 128;
#pragma unroll
  for (int i = 0; i < 2; ++i)
#pragma unroll
    for (int j = 0; j < 2; ++j)
#pragma unroll
      for (int e = 0; e < 16; ++e) acc[i][j][e] = 0.f;
#pragma unroll
  for (int i = 0; i < 4; ++i) {
    *(uint4*)(smem + woff + i * 4096) = ra[i];
    *(uint4*)(smem + 16384 + woff + i * 4096) = rb[i];
  }
  __syncthreads();
  const int KT = K >> 6;
  for (int kt = 0; kt < KT; ++kt) {
    char* st = smem + (kt & 1) * 32768;
    if (kt + 1 < KT) {
#pragma unroll
      for (int i = 0; i < 4; ++i) {
        ra[i] = *(const uint4*)(ga + (size_t)(32 * i) * lda + (kt + 1) * 64);
        rb[i] = *(const uint4*)(gb + (size_t)(32 * i) * ldb + (kt + 1) * 64);
      }
    }
#pragma unroll
    for (int s = 0; s < 4; ++s) {
      const int co = ((2 * s + h) ^ rsw) << 4;
      bf16x8 af[2], bfr[2];
      af[0] = *(const bf16x8*)(st + aoff + co);
      af[1] = *(const bf16x8*)(st + aoff + 32 * 128 + co);
      bfr[0] = *(const bf16x8*)(st + boff + co);
      bfr[1] = *(const bf16x8*)(st + boff + 32 * 128 + co);
#pragma unroll
      for (int i = 0; i < 2; ++i)
#pragma unroll
        for (int j = 0; j < 2; ++j) acc[i][j] = MFMA32(af[i], bfr[j], acc[i][j]);
    }
    if (kt + 1 < KT) {
      char* sn = smem + ((kt + 1) & 1) * 32768;
#pragma unroll
      for (int i = 0; i < 4; ++i) {
        *(uint4*)(sn + woff + i * 4096) = ra[i];
        *(uint4*)(sn + 16384 + woff + i * 4096) = rb[i];
      }
    }
    __syncthreads();
  }
}

enum { EPI_BF16 = 0, EPI_NORM_BF16 = 1, EPI_RES_F32 = 2, EPI_F32 = 3 };
struct EpiArgs {
  void* out; int ldc;
  const float* gainA; const float* gainB; int gshift;
  const float* xin; const float* gate;
};

template <int EPI>
DI void gemm_epilogue(f32x16 (&acc)[2][2], int m0, int n0, int tn, const EpiArgs& ea, char* smem) {
  const int tid = TID(), lane = tid & 63, wave = __builtin_amdgcn_readfirstlane(tid >> 6);
  const int r = lane & 31, h = lane >> 5;
  const int wm = wave >> 1, wn = wave & 1;
  if (EPI == EPI_NORM_BF16) {
    float* red = (float*)smem;
    float ss[2][16];
#pragma unroll
    for (int i = 0; i < 2; ++i)
#pragma unroll
      for (int e = 0; e < 16; ++e) {
        float v = acc[i][0][e] * acc[i][0][e] + acc[i][1][e] * acc[i][1][e];
#pragma unroll
        for (int o = 16; o >= 1; o >>= 1) v += __shfl_xor(v, o);
        ss[i][e] = v;
      }
    if (r == 0) {
#pragma unroll
      for (int i = 0; i < 2; ++i)
#pragma unroll
        for (int e = 0; e < 16; ++e) red[wn * 128 + wm * 64 + i * 32 + crow(e, h)] = ss[i][e];
    }
    __syncthreads();
    const int grp = tn >> ea.gshift;
    const float* gain = ((grp & 2) ? ea.gainB : ea.gainA) + (grp & 1) * 128;
    bf16_t* out = (bf16_t*)ea.out;
#pragma unroll
    for (int i = 0; i < 2; ++i)
#pragma unroll
      for (int e = 0; e < 16; ++e) {
        const int rl = wm * 64 + i * 32 + crow(e, h);
        const float rstd = rsqrtf((red[rl] + red[128 + rl]) * (1.f / 128.f) + 1e-6f);
#pragma unroll
        for (int j = 0; j < 2; ++j) {
          const int cl = wn * 64 + j * 32 + r;
          out[(size_t)(m0 + rl) * ea.ldc + n0 + cl] = f2bf(acc[i][j][e] * rstd * gain[cl]);
        }
      }
    __syncthreads();
  } else {
#pragma unroll
    for (int i = 0; i < 2; ++i)
#pragma unroll
      for (int e = 0; e < 16; ++e) {
        const int row = m0 + wm * 64 + i * 32 + crow(e, h);
#pragma unroll
        for (int j = 0; j < 2; ++j) {
          const int col = n0 + wn * 64 + j * 32 + r;
          const float v = acc[i][j][e];
          if (EPI == EPI_BF16) ((bf16_t*)ea.out)[(size_t)row * ea.ldc + col] = f2bf(v);
          else if (EPI == EPI_F32) ((float*)ea.out)[(size_t)row * ea.ldc + col] = v;
          else {
            const float g = ea.gate[(size_t)(row >> 11) * 12288 + col];
            ((float*)ea.out)[(size_t)row * ea.ldc + col] = ea.xin[(size_t)row * ea.ldc + col] + g * v;
          }
        }
      }
  }
}

template <int EPI>
DI void gemm_phase(const bf16_t* A, int lda, const bf16_t* B, int ldb, int K, int mt, int nt, const EpiArgs& ea, char* smem) {
  const int bid = blockIdx.x, G = gridDim.x;
  const int xcd = bid & 7, slot = bid >> 3, nslots = G >> 3;
  const int nsn = nt >> 3, nsup = (mt >> 3) * nsn;
  const int cnt = (nsup - xcd + 7) >> 3;
  for (int j = slot; j < cnt * 64; j += nslots) {
    const int sup = xcd + 8 * (j >> 6), within = j & 63;
    const int sm = sup / nsn, sn = sup - sm * nsn;
    const int tm = sm * 8 + (within >> 3), tn = sn * 8 + (within & 7);
    f32x16 acc[2][2];
    gemm_tile_compute(A + (size_t)tm * 128 * lda, lda, B + (size_t)tn * 128 * ldb, ldb, K, smem, acc);
    gemm_epilogue<EPI>(acc, tm * 128, tn * 128, tn, ea, smem);
  }
}

template <int MODE>
DI void attn_wave(const bf16_t* __restrict__ Qp, int ldq, const bf16_t* __restrict__ Kp, int ldk,
                  const bf16_t* __restrict__ Vt, int ldv, const float* __restrict__ kbias, const float* tbl,
                  int q0, f32x16 (&o)[4], float& l_out) {
  const int lane = TID() & 63, r = lane & 31, h = lane >> 5;
  const float scale2 = 0.08838834764831845f * LOG2E;
  bf16x8 qf[8];
#pragma unroll
  for (int s = 0; s < 8; ++s) qf[s] = *(const bf16x8*)(Qp + (size_t)(q0 + r) * ldq + 16 * s + 8 * h);
#pragma unroll
  for (int dt = 0; dt < 4; ++dt)
#pragma unroll
    for (int e = 0; e < 16; ++e) o[dt][e] = 0.f;
  float m = -1e30f, l = 0.f;
  const int nkt = (q0 >> 5) + 1;
  for (int kt = 0; kt < nkt; ++kt) {
    const int k0 = kt << 5;
    bf16x8 kf[8];
#pragma unroll
    for (int s = 0; s < 8; ++s) kf[s] = *(const bf16x8*)(Kp + (size_t)(k0 + r) * ldk + 16 * s + 8 * h);
    bf16x4 vf[4][2][2];
#pragma unroll
    for (int dt = 0; dt < 4; ++dt)
#pragma unroll
      for (int s = 0; s < 2; ++s) {
        const bf16_t* vp = Vt + (size_t)(32 * dt + r) * ldv + k0 + 16 * s + 4 * h;
        vf[dt][s][0] = *(const bf16x4*)(vp);
        vf[dt][s][1] = *(const bf16x4*)(vp + 8);
      }
    f32x16 sa;
#pragma unroll
    for (int e = 0; e < 16; ++e) sa[e] = 0.f;
#pragma unroll
    for (int s = 0; s < 8; ++s) sa = MFMA32(kf[s], qf[s], sa);
    float v[16];
    if (MODE == 0) {
#pragma unroll
      for (int c = 0; c < 4; ++c) {
        const float4 kb = *(const float4*)(kbias + k0 + 8 * c + 4 * h);
        v[4 * c + 0] = sa[4 * c + 0] * scale2 - kb.x * LOG2E;
        v[4 * c + 1] = sa[4 * c + 1] * scale2 - kb.y * LOG2E;
        v[4 * c + 2] = sa[4 * c + 2] * scale2 - kb.z * LOG2E;
        v[4 * c + 3] = sa[4 * c + 3] * scale2 - kb.w * LOG2E;
      }
      if (kt == nkt - 1) {
#pragma unroll
        for (int e = 0; e < 16; ++e) if (crow(e, h) > r) v[e] = -INFINITY;
      }
    } else {
      const float* tp = tbl + (q0 - k0) + r + 32 - 4 * h - 27;
#pragma unroll
      for (int e = 0; e < 16; ++e) v[e] = sa[e] * scale2 + tp[27 - ((e & 3) + 8 * (e >> 2))];
    }
    float mx = v[0];
#pragma unroll
    for (int e = 1; e < 16; ++e) mx = fmaxf(mx, v[e]);
    mx = fmaxf(mx, __shfl_xor(mx, 32));
    const float mn = fmaxf(m, mx);
    const float alpha = exp2f(m - mn);
    m = mn;
    float ps = 0.f;
#pragma unroll
    for (int e = 0; e < 16; ++e) { v[e] = exp2f(v[e] - mn); ps += v[e]; }
    l = l * alpha + ps;
#pragma unroll
    for (int dt = 0; dt < 4; ++dt)
#pragma unroll
      for (int e = 0; e < 16; ++e) o[dt][e] *= alpha;
    bf16x8 pb[2];
#pragma unroll
    for (int s = 0; s < 2; ++s) {
      const uint4 u = make_uint4(pack_bf2(v[8 * s + 0], v[8 * s + 1]), pack_bf2(v[8 * s + 2], v[8 * s + 3]),
                                 pack_bf2(v[8 * s + 4], v[8 * s + 5]), pack_bf2(v[8 * s + 6], v[8 * s + 7]));
      pb[s] = __builtin_bit_cast(bf16x8, u);
    }
#pragma unroll
    for (int dt = 0; dt < 4; ++dt)
#pragma unroll
      for (int s = 0; s < 2; ++s) {
        const bf16x8 va = __builtin_shufflevector(vf[dt][s][0], vf[dt][s][1], 0, 1, 2, 3, 4, 5, 6, 7);
        o[dt] = MFMA32(va, pb[s], o[dt]);
      }
  }
  l_out = l + __shfl_xor(l, 32);
}

DI void attn_store_bf16(const f32x16 (&o)[4], float linv, bf16_t* __restrict__ out_row  , int ldo) {
  const int lane = TID() & 63, r = lane & 31, h = lane >> 5;
  bf16_t* op = out_row + (size_t)r * ldo + 4 * h;
#pragma unroll
  for (int dt = 0; dt < 4; ++dt)
#pragma unroll
    for (int c = 0; c < 4; ++c)
      *(uint2*)(op + 32 * dt + 8 * c) = make_uint2(pack_bf2(o[dt][4 * c] * linv, o[dt][4 * c + 1] * linv),
                                                    pack_bf2(o[dt][4 * c + 2] * linv, o[dt][4 * c + 3] * linv));
}

DI int t5_bucket(int n) {
  if (n < 16) return n;
  int lg = 16 + (int)(logf((float)n / 16.f) / 4.852030263919617f * 16.f);
  return lg < 31 ? lg : 31;
}

DI void phase_attn_even(const Params& p, char* smem) {
  const int tid = TID(), wave = __builtin_amdgcn_readfirstlane(tid >> 6), bid = blockIdx.x, G = gridDim.x;
  const bf16_t* QK = (const bf16_t*)(p.ws + WS_QK);
  const bf16_t* VT = (const bf16_t*)(p.ws + WS_VT);
  bf16_t* ATT = (bf16_t*)(p.ws + WS_ATT);
  float* pieces = (float*)smem;
  float* tbl = (float*)(smem + 66048);
  const float lam = ((const float*)(p.ws + WS_MISC))[0];
  for (int item = bid; item < 3072; item += G) {
    const int g = item / 192; int rem = item - g * 192;
    const int qb = 15 - g;
    if (rem < 64) {
      const int b = rem >> 3, hh = rem & 7;
      const int q0 = qb * 128 + 32 * wave;
      const bf16_t* Qp = QK + (size_t)b * S_ * 4096 + hh * 128;
      f32x16 o[4]; float l;
      attn_wave<0>(Qp, 4096, Qp + 1024, 4096, VT + (size_t)(hh * 128) * T_ + b * S_, T_,
                   (const float*)(p.ws + WS_FCUM) + (size_t)(b * 8 + hh) * S_, nullptr, q0, o, l);
      attn_store_bf16(o, 1.f / l, ATT + (size_t)(b * S_ + q0) * D_ + hh * 128, D_);
    } else {
      rem -= 64;
      const int qt = 4 * qb + 3 - (rem >> 5);
      const int bh = rem & 31, b = bh >> 2, hh = bh & 3;
      const int q0 = qt * 32;
      for (int e = tid; e < 2080; e += NTHREADS) {
        const int dist = e - 32;
        tbl[e] = dist >= 0 ? p.rel_bias[t5_bucket(dist) * 16 + hh] * LOG2E : -INFINITY;
      }
      __syncthreads();
      const int mm = wave >> 1, half = wave & 1;
      const bf16_t* Qp = QK + (size_t)b * S_ * 4096 + 2048 + hh * 256 + mm * 128;
      f32x16 o[4]; float l;
      attn_wave<1>(Qp, 4096, Qp + 1024, 4096, VT + (size_t)(1024 + hh * 256 + half * 128) * T_ + b * S_, T_,
                   nullptr, tbl, q0, o, l);
      {
        const int lane = tid & 63, r = lane & 31, h = lane >> 5;
        const float linv = 1.f / l;
        float* pw = pieces + (wave * 32 + r) * 129;
#pragma unroll
        for (int dt = 0; dt < 4; ++dt)
#pragma unroll
          for (int e = 0; e < 16; ++e) pw[32 * dt + crow(e, h)] = o[dt][e] * linv;
      }
      __syncthreads();
      {
        const int q = tid >> 3, d0 = (tid & 7) * 32;
        const int half2 = d0 >> 7, dl = d0 & 127;
        const float* p0 = pieces + ((0 * 2 + half2) * 32 + q) * 129 + dl;
        const float* p1 = pieces + ((1 * 2 + half2) * 32 + q) * 129 + dl;
        float val[32]; float ss = 0.f;
#pragma unroll
        for (int j = 0; j < 32; ++j) { val[j] = p0[j] - lam * p1[j]; ss += val[j] * val[j]; }
        ss += __shfl_xor(ss, 1); ss += __shfl_xor(ss, 2); ss += __shfl_xor(ss, 4);
        const float rstd = rsqrtf(ss * (1.f / 256.f) + 1e-6f) * 0.8f;
        const float* sg = p.even_diff_subln_gain + d0;
        bf16_t* op = ATT + (size_t)(b * S_ + q0 + q) * D_ + 1024 + hh * 256 + d0;
#pragma unroll
        for (int j = 0; j < 32; j += 8) {
          *(uint4*)(op + j) = make_uint4(pack_bf2(val[j] * rstd * sg[j], val[j + 1] * rstd * sg[j + 1]),
                                         pack_bf2(val[j + 2] * rstd * sg[j + 2], val[j + 3] * rstd * sg[j + 3]),
                                         pack_bf2(val[j + 4] * rstd * sg[j + 4], val[j + 5] * rstd * sg[j + 5]),
                                         pack_bf2(val[j + 6] * rstd * sg[j + 6], val[j + 7] * rstd * sg[j + 7]));
        }
      }
      __syncthreads();
    }
  }
}

DI void phase_attn_odd(const Params& p, char* smem) {
  const int tid = TID(), wave = __builtin_amdgcn_readfirstlane(tid >> 6), bid = blockIdx.x, G = gridDim.x;
  const bf16_t* QK = (const bf16_t*)(p.ws + WS_QK);
  const bf16_t* VT = (const bf16_t*)(p.ws + WS_VT);
  bf16_t* ATT = (bf16_t*)(p.ws + WS_ATT);
  float* tbl = (float*)(smem + 66048);
  int cur_head = -1;
  for (int item = bid; item < 2048; item += G) {
    const int g = item >> 7, rem = item & 127;
    const int qb = 15 - g, b = rem >> 4, hd = rem & 15;
    if (hd != cur_head) {
      __syncthreads();
      for (int e = tid; e < 2080; e += NTHREADS) {
        const int dist = e - 32;
        float val = -INFINITY;
        if (dist >= 0) {
          int cnt = 0;
          if (dist <= 128) cnt += 1;
          if (dist <= 512 && (dist & 3) == 0) cnt += 1;
          if ((dist & 15) == 0) cnt += 1;
          if (cnt > 0) val = (p.rel_bias[t5_bucket(dist) * 16 + hd] + __logf((float)cnt)) * LOG2E;
        }
        tbl[e] = val;
      }
      cur_head = hd;
      __syncthreads();
    }
    const int q0 = qb * 128 + 32 * wave;
    const bf16_t* Qp = QK + (size_t)b * S_ * 4096 + hd * 128;
    f32x16 o[4]; float l;
    attn_wave<1>(Qp, 4096, Qp + 2048, 4096, VT + (size_t)(hd * 128) * T_ + b * S_, T_, nullptr, tbl, q0, o, l);
    attn_store_bf16(o, 1.f / l, ATT + (size_t)(b * S_ + q0) * D_ + hd * 128, D_);
  }
}

DI unsigned fkey(float f) { const unsigned u = __float_as_uint(f); return (u & 0x80000000u) ? ~u : (u | 0x80000000u); }
DI int popc64(unsigned long long m) { return __popcll(m); }
DI int mbcnt(unsigned long long m) { return __builtin_amdgcn_mbcnt_hi((unsigned)(m >> 32), __builtin_amdgcn_mbcnt_lo((unsigned)m, 0)); }

template <int NV>
DI void select16(const unsigned (&key)[NV], bool (&sel)[NV], int (&pos)[NV]) {
  unsigned thr = 0;
#pragma unroll 1
  for (int bit = 31; bit >= 0; --bit) {
    const unsigned cand = thr | (1u << bit);
    int cnt = 0;
#pragma unroll
    for (int a = 0; a < NV; ++a) cnt += popc64(__ballot(key[a] >= cand));
    if (cnt >= 16) thr = cand;
  }
  int cgt = 0;
#pragma unroll
  for (int a = 0; a < NV; ++a) cgt += popc64(__ballot(key[a] > thr));
  const int need = 16 - cgt;
  int eqbase = 0, sbase = 0;
#pragma unroll
  for (int a = 0; a < NV; ++a) {
    const bool eq = key[a] == thr;
    const unsigned long long em = __ballot(eq);
    const bool s = (key[a] > thr) || (eq && (eqbase + mbcnt(em)) < need);
    eqbase += popc64(em);
    const unsigned long long sm = __ballot(s);
    sel[a] = s; pos[a] = sbase + mbcnt(sm);
    sbase += popc64(sm);
  }
}

DI float gelu_erf(float x) { return 0.5f * x * (1.f + erff(x * 0.7071067811865476f)); }

DI void phase_peer(const Params& p, int layer, const float* __restrict__ gate2  , char* smem) {
  const int tid = TID(), lane = tid & 63, wave = __builtin_amdgcn_readfirstlane(tid >> 6);
  const int gw = __builtin_amdgcn_readfirstlane((blockIdx.x * NTHREADS + tid) >> 6), nw = (gridDim.x * NTHREADS) >> 6;
  float* wl_s = (float*)(smem + wave * 2048);
  int* wl_i = (int*)(smem + wave * 2048 + 128);
  int* ex_i = (int*)(smem + wave * 2048 + 256);
  float* ex_g = (float*)(smem + wave * 2048 + 768);
  const float* SC = (const float*)(p.ws + WS_SC);
  const bf16_t* H = (const bf16_t*)(p.ws + WS_H);
  const unsigned char* PU = (const unsigned char*)(p.ws + WS_PEERU) + (size_t)layer * NEXP * D_;
  const unsigned char* PV = (const unsigned char*)(p.ws + WS_PEERV8) + (size_t)layer * NEXP * D_;
  const float* USC = (const float*)(p.ws + WS_PEERV) + (size_t)layer * NEXP;
  const float* VSC = (const float*)(p.ws + WS_PEERV) + (size_t)(2 + layer) * NEXP;
  for (int t = gw; t < T_; t += nw) {
#pragma unroll 1
    for (int hh = 0; hh < 8; ++hh) {
      const float* sr = SC + ((size_t)t * 8 + hh) * 256;
      float sv[4];
#pragma unroll
      for (int a = 0; a < 4; ++a) sv[a] = sr[a * 64 + lane];
#pragma unroll
      for (int pp = 0; pp < 2; ++pp) {
        unsigned key[2] = {fkey(sv[2 * pp]), fkey(sv[2 * pp + 1])};
        bool sel[2]; int pos[2];
        select16<2>(key, sel, pos);
#pragma unroll
        for (int a = 0; a < 2; ++a) if (sel[a]) { wl_s[pp * 16 + pos[a]] = sv[2 * pp + a]; wl_i[pp * 16 + pos[a]] = a * 64 + lane; }
      }
      const float sa = wl_s[lane >> 2];
      const int ia = wl_i[lane >> 2];
      float cs[4]; int ci[4]; unsigned key[4];
#pragma unroll
      for (int j = 0; j < 4; ++j) {
        cs[j] = sa + wl_s[16 + (lane & 3) * 4 + j];
        ci[j] = ia * 128 + wl_i[16 + (lane & 3) * 4 + j];
        key[j] = fkey(cs[j]);
      }
      bool sel[4]; int pos[4];
      select16<4>(key, sel, pos);
      float mx = -INFINITY;
#pragma unroll
      for (int j = 0; j < 4; ++j) if (sel[j]) mx = fmaxf(mx, cs[j]);
      mx = wave_max(mx);
      float e[4]; float es = 0.f;
#pragma unroll
      for (int j = 0; j < 4; ++j) { e[j] = sel[j] ? __expf(cs[j] - mx) : 0.f; es += e[j]; }
      es = wave_sum(es);
      const float inv = 1.f / es;
#pragma unroll
      for (int j = 0; j < 4; ++j) if (sel[j]) { ex_i[hh * 16 + pos[j]] = ci[j]; ex_g[hh * 16 + pos[j]] = e[j] * inv; }
    }
    float xf[32];
    {
      const bf16_t* hr = H + (size_t)t * D_ + lane * 16;
#pragma unroll
      for (int i = 0; i < 2; ++i)
#pragma unroll
        for (int hq = 0; hq < 2; ++hq) {
          const uint4 u = *(const uint4*)(hr + 1024 * i + 8 * hq);
          const unsigned w[4] = {u.x, u.y, u.z, u.w};
#pragma unroll
          for (int k = 0; k < 4; ++k) { xf[16 * i + 8 * hq + 2 * k] = bf_lo(w[k]); xf[16 * i + 8 * hq + 2 * k + 1] = bf_hi(w[k]); }
        }
    }
    float y[32];
#pragma unroll
    for (int j = 0; j < 32; ++j) y[j] = 0.f;
    uint4 ua[2][2], va[2][2], ub[2][2], vb[2][2];
    float sua[2], sva[2], sub_[2], svb[2];
#define PEER_LOAD(UR, VR, SU, SV, EB)                                                                   \
    _Pragma("unroll") for (int q = 0; q < 2; ++q) {                                                     \
      const int id = __builtin_amdgcn_readfirstlane(ex_i[(EB) + q]);                                   \
      const unsigned char* up = PU + (size_t)id * D_ + lane * 16;                                      \
      const unsigned char* vp = PV + (size_t)id * D_ + lane * 16;                                      \
      UR[q][0] = *(const uint4*)(up); UR[q][1] = *(const uint4*)(up + 1024);                           \
      VR[q][0] = *(const uint4*)(vp); VR[q][1] = *(const uint4*)(vp + 1024);                           \
      SU[q] = USC[id]; SV[q] = VSC[id];                                                                 \
    }
#define PEER_COMPUTE(UR, VR, SU, SV, EB)                                                                \
    {                                                                                                   \
      float dq[2];                                                                                      \
      _Pragma("unroll") for (int q = 0; q < 2; ++q) {                                                   \
        float a0 = 0.f, a1 = 0.f;                                                                       \
        _Pragma("unroll") for (int i = 0; i < 2; ++i) {                                                 \
          const unsigned w[4] = {UR[q][i].x, UR[q][i].y, UR[q][i].z, UR[q][i].w};                      \
          _Pragma("unroll") for (int k = 0; k < 4; ++k) {                                               \
            const f2_t lo = __builtin_amdgcn_cvt_pk_f32_fp8((int)w[k], false);                         \
            const f2_t hi = __builtin_amdgcn_cvt_pk_f32_fp8((int)w[k], true);                          \
            a0 += lo.x * xf[16 * i + 4 * k] + hi.x * xf[16 * i + 4 * k + 2];                            \
            a1 += lo.y * xf[16 * i + 4 * k + 1] + hi.y * xf[16 * i + 4 * k + 3];                        \
          }                                                                                             \
        }                                                                                               \
        dq[q] = a0 + a1;                                                                                \
      }                                                                                                 \
                            \
      const bool hb = lane >= 32;                                                                       \
      float kk = hb ? dq[1] : dq[0];                                                                    \
      const float ss = hb ? dq[0] : dq[1];                                                              \
      kk += __shfl_xor(ss, 32);                                                                         \
      kk += __shfl_xor(kk, 16); kk += __shfl_xor(kk, 8); kk += __shfl_xor(kk, 4); kk += __shfl_xor(kk, 2); kk += __shfl_xor(kk, 1); \
      const float cfl = (hb ? ex_g[(EB) + 1] : ex_g[(EB)]) * gelu_erf(kk * (hb ? SU[1] : SU[0])) * (hb ? SV[1] : SV[0]); \
      _Pragma("unroll") for (int q = 0; q < 2; ++q) {                                                   \
        const float cf = __builtin_bit_cast(float, __builtin_amdgcn_readlane(__builtin_bit_cast(int, cfl), 32 * q)); \
        _Pragma("unroll") for (int i = 0; i < 2; ++i) {                                                 \
          const unsigned w[4] = {VR[q][i].x, VR[q][i].y, VR[q][i].z, VR[q][i].w};                      \
          _Pragma("unroll") for (int k = 0; k < 4; ++k) {                                               \
            const f2_t lo = __builtin_amdgcn_cvt_pk_f32_fp8((int)w[k], false);                         \
            const f2_t hi = __builtin_amdgcn_cvt_pk_f32_fp8((int)w[k], true);                          \
            y[16 * i + 4 * k] += cf * lo.x; y[16 * i + 4 * k + 1] += cf * lo.y;                          \
            y[16 * i + 4 * k + 2] += cf * hi.x; y[16 * i + 4 * k + 3] += cf * hi.y;                      \
          }                                                                                             \
        }                                                                                               \
      }                                                                                                 \
    }
    PEER_LOAD(ua, va, sua, sva, 0)
#pragma unroll 1
    for (int eb = 0; eb < 128; eb += 4) {
      PEER_LOAD(ub, vb, sub_, svb, eb + 2)
      PEER_COMPUTE(ua, va, sua, sva, eb)
      if (eb + 4 < 128) { PEER_LOAD(ua, va, sua, sva, eb + 4) }
      PEER_COMPUTE(ub, vb, sub_, svb, eb + 2)
    }
#undef PEER_LOAD
#undef PEER_COMPUTE
    {
      const int b = t >> 11;
      float* orow = p.out + (size_t)t * D_ + lane * 16;
      const float* grow = gate2 + (size_t)b * 12288 + lane * 16;
#pragma unroll
      for (int i = 0; i < 2; ++i)
#pragma unroll
        for (int j = 0; j < 4; ++j) {
          float4 a0 = *(const float4*)(orow + 1024 * i + 4 * j);
          const float4 g0 = *(const float4*)(grow + 1024 * i + 4 * j);
          a0.x += g0.x * y[16 * i + 4 * j]; a0.y += g0.y * y[16 * i + 4 * j + 1];
          a0.z += g0.z * y[16 * i + 4 * j + 2]; a0.w += g0.w * y[16 * i + 4 * j + 3];
          *(float4*)(orow + 1024 * i + 4 * j) = a0;
        }
    }
  }
}

DI void phase_peer_scores(const Params& p, int layer, char* smem) {
  const bf16_t* QP = (const bf16_t*)(p.ws + WS_QK);
  const bf16_t* SK = (const bf16_t*)(p.ws + WS_SK) + (size_t)layer * 2 * 128 * 128;
  EpiArgs ea{}; ea.out = nullptr; ea.ldc = 256;
  for (int L = blockIdx.x; L < 2048; L += gridDim.x) {
    const int pp = L & 1, tm = L >> 1;
    f32x16 acc[2][2];
    gemm_tile_compute(QP + (size_t)tm * 128 * 256 + pp * 128, 256, SK + (size_t)pp * 128 * 128, 128, 128, smem, acc);
    ea.out = (float*)(p.ws + WS_SC) + pp * 128;
    gemm_epilogue<EPI_F32>(acc, tm * 128, 0, 0, ea, smem);
  }
}


#define XB_TMO      128
#define XB_XCNT(j)  (256  + 64 * (j))
#define XB_XSUB(j)  (1280 + 64 * (j))
#define XB_XGEN(j)  (2304 + 64 * (j))
#define XB_TOP      3328
#define XB_TOPGEN   3392
#define XCD_BAR_WORDS 3456
#define XB_SPIN_CAP (1u << 22)
#define LAS __attribute__((address_space(3)))
DI unsigned xb_ld(unsigned* p) { return __hip_atomic_load(p, __ATOMIC_RELAXED, __HIP_MEMORY_SCOPE_AGENT); }
DI unsigned xb_add(unsigned* p, unsigned v) { return __hip_atomic_fetch_add(p, v, __ATOMIC_RELAXED, __HIP_MEMORY_SCOPE_AGENT); }
DI unsigned xb_xcc_id() { return (unsigned)__builtin_amdgcn_s_getreg((3 << 11) | 20) & 0xFu; }
#define XB_SPIN(cond, bar) do { unsigned _sp = 0; while (cond) { __builtin_amdgcn_s_sleep(1); \
    if ((++_sp & 255u) == 0u) { if (xb_ld(&(bar)[XB_TMO])) break; if (_sp > XB_SPIN_CAP) { atomicAdd(&(bar)[XB_TMO], 1u); break; } } } } while (0)
struct XcdBarrier { unsigned* bar; unsigned x; volatile LAS unsigned* st; };
DI XcdBarrier xcd_barrier_post(unsigned* bar, volatile LAS unsigned* st) {
  XcdBarrier b; b.bar = bar; b.x = xb_xcc_id(); b.st = st;
  if (threadIdx.x == 0) (void)xb_add(&bar[XB_XCNT(b.x)], 1u);
  return b;
}
DI void xcd_barrier_complete(unsigned* bar, unsigned x, unsigned& nloc, unsigned& nx) {
  const unsigned G = gridDim.x * gridDim.y * gridDim.z;
  unsigned sum, cnt, mine, sp = 0u;
  for (;;) {
    sum = 0u; cnt = 0u; mine = 0u;
#pragma unroll
    for (unsigned j = 0; j < 16; ++j) { const unsigned c = xb_ld(&bar[XB_XCNT(j)]); sum += c; cnt += (c > 0u) ? 1u : 0u; mine = (j == x) ? c : mine; }
    if (sum == G) break;
    __builtin_amdgcn_s_sleep(1);
    if ((++sp & 255u) == 0u) { if (xb_ld(&bar[XB_TMO])) break; if (sp > XB_SPIN_CAP) { atomicAdd(&bar[XB_TMO], 1u); break; } }
  }
  nloc = mine > 0u ? mine : 1u; nx = cnt > 0u ? cnt : 1u;
}
DI void xcd_barrier(const XcdBarrier& b) {
  asm volatile("s_waitcnt vmcnt(0)" ::: "memory");
  __syncthreads();
  if (threadIdx.x == 0) {
    unsigned* bar = b.bar;
    __builtin_amdgcn_s_waitcnt(0);
    unsigned nloc = b.st[0], nx = b.st[1];
    if (nloc == 0u) { xcd_barrier_complete(bar, b.x, nloc, nx); b.st[0] = nloc; b.st[1] = nx; }
    const unsigned old = xb_add(&bar[XB_XSUB(b.x)], 1u);
    const unsigned gen = old / nloc;
    if (old + 1u == (gen + 1u) * nloc) {
      __builtin_amdgcn_fence(__ATOMIC_RELEASE, "agent");
      asm volatile("s_waitcnt vmcnt(0)" ::: "memory");
      const unsigned og = xb_add(&bar[XB_TOP], 1u);
      const unsigned tg = og / nx;
      if (og + 1u == (tg + 1u) * nx) xb_add(&bar[XB_TOPGEN], 1u);
      else XB_SPIN(xb_ld(&bar[XB_TOPGEN]) == tg, bar);
      __builtin_amdgcn_fence(__ATOMIC_ACQUIRE, "agent");
      xb_add(&bar[XB_XGEN(b.x)], 1u);
      asm volatile("s_waitcnt vmcnt(0)" ::: "memory");
    } else {
      XB_SPIN(xb_ld(&bar[XB_XGEN(b.x)]) == gen, bar);
      __builtin_amdgcn_fence(__ATOMIC_ACQUIRE, "agent");
      asm volatile("s_waitcnt vmcnt(0)" ::: "memory");
    }
  }
  __syncthreads();
}

constexpr int N_PHASES = 17;
DI void run_phase(const Params& p, int ph, char* smem) {
  char* ws = p.ws;
  const float* mod = (const float*)(ws + WS_MOD);
  const bf16_t* H = (const bf16_t*)(ws + WS_H);
  if (ph == 0) { phase_prep(p, smem); return; }
  const int layer = (ph - 1) >> 3, sub = (ph - 1) & 7;
  const float* modl = mod + (size_t)layer * 8 * 12288;
  switch (sub) {
    case 0:
      if (layer == 0) phase_norm<true>(p, p.x, p.norm_gain, modl, modl + 2048);
      else phase_norm<false>(p, p.out, p.norm_gain + 2 * 2048, modl, modl + 2048);
      break;
    case 1: {
      if (layer == 0) fox_cumsum(p);
      EpiArgs ea{}; ea.out = ws + WS_QK; ea.ldc = 4096;
      if (layer == 0) {
        ea.gainA = p.even_fox_qk_gain; ea.gainB = p.even_diff_qk_gain; ea.gshift = 3;
      } else { ea.gainA = p.odd_qk_gain; ea.gainB = p.odd_qk_gain; ea.gshift = 4; }
      gemm_phase<EPI_NORM_BF16>(H, 2048, (const bf16_t*)(ws + (layer ? WS_WQK1 : WS_WQK0)), 2048, 2048, 128, 32, ea, smem);
      EpiArgs ev{}; ev.out = ws + WS_VT; ev.ldc = T_;
      gemm_phase<EPI_BF16>((const bf16_t*)(ws + (layer ? WS_WV1 : WS_WV0)), 2048, H, 2048, 2048, 16, 128, ev, smem);
    } break;
    case 2:
      if (layer == 0) phase_attn_even(p, smem); else phase_attn_odd(p, smem);
      break;
    case 3: {
      EpiArgs ea{}; ea.out = p.out; ea.ldc = 2048; ea.xin = layer ? p.out : p.x; ea.gate = modl + 2 * 2048;
      gemm_phase<EPI_RES_F32>((const bf16_t*)(ws + WS_ATT), 2048, (const bf16_t*)(ws + (layer ? WS_WO1 : WS_WO0)), 2048, 2048, 128, 16, ea, smem);
    } break;
    case 4:
      phase_norm<false>(p, p.out, p.norm_gain + (layer * 2 + 1) * 2048, modl + 3 * 2048, modl + 4 * 2048);
      break;
    case 5: {
      EpiArgs ea{}; ea.out = ws + WS_QK; ea.ldc = 2048;
      gemm_phase<EPI_BF16>(H, 2048, (const bf16_t*)(ws + (layer ? WS_WQ1 : WS_WQ0)), 2048, 2048, 128, 16, ea, smem);
    } break;
    case 6: phase_peer_scores(p, layer, smem); break;
    case 7: phase_peer(p, layer, modl + 5 * 2048, smem); break;
  }
}

#if FUSED
__global__ void __launch_bounds__(NTHREADS, 2) mega_kernel(Params p) {
  extern __shared__ __attribute__((aligned(16))) char smem[];
  cg::grid_group grid = cg::this_grid();
  volatile LAS unsigned* xst = (volatile LAS unsigned*)(smem + SMEM_BYTES - 16);
  if (threadIdx.x == 0) { xst[0] = 0u; xst[1] = 0u; }
  __syncthreads();
  const XcdBarrier xb = xcd_barrier_post((unsigned*)(p.ws + WS_BAR), xst);
#pragma unroll
  for (int ph = 0; ph < N_PHASES; ++ph) {
    run_phase(p, ph, smem);
    if (ph == 0) grid.sync();
    else if (ph + 1 < N_PHASES) xcd_barrier(xb);
  }
}
#else
template <int PH>
__global__ void __launch_bounds__(NTHREADS, 2) phase_kernel(Params p) {
  extern __shared__ __attribute__((aligned(16))) char smem[];
  run_phase(p, PH, smem);
}
template <int PH>
static void launch_phases(const Params& p, int grid, hipStream_t stream) {
  if constexpr (PH < N_PHASES) {
    (void)hipFuncSetAttribute((const void*)phase_kernel<PH>, hipFuncAttributeMaxDynamicSharedMemorySize, SMEM_BYTES);
    phase_kernel<PH><<<grid, NTHREADS, SMEM_BYTES, stream>>>(p);
    launch_phases<PH + 1>(p, grid, stream);
  }
}
#endif

extern "C" void kernel_launch(void* const* d_in, const int* in_sizes, int n_in, void* d_out, int out_size, void* d_ws,
                              size_t ws_size, hipStream_t stream) {
  Params p{};
  p.x = (const float*)d_in[0]; p.c = (const float*)d_in[1]; p.rel_bias = (const float*)d_in[2];
  p.norm_gain = (const float*)d_in[3]; p.w_ada = (const float*)d_in[4]; p.b_ada = (const float*)d_in[5];
  p.even_w_in = (const float*)d_in[6]; p.even_b_forget = (const float*)d_in[7]; p.even_fox_qk_gain = (const float*)d_in[8];
  p.even_diff_qk_gain = (const float*)d_in[9]; p.even_diff_lambda = (const float*)d_in[10];
  p.even_diff_subln_gain = (const float*)d_in[11]; p.even_w_out = (const float*)d_in[12];
  p.odd_w_qkv = (const float*)d_in[13]; p.odd_qk_gain = (const float*)d_in[14]; p.odd_w_out = (const float*)d_in[15];
  p.peer_w_query = (const float*)d_in[16]; p.peer_sub_keys = (const float*)d_in[17];
  p.peer_u = (const float*)d_in[18]; p.peer_v = (const float*)d_in[19];
  p.out = (float*)d_out; p.ws = (char*)d_ws;
  if (ws_size < WS_END) { fprintf(stderr, "workspace too small: %zu < %zu\n", ws_size, (size_t)WS_END); return; }
#if FUSED
  static int grid_blocks = 0;
  if (!grid_blocks) {
    int dev = 0, cus = 0, per_cu = 0;
    (void)hipGetDevice(&dev);
    (void)hipDeviceGetAttribute(&cus, hipDeviceAttributeMultiprocessorCount, dev);
    (void)hipFuncSetAttribute((const void*)mega_kernel, hipFuncAttributeMaxDynamicSharedMemorySize, SMEM_BYTES);
    (void)hipOccupancyMaxActiveBlocksPerMultiprocessor(&per_cu, mega_kernel, NTHREADS, SMEM_BYTES);
    if (per_cu > 2) per_cu = 2;
    grid_blocks = cus * per_cu;
  }
  (void)hipMemsetAsync(p.ws + WS_BAR, 0, XCD_BAR_WORDS * 4, stream);
  void* args[] = {&p};
  hipError_t e = hipLaunchCooperativeKernel((void*)mega_kernel, dim3(grid_blocks), dim3(NTHREADS), args, SMEM_BYTES, stream);
  if (e != hipSuccess) fprintf(stderr, "cooperative launch failed: %s (grid %d)\n", hipGetErrorString(e), grid_blocks);
#else
  launch_phases<0>(p, 512, stream);
#endif
}
```

```cpp
#include <hip/hip_runtime.h>
#include <hip/hip_cooperative_groups.h>
#include <stdint.h>
#include <stdio.h>
namespace cg = cooperative_groups;

#ifndef FUSED
#define FUSED 1
#endif

#define DI __device__ __forceinline__
typedef unsigned short bf16_t;
typedef __attribute__((ext_vector_type(8))) short bf16x8;
typedef __attribute__((ext_vector_type(4))) short bf16x4;
typedef __attribute__((ext_vector_type(16))) float f32x16;
typedef __attribute__((ext_vector_type(2))) __bf16 bf2_t;
typedef __attribute__((ext_vector_type(2))) float f2_t;
typedef __attribute__((ext_vector_type(4))) unsigned u32x4;
#define MFMA32(a, b, c) __builtin_amdgcn_mfma_f32_32x32x16_bf16((a), (b), (c), 0, 0, 0)

constexpr int T_ = 16384;
constexpr int D_ = 2048;
constexpr int S_ = 2048;
constexpr int NB_ = 8;
constexpr int NEXP = 16384;
constexpr float LOG2E = 1.4426950408889634f;
constexpr int NTHREADS = 256;
constexpr int SMEM_BYTES = 75776 + 16;

constexpr size_t MiB = 1048576;
constexpr size_t WS_PEERU = 0;
constexpr size_t WS_PEERV8 = WS_PEERU + 64 * MiB;
constexpr size_t WS_PEERV = WS_PEERU + 128 * MiB;
constexpr size_t WS_WQK0 = WS_PEERV + 128 * MiB;
constexpr size_t WS_WV0 = WS_WQK0 + 16 * MiB;
constexpr size_t WS_WQK1 = WS_WV0 + 8 * MiB;
constexpr size_t WS_WV1 = WS_WQK1 + 16 * MiB;
constexpr size_t WS_WO0 = WS_WV1 + 8 * MiB;
constexpr size_t WS_WO1 = WS_WO0 + 8 * MiB;
constexpr size_t WS_WQ0 = WS_WO1 + 8 * MiB;
constexpr size_t WS_WQ1 = WS_WQ0 + 8 * MiB;
constexpr size_t WS_SK = WS_WQ1 + 8 * MiB;
constexpr size_t WS_WFF = WS_SK + 131072;
constexpr size_t WS_MOD = WS_WFF + 65536;
constexpr size_t WS_LOGF = WS_MOD + 786432;
constexpr size_t WS_FCUM = WS_LOGF + 524288;
constexpr size_t WS_MISC = WS_FCUM + 524288;
constexpr size_t WS_H = WS_MISC + 65536;
constexpr size_t WS_QK = WS_H + 64 * MiB;
constexpr size_t WS_VT = WS_QK + 128 * MiB;
constexpr size_t WS_ATT = WS_VT + 64 * MiB;
constexpr size_t WS_SC = WS_ATT + 64 * MiB;
constexpr size_t WS_BAR = WS_SC + 128 * MiB;
constexpr size_t WS_END = WS_BAR + 65536;

struct Params {
  const float* x; const float* c; const float* rel_bias; const float* norm_gain; const float* w_ada; const float* b_ada;
  const float* even_w_in; const float* even_b_forget; const float* even_fox_qk_gain; const float* even_diff_qk_gain;
  const float* even_diff_lambda; const float* even_diff_subln_gain; const float* even_w_out;
  const float* odd_w_qkv; const float* odd_qk_gain; const float* odd_w_out;
  const float* peer_w_query; const float* peer_sub_keys; const float* peer_u; const float* peer_v;
  float* out; char* ws;
};

DI unsigned pack_bf2(float a, float b) { f2_t v = {a, b}; return __builtin_bit_cast(unsigned, __builtin_convertvector(v, bf2_t)); }
DI bf16_t f2bf(float a) { return (bf16_t)(pack_bf2(a, 0.f) & 0xffffu); }
DI float bf_lo(unsigned u) { return __uint_as_float(u << 16); }
DI float bf_hi(unsigned u) { return __uint_as_float(u & 0xffff0000u); }
DI int TID() { int t = threadIdx.x; asm volatile("" : "+v"(t)); return t; }
DI int crow(int reg, int h) { return (reg & 3) + 8 * (reg >> 2) + 4 * h; }
DI float wave_sum(float v) {
#pragma unroll
  for (int o = 32; o >= 1; o >>= 1) v += __shfl_xor(v, o);
  return v;
}
DI float wave_max(float v) {
#pragma unroll
  for (int o = 32; o >= 1; o >>= 1) v = fmaxf(v, __shfl_xor(v, o));
  return v;
}

DI void transpose_tile(const float* __restrict__ src, int ld, int c0, int k0, bf16_t* __restrict__ dst_row0, char* smem) {
  float* tile = (float*)smem;
  const int tid = TID();
  const int ty = tid >> 4, tx = tid & 15;
#pragma unroll
  for (int i = 0; i < 4; ++i) {
    const int k = ty + 16 * i;
    const float4 v = *(const float4*)(src + (size_t)(k0 + k) * ld + c0 + 4 * tx);
    float* t = tile + k * 65 + 4 * tx;
    t[0] = v.x; t[1] = v.y; t[2] = v.z; t[3] = v.w;
  }
  __syncthreads();
  const int cc = tid >> 2, kc = (tid & 3) * 16;
  unsigned pk[8];
#pragma unroll
  for (int j = 0; j < 8; ++j) pk[j] = pack_bf2(tile[(kc + 2 * j) * 65 + cc], tile[(kc + 2 * j + 1) * 65 + cc]);
  uint4* d = (uint4*)(dst_row0 + (size_t)cc * 2048 + k0 + kc);
  d[0] = make_uint4(pk[0], pk[1], pk[2], pk[3]);
  d[1] = make_uint4(pk[4], pk[5], pk[6], pk[7]);
  __syncthreads();
}

DI void phase_prep(const Params& p, char* smem) {
  const int tid = TID(), bid = blockIdx.x, G = gridDim.x;
  char* ws = p.ws;
  {
    float* cond = (float*)smem;
    bool have_cond = false;
    for (int item = bid; item < 384; item += G) {
      if (!have_cond) {
        for (int e = tid; e < NB_ * D_; e += NTHREADS) {
          const int b = e >> 11, d = e & 2047;
          const float v = p.c[e];
          cond[d * 8 + b] = v / (1.f + __expf(-v));
        }
        have_cond = true;
        __syncthreads();
      }
      const int i = item / 192, n = (item % 192) * 64 + (tid & 63);
      const int w = tid >> 6;
      const float* wp = p.w_ada + (size_t)i * D_ * 12288 + n;
      float acc[8];
#pragma unroll
      for (int b = 0; b < 8; ++b) acc[b] = 0.f;
#pragma unroll 8
      for (int d = w; d < D_; d += 4) {
        const float wv = wp[(size_t)d * 12288];
        const float4 c0 = *(const float4*)(cond + d * 8), c1 = *(const float4*)(cond + d * 8 + 4);
        acc[0] += c0.x * wv; acc[1] += c0.y * wv; acc[2] += c0.z * wv; acc[3] += c0.w * wv;
        acc[4] += c1.x * wv; acc[5] += c1.y * wv; acc[6] += c1.z * wv; acc[7] += c1.w * wv;
      }
      float* red = (float*)(smem + 65536);
#pragma unroll
      for (int b = 0; b < 8; ++b) red[(w * 64 + (tid & 63)) * 8 + b] = acc[b];
      __syncthreads();
      if (tid < 64) {
        float* mod = (float*)(ws + WS_MOD);
#pragma unroll
        for (int b = 0; b < 8; ++b) {
          const float s = red[(0 * 64 + tid) * 8 + b] + red[(1 * 64 + tid) * 8 + b] + red[(2 * 64 + tid) * 8 + b] + red[(3 * 64 + tid) * 8 + b];
          mod[((size_t)i * 8 + b) * 12288 + n] = s + p.b_ada[i * 12288 + n];
        }
      }
      __syncthreads();
    }
    __syncthreads();
  }
  {
    bf16_t* wqk0 = (bf16_t*)(ws + WS_WQK0); bf16_t* wv0 = (bf16_t*)(ws + WS_WV0);
    bf16_t* wqk1 = (bf16_t*)(ws + WS_WQK1); bf16_t* wv1 = (bf16_t*)(ws + WS_WV1);
    for (int item = bid; item < 320 * 32; item += G) {
      const int ct = item >> 5, kt = item & 31;
      const float* src; int ld, c0; bf16_t* dst;
      if (ct < 96) {
        const int seg = ct >> 4, cl = (ct & 15) * 64;
        src = p.even_w_in; ld = 6152;
        c0 = (seg < 3 ? seg * 1024 : 3080 + (seg - 3) * 1024) + cl;
        if (seg == 0) dst = wqk0 + (size_t)cl * 2048;
        else if (seg == 1) dst = wqk0 + (size_t)(1024 + cl) * 2048;
        else if (seg == 2) dst = wv0 + (size_t)cl * 2048;
        else if (seg == 3) dst = wqk0 + (size_t)(2048 + cl) * 2048;
        else if (seg == 4) dst = wqk0 + (size_t)(3072 + cl) * 2048;
        else dst = wv0 + (size_t)(1024 + cl) * 2048;
      } else if (ct < 192) {
        const int cl = (ct - 96) * 64;
        src = p.odd_w_qkv; ld = 6144; c0 = cl;
        dst = cl < 4096 ? wqk1 + (size_t)cl * 2048 : wv1 + (size_t)(cl - 4096) * 2048;
      } else {
        const int mi = (ct - 192) >> 5, cl = ((ct - 192) & 31) * 64;
        ld = 2048; c0 = cl;
        if (mi == 0) { src = p.even_w_out; dst = (bf16_t*)(ws + WS_WO0); }
        else if (mi == 1) { src = p.odd_w_out; dst = (bf16_t*)(ws + WS_WO1); }
        else if (mi == 2) { src = p.peer_w_query; dst = (bf16_t*)(ws + WS_WQ0); }
        else { src = p.peer_w_query + (size_t)2048 * 2048; dst = (bf16_t*)(ws + WS_WQ1); }
        dst += (size_t)cl * 2048;
      }
      transpose_tile(src, ld, c0, kt * 64, dst, smem);
    }
  }
  {
    const int lane = tid & 63;
    const int gw = __builtin_amdgcn_readfirstlane((bid * NTHREADS + tid) >> 6), nw = (G * NTHREADS) >> 6;
    float* scl = (float*)(ws + WS_PEERV);
    for (int row = gw; row < 4 * NEXP; row += nw) {
      const int tab = row >> 15, rr = row & 32767;
      const float* src = (tab ? p.peer_v : p.peer_u) + (size_t)rr * D_;
      unsigned char* dst = (unsigned char*)(ws + (tab ? WS_PEERV8 : WS_PEERU)) + (size_t)rr * D_;
      float4 v[8];
      float am = 0.f;
#pragma unroll
      for (int i = 0; i < 2; ++i)
#pragma unroll
        for (int j = 0; j < 4; ++j) {
          v[4 * i + j] = *(const float4*)(src + lane * 16 + 1024 * i + 4 * j);
          am = fmaxf(am, fmaxf(fmaxf(fabsf(v[4 * i + j].x), fabsf(v[4 * i + j].y)), fmaxf(fabsf(v[4 * i + j].z), fabsf(v[4 * i + j].w))));
        }
      am = wave_max(am);
      const float sc = am > 0.f ? 432.f / am : 1.f;
      if (lane == 0) scl[row] = am > 0.f ? am / 432.f : 1.f;
#pragma unroll
      for (int i = 0; i < 2; ++i) {
        unsigned w[4];
#pragma unroll
        for (int j = 0; j < 4; ++j) {
          int d = __builtin_amdgcn_cvt_pk_fp8_f32(v[4 * i + j].x * sc, v[4 * i + j].y * sc, 0, false);
          d = __builtin_amdgcn_cvt_pk_fp8_f32(v[4 * i + j].z * sc, v[4 * i + j].w * sc, d, true);
          w[j] = (unsigned)d;
        }
        *(uint4*)(dst + lane * 16 + 1024 * i) = make_uint4(w[0], w[1], w[2], w[3]);
      }
    }
    for (int item = bid; item < 32; item += G) {
      const size_t off = (size_t)item * 2048;
      const float4 a = *(const float4*)(p.peer_sub_keys + off + tid * 8), b = *(const float4*)(p.peer_sub_keys + off + tid * 8 + 4);
      *(uint4*)((bf16_t*)(ws + WS_SK) + off + tid * 8) = make_uint4(pack_bf2(a.x, a.y), pack_bf2(a.z, a.w), pack_bf2(b.x, b.y), pack_bf2(b.z, b.w));
    }
  }
  if (bid == G - 1) {
    float* wff = (float*)(ws + WS_WFF);
    for (int e = tid; e < 2048 * 8; e += NTHREADS) wff[e] = p.even_w_in[(size_t)(e >> 3) * 6152 + 3072 + (e & 7)];
    if (tid < 64) {
      const float* l = p.even_diff_lambda;
      float s1 = l[tid] * l[128 + tid] + l[64 + tid] * l[128 + 64 + tid];
      float s2 = l[256 + tid] * l[384 + tid] + l[256 + 64 + tid] * l[384 + 64 + tid];
      s1 = wave_sum(s1); s2 = wave_sum(s2);
      if (tid == 0) ((float*)(ws + WS_MISC))[0] = expf(s1) - expf(s2) + 0.2f;
    }
  }
}

template <bool FF>
DI void phase_norm(const Params& p, const float* __restrict__ xin, const float* __restrict__ gain,
                   const float* __restrict__ sh, const float* __restrict__ sc  ) {
  const int lane = TID() & 63;
  const int gw = __builtin_amdgcn_readfirstlane((blockIdx.x * NTHREADS + TID()) >> 6), nw = (gridDim.x * NTHREADS) >> 6;
  bf16_t* H = (bf16_t*)(p.ws + WS_H);
  for (int t = gw; t < T_; t += nw) {
    const int b = t >> 11;
    const float* xr = xin + (size_t)t * D_;
    float4 v[8];
    float ss = 0.f;
#pragma unroll
    for (int i = 0; i < 8; ++i) { v[i] = *(const float4*)(xr + lane * 4 + 256 * i); ss += v[i].x * v[i].x + v[i].y * v[i].y + v[i].z * v[i].z + v[i].w * v[i].w; }
    ss = wave_sum(ss);
    const float rstd = rsqrtf(ss * (1.f / 2048.f) + 1e-6f);
    float ff[8];
    if (FF) {
#pragma unroll
      for (int j = 0; j < 8; ++j) ff[j] = 0.f;
    }
#pragma unroll
    for (int i = 0; i < 8; ++i) {
      const int c = lane * 4 + 256 * i;
      const float4 g = *(const float4*)(gain + c);
      const float4 s1 = *(const float4*)(sc + (size_t)b * 12288 + c);
      const float4 s0 = *(const float4*)(sh + (size_t)b * 12288 + c);
      float4 h;
      h.x = v[i].x * rstd * g.x * (1.f + s1.x) + s0.x;
      h.y = v[i].y * rstd * g.y * (1.f + s1.y) + s0.y;
      h.z = v[i].z * rstd * g.z * (1.f + s1.z) + s0.z;
      h.w = v[i].w * rstd * g.w * (1.f + s1.w) + s0.w;
      *(uint2*)(H + (size_t)t * D_ + c) = make_uint2(pack_bf2(h.x, h.y), pack_bf2(h.z, h.w));
      if (FF) {
        const float* wff = (const float*)(p.ws + WS_WFF) + c * 8;
        const float hv[4] = {h.x, h.y, h.z, h.w};
#pragma unroll
        for (int e = 0; e < 4; ++e) {
          const float4 w0 = *(const float4*)(wff + e * 8), w1 = *(const float4*)(wff + e * 8 + 4);
          ff[0] += hv[e] * w0.x; ff[1] += hv[e] * w0.y; ff[2] += hv[e] * w0.z; ff[3] += hv[e] * w0.w;
          ff[4] += hv[e] * w1.x; ff[5] += hv[e] * w1.y; ff[6] += hv[e] * w1.z; ff[7] += hv[e] * w1.w;
        }
      }
    }
    if (FF) {
#pragma unroll
      for (int j = 0; j < 8; ++j) ff[j] = wave_sum(ff[j]);
      if (lane < 8) {
        float z = ff[0];
#pragma unroll
        for (int j = 1; j < 8; ++j) z = (lane == j) ? ff[j] : z;
        z += p.even_b_forget[lane];
        const float lf = fminf(z, 0.f) - log1pf(__expf(-fabsf(z)));
        ((float*)(p.ws + WS_LOGF))[(size_t)t * 8 + lane] = lf;
      }
    }
  }
}

DI void fox_cumsum(const Params& p) {
  const int lane = TID() & 63;
  const int gw = __builtin_amdgcn_readfirstlane((blockIdx.x * NTHREADS + TID()) >> 6), nw = (gridDim.x * NTHREADS) >> 6;
  const float* lf = (const float*)(p.ws + WS_LOGF);
  float* fc = (float*)(p.ws + WS_FCUM);
  for (int it = gw; it < 64; it += nw) {
    const int b = it >> 3, hh = it & 7;
    float v[32];
    float tot = 0.f;
#pragma unroll
    for (int j = 0; j < 32; ++j) { tot += lf[(size_t)(b * S_ + lane * 32 + j) * 8 + hh]; v[j] = tot; }
    float inc = tot;
#pragma unroll
    for (int o = 1; o < 64; o <<= 1) { const float n = __shfl_up(inc, o); if (lane >= o) inc += n; }
    const float base = inc - tot;
#pragma unroll
    for (int j = 0; j < 32; ++j) fc[(size_t)it * S_ + lane * 32 + j] = v[j] + base;
  }
}

DI void gemm_tile_compute(const bf16_t* A, int lda, const bf16_t* B, int ldb, int K,
                          char* smem, f32x16 (&acc)[2][2]) {
  const int tid = TID(), lane = tid & 63, wave = __builtin_amdgcn_readfirstlane(tid >> 6);
  const int r = lane & 31, h = lane >> 5;
  const int wm = wave >> 1, wn = wave & 1;
  const int srow = tid >> 3, sc = tid & 7;
  const char* Ab = (const char*)A;
  const char* Bb = (const char*)B;
  const unsigned voa = (unsigned)(srow * lda + sc * 8) * 2u;
  const unsigned vob = (unsigned)(srow * ldb + sc * 8) * 2u;
  const unsigned sta = (unsigned)(32 * lda) * 2u, stb = (unsigned)(32 * ldb) * 2u;
  u32x4 ra[4], rb[4];
#pragma unroll
  for (int i = 0; i < 4; ++i) {
    ra[i] = *(const u32x4*)(Ab + (size_t)(i * sta) + voa);
    rb[i] = *(const u32x4*)(Bb + (size_t)(i * stb) + vob);
  }
  const int woff = srow * 128 + ((sc ^ ((srow >> 1) & 7)) << 4);
  const int rsw = (r >> 1) & 7;
  const int aoff = (wm * 64 + r) * 128, boff = 16384 + (wn * 64 + r) * 128;
#pragma unroll
  for (int i = 0; i < 2; ++i)
#pragma unroll
    for (int j = 0; j < 2; ++j)
#pragma unroll
      for (int e = 0; e < 16; ++e) acc[i][j][e] = 0.f;
#pragma unroll
  for (int i = 0; i < 4; ++i) {
    *(u32x4*)(smem + woff + i * 4096) = ra[i];
    *(u32x4*)(smem + 16384 + woff + i * 4096) = rb[i];
  }
  __syncthreads();
  const int KT = K >> 6;
  for (int kt = 0; kt < KT; ++kt) {
    char* st = smem + (kt & 1) * 32768;
    {
      const size_t kn = (size_t)((kt + 1 < KT ? kt + 1 : kt) * 128);
#pragma unroll
      for (int i = 0; i < 4; ++i) {
        ra[i] = *(const u32x4*)(Ab + (kn + i * sta) + voa);
        rb[i] = *(const u32x4*)(Bb + (kn + i * stb) + vob);
      }
    }
    asm volatile("" ::: "memory");
    __builtin_amdgcn_sched_barrier(0);
#pragma unroll
    for (int s = 0; s < 4; ++s) {
      const int co = ((2 * s + h) ^ rsw) << 4;
      bf16x8 af[2], bfr[2];
      af[0] = *(const bf16x8*)(st + aoff + co);
      af[1] = *(const bf16x8*)(st + aoff + 32 * 128 + co);
      bfr[0] = *(const bf16x8*)(st + boff + co);
      bfr[1] = *(const bf16x8*)(st + boff + 32 * 128 + co);
#pragma unroll
      for (int i = 0; i < 2; ++i)
#pragma unroll
        for (int j = 0; j < 2; ++j) acc[i][j] = MFMA32(af[i], bfr[j], acc[i][j]);
    }
    __builtin_amdgcn_sched_barrier(0);
    asm volatile("" ::: "memory");
    {
      char* sn = smem + ((kt + 1) & 1) * 32768;
#pragma unroll
      for (int i = 0; i < 4; ++i) {
        *(u32x4*)(sn + woff + i * 4096) = ra[i];
        *(u32x4*)(sn + 16384 + woff + i * 4096) = rb[i];
      }
    }
    __syncthreads();
  }
}

enum { EPI_BF16 = 0, EPI_NORM_BF16 = 1, EPI_RES_F32 = 2, EPI_F32 = 3 };
struct EpiArgs {
  void* out; int ldc;
  const float* gainA; const float* gainB; int gshift;
  const float* xin; const float* gate;
};

template <int EPI>
DI void gemm_epilogue(f32x16 (&acc)[2][2], int m0, int n0, int tn, const EpiArgs& ea, char* smem) {
  const int tid = TID(), lane = tid & 63, wave = __builtin_amdgcn_readfirstlane(tid >> 6);
  const int r = lane & 31, h = lane >> 5;
  const int wm = wave >> 1, wn = wave & 1;
  if (EPI == EPI_NORM_BF16) {
    float* red = (float*)smem;
    float ss[2][16];
#pragma unroll
    for (int i = 0; i < 2; ++i)
#pragma unroll
      for (int e = 0; e < 16; ++e) {
        float v = acc[i][0][e] * acc[i][0][e] + acc[i][1][e] * acc[i][1][e];
#pragma unroll
        for (int o = 16; o >= 1; o >>= 1) v += __shfl_xor(v, o);
        ss[i][e] = v;
      }
    if (r == 0) {
#pragma unroll
      for (int i = 0; i < 2; ++i)
#pragma unroll
        for (int e = 0; e < 16; ++e) red[wn * 128 + wm * 64 + i * 32 + crow(e, h)] = ss[i][e];
    }
    __syncthreads();
    const int grp = tn >> ea.gshift;
    const float* gain = ((grp & 2) ? ea.gainB : ea.gainA) + (grp & 1) * 128;
    bf16_t* out = (bf16_t*)ea.out;
#pragma unroll
    for (int i = 0; i < 2; ++i)
#pragma unroll
      for (int e = 0; e < 16; ++e) {
        const int rl = wm * 64 + i * 32 + crow(e, h);
        const float rstd = rsqrtf((red[rl] + red[128 + rl]) * (1.f / 128.f) + 1e-6f);
#pragma unroll
        for (int j = 0; j < 2; ++j) {
          const int cl = wn * 64 + j * 32 + r;
          out[(size_t)(m0 + rl) * ea.ldc + n0 + cl] = f2bf(acc[i][j][e] * rstd * gain[cl]);
        }
      }
    __syncthreads();
  } else {
#pragma unroll
    for (int i = 0; i < 2; ++i)
#pragma unroll
      for (int e = 0; e < 16; ++e) {
        const int row = m0 + wm * 64 + i * 32 + crow(e, h);
#pragma unroll
        for (int j = 0; j < 2; ++j) {
          const int col = n0 + wn * 64 + j * 32 + r;
          const float v = acc[i][j][e];
          if (EPI == EPI_BF16) ((bf16_t*)ea.out)[(size_t)row * ea.ldc + col] = f2bf(v);
          else if (EPI == EPI_F32) ((float*)ea.out)[(size_t)row * ea.ldc + col] = v;
          else {
            const float g = ea.gate[(size_t)(row >> 11) * 12288 + col];
            ((float*)ea.out)[(size_t)row * ea.ldc + col] = ea.xin[(size_t)row * ea.ldc + col] + g * v;
          }
        }
      }
  }
}

template <int EPI>
DI void gemm_phase(const bf16_t* A, int lda, const bf16_t* B, int ldb, int K, int mt, int nt, const EpiArgs& ea, char* smem) {
  const int bid = blockIdx.x, G = gridDim.x;
  const int xcd = bid & 7, slot = bid >> 3, nslots = G >> 3;
  const int nsn = nt >> 3, nsup = (mt >> 3) * nsn;
  const int cnt = (nsup - xcd + 7) >> 3;
  for (int j = slot; j < cnt * 64; j += nslots) {
    const int sup = xcd + 8 * (j >> 6), within = j & 63;
    const int sm = sup / nsn, sn = sup - sm * nsn;
    const int tm = sm * 8 + (within >> 3), tn = sn * 8 + (within & 7);
    f32x16 acc[2][2];
    gemm_tile_compute(A + (size_t)tm * 128 * lda, lda, B + (size_t)tn * 128 * ldb, ldb, K, smem, acc);
    gemm_epilogue<EPI>(acc, tm * 128, tn * 128, tn, ea, smem);
  }
}

template <int MODE>
DI void attn_wave(const bf16_t* Qp, int ldq, const bf16_t* Kp, int ldk,
                  const bf16_t* Vt, int ldv, const float* kbias, const float* tbl,
                  int q0, f32x16 (&o)[4], float& l_out) {
  const int lane = TID() & 63, r = lane & 31, h = lane >> 5;
  const float scale2 = 0.08838834764831845f * LOG2E;
  bf16x8 qf[8];
#pragma unroll
  for (int s = 0; s < 8; ++s) qf[s] = *(const bf16x8*)(Qp + (size_t)(q0 + r) * ldq + 16 * s + 8 * h);
#pragma unroll
  for (int dt = 0; dt < 4; ++dt)
#pragma unroll
    for (int e = 0; e < 16; ++e) o[dt][e] = 0.f;
  float m = -1e30f, l = 0.f;
  const int nkt = (q0 >> 5) + 1;
  bf16x8 kf[8];
#pragma unroll
  for (int s = 0; s < 8; ++s) kf[s] = *(const bf16x8*)(Kp + (size_t)r * ldk + 16 * s + 8 * h);
  for (int kt = 0; kt < nkt; ++kt) {
    const int k0 = kt << 5;
    bf16x4 vf[4][2][2];
#pragma unroll
    for (int dt = 0; dt < 4; ++dt)
#pragma unroll
      for (int s = 0; s < 2; ++s) {
        const bf16_t* vp = Vt + (size_t)(32 * dt + r) * ldv + k0 + 16 * s + 4 * h;
        vf[dt][s][0] = *(const bf16x4*)(vp);
        vf[dt][s][1] = *(const bf16x4*)(vp + 8);
      }
    f32x16 sa;
#pragma unroll
    for (int e = 0; e < 16; ++e) sa[e] = 0.f;
#pragma unroll
    for (int s = 0; s < 8; ++s) sa = MFMA32(kf[s], qf[s], sa);
    __builtin_amdgcn_sched_barrier(0);
    {
      const int kn = (kt + 1 < nkt) ? k0 + 32 : k0;
#pragma unroll
      for (int s = 0; s < 8; ++s) kf[s] = *(const bf16x8*)(Kp + (size_t)(kn + r) * ldk + 16 * s + 8 * h);
    }
    asm volatile("" ::: "memory");
    __builtin_amdgcn_sched_barrier(0);
    float v[16];
    if (MODE == 0) {
#pragma unroll
      for (int c = 0; c < 4; ++c) {
        const float4 kb = *(const float4*)(kbias + k0 + 8 * c + 4 * h);
        v[4 * c + 0] = sa[4 * c + 0] * scale2 - kb.x * LOG2E;
        v[4 * c + 1] = sa[4 * c + 1] * scale2 - kb.y * LOG2E;
        v[4 * c + 2] = sa[4 * c + 2] * scale2 - kb.z * LOG2E;
        v[4 * c + 3] = sa[4 * c + 3] * scale2 - kb.w * LOG2E;
      }
      if (kt == nkt - 1) {
#pragma unroll
        for (int e = 0; e < 16; ++e) if (crow(e, h) > r) v[e] = -INFINITY;
      }
    } else {
      const float* tp = tbl + (q0 - k0) + r + 32 - 4 * h - 27;
#pragma unroll
      for (int e = 0; e < 16; ++e) v[e] = sa[e] * scale2 + tp[27 - ((e & 3) + 8 * (e >> 2))];
    }
    float mx = v[0];
#pragma unroll
    for (int e = 1; e < 16; ++e) mx = fmaxf(mx, v[e]);
    mx = fmaxf(mx, __shfl_xor(mx, 32));
    const float mn = fmaxf(m, mx);
    const float alpha = exp2f(m - mn);
    m = mn;
    float ps = 0.f;
#pragma unroll
    for (int e = 0; e < 16; ++e) { v[e] = exp2f(v[e] - mn); ps += v[e]; }
    l = l * alpha + ps;
#pragma unroll
    for (int dt = 0; dt < 4; ++dt)
#pragma unroll
      for (int e = 0; e < 16; ++e) o[dt][e] *= alpha;
    bf16x8 pb[2];
#pragma unroll
    for (int s = 0; s < 2; ++s) {
      const uint4 u = make_uint4(pack_bf2(v[8 * s + 0], v[8 * s + 1]), pack_bf2(v[8 * s + 2], v[8 * s + 3]),
                                 pack_bf2(v[8 * s + 4], v[8 * s + 5]), pack_bf2(v[8 * s + 6], v[8 * s + 7]));
      pb[s] = __builtin_bit_cast(bf16x8, u);
    }
#pragma unroll
    for (int dt = 0; dt < 4; ++dt)
#pragma unroll
      for (int s = 0; s < 2; ++s) {
        const bf16x8 va = __builtin_shufflevector(vf[dt][s][0], vf[dt][s][1], 0, 1, 2, 3, 4, 5, 6, 7);
        o[dt] = MFMA32(va, pb[s], o[dt]);
      }
  }
  l_out = l + __shfl_xor(l, 32);
}

DI void attn_store_bf16(const f32x16 (&o)[4], float linv, bf16_t* __restrict__ out_row  , int ldo) {
  const int lane = TID() & 63, r = lane & 31, h = lane >> 5;
  bf16_t* op = out_row + (size_t)r * ldo + 4 * h;
#pragma unroll
  for (int dt = 0; dt < 4; ++dt)
#pragma unroll
    for (int c = 0; c < 4; ++c)
      *(uint2*)(op + 32 * dt + 8 * c) = make_uint2(pack_bf2(o[dt][4 * c] * linv, o[dt][4 * c + 1] * linv),
                                                    pack_bf2(o[dt][4 * c + 2] * linv, o[dt][4 * c + 3] * linv));
}

DI int t5_bucket(int n) {
  if (n < 16) return n;
  int lg = 16 + (int)(logf((float)n / 16.f) / 4.852030263919617f * 16.f);
  return lg < 31 ? lg : 31;
}

DI void phase_attn_even(const Params& p, char* smem) {
  const int tid = TID(), wave = __builtin_amdgcn_readfirstlane(tid >> 6), bid = blockIdx.x, G = gridDim.x;
  const bf16_t* QK = (const bf16_t*)(p.ws + WS_QK);
  const bf16_t* VT = (const bf16_t*)(p.ws + WS_VT);
  bf16_t* ATT = (bf16_t*)(p.ws + WS_ATT);
  float* pieces = (float*)smem;
  float* tbl = (float*)(smem + 66048);
  const float lam = ((const float*)(p.ws + WS_MISC))[0];
  for (int item = bid; item < 3072; item += G) {
    const int g = item / 192; int rem = item - g * 192;
    const int qb = 15 - g;
    if (rem < 64) {
      const int b = rem >> 3, hh = rem & 7;
      const int q0 = qb * 128 + 32 * wave;
      const bf16_t* Qp = QK + (size_t)b * S_ * 4096 + hh * 128;
      f32x16 o[4]; float l;
      attn_wave<0>(Qp, 4096, Qp + 1024, 4096, VT + (size_t)(hh * 128) * T_ + b * S_, T_,
                   (const float*)(p.ws + WS_FCUM) + (size_t)(b * 8 + hh) * S_, nullptr, q0, o, l);
      attn_store_bf16(o, 1.f / l, ATT + (size_t)(b * S_ + q0) * D_ + hh * 128, D_);
    } else {
      rem -= 64;
      const int qt = 4 * qb + 3 - (rem >> 5);
      const int bh = rem & 31, b = bh >> 2, hh = bh & 3;
      const int q0 = qt * 32;
      for (int e = tid; e < 2080; e += NTHREADS) {
        const int dist = e - 32;
        tbl[e] = dist >= 0 ? p.rel_bias[t5_bucket(dist) * 16 + hh] * LOG2E : -INFINITY;
      }
      __syncthreads();
      const int mm = wave >> 1, half = wave & 1;
      const bf16_t* Qp = QK + (size_t)b * S_ * 4096 + 2048 + hh * 256 + mm * 128;
      f32x16 o[4]; float l;
      attn_wave<1>(Qp, 4096, Qp + 1024, 4096, VT + (size_t)(1024 + hh * 256 + half * 128) * T_ + b * S_, T_,
                   nullptr, tbl, q0, o, l);
      {
        const int lane = tid & 63, r = lane & 31, h = lane >> 5;
        const float linv = 1.f / l;
        float* pw = pieces + (wave * 32 + r) * 129;
#pragma unroll
        for (int dt = 0; dt < 4; ++dt)
#pragma unroll
          for (int e = 0; e < 16; ++e) pw[32 * dt + crow(e, h)] = o[dt][e] * linv;
      }
      __syncthreads();
      {
        const int q = tid >> 3, d0 = (tid & 7) * 32;
        const int half2 = d0 >> 7, dl = d0 & 127;
        const float* p0 = pieces + ((0 * 2 + half2) * 32 + q) * 129 + dl;
        const float* p1 = pieces + ((1 * 2 + half2) * 32 + q) * 129 + dl;
        float val[32]; float ss = 0.f;
#pragma unroll
        for (int j = 0; j < 32; ++j) { val[j] = p0[j] - lam * p1[j]; ss += val[j] * val[j]; }
        ss += __shfl_xor(ss, 1); ss += __shfl_xor(ss, 2); ss += __shfl_xor(ss, 4);
        const float rstd = rsqrtf(ss * (1.f / 256.f) + 1e-6f) * 0.8f;
        const float* sg = p.even_diff_subln_gain + d0;
        bf16_t* op = ATT + (size_t)(b * S_ + q0 + q) * D_ + 1024 + hh * 256 + d0;
#pragma unroll
        for (int j = 0; j < 32; j += 8) {
          *(uint4*)(op + j) = make_uint4(pack_bf2(val[j] * rstd * sg[j], val[j + 1] * rstd * sg[j + 1]),
                                         pack_bf2(val[j + 2] * rstd * sg[j + 2], val[j + 3] * rstd * sg[j + 3]),
                                         pack_bf2(val[j + 4] * rstd * sg[j + 4], val[j + 5] * rstd * sg[j + 5]),
                                         pack_bf2(val[j + 6] * rstd * sg[j + 6], val[j + 7] * rstd * sg[j + 7]));
        }
      }
      __syncthreads();
    }
  }
}

DI void phase_attn_odd(const Params& p, char* smem) {
  const int tid = TID(), wave = __builtin_amdgcn_readfirstlane(tid >> 6), bid = blockIdx.x, G = gridDim.x;
  const bf16_t* QK = (const bf16_t*)(p.ws + WS_QK);
  const bf16_t* VT = (const bf16_t*)(p.ws + WS_VT);
  bf16_t* ATT = (bf16_t*)(p.ws + WS_ATT);
  float* tbl = (float*)(smem + 66048);
  int cur_head = -1;
  for (int item = bid; item < 2048; item += G) {
    const int g = item >> 7, rem = item & 127;
    const int qb = 15 - g, b = rem >> 4, hd = rem & 15;
    if (hd != cur_head) {
      __syncthreads();
      for (int e = tid; e < 2080; e += NTHREADS) {
        const int dist = e - 32;
        float val = -INFINITY;
        if (dist >= 0) {
          int cnt = 0;
          if (dist <= 128) cnt += 1;
          if (dist <= 512 && (dist & 3) == 0) cnt += 1;
          if ((dist & 15) == 0) cnt += 1;
          if (cnt > 0) val = (p.rel_bias[t5_bucket(dist) * 16 + hd] + __logf((float)cnt)) * LOG2E;
        }
        tbl[e] = val;
      }
      cur_head = hd;
      __syncthreads();
    }
    const int q0 = qb * 128 + 32 * wave;
    const bf16_t* Qp = QK + (size_t)b * S_ * 4096 + hd * 128;
    f32x16 o[4]; float l;
    attn_wave<1>(Qp, 4096, Qp + 2048, 4096, VT + (size_t)(hd * 128) * T_ + b * S_, T_, nullptr, tbl, q0, o, l);
    attn_store_bf16(o, 1.f / l, ATT + (size_t)(b * S_ + q0) * D_ + hd * 128, D_);
  }
}

DI unsigned fkey(float f) { const unsigned u = __float_as_uint(f); return (u & 0x80000000u) ? ~u : (u | 0x80000000u); }
DI int popc64(unsigned long long m) { return __popcll(m); }
DI int mbcnt(unsigned long long m) { return __builtin_amdgcn_mbcnt_hi((unsigned)(m >> 32), __builtin_amdgcn_mbcnt_lo((unsigned)m, 0)); }

template <int NV>
DI void select16(const unsigned (&key)[NV], bool (&sel)[NV], int (&pos)[NV]) {
  unsigned thr = 0;
#pragma unroll 1
  for (int bit = 31; bit >= 0; --bit) {
    const unsigned cand = thr | (1u << bit);
    int cnt = 0;
#pragma unroll
    for (int a = 0; a < NV; ++a) cnt += popc64(__ballot(key[a] >= cand));
    if (cnt >= 16) thr = cand;
  }
  int cgt = 0;
#pragma unroll
  for (int a = 0; a < NV; ++a) cgt += popc64(__ballot(key[a] > thr));
  const int need = 16 - cgt;
  int eqbase = 0, sbase = 0;
#pragma unroll
  for (int a = 0; a < NV; ++a) {
    const bool eq = key[a] == thr;
    const unsigned long long em = __ballot(eq);
    const bool s = (key[a] > thr) || (eq && (eqbase + mbcnt(em)) < need);
    eqbase += popc64(em);
    const unsigned long long sm = __ballot(s);
    sel[a] = s; pos[a] = sbase + mbcnt(sm);
    sbase += popc64(sm);
  }
}

DI float gelu_erf(float x) { return 0.5f * x * (1.f + erff(x * 0.7071067811865476f)); }

DI void phase_peer(const Params& p, int layer, const float* __restrict__ gate2  , char* smem) {
  const int tid = TID(), lane = tid & 63, wave = __builtin_amdgcn_readfirstlane(tid >> 6);
  const int gw = __builtin_amdgcn_readfirstlane((blockIdx.x * NTHREADS + tid) >> 6), nw = (gridDim.x * NTHREADS) >> 6;
  float* wl_s = (float*)(smem + wave * 2048);
  int* wl_i = (int*)(smem + wave * 2048 + 128);
  int* ex_i = (int*)(smem + wave * 2048 + 256);
  float* ex_g = (float*)(smem + wave * 2048 + 768);
  const float* SC = (const float*)(p.ws + WS_SC);
  const bf16_t* H = (const bf16_t*)(p.ws + WS_H);
  const unsigned char* PU = (const unsigned char*)(p.ws + WS_PEERU) + (size_t)layer * NEXP * D_;
  const unsigned char* PV = (const unsigned char*)(p.ws + WS_PEERV8) + (size_t)layer * NEXP * D_;
  const float* USC = (const float*)(p.ws + WS_PEERV) + (size_t)layer * NEXP;
  const float* VSC = (const float*)(p.ws + WS_PEERV) + (size_t)(2 + layer) * NEXP;
  for (int t = gw; t < T_; t += nw) {
#pragma unroll 1
    for (int hh = 0; hh < 8; ++hh) {
      const float* sr = SC + ((size_t)t * 8 + hh) * 256;
      float sv[4];
#pragma unroll
      for (int a = 0; a < 4; ++a) sv[a] = sr[a * 64 + lane];
#pragma unroll
      for (int pp = 0; pp < 2; ++pp) {
        unsigned key[2] = {fkey(sv[2 * pp]), fkey(sv[2 * pp + 1])};
        bool sel[2]; int pos[2];
        select16<2>(key, sel, pos);
#pragma unroll
        for (int a = 0; a < 2; ++a) if (sel[a]) { wl_s[pp * 16 + pos[a]] = sv[2 * pp + a]; wl_i[pp * 16 + pos[a]] = a * 64 + lane; }
      }
      const float sa = wl_s[lane >> 2];
      const int ia = wl_i[lane >> 2];
      float cs[4]; int ci[4]; unsigned key[4];
#pragma unroll
      for (int j = 0; j < 4; ++j) {
        cs[j] = sa + wl_s[16 + (lane & 3) * 4 + j];
        ci[j] = ia * 128 + wl_i[16 + (lane & 3) * 4 + j];
        key[j] = fkey(cs[j]);
      }
      bool sel[4]; int pos[4];
      select16<4>(key, sel, pos);
      float mx = -INFINITY;
#pragma unroll
      for (int j = 0; j < 4; ++j) if (sel[j]) mx = fmaxf(mx, cs[j]);
      mx = wave_max(mx);
      float e[4]; float es = 0.f;
#pragma unroll
      for (int j = 0; j < 4; ++j) { e[j] = sel[j] ? __expf(cs[j] - mx) : 0.f; es += e[j]; }
      es = wave_sum(es);
      const float inv = 1.f / es;
#pragma unroll
      for (int j = 0; j < 4; ++j) if (sel[j]) { ex_i[hh * 16 + pos[j]] = ci[j]; ex_g[hh * 16 + pos[j]] = e[j] * inv; }
    }
    float xf[32];
    {
      const bf16_t* hr = H + (size_t)t * D_ + lane * 16;
#pragma unroll
      for (int i = 0; i < 2; ++i)
#pragma unroll
        for (int hq = 0; hq < 2; ++hq) {
          const uint4 u = *(const uint4*)(hr + 1024 * i + 8 * hq);
          const unsigned w[4] = {u.x, u.y, u.z, u.w};
#pragma unroll
          for (int k = 0; k < 4; ++k) { xf[16 * i + 8 * hq + 2 * k] = bf_lo(w[k]); xf[16 * i + 8 * hq + 2 * k + 1] = bf_hi(w[k]); }
        }
    }
    float y[32];
#pragma unroll
    for (int j = 0; j < 32; ++j) y[j] = 0.f;
    uint4 ua[2][2], va[2][2], ub[2][2], vb[2][2];
    float sua[2], sva[2], sub_[2], svb[2];
#define PEER_LOAD(UR, VR, SU, SV, EB)                                                                   \
    _Pragma("unroll") for (int q = 0; q < 2; ++q) {                                                     \
      const int id = __builtin_amdgcn_readfirstlane(ex_i[(EB) + q]);                                   \
      const unsigned char* up = PU + (size_t)id * D_ + lane * 16;                                      \
      const unsigned char* vp = PV + (size_t)id * D_ + lane * 16;                                      \
      UR[q][0] = *(const uint4*)(up); UR[q][1] = *(const uint4*)(up + 1024);                           \
      VR[q][0] = *(const uint4*)(vp); VR[q][1] = *(const uint4*)(vp + 1024);                           \
      SU[q] = USC[id]; SV[q] = VSC[id];                                                                 \
    }
#define PEER_COMPUTE(UR, VR, SU, SV, EB)                                                                \
    {                                                                                                   \
      float dq[2];                                                                                      \
      _Pragma("unroll") for (int q = 0; q < 2; ++q) {                                                   \
        float a0 = 0.f, a1 = 0.f;                                                                       \
        _Pragma("unroll") for (int i = 0; i < 2; ++i) {                                                 \
          const unsigned w[4] = {UR[q][i].x, UR[q][i].y, UR[q][i].z, UR[q][i].w};                      \
          _Pragma("unroll") for (int k = 0; k < 4; ++k) {                                               \
            const f2_t lo = __builtin_amdgcn_cvt_pk_f32_fp8((int)w[k], false);                         \
            const f2_t hi = __builtin_amdgcn_cvt_pk_f32_fp8((int)w[k], true);                          \
            a0 += lo.x * xf[16 * i + 4 * k] + hi.x * xf[16 * i + 4 * k + 2];                            \
            a1 += lo.y * xf[16 * i + 4 * k + 1] + hi.y * xf[16 * i + 4 * k + 3];                        \
          }                                                                                             \
        }                                                                                               \
        dq[q] = a0 + a1;                                                                                \
      }                                                                                                 \
                            \
      const bool hb = lane >= 32;                                                                       \
      float kk = hb ? dq[1] : dq[0];                                                                    \
      const float ss = hb ? dq[0] : dq[1];                                                              \
      kk += __shfl_xor(ss, 32);                                                                         \
      kk += __shfl_xor(kk, 16); kk += __shfl_xor(kk, 8); kk += __shfl_xor(kk, 4); kk += __shfl_xor(kk, 2); kk += __shfl_xor(kk, 1); \
      const float cfl = (hb ? ex_g[(EB) + 1] : ex_g[(EB)]) * gelu_erf(kk * (hb ? SU[1] : SU[0])) * (hb ? SV[1] : SV[0]); \
      _Pragma("unroll") for (int q = 0; q < 2; ++q) {                                                   \
        const float cf = __builtin_bit_cast(float, __builtin_amdgcn_readlane(__builtin_bit_cast(int, cfl), 32 * q)); \
        _Pragma("unroll") for (int i = 0; i < 2; ++i) {                                                 \
          const unsigned w[4] = {VR[q][i].x, VR[q][i].y, VR[q][i].z, VR[q][i].w};                      \
          _Pragma("unroll") for (int k = 0; k < 4; ++k) {                                               \
            const f2_t lo = __builtin_amdgcn_cvt_pk_f32_fp8((int)w[k], false);                         \
            const f2_t hi = __builtin_amdgcn_cvt_pk_f32_fp8((int)w[k], true);                          \
            y[16 * i + 4 * k] += cf * lo.x; y[16 * i + 4 * k + 1] += cf * lo.y;                          \
            y[16 * i + 4 * k + 2] += cf * hi.x; y[16 * i + 4 * k + 3] += cf * hi.y;                      \
          }                                                                                             \
        }                                                                                               \
      }                                                                                                 \
    }
    PEER_LOAD(ua, va, sua, sva, 0)
#pragma unroll 1
    for (int eb = 0; eb < 128; eb += 4) {
      PEER_LOAD(ub, vb, sub_, svb, eb + 2)
      PEER_COMPUTE(ua, va, sua, sva, eb)
      if (eb + 4 < 128) { PEER_LOAD(ua, va, sua, sva, eb + 4) }
      PEER_COMPUTE(ub, vb, sub_, svb, eb + 2)
    }
#undef PEER_LOAD
#undef PEER_COMPUTE
    {
      const int b = t >> 11;
      float* orow = p.out + (size_t)t * D_ + lane * 16;
      const float* grow = gate2 + (size_t)b * 12288 + lane * 16;
#pragma unroll
      for (int i = 0; i < 2; ++i)
#pragma unroll
        for (int j = 0; j < 4; ++j) {
          float4 a0 = *(const float4*)(orow + 1024 * i + 4 * j);
          const float4 g0 = *(const float4*)(grow + 1024 * i + 4 * j);
          a0.x += g0.x * y[16 * i + 4 * j]; a0.y += g0.y * y[16 * i + 4 * j + 1];
          a0.z += g0.z * y[16 * i + 4 * j + 2]; a0.w += g0.w * y[16 * i + 4 * j + 3];
          *(float4*)(orow + 1024 * i + 4 * j) = a0;
        }
    }
  }
}

DI void phase_peer_scores(const Params& p, int layer, char* smem) {
  const bf16_t* QP = (const bf16_t*)(p.ws + WS_QK);
  const bf16_t* SK = (const bf16_t*)(p.ws + WS_SK) + (size_t)layer * 2 * 128 * 128;
  EpiArgs ea{}; ea.out = nullptr; ea.ldc = 256;
  for (int L = blockIdx.x; L < 2048; L += gridDim.x) {
    const int pp = L & 1, tm = L >> 1;
    f32x16 acc[2][2];
    gemm_tile_compute(QP + (size_t)tm * 128 * 256 + pp * 128, 256, SK + (size_t)pp * 128 * 128, 128, 128, smem, acc);
    ea.out = (float*)(p.ws + WS_SC) + pp * 128;
    gemm_epilogue<EPI_F32>(acc, tm * 128, 0, 0, ea, smem);
  }
}


#define XB_TMO      128
#define XB_XCNT(j)  (256  + 64 * (j))
#define XB_XSUB(j)  (1280 + 64 * (j))
#define XB_XGEN(j)  (2304 + 64 * (j))
#define XB_TOP      3328
#define XB_TOPGEN   3392
#define XCD_BAR_WORDS 3456
#define XB_SPIN_CAP (1u << 22)
#define LAS __attribute__((address_space(3)))
DI unsigned xb_ld(unsigned* p) { return __hip_atomic_load(p, __ATOMIC_RELAXED, __HIP_MEMORY_SCOPE_AGENT); }
DI unsigned xb_add(unsigned* p, unsigned v) { return __hip_atomic_fetch_add(p, v, __ATOMIC_RELAXED, __HIP_MEMORY_SCOPE_AGENT); }
DI unsigned xb_xcc_id() { return (unsigned)__builtin_amdgcn_s_getreg((3 << 11) | 20) & 0xFu; }
#define XB_SPIN(cond, bar) do { unsigned _sp = 0; while (cond) { __builtin_amdgcn_s_sleep(1); \
    if ((++_sp & 255u) == 0u) { if (xb_ld(&(bar)[XB_TMO])) break; if (_sp > XB_SPIN_CAP) { atomicAdd(&(bar)[XB_TMO], 1u); break; } } } } while (0)
struct XcdBarrier { unsigned* bar; unsigned x; volatile LAS unsigned* st; };
DI XcdBarrier xcd_barrier_post(unsigned* bar, volatile LAS unsigned* st) {
  XcdBarrier b; b.bar = bar; b.x = xb_xcc_id(); b.st = st;
  if (threadIdx.x == 0) (void)xb_add(&bar[XB_XCNT(b.x)], 1u);
  return b;
}
DI void xcd_barrier_complete(unsigned* bar, unsigned x, unsigned& nloc, unsigned& nx) {
  const unsigned G = gridDim.x * gridDim.y * gridDim.z;
  unsigned sum, cnt, mine, sp = 0u;
  for (;;) {
    sum = 0u; cnt = 0u; mine = 0u;
#pragma unroll
    for (unsigned j = 0; j < 16; ++j) { const unsigned c = xb_ld(&bar[XB_XCNT(j)]); sum += c; cnt += (c > 0u) ? 1u : 0u; mine = (j == x) ? c : mine; }
    if (sum == G) break;
    __builtin_amdgcn_s_sleep(1);
    if ((++sp & 255u) == 0u) { if (xb_ld(&bar[XB_TMO])) break; if (sp > XB_SPIN_CAP) { atomicAdd(&bar[XB_TMO], 1u); break; } }
  }
  nloc = mine > 0u ? mine : 1u; nx = cnt > 0u ? cnt : 1u;
}
DI void xcd_barrier(const XcdBarrier& b) {
  asm volatile("s_waitcnt vmcnt(0)" ::: "memory");
  __syncthreads();
  if (threadIdx.x == 0) {
    unsigned* bar = b.bar;
    __builtin_amdgcn_s_waitcnt(0);
    unsigned nloc = b.st[0], nx = b.st[1];
    if (nloc == 0u) { xcd_barrier_complete(bar, b.x, nloc, nx); b.st[0] = nloc; b.st[1] = nx; }
    const unsigned old = xb_add(&bar[XB_XSUB(b.x)], 1u);
    const unsigned gen = old / nloc;
    if (old + 1u == (gen + 1u) * nloc) {
      __builtin_amdgcn_fence(__ATOMIC_RELEASE, "agent");
      asm volatile("s_waitcnt vmcnt(0)" ::: "memory");
      const unsigned og = xb_add(&bar[XB_TOP], 1u);
      const unsigned tg = og / nx;
      if (og + 1u == (tg + 1u) * nx) xb_add(&bar[XB_TOPGEN], 1u);
      else XB_SPIN(xb_ld(&bar[XB_TOPGEN]) == tg, bar);
      __builtin_amdgcn_fence(__ATOMIC_ACQUIRE, "agent");
      xb_add(&bar[XB_XGEN(b.x)], 1u);
      asm volatile("s_waitcnt vmcnt(0)" ::: "memory");
    } else {
      XB_SPIN(xb_ld(&bar[XB_XGEN(b.x)]) == gen, bar);
      __builtin_amdgcn_fence(__ATOMIC_ACQUIRE, "agent");
      asm volatile("s_waitcnt vmcnt(0)" ::: "memory");
    }
  }
  __syncthreads();
}

constexpr int N_PHASES = 17;
DI void run_phase(const Params& p, int ph, char* smem) {
  char* ws = p.ws;
  const float* mod = (const float*)(ws + WS_MOD);
  const bf16_t* H = (const bf16_t*)(ws + WS_H);
  if (ph == 0) { phase_prep(p, smem); return; }
  const int layer = (ph - 1) >> 3, sub = (ph - 1) & 7;
  const float* modl = mod + (size_t)layer * 8 * 12288;
  switch (sub) {
    case 0:
      if (layer == 0) phase_norm<true>(p, p.x, p.norm_gain, modl, modl + 2048);
      else phase_norm<false>(p, p.out, p.norm_gain + 2 * 2048, modl, modl + 2048);
      break;
    case 1: {
      if (layer == 0) fox_cumsum(p);
      EpiArgs ea{}; ea.out = ws + WS_QK; ea.ldc = 4096;
      if (layer == 0) {
        ea.gainA = p.even_fox_qk_gain; ea.gainB = p.even_diff_qk_gain; ea.gshift = 3;
      } else { ea.gainA = p.odd_qk_gain; ea.gainB = p.odd_qk_gain; ea.gshift = 4; }
      gemm_phase<EPI_NORM_BF16>(H, 2048, (const bf16_t*)(ws + (layer ? WS_WQK1 : WS_WQK0)), 2048, 2048, 128, 32, ea, smem);
      EpiArgs ev{}; ev.out = ws + WS_VT; ev.ldc = T_;
      gemm_phase<EPI_BF16>((const bf16_t*)(ws + (layer ? WS_WV1 : WS_WV0)), 2048, H, 2048, 2048, 16, 128, ev, smem);
    } break;
    case 2:
      if (layer == 0) phase_attn_even(p, smem); else phase_attn_odd(p, smem);
      break;
    case 3: {
      EpiArgs ea{}; ea.out = p.out; ea.ldc = 2048; ea.xin = layer ? p.out : p.x; ea.gate = modl + 2 * 2048;
      gemm_phase<EPI_RES_F32>((const bf16_t*)(ws + WS_ATT), 2048, (const bf16_t*)(ws + (layer ? WS_WO1 : WS_WO0)), 2048, 2048, 128, 16, ea, smem);
    } break;
    case 4:
      phase_norm<false>(p, p.out, p.norm_gain + (layer * 2 + 1) * 2048, modl + 3 * 2048, modl + 4 * 2048);
      break;
    case 5: {
      EpiArgs ea{}; ea.out = ws + WS_QK; ea.ldc = 2048;
      gemm_phase<EPI_BF16>(H, 2048, (const bf16_t*)(ws + (layer ? WS_WQ1 : WS_WQ0)), 2048, 2048, 128, 16, ea, smem);
    } break;
    case 6: phase_peer_scores(p, layer, smem); break;
    case 7: phase_peer(p, layer, modl + 5 * 2048, smem); break;
  }
}

#if FUSED
__global__ void __launch_bounds__(NTHREADS, 2) mega_kernel(Params p) {
  extern __shared__ __attribute__((aligned(16))) char smem[];
  cg::grid_group grid = cg::this_grid();
  volatile LAS unsigned* xst = (volatile LAS unsigned*)(smem + SMEM_BYTES - 16);
  if (threadIdx.x == 0) { xst[0] = 0u; xst[1] = 0u; }
  __syncthreads();
  const XcdBarrier xb = xcd_barrier_post((unsigned*)(p.ws + WS_BAR), xst);
#pragma unroll
  for (int ph = 0; ph < N_PHASES; ++ph) {
    run_phase(p, ph, smem);
    if (ph == 0) grid.sync();
    else if (ph + 1 < N_PHASES) xcd_barrier(xb);
  }
}
#else
template <int PH>
__global__ void __launch_bounds__(NTHREADS, 2) phase_kernel(Params p) {
  extern __shared__ __attribute__((aligned(16))) char smem[];
  run_phase(p, PH, smem);
}
template <int PH>
static void launch_phases(const Params& p, int grid, hipStream_t stream) {
  if constexpr (PH < N_PHASES) {
    (void)hipFuncSetAttribute((const void*)phase_kernel<PH>, hipFuncAttributeMaxDynamicSharedMemorySize, SMEM_BYTES);
    phase_kernel<PH><<<grid, NTHREADS, SMEM_BYTES, stream>>>(p);
    launch_phases<PH + 1>(p, grid, stream);
  }
}
#endif

extern "C" void kernel_launch(void* const* d_in, const int* in_sizes, int n_in, void* d_out, int out_size, void* d_ws,
                              size_t ws_size, hipStream_t stream) {
  Params p{};
  p.x = (const float*)d_in[0]; p.c = (const float*)d_in[1]; p.rel_bias = (const float*)d_in[2];
  p.norm_gain = (const float*)d_in[3]; p.w_ada = (const float*)d_in[4]; p.b_ada = (const float*)d_in[5];
  p.even_w_in = (const float*)d_in[6]; p.even_b_forget = (const float*)d_in[7]; p.even_fox_qk_gain = (const float*)d_in[8];
  p.even_diff_qk_gain = (const float*)d_in[9]; p.even_diff_lambda = (const float*)d_in[10];
  p.even_diff_subln_gain = (const float*)d_in[11]; p.even_w_out = (const float*)d_in[12];
  p.odd_w_qkv = (const float*)d_in[13]; p.odd_qk_gain = (const float*)d_in[14]; p.odd_w_out = (const float*)d_in[15];
  p.peer_w_query = (const float*)d_in[16]; p.peer_sub_keys = (const float*)d_in[17];
  p.peer_u = (const float*)d_in[18]; p.peer_v = (const float*)d_in[19];
  p.out = (float*)d_out; p.ws = (char*)d_ws;
  if (ws_size < WS_END) { fprintf(stderr, "workspace too small: %zu < %zu\n", ws_size, (size_t)WS_END); return; }
#if FUSED
  static int grid_blocks = 0;
  if (!grid_blocks) {
    int dev = 0, cus = 0, per_cu = 0;
    (void)hipGetDevice(&dev);
    (void)hipDeviceGetAttribute(&cus, hipDeviceAttributeMultiprocessorCount, dev);
    (void)hipFuncSetAttribute((const void*)mega_kernel, hipFuncAttributeMaxDynamicSharedMemorySize, SMEM_BYTES);
    (void)hipOccupancyMaxActiveBlocksPerMultiprocessor(&per_cu, mega_kernel, NTHREADS, SMEM_BYTES);
    if (per_cu > 2) per_cu = 2;
    grid_blocks = cus * per_cu;
  }
  (void)hipMemsetAsync(p.ws + WS_BAR, 0, XCD_BAR_WORDS * 4, stream);
  void* args[] = {&p};
  hipError_t e = hipLaunchCooperativeKernel((void*)mega_kernel, dim3(grid_blocks), dim3(NTHREADS), args, SMEM_BYTES, stream);
  if (e != hipSuccess) fprintf(stderr, "cooperative launch failed: %s (grid %d)\n", hipGetErrorString(e), grid_blocks);
#else
  launch_phases<0>(p, 512, stream);
#endif
}
```

```cpp
#include <hip/hip_runtime.h>
#include <hip/hip_cooperative_groups.h>
#include <stdint.h>
#include <stdio.h>
namespace cg = cooperative_groups;

#ifndef FUSED
#define FUSED 1
#endif

#define DI __device__ __forceinline__
typedef unsigned short bf16_t;
typedef __attribute__((ext_vector_type(8))) short bf16x8;
typedef __attribute__((ext_vector_type(4))) short bf16x4;
typedef __attribute__((ext_vector_type(16))) float f32x16;
typedef __attribute__((ext_vector_type(2))) __bf16 bf2_t;
typedef __attribute__((ext_vector_type(2))) float f2_t;
typedef __attribute__((ext_vector_type(4))) unsigned u32x4;
#define MFMA32(a, b, c) __builtin_amdgcn_mfma_f32_32x32x16_bf16((a), (b), (c), 0, 0, 0)

constexpr int T_ = 16384;
constexpr int D_ = 2048;
constexpr int S_ = 2048;
constexpr int NB_ = 8;
constexpr int NEXP = 16384;
constexpr float LOG2E = 1.4426950408889634f;
constexpr int NTHREADS = 256;
constexpr int SMEM_BYTES = 75776 + 16;

constexpr size_t MiB = 1048576;
constexpr size_t WS_PEERU = 0;
constexpr size_t WS_PEERV8 = WS_PEERU + 64 * MiB;
constexpr size_t WS_PEERV = WS_PEERU + 128 * MiB;
constexpr size_t WS_WQK0 = WS_PEERV + 128 * MiB;
constexpr size_t WS_WV0 = WS_WQK0 + 16 * MiB;
constexpr size_t WS_WQK1 = WS_WV0 + 8 * MiB;
constexpr size_t WS_WV1 = WS_WQK1 + 16 * MiB;
constexpr size_t WS_WO0 = WS_WV1 + 8 * MiB;
constexpr size_t WS_WO1 = WS_WO0 + 8 * MiB;
constexpr size_t WS_WQ0 = WS_WO1 + 8 * MiB;
constexpr size_t WS_WQ1 = WS_WQ0 + 8 * MiB;
constexpr size_t WS_SK = WS_WQ1 + 8 * MiB;
constexpr size_t WS_WFF = WS_SK + 131072;
constexpr size_t WS_MOD = WS_WFF + 65536;
constexpr size_t WS_LOGF = WS_MOD + 786432;
constexpr size_t WS_FCUM = WS_LOGF + 524288;
constexpr size_t WS_MISC = WS_FCUM + 524288;
constexpr size_t WS_H = WS_MISC + 65536;
constexpr size_t WS_QK = WS_H + 64 * MiB;
constexpr size_t WS_VT = WS_QK + 128 * MiB;
constexpr size_t WS_ATT = WS_VT + 64 * MiB;
constexpr size_t WS_SC = WS_ATT + 64 * MiB;
constexpr size_t WS_BAR = WS_SC + 128 * MiB;
constexpr size_t WS_END = WS_BAR + 65536;

struct Params {
  const float* x; const float* c; const float* rel_bias; const float* norm_gain; const float* w_ada; const float* b_ada;
  const float* even_w_in; const float* even_b_forget; const float* even_fox_qk_gain; const float* even_diff_qk_gain;
  const float* even_diff_lambda; const float* even_diff_subln_gain; const float* even_w_out;
  const float* odd_w_qkv; const float* odd_qk_gain; const float* odd_w_out;
  const float* peer_w_query; const float* peer_sub_keys; const float* peer_u; const float* peer_v;
  float* out; char* ws;
};

DI unsigned pack_bf2(float a, float b) { f2_t v = {a, b}; return __builtin_bit_cast(unsigned, __builtin_convertvector(v, bf2_t)); }
DI bf16_t f2bf(float a) { return (bf16_t)(pack_bf2(a, 0.f) & 0xffffu); }
DI float bf_lo(unsigned u) { return __uint_as_float(u << 16); }
DI float bf_hi(unsigned u) { return __uint_as_float(u & 0xffff0000u); }
DI int TID() { int t = threadIdx.x; asm volatile("" : "+v"(t)); return t; }
DI int crow(int reg, int h) { return (reg & 3) + 8 * (reg >> 2) + 4 * h; }
DI float wave_sum(float v) {
#pragma unroll
  for (int o = 32; o >= 1; o >>= 1) v += __shfl_xor(v, o);
  return v;
}
DI float wave_max(float v) {
#pragma unroll
  for (int o = 32; o >= 1; o >>= 1) v = fmaxf(v, __shfl_xor(v, o));
  return v;
}

DI void transpose_tile(const float* __restrict__ src, int ld, int c0, int k0, bf16_t* __restrict__ dst_row0, char* smem) {
  float* tile = (float*)smem;
  const int tid = TID();
  const int ty = tid >> 4, tx = tid & 15;
#pragma unroll
  for (int i = 0; i < 4; ++i) {
    const int k = ty + 16 * i;
    const float4 v = *(const float4*)(src + (size_t)(k0 + k) * ld + c0 + 4 * tx);
    float* t = tile + k * 65 + 4 * tx;
    t[0] = v.x; t[1] = v.y; t[2] = v.z; t[3] = v.w;
  }
  __syncthreads();
  const int cc = tid >> 2, kc = (tid & 3) * 16;
  unsigned pk[8];
#pragma unroll
  for (int j = 0; j < 8; ++j) pk[j] = pack_bf2(tile[(kc + 2 * j) * 65 + cc], tile[(kc + 2 * j + 1) * 65 + cc]);
  uint4* d = (uint4*)(dst_row0 + (size_t)cc * 2048 + k0 + kc);
  d[0] = make_uint4(pk[0], pk[1], pk[2], pk[3]);
  d[1] = make_uint4(pk[4], pk[5], pk[6], pk[7]);
  __syncthreads();
}

DI void phase_prep(const Params& p, char* smem) {
  const int tid = TID(), bid = blockIdx.x, G = gridDim.x;
  char* ws = p.ws;
  {
    float* cond = (float*)smem;
    bool have_cond = false;
    for (int item = bid; item < 384; item += G) {
      if (!have_cond) {
        for (int e = tid; e < NB_ * D_; e += NTHREADS) {
          const int b = e >> 11, d = e & 2047;
          const float v = p.c[e];
          cond[d * 8 + b] = v / (1.f + __expf(-v));
        }
        have_cond = true;
        __syncthreads();
      }
      const int i = item / 192, n = (item % 192) * 64 + (tid & 63);
      const int w = tid >> 6;
      const float* wp = p.w_ada + (size_t)i * D_ * 12288 + n;
      float acc[8];
#pragma unroll
      for (int b = 0; b < 8; ++b) acc[b] = 0.f;
#pragma unroll 8
      for (int d = w; d < D_; d += 4) {
        const float wv = wp[(size_t)d * 12288];
        const float4 c0 = *(const float4*)(cond + d * 8), c1 = *(const float4*)(cond + d * 8 + 4);
        acc[0] += c0.x * wv; acc[1] += c0.y * wv; acc[2] += c0.z * wv; acc[3] += c0.w * wv;
        acc[4] += c1.x * wv; acc[5] += c1.y * wv; acc[6] += c1.z * wv; acc[7] += c1.w * wv;
      }
      float* red = (float*)(smem + 65536);
#pragma unroll
      for (int b = 0; b < 8; ++b) red[(w * 64 + (tid & 63)) * 8 + b] = acc[b];
      __syncthreads();
      if (tid < 64) {
        float* mod = (float*)(ws + WS_MOD);
#pragma unroll
        for (int b = 0; b < 8; ++b) {
          const float s = red[(0 * 64 + tid) * 8 + b] + red[(1 * 64 + tid) * 8 + b] + red[(2 * 64 + tid) * 8 + b] + red[(3 * 64 + tid) * 8 + b];
          mod[((size_t)i * 8 + b) * 12288 + n] = s + p.b_ada[i * 12288 + n];
        }
      }
      __syncthreads();
    }
    __syncthreads();
  }
  {
    bf16_t* wqk0 = (bf16_t*)(ws + WS_WQK0); bf16_t* wv0 = (bf16_t*)(ws + WS_WV0);
    bf16_t* wqk1 = (bf16_t*)(ws + WS_WQK1); bf16_t* wv1 = (bf16_t*)(ws + WS_WV1);
    for (int item = bid; item < 320 * 32; item += G) {
      const int ct = item >> 5, kt = item & 31;
      const float* src; int ld, c0; bf16_t* dst;
      if (ct < 96) {
        const int seg = ct >> 4, cl = (ct & 15) * 64;
        src = p.even_w_in; ld = 6152;
        c0 = (seg < 3 ? seg * 1024 : 3080 + (seg - 3) * 1024) + cl;
        if (seg == 0) dst = wqk0 + (size_t)cl * 2048;
        else if (seg == 1) dst = wqk0 + (size_t)(1024 + cl) * 2048;
        else if (seg == 2) dst = wv0 + (size_t)cl * 2048;
        else if (seg == 3) dst = wqk0 + (size_t)(2048 + cl) * 2048;
        else if (seg == 4) dst = wqk0 + (size_t)(3072 + cl) * 2048;
        else dst = wv0 + (size_t)(1024 + cl) * 2048;
      } else if (ct < 192) {
        const int cl = (ct - 96) * 64;
        src = p.odd_w_qkv; ld = 6144; c0 = cl;
        dst = cl < 4096 ? wqk1 + (size_t)cl * 2048 : wv1 + (size_t)(cl - 4096) * 2048;
      } else {
        const int mi = (ct - 192) >> 5, cl = ((ct - 192) & 31) * 64;
        ld = 2048; c0 = cl;
        if (mi == 0) { src = p.even_w_out; dst = (bf16_t*)(ws + WS_WO0); }
        else if (mi == 1) { src = p.odd_w_out; dst = (bf16_t*)(ws + WS_WO1); }
        else if (mi == 2) { src = p.peer_w_query; dst = (bf16_t*)(ws + WS_WQ0); }
        else { src = p.peer_w_query + (size_t)2048 * 2048; dst = (bf16_t*)(ws + WS_WQ1); }
        dst += (size_t)cl * 2048;
      }
      transpose_tile(src, ld, c0, kt * 64, dst, smem);
    }
  }
  {
    const int lane = tid & 63;
    const int gw = __builtin_amdgcn_readfirstlane((bid * NTHREADS + tid) >> 6), nw = (G * NTHREADS) >> 6;
    float* scl = (float*)(ws + WS_PEERV);
    for (int row = gw; row < 4 * NEXP; row += nw) {
      const int tab = row >> 15, rr = row & 32767;
      const float* src = (tab ? p.peer_v : p.peer_u) + (size_t)rr * D_;
      unsigned char* dst = (unsigned char*)(ws + (tab ? WS_PEERV8 : WS_PEERU)) + (size_t)rr * D_;
      float4 v[8];
      float am = 0.f;
#pragma unroll
      for (int i = 0; i < 2; ++i)
#pragma unroll
        for (int j = 0; j < 4; ++j) {
          v[4 * i + j] = *(const float4*)(src + lane * 16 + 1024 * i + 4 * j);
          am = fmaxf(am, fmaxf(fmaxf(fabsf(v[4 * i + j].x), fabsf(v[4 * i + j].y)), fmaxf(fabsf(v[4 * i + j].z), fabsf(v[4 * i + j].w))));
        }
      am = wave_max(am);
      const float sc = am > 0.f ? 432.f / am : 1.f;
      if (lane == 0) scl[row] = am > 0.f ? am / 432.f : 1.f;
#pragma unroll
      for (int i = 0; i < 2; ++i) {
        unsigned w[4];
#pragma unroll
        for (int j = 0; j < 4; ++j) {
          int d = __builtin_amdgcn_cvt_pk_fp8_f32(v[4 * i + j].x * sc, v[4 * i + j].y * sc, 0, false);
          d = __builtin_amdgcn_cvt_pk_fp8_f32(v[4 * i + j].z * sc, v[4 * i + j].w * sc, d, true);
          w[j] = (unsigned)d;
        }
        *(uint4*)(dst + lane * 16 + 1024 * i) = make_uint4(w[0], w[1], w[2], w[3]);
      }
    }
    for (int item = bid; item < 32; item += G) {
      const size_t off = (size_t)item * 2048;
      const float4 a = *(const float4*)(p.peer_sub_keys + off + tid * 8), b = *(const float4*)(p.peer_sub_keys + off + tid * 8 + 4);
      *(uint4*)((bf16_t*)(ws + WS_SK) + off + tid * 8) = make_uint4(pack_bf2(a.x, a.y), pack_bf2(a.z, a.w), pack_bf2(b.x, b.y), pack_bf2(b.z, b.w));
    }
  }
  if (bid == G - 1) {
    float* wff = (float*)(ws + WS_WFF);
    for (int e = tid; e < 2048 * 8; e += NTHREADS) wff[e] = p.even_w_in[(size_t)(e >> 3) * 6152 + 3072 + (e & 7)];
    if (tid < 64) {
      const float* l = p.even_diff_lambda;
      float s1 = l[tid] * l[128 + tid] + l[64 + tid] * l[128 + 64 + tid];
      float s2 = l[256 + tid] * l[384 + tid] + l[256 + 64 + tid] * l[384 + 64 + tid];
      s1 = wave_sum(s1); s2 = wave_sum(s2);
      if (tid == 0) ((float*)(ws + WS_MISC))[0] = expf(s1) - expf(s2) + 0.2f;
    }
  }
}

template <bool FF>
DI void phase_norm(const Params& p, const float* __restrict__ xin, const float* __restrict__ gain,
                   const float* __restrict__ sh, const float* __restrict__ sc  ) {
  const int lane = TID() & 63;
  const int gw = __builtin_amdgcn_readfirstlane((blockIdx.x * NTHREADS + TID()) >> 6), nw = (gridDim.x * NTHREADS) >> 6;
  bf16_t* H = (bf16_t*)(p.ws + WS_H);
  for (int t = gw; t < T_; t += nw) {
    const int b = t >> 11;
    const float* xr = xin + (size_t)t * D_;
    float4 v[8];
    float ss = 0.f;
#pragma unroll
    for (int i = 0; i < 8; ++i) { v[i] = *(const float4*)(xr + lane * 4 + 256 * i); ss += v[i].x * v[i].x + v[i].y * v[i].y + v[i].z * v[i].z + v[i].w * v[i].w; }
    ss = wave_sum(ss);
    const float rstd = rsqrtf(ss * (1.f / 2048.f) + 1e-6f);
    float ff[8];
    if (FF) {
#pragma unroll
      for (int j = 0; j < 8; ++j) ff[j] = 0.f;
    }
#pragma unroll
    for (int i = 0; i < 8; ++i) {
      const int c = lane * 4 + 256 * i;
      const float4 g = *(const float4*)(gain + c);
      const float4 s1 = *(const float4*)(sc + (size_t)b * 12288 + c);
      const float4 s0 = *(const float4*)(sh + (size_t)b * 12288 + c);
      float4 h;
      h.x = v[i].x * rstd * g.x * (1.f + s1.x) + s0.x;
      h.y = v[i].y * rstd * g.y * (1.f + s1.y) + s0.y;
      h.z = v[i].z * rstd * g.z * (1.f + s1.z) + s0.z;
      h.w = v[i].w * rstd * g.w * (1.f + s1.w) + s0.w;
      *(uint2*)(H + (size_t)t * D_ + c) = make_uint2(pack_bf2(h.x, h.y), pack_bf2(h.z, h.w));
      if (FF) {
        const float* wff = (const float*)(p.ws + WS_WFF) + c * 8;
        const float hv[4] = {h.x, h.y, h.z, h.w};
#pragma unroll
        for (int e = 0; e < 4; ++e) {
          const float4 w0 = *(const float4*)(wff + e * 8), w1 = *(const float4*)(wff + e * 8 + 4);
          ff[0] += hv[e] * w0.x; ff[1] += hv[e] * w0.y; ff[2] += hv[e] * w0.z; ff[3] += hv[e] * w0.w;
          ff[4] += hv[e] * w1.x; ff[5] += hv[e] * w1.y; ff[6] += hv[e] * w1.z; ff[7] += hv[e] * w1.w;
        }
      }
    }
    if (FF) {
#pragma unroll
      for (int j = 0; j < 8; ++j) ff[j] = wave_sum(ff[j]);
      if (lane < 8) {
        float z = ff[0];
#pragma unroll
        for (int j = 1; j < 8; ++j) z = (lane == j) ? ff[j] : z;
        z += p.even_b_forget[lane];
        const float lf = fminf(z, 0.f) - log1pf(__expf(-fabsf(z)));
        ((float*)(p.ws + WS_LOGF))[(size_t)t * 8 + lane] = lf;
      }
    }
  }
}

DI void fox_cumsum(const Params& p) {
  const int lane = TID() & 63;
  const int gw = __builtin_amdgcn_readfirstlane((blockIdx.x * NTHREADS + TID()) >> 6), nw = (gridDim.x * NTHREADS) >> 6;
  const float* lf = (const float*)(p.ws + WS_LOGF);
  float* fc = (float*)(p.ws + WS_FCUM);
  for (int it = gw; it < 64; it += nw) {
    const int b = it >> 3, hh = it & 7;
    float v[32];
    float tot = 0.f;
#pragma unroll
    for (int j = 0; j < 32; ++j) { tot += lf[(size_t)(b * S_ + lane * 32 + j) * 8 + hh]; v[j] = tot; }
    float inc = tot;
#pragma unroll
    for (int o = 1; o < 64; o <<= 1) { const float n = __shfl_up(inc, o); if (lane >= o) inc += n; }
    const float base = inc - tot;
#pragma unroll
    for (int j = 0; j < 32; ++j) fc[(size_t)it * S_ + lane * 32 + j] = v[j] + base;
  }
}

DI void gemm_tile_compute(const bf16_t* A, int lda, const bf16_t* B, int ldb, int K,
                          char* smem, f32x16 (&acc)[2][2]) {
  const int tid = TID(), lane = tid & 63, wave = __builtin_amdgcn_readfirstlane(tid >> 6);
  const int r = lane & 31, h = lane >> 5;
  const int wm = wave >> 1, wn = wave & 1;
  const int srow = tid >> 3, sc = tid & 7;
  const char* Ab = (const char*)A;
  const char* Bb = (const char*)B;
  const unsigned voa = (unsigned)(srow * lda + sc * 8) * 2u;
  const unsigned vob = (unsigned)(srow * ldb + sc * 8) * 2u;
  const unsigned sta = (unsigned)(32 * lda) * 2u, stb = (unsigned)(32 * ldb) * 2u;
  u32x4 ra[4], rb[4];
#pragma unroll
  for (int i = 0; i < 4; ++i) {
    ra[i] = *(const u32x4*)(Ab + (size_t)(i * sta) + voa);
    rb[i] = *(const u32x4*)(Bb + (size_t)(i * stb) + vob);
  }
  const int woff = srow * 128 + ((sc ^ ((srow >> 1) & 7)) << 4);
  const int rsw = (r >> 1) & 7;
  const int aoff = (wm * 64 + r) * 128, boff = 16384 + (wn * 64 + r) * 128;
#pragma unroll
  for (int i = 0; i < 2; ++i)
#pragma unroll
    for (int j = 0; j < 2; ++j)
#pragma unroll
      for (int e = 0; e < 16; ++e) acc[i][j][e] = 0.f;
#pragma unroll
  for (int i = 0; i < 4; ++i) {
    *(u32x4*)(smem + woff + i * 4096) = ra[i];
    *(u32x4*)(smem + 16384 + woff + i * 4096) = rb[i];
  }
  __syncthreads();
  const int KT = K >> 6;
  for (int kt = 0; kt < KT; ++kt) {
    char* st = smem + (kt & 1) * 32768;
    {
      const size_t kn = (size_t)((kt + 1 < KT ? kt + 1 : kt) * 128);
#pragma unroll
      for (int i = 0; i < 4; ++i) {
        ra[i] = *(const u32x4*)(Ab + (kn + i * sta) + voa);
        rb[i] = *(const u32x4*)(Bb + (kn + i * stb) + vob);
      }
    }
    asm volatile("" ::: "memory");
    __builtin_amdgcn_sched_barrier(0);
#pragma unroll
    for (int s = 0; s < 4; ++s) {
      const int co = ((2 * s + h) ^ rsw) << 4;
      bf16x8 af[2], bfr[2];
      af[0] = *(const bf16x8*)(st + aoff + co);
      af[1] = *(const bf16x8*)(st + aoff + 32 * 128 + co);
      bfr[0] = *(const bf16x8*)(st + boff + co);
      bfr[1] = *(const bf16x8*)(st + boff + 32 * 128 + co);
#pragma unroll
      for (int i = 0; i < 2; ++i)
#pragma unroll
        for (int j = 0; j < 2; ++j) acc[i][j] = MFMA32(af[i], bfr[j], acc[i][j]);
    }
    __builtin_amdgcn_sched_barrier(0);
    asm volatile("" ::: "memory");
    {
      char* sn = smem + ((kt + 1) & 1) * 32768;
#pragma unroll
      for (int i = 0; i < 4; ++i) {
        *(u32x4*)(sn + woff + i * 4096) = ra[i];
        *(u32x4*)(sn + 16384 + woff + i * 4096) = rb[i];
      }
    }
    __syncthreads();
  }
}

enum { EPI_BF16 = 0, EPI_NORM_BF16 = 1, EPI_RES_F32 = 2, EPI_F32 = 3 };
struct EpiArgs {
  void* out; int ldc;
  const float* gainA; const float* gainB; int gshift;
  const float* xin; const float* gate;
};

template <int EPI>
DI void gemm_epilogue(f32x16 (&acc)[2][2], int m0, int n0, int tn, const EpiArgs& ea, char* smem) {
  const int tid = TID(), lane = tid & 63, wave = __builtin_amdgcn_readfirstlane(tid >> 6);
  const int r = lane & 31, h = lane >> 5;
  const int wm = wave >> 1, wn = wave & 1;
  if (EPI == EPI_NORM_BF16) {
    float* red = (float*)smem;
    float ss[2][16];
#pragma unroll
    for (int i = 0; i < 2; ++i)
#pragma unroll
      for (int e = 0; e < 16; ++e) {
        float v = acc[i][0][e] * acc[i][0][e] + acc[i][1][e] * acc[i][1][e];
#pragma unroll
        for (int o = 16; o >= 1; o >>= 1) v += __shfl_xor(v, o);
        ss[i][e] = v;
      }
    if (r == 0) {
#pragma unroll
      for (int i = 0; i < 2; ++i)
#pragma unroll
        for (int e = 0; e < 16; ++e) red[wn * 128 + wm * 64 + i * 32 + crow(e, h)] = ss[i][e];
    }
    __syncthreads();
    const int grp = tn >> ea.gshift;
    const float* gain = ((grp & 2) ? ea.gainB : ea.gainA) + (grp & 1) * 128;
    bf16_t* out = (bf16_t*)ea.out;
#pragma unroll
    for (int i = 0; i < 2; ++i)
#pragma unroll
      for (int e = 0; e < 16; ++e) {
        const int rl = wm * 64 + i * 32 + crow(e, h);
        const float rstd = rsqrtf((red[rl] + red[128 + rl]) * (1.f / 128.f) + 1e-6f);
#pragma unroll
        for (int j = 0; j < 2; ++j) {
          const int cl = wn * 64 + j * 32 + r;
          out[(size_t)(m0 + rl) * ea.ldc + n0 + cl] = f2bf(acc[i][j][e] * rstd * gain[cl]);
        }
      }
    __syncthreads();
  } else {
#pragma unroll
    for (int i = 0; i < 2; ++i)
#pragma unroll
      for (int e = 0; e < 16; ++e) {
        const int row = m0 + wm * 64 + i * 32 + crow(e, h);
#pragma unroll
        for (int j = 0; j < 2; ++j) {
          const int col = n0 + wn * 64 + j * 32 + r;
          const float v = acc[i][j][e];
          if (EPI == EPI_BF16) ((bf16_t*)ea.out)[(size_t)row * ea.ldc + col] = f2bf(v);
          else if (EPI == EPI_F32) ((float*)ea.out)[(size_t)row * ea.ldc + col] = v;
          else {
            const float g = ea.gate[(size_t)(row >> 11) * 12288 + col];
            ((float*)ea.out)[(size_t)row * ea.ldc + col] = ea.xin[(size_t)row * ea.ldc + col] + g * v;
          }
        }
      }
  }
}

template <int EPI>
DI void gemm_phase(const bf16_t* A, int lda, const bf16_t* B, int ldb, int K, int mt, int nt, const EpiArgs& ea, char* smem) {
  const int bid = blockIdx.x, G = gridDim.x;
  const int xcd = bid & 7, slot = bid >> 3, nslots = G >> 3;
  const int nsn = nt >> 3, nsup = (mt >> 3) * nsn;
  const int cnt = (nsup - xcd + 7) >> 3;
  for (int j = slot; j < cnt * 64; j += nslots) {
    const int sup = xcd + 8 * (j >> 6), within = j & 63;
    const int sm = sup / nsn, sn = sup - sm * nsn;
    const int tm = sm * 8 + (within >> 3), tn = sn * 8 + (within & 7);
    f32x16 acc[2][2];
    gemm_tile_compute(A + (size_t)tm * 128 * lda, lda, B + (size_t)tn * 128 * ldb, ldb, K, smem, acc);
    gemm_epilogue<EPI>(acc, tm * 128, tn * 128, tn, ea, smem);
  }
}

template <int MODE>
DI void attn_wave(const bf16_t* Qp, int ldq, const bf16_t* Kp, int ldk,
                  const bf16_t* Vt, int ldv, const float* kbias, const float* tbl,
                  int q0, f32x16 (&o)[4], float& l_out) {
  const int lane = TID() & 63, r = lane & 31, h = lane >> 5;
  const float scale2 = 0.08838834764831845f * LOG2E;
  bf16x8 qf[8];
#pragma unroll
  for (int s = 0; s < 8; ++s) qf[s] = *(const bf16x8*)(Qp + (size_t)(q0 + r) * ldq + 16 * s + 8 * h);
#pragma unroll
  for (int dt = 0; dt < 4; ++dt)
#pragma unroll
    for (int e = 0; e < 16; ++e) o[dt][e] = 0.f;
  float m = -1e30f, l = 0.f;
  const int nkt = (q0 >> 5) + 1;
  bf16x8 kf[8];
#pragma unroll
  for (int s = 0; s < 8; ++s) kf[s] = *(const bf16x8*)(Kp + (size_t)r * ldk + 16 * s + 8 * h);
  for (int kt = 0; kt < nkt; ++kt) {
    const int k0 = kt << 5;
    bf16x4 vf[4][2][2];
#pragma unroll
    for (int dt = 0; dt < 4; ++dt)
#pragma unroll
      for (int s = 0; s < 2; ++s) {
        const bf16_t* vp = Vt + (size_t)(32 * dt + r) * ldv + k0 + 16 * s + 4 * h;
        vf[dt][s][0] = *(const bf16x4*)(vp);
        vf[dt][s][1] = *(const bf16x4*)(vp + 8);
      }
    f32x16 sa;
#pragma unroll
    for (int e = 0; e < 16; ++e) sa[e] = 0.f;
#pragma unroll
    for (int s = 0; s < 8; ++s) sa = MFMA32(kf[s], qf[s], sa);
    __builtin_amdgcn_sched_barrier(0);
    {
      const int kn = (kt + 1 < nkt) ? k0 + 32 : k0;
#pragma unroll
      for (int s = 0; s < 8; ++s) kf[s] = *(const bf16x8*)(Kp + (size_t)(kn + r) * ldk + 16 * s + 8 * h);
    }
    asm volatile("" ::: "memory");
    __builtin_amdgcn_sched_barrier(0);
    float v[16];
    if (MODE == 0) {
#pragma unroll
      for (int c = 0; c < 4; ++c) {
        const float4 kb = *(const float4*)(kbias + k0 + 8 * c + 4 * h);
        v[4 * c + 0] = sa[4 * c + 0] * scale2 - kb.x * LOG2E;
        v[4 * c + 1] = sa[4 * c + 1] * scale2 - kb.y * LOG2E;
        v[4 * c + 2] = sa[4 * c + 2] * scale2 - kb.z * LOG2E;
        v[4 * c + 3] = sa[4 * c + 3] * scale2 - kb.w * LOG2E;
      }
      if (kt == nkt - 1) {
#pragma unroll
        for (int e = 0; e < 16; ++e) if (crow(e, h) > r) v[e] = -INFINITY;
      }
    } else {
      const float* tp = tbl + (q0 - k0) + r + 32 - 4 * h - 27;
#pragma unroll
      for (int e = 0; e < 16; ++e) v[e] = sa[e] * scale2 + tp[27 - ((e & 3) + 8 * (e >> 2))];
    }
    float mx = v[0];
#pragma unroll
    for (int e = 1; e < 16; ++e) mx = fmaxf(mx, v[e]);
    mx = fmaxf(mx, __shfl_xor(mx, 32));
    const float mn = fmaxf(m, mx);
    const float alpha = exp2f(m - mn);
    m = mn;
    float ps = 0.f;
#pragma unroll
    for (int e = 0; e < 16; ++e) { v[e] = exp2f(v[e] - mn); ps += v[e]; }
    l = l * alpha + ps;
#pragma unroll
    for (int dt = 0; dt < 4; ++dt)
#pragma unroll
      for (int e = 0; e < 16; ++e) o[dt][e] *= alpha;
    bf16x8 pb[2];
#pragma unroll
    for (int s = 0; s < 2; ++s) {
      const uint4 u = make_uint4(pack_bf2(v[8 * s + 0], v[8 * s + 1]), pack_bf2(v[8 * s + 2], v[8 * s + 3]),
                                 pack_bf2(v[8 * s + 4], v[8 * s + 5]), pack_bf2(v[8 * s + 6], v[8 * s + 7]));
      pb[s] = __builtin_bit_cast(bf16x8, u);
    }
#pragma unroll
    for (int dt = 0; dt < 4; ++dt)
#pragma unroll
      for (int s = 0; s < 2; ++s) {
        const bf16x8 va = __builtin_shufflevector(vf[dt][s][0], vf[dt][s][1], 0, 1, 2, 3, 4, 5, 6, 7);
        o[dt] = MFMA32(va, pb[s], o[dt]);
      }
  }
  l_out = l + __shfl_xor(l, 32);
}

DI void attn_store_bf16(const f32x16 (&o)[4], float linv, bf16_t* __restrict__ out_row  , int ldo) {
  const int lane = TID() & 63, r = lane & 31, h = lane >> 5;
  bf16_t* op = out_row + (size_t)r * ldo + 4 * h;
#pragma unroll
  for (int dt = 0; dt < 4; ++dt)
#pragma unroll
    for (int c = 0; c < 4; ++c)
      *(uint2*)(op + 32 * dt + 8 * c) = make_uint2(pack_bf2(o[dt][4 * c] * linv, o[dt][4 * c + 1] * linv),
                                                    pack_bf2(o[dt][4 * c + 2] * linv, o[dt][4 * c + 3] * linv));
}

DI int t5_bucket(int n) {
  if (n < 16) return n;
  int lg = 16 + (int)(logf((float)n / 16.f) / 4.852030263919617f * 16.f);
  return lg < 31 ? lg : 31;
}

DI void phase_attn_even(const Params& p, char* smem) {
  const int tid = TID(), wave = __builtin_amdgcn_readfirstlane(tid >> 6), bid = blockIdx.x, G = gridDim.x;
  const bf16_t* QK = (const bf16_t*)(p.ws + WS_QK);
  const bf16_t* VT = (const bf16_t*)(p.ws + WS_VT);
  bf16_t* ATT = (bf16_t*)(p.ws + WS_ATT);
  float* pieces = (float*)smem;
  float* tbl = (float*)(smem + 66048);
  const float lam = ((const float*)(p.ws + WS_MISC))[0];
  for (int item = bid; item < 3072; item += G) {
    const int g = item / 192; int rem = item - g * 192;
    const int qb = 15 - g;
    if (rem < 64) {
      const int b = rem >> 3, hh = rem & 7;
      const int q0 = qb * 128 + 32 * wave;
      const bf16_t* Qp = QK + (size_t)b * S_ * 4096 + hh * 128;
      f32x16 o[4]; float l;
      attn_wave<0>(Qp, 4096, Qp + 1024, 4096, VT + (size_t)(hh * 128) * T_ + b * S_, T_,
                   (const float*)(p.ws + WS_FCUM) + (size_t)(b * 8 + hh) * S_, nullptr, q0, o, l);
      attn_store_bf16(o, 1.f / l, ATT + (size_t)(b * S_ + q0) * D_ + hh * 128, D_);
    } else {
      rem -= 64;
      const int qt = 4 * qb + 3 - (rem >> 5);
      const int bh = rem & 31, b = bh >> 2, hh = bh & 3;
      const int q0 = qt * 32;
      for (int e = tid; e < 2080; e += NTHREADS) {
        const int dist = e - 32;
        tbl[e] = dist >= 0 ? p.rel_bias[t5_bucket(dist) * 16 + hh] * LOG2E : -INFINITY;
      }
      __syncthreads();
      const int mm = wave >> 1, half = wave & 1;
      const bf16_t* Qp = QK + (size_t)b * S_ * 4096 + 2048 + hh * 256 + mm * 128;
      f32x16 o[4]; float l;
      attn_wave<1>(Qp, 4096, Qp + 1024, 4096, VT + (size_t)(1024 + hh * 256 + half * 128) * T_ + b * S_, T_,
                   nullptr, tbl, q0, o, l);
      {
        const int lane = tid & 63, r = lane & 31, h = lane >> 5;
        const float linv = 1.f / l;
        float* pw = pieces + (wave * 32 + r) * 129;
#pragma unroll
        for (int dt = 0; dt < 4; ++dt)
#pragma unroll
          for (int e = 0; e < 16; ++e) pw[32 * dt + crow(e, h)] = o[dt][e] * linv;
      }
      __syncthreads();
      {
        const int q = tid >> 3, d0 = (tid & 7) * 32;
        const int half2 = d0 >> 7, dl = d0 & 127;
        const float* p0 = pieces + ((0 * 2 + half2) * 32 + q) * 129 + dl;
        const float* p1 = pieces + ((1 * 2 + half2) * 32 + q) * 129 + dl;
        float val[32]; float ss = 0.f;
#pragma unroll
        for (int j = 0; j < 32; ++j) { val[j] = p0[j] - lam * p1[j]; ss += val[j] * val[j]; }
        ss += __shfl_xor(ss, 1); ss += __shfl_xor(ss, 2); ss += __shfl_xor(ss, 4);
        const float rstd = rsqrtf(ss * (1.f / 256.f) + 1e-6f) * 0.8f;
        const float* sg = p.even_diff_subln_gain + d0;
        bf16_t* op = ATT + (size_t)(b * S_ + q0 + q) * D_ + 1024 + hh * 256 + d0;
#pragma unroll
        for (int j = 0; j < 32; j += 8) {
          *(uint4*)(op + j) = make_uint4(pack_bf2(val[j] * rstd * sg[j], val[j + 1] * rstd * sg[j + 1]),
                                         pack_bf2(val[j + 2] * rstd * sg[j + 2], val[j + 3] * rstd * sg[j + 3]),
                                         pack_bf2(val[j + 4] * rstd * sg[j + 4], val[j + 5] * rstd * sg[j + 5]),
                                         pack_bf2(val[j + 6] * rstd * sg[j + 6], val[j + 7] * rstd * sg[j + 7]));
        }
      }
      __syncthreads();
    }
  }
}

DI void phase_attn_odd(const Params& p, char* smem) {
  const int tid = TID(), wave = __builtin_amdgcn_readfirstlane(tid >> 6), bid = blockIdx.x, G = gridDim.x;
  const bf16_t* QK = (const bf16_t*)(p.ws + WS_QK);
  const bf16_t* VT = (const bf16_t*)(p.ws + WS_VT);
  bf16_t* ATT = (bf16_t*)(p.ws + WS_ATT);
  float* tbl = (float*)(smem + 66048);
  int cur_head = -1;
  for (int item = bid; item < 2048; item += G) {
    const int g = item >> 7, rem = item & 127;
    const int qb = 15 - g, b = rem >> 4, hd = rem & 15;
    if (hd != cur_head) {
      __syncthreads();
      for (int e = tid; e < 2080; e += NTHREADS) {
        const int dist = e - 32;
        float val = -INFINITY;
        if (dist >= 0) {
          int cnt = 0;
          if (dist <= 128) cnt += 1;
          if (dist <= 512 && (dist & 3) == 0) cnt += 1;
          if ((dist & 15) == 0) cnt += 1;
          if (cnt > 0) val = (p.rel_bias[t5_bucket(dist) * 16 + hd] + __logf((float)cnt)) * LOG2E;
        }
        tbl[e] = val;
      }
      cur_head = hd;
      __syncthreads();
    }
    const int q0 = qb * 128 + 32 * wave;
    const bf16_t* Qp = QK + (size_t)b * S_ * 4096 + hd * 128;
    f32x16 o[4]; float l;
    attn_wave<1>(Qp, 4096, Qp + 2048, 4096, VT + (size_t)(hd * 128) * T_ + b * S_, T_, nullptr, tbl, q0, o, l);
    attn_store_bf16(o, 1.f / l, ATT + (size_t)(b * S_ + q0) * D_ + hd * 128, D_);
  }
}

DI unsigned fkey(float f) { const unsigned u = __float_as_uint(f); return (u & 0x80000000u) ? ~u : (u | 0x80000000u); }
DI int popc64(unsigned long long m) { return __popcll(m); }
DI int mbcnt(unsigned long long m) { return __builtin_amdgcn_mbcnt_hi((unsigned)(m >> 32), __builtin_amdgcn_mbcnt_lo((unsigned)m, 0)); }

template <int NP, int NV>
DI void select16_multi(const unsigned (&key)[NP][NV], bool (&sel)[NP][NV], int (&pos)[NP][NV]) {
  unsigned thr[NP];
#pragma unroll
  for (int q = 0; q < NP; ++q) thr[q] = 0u;
#pragma unroll 1
  for (int bit = 31; bit >= 0; --bit) {
#pragma unroll
    for (int q = 0; q < NP; ++q) {
      const unsigned cand = thr[q] | (1u << bit);
      int cnt = 0;
#pragma unroll
      for (int a = 0; a < NV; ++a) cnt += popc64(__ballot(key[q][a] >= cand));
      thr[q] = (cnt >= 16) ? cand : thr[q];
    }
  }
#pragma unroll
  for (int q = 0; q < NP; ++q) {
    int cgt = 0;
#pragma unroll
    for (int a = 0; a < NV; ++a) cgt += popc64(__ballot(key[q][a] > thr[q]));
    const int need = 16 - cgt;
    int eqbase = 0, sbase = 0;
#pragma unroll
    for (int a = 0; a < NV; ++a) {
      const bool eq = key[q][a] == thr[q];
      const unsigned long long em = __ballot(eq);
      const bool sl = (key[q][a] > thr[q]) || (eq && (eqbase + mbcnt(em)) < need);
      eqbase += popc64(em);
      const unsigned long long sm = __ballot(sl);
      sel[q][a] = sl; pos[q][a] = sbase + mbcnt(sm);
      sbase += popc64(sm);
    }
  }
}

DI float gelu_erf(float x) { return 0.5f * x * (1.f + erff(x * 0.7071067811865476f)); }

DI void phase_peer(const Params& p, int layer, const float* __restrict__ gate2  , char* smem) {
  const int tid = TID(), lane = tid & 63, wave = __builtin_amdgcn_readfirstlane(tid >> 6);
  const int gw = __builtin_amdgcn_readfirstlane((blockIdx.x * NTHREADS + tid) >> 6), nw = (gridDim.x * NTHREADS) >> 6;
  float* wl_s = (float*)(smem + wave * 2048);
  int* wl_i = (int*)(smem + wave * 2048 + 512);
  int* ex_i = (int*)(smem + wave * 2048 + 1024);
  float* ex_g = (float*)(smem + wave * 2048 + 1536);
  const float* SC = (const float*)(p.ws + WS_SC);
  const bf16_t* H = (const bf16_t*)(p.ws + WS_H);
  const unsigned char* PU = (const unsigned char*)(p.ws + WS_PEERU) + (size_t)layer * NEXP * D_;
  const unsigned char* PV = (const unsigned char*)(p.ws + WS_PEERV8) + (size_t)layer * NEXP * D_;
  const float* USC = (const float*)(p.ws + WS_PEERV) + (size_t)layer * NEXP;
  const float* VSC = (const float*)(p.ws + WS_PEERV) + (size_t)(2 + layer) * NEXP;
  for (int t = gw; t < T_; t += nw) {
#pragma unroll 1
    for (int hg = 0; hg < 2; ++hg) {
      float sv[4][4];
#pragma unroll
      for (int hl = 0; hl < 4; ++hl) {
        const float* sr = SC + ((size_t)t * 8 + hg * 4 + hl) * 256;
#pragma unroll
        for (int a = 0; a < 4; ++a) sv[hl][a] = sr[a * 64 + lane];
      }
      {
        unsigned key[8][2]; bool sel[8][2]; int pos[8][2];
#pragma unroll
        for (int hl = 0; hl < 4; ++hl)
#pragma unroll
          for (int pp = 0; pp < 2; ++pp) { key[hl * 2 + pp][0] = fkey(sv[hl][2 * pp]); key[hl * 2 + pp][1] = fkey(sv[hl][2 * pp + 1]); }
        select16_multi<8, 2>(key, sel, pos);
#pragma unroll
        for (int hl = 0; hl < 4; ++hl)
#pragma unroll
          for (int pp = 0; pp < 2; ++pp)
#pragma unroll
            for (int a = 0; a < 2; ++a)
              if (sel[hl * 2 + pp][a]) { wl_s[(hl * 2 + pp) * 16 + pos[hl * 2 + pp][a]] = sv[hl][2 * pp + a]; wl_i[(hl * 2 + pp) * 16 + pos[hl * 2 + pp][a]] = a * 64 + lane; }
      }
      float cs[4][4]; int ci[4][4]; unsigned ck[4][4]; bool sel[4][4]; int pos[4][4];
#pragma unroll
      for (int hl = 0; hl < 4; ++hl) {
        const float sa = wl_s[(hl * 2) * 16 + (lane >> 2)];
        const int ia = wl_i[(hl * 2) * 16 + (lane >> 2)];
#pragma unroll
        for (int j = 0; j < 4; ++j) {
          cs[hl][j] = sa + wl_s[(hl * 2 + 1) * 16 + (lane & 3) * 4 + j];
          ci[hl][j] = ia * 128 + wl_i[(hl * 2 + 1) * 16 + (lane & 3) * 4 + j];
          ck[hl][j] = fkey(cs[hl][j]);
        }
      }
      select16_multi<4, 4>(ck, sel, pos);
      float mx[4], es[4], e[4][4];
#pragma unroll
      for (int hl = 0; hl < 4; ++hl) {
        mx[hl] = -INFINITY;
#pragma unroll
        for (int j = 0; j < 4; ++j) if (sel[hl][j]) mx[hl] = fmaxf(mx[hl], cs[hl][j]);
      }
#pragma unroll
      for (int o = 32; o >= 1; o >>= 1)
#pragma unroll
        for (int hl = 0; hl < 4; ++hl) mx[hl] = fmaxf(mx[hl], __shfl_xor(mx[hl], o));
#pragma unroll
      for (int hl = 0; hl < 4; ++hl) {
        es[hl] = 0.f;
#pragma unroll
        for (int j = 0; j < 4; ++j) { e[hl][j] = sel[hl][j] ? __expf(cs[hl][j] - mx[hl]) : 0.f; es[hl] += e[hl][j]; }
      }
#pragma unroll
      for (int o = 32; o >= 1; o >>= 1)
#pragma unroll
        for (int hl = 0; hl < 4; ++hl) es[hl] += __shfl_xor(es[hl], o);
#pragma unroll
      for (int hl = 0; hl < 4; ++hl) {
        const float inv = 1.f / es[hl];
        const int hh = hg * 4 + hl;
#pragma unroll
        for (int j = 0; j < 4; ++j) if (sel[hl][j]) { ex_i[hh * 16 + pos[hl][j]] = ci[hl][j]; ex_g[hh * 16 + pos[hl][j]] = e[hl][j] * inv; }
      }
    }
    float xf[32];
    {
      const bf16_t* hr = H + (size_t)t * D_ + lane * 16;
#pragma unroll
      for (int i = 0; i < 2; ++i)
#pragma unroll
        for (int hq = 0; hq < 2; ++hq) {
          const uint4 u = *(const uint4*)(hr + 1024 * i + 8 * hq);
          const unsigned w[4] = {u.x, u.y, u.z, u.w};
#pragma unroll
          for (int k = 0; k < 4; ++k) { xf[16 * i + 8 * hq + 2 * k] = bf_lo(w[k]); xf[16 * i + 8 * hq + 2 * k + 1] = bf_hi(w[k]); }
        }
    }
    float y[32];
#pragma unroll
    for (int j = 0; j < 32; ++j) y[j] = 0.f;
    uint4 ua[2][2], va[2][2], ub[2][2], vb[2][2];
    float sua[2], sva[2], sub_[2], svb[2];
#define PEER_LOAD(UR, VR, SU, SV, EB)                                                                   \
    _Pragma("unroll") for (int q = 0; q < 2; ++q) {                                                     \
      const int id = __builtin_amdgcn_readfirstlane(ex_i[(EB) + q]);                                   \
      const unsigned char* up = PU + (size_t)id * D_ + lane * 16;                                      \
      const unsigned char* vp = PV + (size_t)id * D_ + lane * 16;                                      \
      UR[q][0] = *(const uint4*)(up); UR[q][1] = *(const uint4*)(up + 1024);                           \
      VR[q][0] = *(const uint4*)(vp); VR[q][1] = *(const uint4*)(vp + 1024);                           \
      SU[q] = USC[id]; SV[q] = VSC[id];                                                                 \
    }
#define PEER_COMPUTE(UR, VR, SU, SV, EB)                                                                \
    {                                                                                                   \
      float dq[2];                                                                                      \
      _Pragma("unroll") for (int q = 0; q < 2; ++q) {                                                   \
        float a0 = 0.f, a1 = 0.f;                                                                       \
        _Pragma("unroll") for (int i = 0; i < 2; ++i) {                                                 \
          const unsigned w[4] = {UR[q][i].x, UR[q][i].y, UR[q][i].z, UR[q][i].w};                      \
          _Pragma("unroll") for (int k = 0; k < 4; ++k) {                                               \
            const f2_t lo = __builtin_amdgcn_cvt_pk_f32_fp8((int)w[k], false);                         \
            const f2_t hi = __builtin_amdgcn_cvt_pk_f32_fp8((int)w[k], true);                          \
            a0 += lo.x * xf[16 * i + 4 * k] + hi.x * xf[16 * i + 4 * k + 2];                            \
            a1 += lo.y * xf[16 * i + 4 * k + 1] + hi.y * xf[16 * i + 4 * k + 3];                        \
          }                                                                                             \
        }                                                                                               \
        dq[q] = a0 + a1;                                                                                \
      }                                                                                                 \
                            \
      const bool hb = lane >= 32;                                                                       \
      float kk = hb ? dq[1] : dq[0];                                                                    \
      const float ss = hb ? dq[0] : dq[1];                                                              \
      kk += __shfl_xor(ss, 32);                                                                         \
      kk += __shfl_xor(kk, 16); kk += __shfl_xor(kk, 8); kk += __shfl_xor(kk, 4); kk += __shfl_xor(kk, 2); kk += __shfl_xor(kk, 1); \
      const float cfl = (hb ? ex_g[(EB) + 1] : ex_g[(EB)]) * gelu_erf(kk * (hb ? SU[1] : SU[0])) * (hb ? SV[1] : SV[0]); \
      _Pragma("unroll") for (int q = 0; q < 2; ++q) {                                                   \
        const float cf = __builtin_bit_cast(float, __builtin_amdgcn_readlane(__builtin_bit_cast(int, cfl), 32 * q)); \
        _Pragma("unroll") for (int i = 0; i < 2; ++i) {                                                 \
          const unsigned w[4] = {VR[q][i].x, VR[q][i].y, VR[q][i].z, VR[q][i].w};                      \
          _Pragma("unroll") for (int k = 0; k < 4; ++k) {                                               \
            const f2_t lo = __builtin_amdgcn_cvt_pk_f32_fp8((int)w[k], false);                         \
            const f2_t hi = __builtin_amdgcn_cvt_pk_f32_fp8((int)w[k], true);                          \
            y[16 * i + 4 * k] += cf * lo.x; y[16 * i + 4 * k + 1] += cf * lo.y;                          \
            y[16 * i + 4 * k + 2] += cf * hi.x; y[16 * i + 4 * k + 3] += cf * hi.y;                      \
          }                                                                                             \
        }                                                                                               \
      }                                                                                                 \
    }
    PEER_LOAD(ua, va, sua, sva, 0)
#pragma unroll 1
    for (int eb = 0; eb < 128; eb += 4) {
      PEER_LOAD(ub, vb, sub_, svb, eb + 2)
      PEER_COMPUTE(ua, va, sua, sva, eb)
      if (eb + 4 < 128) { PEER_LOAD(ua, va, sua, sva, eb + 4) }
      PEER_COMPUTE(ub, vb, sub_, svb, eb + 2)
    }
#undef PEER_LOAD
#undef PEER_COMPUTE
    {
      const int b = t >> 11;
      float* orow = p.out + (size_t)t * D_ + lane * 16;
      const float* grow = gate2 + (size_t)b * 12288 + lane * 16;
#pragma unroll
      for (int i = 0; i < 2; ++i)
#pragma unroll
        for (int j = 0; j < 4; ++j) {
          float4 a0 = *(const float4*)(orow + 1024 * i + 4 * j);
          const float4 g0 = *(const float4*)(grow + 1024 * i + 4 * j);
          a0.x += g0.x * y[16 * i + 4 * j]; a0.y += g0.y * y[16 * i + 4 * j + 1];
          a0.z += g0.z * y[16 * i + 4 * j + 2]; a0.w += g0.w * y[16 * i + 4 * j + 3];
          *(float4*)(orow + 1024 * i + 4 * j) = a0;
        }
    }
  }
}

DI void phase_peer_scores(const Params& p, int layer, char* smem) {
  const bf16_t* QP = (const bf16_t*)(p.ws + WS_QK);
  const bf16_t* SK = (const bf16_t*)(p.ws + WS_SK) + (size_t)layer * 2 * 128 * 128;
  EpiArgs ea{}; ea.out = nullptr; ea.ldc = 256;
  for (int L = blockIdx.x; L < 2048; L += gridDim.x) {
    const int pp = L & 1, tm = L >> 1;
    f32x16 acc[2][2];
    gemm_tile_compute(QP + (size_t)tm * 128 * 256 + pp * 128, 256, SK + (size_t)pp * 128 * 128, 128, 128, smem, acc);
    ea.out = (float*)(p.ws + WS_SC) + pp * 128;
    gemm_epilogue<EPI_F32>(acc, tm * 128, 0, 0, ea, smem);
  }
}


#define XB_TMO      128
#define XB_XCNT(j)  (256  + 64 * (j))
#define XB_XSUB(j)  (1280 + 64 * (j))
#define XB_XGEN(j)  (2304 + 64 * (j))
#define XB_TOP      3328
#define XB_TOPGEN   3392
#define XCD_BAR_WORDS 3456
#define XB_SPIN_CAP (1u << 22)
#define LAS __attribute__((address_space(3)))
DI unsigned xb_ld(unsigned* p) { return __hip_atomic_load(p, __ATOMIC_RELAXED, __HIP_MEMORY_SCOPE_AGENT); }
DI unsigned xb_add(unsigned* p, unsigned v) { return __hip_atomic_fetch_add(p, v, __ATOMIC_RELAXED, __HIP_MEMORY_SCOPE_AGENT); }
DI unsigned xb_xcc_id() { return (unsigned)__builtin_amdgcn_s_getreg((3 << 11) | 20) & 0xFu; }
#define XB_SPIN(cond, bar) do { unsigned _sp = 0; while (cond) { __builtin_amdgcn_s_sleep(1); \
    if ((++_sp & 255u) == 0u) { if (xb_ld(&(bar)[XB_TMO])) break; if (_sp > XB_SPIN_CAP) { atomicAdd(&(bar)[XB_TMO], 1u); break; } } } } while (0)
struct XcdBarrier { unsigned* bar; unsigned x; volatile LAS unsigned* st; };
DI XcdBarrier xcd_barrier_post(unsigned* bar, volatile LAS unsigned* st) {
  XcdBarrier b; b.bar = bar; b.x = xb_xcc_id(); b.st = st;
  if (threadIdx.x == 0) (void)xb_add(&bar[XB_XCNT(b.x)], 1u);
  return b;
}
DI void xcd_barrier_complete(unsigned* bar, unsigned x, unsigned& nloc, unsigned& nx) {
  const unsigned G = gridDim.x * gridDim.y * gridDim.z;
  unsigned sum, cnt, mine, sp = 0u;
  for (;;) {
    sum = 0u; cnt = 0u; mine = 0u;
#pragma unroll
    for (unsigned j = 0; j < 16; ++j) { const unsigned c = xb_ld(&bar[XB_XCNT(j)]); sum += c; cnt += (c > 0u) ? 1u : 0u; mine = (j == x) ? c : mine; }
    if (sum == G) break;
    __builtin_amdgcn_s_sleep(1);
    if ((++sp & 255u) == 0u) { if (xb_ld(&bar[XB_TMO])) break; if (sp > XB_SPIN_CAP) { atomicAdd(&bar[XB_TMO], 1u); break; } }
  }
  nloc = mine > 0u ? mine : 1u; nx = cnt > 0u ? cnt : 1u;
}
DI void xcd_barrier(const XcdBarrier& b) {
  asm volatile("s_waitcnt vmcnt(0)" ::: "memory");
  __syncthreads();
  if (threadIdx.x == 0) {
    unsigned* bar = b.bar;
    __builtin_amdgcn_s_waitcnt(0);
    unsigned nloc = b.st[0], nx = b.st[1];
    if (nloc == 0u) { xcd_barrier_complete(bar, b.x, nloc, nx); b.st[0] = nloc; b.st[1] = nx; }
    const unsigned old = xb_add(&bar[XB_XSUB(b.x)], 1u);
    const unsigned gen = old / nloc;
    if (old + 1u == (gen + 1u) * nloc) {
      __builtin_amdgcn_fence(__ATOMIC_RELEASE, "agent");
      asm volatile("s_waitcnt vmcnt(0)" ::: "memory");
      const unsigned og = xb_add(&bar[XB_TOP], 1u);
      const unsigned tg = og / nx;
      if (og + 1u == (tg + 1u) * nx) xb_add(&bar[XB_TOPGEN], 1u);
      else XB_SPIN(xb_ld(&bar[XB_TOPGEN]) == tg, bar);
      __builtin_amdgcn_fence(__ATOMIC_ACQUIRE, "agent");
      xb_add(&bar[XB_XGEN(b.x)], 1u);
      asm volatile("s_waitcnt vmcnt(0)" ::: "memory");
    } else {
      XB_SPIN(xb_ld(&bar[XB_XGEN(b.x)]) == gen, bar);
      __builtin_amdgcn_fence(__ATOMIC_ACQUIRE, "agent");
      asm volatile("s_waitcnt vmcnt(0)" ::: "memory");
    }
  }
  __syncthreads();
}

constexpr int N_PHASES = 17;
DI void run_phase(const Params& p, int ph, char* smem) {
  char* ws = p.ws;
  const float* mod = (const float*)(ws + WS_MOD);
  const bf16_t* H = (const bf16_t*)(ws + WS_H);
  if (ph == 0) { phase_prep(p, smem); return; }
  const int layer = (ph - 1) >> 3, sub = (ph - 1) & 7;
  const float* modl = mod + (size_t)layer * 8 * 12288;
  switch (sub) {
    case 0:
      if (layer == 0) phase_norm<true>(p, p.x, p.norm_gain, modl, modl + 2048);
      else phase_norm<false>(p, p.out, p.norm_gain + 2 * 2048, modl, modl + 2048);
      break;
    case 1: {
      if (layer == 0) fox_cumsum(p);
      EpiArgs ea{}; ea.out = ws + WS_QK; ea.ldc = 4096;
      if (layer == 0) {
        ea.gainA = p.even_fox_qk_gain; ea.gainB = p.even_diff_qk_gain; ea.gshift = 3;
      } else { ea.gainA = p.odd_qk_gain; ea.gainB = p.odd_qk_gain; ea.gshift = 4; }
      gemm_phase<EPI_NORM_BF16>(H, 2048, (const bf16_t*)(ws + (layer ? WS_WQK1 : WS_WQK0)), 2048, 2048, 128, 32, ea, smem);
      EpiArgs ev{}; ev.out = ws + WS_VT; ev.ldc = T_;
      gemm_phase<EPI_BF16>((const bf16_t*)(ws + (layer ? WS_WV1 : WS_WV0)), 2048, H, 2048, 2048, 16, 128, ev, smem);
    } break;
    case 2:
      if (layer == 0) phase_attn_even(p, smem); else phase_attn_odd(p, smem);
      break;
    case 3: {
      EpiArgs ea{}; ea.out = p.out; ea.ldc = 2048; ea.xin = layer ? p.out : p.x; ea.gate = modl + 2 * 2048;
      gemm_phase<EPI_RES_F32>((const bf16_t*)(ws + WS_ATT), 2048, (const bf16_t*)(ws + (layer ? WS_WO1 : WS_WO0)), 2048, 2048, 128, 16, ea, smem);
    } break;
    case 4:
      phase_norm<false>(p, p.out, p.norm_gain + (layer * 2 + 1) * 2048, modl + 3 * 2048, modl + 4 * 2048);
      break;
    case 5: {
      EpiArgs ea{}; ea.out = ws + WS_QK; ea.ldc = 2048;
      gemm_phase<EPI_BF16>(H, 2048, (const bf16_t*)(ws + (layer ? WS_WQ1 : WS_WQ0)), 2048, 2048, 128, 16, ea, smem);
    } break;
    case 6: phase_peer_scores(p, layer, smem); break;
    case 7: phase_peer(p, layer, modl + 5 * 2048, smem); break;
  }
}

#if FUSED
__global__ void __launch_bounds__(NTHREADS, 2) mega_kernel(Params p) {
  extern __shared__ __attribute__((aligned(16))) char smem[];
  cg::grid_group grid = cg::this_grid();
  volatile LAS unsigned* xst = (volatile LAS unsigned*)(smem + SMEM_BYTES - 16);
  if (threadIdx.x == 0) { xst[0] = 0u; xst[1] = 0u; }
  __syncthreads();
  const XcdBarrier xb = xcd_barrier_post((unsigned*)(p.ws + WS_BAR), xst);
#pragma unroll
  for (int ph = 0; ph < N_PHASES; ++ph) {
    run_phase(p, ph, smem);
    if (ph == 0) grid.sync();
    else if (ph + 1 < N_PHASES) xcd_barrier(xb);
  }
}
#else
template <int PH>
__global__ void __launch_bounds__(NTHREADS, 2) phase_kernel(Params p) {
  extern __shared__ __attribute__((aligned(16))) char smem[];
  run_phase(p, PH, smem);
}
template <int PH>
static void launch_phases(const Params& p, int grid, hipStream_t stream) {
  if constexpr (PH < N_PHASES) {
    (void)hipFuncSetAttribute((const void*)phase_kernel<PH>, hipFuncAttributeMaxDynamicSharedMemorySize, SMEM_BYTES);
    phase_kernel<PH><<<grid, NTHREADS, SMEM_BYTES, stream>>>(p);
    launch_phases<PH + 1>(p, grid, stream);
  }
}
#endif

extern "C" void kernel_launch(void* const* d_in, const int* in_sizes, int n_in, void* d_out, int out_size, void* d_ws,
                              size_t ws_size, hipStream_t stream) {
  Params p{};
  p.x = (const float*)d_in[0]; p.c = (const float*)d_in[1]; p.rel_bias = (const float*)d_in[2];
  p.norm_gain = (const float*)d_in[3]; p.w_ada = (const float*)d_in[4]; p.b_ada = (const float*)d_in[5];
  p.even_w_in = (const float*)d_in[6]; p.even_b_forget = (const float*)d_in[7]; p.even_fox_qk_gain = (const float*)d_in[8];
  p.even_diff_qk_gain = (const float*)d_in[9]; p.even_diff_lambda = (const float*)d_in[10];
  p.even_diff_subln_gain = (const float*)d_in[11]; p.even_w_out = (const float*)d_in[12];
  p.odd_w_qkv = (const float*)d_in[13]; p.odd_qk_gain = (const float*)d_in[14]; p.odd_w_out = (const float*)d_in[15];
  p.peer_w_query = (const float*)d_in[16]; p.peer_sub_keys = (const float*)d_in[17];
  p.peer_u = (const float*)d_in[18]; p.peer_v = (const float*)d_in[19];
  p.out = (float*)d_out; p.ws = (char*)d_ws;
  if (ws_size < WS_END) { fprintf(stderr, "workspace too small: %zu < %zu\n", ws_size, (size_t)WS_END); return; }
#if FUSED
  static int grid_blocks = 0;
  if (!grid_blocks) {
    int dev = 0, cus = 0, per_cu = 0;
    (void)hipGetDevice(&dev);
    (void)hipDeviceGetAttribute(&cus, hipDeviceAttributeMultiprocessorCount, dev);
    (void)hipFuncSetAttribute((const void*)mega_kernel, hipFuncAttributeMaxDynamicSharedMemorySize, SMEM_BYTES);
    (void)hipOccupancyMaxActiveBlocksPerMultiprocessor(&per_cu, mega_kernel, NTHREADS, SMEM_BYTES);
    if (per_cu > 2) per_cu = 2;
    grid_blocks = cus * per_cu;
  }
  (void)hipMemsetAsync(p.ws + WS_BAR, 0, XCD_BAR_WORDS * 4, stream);
  void* args[] = {&p};
  hipError_t e = hipLaunchCooperativeKernel((void*)mega_kernel, dim3(grid_blocks), dim3(NTHREADS), args, SMEM_BYTES, stream);
  if (e != hipSuccess) fprintf(stderr, "cooperative launch failed: %s (grid %d)\n", hipGetErrorString(e), grid_blocks);
#else
  launch_phases<0>(p, 512, stream);
#endif
}
```

```cpp
#include <hip/hip_runtime.h>
#include <hip/hip_cooperative_groups.h>
#include <stdint.h>
#include <stdio.h>
namespace cg = cooperative_groups;

#ifndef FUSED
#define FUSED 1
#endif

#define DI __device__ __forceinline__
typedef unsigned short bf16_t;
typedef __attribute__((ext_vector_type(8))) short bf16x8;
typedef __attribute__((ext_vector_type(4))) short bf16x4;
typedef __attribute__((ext_vector_type(16))) float f32x16;
typedef __attribute__((ext_vector_type(2))) __bf16 bf2_t;
typedef __attribute__((ext_vector_type(2))) float f2_t;
typedef __attribute__((ext_vector_type(4))) unsigned u32x4;
#define MFMA32(a, b, c) __builtin_amdgcn_mfma_f32_32x32x16_bf16((a), (b), (c), 0, 0, 0)

constexpr int T_ = 16384;
constexpr int D_ = 2048;
constexpr int S_ = 2048;
constexpr int NB_ = 8;
constexpr int NEXP = 16384;
constexpr float LOG2E = 1.4426950408889634f;
constexpr int NTHREADS = 256;
constexpr int SMEM_BYTES = 75776 + 16;

constexpr size_t MiB = 1048576;
constexpr size_t WS_PEERU = 0;
constexpr size_t WS_PEERV8 = WS_PEERU + 64 * MiB;
constexpr size_t WS_PEERV = WS_PEERU + 128 * MiB;
constexpr size_t WS_WQK0 = WS_PEERV + 128 * MiB;
constexpr size_t WS_WV0 = WS_WQK0 + 16 * MiB;
constexpr size_t WS_WQK1 = WS_WV0 + 8 * MiB;
constexpr size_t WS_WV1 = WS_WQK1 + 16 * MiB;
constexpr size_t WS_WO0 = WS_WV1 + 8 * MiB;
constexpr size_t WS_WO1 = WS_WO0 + 8 * MiB;
constexpr size_t WS_WQ0 = WS_WO1 + 8 * MiB;
constexpr size_t WS_WQ1 = WS_WQ0 + 8 * MiB;
constexpr size_t WS_SK = WS_WQ1 + 8 * MiB;
constexpr size_t WS_WFF = WS_SK + 131072;
constexpr size_t WS_MOD = WS_WFF + 65536;
constexpr size_t WS_LOGF = WS_MOD + 786432;
constexpr size_t WS_FCUM = WS_LOGF + 524288;
constexpr size_t WS_MISC = WS_FCUM + 524288;
constexpr size_t WS_H = WS_MISC + 65536;
constexpr size_t WS_QK = WS_H + 64 * MiB;
constexpr size_t WS_VT = WS_QK + 128 * MiB;
constexpr size_t WS_ATT = WS_VT + 64 * MiB;
constexpr size_t WS_SC = WS_ATT + 64 * MiB;
constexpr size_t WS_BAR = WS_SC + 128 * MiB;
constexpr size_t WS_END = WS_BAR + 65536;

struct Params {
  const float* x; const float* c; const float* rel_bias; const float* norm_gain; const float* w_ada; const float* b_ada;
  const float* even_w_in; const float* even_b_forget; const float* even_fox_qk_gain; const float* even_diff_qk_gain;
  const float* even_diff_lambda; const float* even_diff_subln_gain; const float* even_w_out;
  const float* odd_w_qkv; const float* odd_qk_gain; const float* odd_w_out;
  const float* peer_w_query; const float* peer_sub_keys; const float* peer_u; const float* peer_v;
  float* out; char* ws;
};

DI unsigned pack_bf2(float a, float b) { f2_t v = {a, b}; return __builtin_bit_cast(unsigned, __builtin_convertvector(v, bf2_t)); }
DI bf16_t f2bf(float a) { return (bf16_t)(pack_bf2(a, 0.f) & 0xffffu); }
DI float bf_lo(unsigned u) { return __uint_as_float(u << 16); }
DI float bf_hi(unsigned u) { return __uint_as_float(u & 0xffff0000u); }
DI int TID() { int t = threadIdx.x; asm volatile("" : "+v"(t)); return t; }
DI int crow(int reg, int h) { return (reg & 3) + 8 * (reg >> 2) + 4 * h; }
DI float wave_sum(float v) {
#pragma unroll
  for (int o = 32; o >= 1; o >>= 1) v += __shfl_xor(v, o);
  return v;
}
DI float wave_max(float v) {
#pragma unroll
  for (int o = 32; o >= 1; o >>= 1) v = fmaxf(v, __shfl_xor(v, o));
  return v;
}

DI void transpose_tile(const float* __restrict__ src, int ld, int c0, int k0, bf16_t* __restrict__ dst_row0, char* smem) {
  float* tile = (float*)smem;
  const int tid = TID();
  const int ty = tid >> 4, tx = tid & 15;
#pragma unroll
  for (int i = 0; i < 4; ++i) {
    const int k = ty + 16 * i;
    const float4 v = *(const float4*)(src + (size_t)(k0 + k) * ld + c0 + 4 * tx);
    float* t = tile + k * 65 + 4 * tx;
    t[0] = v.x; t[1] = v.y; t[2] = v.z; t[3] = v.w;
  }
  __syncthreads();
  const int cc = tid >> 2, kc = (tid & 3) * 16;
  unsigned pk[8];
#pragma unroll
  for (int j = 0; j < 8; ++j) pk[j] = pack_bf2(tile[(kc + 2 * j) * 65 + cc], tile[(kc + 2 * j + 1) * 65 + cc]);
  uint4* d = (uint4*)(dst_row0 + (size_t)cc * 2048 + k0 + kc);
  d[0] = make_uint4(pk[0], pk[1], pk[2], pk[3]);
  d[1] = make_uint4(pk[4], pk[5], pk[6], pk[7]);
  __syncthreads();
}

DI void phase_prep(const Params& p, char* smem) {
  const int tid = TID(), bid = blockIdx.x, G = gridDim.x;
  char* ws = p.ws;
  {
    float* cond = (float*)smem;
    bool have_cond = false;
    for (int item = bid; item < 384; item += G) {
      if (!have_cond) {
        for (int e = tid; e < NB_ * D_; e += NTHREADS) {
          const int b = e >> 11, d = e & 2047;
          const float v = p.c[e];
          cond[d * 8 + b] = v / (1.f + __expf(-v));
        }
        have_cond = true;
        __syncthreads();
      }
      const int i = item / 192, n = (item % 192) * 64 + (tid & 63);
      const int w = tid >> 6;
      const float* wp = p.w_ada + (size_t)i * D_ * 12288 + n;
      float acc[8];
#pragma unroll
      for (int b = 0; b < 8; ++b) acc[b] = 0.f;
#pragma unroll 8
      for (int d = w; d < D_; d += 4) {
        const float wv = wp[(size_t)d * 12288];
        const float4 c0 = *(const float4*)(cond + d * 8), c1 = *(const float4*)(cond + d * 8 + 4);
        acc[0] += c0.x * wv; acc[1] += c0.y * wv; acc[2] += c0.z * wv; acc[3] += c0.w * wv;
        acc[4] += c1.x * wv; acc[5] += c1.y * wv; acc[6] += c1.z * wv; acc[7] += c1.w * wv;
      }
      float* red = (float*)(smem + 65536);
#pragma unroll
      for (int b = 0; b < 8; ++b) red[(w * 64 + (tid & 63)) * 8 + b] = acc[b];
      __syncthreads();
      if (tid < 64) {
        float* mod = (float*)(ws + WS_MOD);
#pragma unroll
        for (int b = 0; b < 8; ++b) {
          const float s = red[(0 * 64 + tid) * 8 + b] + red[(1 * 64 + tid) * 8 + b] + red[(2 * 64 + tid) * 8 + b] + red[(3 * 64 + tid) * 8 + b];
          mod[((size_t)i * 8 + b) * 12288 + n] = s + p.b_ada[i * 12288 + n];
        }
      }
      __syncthreads();
    }
    __syncthreads();
  }
  {
    bf16_t* wqk0 = (bf16_t*)(ws + WS_WQK0); bf16_t* wv0 = (bf16_t*)(ws + WS_WV0);
    bf16_t* wqk1 = (bf16_t*)(ws + WS_WQK1); bf16_t* wv1 = (bf16_t*)(ws + WS_WV1);
    for (int item = bid; item < 320 * 32; item += G) {
      const int ct = item >> 5, kt = item & 31;
      const float* src; int ld, c0; bf16_t* dst;
      if (ct < 96) {
        const int seg = ct >> 4, cl = (ct & 15) * 64;
        src = p.even_w_in; ld = 6152;
        c0 = (seg < 3 ? seg * 1024 : 3080 + (seg - 3) * 1024) + cl;
        if (seg == 0) dst = wqk0 + (size_t)cl * 2048;
        else if (seg == 1) dst = wqk0 + (size_t)(1024 + cl) * 2048;
        else if (seg == 2) dst = wv0 + (size_t)cl * 2048;
        else if (seg == 3) dst = wqk0 + (size_t)(2048 + cl) * 2048;
        else if (seg == 4) dst = wqk0 + (size_t)(3072 + cl) * 2048;
        else dst = wv0 + (size_t)(1024 + cl) * 2048;
      } else if (ct < 192) {
        const int cl = (ct - 96) * 64;
        src = p.odd_w_qkv; ld = 6144; c0 = cl;
        dst = cl < 4096 ? wqk1 + (size_t)cl * 2048 : wv1 + (size_t)(cl - 4096) * 2048;
      } else {
        const int mi = (ct - 192) >> 5, cl = ((ct - 192) & 31) * 64;
        ld = 2048; c0 = cl;
        if (mi == 0) { src = p.even_w_out; dst = (bf16_t*)(ws + WS_WO0); }
        else if (mi == 1) { src = p.odd_w_out; dst = (bf16_t*)(ws + WS_WO1); }
        else if (mi == 2) { src = p.peer_w_query; dst = (bf16_t*)(ws + WS_WQ0); }
        else { src = p.peer_w_query + (size_t)2048 * 2048; dst = (bf16_t*)(ws + WS_WQ1); }
        dst += (size_t)cl * 2048;
      }
      transpose_tile(src, ld, c0, kt * 64, dst, smem);
    }
  }
  {
    const int lane = tid & 63;
    const int gw = __builtin_amdgcn_readfirstlane((bid * NTHREADS + tid) >> 6), nw = (G * NTHREADS) >> 6;
    float* scl = (float*)(ws + WS_PEERV);
    for (int row = gw; row < 4 * NEXP; row += nw) {
      const int tab = row >> 15, rr = row & 32767;
      const float* src = (tab ? p.peer_v : p.peer_u) + (size_t)rr * D_;
      unsigned char* dst = (unsigned char*)(ws + (tab ? WS_PEERV8 : WS_PEERU)) + (size_t)rr * D_;
      float4 v[8];
      float am = 0.f;
#pragma unroll
      for (int i = 0; i < 2; ++i)
#pragma unroll
        for (int j = 0; j < 4; ++j) {
          v[4 * i + j] = *(const float4*)(src + lane * 16 + 1024 * i + 4 * j);
          am = fmaxf(am, fmaxf(fmaxf(fabsf(v[4 * i + j].x), fabsf(v[4 * i + j].y)), fmaxf(fabsf(v[4 * i + j].z), fabsf(v[4 * i + j].w))));
        }
      am = wave_max(am);
      const float sc = am > 0.f ? 432.f / am : 1.f;
      if (lane == 0) scl[row] = am > 0.f ? am / 432.f : 1.f;
#pragma unroll
      for (int i = 0; i < 2; ++i) {
        unsigned w[4];
#pragma unroll
        for (int j = 0; j < 4; ++j) {
          int d = __builtin_amdgcn_cvt_pk_fp8_f32(v[4 * i + j].x * sc, v[4 * i + j].y * sc, 0, false);
          d = __builtin_amdgcn_cvt_pk_fp8_f32(v[4 * i + j].z * sc, v[4 * i + j].w * sc, d, true);
          w[j] = (unsigned)d;
        }
        *(uint4*)(dst + lane * 16 + 1024 * i) = make_uint4(w[0], w[1], w[2], w[3]);
      }
    }
    for (int item = bid; item < 32; item += G) {
      const size_t off = (size_t)item * 2048;
      const float4 a = *(const float4*)(p.peer_sub_keys + off + tid * 8), b = *(const float4*)(p.peer_sub_keys + off + tid * 8 + 4);
      *(uint4*)((bf16_t*)(ws + WS_SK) + off + tid * 8) = make_uint4(pack_bf2(a.x, a.y), pack_bf2(a.z, a.w), pack_bf2(b.x, b.y), pack_bf2(b.z, b.w));
    }
  }
  if (bid == G - 1) {
    float* wff = (float*)(ws + WS_WFF);
    for (int e = tid; e < 2048 * 8; e += NTHREADS) wff[e] = p.even_w_in[(size_t)(e >> 3) * 6152 + 3072 + (e & 7)];
    if (tid < 64) {
      const float* l = p.even_diff_lambda;
      float s1 = l[tid] * l[128 + tid] + l[64 + tid] * l[128 + 64 + tid];
      float s2 = l[256 + tid] * l[384 + tid] + l[256 + 64 + tid] * l[384 + 64 + tid];
      s1 = wave_sum(s1); s2 = wave_sum(s2);
      if (tid == 0) ((float*)(ws + WS_MISC))[0] = expf(s1) - expf(s2) + 0.2f;
    }
  }
}

template <bool FF>
DI void phase_norm(const Params& p, const float* __restrict__ xin, const float* __restrict__ gain,
                   const float* __restrict__ sh, const float* __restrict__ sc  ) {
  const int lane = TID() & 63;
  const int gw = __builtin_amdgcn_readfirstlane((blockIdx.x * NTHREADS + TID()) >> 6), nw = (gridDim.x * NTHREADS) >> 6;
  bf16_t* H = (bf16_t*)(p.ws + WS_H);
  for (int t = gw; t < T_; t += nw) {
    const int b = t >> 11;
    const float* xr = xin + (size_t)t * D_;
    float4 v[8];
    float ss = 0.f;
#pragma unroll
    for (int i = 0; i < 8; ++i) { v[i] = *(const float4*)(xr + lane * 4 + 256 * i); ss += v[i].x * v[i].x + v[i].y * v[i].y + v[i].z * v[i].z + v[i].w * v[i].w; }
    ss = wave_sum(ss);
    const float rstd = rsqrtf(ss * (1.f / 2048.f) + 1e-6f);
    float ff[8];
    if (FF) {
#pragma unroll
      for (int j = 0; j < 8; ++j) ff[j] = 0.f;
    }
#pragma unroll
    for (int i = 0; i < 8; ++i) {
      const int c = lane * 4 + 256 * i;
      const float4 g = *(const float4*)(gain + c);
      const float4 s1 = *(const float4*)(sc + (size_t)b * 12288 + c);
      const float4 s0 = *(const float4*)(sh + (size_t)b * 12288 + c);
      float4 h;
      h.x = v[i].x * rstd * g.x * (1.f + s1.x) + s0.x;
      h.y = v[i].y * rstd * g.y * (1.f + s1.y) + s0.y;
      h.z = v[i].z * rstd * g.z * (1.f + s1.z) + s0.z;
      h.w = v[i].w * rstd * g.w * (1.f + s1.w) + s0.w;
      *(uint2*)(H + (size_t)t * D_ + c) = make_uint2(pack_bf2(h.x, h.y), pack_bf2(h.z, h.w));
      if (FF) {
        const float* wff = (const float*)(p.ws + WS_WFF) + c * 8;
        const float hv[4] = {h.x, h.y, h.z, h.w};
#pragma unroll
        for (int e = 0; e < 4; ++e) {
          const float4 w0 = *(const float4*)(wff + e * 8), w1 = *(const float4*)(wff + e * 8 + 4);
          ff[0] += hv[e] * w0.x; ff[1] += hv[e] * w0.y; ff[2] += hv[e] * w0.z; ff[3] += hv[e] * w0.w;
          ff[4] += hv[e] * w1.x; ff[5] += hv[e] * w1.y; ff[6] += hv[e] * w1.z; ff[7] += hv[e] * w1.w;
        }
      }
    }
    if (FF) {
#pragma unroll
      for (int j = 0; j < 8; ++j) ff[j] = wave_sum(ff[j]);
      if (lane < 8) {
        float z = ff[0];
#pragma unroll
        for (int j = 1; j < 8; ++j) z = (lane == j) ? ff[j] : z;
        z += p.even_b_forget[lane];
        const float lf = fminf(z, 0.f) - log1pf(__expf(-fabsf(z)));
        ((float*)(p.ws + WS_LOGF))[(size_t)t * 8 + lane] = lf;
      }
    }
  }
}

DI void fox_cumsum(const Params& p) {
  const int lane = TID() & 63;
  const int gw = __builtin_amdgcn_readfirstlane((blockIdx.x * NTHREADS + TID()) >> 6), nw = (gridDim.x * NTHREADS) >> 6;
  const float* lf = (const float*)(p.ws + WS_LOGF);
  float* fc = (float*)(p.ws + WS_FCUM);
  for (int it = gw; it < 64; it += nw) {
    const int b = it >> 3, hh = it & 7;
    float v[32];
    float tot = 0.f;
#pragma unroll
    for (int j = 0; j < 32; ++j) { tot += lf[(size_t)(b * S_ + lane * 32 + j) * 8 + hh]; v[j] = tot; }
    float inc = tot;
#pragma unroll
    for (int o = 1; o < 64; o <<= 1) { const float n = __shfl_up(inc, o); if (lane >= o) inc += n; }
    const float base = inc - tot;
#pragma unroll
    for (int j = 0; j < 32; ++j) fc[(size_t)it * S_ + lane * 32 + j] = v[j] + base;
  }
}

DI void gemm_tile_compute(const bf16_t* A, int lda, const bf16_t* B, int ldb, int K,
                          char* smem, f32x16 (&acc)[2][2]) {
  const int tid = TID(), lane = tid & 63, wave = __builtin_amdgcn_readfirstlane(tid >> 6);
  const int r = lane & 31, h = lane >> 5;
  const int wm = wave >> 1, wn = wave & 1;
  const int srow = tid >> 3, sc = tid & 7;
  const char* Ab = (const char*)A;
  const char* Bb = (const char*)B;
  const unsigned voa = (unsigned)(srow * lda + sc * 8) * 2u;
  const unsigned vob = (unsigned)(srow * ldb + sc * 8) * 2u;
  const unsigned sta = (unsigned)(32 * lda) * 2u, stb = (unsigned)(32 * ldb) * 2u;
  u32x4 ra[4], rb[4];
#pragma unroll
  for (int i = 0; i < 4; ++i) {
    ra[i] = *(const u32x4*)(Ab + (size_t)(i * sta) + voa);
    rb[i] = *(const u32x4*)(Bb + (size_t)(i * stb) + vob);
  }
  const int woff = srow * 128 + ((sc ^ ((srow >> 1) & 7)) << 4);
  const int rsw = (r >> 1) & 7;
  const int aoff = (wm * 64 + r) * 128, boff = 16384 + (wn * 64 + r) * 128;
#pragma unroll
  for (int i = 0; i < 2; ++i)
#pragma unroll
    for (int j = 0; j < 2; ++j)
#pragma unroll
      for (int e = 0; e < 16; ++e) acc[i][j][e] = 0.f;
#pragma unroll
  for (int i = 0; i < 4; ++i) {
    *(u32x4*)(smem + woff + i * 4096) = ra[i];
    *(u32x4*)(smem + 16384 + woff + i * 4096) = rb[i];
  }
  __syncthreads();
  const int KT = K >> 6;
  for (int kt = 0; kt < KT; ++kt) {
    char* st = smem + (kt & 1) * 32768;
    {
      const size_t kn = (size_t)((kt + 1 < KT ? kt + 1 : kt) * 128);
#pragma unroll
      for (int i = 0; i < 4; ++i) {
        ra[i] = *(const u32x4*)(Ab + (kn + i * sta) + voa);
        rb[i] = *(const u32x4*)(Bb + (kn + i * stb) + vob);
      }
    }
    asm volatile("" ::: "memory");
    __builtin_amdgcn_sched_barrier(0);
#pragma unroll
    for (int s = 0; s < 4; ++s) {
      const int co = ((2 * s + h) ^ rsw) << 4;
      bf16x8 af[2], bfr[2];
      af[0] = *(const bf16x8*)(st + aoff + co);
      af[1] = *(const bf16x8*)(st + aoff + 32 * 128 + co);
      bfr[0] = *(const bf16x8*)(st + boff + co);
      bfr[1] = *(const bf16x8*)(st + boff + 32 * 128 + co);
#pragma unroll
      for (int i = 0; i < 2; ++i)
#pragma unroll
        for (int j = 0; j < 2; ++j) acc[i][j] = MFMA32(af[i], bfr[j], acc[i][j]);
    }
    __builtin_amdgcn_sched_barrier(0);
    asm volatile("" ::: "memory");
    {
      char* sn = smem + ((kt + 1) & 1) * 32768;
#pragma unroll
      for (int i = 0; i < 4; ++i) {
        *(u32x4*)(sn + woff + i * 4096) = ra[i];
        *(u32x4*)(sn + 16384 + woff + i * 4096) = rb[i];
      }
    }
    __syncthreads();
  }
}

enum { EPI_BF16 = 0, EPI_NORM_BF16 = 1, EPI_RES_F32 = 2, EPI_F32 = 3 };
struct EpiArgs {
  void* out; int ldc;
  const float* gainA; const float* gainB; int gshift;
  const float* xin; const float* gate;
};

template <int EPI>
DI void gemm_epilogue(f32x16 (&acc)[2][2], int m0, int n0, int tn, const EpiArgs& ea, char* smem) {
  const int tid = TID(), lane = tid & 63, wave = __builtin_amdgcn_readfirstlane(tid >> 6);
  const int r = lane & 31, h = lane >> 5;
  const int wm = wave >> 1, wn = wave & 1;
  if (EPI == EPI_NORM_BF16) {
    float* red = (float*)smem;
    float ss[2][16];
#pragma unroll
    for (int i = 0; i < 2; ++i)
#pragma unroll
      for (int e = 0; e < 16; ++e) {
        float v = acc[i][0][e] * acc[i][0][e] + acc[i][1][e] * acc[i][1][e];
#pragma unroll
        for (int o = 16; o >= 1; o >>= 1) v += __shfl_xor(v, o);
        ss[i][e] = v;
      }
    if (r == 0) {
#pragma unroll
      for (int i = 0; i < 2; ++i)
#pragma unroll
        for (int e = 0; e < 16; ++e) red[wn * 128 + wm * 64 + i * 32 + crow(e, h)] = ss[i][e];
    }
    __syncthreads();
    const int grp = tn >> ea.gshift;
    const float* gain = ((grp & 2) ? ea.gainB : ea.gainA) + (grp & 1) * 128;
    bf16_t* out = (bf16_t*)ea.out;
#pragma unroll
    for (int i = 0; i < 2; ++i)
#pragma unroll
      for (int e = 0; e < 16; ++e) {
        const int rl = wm * 64 + i * 32 + crow(e, h);
        const float rstd = rsqrtf((red[rl] + red[128 + rl]) * (1.f / 128.f) + 1e-6f);
#pragma unroll
        for (int j = 0; j < 2; ++j) {
          const int cl = wn * 64 + j * 32 + r;
          out[(size_t)(m0 + rl) * ea.ldc + n0 + cl] = f2bf(acc[i][j][e] * rstd * gain[cl]);
        }
      }
    __syncthreads();
  } else {
#pragma unroll
    for (int i = 0; i < 2; ++i)
#pragma unroll
      for (int e = 0; e < 16; ++e) {
        const int row = m0 + wm * 64 + i * 32 + crow(e, h);
#pragma unroll
        for (int j = 0; j < 2; ++j) {
          const int col = n0 + wn * 64 + j * 32 + r;
          const float v = acc[i][j][e];
          if (EPI == EPI_BF16) ((bf16_t*)ea.out)[(size_t)row * ea.ldc + col] = f2bf(v);
          else if (EPI == EPI_F32) ((float*)ea.out)[(size_t)row * ea.ldc + col] = v;
          else {
            const float g = ea.gate[(size_t)(row >> 11) * 12288 + col];
            ((float*)ea.out)[(size_t)row * ea.ldc + col] = ea.xin[(size_t)row * ea.ldc + col] + g * v;
          }
        }
      }
  }
}

template <int EPI>
DI void gemm_phase(const bf16_t* A, int lda, const bf16_t* B, int ldb, int K, int mt, int nt, const EpiArgs& ea, char* smem) {
  const int bid = blockIdx.x, G = gridDim.x;
  const int xcd = bid & 7, slot = bid >> 3, nslots = G >> 3;
  const int nsn = nt >> 3, nsup = (mt >> 3) * nsn;
  const int cnt = (nsup - xcd + 7) >> 3;
  for (int j = slot; j < cnt * 64; j += nslots) {
    const int sup = xcd + 8 * (j >> 6), within = j & 63;
    const int sm = sup / nsn, sn = sup - sm * nsn;
    const int tm = sm * 8 + (within >> 3), tn = sn * 8 + (within & 7);
    f32x16 acc[2][2];
    gemm_tile_compute(A + (size_t)tm * 128 * lda, lda, B + (size_t)tn * 128 * ldb, ldb, K, smem, acc);
    gemm_epilogue<EPI>(acc, tm * 128, tn * 128, tn, ea, smem);
  }
}

struct AttnPtrs { const bf16_t* Q; int ldq; const bf16_t* K; int ldk; const bf16_t* Vt; int ldv; const float* kbias; };

DI float xhalf_max(float v) {
  const auto r2 = __builtin_amdgcn_permlane32_swap(__float_as_uint(v), __float_as_uint(v), false, false);
  return fmaxf(__uint_as_float(r2[0]), __uint_as_float(r2[1]));
}
DI float xhalf_sum(float v) {
  const auto r2 = __builtin_amdgcn_permlane32_swap(__float_as_uint(v), __float_as_uint(v), false, false);
  return __uint_as_float(r2[0]) + __uint_as_float(r2[1]);
}

template <int MODE>
DI void attn_block(const AttnPtrs& a, int q0b, char* smem, const float* tbl, f32x16 (&o)[4], float& l_out) {
  const int tid = TID(), lane = tid & 63, wave = __builtin_amdgcn_readfirstlane(tid >> 6);
  const int r = lane & 31, h = lane >> 5;
  const int q0 = q0b + 32 * wave;
  const float scale2 = 0.08838834764831845f * LOG2E;
  const int krow = tid >> 4, kch = tid & 15;
  const int vrow = tid >> 3, vch = tid & 7;
  const char* Kb = (const char*)a.K;
  const char* Vb = (const char*)a.Vt;
  const unsigned kvo = (unsigned)(krow * a.ldk + kch * 8) * 2u;
  const unsigned vvo = (unsigned)(vrow * a.ldv + vch * 8) * 2u;
  const unsigned kst = (unsigned)(16 * a.ldk) * 2u, vst = (unsigned)(32 * a.ldv) * 2u;
  const int kwo = krow * 256 + ((kch ^ (krow & 15)) << 4);
  const int vwo = 16384 + vrow * 128 + ((vch ^ ((vrow >> 1) & 7)) << 4);
  const int pr = (r & ~12) | ((r & 4) << 1) | ((r & 8) >> 1);
  const int kro = pr * 256, ksw = pr & 15;
  const int vro = 16384 + r * 128, vsw = (r >> 1) & 7;
  bf16x8 qf[8];
#pragma unroll
  for (int s = 0; s < 8; ++s) qf[s] = *(const bf16x8*)(a.Q + (size_t)(q0 + r) * a.ldq + 16 * s + 8 * h);
#pragma unroll
  for (int dt = 0; dt < 4; ++dt)
#pragma unroll
    for (int e = 0; e < 16; ++e) o[dt][e] = 0.f;
  float m = -1e30f, l = 0.f;
  const int nkt = (q0b + 128) >> 6;
  u32x4 rk[4], rv[4];
#pragma unroll
  for (int i = 0; i < 4; ++i) {
    rk[i] = *(const u32x4*)(Kb + (size_t)(i * kst) + kvo);
    rv[i] = *(const u32x4*)(Vb + (size_t)(i * vst) + vvo);
  }
#pragma unroll
  for (int i = 0; i < 4; ++i) {
    *(u32x4*)(smem + kwo + i * 4096) = rk[i];
    *(u32x4*)(smem + vwo + i * 4096) = rv[i];
  }
  __syncthreads();
  for (int kt = 0; kt < nkt; ++kt) {
    const int k0 = kt << 6;
    char* st = smem + (kt & 1) * 32768;
    {
      const int kn = (kt + 1 < nkt) ? k0 + 64 : k0;
      const size_t kbo = (size_t)kn * (size_t)a.ldk * 2u, vbo = (size_t)kn * 2u;
#pragma unroll
      for (int i = 0; i < 4; ++i) {
        rk[i] = *(const u32x4*)(Kb + (kbo + i * kst) + kvo);
        rv[i] = *(const u32x4*)(Vb + (vbo + i * vst) + vvo);
      }
    }
    asm volatile("" ::: "memory");
    __builtin_amdgcn_sched_barrier(0);
#pragma unroll
    for (int sub = 0; sub < 2; ++sub) {
      const int ks0 = k0 + 32 * sub;
      if (ks0 <= q0) {
        f32x16 sa;
#pragma unroll
        for (int e = 0; e < 16; ++e) sa[e] = 0.f;
#pragma unroll
        for (int s = 0; s < 8; ++s) {
          const bf16x8 kf = *(const bf16x8*)(st + kro + sub * 8192 + (((2 * s + h) ^ ksw) << 4));
          sa = MFMA32(kf, qf[s], sa);
        }
        float v[16];
        if (MODE == 0) {
#pragma unroll
          for (int c = 0; c < 2; ++c) {
            const float4 kb0 = *(const float4*)(a.kbias + ks0 + 16 * c + 8 * h);
            const float4 kb1 = *(const float4*)(a.kbias + ks0 + 16 * c + 8 * h + 4);
            v[8 * c + 0] = sa[8 * c + 0] * scale2 - kb0.x * LOG2E; v[8 * c + 1] = sa[8 * c + 1] * scale2 - kb0.y * LOG2E;
            v[8 * c + 2] = sa[8 * c + 2] * scale2 - kb0.z * LOG2E; v[8 * c + 3] = sa[8 * c + 3] * scale2 - kb0.w * LOG2E;
            v[8 * c + 4] = sa[8 * c + 4] * scale2 - kb1.x * LOG2E; v[8 * c + 5] = sa[8 * c + 5] * scale2 - kb1.y * LOG2E;
            v[8 * c + 6] = sa[8 * c + 6] * scale2 - kb1.z * LOG2E; v[8 * c + 7] = sa[8 * c + 7] * scale2 - kb1.w * LOG2E;
          }
          if (ks0 == q0) {
#pragma unroll
            for (int e = 0; e < 16; ++e) if ((e & 7) + 8 * h + 16 * (e >> 3) > r) v[e] = -INFINITY;
          }
        } else {
          const float* tp = tbl + (q0 - ks0) + r + 32 - 8 * h - 23;
#pragma unroll
          for (int e = 0; e < 16; ++e) v[e] = sa[e] * scale2 + tp[23 - ((e & 7) + 16 * (e >> 3))];
        }
        float mx = v[0];
#pragma unroll
        for (int e = 1; e < 16; ++e) mx = fmaxf(mx, v[e]);
        mx = xhalf_max(mx);
        if (__ballot(mx > m + 8.f) != 0ull) {
          const float mn = fmaxf(m, mx);
          const float alpha = exp2f(m - mn);
          m = mn;
          l *= alpha;
#pragma unroll
          for (int dt = 0; dt < 4; ++dt)
#pragma unroll
            for (int e = 0; e < 16; ++e) o[dt][e] *= alpha;
        }
        float ps = 0.f;
#pragma unroll
        for (int e = 0; e < 16; ++e) { v[e] = exp2f(v[e] - m); ps += v[e]; }
        l += ps;
        bf16x8 pb[2];
#pragma unroll
        for (int s = 0; s < 2; ++s) {
          const u32x4 u = {pack_bf2(v[8 * s + 0], v[8 * s + 1]), pack_bf2(v[8 * s + 2], v[8 * s + 3]),
                           pack_bf2(v[8 * s + 4], v[8 * s + 5]), pack_bf2(v[8 * s + 6], v[8 * s + 7])};
          pb[s] = __builtin_bit_cast(bf16x8, u);
        }
#pragma unroll
        for (int dt = 0; dt < 4; ++dt)
#pragma unroll
          for (int s = 0; s < 2; ++s) {
            const bf16x8 va = *(const bf16x8*)(st + vro + dt * 4096 + (((4 * sub + 2 * s + h) ^ vsw) << 4));
            o[dt] = MFMA32(va, pb[s], o[dt]);
          }
      }
    }
    __builtin_amdgcn_sched_barrier(0);
    asm volatile("" ::: "memory");
    {
      char* sn = smem + ((kt + 1) & 1) * 32768;
#pragma unroll
      for (int i = 0; i < 4; ++i) {
        *(u32x4*)(sn + kwo + i * 4096) = rk[i];
        *(u32x4*)(sn + vwo + i * 4096) = rv[i];
      }
    }
    __syncthreads();
  }
  l_out = xhalf_sum(l);
}

DI void attn_store_bf16(const f32x16 (&o)[4], float linv, bf16_t* out_row  , int ldo) {
  const int lane = TID() & 63, r = lane & 31, h = lane >> 5;
  bf16_t* op = out_row + (size_t)r * ldo + 4 * h;
#pragma unroll
  for (int dt = 0; dt < 4; ++dt)
#pragma unroll
    for (int c = 0; c < 4; ++c)
      *(uint2*)(op + 32 * dt + 8 * c) = make_uint2(pack_bf2(o[dt][4 * c] * linv, o[dt][4 * c + 1] * linv),
                                                    pack_bf2(o[dt][4 * c + 2] * linv, o[dt][4 * c + 3] * linv));
}
DI void attn_store_f32(const f32x16 (&o)[4], float linv, float* out_row, int ldo) {
  const int lane = TID() & 63, r = lane & 31, h = lane >> 5;
  float* op = out_row + (size_t)r * ldo + 4 * h;
#pragma unroll
  for (int dt = 0; dt < 4; ++dt)
#pragma unroll
    for (int c = 0; c < 4; ++c)
      *(float4*)(op + 32 * dt + 8 * c) = make_float4(o[dt][4 * c] * linv, o[dt][4 * c + 1] * linv, o[dt][4 * c + 2] * linv, o[dt][4 * c + 3] * linv);
}

DI int t5_bucket(int n) {
  if (n < 16) return n;
  int lg = 16 + (int)(logf((float)n / 16.f) / 4.852030263919617f * 16.f);
  return lg < 31 ? lg : 31;
}

DI void phase_attn_even(const Params& p, char* smem) {
  const int tid = TID(), wave = __builtin_amdgcn_readfirstlane(tid >> 6), bid = blockIdx.x, G = gridDim.x;
  const bf16_t* QK = (const bf16_t*)(p.ws + WS_QK);
  const bf16_t* VT = (const bf16_t*)(p.ws + WS_VT);
  bf16_t* ATT = (bf16_t*)(p.ws + WS_ATT);
  float* PCS = (float*)(p.ws + WS_SC);
  float* tbl = (float*)(smem + 66048);
  int cur_head = -1;
  for (int item = bid; item < 3072; item += G) {
    const int g = item / 192; int rem = item - g * 192;
    const int qb = 15 - g;
    const int q0b = qb * 128, q0 = q0b + 32 * wave;
    __syncthreads();
    if (rem < 64) {
      const int b = rem >> 3, hh = rem & 7;
      AttnPtrs a;
      a.Q = QK + (size_t)b * S_ * 4096 + hh * 128; a.ldq = 4096;
      a.K = a.Q + 1024; a.ldk = 4096;
      a.Vt = VT + (size_t)(hh * 128) * T_ + b * S_; a.ldv = T_;
      a.kbias = (const float*)(p.ws + WS_FCUM) + (size_t)(b * 8 + hh) * S_;
      f32x16 o[4]; float l;
      attn_block<0>(a, q0b, smem, nullptr, o, l);
      attn_store_bf16(o, 1.f / l, ATT + (size_t)(b * S_ + q0) * D_ + hh * 128, D_);
    } else {
      rem -= 64;
      const int b = rem >> 4, hh = (rem >> 2) & 3, piece = rem & 3;
      const int mm = piece >> 1, half = piece & 1;
      if (hh != cur_head) {
        for (int e = tid; e < 2080; e += NTHREADS) {
          const int dist = e - 32;
          tbl[e] = dist >= 0 ? p.rel_bias[t5_bucket(dist) * 16 + hh] * LOG2E : -INFINITY;
        }
        cur_head = hh;
      }
      AttnPtrs a;
      a.Q = QK + (size_t)b * S_ * 4096 + 2048 + hh * 256 + mm * 128; a.ldq = 4096;
      a.K = a.Q + 1024; a.ldk = 4096;
      a.Vt = VT + (size_t)(1024 + hh * 256 + half * 128) * T_ + b * S_; a.ldv = T_;
      a.kbias = nullptr;
      f32x16 o[4]; float l;
      attn_block<1>(a, q0b, smem, tbl, o, l);
      attn_store_f32(o, 1.f / l, PCS + (((size_t)piece * T_ + (size_t)(b * S_ + q0)) * 4 + hh) * 128, 512);
    }
  }
}

DI void phase_diff_combine(const Params& p) {
  const int lane = TID() & 63;
  const int gw = __builtin_amdgcn_readfirstlane((blockIdx.x * NTHREADS + TID()) >> 6), nw = (gridDim.x * NTHREADS) >> 6;
  const float* PCS = (const float*)(p.ws + WS_SC);
  bf16_t* ATT = (bf16_t*)(p.ws + WS_ATT);
  const float lam = ((const float*)(p.ws + WS_MISC))[0];
  const int half = lane >> 5, dl = (lane & 31) * 4;
  const float4 sg = *(const float4*)(p.even_diff_subln_gain + lane * 4);
  for (int it = gw; it < T_ * 4; it += nw) {
    const float4 a0 = *(const float4*)(PCS + ((size_t)(0 + half) * T_ * 4 + it) * 128 + dl);
    const float4 a1 = *(const float4*)(PCS + ((size_t)(2 + half) * T_ * 4 + it) * 128 + dl);
    float4 v;
    v.x = a0.x - lam * a1.x; v.y = a0.y - lam * a1.y; v.z = a0.z - lam * a1.z; v.w = a0.w - lam * a1.w;
    const float ss = wave_sum(v.x * v.x + v.y * v.y + v.z * v.z + v.w * v.w);
    const float rstd = rsqrtf(ss * (1.f / 256.f) + 1e-6f) * 0.8f;
    const int t = it >> 2, hh = it & 3;
    *(uint2*)(ATT + (size_t)t * D_ + 1024 + hh * 256 + lane * 4) =
        make_uint2(pack_bf2(v.x * rstd * sg.x, v.y * rstd * sg.y), pack_bf2(v.z * rstd * sg.z, v.w * rstd * sg.w));
  }
}

DI void phase_attn_odd(const Params& p, char* smem) {
  const int tid = TID(), wave = __builtin_amdgcn_readfirstlane(tid >> 6), bid = blockIdx.x, G = gridDim.x;
  const bf16_t* QK = (const bf16_t*)(p.ws + WS_QK);
  const bf16_t* VT = (const bf16_t*)(p.ws + WS_VT);
  bf16_t* ATT = (bf16_t*)(p.ws + WS_ATT);
  float* tbl = (float*)(smem + 66048);
  int cur_head = -1;
  for (int item = bid; item < 2048; item += G) {
    const int g = item >> 7, rem = item & 127;
    const int qb = 15 - g, b = rem >> 4, hd = rem & 15;
    __syncthreads();
    if (hd != cur_head) {
      for (int e = tid; e < 2080; e += NTHREADS) {
        const int dist = e - 32;
        float val = -INFINITY;
        if (dist >= 0) {
          int cnt = 0;
          if (dist <= 128) cnt += 1;
          if (dist <= 512 && (dist & 3) == 0) cnt += 1;
          if ((dist & 15) == 0) cnt += 1;
          if (cnt > 0) val = (p.rel_bias[t5_bucket(dist) * 16 + hd] + __logf((float)cnt)) * LOG2E;
        }
        tbl[e] = val;
      }
      cur_head = hd;
    }
    const int q0b = qb * 128, q0 = q0b + 32 * wave;
    AttnPtrs a;
    a.Q = QK + (size_t)b * S_ * 4096 + hd * 128; a.ldq = 4096;
    a.K = a.Q + 2048; a.ldk = 4096;
    a.Vt = VT + (size_t)(hd * 128) * T_ + b * S_; a.ldv = T_;
    a.kbias = nullptr;
    f32x16 o[4]; float l;
    attn_block<1>(a, q0b, smem, tbl, o, l);
    attn_store_bf16(o, 1.f / l, ATT + (size_t)(b * S_ + q0) * D_ + hd * 128, D_);
  }
}

DI unsigned fkey(float f) { const unsigned u = __float_as_uint(f); return (u & 0x80000000u) ? ~u : (u | 0x80000000u); }
DI int popc64(unsigned long long m) { return __popcll(m); }
DI int mbcnt(unsigned long long m) { return __builtin_amdgcn_mbcnt_hi((unsigned)(m >> 32), __builtin_amdgcn_mbcnt_lo((unsigned)m, 0)); }

template <int NP, int NV>
DI void select16_multi(const unsigned (&key)[NP][NV], bool (&sel)[NP][NV], int (&pos)[NP][NV]) {
  unsigned thr[NP];
#pragma unroll
  for (int q = 0; q < NP; ++q) thr[q] = 0u;
#pragma unroll 1
  for (int bit = 31; bit >= 0; --bit) {
#pragma unroll
    for (int q = 0; q < NP; ++q) {
      const unsigned cand = thr[q] | (1u << bit);
      int cnt = 0;
#pragma unroll
      for (int a = 0; a < NV; ++a) cnt += popc64(__ballot(key[q][a] >= cand));
      thr[q] = (cnt >= 16) ? cand : thr[q];
    }
  }
#pragma unroll
  for (int q = 0; q < NP; ++q) {
    int cgt = 0;
#pragma unroll
    for (int a = 0; a < NV; ++a) cgt += popc64(__ballot(key[q][a] > thr[q]));
    const int need = 16 - cgt;
    int eqbase = 0, sbase = 0;
#pragma unroll
    for (int a = 0; a < NV; ++a) {
      const bool eq = key[q][a] == thr[q];
      const unsigned long long em = __ballot(eq);
      const bool sl = (key[q][a] > thr[q]) || (eq && (eqbase + mbcnt(em)) < need);
      eqbase += popc64(em);
      const unsigned long long sm = __ballot(sl);
      sel[q][a] = sl; pos[q][a] = sbase + mbcnt(sm);
      sbase += popc64(sm);
    }
  }
}

DI float gelu_erf(float x) { return 0.5f * x * (1.f + erff(x * 0.7071067811865476f)); }

DI void phase_peer(const Params& p, int layer, const float* __restrict__ gate2  , char* smem) {
  const int tid = TID(), lane = tid & 63, wave = __builtin_amdgcn_readfirstlane(tid >> 6);
  const int gw = __builtin_amdgcn_readfirstlane((blockIdx.x * NTHREADS + tid) >> 6), nw = (gridDim.x * NTHREADS) >> 6;
  float* wl_s = (float*)(smem + wave * 2048);
  int* wl_i = (int*)(smem + wave * 2048 + 512);
  int* ex_i = (int*)(smem + wave * 2048 + 1024);
  float* ex_g = (float*)(smem + wave * 2048 + 1536);
  const float* SC = (const float*)(p.ws + WS_SC);
  const bf16_t* H = (const bf16_t*)(p.ws + WS_H);
  const unsigned char* PU = (const unsigned char*)(p.ws + WS_PEERU) + (size_t)layer * NEXP * D_;
  const unsigned char* PV = (const unsigned char*)(p.ws + WS_PEERV8) + (size_t)layer * NEXP * D_;
  const float* USC = (const float*)(p.ws + WS_PEERV) + (size_t)layer * NEXP;
  const float* VSC = (const float*)(p.ws + WS_PEERV) + (size_t)(2 + layer) * NEXP;
  for (int t = gw; t < T_; t += nw) {
#pragma unroll 1
    for (int hg = 0; hg < 2; ++hg) {
      float sv[4][4];
#pragma unroll
      for (int hl = 0; hl < 4; ++hl) {
        const float* sr = SC + ((size_t)t * 8 + hg * 4 + hl) * 256;
#pragma unroll
        for (int a = 0; a < 4; ++a) sv[hl][a] = sr[a * 64 + lane];
      }
      {
        unsigned key[8][2]; bool sel[8][2]; int pos[8][2];
#pragma unroll
        for (int hl = 0; hl < 4; ++hl)
#pragma unroll
          for (int pp = 0; pp < 2; ++pp) { key[hl * 2 + pp][0] = fkey(sv[hl][2 * pp]); key[hl * 2 + pp][1] = fkey(sv[hl][2 * pp + 1]); }
        select16_multi<8, 2>(key, sel, pos);
#pragma unroll
        for (int hl = 0; hl < 4; ++hl)
#pragma unroll
          for (int pp = 0; pp < 2; ++pp)
#pragma unroll
            for (int a = 0; a < 2; ++a)
              if (sel[hl * 2 + pp][a]) { wl_s[(hl * 2 + pp) * 16 + pos[hl * 2 + pp][a]] = sv[hl][2 * pp + a]; wl_i[(hl * 2 + pp) * 16 + pos[hl * 2 + pp][a]] = a * 64 + lane; }
      }
      float cs[4][4]; int ci[4][4]; unsigned ck[4][4]; bool sel[4][4]; int pos[4][4];
#pragma unroll
      for (int hl = 0; hl < 4; ++hl) {
        const float sa = wl_s[(hl * 2) * 16 + (lane >> 2)];
        const int ia = wl_i[(hl * 2) * 16 + (lane >> 2)];
#pragma unroll
        for (int j = 0; j < 4; ++j) {
          cs[hl][j] = sa + wl_s[(hl * 2 + 1) * 16 + (lane & 3) * 4 + j];
          ci[hl][j] = ia * 128 + wl_i[(hl * 2 + 1) * 16 + (lane & 3) * 4 + j];
          ck[hl][j] = fkey(cs[hl][j]);
        }
      }
      select16_multi<4, 4>(ck, sel, pos);
      float mx[4], es[4], e[4][4];
#pragma unroll
      for (int hl = 0; hl < 4; ++hl) {
        mx[hl] = -INFINITY;
#pragma unroll
        for (int j = 0; j < 4; ++j) if (sel[hl][j]) mx[hl] = fmaxf(mx[hl], cs[hl][j]);
      }
#pragma unroll
      for (int o = 32; o >= 1; o >>= 1)
#pragma unroll
        for (int hl = 0; hl < 4; ++hl) mx[hl] = fmaxf(mx[hl], __shfl_xor(mx[hl], o));
#pragma unroll
      for (int hl = 0; hl < 4; ++hl) {
        es[hl] = 0.f;
#pragma unroll
        for (int j = 0; j < 4; ++j) { e[hl][j] = sel[hl][j] ? __expf(cs[hl][j] - mx[hl]) : 0.f; es[hl] += e[hl][j]; }
      }
#pragma unroll
      for (int o = 32; o >= 1; o >>= 1)
#pragma unroll
        for (int hl = 0; hl < 4; ++hl) es[hl] += __shfl_xor(es[hl], o);
#pragma unroll
      for (int hl = 0; hl < 4; ++hl) {
        const float inv = 1.f / es[hl];
        const int hh = hg * 4 + hl;
#pragma unroll
        for (int j = 0; j < 4; ++j) if (sel[hl][j]) { ex_i[hh * 16 + pos[hl][j]] = ci[hl][j]; ex_g[hh * 16 + pos[hl][j]] = e[hl][j] * inv; }
      }
    }
    float xf[32];
    {
      const bf16_t* hr = H + (size_t)t * D_ + lane * 16;
#pragma unroll
      for (int i = 0; i < 2; ++i)
#pragma unroll
        for (int hq = 0; hq < 2; ++hq) {
          const uint4 u = *(const uint4*)(hr + 1024 * i + 8 * hq);
          const unsigned w[4] = {u.x, u.y, u.z, u.w};
#pragma unroll
          for (int k = 0; k < 4; ++k) { xf[16 * i + 8 * hq + 2 * k] = bf_lo(w[k]); xf[16 * i + 8 * hq + 2 * k + 1] = bf_hi(w[k]); }
        }
    }
    float y[32];
#pragma unroll
    for (int j = 0; j < 32; ++j) y[j] = 0.f;
    uint4 ua[2][2], va[2][2], ub[2][2], vb[2][2];
    float sua[2], sva[2], sub_[2], svb[2];
#define PEER_LOAD(UR, VR, SU, SV, EB)                                                                   \
    _Pragma("unroll") for (int q = 0; q < 2; ++q) {                                                     \
      const int id = __builtin_amdgcn_readfirstlane(ex_i[(EB) + q]);                                   \
      const unsigned char* up = PU + (size_t)id * D_ + lane * 16;                                      \
      const unsigned char* vp = PV + (size_t)id * D_ + lane * 16;                                      \
      UR[q][0] = *(const uint4*)(up); UR[q][1] = *(const uint4*)(up + 1024);                           \
      VR[q][0] = *(const uint4*)(vp); VR[q][1] = *(const uint4*)(vp + 1024);                           \
      SU[q] = USC[id]; SV[q] = VSC[id];                                                                 \
    }
#define PEER_COMPUTE(UR, VR, SU, SV, EB)                                                                \
    {                                                                                                   \
      float dq[2];                                                                                      \
      _Pragma("unroll") for (int q = 0; q < 2; ++q) {                                                   \
        float a0 = 0.f, a1 = 0.f;                                                                       \
        _Pragma("unroll") for (int i = 0; i < 2; ++i) {                                                 \
          const unsigned w[4] = {UR[q][i].x, UR[q][i].y, UR[q][i].z, UR[q][i].w};                      \
          _Pragma("unroll") for (int k = 0; k < 4; ++k) {                                               \
            const f2_t lo = __builtin_amdgcn_cvt_pk_f32_fp8((int)w[k], false);                         \
            const f2_t hi = __builtin_amdgcn_cvt_pk_f32_fp8((int)w[k], true);                          \
            a0 += lo.x * xf[16 * i + 4 * k] + hi.x * xf[16 * i + 4 * k + 2];                            \
            a1 += lo.y * xf[16 * i + 4 * k + 1] + hi.y * xf[16 * i + 4 * k + 3];                        \
          }                                                                                             \
        }                                                                                               \
        dq[q] = a0 + a1;                                                                                \
      }                                                                                                 \
                            \
      const bool hb = lane >= 32;                                                                       \
      float kk = hb ? dq[1] : dq[0];                                                                    \
      const float ss = hb ? dq[0] : dq[1];                                                              \
      kk += __shfl_xor(ss, 32);                                                                         \
      kk += __shfl_xor(kk, 16); kk += __shfl_xor(kk, 8); kk += __shfl_xor(kk, 4); kk += __shfl_xor(kk, 2); kk += __shfl_xor(kk, 1); \
      const float cfl = (hb ? ex_g[(EB) + 1] : ex_g[(EB)]) * gelu_erf(kk * (hb ? SU[1] : SU[0])) * (hb ? SV[1] : SV[0]); \
      _Pragma("unroll") for (int q = 0; q < 2; ++q) {                                                   \
        const float cf = __builtin_bit_cast(float, __builtin_amdgcn_readlane(__builtin_bit_cast(int, cfl), 32 * q)); \
        _Pragma("unroll") for (int i = 0; i < 2; ++i) {                                                 \
          const unsigned w[4] = {VR[q][i].x, VR[q][i].y, VR[q][i].z, VR[q][i].w};                      \
          _Pragma("unroll") for (int k = 0; k < 4; ++k) {                                               \
            const f2_t lo = __builtin_amdgcn_cvt_pk_f32_fp8((int)w[k], false);                         \
            const f2_t hi = __builtin_amdgcn_cvt_pk_f32_fp8((int)w[k], true);                          \
            y[16 * i + 4 * k] += cf * lo.x; y[16 * i + 4 * k + 1] += cf * lo.y;                          \
            y[16 * i + 4 * k + 2] += cf * hi.x; y[16 * i + 4 * k + 3] += cf * hi.y;                      \
          }                                                                                             \
        }                                                                                               \
      }                                                                                                 \
    }
    PEER_LOAD(ua, va, sua, sva, 0)
#pragma unroll 1
    for (int eb = 0; eb < 128; eb += 4) {
      PEER_LOAD(ub, vb, sub_, svb, eb + 2)
      PEER_COMPUTE(ua, va, sua, sva, eb)
      if (eb + 4 < 128) { PEER_LOAD(ua, va, sua, sva, eb + 4) }
      PEER_COMPUTE(ub, vb, sub_, svb, eb + 2)
    }
#undef PEER_LOAD
#undef PEER_COMPUTE
    {
      const int b = t >> 11;
      float* orow = p.out + (size_t)t * D_ + lane * 16;
      const float* grow = gate2 + (size_t)b * 12288 + lane * 16;
#pragma unroll
      for (int i = 0; i < 2; ++i)
#pragma unroll
        for (int j = 0; j < 4; ++j) {
          float4 a0 = *(const float4*)(orow + 1024 * i + 4 * j);
          const float4 g0 = *(const float4*)(grow + 1024 * i + 4 * j);
          a0.x += g0.x * y[16 * i + 4 * j]; a0.y += g0.y * y[16 * i + 4 * j + 1];
          a0.z += g0.z * y[16 * i + 4 * j + 2]; a0.w += g0.w * y[16 * i + 4 * j + 3];
          *(float4*)(orow + 1024 * i + 4 * j) = a0;
        }
    }
  }
}

DI void phase_peer_scores(const Params& p, int layer, char* smem) {
  const bf16_t* QP = (const bf16_t*)(p.ws + WS_QK);
  const bf16_t* SK = (const bf16_t*)(p.ws + WS_SK) + (size_t)layer * 2 * 128 * 128;
  EpiArgs ea{}; ea.out = nullptr; ea.ldc = 256;
  for (int L = blockIdx.x; L < 2048; L += gridDim.x) {
    const int pp = L & 1, tm = L >> 1;
    f32x16 acc[2][2];
    gemm_tile_compute(QP + (size_t)tm * 128 * 256 + pp * 128, 256, SK + (size_t)pp * 128 * 128, 128, 128, smem, acc);
    ea.out = (float*)(p.ws + WS_SC) + pp * 128;
    gemm_epilogue<EPI_F32>(acc, tm * 128, 0, 0, ea, smem);
  }
}


#define XB_TMO      128
#define XB_XCNT(j)  (256  + 64 * (j))
#define XB_XSUB(j)  (1280 + 64 * (j))
#define XB_XGEN(j)  (2304 + 64 * (j))
#define XB_TOP      3328
#define XB_TOPGEN   3392
#define XCD_BAR_WORDS 3456
#define XB_SPIN_CAP (1u << 22)
#define LAS __attribute__((address_space(3)))
DI unsigned xb_ld(unsigned* p) { return __hip_atomic_load(p, __ATOMIC_RELAXED, __HIP_MEMORY_SCOPE_AGENT); }
DI unsigned xb_add(unsigned* p, unsigned v) { return __hip_atomic_fetch_add(p, v, __ATOMIC_RELAXED, __HIP_MEMORY_SCOPE_AGENT); }
DI unsigned xb_xcc_id() { return (unsigned)__builtin_amdgcn_s_getreg((3 << 11) | 20) & 0xFu; }
#define XB_SPIN(cond, bar) do { unsigned _sp = 0; while (cond) { __builtin_amdgcn_s_sleep(1); \
    if ((++_sp & 255u) == 0u) { if (xb_ld(&(bar)[XB_TMO])) break; if (_sp > XB_SPIN_CAP) { atomicAdd(&(bar)[XB_TMO], 1u); break; } } } } while (0)
struct XcdBarrier { unsigned* bar; unsigned x; volatile LAS unsigned* st; };
DI XcdBarrier xcd_barrier_post(unsigned* bar, volatile LAS unsigned* st) {
  XcdBarrier b; b.bar = bar; b.x = xb_xcc_id(); b.st = st;
  if (threadIdx.x == 0) (void)xb_add(&bar[XB_XCNT(b.x)], 1u);
  return b;
}
DI void xcd_barrier_complete(unsigned* bar, unsigned x, unsigned& nloc, unsigned& nx) {
  const unsigned G = gridDim.x * gridDim.y * gridDim.z;
  unsigned sum, cnt, mine, sp = 0u;
  for (;;) {
    sum = 0u; cnt = 0u; mine = 0u;
#pragma unroll
    for (unsigned j = 0; j < 16; ++j) { const unsigned c = xb_ld(&bar[XB_XCNT(j)]); sum += c; cnt += (c > 0u) ? 1u : 0u; mine = (j == x) ? c : mine; }
    if (sum == G) break;
    __builtin_amdgcn_s_sleep(1);
    if ((++sp & 255u) == 0u) { if (xb_ld(&bar[XB_TMO])) break; if (sp > XB_SPIN_CAP) { atomicAdd(&bar[XB_TMO], 1u); break; } }
  }
  nloc = mine > 0u ? mine : 1u; nx = cnt > 0u ? cnt : 1u;
}
DI void xcd_barrier(const XcdBarrier& b) {
  asm volatile("s_waitcnt vmcnt(0)" ::: "memory");
  __syncthreads();
  if (threadIdx.x == 0) {
    unsigned* bar = b.bar;
    __builtin_amdgcn_s_waitcnt(0);
    unsigned nloc = b.st[0], nx = b.st[1];
    if (nloc == 0u) { xcd_barrier_complete(bar, b.x, nloc, nx); b.st[0] = nloc; b.st[1] = nx; }
    const unsigned old = xb_add(&bar[XB_XSUB(b.x)], 1u);
    const unsigned gen = old / nloc;
    if (old + 1u == (gen + 1u) * nloc) {
      __builtin_amdgcn_fence(__ATOMIC_RELEASE, "agent");
      asm volatile("s_waitcnt vmcnt(0)" ::: "memory");
      const unsigned og = xb_add(&bar[XB_TOP], 1u);
      const unsigned tg = og / nx;
      if (og + 1u == (tg + 1u) * nx) xb_add(&bar[XB_TOPGEN], 1u);
      else XB_SPIN(xb_ld(&bar[XB_TOPGEN]) == tg, bar);
      __builtin_amdgcn_fence(__ATOMIC_ACQUIRE, "agent");
      xb_add(&bar[XB_XGEN(b.x)], 1u);
      asm volatile("s_waitcnt vmcnt(0)" ::: "memory");
    } else {
      XB_SPIN(xb_ld(&bar[XB_XGEN(b.x)]) == gen, bar);
      __builtin_amdgcn_fence(__ATOMIC_ACQUIRE, "agent");
      asm volatile("s_waitcnt vmcnt(0)" ::: "memory");
    }
  }
  __syncthreads();
}

constexpr int N_PHASES = 18;
DI void run_phase(const Params& p, int ph, char* smem) {
  char* ws = p.ws;
  const float* mod = (const float*)(ws + WS_MOD);
  const bf16_t* H = (const bf16_t*)(ws + WS_H);
  if (ph == 0) { phase_prep(p, smem); return; }
  const int layer = ph >= 10 ? 1 : 0;
  int sub;
  if (layer == 0) sub = ph <= 3 ? ph - 1 : (ph == 4 ? 8 : ph - 2);
  else sub = ph <= 12 ? ph - 10 : ph - 10;
  const float* modl = mod + (size_t)layer * 8 * 12288;
  switch (sub) {
    case 0:
      if (layer == 0) phase_norm<true>(p, p.x, p.norm_gain, modl, modl + 2048);
      else phase_norm<false>(p, p.out, p.norm_gain + 2 * 2048, modl, modl + 2048);
      break;
    case 1: {
      if (layer == 0) fox_cumsum(p);
      EpiArgs ea{}; ea.out = ws + WS_QK; ea.ldc = 4096;
      if (layer == 0) {
        ea.gainA = p.even_fox_qk_gain; ea.gainB = p.even_diff_qk_gain; ea.gshift = 3;
      } else { ea.gainA = p.odd_qk_gain; ea.gainB = p.odd_qk_gain; ea.gshift = 4; }
      gemm_phase<EPI_NORM_BF16>(H, 2048, (const bf16_t*)(ws + (layer ? WS_WQK1 : WS_WQK0)), 2048, 2048, 128, 32, ea, smem);
      EpiArgs ev{}; ev.out = ws + WS_VT; ev.ldc = T_;
      gemm_phase<EPI_BF16>((const bf16_t*)(ws + (layer ? WS_WV1 : WS_WV0)), 2048, H, 2048, 2048, 16, 128, ev, smem);
    } break;
    case 2:
      if (layer == 0) phase_attn_even(p, smem); else phase_attn_odd(p, smem);
      break;
    case 8: phase_diff_combine(p); break;
    case 3: {
      EpiArgs ea{}; ea.out = p.out; ea.ldc = 2048; ea.xin = layer ? p.out : p.x; ea.gate = modl + 2 * 2048;
      gemm_phase<EPI_RES_F32>((const bf16_t*)(ws + WS_ATT), 2048, (const bf16_t*)(ws + (layer ? WS_WO1 : WS_WO0)), 2048, 2048, 128, 16, ea, smem);
    } break;
    case 4:
      phase_norm<false>(p, p.out, p.norm_gain + (layer * 2 + 1) * 2048, modl + 3 * 2048, modl + 4 * 2048);
      break;
    case 5: {
      EpiArgs ea{}; ea.out = ws + WS_QK; ea.ldc = 2048;
      gemm_phase<EPI_BF16>(H, 2048, (const bf16_t*)(ws + (layer ? WS_WQ1 : WS_WQ0)), 2048, 2048, 128, 16, ea, smem);
    } break;
    case 6: phase_peer_scores(p, layer, smem); break;
    case 7: phase_peer(p, layer, modl + 5 * 2048, smem); break;
  }
}

#if FUSED
__global__ void __launch_bounds__(NTHREADS, 2) mega_kernel(Params p) {
  extern __shared__ __attribute__((aligned(16))) char smem[];
  cg::grid_group grid = cg::this_grid();
  volatile LAS unsigned* xst = (volatile LAS unsigned*)(smem + SMEM_BYTES - 16);
  if (threadIdx.x == 0) { xst[0] = 0u; xst[1] = 0u; }
  __syncthreads();
  const XcdBarrier xb = xcd_barrier_post((unsigned*)(p.ws + WS_BAR), xst);
#pragma unroll
  for (int ph = 0; ph < N_PHASES; ++ph) {
    run_phase(p, ph, smem);
    if (ph == 0) grid.sync();
    else if (ph + 1 < N_PHASES) xcd_barrier(xb);
  }
}
#else
template <int PH>
__global__ void __launch_bounds__(NTHREADS, 2) phase_kernel(Params p) {
  extern __shared__ __attribute__((aligned(16))) char smem[];
  run_phase(p, PH, smem);
}
template <int PH>
static void launch_phases(const Params& p, int grid, hipStream_t stream) {
  if constexpr (PH < N_PHASES) {
    (void)hipFuncSetAttribute((const void*)phase_kernel<PH>, hipFuncAttributeMaxDynamicSharedMemorySize, SMEM_BYTES);
    phase_kernel<PH><<<grid, NTHREADS, SMEM_BYTES, stream>>>(p);
    launch_phases<PH + 1>(p, grid, stream);
  }
}
#endif

extern "C" void kernel_launch(void* const* d_in, const int* in_sizes, int n_in, void* d_out, int out_size, void* d_ws,
                              size_t ws_size, hipStream_t stream) {
  Params p{};
  p.x = (const float*)d_in[0]; p.c = (const float*)d_in[1]; p.rel_bias = (const float*)d_in[2];
  p.norm_gain = (const float*)d_in[3]; p.w_ada = (const float*)d_in[4]; p.b_ada = (const float*)d_in[5];
  p.even_w_in = (const float*)d_in[6]; p.even_b_forget = (const float*)d_in[7]; p.even_fox_qk_gain = (const float*)d_in[8];
  p.even_diff_qk_gain = (const float*)d_in[9]; p.even_diff_lambda = (const float*)d_in[10];
  p.even_diff_subln_gain = (const float*)d_in[11]; p.even_w_out = (const float*)d_in[12];
  p.odd_w_qkv = (const float*)d_in[13]; p.odd_qk_gain = (const float*)d_in[14]; p.odd_w_out = (const float*)d_in[15];
  p.peer_w_query = (const float*)d_in[16]; p.peer_sub_keys = (const float*)d_in[17];
  p.peer_u = (const float*)d_in[18]; p.peer_v = (const float*)d_in[19];
  p.out = (float*)d_out; p.ws = (char*)d_ws;
  if (ws_size < WS_END) { fprintf(stderr, "workspace too small: %zu < %zu\n", ws_size, (size_t)WS_END); return; }
#if FUSED
  static int grid_blocks = 0;
  if (!grid_blocks) {
    int dev = 0, cus = 0, per_cu = 0;
    (void)hipGetDevice(&dev);
    (void)hipDeviceGetAttribute(&cus, hipDeviceAttributeMultiprocessorCount, dev);
    (void)hipFuncSetAttribute((const void*)mega_kernel, hipFuncAttributeMaxDynamicSharedMemorySize, SMEM_BYTES);
    (void)hipOccupancyMaxActiveBlocksPerMultiprocessor(&per_cu, mega_kernel, NTHREADS, SMEM_BYTES);
    if (per_cu > 2) per_cu = 2;
    grid_blocks = cus * per_cu;
  }
  (void)hipMemsetAsync(p.ws + WS_BAR, 0, XCD_BAR_WORDS * 4, stream);
  void* args[] = {&p};
  hipError_t e = hipLaunchCooperativeKernel((void*)mega_kernel, dim3(grid_blocks), dim3(NTHREADS), args, SMEM_BYTES, stream);
  if (e != hipSuccess) fprintf(stderr, "cooperative launch failed: %s (grid %d)\n", hipGetErrorString(e), grid_blocks);
#else
  launch_phases<0>(p, 512, stream);
#endif
}
```

```cpp
#include <hip/hip_runtime.h>
#include <hip/hip_cooperative_groups.h>
#include <stdint.h>
#include <stdio.h>
namespace cg = cooperative_groups;

#ifndef FUSED
#define FUSED 1
#endif

#define DI __device__ __forceinline__
typedef unsigned short bf16_t;
typedef __attribute__((ext_vector_type(8))) short bf16x8;
typedef __attribute__((ext_vector_type(4))) short bf16x4;
typedef __attribute__((ext_vector_type(16))) float f32x16;
typedef __attribute__((ext_vector_type(2))) __bf16 bf2_t;
typedef __attribute__((ext_vector_type(2))) float f2_t;
typedef __attribute__((ext_vector_type(4))) unsigned u32x4;
#define MFMA32(a, b, c) __builtin_amdgcn_mfma_f32_32x32x16_bf16((a), (b), (c), 0, 0, 0)

constexpr int T_ = 16384;
constexpr int D_ = 2048;
constexpr int S_ = 2048;
constexpr int NB_ = 8;
constexpr int NEXP = 16384;
constexpr float LOG2E = 1.4426950408889634f;
constexpr int NTHREADS = 256;
constexpr int HALF_SMEM = 75776;
constexpr int RTHREADS = 512;
constexpr int SMEM_BYTES = 2 * HALF_SMEM + 16;

constexpr size_t MiB = 1048576;
constexpr size_t WS_PEERU = 0;
constexpr size_t WS_PEERV8 = WS_PEERU + 64 * MiB;
constexpr size_t WS_PEERV = WS_PEERU + 128 * MiB;
constexpr size_t WS_WQK0 = WS_PEERV + 128 * MiB;
constexpr size_t WS_WV0 = WS_WQK0 + 16 * MiB;
constexpr size_t WS_WQK1 = WS_WV0 + 8 * MiB;
constexpr size_t WS_WV1 = WS_WQK1 + 16 * MiB;
constexpr size_t WS_WO0 = WS_WV1 + 8 * MiB;
constexpr size_t WS_WO1 = WS_WO0 + 8 * MiB;
constexpr size_t WS_WQ0 = WS_WO1 + 8 * MiB;
constexpr size_t WS_WQ1 = WS_WQ0 + 8 * MiB;
constexpr size_t WS_SK = WS_WQ1 + 8 * MiB;
constexpr size_t WS_WFF = WS_SK + 131072;
constexpr size_t WS_MOD = WS_WFF + 65536;
constexpr size_t WS_LOGF = WS_MOD + 786432;
constexpr size_t WS_FCUM = WS_LOGF + 524288;
constexpr size_t WS_MISC = WS_FCUM + 524288;
constexpr size_t WS_H = WS_MISC + 65536;
constexpr size_t WS_QK = WS_H + 64 * MiB;
constexpr size_t WS_VT = WS_QK + 128 * MiB;
constexpr size_t WS_ATT = WS_VT + 64 * MiB;
constexpr size_t WS_SC = WS_ATT + 64 * MiB;
constexpr size_t WS_BAR = WS_SC + 128 * MiB;
constexpr size_t WS_TICKETS = WS_BAR + 16384;
constexpr size_t WS_BAR_BYTES = 16384 + 4096;
constexpr size_t WS_IDX = WS_ATT;
constexpr size_t WS_GATE = WS_ATT + 8 * MiB;
constexpr size_t WS_ACT = WS_ATT + 16 * MiB;
constexpr size_t WS_PD = WS_SC;
constexpr size_t WS_USC4 = WS_PEERV + 1 * MiB;
constexpr size_t WS_H8 = WS_QK;
constexpr size_t WS_HS = WS_QK + 32 * MiB;
constexpr size_t WS_END = WS_BAR + 65536;

struct Params {
  const float* x; const float* c; const float* rel_bias; const float* norm_gain; const float* w_ada; const float* b_ada;
  const float* even_w_in; const float* even_b_forget; const float* even_fox_qk_gain; const float* even_diff_qk_gain;
  const float* even_diff_lambda; const float* even_diff_subln_gain; const float* even_w_out;
  const float* odd_w_qkv; const float* odd_qk_gain; const float* odd_w_out;
  const float* peer_w_query; const float* peer_sub_keys; const float* peer_u; const float* peer_v;
  float* out; char* ws;
};

DI unsigned pack_bf2(float a, float b) { f2_t v = {a, b}; return __builtin_bit_cast(unsigned, __builtin_convertvector(v, bf2_t)); }
DI unsigned pack_i8x4(float a, float b, float c, float d) {
  const int ia = (int)rintf(a), ib = (int)rintf(b), ic = (int)rintf(c), id = (int)rintf(d);
  return (unsigned)(ia & 255) | ((unsigned)(ib & 255) << 8) | ((unsigned)(ic & 255) << 16) | ((unsigned)id << 24);
}
DI unsigned q4(float v) { int q = (int)rintf(v); q = q > 7 ? 7 : (q < -7 ? -7 : q); return (unsigned)q & 15u; }
DI unsigned pack_i4x4(float a, float b, float c, float d) { return q4(a) | (q4(b) << 8) | (q4(c) << 16) | (q4(d) << 24); }
DI bf16_t f2bf(float a) { return (bf16_t)(pack_bf2(a, 0.f) & 0xffffu); }
DI float bf_lo(unsigned u) { return __uint_as_float(u << 16); }
DI float bf_hi(unsigned u) { return __uint_as_float(u & 0xffff0000u); }
DI int RTID() { int t = threadIdx.x; asm volatile("" : "+v"(t)); return t; }
DI int TID() { return RTID() & 255; }
DI int VBID() { return __builtin_amdgcn_readfirstlane(blockIdx.x * 2 + (RTID() >> 8)); }
DI int VGRID() { return gridDim.x * 2; }
DI int xcc_id() { return (int)(__builtin_amdgcn_s_getreg((3 << 11) | 20) & 0xFu); }
DI int crow(int reg, int h) { return (reg & 3) + 8 * (reg >> 2) + 4 * h; }
DI float wave_sum(float v) {
#pragma unroll
  for (int o = 32; o >= 1; o >>= 1) v += __shfl_xor(v, o);
  return v;
}
DI float wave_max(float v) {
#pragma unroll
  for (int o = 32; o >= 1; o >>= 1) v = fmaxf(v, __shfl_xor(v, o));
  return v;
}

DI void transpose_tile(const float* __restrict__ src, int ld, int c0, int k0, bf16_t* __restrict__ dst_row0, char* smem) {
  float* tile = (float*)smem;
  const int tid = TID();
  const int ty = tid >> 4, tx = tid & 15;
#pragma unroll
  for (int i = 0; i < 4; ++i) {
    const int k = ty + 16 * i;
    const float4 v = *(const float4*)(src + (size_t)(k0 + k) * ld + c0 + 4 * tx);
    float* t = tile + k * 65 + 4 * tx;
    t[0] = v.x; t[1] = v.y; t[2] = v.z; t[3] = v.w;
  }
  __syncthreads();
  const int cc = tid >> 2, kc = (tid & 3) * 16;
  unsigned pk[8];
#pragma unroll
  for (int j = 0; j < 8; ++j) pk[j] = pack_bf2(tile[(kc + 2 * j) * 65 + cc], tile[(kc + 2 * j + 1) * 65 + cc]);
  uint4* d = (uint4*)(dst_row0 + (size_t)cc * 2048 + k0 + kc);
  d[0] = make_uint4(pk[0], pk[1], pk[2], pk[3]);
  d[1] = make_uint4(pk[4], pk[5], pk[6], pk[7]);
  __syncthreads();
}

DI void phase_prep(const Params& p, char* smem) {
  const int tid = TID(), bid = VBID(), G = VGRID();
  char* ws = p.ws;
  {
    float* cond = (float*)smem;
    bool have_cond = false;
    for (int item = bid; item < 384; item += G) {
      if (!have_cond) {
        for (int e = tid; e < NB_ * D_; e += NTHREADS) {
          const int b = e >> 11, d = e & 2047;
          const float v = p.c[e];
          cond[d * 8 + b] = v / (1.f + __expf(-v));
        }
        have_cond = true;
        __syncthreads();
      }
      const int i = item / 192, n = (item % 192) * 64 + (tid & 63);
      const int w = tid >> 6;
      const float* wp = p.w_ada + (size_t)i * D_ * 12288 + n;
      float acc[8];
#pragma unroll
      for (int b = 0; b < 8; ++b) acc[b] = 0.f;
#pragma unroll 8
      for (int d = w; d < D_; d += 4) {
        const float wv = wp[(size_t)d * 12288];
        const float4 c0 = *(const float4*)(cond + d * 8), c1 = *(const float4*)(cond + d * 8 + 4);
        acc[0] += c0.x * wv; acc[1] += c0.y * wv; acc[2] += c0.z * wv; acc[3] += c0.w * wv;
        acc[4] += c1.x * wv; acc[5] += c1.y * wv; acc[6] += c1.z * wv; acc[7] += c1.w * wv;
      }
      float* red = (float*)(smem + 65536);
#pragma unroll
      for (int b = 0; b < 8; ++b) red[(w * 64 + (tid & 63)) * 8 + b] = acc[b];
      __syncthreads();
      if (tid < 64) {
        float* mod = (float*)(ws + WS_MOD);
#pragma unroll
        for (int b = 0; b < 8; ++b) {
          const float s = red[(0 * 64 + tid) * 8 + b] + red[(1 * 64 + tid) * 8 + b] + red[(2 * 64 + tid) * 8 + b] + red[(3 * 64 + tid) * 8 + b];
          mod[((size_t)i * 8 + b) * 12288 + n] = s + p.b_ada[i * 12288 + n];
        }
      }
      __syncthreads();
    }
    __syncthreads();
  }
  {
    bf16_t* wqk0 = (bf16_t*)(ws + WS_WQK0); bf16_t* wv0 = (bf16_t*)(ws + WS_WV0);
    bf16_t* wqk1 = (bf16_t*)(ws + WS_WQK1); bf16_t* wv1 = (bf16_t*)(ws + WS_WV1);
    for (int item = bid; item < 256 * 32; item += G) {
      const int ct = item >> 5, kt = item & 31;
      const float* src; int ld, c0; bf16_t* dst;
      if (ct < 96) {
        const int seg = ct >> 4, cl = (ct & 15) * 64;
        src = p.even_w_in; ld = 6152;
        c0 = (seg < 3 ? seg * 1024 : 3080 + (seg - 3) * 1024) + cl;
        if (seg == 0) dst = wqk0 + (size_t)cl * 2048;
        else if (seg == 1) dst = wqk0 + (size_t)(1024 + cl) * 2048;
        else if (seg == 2) dst = wv0 + (size_t)cl * 2048;
        else if (seg == 3) dst = wqk0 + (size_t)(2048 + cl) * 2048;
        else if (seg == 4) dst = wqk0 + (size_t)(3072 + cl) * 2048;
        else dst = wv0 + (size_t)(1024 + cl) * 2048;
      } else if (ct < 192) {
        const int cl = (ct - 96) * 64;
        src = p.odd_w_qkv; ld = 6144; c0 = cl;
        dst = cl < 4096 ? wqk1 + (size_t)cl * 2048 : wv1 + (size_t)(cl - 4096) * 2048;
      } else {
        const int mi = (ct - 192) >> 5, cl = ((ct - 192) & 31) * 64;
        ld = 2048; c0 = cl;
        if (mi == 0) { src = p.even_w_out; dst = (bf16_t*)(ws + WS_WO0); }
        else { src = p.odd_w_out; dst = (bf16_t*)(ws + WS_WO1); }
        dst += (size_t)cl * 2048;
      }
      transpose_tile(src, ld, c0, kt * 64, dst, smem);
    }
  }
  {
    const int lane = tid & 63;
    const int gw = __builtin_amdgcn_readfirstlane((bid * NTHREADS + tid) >> 6), nw = (G * NTHREADS) >> 6;
    float* scl = (float*)(ws + WS_PEERV);
    float4 nx[8];
    {
      const int r0 = gw < 4 * NEXP ? gw : 0;
      const float* s0 = ((r0 >> 15) ? p.peer_v : p.peer_u) + (size_t)(r0 & 32767) * D_;
#pragma unroll
      for (int i = 0; i < 2; ++i)
#pragma unroll
        for (int j = 0; j < 4; ++j) nx[4 * i + j] = *(const float4*)(s0 + lane * 16 + 1024 * i + 4 * j);
    }
    for (int row = gw; row < 4 * NEXP; row += nw) {
      const int tab = row >> 15, rr = row & 32767;
      unsigned char* dst = (unsigned char*)(ws + (tab ? WS_PEERV8 : WS_PEERU)) + (size_t)(rr >> 14) * NEXP * D_ + (size_t)(rr & (NEXP - 1)) * 128;
      float4 v[8];
      float am = 0.f;
#pragma unroll
      for (int i = 0; i < 8; ++i) v[i] = nx[i];
      {
        const int rn = row + nw < 4 * NEXP ? row + nw : row;
        const float* sn = ((rn >> 15) ? p.peer_v : p.peer_u) + (size_t)(rn & 32767) * D_;
#pragma unroll
        for (int i = 0; i < 2; ++i)
#pragma unroll
          for (int j = 0; j < 4; ++j) nx[4 * i + j] = *(const float4*)(sn + lane * 16 + 1024 * i + 4 * j);
        asm volatile("" ::: "memory");
      }
#pragma unroll
      for (int i = 0; i < 8; ++i) am = fmaxf(am, fmaxf(fmaxf(fabsf(v[i].x), fabsf(v[i].y)), fmaxf(fabsf(v[i].z), fabsf(v[i].w))));
      if (!tab) {
        unsigned char* d4 = (unsigned char*)(ws + WS_PEERU) + (size_t)(rr >> 14) * (8 * NEXP * 128) + (size_t)(rr & (NEXP - 1)) * 128 + (lane & 15) * 8;
        float* sc4 = (float*)(ws + WS_USC4) + (size_t)(rr >> 14) * (8 * NEXP) + (rr & (NEXP - 1));
#pragma unroll
        for (int i = 0; i < 2; ++i) {
          float bm = 0.f;
#pragma unroll
          for (int j = 0; j < 4; ++j) bm = fmaxf(bm, fmaxf(fmaxf(fabsf(v[4 * i + j].x), fabsf(v[4 * i + j].y)), fmaxf(fabsf(v[4 * i + j].z), fabsf(v[4 * i + j].w))));
#pragma unroll
          for (int o = 1; o < 16; o <<= 1) bm = fmaxf(bm, __shfl_xor(bm, o));
          const float sc = bm > 0.f ? 7.5f / bm : 1.f;
          const int slice = 4 * i + (lane >> 4);
          if ((lane & 15) == 0) sc4[(size_t)slice * NEXP] = bm > 0.f ? bm / 7.5f : 1.f;
          unsigned w[2];
#pragma unroll
          for (int gq = 0; gq < 2; ++gq) {
            const float4 a = v[4 * i + 2 * gq], b = v[4 * i + 2 * gq + 1];
            const unsigned lo = pack_i4x4(a.x * sc, a.y * sc, a.z * sc, a.w * sc);
            const unsigned hi = pack_i4x4(b.x * sc, b.y * sc, b.z * sc, b.w * sc);
            w[gq] = lo | (hi << 4);
          }
          *(uint2*)(d4 + (size_t)slice * (NEXP * 128)) = make_uint2(w[0], w[1]);
        }
        continue;
      }
      am = wave_max(am);
      const float sc = am > 0.f ? 127.f / am : 1.f;
      if (lane == 0) scl[row] = am > 0.f ? am / 127.f : 1.f;
#pragma unroll
      for (int i = 0; i < 2; ++i) {
        unsigned w[4];
#pragma unroll
        for (int j = 0; j < 4; ++j) w[j] = pack_i8x4(v[4 * i + j].x * sc, v[4 * i + j].y * sc, v[4 * i + j].z * sc, v[4 * i + j].w * sc);
        *(uint4*)(dst + (size_t)((lane >> 3) + 8 * i) * (NEXP * 128) + (lane & 7) * 16) = make_uint4(w[0], w[1], w[2], w[3]);
      }
    }
  }
  {
    float* sks = (float*)smem;
    float* wqs = (float*)(smem + 33792);
    const int tn = tid >> 4, tk = tid & 15;
    for (int item = bid; item < 2048; item += G) {
      const int layer = item >> 10, hp = (item >> 6) & 15, nt = (item >> 5) & 1, kt = item & 31;
      const float* sk = p.peer_sub_keys + ((size_t)(layer * 2 + (hp & 1)) * 128 + nt * 64) * 128;
      const float* wq = p.peer_w_query + (size_t)layer * 2048 * 2048 + (size_t)(kt * 64) * 2048 + hp * 128;
      __syncthreads();
#pragma unroll
      for (int i = 0; i < 8; ++i) {
        const int idx = tid + 256 * i, row = idx >> 5, c4 = (idx & 31) * 4;
        *(float4*)(sks + row * 132 + c4) = *(const float4*)(sk + (size_t)row * 128 + c4);
        *(float4*)(wqs + row * 132 + c4) = *(const float4*)(wq + (size_t)row * 2048 + c4);
      }
      __syncthreads();
      float acc[4][4];
#pragma unroll
      for (int i = 0; i < 4; ++i)
#pragma unroll
        for (int j = 0; j < 4; ++j) acc[i][j] = 0.f;
#pragma unroll 4
      for (int d = 0; d < 128; d += 4) {
        float4 a[4], b[4];
#pragma unroll
        for (int i = 0; i < 4; ++i) { a[i] = *(const float4*)(sks + (tn + 16 * i) * 132 + d); b[i] = *(const float4*)(wqs + (tk + 16 * i) * 132 + d); }
#pragma unroll
        for (int i = 0; i < 4; ++i)
#pragma unroll
          for (int j = 0; j < 4; ++j) acc[i][j] += a[i].x * b[j].x + a[i].y * b[j].y + a[i].z * b[j].z + a[i].w * b[j].w;
      }
      bf16_t* dst = (bf16_t*)(ws + (layer ? WS_WQ1 : WS_WQ0)) + (size_t)(hp * 128 + nt * 64) * 2048 + kt * 64;
#pragma unroll
      for (int i = 0; i < 4; ++i)
#pragma unroll
        for (int j = 0; j < 4; ++j) dst[(size_t)(tn + 16 * i) * 2048 + tk + 16 * j] = f2bf(acc[i][j]);
    }
    __syncthreads();
  }
  if (bid == G - 1) {
    float* wff = (float*)(ws + WS_WFF);
    for (int e = tid; e < 2048 * 8; e += NTHREADS) wff[e] = p.even_w_in[(size_t)(e >> 3) * 6152 + 3072 + (e & 7)];
    if (tid < 64) {
      const float* l = p.even_diff_lambda;
      float s1 = l[tid] * l[128 + tid] + l[64 + tid] * l[128 + 64 + tid];
      float s2 = l[256 + tid] * l[384 + tid] + l[256 + 64 + tid] * l[384 + 64 + tid];
      s1 = wave_sum(s1); s2 = wave_sum(s2);
      if (tid == 0) ((float*)(ws + WS_MISC))[0] = expf(s1) - expf(s2) + 0.2f;
    }
  }
}

template <bool FF, bool Q8 = false>
DI void phase_norm(const Params& p, const float* __restrict__ xin, const float* __restrict__ gain,
                   const float* __restrict__ sh, const float* __restrict__ sc  ) {
  const int lane = TID() & 63;
  const int gw = __builtin_amdgcn_readfirstlane((VBID() * NTHREADS + TID()) >> 6), nw = (VGRID() * NTHREADS) >> 6;
  bf16_t* H = (bf16_t*)(p.ws + WS_H);
  for (int t = gw; t < T_; t += nw) {
    const int b = t >> 11;
    const float* xr = xin + (size_t)t * D_;
    float4 v[8];
    float ss = 0.f;
#pragma unroll
    for (int i = 0; i < 8; ++i) { v[i] = *(const float4*)(xr + lane * 4 + 256 * i); ss += v[i].x * v[i].x + v[i].y * v[i].y + v[i].z * v[i].z + v[i].w * v[i].w; }
    ss = wave_sum(ss);
    const float rstd = rsqrtf(ss * (1.f / 2048.f) + 1e-6f);
    float ff[8];
    if (FF) {
#pragma unroll
      for (int j = 0; j < 8; ++j) ff[j] = 0.f;
    }
    float am = 0.f;
#pragma unroll
    for (int i = 0; i < 8; ++i) {
      const int c = lane * 4 + 256 * i;
      const float4 g = *(const float4*)(gain + c);
      const float4 s1 = *(const float4*)(sc + (size_t)b * 12288 + c);
      const float4 s0 = *(const float4*)(sh + (size_t)b * 12288 + c);
      float4 h;
      h.x = v[i].x * rstd * g.x * (1.f + s1.x) + s0.x;
      h.y = v[i].y * rstd * g.y * (1.f + s1.y) + s0.y;
      h.z = v[i].z * rstd * g.z * (1.f + s1.z) + s0.z;
      h.w = v[i].w * rstd * g.w * (1.f + s1.w) + s0.w;
      *(uint2*)(H + (size_t)t * D_ + c) = make_uint2(pack_bf2(h.x, h.y), pack_bf2(h.z, h.w));
      if (Q8) { v[i] = h; am = fmaxf(am, fmaxf(fmaxf(fabsf(h.x), fabsf(h.y)), fmaxf(fabsf(h.z), fabsf(h.w)))); }
      if (FF) {
        const float* wff = (const float*)(p.ws + WS_WFF) + c * 8;
        const float hv[4] = {h.x, h.y, h.z, h.w};
#pragma unroll
        for (int e = 0; e < 4; ++e) {
          const float4 w0 = *(const float4*)(wff + e * 8), w1 = *(const float4*)(wff + e * 8 + 4);
          ff[0] += hv[e] * w0.x; ff[1] += hv[e] * w0.y; ff[2] += hv[e] * w0.z; ff[3] += hv[e] * w0.w;
          ff[4] += hv[e] * w1.x; ff[5] += hv[e] * w1.y; ff[6] += hv[e] * w1.z; ff[7] += hv[e] * w1.w;
        }
      }
    }
    if (Q8) {
      am = wave_max(am);
      const float qs = am > 0.f ? 119.f / am : 1.f;
      unsigned char* h8 = (unsigned char*)(p.ws + WS_H8) + (size_t)t * D_ + lane * 4;
#pragma unroll
      for (int i = 0; i < 8; ++i) *(unsigned*)(h8 + 256 * i) = pack_i8x4(v[i].x * qs, v[i].y * qs, v[i].z * qs, v[i].w * qs);
      if (lane == 0) ((float*)(p.ws + WS_HS))[t] = am > 0.f ? am / 119.f : 1.f;
    }
    if (FF) {
#pragma unroll
      for (int j = 0; j < 8; ++j) ff[j] = wave_sum(ff[j]);
      if (lane < 8) {
        float z = ff[0];
#pragma unroll
        for (int j = 1; j < 8; ++j) z = (lane == j) ? ff[j] : z;
        z += p.even_b_forget[lane];
        const float lf = fminf(z, 0.f) - log1pf(__expf(-fabsf(z)));
        ((float*)(p.ws + WS_LOGF))[(size_t)t * 8 + lane] = lf;
      }
    }
  }
}

DI void fox_cumsum(const Params& p) {
  const int lane = TID() & 63;
  const int gw = __builtin_amdgcn_readfirstlane((VBID() * NTHREADS + TID()) >> 6), nw = (VGRID() * NTHREADS) >> 6;
  const float* lf = (const float*)(p.ws + WS_LOGF);
  float* fc = (float*)(p.ws + WS_FCUM);
  for (int it = gw; it < 64; it += nw) {
    const int b = it >> 3, hh = it & 7;
    float v[32];
    float tot = 0.f;
#pragma unroll
    for (int j = 0; j < 32; ++j) { tot += lf[(size_t)(b * S_ + lane * 32 + j) * 8 + hh]; v[j] = tot; }
    float inc = tot;
#pragma unroll
    for (int o = 1; o < 64; o <<= 1) { const float n = __shfl_up(inc, o); if (lane >= o) inc += n; }
    const float base = inc - tot;
#pragma unroll
    for (int j = 0; j < 32; ++j) fc[(size_t)it * S_ + lane * 32 + j] = v[j] + base;
  }
}

namespace pg8 {
#define PG8_LAS __attribute__((address_space(3)))
typedef float f32x4 __attribute__((ext_vector_type(4)));
constexpr int BM = 256, BK = 64, HALF = 128, HTB = HALF * BK * 2  , STAGE_BYTES = 8 * HTB, NXCD = 8, WGM = 8;

__host__ __device__ __forceinline__ int lds_byte(int r, int c) { const int st = (r >> 4) * 2 + (c >> 5), rr = r & 15, cc = c & 31, ob = rr * 64 + cc * 2; return st * 1024 + (ob ^ (((ob >> 9) & 1) << 5)); }
__host__ __device__ __forceinline__ void stage_rc(int b, int& R, int& C) { const int st = b / 1024, sb = b % 1024, swz = sb ^ (((sb >> 9) & 1) << 5); R = (st >> 1) * 16 + swz / 64; C = (st & 1) * 32 + (swz % 64) / 2; }
__host__ __device__ __forceinline__ int perm32(int rho) { const int n = rho >> 4, i = rho & 15; return 8 * (i >> 2) + 4 * n + (i & 3); }

struct Unit { int pm, pn; };
struct Gemm { const bf16_t* A; const bf16_t* Bt; int M, N, K; };

struct StaticOrder {
    int nM, nN, nwg, G, c;
    __host__ __device__ void init(int M, int N, int G_, int c_) { nM = M / BM; nN = N / BM; nwg = nM * nN; G = G_; c = c_; }
    __host__ __device__ bool next(int i, Unit& u) const {
        const long L = (long)i * G + c; if (L >= nwg) return false;
        int wgid = (int)L; { const int q = nwg / NXCD, r = nwg % NXCD, xcd = wgid % NXCD, off = wgid / NXCD; wgid = (xcd < r ? xcd * (q + 1) : r * (q + 1) + (xcd - r) * q) + off; }
        const int nig = WGM * nN, gid = wgid / nig, fm = gid * WGM, gsz = (nM - fm) < WGM ? (nM - fm) : WGM;
        u.pm = fm + ((wgid % nig) % gsz); u.pn = (wgid % nig) / gsz; return true;
    }
    __device__ __forceinline__ void a_ready(const Unit&) const {}
    __device__ __forceinline__ void done(const Unit&) const {}
};

struct EpiF32 {
    static constexpr bool PERM = false, AFTER_DRAIN = false;
    float* C; int ldc; const float* bias;
    __device__ __forceinline__ void operator()(const f32x4 (&acc)[2][2][4][2], const Unit& u, int wr, int wc, int fr, int fq) const {
        const int row0 = u.pm * BM + wr * 64 + fr, col0 = u.pn * BM + wc * 32 + 4 * fq;
        f32x4 bv[2][2];
#pragma unroll
        for (int bj = 0; bj < 2; ++bj)
#pragma unroll
            for (int n = 0; n < 2; ++n) bv[bj][n] = bias ? *(const f32x4*)(bias + col0 + bj * HALF + n * 16) : (f32x4){0.f, 0.f, 0.f, 0.f};
#pragma unroll
        for (int ai = 0; ai < 2; ++ai)
#pragma unroll
            for (int m = 0; m < 4; ++m) { float* rowp = C + (size_t)(row0 + ai * HALF + m * 16) * ldc + col0;
#pragma unroll
                for (int bj = 0; bj < 2; ++bj)
#pragma unroll
                    for (int n = 0; n < 2; ++n) *(f32x4*)(rowp + bj * HALF + n * 16) = acc[ai][bj][m][n] + bv[bj][n]; }
    }
};
struct EpiBf16 {
    static constexpr bool PERM = true, AFTER_DRAIN = false;
    bf16_t* O; int ldc;
    __device__ __forceinline__ void operator()(const f32x4 (&acc)[2][2][4][2], const Unit& u, int wr, int wc, int fr, int fq) const {
        const int row0 = u.pm * BM + wr * 64 + fr, col0 = u.pn * BM + wc * 32 + 8 * fq;
#pragma unroll
        for (int ai = 0; ai < 2; ++ai)
#pragma unroll
            for (int m = 0; m < 4; ++m) { bf16_t* rowp = O + (size_t)(row0 + ai * HALF + m * 16) * ldc + col0;
#pragma unroll
                for (int bj = 0; bj < 2; ++bj) { const f32x4 v0 = acc[ai][bj][m][0], v1 = acc[ai][bj][m][1];
                    u32x4 w; w.x = pack_bf2(v0[0], v0[1]); w.y = pack_bf2(v0[2], v0[3]); w.z = pack_bf2(v1[0], v1[1]); w.w = pack_bf2(v1[2], v1[3]);
                    *(u32x4*)(rowp + bj * HALF) = w; } }
    }
};
struct EpiQkNorm {
    static constexpr bool PERM = true, AFTER_DRAIN = false;
    bf16_t* O; int ldc; const float* gainA; const float* gainB; int gshift; float* red;
    __device__ __forceinline__ void operator()(const f32x4 (&acc)[2][2][4][2], const Unit& u, int wr, int wc, int fr, int fq) const {
        float ss[2][4][2];
#pragma unroll
        for (int ai = 0; ai < 2; ++ai)
#pragma unroll
            for (int m = 0; m < 4; ++m)
#pragma unroll
                for (int bj = 0; bj < 2; ++bj) {
                    const f32x4 v0 = acc[ai][bj][m][0], v1 = acc[ai][bj][m][1];
                    float t = v0[0] * v0[0] + v0[1] * v0[1] + v0[2] * v0[2] + v0[3] * v0[3] + v1[0] * v1[0] + v1[1] * v1[1] + v1[2] * v1[2] + v1[3] * v1[3];
                    t += __shfl_xor(t, 16); t += __shfl_xor(t, 32);
                    ss[ai][m][bj] = t;
                }
        float* myred = red + (wr * 4 + wc) * 256;
        if (fq == 0) {
#pragma unroll
            for (int ai = 0; ai < 2; ++ai)
#pragma unroll
                for (int m = 0; m < 4; ++m)
#pragma unroll
                    for (int bj = 0; bj < 2; ++bj) myred[(ai * 64 + m * 16 + fr) * 2 + bj] = ss[ai][m][bj];
        }
        asm volatile("s_waitcnt lgkmcnt(0)" ::: "memory"); __builtin_amdgcn_s_barrier(); asm volatile("" ::: "memory");
        const int row0 = u.pm * BM + wr * 64 + fr, col0 = u.pn * BM + wc * 32 + 8 * fq;
        const float* rbase = red + (wr * 4) * 256;
#pragma unroll
        for (int bj = 0; bj < 2; ++bj) {
            const int grp = (u.pn * 2 + bj) >> gshift;
            const float* gain = ((grp & 2) ? gainB : gainA) + (grp & 1) * 128 + wc * 32 + 8 * fq;
            const float qs = (grp & 1) ? 1.f : 0.08838834764831845f * LOG2E;
            float4 g0 = *(const float4*)gain, g1 = *(const float4*)(gain + 4);
            g0.x *= qs; g0.y *= qs; g0.z *= qs; g0.w *= qs; g1.x *= qs; g1.y *= qs; g1.z *= qs; g1.w *= qs;
#pragma unroll
            for (int ai = 0; ai < 2; ++ai)
#pragma unroll
                for (int m = 0; m < 4; ++m) {
                    const int ri = (ai * 64 + m * 16 + fr) * 2 + bj;
                    const float tot = rbase[ri] + rbase[256 + ri] + rbase[512 + ri] + rbase[768 + ri];
                    const float rstd = rsqrtf(tot * (1.f / 128.f) + 1e-6f);
                    const f32x4 v0 = acc[ai][bj][m][0], v1 = acc[ai][bj][m][1];
                    u32x4 w;
                    w.x = pack_bf2(v0[0] * rstd * g0.x, v0[1] * rstd * g0.y); w.y = pack_bf2(v0[2] * rstd * g0.z, v0[3] * rstd * g0.w);
                    w.z = pack_bf2(v1[0] * rstd * g1.x, v1[1] * rstd * g1.y); w.w = pack_bf2(v1[2] * rstd * g1.z, v1[3] * rstd * g1.w);
                    *(u32x4*)(O + (size_t)(row0 + ai * HALF + m * 16) * ldc + col0 + bj * HALF) = w;
                }
        }
    }
};
struct EpiRes {
    static constexpr bool PERM = false, AFTER_DRAIN = false;
    float* C; int ldc; const float* xin; const float* gate;
    __device__ __forceinline__ void operator()(const f32x4 (&acc)[2][2][4][2], const Unit& u, int wr, int wc, int fr, int fq) const {
        const int row0 = u.pm * BM + wr * 64 + fr, col0 = u.pn * BM + wc * 32 + 4 * fq;
        const float* gp = gate + (size_t)((u.pm * BM) >> 11) * 12288 + col0;
        f32x4 gv[2][2];
#pragma unroll
        for (int bj = 0; bj < 2; ++bj)
#pragma unroll
            for (int n = 0; n < 2; ++n) gv[bj][n] = *(const f32x4*)(gp + bj * HALF + n * 16);
#pragma unroll
        for (int ai = 0; ai < 2; ++ai)
#pragma unroll
            for (int m = 0; m < 4; ++m) { const size_t ro = (size_t)(row0 + ai * HALF + m * 16) * ldc + col0;
#pragma unroll
                for (int bj = 0; bj < 2; ++bj)
#pragma unroll
                    for (int n = 0; n < 2; ++n) { const f32x4 xv = *(const f32x4*)(xin + ro + bj * HALF + n * 16);
                        *(f32x4*)(C + ro + bj * HALF + n * 16) = xv + gv[bj][n] * acc[ai][bj][m][n]; } }
    }
};

template <class Epi, class Sched, bool STAMP = false>
__device__ __forceinline__ void gemm_phase(PG8_LAS unsigned char* lds, const Gemm g, const Sched& S, const Epi& E, unsigned long long* stamps) {
    const int tid = RTID(), wid = __builtin_amdgcn_readfirstlane(tid >> 6), lane = tid & 63, wr = wid >> 2, wc = wid & 3, fr = lane & 15, fq = lane >> 4;
    const int K = g.K, nt = K / BK;
    int ts_lo = 0, ts_hi = 0, nts = 0; const unsigned long long rt_entry = STAMP ? (unsigned long long)wall_clock64() : 0ull;
#define PG8_STAMP() do { if (STAMP && wid == 0 && nts < 64) { const unsigned long long _c = (unsigned long long)clock64(); \
        ts_lo = (lane == nts) ? (int)(unsigned)_c : ts_lo; ts_hi = (lane == nts) ? (int)(unsigned)(_c >> 32) : ts_hi; ++nts; } } while (0)
    PG8_STAMP();
    unsigned voffA[2], voffB[2];
#pragma unroll
    for (int i = 0; i < 2; ++i) { int R, C; stage_rc(tid * 16 + i * 8192, R, C); const int Rb = Epi::PERM ? ((R & ~31) + perm32(R & 31)) : R;
        voffA[i] = (unsigned)(R * K + C) * 2u; voffB[i] = (unsigned)(Rb * K + C) * 2u; }
    const size_t kstep = (size_t)(BK * 2);
    const size_t hstep = (size_t)HALF * K * 2;
    const size_t tstep = 2 * hstep;
    const unsigned ldsw = (unsigned)wid * 1024u;
    const int aoff = lds_byte(wr * 64 + fr, fq * 8), boff = lds_byte(wc * 32 + fr, fq * 8);
#define PG8_SA(b, h) (((b) * 2 + (h)) * HTB)
#define PG8_SB(b, h) ((4 + (b) * 2 + (h)) * HTB)
#define PG8_STAGE(bufoff, gbase, voff) do { _Pragma("unroll") for (int _i = 0; _i < 2; ++_i) \
        __builtin_amdgcn_global_load_lds((const unsigned*)((const char*)(gbase) + (voff)[_i]), (PG8_LAS unsigned*)(lds + (bufoff) + ldsw + _i * 8192), 16, 0, 0); } while (0)
#define PG8_LDA(dst, b, h) do { _Pragma("unroll") for (int m = 0; m < 4; ++m) _Pragma("unroll") for (int k = 0; k < 2; ++k) dst[m][k] = *(const PG8_LAS bf16x8*)(lds + PG8_SA(b, h) + aoff + m * 2048 + k * 1024); } while (0)
#define PG8_LDB(dst, b, h) do { _Pragma("unroll") for (int n = 0; n < 2; ++n) _Pragma("unroll") for (int k = 0; k < 2; ++k) dst[n][k] = *(const PG8_LAS bf16x8*)(lds + PG8_SB(b, h) + boff + n * 2048 + k * 1024); } while (0)
#define PG8_MMA(ai, bj, At, Bt) do { __builtin_amdgcn_s_setprio(1); _Pragma("unroll") for (int m = 0; m < 4; ++m) _Pragma("unroll") for (int n = 0; n < 2; ++n) _Pragma("unroll") for (int k = 0; k < 2; ++k) \
        acc[ai][bj][m][n] = __builtin_amdgcn_mfma_f32_16x16x32_bf16(Bt[n][k], At[m][k], acc[ai][bj][m][n], 0, 0, 0); __builtin_amdgcn_s_setprio(0); } while (0)
#define PG8_WAIT_V(n) asm volatile("s_waitcnt vmcnt(" #n ")" ::: "memory")
#define PG8_WAIT_L(n) asm volatile("s_waitcnt lgkmcnt(" #n ")" ::: "memory")
#define PG8_BAR __builtin_amdgcn_s_barrier()
#define PG8_SCHED __builtin_amdgcn_sched_barrier(0)
    Unit cur, nxt; int ui = 0;
    if (!S.next(0, cur)) return;
    f32x4 acc[2][2][4][2];
#pragma unroll
    for (int a = 0; a < 2; ++a)
#pragma unroll
        for (int b = 0; b < 2; ++b)
#pragma unroll
            for (int m = 0; m < 4; ++m)
#pragma unroll
                for (int n = 0; n < 2; ++n) acc[a][b][m][n] = (f32x4){0.f, 0.f, 0.f, 0.f};
    bf16x8 At[4][2], B0[2][2], B1[2][2];
    const char* cA = (const char*)g.A + (size_t)cur.pm * tstep; const char* cB = (const char*)g.Bt + (size_t)cur.pn * tstep;
    S.a_ready(cur);
    PG8_STAGE(PG8_SB(0, 0), cB, voffB); PG8_STAGE(PG8_SA(0, 0), cA, voffA); PG8_STAGE(PG8_SB(0, 1), cB + hstep, voffB); PG8_STAGE(PG8_SA(0, 1), cA + hstep, voffA);
    if (wr == 1) PG8_BAR;
    PG8_WAIT_V(4); PG8_BAR;
    PG8_STAGE(PG8_SB(1, 0), cB + kstep, voffB); PG8_STAGE(PG8_SA(1, 0), cA + kstep, voffA); PG8_STAGE(PG8_SB(1, 1), cB + hstep + kstep, voffB);
    PG8_WAIT_V(6); PG8_BAR;
    PG8_STAMP();
    for (;;) {
        const bool has_next = S.next(ui + 1, nxt);
        const char* nA = has_next ? (const char*)g.A + (size_t)nxt.pm * tstep : cA; const char* nB = has_next ? (const char*)g.Bt + (size_t)nxt.pn * tstep : cB;
        for (int t = 0; t < nt; t += 2) {
            const bool last = (t == nt - 2);
            const char* a1 = cA + (size_t)(t + 1) * kstep;
            const char* a2 = last ? nA : cA + (size_t)(t + 2) * kstep; const char* b2 = last ? nB : cB + (size_t)(t + 2) * kstep;
            const char* a3 = a2 + kstep; const char* b3 = b2 + kstep;
            if (last && has_next) S.a_ready(nxt);
            PG8_LDB(B0, 0, 0); PG8_SCHED; PG8_LDA(At, 0, 0); PG8_STAGE(PG8_SA(1, 1), a1 + hstep, voffA);
            PG8_WAIT_L(8); PG8_BAR; PG8_WAIT_L(0); PG8_MMA(0, 0, At, B0); PG8_BAR; PG8_SCHED;
            PG8_LDB(B1, 0, 1); PG8_STAGE(PG8_SB(0, 0), b2, voffB);
            PG8_BAR; PG8_WAIT_L(0); PG8_MMA(0, 1, At, B1); PG8_BAR;
            PG8_LDA(At, 0, 1); PG8_STAGE(PG8_SA(0, 0), a2, voffA);
            PG8_BAR; PG8_WAIT_L(0); PG8_MMA(1, 0, At, B0); PG8_BAR; PG8_SCHED;
            PG8_STAGE(PG8_SB(0, 1), b2 + hstep, voffB);
            PG8_WAIT_V(6); PG8_BAR; PG8_MMA(1, 1, At, B1); PG8_BAR;
            PG8_LDB(B0, 1, 0); PG8_SCHED; PG8_LDA(At, 1, 0); PG8_STAGE(PG8_SA(0, 1), a2 + hstep, voffA);
            PG8_WAIT_L(8); PG8_BAR; PG8_WAIT_L(0); PG8_MMA(0, 0, At, B0); PG8_BAR; PG8_SCHED;
            PG8_LDB(B1, 1, 1); PG8_STAGE(PG8_SB(1, 0), b3, voffB);
            PG8_BAR; PG8_WAIT_L(0); PG8_MMA(0, 1, At, B1); PG8_BAR;
            PG8_LDA(At, 1, 1); PG8_STAGE(PG8_SA(1, 0), a3, voffA);
            PG8_BAR; PG8_WAIT_L(0); PG8_MMA(1, 0, At, B0); PG8_BAR; PG8_SCHED;
            PG8_STAGE(PG8_SB(1, 1), b3 + hstep, voffB);
            PG8_WAIT_V(6); PG8_BAR; PG8_MMA(1, 1, At, B1); PG8_BAR;
        }
        PG8_STAMP();
        if constexpr (!Epi::AFTER_DRAIN) { E(acc, cur, wr, wc, fr, fq); S.done(cur); }
        PG8_STAMP();
        if (!has_next) break;
#pragma unroll
        for (int a = 0; a < 2; ++a)
#pragma unroll
            for (int b = 0; b < 2; ++b)
#pragma unroll
                for (int m = 0; m < 4; ++m)
#pragma unroll
                    for (int n = 0; n < 2; ++n) acc[a][b][m][n] = (f32x4){0.f, 0.f, 0.f, 0.f};
        cur = nxt; cA = nA; cB = nB; ++ui;
    }
    PG8_WAIT_V(0);
    if (wr == 0) PG8_BAR;
    PG8_BAR;
    if constexpr (Epi::AFTER_DRAIN) { E.fused(acc, cur, wr, wc, fr, fq, lds, wid, lane); S.done(cur); }
    PG8_STAMP();
    if (STAMP && wid == 0) { stamps[lane] = lane < nts ? (((unsigned long long)(unsigned)ts_hi << 32) | (unsigned)ts_lo) : 0ull;
        if (lane == 62) stamps[62] = rt_entry; if (lane == 63) stamps[63] = (unsigned long long)wall_clock64(); }
#undef PG8_STAMP
#undef PG8_SA
#undef PG8_SB
#undef PG8_STAGE
#undef PG8_LDA
#undef PG8_LDB
#undef PG8_MMA
#undef PG8_WAIT_V
#undef PG8_WAIT_L
#undef PG8_BAR
#undef PG8_SCHED
}
}

struct AttnPtrs { const bf16_t* Q; int ldq; const bf16_t* K; int ldk; const bf16_t* Vt; int ldv; const float* kbias; };

DI float xhalf_max(float v) {
  const auto r2 = __builtin_amdgcn_permlane32_swap(__float_as_uint(v), __float_as_uint(v), false, false);
  return fmaxf(__uint_as_float(r2[0]), __uint_as_float(r2[1]));
}
DI float xhalf_sum(float v) {
  const auto r2 = __builtin_amdgcn_permlane32_swap(__float_as_uint(v), __float_as_uint(v), false, false);
  return __uint_as_float(r2[0]) + __uint_as_float(r2[1]);
}

template <int MODE, int DVB>
DI void attn_block(const AttnPtrs& a, int q0b, char* smem, const float* tbl, f32x16 (&o)[DVB], float& l_out) {
  constexpr int STG = 16384 + DVB * 4096;
  const int tid = RTID(), lane = tid & 63, wave = __builtin_amdgcn_readfirstlane(tid >> 6);
  const int r = lane & 31, h = lane >> 5;
  const int q0 = q0b + 32 * wave;
  const int krow = tid >> 4, kch = tid & 15;
  const int vrow = tid >> 3, vch = tid & 7;
  const char* Kb = (const char*)a.K;
  const char* Vb = (const char*)a.Vt;
  const unsigned kvo = (unsigned)(krow * a.ldk + kch * 8) * 2u;
  const unsigned vvo = (unsigned)(vrow * a.ldv + vch * 8) * 2u;
  const unsigned kst = (unsigned)(32 * a.ldk) * 2u, vst = (unsigned)(64 * a.ldv) * 2u;
  const int kwo = krow * 256 + ((kch ^ (krow & 15)) << 4);
  const int vwo = 16384 + vrow * 128 + ((vch ^ ((vrow >> 1) & 7)) << 4);
  const int pr = (r & ~12) | ((r & 4) << 1) | ((r & 8) >> 1);
  const int kro = pr * 256, ksw = pr & 15;
  const int vro = 16384 + r * 128, vsw = (r >> 1) & 7;
  bf16x8 qf[8];
#pragma unroll
  for (int s = 0; s < 8; ++s) qf[s] = *(const bf16x8*)(a.Q + (size_t)(q0 + r) * a.ldq + 16 * s + 8 * h);
#pragma unroll
  for (int dt = 0; dt < DVB; ++dt)
#pragma unroll
    for (int e = 0; e < 16; ++e) o[dt][e] = 0.f;
  float m = -1e30f, l = 0.f;
  const int nkt = (q0b + 256) >> 6;
  u32x4 rk[2], rv[DVB / 2];
#pragma unroll
  for (int i = 0; i < 2; ++i) rk[i] = *(const u32x4*)(Kb + (size_t)(i * kst) + kvo);
#pragma unroll
  for (int i = 0; i < DVB / 2; ++i) rv[i] = *(const u32x4*)(Vb + (size_t)(i * vst) + vvo);
#pragma unroll
  for (int i = 0; i < 2; ++i) *(u32x4*)(smem + kwo + i * 8192) = rk[i];
#pragma unroll
  for (int i = 0; i < DVB / 2; ++i) *(u32x4*)(smem + vwo + i * 8192) = rv[i];
  u32x4 rkB[2], rvB[DVB / 2];
  if constexpr (DVB == 4) {
    const int k1 = nkt > 1 ? 64 : 0;
#pragma unroll
    for (int i = 0; i < 2; ++i) rk[i] = *(const u32x4*)(Kb + ((size_t)k1 * (size_t)a.ldk * 2u + i * kst) + kvo);
#pragma unroll
    for (int i = 0; i < DVB / 2; ++i) rv[i] = *(const u32x4*)(Vb + ((size_t)k1 * 2u + i * vst) + vvo);
  }
  __syncthreads();
#define ATT_TILE(KT, RL, RVL, RW, RVW) { const int kt = (KT); \
    const int k0 = kt << 6; \
    char* st = smem + (kt & 1) * STG; \
    { \
      const int kn = (kt + 2 < nkt ? kt + 2 : nkt - 1) << 6;        \
      const size_t kbo = (size_t)kn * (size_t)a.ldk * 2u, vbo = (size_t)kn * 2u; \
_Pragma("unroll") \
      for (int i = 0; i < 2; ++i) RL[i] = *(const u32x4*)(Kb + (kbo + i * kst) + kvo); \
_Pragma("unroll") \
      for (int i = 0; i < DVB / 2; ++i) RVL[i] = *(const u32x4*)(Vb + (vbo + i * vst) + vvo); \
    } \
    asm volatile("" ::: "memory"); \
    __builtin_amdgcn_sched_barrier(0); \
_Pragma("unroll") \
    for (int sub = 0; sub < 2; ++sub) { \
      const int ks0 = k0 + 32 * sub; \
      if (ks0 <= q0) { \
        f32x16 sa; \
_Pragma("unroll") \
        for (int e = 0; e < 16; ++e) sa[e] = 0.f; \
_Pragma("unroll") \
        for (int s = 0; s < 8; ++s) { \
          const bf16x8 kf = *(const bf16x8*)(st + kro + sub * 8192 + (((2 * s + h) ^ ksw) << 4)); \
          sa = MFMA32(kf, qf[s], sa); \
        } \
        float v[16]; \
        if (MODE == 0) { \
_Pragma("unroll") \
          for (int c = 0; c < 2; ++c) { \
            const float4 kb0 = *(const float4*)(a.kbias + ks0 + 16 * c + 8 * h); \
            const float4 kb1 = *(const float4*)(a.kbias + ks0 + 16 * c + 8 * h + 4); \
            v[8 * c + 0] = sa[8 * c + 0] - kb0.x * LOG2E; v[8 * c + 1] = sa[8 * c + 1] - kb0.y * LOG2E; \
            v[8 * c + 2] = sa[8 * c + 2] - kb0.z * LOG2E; v[8 * c + 3] = sa[8 * c + 3] - kb0.w * LOG2E; \
            v[8 * c + 4] = sa[8 * c + 4] - kb1.x * LOG2E; v[8 * c + 5] = sa[8 * c + 5] - kb1.y * LOG2E; \
            v[8 * c + 6] = sa[8 * c + 6] - kb1.z * LOG2E; v[8 * c + 7] = sa[8 * c + 7] - kb1.w * LOG2E; \
          } \
          if (ks0 == q0) { \
_Pragma("unroll") \
            for (int e = 0; e < 16; ++e) if ((e & 7) + 8 * h + 16 * (e >> 3) > r) v[e] = -INFINITY; \
          } \
        } else { \
          const float* tp = tbl + (q0 - ks0) + r + 32 - 8 * h - 23; \
_Pragma("unroll") \
          for (int e = 0; e < 16; ++e) v[e] = sa[e] + tp[23 - ((e & 7) + 16 * (e >> 3))]; \
        } \
        float mx = v[0]; \
_Pragma("unroll") \
        for (int e = 1; e < 16; ++e) mx = fmaxf(mx, v[e]); \
        mx = xhalf_max(mx); \
        if (__ballot(mx > m + 8.f) != 0ull) { \
          const float mn = fmaxf(m, mx); \
          const float alpha = __builtin_amdgcn_exp2f(m - mn); \
          m = mn; \
          l *= alpha; \
_Pragma("unroll") \
          for (int dt = 0; dt < DVB; ++dt) \
_Pragma("unroll") \
            for (int e = 0; e < 16; ++e) o[dt][e] *= alpha; \
        } \
        float ps = 0.f; \
_Pragma("unroll") \
        for (int e = 0; e < 16; ++e) { v[e] = __builtin_amdgcn_exp2f(v[e] - m); ps += v[e]; } \
        l += ps; \
        bf16x8 pb[2]; \
_Pragma("unroll") \
        for (int s = 0; s < 2; ++s) { \
          const u32x4 u = {pack_bf2(v[8 * s + 0], v[8 * s + 1]), pack_bf2(v[8 * s + 2], v[8 * s + 3]), \
                           pack_bf2(v[8 * s + 4], v[8 * s + 5]), pack_bf2(v[8 * s + 6], v[8 * s + 7])}; \
          pb[s] = __builtin_bit_cast(bf16x8, u); \
        } \
_Pragma("unroll") \
        for (int dt = 0; dt < DVB; ++dt) \
_Pragma("unroll") \
          for (int s = 0; s < 2; ++s) { \
            const bf16x8 va = *(const bf16x8*)(st + vro + dt * 4096 + (((4 * sub + 2 * s + h) ^ vsw) << 4)); \
            o[dt] = MFMA32(va, pb[s], o[dt]); \
          } \
      } \
    } \
    __builtin_amdgcn_sched_barrier(0); \
    asm volatile("" ::: "memory"); \
    { \
      char* sn = smem + ((kt + 1) & 1) * STG; \
_Pragma("unroll") \
      for (int i = 0; i < 2; ++i) *(u32x4*)(sn + kwo + i * 8192) = RW[i]; \
_Pragma("unroll") \
      for (int i = 0; i < DVB / 2; ++i) *(u32x4*)(sn + vwo + i * 8192) = RVW[i]; \
    } \
    __syncthreads(); \
  }
  if constexpr (DVB == 4) {
  for (int kt2 = 0; kt2 < nkt; kt2 += 2) {
    ATT_TILE(kt2, rkB, rvB, rk, rv)
    if (kt2 + 1 < nkt) ATT_TILE(kt2 + 1, rk, rv, rkB, rvB)
  }
  } else {
  for (int kt = 0; kt < nkt; ++kt) {
    const int k0 = kt << 6;
    char* st = smem + (kt & 1) * STG;
    {
      const int kn = (kt + 1 < nkt) ? k0 + 64 : k0;
      const size_t kbo = (size_t)kn * (size_t)a.ldk * 2u, vbo = (size_t)kn * 2u;
#pragma unroll
      for (int i = 0; i < 2; ++i) rk[i] = *(const u32x4*)(Kb + (kbo + i * kst) + kvo);
#pragma unroll
      for (int i = 0; i < DVB / 2; ++i) rv[i] = *(const u32x4*)(Vb + (vbo + i * vst) + vvo);
    }
    asm volatile("" ::: "memory");
    __builtin_amdgcn_sched_barrier(0);
#pragma unroll
    for (int sub = 0; sub < 2; ++sub) {
      const int ks0 = k0 + 32 * sub;
      if (ks0 <= q0) {
        f32x16 sa;
#pragma unroll
        for (int e = 0; e < 16; ++e) sa[e] = 0.f;
#pragma unroll
        for (int s = 0; s < 8; ++s) {
          const bf16x8 kf = *(const bf16x8*)(st + kro + sub * 8192 + (((2 * s + h) ^ ksw) << 4));
          sa = MFMA32(kf, qf[s], sa);
        }
        float v[16];
        if (MODE == 0) {
#pragma unroll
          for (int c = 0; c < 2; ++c) {
            const float4 kb0 = *(const float4*)(a.kbias + ks0 + 16 * c + 8 * h);
            const float4 kb1 = *(const float4*)(a.kbias + ks0 + 16 * c + 8 * h + 4);
            v[8 * c + 0] = sa[8 * c + 0] - kb0.x * LOG2E; v[8 * c + 1] = sa[8 * c + 1] - kb0.y * LOG2E;
            v[8 * c + 2] = sa[8 * c + 2] - kb0.z * LOG2E; v[8 * c + 3] = sa[8 * c + 3] - kb0.w * LOG2E;
            v[8 * c + 4] = sa[8 * c + 4] - kb1.x * LOG2E; v[8 * c + 5] = sa[8 * c + 5] - kb1.y * LOG2E;
            v[8 * c + 6] = sa[8 * c + 6] - kb1.z * LOG2E; v[8 * c + 7] = sa[8 * c + 7] - kb1.w * LOG2E;
          }
          if (ks0 == q0) {
#pragma unroll
            for (int e = 0; e < 16; ++e) if ((e & 7) + 8 * h + 16 * (e >> 3) > r) v[e] = -INFINITY;
          }
        } else {
          const float* tp = tbl + (q0 - ks0) + r + 32 - 8 * h - 23;
#pragma unroll
          for (int e = 0; e < 16; ++e) v[e] = sa[e] + tp[23 - ((e & 7) + 16 * (e >> 3))];
        }
        float mx = v[0];
#pragma unroll
        for (int e = 1; e < 16; ++e) mx = fmaxf(mx, v[e]);
        mx = xhalf_max(mx);
        if (__ballot(mx > m + 8.f) != 0ull) {
          const float mn = fmaxf(m, mx);
          const float alpha = __builtin_amdgcn_exp2f(m - mn);
          m = mn;
          l *= alpha;
#pragma unroll
          for (int dt = 0; dt < DVB; ++dt)
#pragma unroll
            for (int e = 0; e < 16; ++e) o[dt][e] *= alpha;
        }
        float ps = 0.f;
#pragma unroll
        for (int e = 0; e < 16; ++e) { v[e] = __builtin_amdgcn_exp2f(v[e] - m); ps += v[e]; }
        l += ps;
        bf16x8 pb[2];
#pragma unroll
        for (int s = 0; s < 2; ++s) {
          const u32x4 u = {pack_bf2(v[8 * s + 0], v[8 * s + 1]), pack_bf2(v[8 * s + 2], v[8 * s + 3]),
                           pack_bf2(v[8 * s + 4], v[8 * s + 5]), pack_bf2(v[8 * s + 6], v[8 * s + 7])};
          pb[s] = __builtin_bit_cast(bf16x8, u);
        }
#pragma unroll
        for (int dt = 0; dt < DVB; ++dt)
#pragma unroll
          for (int s = 0; s < 2; ++s) {
            const bf16x8 va = *(const bf16x8*)(st + vro + dt * 4096 + (((4 * sub + 2 * s + h) ^ vsw) << 4));
            o[dt] = MFMA32(va, pb[s], o[dt]);
          }
      }
    }
    __builtin_amdgcn_sched_barrier(0);
    asm volatile("" ::: "memory");
    {
      char* sn = smem + ((kt + 1) & 1) * STG;
#pragma unroll
      for (int i = 0; i < 2; ++i) *(u32x4*)(sn + kwo + i * 8192) = rk[i];
#pragma unroll
      for (int i = 0; i < DVB / 2; ++i) *(u32x4*)(sn + vwo + i * 8192) = rv[i];
    }
    __syncthreads();
  }
  }
#undef ATT_TILE
  l_out = xhalf_sum(l);
}

DI void attn_store_bf16(const f32x16 (&o)[4], float linv, bf16_t* out_row  , int ldo) {
  const int lane = TID() & 63, r = lane & 31, h = lane >> 5;
  bf16_t* op = out_row + (size_t)r * ldo + 4 * h;
#pragma unroll
  for (int dt = 0; dt < 4; ++dt)
#pragma unroll
    for (int c = 0; c < 4; ++c)
      *(uint2*)(op + 32 * dt + 8 * c) = make_uint2(pack_bf2(o[dt][4 * c] * linv, o[dt][4 * c + 1] * linv),
                                                    pack_bf2(o[dt][4 * c + 2] * linv, o[dt][4 * c + 3] * linv));
}
template <int N, int B0>
DI void attn_store_f32(const f32x16 (&o)[N], float linv, float* out_row, int ldo) {
  const int lane = TID() & 63, r = lane & 31, h = lane >> 5;
  float* op = out_row + (size_t)r * ldo + 4 * h;
#pragma unroll
  for (int dt = 0; dt < 4; ++dt)
#pragma unroll
    for (int c = 0; c < 4; ++c)
      *(float4*)(op + 32 * dt + 8 * c) = make_float4(o[B0 + dt][4 * c] * linv, o[B0 + dt][4 * c + 1] * linv, o[B0 + dt][4 * c + 2] * linv, o[B0 + dt][4 * c + 3] * linv);
}

DI int t5_bucket(int n) {
  if (n < 16) return n;
  int lg = 16 + (int)(logf((float)n / 16.f) / 4.852030263919617f * 16.f);
  return lg < 31 ? lg : 31;
}

DI void phase_attn_even(const Params& p, char* smem) {
  const int tid = RTID(), wave = __builtin_amdgcn_readfirstlane(tid >> 6), bid = blockIdx.x, G = gridDim.x;
  const bf16_t* QK = (const bf16_t*)(p.ws + WS_QK);
  const bf16_t* VT = (const bf16_t*)(p.ws + WS_VT);
  bf16_t* ATT = (bf16_t*)(p.ws + WS_ATT);
  float* PCS = (float*)(p.ws + WS_SC);
  float* tbl = (float*)(smem + 98304);
  int cur_head = -1;
  for (int rnd = 0; rnd * G < 1024; ++rnd) {
    int item = rnd * G + ((rnd & 1) ? G - 1 - bid : bid);
    if (G == 256) {
      const int rc = rnd * 4 + (bid >> 6);
      const int gq = (int)((0x6767455432231010ull >> (4 * rc)) & 15ull), dq = (0x3CC3 >> rc) & 1;
      item = gq * 128 + (dq ? 0 : 64) + (bid & 63);
    }
    if (item >= 1024) break;
    const int g = item >> 7; int rem = item & 127;
    const int qb = 7 - g;
    const int q0b = qb * 256, q0 = q0b + 32 * wave;
    __syncthreads();
    if (rem >= 64) {
      rem -= 64;
      const int b = rem >> 3, hh = rem & 7;
      AttnPtrs a;
      a.Q = QK + (size_t)b * S_ * 4096 + hh * 128; a.ldq = 4096;
      a.K = a.Q + 1024; a.ldk = 4096;
      a.Vt = VT + (size_t)(hh * 128) * T_ + b * S_; a.ldv = T_;
      a.kbias = (const float*)(p.ws + WS_FCUM) + (size_t)(b * 8 + hh) * S_;
      f32x16 o[4]; float l;
      attn_block<0, 4>(a, q0b, smem, nullptr, o, l);
      attn_store_bf16(o, 1.f / l, ATT + (size_t)(b * S_ + q0) * D_ + hh * 128, D_);
    } else {
      const int b = rem >> 3, hh = (rem >> 1) & 3, mm = rem & 1;
      if (hh != cur_head) {
        for (int e = tid; e < 2080; e += RTHREADS) {
          const int dist = e - 32;
          tbl[e] = dist >= 0 ? p.rel_bias[t5_bucket(dist) * 16 + hh] * LOG2E : -INFINITY;
        }
        cur_head = hh;
      }
      AttnPtrs a;
      a.Q = QK + (size_t)b * S_ * 4096 + 2048 + hh * 256 + mm * 128; a.ldq = 4096;
      a.K = a.Q + 1024; a.ldk = 4096;
      a.Vt = VT + (size_t)(1024 + hh * 256) * T_ + b * S_; a.ldv = T_;
      a.kbias = nullptr;
      f32x16 o[8]; float l;
      attn_block<1, 8>(a, q0b, smem, tbl, o, l);
      const float linv = 1.f / l;
      attn_store_f32<8, 0>(o, linv, PCS + (((size_t)(mm * 2 + 0) * T_ + (size_t)(b * S_ + q0)) * 4 + hh) * 128, 512);
      attn_store_f32<8, 4>(o, linv, PCS + (((size_t)(mm * 2 + 1) * T_ + (size_t)(b * S_ + q0)) * 4 + hh) * 128, 512);
    }
  }
}

DI void phase_diff_combine(const Params& p) {
  const int lane = TID() & 63;
  const int gw = __builtin_amdgcn_readfirstlane((VBID() * NTHREADS + TID()) >> 6), nw = (VGRID() * NTHREADS) >> 6;
  const float* PCS = (const float*)(p.ws + WS_SC);
  bf16_t* ATT = (bf16_t*)(p.ws + WS_ATT);
  const float lam = ((const float*)(p.ws + WS_MISC))[0];
  const int half = lane >> 5, dl = (lane & 31) * 4;
  const float4 sg = *(const float4*)(p.even_diff_subln_gain + lane * 4);
  for (int it = gw; it < T_ * 4; it += nw) {
    const float4 a0 = *(const float4*)(PCS + ((size_t)(0 + half) * T_ * 4 + it) * 128 + dl);
    const float4 a1 = *(const float4*)(PCS + ((size_t)(2 + half) * T_ * 4 + it) * 128 + dl);
    float4 v;
    v.x = a0.x - lam * a1.x; v.y = a0.y - lam * a1.y; v.z = a0.z - lam * a1.z; v.w = a0.w - lam * a1.w;
    const float ss = wave_sum(v.x * v.x + v.y * v.y + v.z * v.z + v.w * v.w);
    const float rstd = rsqrtf(ss * (1.f / 256.f) + 1e-6f) * 0.8f;
    const int t = it >> 2, hh = it & 3;
    *(uint2*)(ATT + (size_t)t * D_ + 1024 + hh * 256 + lane * 4) =
        make_uint2(pack_bf2(v.x * rstd * sg.x, v.y * rstd * sg.y), pack_bf2(v.z * rstd * sg.z, v.w * rstd * sg.w));
  }
}

DI void phase_attn_odd(const Params& p, char* smem) {
  const int tid = RTID(), wave = __builtin_amdgcn_readfirstlane(tid >> 6), bid = blockIdx.x, G = gridDim.x;
  const bf16_t* QK = (const bf16_t*)(p.ws + WS_QK);
  const bf16_t* VT = (const bf16_t*)(p.ws + WS_VT);
  bf16_t* ATT = (bf16_t*)(p.ws + WS_ATT);
  float* tbl = (float*)(smem + 98304);
  int cur_head = -1;
  for (int rnd = 0; rnd * G < 1024; ++rnd) {
    const int item = rnd * G + ((rnd & 1) ? G - 1 - bid : bid);
    if (item >= 1024) break;
    const int g = item >> 7, rem = item & 127;
    const int qb = 7 - g, b = rem >> 4, hd = rem & 15;
    __syncthreads();
    if (hd != cur_head) {
      for (int e = tid; e < 2080; e += RTHREADS) {
        const int dist = e - 32;
        float val = -INFINITY;
        if (dist >= 0) {
          int cnt = 0;
          if (dist <= 128) cnt += 1;
          if (dist <= 512 && (dist & 3) == 0) cnt += 1;
          if ((dist & 15) == 0) cnt += 1;
          if (cnt > 0) val = (p.rel_bias[t5_bucket(dist) * 16 + hd] + __logf((float)cnt)) * LOG2E;
        }
        tbl[e] = val;
      }
      cur_head = hd;
    }
    const int q0b = qb * 256, q0 = q0b + 32 * wave;
    AttnPtrs a;
    a.Q = QK + (size_t)b * S_ * 4096 + hd * 128; a.ldq = 4096;
    a.K = a.Q + 2048; a.ldk = 4096;
    a.Vt = VT + (size_t)(hd * 128) * T_ + b * S_; a.ldv = T_;
    a.kbias = nullptr;
    f32x16 o[4]; float l;
    attn_block<1, 4>(a, q0b, smem, tbl, o, l);
    attn_store_bf16(o, 1.f / l, ATT + (size_t)(b * S_ + q0) * D_ + hd * 128, D_);
  }
}

DI float gelu_erf(float x) { return 0.5f * x * (1.f + erff(x * 0.7071067811865476f)); }

DI void ins16(float (&L)[16], float x) {
#pragma unroll
  for (int k = 15; k >= 1; --k) L[k] = __builtin_amdgcn_fmed3f(L[k - 1], L[k], x);
  L[0] = __builtin_amdgcn_fmed3f(__builtin_inff(), L[0], x);
}
DI float f_and_or(float v, unsigned mask, unsigned orv) { return __uint_as_float((__float_as_uint(v) & mask) | orv); }

DI void phase_peer_retrieve(const Params& p, char* smem) {
  const int tid = TID(), lane = tid & 63, wave = __builtin_amdgcn_readfirstlane(tid >> 6);
  const int gw = __builtin_amdgcn_readfirstlane((VBID() * NTHREADS + tid) >> 6), nw = (VGRID() * NTHREADS) >> 6;
  unsigned* wbuf = (unsigned*)(smem + wave * 9216);
  const bf16_t* SC = (const bf16_t*)(p.ws + WS_SC);
  int* IDX = (int*)(p.ws + WS_IDX);
  float* GATE = (float*)(p.ws + WS_GATE);
  const float NINF = -__builtin_inff();
  for (int it = gw; it < T_ / 8; it += nw) {
    const bf16_t* gsrc = SC + (size_t)it * (8 * 2048) + (lane >> 2) * 256 + (lane & 3) * 8;
    unsigned* wdst = wbuf + (lane >> 2) * 20 + (lane & 3) * 4;
    const unsigned* wsrc = wbuf + lane * 20;
    u32x4 stg[4];
#define PR_LOAD(CH) _Pragma("unroll") for (int i = 0; i < 4; ++i) stg[i] = *(const u32x4*)(gsrc + i * (16 * 256) + ((CH) >> 2) * 128 + ((CH) & 3) * 32);
    PR_LOAD(0)
    float A[16], B[16];
#pragma unroll
    for (int hf = 0; hf < 2; ++hf) {
      float L[16];
#pragma unroll
      for (int k = 0; k < 16; ++k) L[k] = NINF;
#pragma unroll 1
      for (int c = 0; c < 4; ++c) {
#pragma unroll
        for (int i = 0; i < 4; ++i) *(u32x4*)(wdst + i * (16 * 20)) = stg[i];
        { const int cn = hf * 4 + c + 1 < 7 ? hf * 4 + c + 1 : 7; PR_LOAD(cn) }
        u32x4 v[4];
#pragma unroll
        for (int k = 0; k < 4; ++k) v[k] = *(const u32x4*)(wsrc + 4 * k);
#pragma unroll
        for (int k = 0; k < 4; ++k)
#pragma unroll
          for (int e = 0; e < 4; ++e) {
            const unsigned w = v[k][e], id0 = (unsigned)(c * 32 + 8 * k + 2 * e);
            ins16(L, __uint_as_float((w << 16) | id0));
            ins16(L, __uint_as_float((w & 0xFFFF0000u) | (id0 + 1u)));
          }
      }
#pragma unroll
      for (int k = 0; k < 16; ++k) { if (hf == 0) A[k] = L[k]; else B[k] = L[k]; }
    }
#undef PR_LOAD
    unsigned* lut = wbuf + lane * 33;
#pragma unroll
    for (int k = 0; k < 16; ++k) {
      const unsigned ua = __float_as_uint(A[k]), ub = __float_as_uint(B[k]);
      lut[k] = (ua & 0x7Fu) << 7; lut[16 + k] = ub & 0x7Fu;
      A[k] = __uint_as_float(ua & 0xFFFFFF80u); B[k] = __uint_as_float(ub & 0xFFFFFF80u);
    }
    float C[16];
#pragma unroll
    for (int k = 0; k < 16; ++k) C[k] = NINF;
#pragma unroll
    for (int i = 0; i < 16; ++i)
#pragma unroll
      for (int j = 0; j < 16; ++j)
        if ((i + 1) * (j + 1) <= 16) ins16(C, f_and_or(A[i] + B[j], 0xFFFFFF00u, (unsigned)(i * 16 + j)));
    float ev[16], es = 0.f;
    int ids[16];
    const float mx = __uint_as_float(__float_as_uint(C[0]) & 0xFFFFFF00u);
#pragma unroll
    for (int k = 0; k < 16; ++k) {
      const unsigned uc = __float_as_uint(C[k]);
      ev[k] = __expf(__uint_as_float(uc & 0xFFFFFF00u) - mx);
      es += ev[k];
      ids[k] = (int)(lut[(uc >> 4) & 15u] + lut[16 + (uc & 15u)]);
    }
    const float inv = 1.f / es;
    int* ip = IDX + (size_t)it * (8 * 128) + lane * 16;
    float* gp = GATE + (size_t)it * (8 * 128) + lane * 16;
#pragma unroll
    for (int q = 0; q < 4; ++q) {
      *(int4*)(ip + 4 * q) = make_int4(ids[4 * q], ids[4 * q + 1], ids[4 * q + 2], ids[4 * q + 3]);
      *(float4*)(gp + 4 * q) = make_float4(ev[4 * q] * inv, ev[4 * q + 1] * inv, ev[4 * q + 2] * inv, ev[4 * q + 3] * inv);
    }
  }
}

DI unsigned peer_ticket_issue(unsigned* cnt) {
  unsigned v = 0;
  if ((TID() & 63) == 0) v = __hip_atomic_fetch_add(cnt, 1u, __ATOMIC_RELAXED, __HIP_MEMORY_SCOPE_AGENT);
  return v;
}
DI float oct_sum(float v) {
  v += __builtin_bit_cast(float, __builtin_amdgcn_update_dpp(0, __builtin_bit_cast(int, v), 0xB1, 0xF, 0xF, true));
  v += __builtin_bit_cast(float, __builtin_amdgcn_update_dpp(0, __builtin_bit_cast(int, v), 0x4E, 0xF, 0xF, true));
  v += __builtin_bit_cast(float, __builtin_amdgcn_update_dpp(0, __builtin_bit_cast(int, v), 0x141, 0xF, 0xF, true));
  return v;
}

DI unsigned swar_add8(unsigned x) { return ((x & 0x7F7F7F7Fu) + 0x08080808u) ^ (x & 0x80808080u); }
DI void phase_peer_dots(const Params& p, int layer, char* smem_all) {
  const int rtid = RTID(), lane = rtid & 63, rwave = __builtin_amdgcn_readfirstlane(rtid >> 6);
  const int g = lane >> 3, j = lane & 7;
  int* lidx_all = (int*)(smem_all + rwave * 8192);
  const unsigned char* H8 = (const unsigned char*)(p.ws + WS_H8);
  const int* IDX = (const int*)(p.ws + WS_IDX);
  bf16_t* PD = (bf16_t*)(p.ws + WS_PD);
  const unsigned char* PU = (const unsigned char*)(p.ws + WS_PEERU) + (size_t)layer * (8 * NEXP * 128);
  const float* SC4 = (const float*)(p.ws + WS_USC4) + (size_t)layer * (8 * NEXP);
  unsigned* tick = (unsigned*)(p.ws + WS_TICKETS) + (size_t)(layer * 2 + 0) * 16 * 16;
  const int xcc = xcc_id() & 7;
#pragma unroll 1
  for (int so = 0; so < 8; ++so) {
    const int s = (xcc + so) & 7;
    unsigned tv = peer_ticket_issue(tick + s * 16);
    for (;;) {
      const int c = __builtin_amdgcn_readfirstlane((int)tv);
      if (c >= T_ / 16) break;
      tv = peer_ticket_issue(tick + s * 16);
#pragma unroll
      for (int gi = 0; gi < 2; ++gi) {
        const int* ip = IDX + (size_t)(c * 16 + gi * 8 + g) * 128 + 16 * j;
#pragma unroll
        for (int i = 0; i < 4; ++i) *(uint4*)(lidx_all + gi * 1024 + g * 128 + 16 * j + 4 * i) = *(const uint4*)(ip + 4 * i);
      }
#pragma unroll 1
      for (int gi = 0; gi < 2; ++gi) {
      const int t0 = c * 16 + gi * 8;
      const int* lidx = lidx_all + gi * 1024;
      unsigned xl[4], xh[4];
      {
        const unsigned char* hp = H8 + (size_t)(t0 + g) * D_ + s * 256 + 32 * j;
        const u32x4 h0 = *(const u32x4*)hp, h1 = *(const u32x4*)(hp + 16);
        const unsigned d[8] = {h0.x, h0.y, h0.z, h0.w, h1.x, h1.y, h1.z, h1.w};
#pragma unroll
        for (int m = 0; m < 4; ++m) {
          xl[m] = (d[2 * m] & 0x0F0F0F0Fu) | ((d[2 * m + 1] & 0x0F0F0F0Fu) << 4);
          xh[m] = ((swar_add8(d[2 * m]) >> 4) & 0x0F0F0F0Fu) | (swar_add8(d[2 * m + 1]) & 0xF0F0F0F0u);
        }
      }
      const unsigned char* ub = PU + (size_t)s * (NEXP * 128);
      const float* scs = SC4 + (size_t)s * NEXP;
      bf16_t* pd = PD + ((size_t)s * T_ + t0 + g) * 128;
      const bool b2_ = (lane & 4) != 0, b1_ = (lane & 2) != 0, b0_ = (lane & 1) != 0;
      u32x4 ra[8], rb[8], rc[8];
      float sa, sb, sc;
#define PD_LOAD(R, S, KB) { _Pragma("unroll") for (int q = 0; q < 8; ++q) { const int id = lidx[g * 128 + (KB) + q]; R[q] = *(const u32x4*)(ub + (unsigned)(id * 128 + 16 * j)); } \
                            S = scs[lidx[g * 128 + (KB) + j]]; }
#define DPPI(X, CTRL) __builtin_amdgcn_update_dpp(0, (X), (CTRL), 0xF, 0xF, true)
#define PD_COMP(R, S, KB)                                                                         \
      {                                                                                           \
        int pp[8];                                                                                \
        _Pragma("unroll") for (int q = 0; q < 8; ++q) {                                           \
          int al = __builtin_amdgcn_sdot8((int)R[q].x, (int)xl[0], 0, false);                     \
          int ah = __builtin_amdgcn_sdot8((int)R[q].x, (int)xh[0], 0, false);                     \
          al = __builtin_amdgcn_sdot8((int)R[q].y, (int)xl[1], al, false);                        \
          ah = __builtin_amdgcn_sdot8((int)R[q].y, (int)xh[1], ah, false);                        \
          al = __builtin_amdgcn_sdot8((int)R[q].z, (int)xl[2], al, false);                        \
          ah = __builtin_amdgcn_sdot8((int)R[q].z, (int)xh[2], ah, false);                        \
          al = __builtin_amdgcn_sdot8((int)R[q].w, (int)xl[3], al, false);                        \
          ah = __builtin_amdgcn_sdot8((int)R[q].w, (int)xh[3], ah, false);                        \
          pp[q] = al + 16 * ah;                                                                   \
        }                                                                                         \
          \
        int q4[4], q2[2];                                                                         \
        _Pragma("unroll") for (int i = 0; i < 4; ++i) {                                           \
          const int keep = b2_ ? pp[4 + i] : pp[i], send = b2_ ? pp[i] : pp[4 + i];               \
          q4[i] = keep + DPPI(send, 0x141);                   \
        }                                                                                         \
        _Pragma("unroll") for (int i = 0; i < 2; ++i) {                                           \
          const int keep = b1_ ? q4[2 + i] : q4[i], send = b1_ ? q4[i] : q4[2 + i];               \
          q2[i] = keep + DPPI(send, 0x4E);                      \
        }                                                                                         \
        {                                                                                         \
          const int keep = b0_ ? q2[1] : q2[0], send = b0_ ? q2[0] : q2[1];                       \
          const float mine_ = (float)(keep + DPPI(send, 0xB1)) * S;     \
          const float nb_ = __builtin_bit_cast(float, DPPI(__builtin_bit_cast(int, mine_), 0xB1));     \
          if (!b0_) *(unsigned*)(pd + (KB) + j) = pack_bf2(mine_, nb_);     \
        }                                                                                         \
        __builtin_amdgcn_sched_barrier(0);                                                        \
      }
      PD_LOAD(ra, sa, 0)
      PD_LOAD(rb, sb, 8)
#pragma unroll 1
      for (int kb = 0; kb < 120; kb += 24) {
        PD_LOAD(rc, sc, kb + 16)
        PD_COMP(ra, sa, kb)
        PD_LOAD(ra, sa, kb + 24)
        PD_COMP(rb, sb, kb + 8)
        { const int kl = kb + 32 < 120 ? kb + 32 : 120; PD_LOAD(rb, sb, kl) }
        PD_COMP(rc, sc, kb + 16)
      }
      PD_COMP(ra, sa, 120)
#undef PD_LOAD
#undef PD_COMP
#undef DPPI
      }
    }
  }
}

DI void phase_peer_act(const Params& p, int layer) {
  const int rtid = RTID(), lane = rtid & 63;
  const int gw = __builtin_amdgcn_readfirstlane((int)((blockIdx.x * RTHREADS + rtid) >> 6)), nw = (int)(gridDim.x * RTHREADS) >> 6;
  const bf16_t* PD = (const bf16_t*)(p.ws + WS_PD);
  const int* IDX = (const int*)(p.ws + WS_IDX);
  const float* GATE = (const float*)(p.ws + WS_GATE);
  const float* HS = (const float*)(p.ws + WS_HS);
  unsigned short* ACTQ = (unsigned short*)(p.ws + WS_ACT);
  float* ACTS = (float*)(p.ws + WS_ACT + 4 * MiB);
  const float* VSC = (const float*)(p.ws + WS_PEERV) + (size_t)(2 + layer) * NEXP;
  for (int t = gw; t < T_; t += nw) {
    const size_t e = (size_t)t * 128 + 2 * lane;
    float2 a = make_float2(0.f, 0.f);
#pragma unroll
    for (int s2 = 0; s2 < 8; ++s2) { const unsigned q = *(const unsigned*)(PD + (size_t)s2 * T_ * 128 + e); a.x += bf_lo(q); a.y += bf_hi(q); }
    const int2 id = *(const int2*)(IDX + e);
    const float2 gt = *(const float2*)(GATE + e);
    const float hs = HS[t];
    const float v0 = gt.x * gelu_erf(a.x * hs) * VSC[id.x], v1 = gt.y * gelu_erf(a.y * hs) * VSC[id.y];
    const float am = wave_max(fmaxf(fabsf(v0), fabsf(v1)));
    const float qs = am > 0.f ? 127.f / am : 1.f;
    const int q0 = (int)rintf(v0 * qs), q1 = (int)rintf(v1 * qs);
    ACTQ[(size_t)t * 64 + lane] = (unsigned short)((q0 & 255) | ((q1 & 255) << 8));
    if (lane == 0) ACTS[t] = am > 0.f ? am / 127.f : 1.f;
  }
}

DI void phase_peer_values(const Params& p, int layer, const float* gate2, char* smem_all) {
  const int rtid = RTID(), lane = rtid & 63, rwave = __builtin_amdgcn_readfirstlane(rtid >> 6);
  const int g = lane >> 3, j = lane & 7;
  int* lidx_all = (int*)(smem_all + rwave * 16384);
  unsigned* lact_all = (unsigned*)(smem_all + rwave * 16384 + 4096);
  const int* IDX = (const int*)(p.ws + WS_IDX);
  const unsigned* ACTQ = (const unsigned*)(p.ws + WS_ACT);
  const float* ACTS = (const float*)(p.ws + WS_ACT + 4 * MiB);
  const unsigned char* PV = (const unsigned char*)(p.ws + WS_PEERV8) + (size_t)layer * NEXP * D_;
  unsigned* tick = (unsigned*)(p.ws + WS_TICKETS) + (size_t)(layer * 2 + 1) * 16 * 16;
  const int xcc = xcc_id() & 7;
#pragma unroll 1
  for (int so = 0; so < 16; ++so) {
    const int s = ((xcc + (so >> 1)) & 7) + 8 * (so & 1);
    unsigned tv = peer_ticket_issue(tick + s * 16);
    for (;;) {
      const int c = __builtin_amdgcn_readfirstlane((int)tv);
      if (c >= T_ / 16) break;
      tv = peer_ticket_issue(tick + s * 16);
#pragma unroll
      for (int gi = 0; gi < 2; ++gi) {
        const int* ip = IDX + (size_t)(c * 16 + gi * 8 + g) * 128 + 16 * j;
#pragma unroll
        for (int i = 0; i < 4; ++i) *(uint4*)(lidx_all + gi * 2048 + g * 128 + 16 * j + 4 * i) = *(const uint4*)(ip + 4 * i);
        *(uint4*)(lact_all + gi * 2048 + g * 32 + 4 * j) = *(const uint4*)(ACTQ + (size_t)(c * 16 + gi * 8 + g) * 32 + 4 * j);
      }
#pragma unroll 1
      for (int gi = 0; gi < 2; ++gi) {
      const int t0 = c * 16 + gi * 8;
      const int* lidx = lidx_all + gi * 2048;
      const unsigned* lact = lact_all + gi * 2048;
      const unsigned char* vb = PV + (size_t)s * (NEXP * 128);
      int y[16];
#pragma unroll
      for (int i = 0; i < 16; ++i) y[i] = 0;
      u32x4 ra[8], rb[8];
      const int tq = t0 + g;
      float* orow = p.out + (size_t)tq * D_ + s * 128 + 16 * j;
      const float* grow = gate2 + (size_t)(tq >> 11) * 12288 + s * 128 + 16 * j;
      u32x4 ia0 = *(const u32x4*)(lidx + g * 128), ia1 = *(const u32x4*)(lidx + g * 128 + 4);
#define PV_LOAD(R, KBN) { const unsigned ids_[8] = {ia0.x, ia0.y, ia0.z, ia0.w, ia1.x, ia1.y, ia1.z, ia1.w};                         \
        _Pragma("unroll") for (int q = 0; q < 8; ++q) R[q] = *(const u32x4*)(vb + (ids_[q] * 128u + 16u * (unsigned)j));              \
        ia0 = *(const u32x4*)(lidx + g * 128 + (KBN)); ia1 = *(const u32x4*)(lidx + g * 128 + (KBN) + 4); }
#define PV_QUAD(W0, W1, W2, W3, AQ, YB) {                                                                                             \
        const unsigned t0_ = __builtin_amdgcn_perm((W1), (W0), 0x05010400u), t1_ = __builtin_amdgcn_perm((W1), (W0), 0x07030602u);    \
        const unsigned t2_ = __builtin_amdgcn_perm((W3), (W2), 0x05010400u), t3_ = __builtin_amdgcn_perm((W3), (W2), 0x07030602u);    \
        y[(YB) + 0] = __builtin_amdgcn_sdot4((int)__builtin_amdgcn_perm(t2_, t0_, 0x05040100u), (int)(AQ), y[(YB) + 0], false);       \
        y[(YB) + 1] = __builtin_amdgcn_sdot4((int)__builtin_amdgcn_perm(t2_, t0_, 0x07060302u), (int)(AQ), y[(YB) + 1], false);       \
        y[(YB) + 2] = __builtin_amdgcn_sdot4((int)__builtin_amdgcn_perm(t3_, t1_, 0x05040100u), (int)(AQ), y[(YB) + 2], false);       \
        y[(YB) + 3] = __builtin_amdgcn_sdot4((int)__builtin_amdgcn_perm(t3_, t1_, 0x07060302u), (int)(AQ), y[(YB) + 3], false); }
#define PV_COMP(R, KB)                                                                            \
      { const unsigned aq0 = lact[g * 32 + ((KB) >> 2)], aq1 = lact[g * 32 + ((KB) >> 2) + 1];    \
        PV_QUAD(R[0].x, R[1].x, R[2].x, R[3].x, aq0, 0)  PV_QUAD(R[0].y, R[1].y, R[2].y, R[3].y, aq0, 4)   \
        PV_QUAD(R[0].z, R[1].z, R[2].z, R[3].z, aq0, 8)  PV_QUAD(R[0].w, R[1].w, R[2].w, R[3].w, aq0, 12)  \
        __builtin_amdgcn_sched_barrier(0);                                                        \
        PV_QUAD(R[4].x, R[5].x, R[6].x, R[7].x, aq1, 0)  PV_QUAD(R[4].y, R[5].y, R[6].y, R[7].y, aq1, 4)   \
        PV_QUAD(R[4].z, R[5].z, R[6].z, R[7].z, aq1, 8)  PV_QUAD(R[4].w, R[5].w, R[6].w, R[7].w, aq1, 12)  \
        __builtin_amdgcn_sched_barrier(0); }
      PV_LOAD(ra, 8)
#pragma unroll 1
      for (int kb = 0; kb < 128; kb += 16) {
        { const int kn = kb + 16 < 120 ? kb + 16 : 120; PV_LOAD(rb, kn) }
        PV_COMP(ra, kb)
        { const int kn = kb + 24 < 120 ? kb + 24 : 120; PV_LOAD(ra, kn) }
        PV_COMP(rb, kb + 8)
      }
#undef PV_LOAD
#undef PV_COMP
#undef PV_QUAD
      const float as = ACTS[tq];
#pragma unroll
      for (int i = 0; i < 4; ++i) {
        float4 a0 = *(const float4*)(orow + 4 * i);
        float4 g0 = *(const float4*)(grow + 4 * i);
        g0.x *= as; g0.y *= as; g0.z *= as; g0.w *= as;
        a0.x += g0.x * (float)y[4 * i]; a0.y += g0.y * (float)y[4 * i + 1]; a0.z += g0.z * (float)y[4 * i + 2]; a0.w += g0.w * (float)y[4 * i + 3];
        *(float4*)(orow + 4 * i) = a0;
      }
      }
    }
  }
}

#define XB_TMO      128
#define XB_XCNT(j)  (256  + 64 * (j))
#define XB_XSUB(j)  (1280 + 64 * (j))
#define XB_XGEN(j)  (2304 + 64 * (j))
#define XB_TOP      3328
#define XB_TOPGEN   3392
#define XCD_BAR_WORDS 3456
#define XB_SPIN_CAP (1u << 22)
#define LAS __attribute__((address_space(3)))
DI unsigned xb_ld(unsigned* p) { return __hip_atomic_load(p, __ATOMIC_RELAXED, __HIP_MEMORY_SCOPE_AGENT); }
DI unsigned xb_add(unsigned* p, unsigned v) { return __hip_atomic_fetch_add(p, v, __ATOMIC_RELAXED, __HIP_MEMORY_SCOPE_AGENT); }
DI unsigned xb_xcc_id() { return (unsigned)__builtin_amdgcn_s_getreg((3 << 11) | 20) & 0xFu; }
#define XB_SPIN(cond, bar) do { unsigned _sp = 0; while (cond) { __builtin_amdgcn_s_sleep(1); \
    if ((++_sp & 255u) == 0u) { if (xb_ld(&(bar)[XB_TMO])) break; if (_sp > XB_SPIN_CAP) { atomicAdd(&(bar)[XB_TMO], 1u); break; } } } } while (0)
struct XcdBarrier { unsigned* bar; unsigned x; volatile LAS unsigned* st; };
DI XcdBarrier xcd_barrier_post(unsigned* bar, volatile LAS unsigned* st) {
  XcdBarrier b; b.bar = bar; b.x = xb_xcc_id(); b.st = st;
  if (threadIdx.x == 0) (void)xb_add(&bar[XB_XCNT(b.x)], 1u);
  return b;
}
DI void xcd_barrier_complete(unsigned* bar, unsigned x, unsigned& nloc, unsigned& nx) {
  const unsigned G = gridDim.x * gridDim.y * gridDim.z;
  unsigned sum, cnt, mine, sp = 0u;
  for (;;) {
    sum = 0u; cnt = 0u; mine = 0u;
#pragma unroll
    for (unsigned j = 0; j < 16; ++j) { const unsigned c = xb_ld(&bar[XB_XCNT(j)]); sum += c; cnt += (c > 0u) ? 1u : 0u; mine = (j == x) ? c : mine; }
    if (sum == G) break;
    __builtin_amdgcn_s_sleep(1);
    if ((++sp & 255u) == 0u) { if (xb_ld(&bar[XB_TMO])) break; if (sp > XB_SPIN_CAP) { atomicAdd(&bar[XB_TMO], 1u); break; } }
  }
  nloc = mine > 0u ? mine : 1u; nx = cnt > 0u ? cnt : 1u;
}
DI void xcd_barrier(const XcdBarrier& b) {
  asm volatile("s_waitcnt vmcnt(0)" ::: "memory");
  __syncthreads();
  if (threadIdx.x == 0) {
    unsigned* bar = b.bar;
    __builtin_amdgcn_s_waitcnt(0);
    unsigned nloc = b.st[0], nx = b.st[1];
    if (nloc == 0u) { xcd_barrier_complete(bar, b.x, nloc, nx); b.st[0] = nloc; b.st[1] = nx; }
    const unsigned old = xb_add(&bar[XB_XSUB(b.x)], 1u);
    const unsigned gen = old / nloc;
    if (old + 1u == (gen + 1u) * nloc) {
      __builtin_amdgcn_fence(__ATOMIC_RELEASE, "agent");
      asm volatile("s_waitcnt vmcnt(0)" ::: "memory");
      const unsigned og = xb_add(&bar[XB_TOP], 1u);
      const unsigned tg = og / nx;
      if (og + 1u == (tg + 1u) * nx) xb_add(&bar[XB_TOPGEN], 1u);
      else XB_SPIN(xb_ld(&bar[XB_TOPGEN]) == tg, bar);
      __builtin_amdgcn_fence(__ATOMIC_ACQUIRE, "agent");
      xb_add(&bar[XB_XGEN(b.x)], 1u);
      asm volatile("s_waitcnt vmcnt(0)" ::: "memory");
    } else {
      XB_SPIN(xb_ld(&bar[XB_XGEN(b.x)]) == gen, bar);
      __builtin_amdgcn_fence(__ATOMIC_ACQUIRE, "agent");
      asm volatile("s_waitcnt vmcnt(0)" ::: "memory");
    }
  }
  __syncthreads();
}

constexpr int N_PHASES = 22;
template <class Epi>
DI void gemm256(char* smem_all, const bf16_t* A, const bf16_t* Bt, int M, int N, int K, const Epi& E) {
  pg8::Gemm g{A, Bt, M, N, K};
  pg8::StaticOrder S; S.init(M, N, (int)gridDim.x, (int)blockIdx.x);
  pg8::gemm_phase<Epi, pg8::StaticOrder, false>((PG8_LAS unsigned char*)smem_all, g, S, E, nullptr);
}
template <int ph>
DI void run_phase(const Params& p_in, char* smem, char* smem_all) {
  Params p = p_in;
  {
    size_t z = 0; asm volatile("" : "+s"(z)); p.ws = p_in.ws + z; p.out = p_in.out + z;
  }
  char* ws = p.ws;
  const float* mod = (const float*)(ws + WS_MOD);
  const bf16_t* H = (const bf16_t*)(ws + WS_H);
  if (ph == 0) { phase_prep(p, smem); return; }
  const int layer = ph >= 12 ? 1 : 0;
  const int lp = ph - (layer ? 12 : 1);
  int sub;
  if (layer == 0) sub = lp < 2 ? lp : lp + 1;
  else sub = lp < 2 ? lp : (lp == 2 ? 3 : lp + 2);
  const float* modl = mod + (size_t)layer * 8 * 12288;
  switch (sub) {
    case 0:
      if (layer == 0) phase_norm<true>(p, p.x, p.norm_gain, modl, modl + 2048);
      else phase_norm<false>(p, p.out, p.norm_gain + 2 * 2048, modl, modl + 2048);
      break;
    case 1: {
      if (layer == 0) fox_cumsum(p);
      pg8::EpiQkNorm eq{(bf16_t*)(ws + WS_QK), 4096, layer ? p.odd_qk_gain : p.even_fox_qk_gain, layer ? p.odd_qk_gain : p.even_diff_qk_gain,
                        layer ? 4 : 3, (float*)(smem_all + 131072)};
      gemm256(smem_all, H, (const bf16_t*)(ws + (layer ? WS_WQK1 : WS_WQK0)), T_, 4096, 2048, eq);
      pg8::EpiBf16 ev{(bf16_t*)(ws + WS_VT), T_};
      gemm256(smem_all, (const bf16_t*)(ws + (layer ? WS_WV1 : WS_WV0)), H, 2048, T_, 2048, ev);
    } break;
    case 3:
      if (layer == 0) phase_attn_even(p, smem_all); else phase_attn_odd(p, smem_all);
      break;
    case 4: phase_diff_combine(p); break;
    case 5: {
      pg8::EpiRes er{p.out, 2048, layer ? p.out : p.x, modl + 2 * 2048};
      gemm256(smem_all, (const bf16_t*)(ws + WS_ATT), (const bf16_t*)(ws + (layer ? WS_WO1 : WS_WO0)), T_, 2048, 2048, er);
    } break;
    case 6:
      phase_norm<false, true>(p, p.out, p.norm_gain + (layer * 2 + 1) * 2048, modl + 3 * 2048, modl + 4 * 2048);
      break;
    case 7: {
      pg8::EpiBf16 es{(bf16_t*)(ws + WS_SC), 2048};
      gemm256(smem_all, H, (const bf16_t*)(ws + (layer ? WS_WQ1 : WS_WQ0)), T_, 2048, 2048, es);
    } break;
    case 8: phase_peer_retrieve(p, smem); break;
    case 9: phase_peer_dots(p, layer, smem_all); break;
    case 10: phase_peer_act(p, layer); break;
    case 11: phase_peer_values(p, layer, modl + 5 * 2048, smem_all); break;
  }
}

#if FUSED
template <int PH>
DI void run_all(const Params& p, char* smem, char* smem_all, const XcdBarrier& xb, cg::grid_group& grid) {
  if constexpr (PH < N_PHASES) {
    run_phase<PH>(p, smem, smem_all);
    if constexpr (PH + 1 < N_PHASES) xcd_barrier(xb);
    run_all<PH + 1>(p, smem, smem_all, xb, grid);
  }
}
__global__ void __launch_bounds__(RTHREADS, 2) mega_kernel(Params p) {
  extern __shared__ __attribute__((aligned(16))) char smem_all[];
  char* smem = smem_all + (RTID() >> 8) * HALF_SMEM;
  cg::grid_group grid = cg::this_grid();
  volatile LAS unsigned* xst = (volatile LAS unsigned*)(smem_all + SMEM_BYTES - 16);
  if (threadIdx.x == 0) { xst[0] = 0u; xst[1] = 0u; }
  __syncthreads();
  const XcdBarrier xb = xcd_barrier_post((unsigned*)(p.ws + WS_BAR), xst);
  if (p.ws == nullptr) grid.sync();
  run_all<0>(p, smem, smem_all, xb, grid);
}
#else
template <int PH>
__global__ void __launch_bounds__(RTHREADS, 2) phase_kernel(Params p) {
  extern __shared__ __attribute__((aligned(16))) char smem_all[];
  char* smem = smem_all + (RTID() >> 8) * HALF_SMEM;
  run_phase<PH>(p, smem, smem_all);
}
template <int PH>
static void launch_phases(const Params& p, int grid, hipStream_t stream) {
  if constexpr (PH < N_PHASES) {
    (void)hipFuncSetAttribute((const void*)phase_kernel<PH>, hipFuncAttributeMaxDynamicSharedMemorySize, SMEM_BYTES);
    phase_kernel<PH><<<grid, RTHREADS, SMEM_BYTES, stream>>>(p);
    launch_phases<PH + 1>(p, grid, stream);
  }
}
#endif

extern "C" void kernel_launch(void* const* d_in, const int* in_sizes, int n_in, void* d_out, int out_size, void* d_ws,
                              size_t ws_size, hipStream_t stream) {
  Params p{};
  p.x = (const float*)d_in[0]; p.c = (const float*)d_in[1]; p.rel_bias = (const float*)d_in[2];
  p.norm_gain = (const float*)d_in[3]; p.w_ada = (const float*)d_in[4]; p.b_ada = (const float*)d_in[5];
  p.even_w_in = (const float*)d_in[6]; p.even_b_forget = (const float*)d_in[7]; p.even_fox_qk_gain = (const float*)d_in[8];
  p.even_diff_qk_gain = (const float*)d_in[9]; p.even_diff_lambda = (const float*)d_in[10];
  p.even_diff_subln_gain = (const float*)d_in[11]; p.even_w_out = (const float*)d_in[12];
  p.odd_w_qkv = (const float*)d_in[13]; p.odd_qk_gain = (const float*)d_in[14]; p.odd_w_out = (const float*)d_in[15];
  p.peer_w_query = (const float*)d_in[16]; p.peer_sub_keys = (const float*)d_in[17];
  p.peer_u = (const float*)d_in[18]; p.peer_v = (const float*)d_in[19];
  p.out = (float*)d_out; p.ws = (char*)d_ws;
  if (ws_size < WS_END) { fprintf(stderr, "workspace too small: %zu < %zu\n", ws_size, (size_t)WS_END); return; }
#if FUSED
  static int grid_blocks = 0;
  if (!grid_blocks) {
    int dev = 0, cus = 0, per_cu = 0;
    (void)hipGetDevice(&dev);
    (void)hipDeviceGetAttribute(&cus, hipDeviceAttributeMultiprocessorCount, dev);
    (void)hipFuncSetAttribute((const void*)mega_kernel, hipFuncAttributeMaxDynamicSharedMemorySize, SMEM_BYTES);
    (void)hipOccupancyMaxActiveBlocksPerMultiprocessor(&per_cu, mega_kernel, RTHREADS, SMEM_BYTES);
    if (per_cu > 1) per_cu = 1;
    grid_blocks = cus * per_cu;
  }
  (void)hipMemsetAsync(p.ws + WS_BAR, 0, WS_BAR_BYTES, stream);
  void* args[] = {&p};
  hipError_t e = hipLaunchCooperativeKernel((void*)mega_kernel, dim3(grid_blocks), dim3(RTHREADS), args, SMEM_BYTES, stream);
  if (e != hipSuccess) fprintf(stderr, "cooperative launch failed: %s (grid %d)\n", hipGetErrorString(e), grid_blocks);
#else
  launch_phases<0>(p, 256, stream);
#endif
}
```

```cpp
#include <hip/hip_runtime.h>
#include <hip/hip_cooperative_groups.h>
#include <stdint.h>
#include <stdio.h>
namespace cg = cooperative_groups;

#ifndef FUSED
#define FUSED 1
#endif

#define DI __device__ __forceinline__
typedef unsigned short bf16_t;
typedef __attribute__((ext_vector_type(8))) short bf16x8;
typedef __attribute__((ext_vector_type(4))) short bf16x4;
typedef __attribute__((ext_vector_type(16))) float f32x16;
typedef __attribute__((ext_vector_type(2))) __bf16 bf2_t;
typedef __attribute__((ext_vector_type(2))) float f2_t;
typedef __attribute__((ext_vector_type(4))) unsigned u32x4;
#define MFMA32(a, b, c) __builtin_amdgcn_mfma_f32_32x32x16_bf16((a), (b), (c), 0, 0, 0)

constexpr int T_ = 16384;
constexpr int D_ = 2048;
constexpr int S_ = 2048;
constexpr int NB_ = 8;
constexpr int NEXP = 16384;
constexpr float LOG2E = 1.4426950408889634f;
constexpr int NTHREADS = 256;
constexpr int HALF_SMEM = 75776;
constexpr int RTHREADS = 512;
constexpr int SMEM_BYTES = 2 * HALF_SMEM + 16;

constexpr size_t MiB = 1048576;
constexpr size_t WS_PEERU = 0;
constexpr size_t WS_PEERV8 = WS_PEERU + 64 * MiB;
constexpr size_t WS_PEERV = WS_PEERU + 128 * MiB;
constexpr size_t WS_WQK0 = WS_PEERV + 128 * MiB;
constexpr size_t WS_WV0 = WS_WQK0 + 16 * MiB;
constexpr size_t WS_WQK1 = WS_WV0 + 8 * MiB;
constexpr size_t WS_WV1 = WS_WQK1 + 16 * MiB;
constexpr size_t WS_WO0 = WS_WV1 + 8 * MiB;
constexpr size_t WS_WO1 = WS_WO0 + 8 * MiB;
constexpr size_t WS_WQ0 = WS_WO1 + 8 * MiB;
constexpr size_t WS_WQ1 = WS_WQ0 + 8 * MiB;
constexpr size_t WS_SK = WS_WQ1 + 8 * MiB;
constexpr size_t WS_WFF = WS_SK + 131072;
constexpr size_t WS_MOD = WS_WFF + 65536;
constexpr size_t WS_LOGF = WS_MOD + 786432;
constexpr size_t WS_FCUM = WS_LOGF + 524288;
constexpr size_t WS_MISC = WS_FCUM + 524288;
constexpr size_t WS_H = WS_MISC + 65536;
constexpr size_t WS_QK = WS_H + 64 * MiB;
constexpr size_t WS_VT = WS_QK + 128 * MiB;
constexpr size_t WS_ATT = WS_VT + 64 * MiB;
constexpr size_t WS_SC = WS_ATT + 64 * MiB;
constexpr size_t WS_BAR = WS_SC + 128 * MiB;
constexpr size_t WS_TICKETS = WS_BAR + 16384;
constexpr size_t WS_BAR_BYTES = 16384 + 4096;
constexpr size_t WS_IDX = WS_ATT;
constexpr size_t WS_GATE = WS_ATT + 8 * MiB;
constexpr size_t WS_ACT = WS_ATT + 16 * MiB;
constexpr size_t WS_PD = WS_SC;
constexpr size_t WS_USC4 = WS_PEERV + 1 * MiB;
constexpr size_t WS_H8 = WS_QK;
constexpr size_t WS_HS = WS_QK + 32 * MiB;
constexpr size_t WS_END = WS_BAR + 65536;

struct Params {
  const float* x; const float* c; const float* rel_bias; const float* norm_gain; const float* w_ada; const float* b_ada;
  const float* even_w_in; const float* even_b_forget; const float* even_fox_qk_gain; const float* even_diff_qk_gain;
  const float* even_diff_lambda; const float* even_diff_subln_gain; const float* even_w_out;
  const float* odd_w_qkv; const float* odd_qk_gain; const float* odd_w_out;
  const float* peer_w_query; const float* peer_sub_keys; const float* peer_u; const float* peer_v;
  float* out; char* ws;
};

DI unsigned pack_bf2(float a, float b) { f2_t v = {a, b}; return __builtin_bit_cast(unsigned, __builtin_convertvector(v, bf2_t)); }
DI unsigned pack_i8x4(float a, float b, float c, float d) {
  const int ia = (int)rintf(a), ib = (int)rintf(b), ic = (int)rintf(c), id = (int)rintf(d);
  return (unsigned)(ia & 255) | ((unsigned)(ib & 255) << 8) | ((unsigned)(ic & 255) << 16) | ((unsigned)id << 24);
}
DI unsigned q4(float v) { int q = (int)rintf(v); q = q > 7 ? 7 : (q < -7 ? -7 : q); return (unsigned)q & 15u; }
DI unsigned pack_i4x4(float a, float b, float c, float d) { return q4(a) | (q4(b) << 8) | (q4(c) << 16) | (q4(d) << 24); }
DI bf16_t f2bf(float a) { return (bf16_t)(pack_bf2(a, 0.f) & 0xffffu); }
DI float bf_lo(unsigned u) { return __uint_as_float(u << 16); }
DI float bf_hi(unsigned u) { return __uint_as_float(u & 0xffff0000u); }
DI int RTID() { int t = threadIdx.x; asm volatile("" : "+v"(t)); return t; }
DI int TID() { return RTID() & 255; }
DI int VBID() { return __builtin_amdgcn_readfirstlane(blockIdx.x * 2 + (RTID() >> 8)); }
DI int VGRID() { return gridDim.x * 2; }
DI int xcc_id() { return (int)(__builtin_amdgcn_s_getreg((3 << 11) | 20) & 0xFu); }
DI int crow(int reg, int h) { return (reg & 3) + 8 * (reg >> 2) + 4 * h; }
DI float wave_sum(float v) {
#pragma unroll
  for (int o = 32; o >= 1; o >>= 1) v += __shfl_xor(v, o);
  return v;
}
DI float wave_max(float v) {
#pragma unroll
  for (int o = 32; o >= 1; o >>= 1) v = fmaxf(v, __shfl_xor(v, o));
  return v;
}

DI void transpose_tile(const float* __restrict__ src, int ld, int c0, int k0, bf16_t* __restrict__ dst_row0, char* smem) {
  float* tile = (float*)smem;
  const int tid = TID();
  const int ty = tid >> 4, tx = tid & 15;
#pragma unroll
  for (int i = 0; i < 4; ++i) {
    const int k = ty + 16 * i;
    const float4 v = *(const float4*)(src + (size_t)(k0 + k) * ld + c0 + 4 * tx);
    float* t = tile + k * 65 + 4 * tx;
    t[0] = v.x; t[1] = v.y; t[2] = v.z; t[3] = v.w;
  }
  __syncthreads();
  const int cc = tid >> 2, kc = (tid & 3) * 16;
  unsigned pk[8];
#pragma unroll
  for (int j = 0; j < 8; ++j) pk[j] = pack_bf2(tile[(kc + 2 * j) * 65 + cc], tile[(kc + 2 * j + 1) * 65 + cc]);
  uint4* d = (uint4*)(dst_row0 + (size_t)cc * 2048 + k0 + kc);
  d[0] = make_uint4(pk[0], pk[1], pk[2], pk[3]);
  d[1] = make_uint4(pk[4], pk[5], pk[6], pk[7]);
  __syncthreads();
}

DI void phase_prep(const Params& p, char* smem) {
  const int tid = TID(), bid = VBID(), G = VGRID();
  char* ws = p.ws;
  {
    float* cond = (float*)smem;
    bool have_cond = false;
    for (int item = bid; item < 384; item += G) {
      if (!have_cond) {
        for (int e = tid; e < NB_ * D_; e += NTHREADS) {
          const int b = e >> 11, d = e & 2047;
          const float v = p.c[e];
          cond[d * 8 + b] = v / (1.f + __expf(-v));
        }
        have_cond = true;
        __syncthreads();
      }
      const int i = item / 192, n = (item % 192) * 64 + (tid & 63);
      const int w = tid >> 6;
      const float* wp = p.w_ada + (size_t)i * D_ * 12288 + n;
      float acc[8];
#pragma unroll
      for (int b = 0; b < 8; ++b) acc[b] = 0.f;
#pragma unroll 8
      for (int d = w; d < D_; d += 4) {
        const float wv = wp[(size_t)d * 12288];
        const float4 c0 = *(const float4*)(cond + d * 8), c1 = *(const float4*)(cond + d * 8 + 4);
        acc[0] += c0.x * wv; acc[1] += c0.y * wv; acc[2] += c0.z * wv; acc[3] += c0.w * wv;
        acc[4] += c1.x * wv; acc[5] += c1.y * wv; acc[6] += c1.z * wv; acc[7] += c1.w * wv;
      }
      float* red = (float*)(smem + 65536);
#pragma unroll
      for (int b = 0; b < 8; ++b) red[(w * 64 + (tid & 63)) * 8 + b] = acc[b];
      __syncthreads();
      if (tid < 64) {
        float* mod = (float*)(ws + WS_MOD);
#pragma unroll
        for (int b = 0; b < 8; ++b) {
          const float s = red[(0 * 64 + tid) * 8 + b] + red[(1 * 64 + tid) * 8 + b] + red[(2 * 64 + tid) * 8 + b] + red[(3 * 64 + tid) * 8 + b];
          mod[((size_t)i * 8 + b) * 12288 + n] = s + p.b_ada[i * 12288 + n];
        }
      }
      __syncthreads();
    }
    __syncthreads();
  }
  {
    bf16_t* wqk0 = (bf16_t*)(ws + WS_WQK0); bf16_t* wv0 = (bf16_t*)(ws + WS_WV0);
    bf16_t* wqk1 = (bf16_t*)(ws + WS_WQK1); bf16_t* wv1 = (bf16_t*)(ws + WS_WV1);
    for (int item = bid; item < 256 * 32; item += G) {
      const int ct = item >> 5, kt = item & 31;
      const float* src; int ld, c0; bf16_t* dst;
      if (ct < 96) {
        const int seg = ct >> 4, cl = (ct & 15) * 64;
        src = p.even_w_in; ld = 6152;
        c0 = (seg < 3 ? seg * 1024 : 3080 + (seg - 3) * 1024) + cl;
        if (seg == 0) dst = wqk0 + (size_t)cl * 2048;
        else if (seg == 1) dst = wqk0 + (size_t)(1024 + cl) * 2048;
        else if (seg == 2) dst = wv0 + (size_t)cl * 2048;
        else if (seg == 3) dst = wqk0 + (size_t)(2048 + cl) * 2048;
        else if (seg == 4) dst = wqk0 + (size_t)(3072 + cl) * 2048;
        else dst = wv0 + (size_t)(1024 + cl) * 2048;
      } else if (ct < 192) {
        const int cl = (ct - 96) * 64;
        src = p.odd_w_qkv; ld = 6144; c0 = cl;
        dst = cl < 4096 ? wqk1 + (size_t)cl * 2048 : wv1 + (size_t)(cl - 4096) * 2048;
      } else {
        const int mi = (ct - 192) >> 5, cl = ((ct - 192) & 31) * 64;
        ld = 2048; c0 = cl;
        if (mi == 0) { src = p.even_w_out; dst = (bf16_t*)(ws + WS_WO0); }
        else { src = p.odd_w_out; dst = (bf16_t*)(ws + WS_WO1); }
        dst += (size_t)cl * 2048;
      }
      transpose_tile(src, ld, c0, kt * 64, dst, smem);
    }
  }
  {
    const int lane = tid & 63;
    const int gw = __builtin_amdgcn_readfirstlane((bid * NTHREADS + tid) >> 6), nw = (G * NTHREADS) >> 6;
    float* scl = (float*)(ws + WS_PEERV);
    float4 nx[8];
    {
      const int r0 = gw < 4 * NEXP ? gw : 0;
      const float* s0 = ((r0 >> 15) ? p.peer_v : p.peer_u) + (size_t)(r0 & 32767) * D_;
#pragma unroll
      for (int i = 0; i < 2; ++i)
#pragma unroll
        for (int j = 0; j < 4; ++j) nx[4 * i + j] = *(const float4*)(s0 + lane * 16 + 1024 * i + 4 * j);
    }
    for (int row = gw; row < 4 * NEXP; row += nw) {
      const int tab = row >> 15, rr = row & 32767;
      unsigned char* dst = (unsigned char*)(ws + (tab ? WS_PEERV8 : WS_PEERU)) + (size_t)(rr >> 14) * NEXP * D_ + (size_t)(rr & (NEXP - 1)) * 128;
      float4 v[8];
      float am = 0.f;
#pragma unroll
      for (int i = 0; i < 8; ++i) v[i] = nx[i];
      {
        const int rn = row + nw < 4 * NEXP ? row + nw : row;
        const float* sn = ((rn >> 15) ? p.peer_v : p.peer_u) + (size_t)(rn & 32767) * D_;
#pragma unroll
        for (int i = 0; i < 2; ++i)
#pragma unroll
          for (int j = 0; j < 4; ++j) nx[4 * i + j] = *(const float4*)(sn + lane * 16 + 1024 * i + 4 * j);
        asm volatile("" ::: "memory");
      }
#pragma unroll
      for (int i = 0; i < 8; ++i) am = fmaxf(am, fmaxf(fmaxf(fabsf(v[i].x), fabsf(v[i].y)), fmaxf(fabsf(v[i].z), fabsf(v[i].w))));
      if (!tab) {
        unsigned char* d4 = (unsigned char*)(ws + WS_PEERU) + (size_t)(rr >> 14) * (8 * NEXP * 128) + (size_t)(rr & (NEXP - 1)) * 128 + (lane & 15) * 8;
        float* sc4 = (float*)(ws + WS_USC4) + (size_t)(rr >> 14) * (8 * NEXP) + (rr & (NEXP - 1));
#pragma unroll
        for (int i = 0; i < 2; ++i) {
          float bm = 0.f;
#pragma unroll
          for (int j = 0; j < 4; ++j) bm = fmaxf(bm, fmaxf(fmaxf(fabsf(v[4 * i + j].x), fabsf(v[4 * i + j].y)), fmaxf(fabsf(v[4 * i + j].z), fabsf(v[4 * i + j].w))));
#pragma unroll
          for (int o = 1; o < 16; o <<= 1) bm = fmaxf(bm, __shfl_xor(bm, o));
          const float sc = bm > 0.f ? 7.5f / bm : 1.f;
          const int slice = 4 * i + (lane >> 4);
          if ((lane & 15) == 0) sc4[(size_t)slice * NEXP] = bm > 0.f ? bm / 7.5f : 1.f;
          unsigned w[2];
#pragma unroll
          for (int gq = 0; gq < 2; ++gq) {
            const float4 a = v[4 * i + 2 * gq], b = v[4 * i + 2 * gq + 1];
            const unsigned lo = pack_i4x4(a.x * sc, a.y * sc, a.z * sc, a.w * sc);
            const unsigned hi = pack_i4x4(b.x * sc, b.y * sc, b.z * sc, b.w * sc);
            w[gq] = lo | (hi << 4);
          }
          *(uint2*)(d4 + (size_t)slice * (NEXP * 128)) = make_uint2(w[0], w[1]);
        }
        continue;
      }
      am = wave_max(am);
      const float sc = am > 0.f ? 127.f / am : 1.f;
      if (lane == 0) scl[row] = am > 0.f ? am / 127.f : 1.f;
#pragma unroll
      for (int i = 0; i < 2; ++i) {
        unsigned w[4];
#pragma unroll
        for (int j = 0; j < 4; ++j) w[j] = pack_i8x4(v[4 * i + j].x * sc, v[4 * i + j].y * sc, v[4 * i + j].z * sc, v[4 * i + j].w * sc);
        *(uint4*)(dst + (size_t)((lane >> 3) + 8 * i) * (NEXP * 128) + (lane & 7) * 16) = make_uint4(w[0], w[1], w[2], w[3]);
      }
    }
  }
  {
    float* sks = (float*)smem;
    float* wqs = (float*)(smem + 33792);
    const int tn = tid >> 4, tk = tid & 15;
    for (int item = bid; item < 2048; item += G) {
      const int layer = item >> 10, hp = (item >> 6) & 15, nt = (item >> 5) & 1, kt = item & 31;
      const float* sk = p.peer_sub_keys + ((size_t)(layer * 2 + (hp & 1)) * 128 + nt * 64) * 128;
      const float* wq = p.peer_w_query + (size_t)layer * 2048 * 2048 + (size_t)(kt * 64) * 2048 + hp * 128;
      __syncthreads();
#pragma unroll
      for (int i = 0; i < 8; ++i) {
        const int idx = tid + 256 * i, row = idx >> 5, c4 = (idx & 31) * 4;
        *(float4*)(sks + row * 132 + c4) = *(const float4*)(sk + (size_t)row * 128 + c4);
        *(float4*)(wqs + row * 132 + c4) = *(const float4*)(wq + (size_t)row * 2048 + c4);
      }
      __syncthreads();
      float acc[4][4];
#pragma unroll
      for (int i = 0; i < 4; ++i)
#pragma unroll
        for (int j = 0; j < 4; ++j) acc[i][j] = 0.f;
#pragma unroll 4
      for (int d = 0; d < 128; d += 4) {
        float4 a[4], b[4];
#pragma unroll
        for (int i = 0; i < 4; ++i) { a[i] = *(const float4*)(sks + (tn + 16 * i) * 132 + d); b[i] = *(const float4*)(wqs + (tk + 16 * i) * 132 + d); }
#pragma unroll
        for (int i = 0; i < 4; ++i)
#pragma unroll
          for (int j = 0; j < 4; ++j) acc[i][j] += a[i].x * b[j].x + a[i].y * b[j].y + a[i].z * b[j].z + a[i].w * b[j].w;
      }
      bf16_t* dst = (bf16_t*)(ws + (layer ? WS_WQ1 : WS_WQ0)) + (size_t)(hp * 128 + nt * 64) * 2048 + kt * 64;
#pragma unroll
      for (int i = 0; i < 4; ++i)
#pragma unroll
        for (int j = 0; j < 4; ++j) dst[(size_t)(tn + 16 * i) * 2048 + tk + 16 * j] = f2bf(acc[i][j]);
    }
    __syncthreads();
  }
  if (bid == G - 1) {
    float* wff = (float*)(ws + WS_WFF);
    for (int e = tid; e < 2048 * 8; e += NTHREADS) wff[e] = p.even_w_in[(size_t)(e >> 3) * 6152 + 3072 + (e & 7)];
    if (tid < 64) {
      const float* l = p.even_diff_lambda;
      float s1 = l[tid] * l[128 + tid] + l[64 + tid] * l[128 + 64 + tid];
      float s2 = l[256 + tid] * l[384 + tid] + l[256 + 64 + tid] * l[384 + 64 + tid];
      s1 = wave_sum(s1); s2 = wave_sum(s2);
      if (tid == 0) ((float*)(ws + WS_MISC))[0] = expf(s1) - expf(s2) + 0.2f;
    }
  }
}

template <bool FF, bool Q8 = false>
DI void phase_norm(const Params& p, const float* __restrict__ xin, const float* __restrict__ gain,
                   const float* __restrict__ sh, const float* __restrict__ sc  ) {
  const int lane = TID() & 63;
  const int gw = __builtin_amdgcn_readfirstlane((VBID() * NTHREADS + TID()) >> 6), nw = (VGRID() * NTHREADS) >> 6;
  bf16_t* H = (bf16_t*)(p.ws + WS_H);
  for (int t = gw; t < T_; t += nw) {
    const int b = t >> 11;
    const float* xr = xin + (size_t)t * D_;
    float4 v[8];
    float ss = 0.f;
#pragma unroll
    for (int i = 0; i < 8; ++i) { v[i] = *(const float4*)(xr + lane * 4 + 256 * i); ss += v[i].x * v[i].x + v[i].y * v[i].y + v[i].z * v[i].z + v[i].w * v[i].w; }
    ss = wave_sum(ss);
    const float rstd = rsqrtf(ss * (1.f / 2048.f) + 1e-6f);
    float ff[8];
    if (FF) {
#pragma unroll
      for (int j = 0; j < 8; ++j) ff[j] = 0.f;
    }
    float am = 0.f;
#pragma unroll
    for (int i = 0; i < 8; ++i) {
      const int c = lane * 4 + 256 * i;
      const float4 g = *(const float4*)(gain + c);
      const float4 s1 = *(const float4*)(sc + (size_t)b * 12288 + c);
      const float4 s0 = *(const float4*)(sh + (size_t)b * 12288 + c);
      float4 h;
      h.x = v[i].x * rstd * g.x * (1.f + s1.x) + s0.x;
      h.y = v[i].y * rstd * g.y * (1.f + s1.y) + s0.y;
      h.z = v[i].z * rstd * g.z * (1.f + s1.z) + s0.z;
      h.w = v[i].w * rstd * g.w * (1.f + s1.w) + s0.w;
      *(uint2*)(H + (size_t)t * D_ + c) = make_uint2(pack_bf2(h.x, h.y), pack_bf2(h.z, h.w));
      if (Q8) { v[i] = h; am = fmaxf(am, fmaxf(fmaxf(fabsf(h.x), fabsf(h.y)), fmaxf(fabsf(h.z), fabsf(h.w)))); }
      if (FF) {
        const float* wff = (const float*)(p.ws + WS_WFF) + c * 8;
        const float hv[4] = {h.x, h.y, h.z, h.w};
#pragma unroll
        for (int e = 0; e < 4; ++e) {
          const float4 w0 = *(const float4*)(wff + e * 8), w1 = *(const float4*)(wff + e * 8 + 4);
          ff[0] += hv[e] * w0.x; ff[1] += hv[e] * w0.y; ff[2] += hv[e] * w0.z; ff[3] += hv[e] * w0.w;
          ff[4] += hv[e] * w1.x; ff[5] += hv[e] * w1.y; ff[6] += hv[e] * w1.z; ff[7] += hv[e] * w1.w;
        }
      }
    }
    if (Q8) {
      am = wave_max(am);
      const float qs = am > 0.f ? 119.f / am : 1.f;
      unsigned char* h8 = (unsigned char*)(p.ws + WS_H8) + (size_t)t * D_ + lane * 4;
#pragma unroll
      for (int i = 0; i < 8; ++i) *(unsigned*)(h8 + 256 * i) = pack_i8x4(v[i].x * qs, v[i].y * qs, v[i].z * qs, v[i].w * qs);
      if (lane == 0) ((float*)(p.ws + WS_HS))[t] = am > 0.f ? am / 119.f : 1.f;
    }
    if (FF) {
#pragma unroll
      for (int j = 0; j < 8; ++j) ff[j] = wave_sum(ff[j]);
      if (lane < 8) {
        float z = ff[0];
#pragma unroll
        for (int j = 1; j < 8; ++j) z = (lane == j) ? ff[j] : z;
        z += p.even_b_forget[lane];
        const float lf = fminf(z, 0.f) - log1pf(__expf(-fabsf(z)));
        ((float*)(p.ws + WS_LOGF))[(size_t)t * 8 + lane] = lf;
      }
    }
  }
}

DI void fox_cumsum(const Params& p) {
  const int lane = TID() & 63;
  const int gw = __builtin_amdgcn_readfirstlane((VBID() * NTHREADS + TID()) >> 6), nw = (VGRID() * NTHREADS) >> 6;
  const float* lf = (const float*)(p.ws + WS_LOGF);
  float* fc = (float*)(p.ws + WS_FCUM);
  for (int it = gw; it < 64; it += nw) {
    const int b = it >> 3, hh = it & 7;
    float v[32];
    float tot = 0.f;
#pragma unroll
    for (int j = 0; j < 32; ++j) { tot += lf[(size_t)(b * S_ + lane * 32 + j) * 8 + hh]; v[j] = tot; }
    float inc = tot;
#pragma unroll
    for (int o = 1; o < 64; o <<= 1) { const float n = __shfl_up(inc, o); if (lane >= o) inc += n; }
    const float base = inc - tot;
#pragma unroll
    for (int j = 0; j < 32; ++j) fc[(size_t)it * S_ + lane * 32 + j] = v[j] + base;
  }
}

namespace pg8 {
#define PG8_LAS __attribute__((address_space(3)))
typedef float f32x4 __attribute__((ext_vector_type(4)));
constexpr int BM = 256, BK = 64, HALF = 128, HTB = HALF * BK * 2  , STAGE_BYTES = 8 * HTB, NXCD = 8, WGM = 8;

__host__ __device__ __forceinline__ int lds_byte(int r, int c) { const int st = (r >> 4) * 2 + (c >> 5), rr = r & 15, cc = c & 31, ob = rr * 64 + cc * 2; return st * 1024 + (ob ^ (((ob >> 9) & 1) << 5)); }
__host__ __device__ __forceinline__ void stage_rc(int b, int& R, int& C) { const int st = b / 1024, sb = b % 1024, swz = sb ^ (((sb >> 9) & 1) << 5); R = (st >> 1) * 16 + swz / 64; C = (st & 1) * 32 + (swz % 64) / 2; }
__host__ __device__ __forceinline__ int perm32(int rho) { const int n = rho >> 4, i = rho & 15; return 8 * (i >> 2) + 4 * n + (i & 3); }

struct Unit { int pm, pn; };
struct Gemm { const bf16_t* A; const bf16_t* Bt; int M, N, K; };

struct StaticOrder {
    int nM, nN, nwg, G, c;
    __host__ __device__ void init(int M, int N, int G_, int c_) { nM = M / BM; nN = N / BM; nwg = nM * nN; G = G_; c = c_; }
    __host__ __device__ bool next(int i, Unit& u) const {
        const long L = (long)i * G + c; if (L >= nwg) return false;
        int wgid = (int)L; { const int q = nwg / NXCD, r = nwg % NXCD, xcd = wgid % NXCD, off = wgid / NXCD; wgid = (xcd < r ? xcd * (q + 1) : r * (q + 1) + (xcd - r) * q) + off; }
        const int nig = WGM * nN, gid = wgid / nig, fm = gid * WGM, gsz = (nM - fm) < WGM ? (nM - fm) : WGM;
        u.pm = fm + ((wgid % nig) % gsz); u.pn = (wgid % nig) / gsz; return true;
    }
    __device__ __forceinline__ void a_ready(const Unit&) const {}
    __device__ __forceinline__ void done(const Unit&) const {}
};

struct EpiF32 {
    static constexpr bool PERM = false, AFTER_DRAIN = false;
    float* C; int ldc; const float* bias;
    __device__ __forceinline__ void operator()(const f32x4 (&acc)[2][2][4][2], const Unit& u, int wr, int wc, int fr, int fq) const {
        const int row0 = u.pm * BM + wr * 64 + fr, col0 = u.pn * BM + wc * 32 + 4 * fq;
        f32x4 bv[2][2];
#pragma unroll
        for (int bj = 0; bj < 2; ++bj)
#pragma unroll
            for (int n = 0; n < 2; ++n) bv[bj][n] = bias ? *(const f32x4*)(bias + col0 + bj * HALF + n * 16) : (f32x4){0.f, 0.f, 0.f, 0.f};
#pragma unroll
        for (int ai = 0; ai < 2; ++ai)
#pragma unroll
            for (int m = 0; m < 4; ++m) { float* rowp = C + (size_t)(row0 + ai * HALF + m * 16) * ldc + col0;
#pragma unroll
                for (int bj = 0; bj < 2; ++bj)
#pragma unroll
                    for (int n = 0; n < 2; ++n) *(f32x4*)(rowp + bj * HALF + n * 16) = acc[ai][bj][m][n] + bv[bj][n]; }
    }
};
struct EpiBf16 {
    static constexpr bool PERM = true, AFTER_DRAIN = false;
    bf16_t* O; int ldc;
    __device__ __forceinline__ void operator()(const f32x4 (&acc)[2][2][4][2], const Unit& u, int wr, int wc, int fr, int fq) const {
        const int row0 = u.pm * BM + wr * 64 + fr, col0 = u.pn * BM + wc * 32 + 8 * fq;
#pragma unroll
        for (int ai = 0; ai < 2; ++ai)
#pragma unroll
            for (int m = 0; m < 4; ++m) { bf16_t* rowp = O + (size_t)(row0 + ai * HALF + m * 16) * ldc + col0;
#pragma unroll
                for (int bj = 0; bj < 2; ++bj) { const f32x4 v0 = acc[ai][bj][m][0], v1 = acc[ai][bj][m][1];
                    u32x4 w; w.x = pack_bf2(v0[0], v0[1]); w.y = pack_bf2(v0[2], v0[3]); w.z = pack_bf2(v1[0], v1[1]); w.w = pack_bf2(v1[2], v1[3]);
                    *(u32x4*)(rowp + bj * HALF) = w; } }
    }
};
struct EpiQkNorm {
    static constexpr bool PERM = true, AFTER_DRAIN = false;
    bf16_t* O; int ldc; const float* gainA; const float* gainB; int gshift; float* red;
    __device__ __forceinline__ void operator()(const f32x4 (&acc)[2][2][4][2], const Unit& u, int wr, int wc, int fr, int fq) const {
        float ss[2][4][2];
#pragma unroll
        for (int ai = 0; ai < 2; ++ai)
#pragma unroll
            for (int m = 0; m < 4; ++m)
#pragma unroll
                for (int bj = 0; bj < 2; ++bj) {
                    const f32x4 v0 = acc[ai][bj][m][0], v1 = acc[ai][bj][m][1];
                    float t = v0[0] * v0[0] + v0[1] * v0[1] + v0[2] * v0[2] + v0[3] * v0[3] + v1[0] * v1[0] + v1[1] * v1[1] + v1[2] * v1[2] + v1[3] * v1[3];
                    t += __shfl_xor(t, 16); t += __shfl_xor(t, 32);
                    ss[ai][m][bj] = t;
                }
        float* myred = red + (wr * 4 + wc) * 256;
        if (fq == 0) {
#pragma unroll
            for (int ai = 0; ai < 2; ++ai)
#pragma unroll
                for (int m = 0; m < 4; ++m)
#pragma unroll
                    for (int bj = 0; bj < 2; ++bj) myred[(ai * 64 + m * 16 + fr) * 2 + bj] = ss[ai][m][bj];
        }
        asm volatile("s_waitcnt lgkmcnt(0)" ::: "memory"); __builtin_amdgcn_s_barrier(); asm volatile("" ::: "memory");
        const int row0 = u.pm * BM + wr * 64 + fr, col0 = u.pn * BM + wc * 32 + 8 * fq;
        const float* rbase = red + (wr * 4) * 256;
#pragma unroll
        for (int bj = 0; bj < 2; ++bj) {
            const int grp = (u.pn * 2 + bj) >> gshift;
            const float* gain = ((grp & 2) ? gainB : gainA) + (grp & 1) * 128 + wc * 32 + 8 * fq;
            const float qs = (grp & 1) ? 1.f : 0.08838834764831845f * LOG2E;
            float4 g0 = *(const float4*)gain, g1 = *(const float4*)(gain + 4);
            g0.x *= qs; g0.y *= qs; g0.z *= qs; g0.w *= qs; g1.x *= qs; g1.y *= qs; g1.z *= qs; g1.w *= qs;
#pragma unroll
            for (int ai = 0; ai < 2; ++ai)
#pragma unroll
                for (int m = 0; m < 4; ++m) {
                    const int ri = (ai * 64 + m * 16 + fr) * 2 + bj;
                    const float tot = rbase[ri] + rbase[256 + ri] + rbase[512 + ri] + rbase[768 + ri];
                    const float rstd = rsqrtf(tot * (1.f / 128.f) + 1e-6f);
                    const f32x4 v0 = acc[ai][bj][m][0], v1 = acc[ai][bj][m][1];
                    u32x4 w;
                    w.x = pack_bf2(v0[0] * rstd * g0.x, v0[1] * rstd * g0.y); w.y = pack_bf2(v0[2] * rstd * g0.z, v0[3] * rstd * g0.w);
                    w.z = pack_bf2(v1[0] * rstd * g1.x, v1[1] * rstd * g1.y); w.w = pack_bf2(v1[2] * rstd * g1.z, v1[3] * rstd * g1.w);
                    *(u32x4*)(O + (size_t)(row0 + ai * HALF + m * 16) * ldc + col0 + bj * HALF) = w;
                }
        }
    }
};
struct EpiRes {
    static constexpr bool PERM = false, AFTER_DRAIN = false;
    float* C; int ldc; const float* xin; const float* gate;
    __device__ __forceinline__ void operator()(const f32x4 (&acc)[2][2][4][2], const Unit& u, int wr, int wc, int fr, int fq) const {
        const int row0 = u.pm * BM + wr * 64 + fr, col0 = u.pn * BM + wc * 32 + 4 * fq;
        const float* gp = gate + (size_t)((u.pm * BM) >> 11) * 12288 + col0;
        f32x4 gv[2][2];
#pragma unroll
        for (int bj = 0; bj < 2; ++bj)
#pragma unroll
            for (int n = 0; n < 2; ++n) gv[bj][n] = *(const f32x4*)(gp + bj * HALF + n * 16);
#pragma unroll
        for (int ai = 0; ai < 2; ++ai)
#pragma unroll
            for (int m = 0; m < 4; ++m) { const size_t ro = (size_t)(row0 + ai * HALF + m * 16) * ldc + col0;
#pragma unroll
                for (int bj = 0; bj < 2; ++bj)
#pragma unroll
                    for (int n = 0; n < 2; ++n) { const f32x4 xv = *(const f32x4*)(xin + ro + bj * HALF + n * 16);
                        *(f32x4*)(C + ro + bj * HALF + n * 16) = xv + gv[bj][n] * acc[ai][bj][m][n]; } }
    }
};

template <class Epi, class Sched, bool STAMP = false>
__device__ __forceinline__ void gemm_phase(PG8_LAS unsigned char* lds, const Gemm g, const Sched& S, const Epi& E, unsigned long long* stamps) {
    const int tid = RTID(), wid = __builtin_amdgcn_readfirstlane(tid >> 6), lane = tid & 63, wr = wid >> 2, wc = wid & 3, fr = lane & 15, fq = lane >> 4;
    const int K = g.K, nt = K / BK;
    int ts_lo = 0, ts_hi = 0, nts = 0; const unsigned long long rt_entry = STAMP ? (unsigned long long)wall_clock64() : 0ull;
#define PG8_STAMP() do { if (STAMP && wid == 0 && nts < 64) { const unsigned long long _c = (unsigned long long)clock64(); \
        ts_lo = (lane == nts) ? (int)(unsigned)_c : ts_lo; ts_hi = (lane == nts) ? (int)(unsigned)(_c >> 32) : ts_hi; ++nts; } } while (0)
    PG8_STAMP();
    unsigned voffA[2], voffB[2];
#pragma unroll
    for (int i = 0; i < 2; ++i) { int R, C; stage_rc(tid * 16 + i * 8192, R, C); const int Rb = Epi::PERM ? ((R & ~31) + perm32(R & 31)) : R;
        voffA[i] = (unsigned)(R * K + C) * 2u; voffB[i] = (unsigned)(Rb * K + C) * 2u; }
    const size_t kstep = (size_t)(BK * 2);
    const size_t hstep = (size_t)HALF * K * 2;
    const size_t tstep = 2 * hstep;
    const unsigned ldsw = (unsigned)wid * 1024u;
    const int aoff = lds_byte(wr * 64 + fr, fq * 8), boff = lds_byte(wc * 32 + fr, fq * 8);
#define PG8_SA(b, h) (((b) * 2 + (h)) * HTB)
#define PG8_SB(b, h) ((4 + (b) * 2 + (h)) * HTB)
#define PG8_STAGE(bufoff, gbase, voff) do { _Pragma("unroll") for (int _i = 0; _i < 2; ++_i) \
        __builtin_amdgcn_global_load_lds((const unsigned*)((const char*)(gbase) + (voff)[_i]), (PG8_LAS unsigned*)(lds + (bufoff) + ldsw + _i * 8192), 16, 0, 0); } while (0)
#define PG8_LDA(dst, b, h) do { _Pragma("unroll") for (int m = 0; m < 4; ++m) _Pragma("unroll") for (int k = 0; k < 2; ++k) dst[m][k] = *(const PG8_LAS bf16x8*)(lds + PG8_SA(b, h) + aoff + m * 2048 + k * 1024); } while (0)
#define PG8_LDB(dst, b, h) do { _Pragma("unroll") for (int n = 0; n < 2; ++n) _Pragma("unroll") for (int k = 0; k < 2; ++k) dst[n][k] = *(const PG8_LAS bf16x8*)(lds + PG8_SB(b, h) + boff + n * 2048 + k * 1024); } while (0)
#define PG8_MMA(ai, bj, At, Bt) do { __builtin_amdgcn_s_setprio(1); _Pragma("unroll") for (int m = 0; m < 4; ++m) _Pragma("unroll") for (int n = 0; n < 2; ++n) _Pragma("unroll") for (int k = 0; k < 2; ++k) \
        acc[ai][bj][m][n] = __builtin_amdgcn_mfma_f32_16x16x32_bf16(Bt[n][k], At[m][k], acc[ai][bj][m][n], 0, 0, 0); __builtin_amdgcn_s_setprio(0); } while (0)
#define PG8_WAIT_V(n) asm volatile("s_waitcnt vmcnt(" #n ")" ::: "memory")
#define PG8_WAIT_L(n) asm volatile("s_waitcnt lgkmcnt(" #n ")" ::: "memory")
#define PG8_BAR __builtin_amdgcn_s_barrier()
#define PG8_SCHED __builtin_amdgcn_sched_barrier(0)
    Unit cur, nxt; int ui = 0;
    if (!S.next(0, cur)) return;
    f32x4 acc[2][2][4][2];
#pragma unroll
    for (int a = 0; a < 2; ++a)
#pragma unroll
        for (int b = 0; b < 2; ++b)
#pragma unroll
            for (int m = 0; m < 4; ++m)
#pragma unroll
                for (int n = 0; n < 2; ++n) acc[a][b][m][n] = (f32x4){0.f, 0.f, 0.f, 0.f};
    bf16x8 At[4][2], B0[2][2], B1[2][2];
    const char* cA = (const char*)g.A + (size_t)cur.pm * tstep; const char* cB = (const char*)g.Bt + (size_t)cur.pn * tstep;
    S.a_ready(cur);
    PG8_STAGE(PG8_SB(0, 0), cB, voffB); PG8_STAGE(PG8_SA(0, 0), cA, voffA); PG8_STAGE(PG8_SB(0, 1), cB + hstep, voffB); PG8_STAGE(PG8_SA(0, 1), cA + hstep, voffA);
    if (wr == 1) PG8_BAR;
    PG8_WAIT_V(4); PG8_BAR;
    PG8_STAGE(PG8_SB(1, 0), cB + kstep, voffB); PG8_STAGE(PG8_SA(1, 0), cA + kstep, voffA); PG8_STAGE(PG8_SB(1, 1), cB + hstep + kstep, voffB);
    PG8_WAIT_V(6); PG8_BAR;
    PG8_STAMP();
    for (;;) {
        const bool has_next = S.next(ui + 1, nxt);
        const char* nA = has_next ? (const char*)g.A + (size_t)nxt.pm * tstep : cA; const char* nB = has_next ? (const char*)g.Bt + (size_t)nxt.pn * tstep : cB;
        for (int t = 0; t < nt; t += 2) {
            const bool last = (t == nt - 2);
            const char* a1 = cA + (size_t)(t + 1) * kstep;
            const char* a2 = last ? nA : cA + (size_t)(t + 2) * kstep; const char* b2 = last ? nB : cB + (size_t)(t + 2) * kstep;
            const char* a3 = a2 + kstep; const char* b3 = b2 + kstep;
            if (last && has_next) S.a_ready(nxt);
            PG8_LDB(B0, 0, 0); PG8_SCHED; PG8_LDA(At, 0, 0); PG8_STAGE(PG8_SA(1, 1), a1 + hstep, voffA);
            PG8_WAIT_L(8); PG8_BAR; PG8_WAIT_L(0); PG8_MMA(0, 0, At, B0); PG8_BAR; PG8_SCHED;
            PG8_LDB(B1, 0, 1); PG8_STAGE(PG8_SB(0, 0), b2, voffB);
            PG8_BAR; PG8_WAIT_L(0); PG8_MMA(0, 1, At, B1); PG8_BAR;
            PG8_LDA(At, 0, 1); PG8_STAGE(PG8_SA(0, 0), a2, voffA);
            PG8_BAR; PG8_WAIT_L(0); PG8_MMA(1, 0, At, B0); PG8_BAR; PG8_SCHED;
            PG8_STAGE(PG8_SB(0, 1), b2 + hstep, voffB);
            PG8_WAIT_V(6); PG8_BAR; PG8_MMA(1, 1, At, B1); PG8_BAR;
            PG8_LDB(B0, 1, 0); PG8_SCHED; PG8_LDA(At, 1, 0); PG8_STAGE(PG8_SA(0, 1), a2 + hstep, voffA);
            PG8_WAIT_L(8); PG8_BAR; PG8_WAIT_L(0); PG8_MMA(0, 0, At, B0); PG8_BAR; PG8_SCHED;
            PG8_LDB(B1, 1, 1); PG8_STAGE(PG8_SB(1, 0), b3, voffB);
            PG8_BAR; PG8_WAIT_L(0); PG8_MMA(0, 1, At, B1); PG8_BAR;
            PG8_LDA(At, 1, 1); PG8_STAGE(PG8_SA(1, 0), a3, voffA);
            PG8_BAR; PG8_WAIT_L(0); PG8_MMA(1, 0, At, B0); PG8_BAR; PG8_SCHED;
            PG8_STAGE(PG8_SB(1, 1), b3 + hstep, voffB);
            PG8_WAIT_V(6); PG8_BAR; PG8_MMA(1, 1, At, B1); PG8_BAR;
        }
        PG8_STAMP();
        if constexpr (!Epi::AFTER_DRAIN) { E(acc, cur, wr, wc, fr, fq); S.done(cur); }
        PG8_STAMP();
        if (!has_next) break;
#pragma unroll
        for (int a = 0; a < 2; ++a)
#pragma unroll
            for (int b = 0; b < 2; ++b)
#pragma unroll
                for (int m = 0; m < 4; ++m)
#pragma unroll
                    for (int n = 0; n < 2; ++n) acc[a][b][m][n] = (f32x4){0.f, 0.f, 0.f, 0.f};
        cur = nxt; cA = nA; cB = nB; ++ui;
    }
    PG8_WAIT_V(0);
    if (wr == 0) PG8_BAR;
    PG8_BAR;
    if constexpr (Epi::AFTER_DRAIN) { E.fused(acc, cur, wr, wc, fr, fq, lds, wid, lane); S.done(cur); }
    PG8_STAMP();
    if (STAMP && wid == 0) { stamps[lane] = lane < nts ? (((unsigned long long)(unsigned)ts_hi << 32) | (unsigned)ts_lo) : 0ull;
        if (lane == 62) stamps[62] = rt_entry; if (lane == 63) stamps[63] = (unsigned long long)wall_clock64(); }
#undef PG8_STAMP
#undef PG8_SA
#undef PG8_SB
#undef PG8_STAGE
#undef PG8_LDA
#undef PG8_LDB
#undef PG8_MMA
#undef PG8_WAIT_V
#undef PG8_WAIT_L
#undef PG8_BAR
#undef PG8_SCHED
}
}

struct AttnPtrs { const bf16_t* Q; int ldq; const bf16_t* K; int ldk; const bf16_t* Vt; int ldv; const float* kbias; };

DI float xhalf_max(float v) {
  const auto r2 = __builtin_amdgcn_permlane32_swap(__float_as_uint(v), __float_as_uint(v), false, false);
  return fmaxf(__uint_as_float(r2[0]), __uint_as_float(r2[1]));
}
DI float xhalf_sum(float v) {
  const auto r2 = __builtin_amdgcn_permlane32_swap(__float_as_uint(v), __float_as_uint(v), false, false);
  return __uint_as_float(r2[0]) + __uint_as_float(r2[1]);
}

template <int MODE, int DVB>
DI void attn_block(const AttnPtrs& a, int q0b, char* smem, const float* tbl, f32x16 (&o)[DVB], float& l_out) {
  constexpr int STG = 16384 + DVB * 4096;
  const int tid = RTID(), lane = tid & 63, wave = __builtin_amdgcn_readfirstlane(tid >> 6);
  const int r = lane & 31, h = lane >> 5;
  const int q0 = q0b + 32 * wave;
  const int krow = tid >> 4, kch = tid & 15;
  const int vrow = tid >> 3, vch = tid & 7;
  const char* Kb = (const char*)a.K;
  const char* Vb = (const char*)a.Vt;
  const unsigned kvo = (unsigned)(krow * a.ldk + kch * 8) * 2u;
  const unsigned vvo = (unsigned)(vrow * a.ldv + vch * 8) * 2u;
  const unsigned kst = (unsigned)(32 * a.ldk) * 2u, vst = (unsigned)(64 * a.ldv) * 2u;
  const int kwo = krow * 256 + ((kch ^ (krow & 15)) << 4);
  const int vwo = 16384 + vrow * 128 + ((vch ^ ((vrow >> 1) & 7)) << 4);
  const int pr = (r & ~12) | ((r & 4) << 1) | ((r & 8) >> 1);
  const int kro = pr * 256, ksw = pr & 15;
  const int vro = 16384 + r * 128, vsw = (r >> 1) & 7;
  bf16x8 qf[8];
#pragma unroll
  for (int s = 0; s < 8; ++s) qf[s] = *(const bf16x8*)(a.Q + (size_t)(q0 + r) * a.ldq + 16 * s + 8 * h);
#pragma unroll
  for (int dt = 0; dt < DVB; ++dt)
#pragma unroll
    for (int e = 0; e < 16; ++e) o[dt][e] = 0.f;
  float m = -1e30f, l = 0.f;
  const int nkt = (q0b + 256) >> 6;
  u32x4 rk[2], rv[DVB / 2];
#pragma unroll
  for (int i = 0; i < 2; ++i) rk[i] = *(const u32x4*)(Kb + (size_t)(i * kst) + kvo);
#pragma unroll
  for (int i = 0; i < DVB / 2; ++i) rv[i] = *(const u32x4*)(Vb + (size_t)(i * vst) + vvo);
#pragma unroll
  for (int i = 0; i < 2; ++i) *(u32x4*)(smem + kwo + i * 8192) = rk[i];
#pragma unroll
  for (int i = 0; i < DVB / 2; ++i) *(u32x4*)(smem + vwo + i * 8192) = rv[i];
  u32x4 rkB[2], rvB[DVB / 2];
  if constexpr (DVB == 4) {
    const int k1 = nkt > 1 ? 64 : 0;
#pragma unroll
    for (int i = 0; i < 2; ++i) rk[i] = *(const u32x4*)(Kb + ((size_t)k1 * (size_t)a.ldk * 2u + i * kst) + kvo);
#pragma unroll
    for (int i = 0; i < DVB / 2; ++i) rv[i] = *(const u32x4*)(Vb + ((size_t)k1 * 2u + i * vst) + vvo);
  }
  __syncthreads();
#define ATT_TILE(KT, RL, RVL, RW, RVW) { const int kt = (KT); \
    const int k0 = kt << 6; \
    char* st = smem + (kt & 1) * STG; \
    { \
      const int kn = (kt + 2 < nkt ? kt + 2 : nkt - 1) << 6;        \
      const size_t kbo = (size_t)kn * (size_t)a.ldk * 2u, vbo = (size_t)kn * 2u; \
_Pragma("unroll") \
      for (int i = 0; i < 2; ++i) RL[i] = *(const u32x4*)(Kb + (kbo + i * kst) + kvo); \
_Pragma("unroll") \
      for (int i = 0; i < DVB / 2; ++i) RVL[i] = *(const u32x4*)(Vb + (vbo + i * vst) + vvo); \
    } \
    asm volatile("" ::: "memory"); \
    __builtin_amdgcn_sched_barrier(0); \
_Pragma("unroll") \
    for (int sub = 0; sub < 2; ++sub) { \
      const int ks0 = k0 + 32 * sub; \
      if (ks0 <= q0) { \
        f32x16 sa; \
_Pragma("unroll") \
        for (int e = 0; e < 16; ++e) sa[e] = 0.f; \
_Pragma("unroll") \
        for (int s = 0; s < 8; ++s) { \
          const bf16x8 kf = *(const bf16x8*)(st + kro + sub * 8192 + (((2 * s + h) ^ ksw) << 4)); \
          sa = MFMA32(kf, qf[s], sa); \
        } \
        float v[16]; \
        if (MODE == 0) { \
_Pragma("unroll") \
          for (int c = 0; c < 2; ++c) { \
            const float4 kb0 = *(const float4*)(a.kbias + ks0 + 16 * c + 8 * h); \
            const float4 kb1 = *(const float4*)(a.kbias + ks0 + 16 * c + 8 * h + 4); \
            v[8 * c + 0] = sa[8 * c + 0] - kb0.x * LOG2E; v[8 * c + 1] = sa[8 * c + 1] - kb0.y * LOG2E; \
            v[8 * c + 2] = sa[8 * c + 2] - kb0.z * LOG2E; v[8 * c + 3] = sa[8 * c + 3] - kb0.w * LOG2E; \
            v[8 * c + 4] = sa[8 * c + 4] - kb1.x * LOG2E; v[8 * c + 5] = sa[8 * c + 5] - kb1.y * LOG2E; \
            v[8 * c + 6] = sa[8 * c + 6] - kb1.z * LOG2E; v[8 * c + 7] = sa[8 * c + 7] - kb1.w * LOG2E; \
          } \
          if (ks0 == q0) { \
_Pragma("unroll") \
            for (int e = 0; e < 16; ++e) if ((e & 7) + 8 * h + 16 * (e >> 3) > r) v[e] = -INFINITY; \
          } \
        } else { \
          const float* tp = tbl + (q0 - ks0) + r + 32 - 8 * h - 23; \
_Pragma("unroll") \
          for (int e = 0; e < 16; ++e) v[e] = sa[e] + tp[23 - ((e & 7) + 16 * (e >> 3))]; \
        } \
        float mx = v[0]; \
_Pragma("unroll") \
        for (int e = 1; e < 16; ++e) mx = fmaxf(mx, v[e]); \
        mx = xhalf_max(mx); \
        if (__ballot(mx > m + 8.f) != 0ull) { \
          const float mn = fmaxf(m, mx); \
          const float alpha = __builtin_amdgcn_exp2f(m - mn); \
          m = mn; \
          l *= alpha; \
_Pragma("unroll") \
          for (int dt = 0; dt < DVB; ++dt) \
_Pragma("unroll") \
            for (int e = 0; e < 16; ++e) o[dt][e] *= alpha; \
        } \
        float ps = 0.f; \
_Pragma("unroll") \
        for (int e = 0; e < 16; ++e) { v[e] = __builtin_amdgcn_exp2f(v[e] - m); ps += v[e]; } \
        l += ps; \
        bf16x8 pb[2]; \
_Pragma("unroll") \
        for (int s = 0; s < 2; ++s) { \
          const u32x4 u = {pack_bf2(v[8 * s + 0], v[8 * s + 1]), pack_bf2(v[8 * s + 2], v[8 * s + 3]), \
                           pack_bf2(v[8 * s + 4], v[8 * s + 5]), pack_bf2(v[8 * s + 6], v[8 * s + 7])}; \
          pb[s] = __builtin_bit_cast(bf16x8, u); \
        } \
_Pragma("unroll") \
        for (int dt = 0; dt < DVB; ++dt) \
_Pragma("unroll") \
          for (int s = 0; s < 2; ++s) { \
            const bf16x8 va = *(const bf16x8*)(st + vro + dt * 4096 + (((4 * sub + 2 * s + h) ^ vsw) << 4)); \
            o[dt] = MFMA32(va, pb[s], o[dt]); \
          } \
      } \
    } \
    __builtin_amdgcn_sched_barrier(0); \
    asm volatile("" ::: "memory"); \
    { \
      char* sn = smem + ((kt + 1) & 1) * STG; \
_Pragma("unroll") \
      for (int i = 0; i < 2; ++i) *(u32x4*)(sn + kwo + i * 8192) = RW[i]; \
_Pragma("unroll") \
      for (int i = 0; i < DVB / 2; ++i) *(u32x4*)(sn + vwo + i * 8192) = RVW[i]; \
    } \
    __syncthreads(); \
  }
  if constexpr (DVB == 4) {
  for (int kt2 = 0; kt2 < nkt; kt2 += 2) {
    ATT_TILE(kt2, rkB, rvB, rk, rv)
    if (kt2 + 1 < nkt) ATT_TILE(kt2 + 1, rk, rv, rkB, rvB)
  }
  } else {
  for (int kt = 0; kt < nkt; ++kt) {
    const int k0 = kt << 6;
    char* st = smem + (kt & 1) * STG;
    {
      const int kn = (kt + 1 < nkt) ? k0 + 64 : k0;
      const size_t kbo = (size_t)kn * (size_t)a.ldk * 2u, vbo = (size_t)kn * 2u;
#pragma unroll
      for (int i = 0; i < 2; ++i) rk[i] = *(const u32x4*)(Kb + (kbo + i * kst) + kvo);
#pragma unroll
      for (int i = 0; i < DVB / 2; ++i) rv[i] = *(const u32x4*)(Vb + (vbo + i * vst) + vvo);
    }
    asm volatile("" ::: "memory");
    __builtin_amdgcn_sched_barrier(0);
#pragma unroll
    for (int sub = 0; sub < 2; ++sub) {
      const int ks0 = k0 + 32 * sub;
      if (ks0 <= q0) {
        f32x16 sa;
#pragma unroll
        for (int e = 0; e < 16; ++e) sa[e] = 0.f;
#pragma unroll
        for (int s = 0; s < 8; ++s) {
          const bf16x8 kf = *(const bf16x8*)(st + kro + sub * 8192 + (((2 * s + h) ^ ksw) << 4));
          sa = MFMA32(kf, qf[s], sa);
        }
        float v[16];
        if (MODE == 0) {
#pragma unroll
          for (int c = 0; c < 2; ++c) {
            const float4 kb0 = *(const float4*)(a.kbias + ks0 + 16 * c + 8 * h);
            const float4 kb1 = *(const float4*)(a.kbias + ks0 + 16 * c + 8 * h + 4);
            v[8 * c + 0] = sa[8 * c + 0] - kb0.x * LOG2E; v[8 * c + 1] = sa[8 * c + 1] - kb0.y * LOG2E;
            v[8 * c + 2] = sa[8 * c + 2] - kb0.z * LOG2E; v[8 * c + 3] = sa[8 * c + 3] - kb0.w * LOG2E;
            v[8 * c + 4] = sa[8 * c + 4] - kb1.x * LOG2E; v[8 * c + 5] = sa[8 * c + 5] - kb1.y * LOG2E;
            v[8 * c + 6] = sa[8 * c + 6] - kb1.z * LOG2E; v[8 * c + 7] = sa[8 * c + 7] - kb1.w * LOG2E;
          }
          if (ks0 == q0) {
#pragma unroll
            for (int e = 0; e < 16; ++e) if ((e & 7) + 8 * h + 16 * (e >> 3) > r) v[e] = -INFINITY;
          }
        } else {
          const float* tp = tbl + (q0 - ks0) + r + 32 - 8 * h - 23;
#pragma unroll
          for (int e = 0; e < 16; ++e) v[e] = sa[e] + tp[23 - ((e & 7) + 16 * (e >> 3))];
        }
        float mx = v[0];
#pragma unroll
        for (int e = 1; e < 16; ++e) mx = fmaxf(mx, v[e]);
        mx = xhalf_max(mx);
        if (__ballot(mx > m + 8.f) != 0ull) {
          const float mn = fmaxf(m, mx);
          const float alpha = __builtin_amdgcn_exp2f(m - mn);
          m = mn;
          l *= alpha;
#pragma unroll
          for (int dt = 0; dt < DVB; ++dt)
#pragma unroll
            for (int e = 0; e < 16; ++e) o[dt][e] *= alpha;
        }
        float ps = 0.f;
#pragma unroll
        for (int e = 0; e < 16; ++e) { v[e] = __builtin_amdgcn_exp2f(v[e] - m); ps += v[e]; }
        l += ps;
        bf16x8 pb[2];
#pragma unroll
        for (int s = 0; s < 2; ++s) {
          const u32x4 u = {pack_bf2(v[8 * s + 0], v[8 * s + 1]), pack_bf2(v[8 * s + 2], v[8 * s + 3]),
                           pack_bf2(v[8 * s + 4], v[8 * s + 5]), pack_bf2(v[8 * s + 6], v[8 * s + 7])};
          pb[s] = __builtin_bit_cast(bf16x8, u);
        }
#pragma unroll
        for (int dt = 0; dt < DVB; ++dt)
#pragma unroll
          for (int s = 0; s < 2; ++s) {
            const bf16x8 va = *(const bf16x8*)(st + vro + dt * 4096 + (((4 * sub + 2 * s + h) ^ vsw) << 4));
            o[dt] = MFMA32(va, pb[s], o[dt]);
          }
      }
    }
    __builtin_amdgcn_sched_barrier(0);
    asm volatile("" ::: "memory");
    {
      char* sn = smem + ((kt + 1) & 1) * STG;
#pragma unroll
      for (int i = 0; i < 2; ++i) *(u32x4*)(sn + kwo + i * 8192) = rk[i];
#pragma unroll
      for (int i = 0; i < DVB / 2; ++i) *(u32x4*)(sn + vwo + i * 8192) = rv[i];
    }
    __syncthreads();
  }
  }
#undef ATT_TILE
  l_out = xhalf_sum(l);
}

template <int N = 4, int B0 = 0>
DI void attn_store_bf16(const f32x16 (&o)[N], float linv, bf16_t* out_row  , int ldo) {
  const int lane = TID() & 63, r = lane & 31, h = lane >> 5;
  bf16_t* op = out_row + (size_t)r * ldo + 4 * h;
#pragma unroll
  for (int dt = 0; dt < 4; ++dt)
#pragma unroll
    for (int c = 0; c < 4; ++c)
      *(uint2*)(op + 32 * dt + 8 * c) = make_uint2(pack_bf2(o[B0 + dt][4 * c] * linv, o[B0 + dt][4 * c + 1] * linv),
                                                    pack_bf2(o[B0 + dt][4 * c + 2] * linv, o[B0 + dt][4 * c + 3] * linv));
}
template <int N, int B0>
DI void attn_store_f32(const f32x16 (&o)[N], float linv, float* out_row, int ldo) {
  const int lane = TID() & 63, r = lane & 31, h = lane >> 5;
  float* op = out_row + (size_t)r * ldo + 4 * h;
#pragma unroll
  for (int dt = 0; dt < 4; ++dt)
#pragma unroll
    for (int c = 0; c < 4; ++c)
      *(float4*)(op + 32 * dt + 8 * c) = make_float4(o[B0 + dt][4 * c] * linv, o[B0 + dt][4 * c + 1] * linv, o[B0 + dt][4 * c + 2] * linv, o[B0 + dt][4 * c + 3] * linv);
}

DI int t5_bucket(int n) {
  if (n < 16) return n;
  int lg = 16 + (int)(logf((float)n / 16.f) / 4.852030263919617f * 16.f);
  return lg < 31 ? lg : 31;
}

DI void phase_attn_even(const Params& p, char* smem) {
  const int tid = RTID(), wave = __builtin_amdgcn_readfirstlane(tid >> 6), bid = blockIdx.x, G = gridDim.x;
  const bf16_t* QK = (const bf16_t*)(p.ws + WS_QK);
  const bf16_t* VT = (const bf16_t*)(p.ws + WS_VT);
  bf16_t* ATT = (bf16_t*)(p.ws + WS_ATT);
  bf16_t* PCS = (bf16_t*)(p.ws + WS_SC);
  float* tbl = (float*)(smem + 98304);
  int cur_head = -1;
  for (int rnd = 0; rnd * G < 1024; ++rnd) {
    int item = rnd * G + ((rnd & 1) ? G - 1 - bid : bid);
    if (G == 256) {
      const int rc = rnd * 4 + (bid >> 6);
      const int gq = (int)((0x6767455432231010ull >> (4 * rc)) & 15ull), dq = (0x3CC3 >> rc) & 1;
      item = gq * 128 + (dq ? 0 : 64) + (bid & 63);
    }
    if (item >= 1024) break;
    const int g = item >> 7; int rem = item & 127;
    const int qb = 7 - g;
    const int q0b = qb * 256, q0 = q0b + 32 * wave;
    __syncthreads();
    if (rem >= 64) {
      rem -= 64;
      const int b = rem >> 3, hh = rem & 7;
      AttnPtrs a;
      a.Q = QK + (size_t)b * S_ * 4096 + hh * 128; a.ldq = 4096;
      a.K = a.Q + 1024; a.ldk = 4096;
      a.Vt = VT + (size_t)(hh * 128) * T_ + b * S_; a.ldv = T_;
      a.kbias = (const float*)(p.ws + WS_FCUM) + (size_t)(b * 8 + hh) * S_;
      f32x16 o[4]; float l;
      attn_block<0, 4>(a, q0b, smem, nullptr, o, l);
      attn_store_bf16(o, 1.f / l, ATT + (size_t)(b * S_ + q0) * D_ + hh * 128, D_);
    } else {
      const int b = rem >> 3, hh = (rem >> 1) & 3, mm = rem & 1;
      if (hh != cur_head) {
        for (int e = tid; e < 2080; e += RTHREADS) {
          const int dist = e - 32;
          tbl[e] = dist >= 0 ? p.rel_bias[t5_bucket(dist) * 16 + hh] * LOG2E : -INFINITY;
        }
        cur_head = hh;
      }
      AttnPtrs a;
      a.Q = QK + (size_t)b * S_ * 4096 + 2048 + hh * 256 + mm * 128; a.ldq = 4096;
      a.K = a.Q + 1024; a.ldk = 4096;
      a.Vt = VT + (size_t)(1024 + hh * 256) * T_ + b * S_; a.ldv = T_;
      a.kbias = nullptr;
      f32x16 o[8]; float l;
      attn_block<1, 8>(a, q0b, smem, tbl, o, l);
      const float linv = 1.f / l;
      attn_store_bf16<8, 0>(o, linv, PCS + (((size_t)(mm * 2 + 0) * T_ + (size_t)(b * S_ + q0)) * 4 + hh) * 128, 512);
      attn_store_bf16<8, 4>(o, linv, PCS + (((size_t)(mm * 2 + 1) * T_ + (size_t)(b * S_ + q0)) * 4 + hh) * 128, 512);
    }
  }
}

DI void phase_diff_combine(const Params& p) {
  const int lane = TID() & 63;
  const int gw = __builtin_amdgcn_readfirstlane((VBID() * NTHREADS + TID()) >> 6), nw = (VGRID() * NTHREADS) >> 6;
  const bf16_t* PCS = (const bf16_t*)(p.ws + WS_SC);
  bf16_t* ATT = (bf16_t*)(p.ws + WS_ATT);
  const float lam = ((const float*)(p.ws + WS_MISC))[0];
  const int half = lane >> 5, dl = (lane & 31) * 4;
  const float4 sg = *(const float4*)(p.even_diff_subln_gain + lane * 4);
  for (int it = gw; it < T_ * 4; it += nw) {
    const uint2 a0 = *(const uint2*)(PCS + ((size_t)(0 + half) * T_ * 4 + it) * 128 + dl);
    const uint2 a1 = *(const uint2*)(PCS + ((size_t)(2 + half) * T_ * 4 + it) * 128 + dl);
    float4 v;
    v.x = bf_lo(a0.x) - lam * bf_lo(a1.x); v.y = bf_hi(a0.x) - lam * bf_hi(a1.x); v.z = bf_lo(a0.y) - lam * bf_lo(a1.y); v.w = bf_hi(a0.y) - lam * bf_hi(a1.y);
    const float ss = wave_sum(v.x * v.x + v.y * v.y + v.z * v.z + v.w * v.w);
    const float rstd = rsqrtf(ss * (1.f / 256.f) + 1e-6f) * 0.8f;
    const int t = it >> 2, hh = it & 3;
    *(uint2*)(ATT + (size_t)t * D_ + 1024 + hh * 256 + lane * 4) =
        make_uint2(pack_bf2(v.x * rstd * sg.x, v.y * rstd * sg.y), pack_bf2(v.z * rstd * sg.z, v.w * rstd * sg.w));
  }
}

DI void phase_attn_odd(const Params& p, char* smem) {
  const int tid = RTID(), wave = __builtin_amdgcn_readfirstlane(tid >> 6), bid = blockIdx.x, G = gridDim.x;
  const bf16_t* QK = (const bf16_t*)(p.ws + WS_QK);
  const bf16_t* VT = (const bf16_t*)(p.ws + WS_VT);
  bf16_t* ATT = (bf16_t*)(p.ws + WS_ATT);
  float* tbl = (float*)(smem + 98304);
  int cur_head = -1;
  for (int rnd = 0; rnd * G < 1024; ++rnd) {
    const int item = rnd * G + ((rnd & 1) ? G - 1 - bid : bid);
    if (item >= 1024) break;
    const int g = item >> 7, rem = item & 127;
    const int qb = 7 - g, b = rem >> 4, hd = rem & 15;
    __syncthreads();
    if (hd != cur_head) {
      for (int e = tid; e < 2080; e += RTHREADS) {
        const int dist = e - 32;
        float val = -INFINITY;
        if (dist >= 0) {
          int cnt = 0;
          if (dist <= 128) cnt += 1;
          if (dist <= 512 && (dist & 3) == 0) cnt += 1;
          if ((dist & 15) == 0) cnt += 1;
          if (cnt > 0) val = (p.rel_bias[t5_bucket(dist) * 16 + hd] + __logf((float)cnt)) * LOG2E;
        }
        tbl[e] = val;
      }
      cur_head = hd;
    }
    const int q0b = qb * 256, q0 = q0b + 32 * wave;
    AttnPtrs a;
    a.Q = QK + (size_t)b * S_ * 4096 + hd * 128; a.ldq = 4096;
    a.K = a.Q + 2048; a.ldk = 4096;
    a.Vt = VT + (size_t)(hd * 128) * T_ + b * S_; a.ldv = T_;
    a.kbias = nullptr;
    f32x16 o[4]; float l;
    attn_block<1, 4>(a, q0b, smem, tbl, o, l);
    attn_store_bf16(o, 1.f / l, ATT + (size_t)(b * S_ + q0) * D_ + hd * 128, D_);
  }
}

DI float gelu_erf(float x) { return 0.5f * x * (1.f + erff(x * 0.7071067811865476f)); }

DI void ins16(float (&L)[16], float x) {
#pragma unroll
  for (int k = 15; k >= 1; --k) L[k] = __builtin_amdgcn_fmed3f(L[k - 1], L[k], x);
  L[0] = __builtin_amdgcn_fmed3f(__builtin_inff(), L[0], x);
}
DI float f_and_or(float v, unsigned mask, unsigned orv) { return __uint_as_float((__float_as_uint(v) & mask) | orv); }

DI void phase_peer_retrieve(const Params& p, char* smem) {
  const int tid = TID(), lane = tid & 63, wave = __builtin_amdgcn_readfirstlane(tid >> 6);
  const int gw = __builtin_amdgcn_readfirstlane((VBID() * NTHREADS + tid) >> 6), nw = (VGRID() * NTHREADS) >> 6;
  unsigned* wbuf = (unsigned*)(smem + wave * 9216);
  const bf16_t* SC = (const bf16_t*)(p.ws + WS_SC);
  int* IDX = (int*)(p.ws + WS_IDX);
  float* GATE = (float*)(p.ws + WS_GATE);
  const float NINF = -__builtin_inff();
  for (int it = gw; it < T_ / 8; it += nw) {
    const bf16_t* gsrc = SC + (size_t)it * (8 * 2048) + (lane >> 2) * 256 + (lane & 3) * 8;
    unsigned* wdst = wbuf + (lane >> 2) * 20 + (lane & 3) * 4;
    const unsigned* wsrc = wbuf + lane * 20;
    u32x4 stg[4];
#define PR_LOAD(CH) _Pragma("unroll") for (int i = 0; i < 4; ++i) stg[i] = *(const u32x4*)(gsrc + i * (16 * 256) + ((CH) >> 2) * 128 + ((CH) & 3) * 32);
    PR_LOAD(0)
    float A[16], B[16];
#pragma unroll
    for (int hf = 0; hf < 2; ++hf) {
      float L[16];
#pragma unroll
      for (int k = 0; k < 16; ++k) L[k] = NINF;
#pragma unroll 1
      for (int c = 0; c < 4; ++c) {
#pragma unroll
        for (int i = 0; i < 4; ++i) *(u32x4*)(wdst + i * (16 * 20)) = stg[i];
        { const int cn = hf * 4 + c + 1 < 7 ? hf * 4 + c + 1 : 7; PR_LOAD(cn) }
        u32x4 v[4];
#pragma unroll
        for (int k = 0; k < 4; ++k) v[k] = *(const u32x4*)(wsrc + 4 * k);
#pragma unroll
        for (int k = 0; k < 4; ++k)
#pragma unroll
          for (int e = 0; e < 4; ++e) {
            const unsigned w = v[k][e], id0 = (unsigned)(c * 32 + 8 * k + 2 * e);
            ins16(L, __uint_as_float((w << 16) | id0));
            ins16(L, __uint_as_float((w & 0xFFFF0000u) | (id0 + 1u)));
          }
      }
#pragma unroll
      for (int k = 0; k < 16; ++k) { if (hf == 0) A[k] = L[k]; else B[k] = L[k]; }
    }
#undef PR_LOAD
    unsigned* lut = wbuf + lane * 33;
#pragma unroll
    for (int k = 0; k < 16; ++k) {
      const unsigned ua = __float_as_uint(A[k]), ub = __float_as_uint(B[k]);
      lut[k] = (ua & 0x7Fu) << 7; lut[16 + k] = ub & 0x7Fu;
      A[k] = __uint_as_float(ua & 0xFFFFFF80u); B[k] = __uint_as_float(ub & 0xFFFFFF80u);
    }
    float C[16];
#pragma unroll
    for (int k = 0; k < 16; ++k) C[k] = NINF;
#pragma unroll
    for (int i = 0; i < 16; ++i)
#pragma unroll
      for (int j = 0; j < 16; ++j)
        if ((i + 1) * (j + 1) <= 16) ins16(C, f_and_or(A[i] + B[j], 0xFFFFFF00u, (unsigned)(i * 16 + j)));
    float ev[16], es = 0.f;
    int ids[16];
    const float mx = __uint_as_float(__float_as_uint(C[0]) & 0xFFFFFF00u);
#pragma unroll
    for (int k = 0; k < 16; ++k) {
      const unsigned uc = __float_as_uint(C[k]);
      ev[k] = __expf(__uint_as_float(uc & 0xFFFFFF00u) - mx);
      es += ev[k];
      ids[k] = (int)(lut[(uc >> 4) & 15u] + lut[16 + (uc & 15u)]);
    }
    const float inv = 1.f / es;
    int* ip = IDX + (size_t)it * (8 * 128) + lane * 16;
    float* gp = GATE + (size_t)it * (8 * 128) + lane * 16;
#pragma unroll
    for (int q = 0; q < 4; ++q) {
      *(int4*)(ip + 4 * q) = make_int4(ids[4 * q], ids[4 * q + 1], ids[4 * q + 2], ids[4 * q + 3]);
      *(float4*)(gp + 4 * q) = make_float4(ev[4 * q] * inv, ev[4 * q + 1] * inv, ev[4 * q + 2] * inv, ev[4 * q + 3] * inv);
    }
  }
}

DI unsigned peer_ticket_issue(unsigned* cnt) {
  unsigned v = 0;
  if ((TID() & 63) == 0) v = __hip_atomic_fetch_add(cnt, 1u, __ATOMIC_RELAXED, __HIP_MEMORY_SCOPE_AGENT);
  return v;
}
DI float oct_sum(float v) {
  v += __builtin_bit_cast(float, __builtin_amdgcn_update_dpp(0, __builtin_bit_cast(int, v), 0xB1, 0xF, 0xF, true));
  v += __builtin_bit_cast(float, __builtin_amdgcn_update_dpp(0, __builtin_bit_cast(int, v), 0x4E, 0xF, 0xF, true));
  v += __builtin_bit_cast(float, __builtin_amdgcn_update_dpp(0, __builtin_bit_cast(int, v), 0x141, 0xF, 0xF, true));
  return v;
}

DI unsigned swar_add8(unsigned x) { return ((x & 0x7F7F7F7Fu) + 0x08080808u) ^ (x & 0x80808080u); }
DI void phase_peer_dots(const Params& p, int layer, char* smem_all) {
  const int rtid = RTID(), lane = rtid & 63, rwave = __builtin_amdgcn_readfirstlane(rtid >> 6);
  const int g = lane >> 3, j = lane & 7;
  int* lidx_all = (int*)(smem_all + rwave * 8192);
  const unsigned char* H8 = (const unsigned char*)(p.ws + WS_H8);
  const int* IDX = (const int*)(p.ws + WS_IDX);
  float* PD = (float*)(p.ws + WS_PD);
  const unsigned char* PU = (const unsigned char*)(p.ws + WS_PEERU) + (size_t)layer * (8 * NEXP * 128);
  const float* SC4 = (const float*)(p.ws + WS_USC4) + (size_t)layer * (8 * NEXP);
  unsigned* tick = (unsigned*)(p.ws + WS_TICKETS) + (size_t)(layer * 2 + 0) * 16 * 16;
  const int xcc = xcc_id() & 7;
#pragma unroll 1
  for (int so = 0; so < 8; ++so) {
    const int s = (xcc + so) & 7;
    unsigned tv = peer_ticket_issue(tick + s * 16);
    for (;;) {
      const int c = __builtin_amdgcn_readfirstlane((int)tv);
      if (c >= T_ / 16) break;
      tv = peer_ticket_issue(tick + s * 16);
#pragma unroll
      for (int gi = 0; gi < 2; ++gi) {
        const int* ip = IDX + (size_t)(c * 16 + gi * 8 + g) * 128 + 16 * j;
#pragma unroll
        for (int i = 0; i < 4; ++i) *(uint4*)(lidx_all + gi * 1024 + g * 128 + 16 * j + 4 * i) = *(const uint4*)(ip + 4 * i);
      }
#pragma unroll 1
      for (int gi = 0; gi < 2; ++gi) {
      const int t0 = c * 16 + gi * 8;
      const int* lidx = lidx_all + gi * 1024;
      unsigned xl[4], xh[4];
      {
        const unsigned char* hp = H8 + (size_t)(t0 + g) * D_ + s * 256 + 32 * j;
        const u32x4 h0 = *(const u32x4*)hp, h1 = *(const u32x4*)(hp + 16);
        const unsigned d[8] = {h0.x, h0.y, h0.z, h0.w, h1.x, h1.y, h1.z, h1.w};
#pragma unroll
        for (int m = 0; m < 4; ++m) {
          xl[m] = (d[2 * m] & 0x0F0F0F0Fu) | ((d[2 * m + 1] & 0x0F0F0F0Fu) << 4);
          xh[m] = ((swar_add8(d[2 * m]) >> 4) & 0x0F0F0F0Fu) | (swar_add8(d[2 * m + 1]) & 0xF0F0F0F0u);
        }
      }
      const unsigned char* ub = PU + (size_t)s * (NEXP * 128);
      const float* scs = SC4 + (size_t)s * NEXP;
      float* pd = PD + ((size_t)s * T_ + t0 + g) * 128;
      const bool b2_ = (lane & 4) != 0, b1_ = (lane & 2) != 0, b0_ = (lane & 1) != 0;
      u32x4 ra[8], rb[8], rc[8];
      float sa, sb, sc;
#define PD_LOAD(R, S, KB) { _Pragma("unroll") for (int q = 0; q < 8; ++q) { const int id = lidx[g * 128 + (KB) + q]; R[q] = *(const u32x4*)(ub + (unsigned)(id * 128 + 16 * j)); } \
                            S = scs[lidx[g * 128 + (KB) + j]]; }
#define DPPI(X, CTRL) __builtin_amdgcn_update_dpp(0, (X), (CTRL), 0xF, 0xF, true)
#define PD_COMP(R, S, KB)                                                                         \
      {                                                                                           \
        int pp[8];                                                                                \
        _Pragma("unroll") for (int q = 0; q < 8; ++q) {                                           \
          int al = __builtin_amdgcn_sdot8((int)R[q].x, (int)xl[0], 0, false);                     \
          int ah = __builtin_amdgcn_sdot8((int)R[q].x, (int)xh[0], 0, false);                     \
          al = __builtin_amdgcn_sdot8((int)R[q].y, (int)xl[1], al, false);                        \
          ah = __builtin_amdgcn_sdot8((int)R[q].y, (int)xh[1], ah, false);                        \
          al = __builtin_amdgcn_sdot8((int)R[q].z, (int)xl[2], al, false);                        \
          ah = __builtin_amdgcn_sdot8((int)R[q].z, (int)xh[2], ah, false);                        \
          al = __builtin_amdgcn_sdot8((int)R[q].w, (int)xl[3], al, false);                        \
          ah = __builtin_amdgcn_sdot8((int)R[q].w, (int)xh[3], ah, false);                        \
          pp[q] = al + 16 * ah;                                                                   \
        }                                                                                         \
          \
        int q4[4], q2[2];                                                                         \
        _Pragma("unroll") for (int i = 0; i < 4; ++i) {                                           \
          const int keep = b2_ ? pp[4 + i] : pp[i], send = b2_ ? pp[i] : pp[4 + i];               \
          q4[i] = keep + DPPI(send, 0x141);                   \
        }                                                                                         \
        _Pragma("unroll") for (int i = 0; i < 2; ++i) {                                           \
          const int keep = b1_ ? q4[2 + i] : q4[i], send = b1_ ? q4[i] : q4[2 + i];               \
          q2[i] = keep + DPPI(send, 0x4E);                      \
        }                                                                                         \
        {                                                                                         \
          const int keep = b0_ ? q2[1] : q2[0], send = b0_ ? q2[0] : q2[1];                       \
          pd[(KB) + j] = (float)(keep + DPPI(send, 0xB1)) * S;     \
        }                                                                                         \
        __builtin_amdgcn_sched_barrier(0);                                                        \
      }
      PD_LOAD(ra, sa, 0)
      PD_LOAD(rb, sb, 8)
#pragma unroll 1
      for (int kb = 0; kb < 120; kb += 24) {
        PD_LOAD(rc, sc, kb + 16)
        PD_COMP(ra, sa, kb)
        PD_LOAD(ra, sa, kb + 24)
        PD_COMP(rb, sb, kb + 8)
        { const int kl = kb + 32 < 120 ? kb + 32 : 120; PD_LOAD(rb, sb, kl) }
        PD_COMP(rc, sc, kb + 16)
      }
      PD_COMP(ra, sa, 120)
#undef PD_LOAD
#undef PD_COMP
#undef DPPI
      }
    }
  }
}

DI void phase_peer_act(const Params& p, int layer) {
  const int rtid = RTID(), lane = rtid & 63;
  const int gw = __builtin_amdgcn_readfirstlane((int)((blockIdx.x * RTHREADS + rtid) >> 6)), nw = (int)(gridDim.x * RTHREADS) >> 6;
  const float* PD = (const float*)(p.ws + WS_PD);
  const int* IDX = (const int*)(p.ws + WS_IDX);
  const float* GATE = (const float*)(p.ws + WS_GATE);
  const float* HS = (const float*)(p.ws + WS_HS);
  unsigned short* ACTQ = (unsigned short*)(p.ws + WS_ACT);
  float* ACTS = (float*)(p.ws + WS_ACT + 4 * MiB);
  const float* VSC = (const float*)(p.ws + WS_PEERV) + (size_t)(2 + layer) * NEXP;
  for (int t = gw; t < T_; t += nw) {
    const size_t e = (size_t)t * 128 + 2 * lane;
    float2 a = make_float2(0.f, 0.f);
#pragma unroll
    for (int s2 = 0; s2 < 8; ++s2) { const float2 q = *(const float2*)(PD + (size_t)s2 * T_ * 128 + e); a.x += q.x; a.y += q.y; }
    const int2 id = *(const int2*)(IDX + e);
    const float2 gt = *(const float2*)(GATE + e);
    const float hs = HS[t];
    const float v0 = gt.x * gelu_erf(a.x * hs) * VSC[id.x], v1 = gt.y * gelu_erf(a.y * hs) * VSC[id.y];
    const float am = wave_max(fmaxf(fabsf(v0), fabsf(v1)));
    const float qs = am > 0.f ? 127.f / am : 1.f;
    const int q0 = (int)rintf(v0 * qs), q1 = (int)rintf(v1 * qs);
    ACTQ[(size_t)t * 64 + lane] = (unsigned short)((q0 & 255) | ((q1 & 255) << 8));
    if (lane == 0) ACTS[t] = am > 0.f ? am / 127.f : 1.f;
  }
}

DI void phase_peer_values(const Params& p, int layer, const float* gate2, char* smem_all) {
  const int rtid = RTID(), lane = rtid & 63, rwave = __builtin_amdgcn_readfirstlane(rtid >> 6);
  const int g = lane >> 3, j = lane & 7;
  int* lidx_all = (int*)(smem_all + rwave * 16384);
  unsigned* lact_all = (unsigned*)(smem_all + rwave * 16384 + 4096);
  const int* IDX = (const int*)(p.ws + WS_IDX);
  const unsigned* ACTQ = (const unsigned*)(p.ws + WS_ACT);
  const float* ACTS = (const float*)(p.ws + WS_ACT + 4 * MiB);
  const unsigned char* PV = (const unsigned char*)(p.ws + WS_PEERV8) + (size_t)layer * NEXP * D_;
  unsigned* tick = (unsigned*)(p.ws + WS_TICKETS) + (size_t)(layer * 2 + 1) * 16 * 16;
  const int xcc = xcc_id() & 7;
#pragma unroll 1
  for (int so = 0; so < 16; ++so) {
    const int s = ((xcc + (so >> 1)) & 7) + 8 * (so & 1);
    unsigned tv = peer_ticket_issue(tick + s * 16);
    for (;;) {
      const int c = __builtin_amdgcn_readfirstlane((int)tv);
      if (c >= T_ / 16) break;
      tv = peer_ticket_issue(tick + s * 16);
#pragma unroll
      for (int gi = 0; gi < 2; ++gi) {
        const int* ip = IDX + (size_t)(c * 16 + gi * 8 + g) * 128 + 16 * j;
#pragma unroll
        for (int i = 0; i < 4; ++i) *(uint4*)(lidx_all + gi * 2048 + g * 128 + 16 * j + 4 * i) = *(const uint4*)(ip + 4 * i);
        *(uint4*)(lact_all + gi * 2048 + g * 32 + 4 * j) = *(const uint4*)(ACTQ + (size_t)(c * 16 + gi * 8 + g) * 32 + 4 * j);
      }
#pragma unroll 1
      for (int gi = 0; gi < 2; ++gi) {
      const int t0 = c * 16 + gi * 8;
      const int* lidx = lidx_all + gi * 2048;
      const unsigned* lact = lact_all + gi * 2048;
      const unsigned char* vb = PV + (size_t)s * (NEXP * 128);
      int y[16];
#pragma unroll
      for (int i = 0; i < 16; ++i) y[i] = 0;
      u32x4 ra[8], rb[8];
      const int tq = t0 + g;
      float* orow = p.out + (size_t)tq * D_ + s * 128 + 16 * j;
      const float* grow = gate2 + (size_t)(tq >> 11) * 12288 + s * 128 + 16 * j;
      u32x4 ia0 = *(const u32x4*)(lidx + g * 128), ia1 = *(const u32x4*)(lidx + g * 128 + 4);
#define PV_LOAD(R, KBN) { const unsigned ids_[8] = {ia0.x, ia0.y, ia0.z, ia0.w, ia1.x, ia1.y, ia1.z, ia1.w};                         \
        _Pragma("unroll") for (int q = 0; q < 8; ++q) R[q] = *(const u32x4*)(vb + (ids_[q] * 128u + 16u * (unsigned)j));              \
        ia0 = *(const u32x4*)(lidx + g * 128 + (KBN)); ia1 = *(const u32x4*)(lidx + g * 128 + (KBN) + 4); }
#define PV_QUAD(W0, W1, W2, W3, AQ, YB) {                                                                                             \
        const unsigned t0_ = __builtin_amdgcn_perm((W1), (W0), 0x05010400u), t1_ = __builtin_amdgcn_perm((W1), (W0), 0x07030602u);    \
        const unsigned t2_ = __builtin_amdgcn_perm((W3), (W2), 0x05010400u), t3_ = __builtin_amdgcn_perm((W3), (W2), 0x07030602u);    \
        y[(YB) + 0] = __builtin_amdgcn_sdot4((int)__builtin_amdgcn_perm(t2_, t0_, 0x05040100u), (int)(AQ), y[(YB) + 0], false);       \
        y[(YB) + 1] = __builtin_amdgcn_sdot4((int)__builtin_amdgcn_perm(t2_, t0_, 0x07060302u), (int)(AQ), y[(YB) + 1], false);       \
        y[(YB) + 2] = __builtin_amdgcn_sdot4((int)__builtin_amdgcn_perm(t3_, t1_, 0x05040100u), (int)(AQ), y[(YB) + 2], false);       \
        y[(YB) + 3] = __builtin_amdgcn_sdot4((int)__builtin_amdgcn_perm(t3_, t1_, 0x07060302u), (int)(AQ), y[(YB) + 3], false); }
#define PV_COMP(R, KB)                                                                            \
      { const unsigned aq0 = lact[g * 32 + ((KB) >> 2)], aq1 = lact[g * 32 + ((KB) >> 2) + 1];    \
        PV_QUAD(R[0].x, R[1].x, R[2].x, R[3].x, aq0, 0)  PV_QUAD(R[0].y, R[1].y, R[2].y, R[3].y, aq0, 4)   \
        PV_QUAD(R[0].z, R[1].z, R[2].z, R[3].z, aq0, 8)  PV_QUAD(R[0].w, R[1].w, R[2].w, R[3].w, aq0, 12)  \
        __builtin_amdgcn_sched_barrier(0);                                                        \
        PV_QUAD(R[4].x, R[5].x, R[6].x, R[7].x, aq1, 0)  PV_QUAD(R[4].y, R[5].y, R[6].y, R[7].y, aq1, 4)   \
        PV_QUAD(R[4].z, R[5].z, R[6].z, R[7].z, aq1, 8)  PV_QUAD(R[4].w, R[5].w, R[6].w, R[7].w, aq1, 12)  \
        __builtin_amdgcn_sched_barrier(0); }
      PV_LOAD(ra, 8)
#pragma unroll 1
      for (int kb = 0; kb < 128; kb += 16) {
        { const int kn = kb + 16 < 120 ? kb + 16 : 120; PV_LOAD(rb, kn) }
        PV_COMP(ra, kb)
        { const int kn = kb + 24 < 120 ? kb + 24 : 120; PV_LOAD(ra, kn) }
        PV_COMP(rb, kb + 8)
      }
#undef PV_LOAD
#undef PV_COMP
#undef PV_QUAD
      const float as = ACTS[tq];
#pragma unroll
      for (int i = 0; i < 4; ++i) {
        float4 a0 = *(const float4*)(orow + 4 * i);
        float4 g0 = *(const float4*)(grow + 4 * i);
        g0.x *= as; g0.y *= as; g0.z *= as; g0.w *= as;
        a0.x += g0.x * (float)y[4 * i]; a0.y += g0.y * (float)y[4 * i + 1]; a0.z += g0.z * (float)y[4 * i + 2]; a0.w += g0.w * (float)y[4 * i + 3];
        *(float4*)(orow + 4 * i) = a0;
      }
      }
    }
  }
}

#define XB_TMO      128
#define XB_XCNT(j)  (256  + 64 * (j))
#define XB_XSUB(j)  (1280 + 64 * (j))
#define XB_XGEN(j)  (2304 + 64 * (j))
#define XB_TOP      3328
#define XB_TOPGEN   3392
#define XCD_BAR_WORDS 3456
#define XB_SPIN_CAP (1u << 22)
#define LAS __attribute__((address_space(3)))
DI unsigned xb_ld(unsigned* p) { return __hip_atomic_load(p, __ATOMIC_RELAXED, __HIP_MEMORY_SCOPE_AGENT); }
DI unsigned xb_add(unsigned* p, unsigned v) { return __hip_atomic_fetch_add(p, v, __ATOMIC_RELAXED, __HIP_MEMORY_SCOPE_AGENT); }
DI unsigned xb_xcc_id() { return (unsigned)__builtin_amdgcn_s_getreg((3 << 11) | 20) & 0xFu; }
#define XB_SPIN(cond, bar) do { unsigned _sp = 0; while (cond) { __builtin_amdgcn_s_sleep(1); \
    if ((++_sp & 255u) == 0u) { if (xb_ld(&(bar)[XB_TMO])) break; if (_sp > XB_SPIN_CAP) { atomicAdd(&(bar)[XB_TMO], 1u); break; } } } } while (0)
struct XcdBarrier { unsigned* bar; unsigned x; volatile LAS unsigned* st; };
DI XcdBarrier xcd_barrier_post(unsigned* bar, volatile LAS unsigned* st) {
  XcdBarrier b; b.bar = bar; b.x = xb_xcc_id(); b.st = st;
  if (threadIdx.x == 0) (void)xb_add(&bar[XB_XCNT(b.x)], 1u);
  return b;
}
DI void xcd_barrier_complete(unsigned* bar, unsigned x, unsigned& nloc, unsigned& nx) {
  const unsigned G = gridDim.x * gridDim.y * gridDim.z;
  unsigned sum, cnt, mine, sp = 0u;
  for (;;) {
    sum = 0u; cnt = 0u; mine = 0u;
#pragma unroll
    for (unsigned j = 0; j < 16; ++j) { const unsigned c = xb_ld(&bar[XB_XCNT(j)]); sum += c; cnt += (c > 0u) ? 1u : 0u; mine = (j == x) ? c : mine; }
    if (sum == G) break;
    __builtin_amdgcn_s_sleep(1);
    if ((++sp & 255u) == 0u) { if (xb_ld(&bar[XB_TMO])) break; if (sp > XB_SPIN_CAP) { atomicAdd(&bar[XB_TMO], 1u); break; } }
  }
  nloc = mine > 0u ? mine : 1u; nx = cnt > 0u ? cnt : 1u;
}
DI void xcd_barrier(const XcdBarrier& b) {
  asm volatile("s_waitcnt vmcnt(0)" ::: "memory");
  __syncthreads();
  if (threadIdx.x == 0) {
    unsigned* bar = b.bar;
    __builtin_amdgcn_s_waitcnt(0);
    unsigned nloc = b.st[0], nx = b.st[1];
    if (nloc == 0u) { xcd_barrier_complete(bar, b.x, nloc, nx); b.st[0] = nloc; b.st[1] = nx; }
    const unsigned old = xb_add(&bar[XB_XSUB(b.x)], 1u);
    const unsigned gen = old / nloc;
    if (old + 1u == (gen + 1u) * nloc) {
      __builtin_amdgcn_fence(__ATOMIC_RELEASE, "agent");
      asm volatile("s_waitcnt vmcnt(0)" ::: "memory");
      const unsigned og = xb_add(&bar[XB_TOP], 1u);
      const unsigned tg = og / nx;
      if (og + 1u == (tg + 1u) * nx) xb_add(&bar[XB_TOPGEN], 1u);
      else XB_SPIN(xb_ld(&bar[XB_TOPGEN]) == tg, bar);
      __builtin_amdgcn_fence(__ATOMIC_ACQUIRE, "agent");
      xb_add(&bar[XB_XGEN(b.x)], 1u);
      asm volatile("s_waitcnt vmcnt(0)" ::: "memory");
    } else {
      XB_SPIN(xb_ld(&bar[XB_XGEN(b.x)]) == gen, bar);
      __builtin_amdgcn_fence(__ATOMIC_ACQUIRE, "agent");
      asm volatile("s_waitcnt vmcnt(0)" ::: "memory");
    }
  }
  __syncthreads();
}

constexpr int N_PHASES = 22;
template <class Epi>
DI void gemm256(char* smem_all, const bf16_t* A, const bf16_t* Bt, int M, int N, int K, const Epi& E) {
  pg8::Gemm g{A, Bt, M, N, K};
  pg8::StaticOrder S; S.init(M, N, (int)gridDim.x, (int)blockIdx.x);
  pg8::gemm_phase<Epi, pg8::StaticOrder, false>((PG8_LAS unsigned char*)smem_all, g, S, E, nullptr);
}
template <int ph>
DI void run_phase(const Params& p_in, char* smem, char* smem_all) {
  Params p = p_in;
  {
    size_t z = 0; asm volatile("" : "+s"(z)); p.ws = p_in.ws + z; p.out = p_in.out + z;
  }
  char* ws = p.ws;
  const float* mod = (const float*)(ws + WS_MOD);
  const bf16_t* H = (const bf16_t*)(ws + WS_H);
  if (ph == 0) { phase_prep(p, smem); return; }
  const int layer = ph >= 12 ? 1 : 0;
  const int lp = ph - (layer ? 12 : 1);
  int sub;
  if (layer == 0) sub = lp < 2 ? lp : lp + 1;
  else sub = lp < 2 ? lp : (lp == 2 ? 3 : lp + 2);
  const float* modl = mod + (size_t)layer * 8 * 12288;
  switch (sub) {
    case 0:
      if (layer == 0) phase_norm<true>(p, p.x, p.norm_gain, modl, modl + 2048);
      else phase_norm<false>(p, p.out, p.norm_gain + 2 * 2048, modl, modl + 2048);
      break;
    case 1: {
      if (layer == 0) fox_cumsum(p);
      pg8::EpiQkNorm eq{(bf16_t*)(ws + WS_QK), 4096, layer ? p.odd_qk_gain : p.even_fox_qk_gain, layer ? p.odd_qk_gain : p.even_diff_qk_gain,
                        layer ? 4 : 3, (float*)(smem_all + 131072)};
      gemm256(smem_all, H, (const bf16_t*)(ws + (layer ? WS_WQK1 : WS_WQK0)), T_, 4096, 2048, eq);
      pg8::EpiBf16 ev{(bf16_t*)(ws + WS_VT), T_};
      gemm256(smem_all, (const bf16_t*)(ws + (layer ? WS_WV1 : WS_WV0)), H, 2048, T_, 2048, ev);
    } break;
    case 3:
      if (layer == 0) phase_attn_even(p, smem_all); else phase_attn_odd(p, smem_all);
      break;
    case 4: phase_diff_combine(p); break;
    case 5: {
      pg8::EpiRes er{p.out, 2048, layer ? p.out : p.x, modl + 2 * 2048};
      gemm256(smem_all, (const bf16_t*)(ws + WS_ATT), (const bf16_t*)(ws + (layer ? WS_WO1 : WS_WO0)), T_, 2048, 2048, er);
    } break;
    case 6:
      phase_norm<false, true>(p, p.out, p.norm_gain + (layer * 2 + 1) * 2048, modl + 3 * 2048, modl + 4 * 2048);
      break;
    case 7: {
      pg8::EpiBf16 es{(bf16_t*)(ws + WS_SC), 2048};
      gemm256(smem_all, H, (const bf16_t*)(ws + (layer ? WS_WQ1 : WS_WQ0)), T_, 2048, 2048, es);
    } break;
    case 8: phase_peer_retrieve(p, smem); break;
    case 9: phase_peer_dots(p, layer, smem_all); break;
    case 10: phase_peer_act(p, layer); break;
    case 11: phase_peer_values(p, layer, modl + 5 * 2048, smem_all); break;
  }
}

#if FUSED
template <int PH>
DI void run_all(const Params& p, char* smem, char* smem_all, const XcdBarrier& xb, cg::grid_group& grid) {
  if constexpr (PH < N_PHASES) {
    run_phase<PH>(p, smem, smem_all);
    if constexpr (PH + 1 < N_PHASES) xcd_barrier(xb);
    run_all<PH + 1>(p, smem, smem_all, xb, grid);
  }
}
__global__ void __launch_bounds__(RTHREADS, 2) mega_kernel(Params p) {
  extern __shared__ __attribute__((aligned(16))) char smem_all[];
  char* smem = smem_all + (RTID() >> 8) * HALF_SMEM;
  cg::grid_group grid = cg::this_grid();
  volatile LAS unsigned* xst = (volatile LAS unsigned*)(smem_all + SMEM_BYTES - 16);
  if (threadIdx.x == 0) { xst[0] = 0u; xst[1] = 0u; }
  __syncthreads();
  const XcdBarrier xb = xcd_barrier_post((unsigned*)(p.ws + WS_BAR), xst);
  if (p.ws == nullptr) grid.sync();
  run_all<0>(p, smem, smem_all, xb, grid);
}
#else
template <int PH>
__global__ void __launch_bounds__(RTHREADS, 2) phase_kernel(Params p) {
  extern __shared__ __attribute__((aligned(16))) char smem_all[];
  char* smem = smem_all + (RTID() >> 8) * HALF_SMEM;
  run_phase<PH>(p, smem, smem_all);
}
template <int PH>
static void launch_phases(const Params& p, int grid, hipStream_t stream) {
  if constexpr (PH < N_PHASES) {
    (void)hipFuncSetAttribute((const void*)phase_kernel<PH>, hipFuncAttributeMaxDynamicSharedMemorySize, SMEM_BYTES);
    phase_kernel<PH><<<grid, RTHREADS, SMEM_BYTES, stream>>>(p);
    launch_phases<PH + 1>(p, grid, stream);
  }
}
#endif

extern "C" void kernel_launch(void* const* d_in, const int* in_sizes, int n_in, void* d_out, int out_size, void* d_ws,
                              size_t ws_size, hipStream_t stream) {
  Params p{};
  p.x = (const float*)d_in[0]; p.c = (const float*)d_in[1]; p.rel_bias = (const float*)d_in[2];
  p.norm_gain = (const float*)d_in[3]; p.w_ada = (const float*)d_in[4]; p.b_ada = (const float*)d_in[5];
  p.even_w_in = (const float*)d_in[6]; p.even_b_forget = (const float*)d_in[7]; p.even_fox_qk_gain = (const float*)d_in[8];
  p.even_diff_qk_gain = (const float*)d_in[9]; p.even_diff_lambda = (const float*)d_in[10];
  p.even_diff_subln_gain = (const float*)d_in[11]; p.even_w_out = (const float*)d_in[12];
  p.odd_w_qkv = (const float*)d_in[13]; p.odd_qk_gain = (const float*)d_in[14]; p.odd_w_out = (const float*)d_in[15];
  p.peer_w_query = (const float*)d_in[16]; p.peer_sub_keys = (const float*)d_in[17];
  p.peer_u = (const float*)d_in[18]; p.peer_v = (const float*)d_in[19];
  p.out = (float*)d_out; p.ws = (char*)d_ws;
  if (ws_size < WS_END) { fprintf(stderr, "workspace too small: %zu < %zu\n", ws_size, (size_t)WS_END); return; }
#if FUSED
  static int grid_blocks = 0;
  if (!grid_blocks) {
    int dev = 0, cus = 0, per_cu = 0;
    (void)hipGetDevice(&dev);
    (void)hipDeviceGetAttribute(&cus, hipDeviceAttributeMultiprocessorCount, dev);
    (void)hipFuncSetAttribute((const void*)mega_kernel, hipFuncAttributeMaxDynamicSharedMemorySize, SMEM_BYTES);
    (void)hipOccupancyMaxActiveBlocksPerMultiprocessor(&per_cu, mega_kernel, RTHREADS, SMEM_BYTES);
    if (per_cu > 1) per_cu = 1;
    grid_blocks = cus * per_cu;
  }
  (void)hipMemsetAsync(p.ws + WS_BAR, 0, WS_BAR_BYTES, stream);
  void* args[] = {&p};
  hipError_t e = hipLaunchCooperativeKernel((void*)mega_kernel, dim3(grid_blocks), dim3(RTHREADS), args, SMEM_BYTES, stream);
  if (e != hipSuccess) fprintf(stderr, "cooperative launch failed: %s (grid %d)\n", hipGetErrorString(e), grid_blocks);
#else
  launch_phases<0>(p, 256, stream);
#endif
}
```

```cpp
#include <hip/hip_runtime.h>
#include <hip/hip_cooperative_groups.h>
#include <stdint.h>
#include <stdio.h>
namespace cg = cooperative_groups;

#ifndef FUSED
#define FUSED 1
#endif

#define DI __device__ __forceinline__
typedef unsigned short bf16_t;
typedef __attribute__((ext_vector_type(8))) short bf16x8;
typedef __attribute__((ext_vector_type(4))) short bf16x4;
typedef __attribute__((ext_vector_type(16))) float f32x16;
typedef __attribute__((ext_vector_type(2))) __bf16 bf2_t;
typedef __attribute__((ext_vector_type(2))) float f2_t;
typedef __attribute__((ext_vector_type(4))) unsigned u32x4;
#define MFMA32(a, b, c) __builtin_amdgcn_mfma_f32_32x32x16_bf16((a), (b), (c), 0, 0, 0)

constexpr int T_ = 16384;
constexpr int D_ = 2048;
constexpr int S_ = 2048;
constexpr int NB_ = 8;
constexpr int NEXP = 16384;
constexpr float LOG2E = 1.4426950408889634f;
constexpr int NTHREADS = 256;
constexpr int HALF_SMEM = 75776;
constexpr int RTHREADS = 512;
constexpr int SMEM_BYTES = 2 * HALF_SMEM + 16;

constexpr size_t MiB = 1048576;
constexpr size_t WS_PEERU = 0;
constexpr size_t WS_PEERV8 = WS_PEERU + 64 * MiB;
constexpr size_t WS_PEERV = WS_PEERU + 128 * MiB;
constexpr size_t WS_WQK0 = WS_PEERV + 128 * MiB;
constexpr size_t WS_WV0 = WS_WQK0 + 16 * MiB;
constexpr size_t WS_WQK1 = WS_WV0 + 8 * MiB;
constexpr size_t WS_WV1 = WS_WQK1 + 16 * MiB;
constexpr size_t WS_WO0 = WS_WV1 + 8 * MiB;
constexpr size_t WS_WO1 = WS_WO0 + 8 * MiB;
constexpr size_t WS_WQ0 = WS_WO1 + 8 * MiB;
constexpr size_t WS_WQ1 = WS_WQ0 + 8 * MiB;
constexpr size_t WS_SK = WS_WQ1 + 8 * MiB;
constexpr size_t WS_WFF = WS_SK + 131072;
constexpr size_t WS_MOD = WS_WFF + 65536;
constexpr size_t WS_LOGF = WS_MOD + 786432;
constexpr size_t WS_FCUM = WS_LOGF + 524288;
constexpr size_t WS_MISC = WS_FCUM + 524288;
constexpr size_t WS_H = WS_MISC + 65536;
constexpr size_t WS_QK = WS_H + 64 * MiB;
constexpr size_t WS_VT = WS_QK + 128 * MiB;
constexpr size_t WS_ATT = WS_VT + 64 * MiB;
constexpr size_t WS_SC = WS_ATT + 64 * MiB;
constexpr size_t WS_BAR = WS_SC + 128 * MiB;
constexpr size_t WS_TICKETS = WS_BAR + 16384;
constexpr size_t WS_BAR_BYTES = 16384 + 4096;
constexpr size_t WS_IDX = WS_ATT;
constexpr size_t WS_GATE = WS_ATT + 8 * MiB;
constexpr size_t WS_ACT = WS_ATT + 16 * MiB;
constexpr size_t WS_PD = WS_SC;
constexpr size_t WS_USC4 = WS_PEERV + 1 * MiB;
constexpr size_t WS_H8 = WS_QK;
constexpr size_t WS_HS = WS_QK + 32 * MiB;
constexpr size_t WS_R16 = WS_BAR + 65536;
constexpr size_t WS_END = WS_R16 + 64 * MiB;

struct Params {
  const float* x; const float* c; const float* rel_bias; const float* norm_gain; const float* w_ada; const float* b_ada;
  const float* even_w_in; const float* even_b_forget; const float* even_fox_qk_gain; const float* even_diff_qk_gain;
  const float* even_diff_lambda; const float* even_diff_subln_gain; const float* even_w_out;
  const float* odd_w_qkv; const float* odd_qk_gain; const float* odd_w_out;
  const float* peer_w_query; const float* peer_sub_keys; const float* peer_u; const float* peer_v;
  float* out; char* ws;
};

DI unsigned pack_bf2(float a, float b) { f2_t v = {a, b}; return __builtin_bit_cast(unsigned, __builtin_convertvector(v, bf2_t)); }
DI unsigned pack_i8x4(float a, float b, float c, float d) {
  const int ia = (int)rintf(a), ib = (int)rintf(b), ic = (int)rintf(c), id = (int)rintf(d);
  return (unsigned)(ia & 255) | ((unsigned)(ib & 255) << 8) | ((unsigned)(ic & 255) << 16) | ((unsigned)id << 24);
}
DI unsigned q4(float v) { int q = (int)rintf(v); q = q > 7 ? 7 : (q < -7 ? -7 : q); return (unsigned)q & 15u; }
DI unsigned pack_i4x4(float a, float b, float c, float d) { return q4(a) | (q4(b) << 8) | (q4(c) << 16) | (q4(d) << 24); }
DI bf16_t f2bf(float a) { return (bf16_t)(pack_bf2(a, 0.f) & 0xffffu); }
DI float bf_lo(unsigned u) { return __uint_as_float(u << 16); }
DI float bf_hi(unsigned u) { return __uint_as_float(u & 0xffff0000u); }
DI int RTID() { int t = threadIdx.x; asm volatile("" : "+v"(t)); return t; }
DI int TID() { return RTID() & 255; }
DI int VBID() { return __builtin_amdgcn_readfirstlane(blockIdx.x * 2 + (RTID() >> 8)); }
DI int VGRID() { return gridDim.x * 2; }
DI int xcc_id() { return (int)(__builtin_amdgcn_s_getreg((3 << 11) | 20) & 0xFu); }
DI int crow(int reg, int h) { return (reg & 3) + 8 * (reg >> 2) + 4 * h; }
DI float wave_sum(float v) {
#pragma unroll
  for (int o = 32; o >= 1; o >>= 1) v += __shfl_xor(v, o);
  return v;
}
DI float wave_max(float v) {
#pragma unroll
  for (int o = 32; o >= 1; o >>= 1) v = fmaxf(v, __shfl_xor(v, o));
  return v;
}

DI void transpose_tile(const float* __restrict__ src, int ld, int c0, int k0, bf16_t* __restrict__ dst_row0, char* smem) {
  float* tile = (float*)smem;
  const int tid = TID();
  const int ty = tid >> 4, tx = tid & 15;
#pragma unroll
  for (int i = 0; i < 4; ++i) {
    const int k = ty + 16 * i;
    const float4 v = *(const float4*)(src + (size_t)(k0 + k) * ld + c0 + 4 * tx);
    float* t = tile + k * 65 + 4 * tx;
    t[0] = v.x; t[1] = v.y; t[2] = v.z; t[3] = v.w;
  }
  __syncthreads();
  const int cc = tid >> 2, kc = (tid & 3) * 16;
  unsigned pk[8];
#pragma unroll
  for (int j = 0; j < 8; ++j) pk[j] = pack_bf2(tile[(kc + 2 * j) * 65 + cc], tile[(kc + 2 * j + 1) * 65 + cc]);
  uint4* d = (uint4*)(dst_row0 + (size_t)cc * 2048 + k0 + kc);
  d[0] = make_uint4(pk[0], pk[1], pk[2], pk[3]);
  d[1] = make_uint4(pk[4], pk[5], pk[6], pk[7]);
  __syncthreads();
}

DI void phase_prep(const Params& p, char* smem) {
  const int tid = TID(), bid = VBID(), G = VGRID();
  char* ws = p.ws;
  {
    float* cond = (float*)smem;
    bool have_cond = false;
    for (int item = bid; item < 384; item += G) {
      if (!have_cond) {
        for (int e = tid; e < NB_ * D_; e += NTHREADS) {
          const int b = e >> 11, d = e & 2047;
          const float v = p.c[e];
          cond[d * 8 + b] = v / (1.f + __expf(-v));
        }
        have_cond = true;
        __syncthreads();
      }
      const int i = item / 192, n = (item % 192) * 64 + (tid & 63);
      const int w = tid >> 6;
      const float* wp = p.w_ada + (size_t)i * D_ * 12288 + n;
      float acc[8];
#pragma unroll
      for (int b = 0; b < 8; ++b) acc[b] = 0.f;
#pragma unroll 8
      for (int d = w; d < D_; d += 4) {
        const float wv = wp[(size_t)d * 12288];
        const float4 c0 = *(const float4*)(cond + d * 8), c1 = *(const float4*)(cond + d * 8 + 4);
        acc[0] += c0.x * wv; acc[1] += c0.y * wv; acc[2] += c0.z * wv; acc[3] += c0.w * wv;
        acc[4] += c1.x * wv; acc[5] += c1.y * wv; acc[6] += c1.z * wv; acc[7] += c1.w * wv;
      }
      float* red = (float*)(smem + 65536);
#pragma unroll
      for (int b = 0; b < 8; ++b) red[(w * 64 + (tid & 63)) * 8 + b] = acc[b];
      __syncthreads();
      if (tid < 64) {
        float* mod = (float*)(ws + WS_MOD);
#pragma unroll
        for (int b = 0; b < 8; ++b) {
          const float s = red[(0 * 64 + tid) * 8 + b] + red[(1 * 64 + tid) * 8 + b] + red[(2 * 64 + tid) * 8 + b] + red[(3 * 64 + tid) * 8 + b];
          mod[((size_t)i * 8 + b) * 12288 + n] = s + p.b_ada[i * 12288 + n];
        }
      }
      __syncthreads();
    }
    __syncthreads();
  }
  {
    bf16_t* wqk0 = (bf16_t*)(ws + WS_WQK0); bf16_t* wv0 = (bf16_t*)(ws + WS_WV0);
    bf16_t* wqk1 = (bf16_t*)(ws + WS_WQK1); bf16_t* wv1 = (bf16_t*)(ws + WS_WV1);
    for (int item = bid; item < 256 * 32; item += G) {
      const int ct = item >> 5, kt = item & 31;
      const float* src; int ld, c0; bf16_t* dst;
      if (ct < 96) {
        const int seg = ct >> 4, cl = (ct & 15) * 64;
        src = p.even_w_in; ld = 6152;
        c0 = (seg < 3 ? seg * 1024 : 3080 + (seg - 3) * 1024) + cl;
        if (seg == 0) dst = wqk0 + (size_t)cl * 2048;
        else if (seg == 1) dst = wqk0 + (size_t)(1024 + cl) * 2048;
        else if (seg == 2) dst = wv0 + (size_t)cl * 2048;
        else if (seg == 3) dst = wqk0 + (size_t)(2048 + cl) * 2048;
        else if (seg == 4) dst = wqk0 + (size_t)(3072 + cl) * 2048;
        else dst = wv0 + (size_t)(1024 + cl) * 2048;
      } else if (ct < 192) {
        const int cl = (ct - 96) * 64;
        src = p.odd_w_qkv; ld = 6144; c0 = cl;
        dst = cl < 4096 ? wqk1 + (size_t)cl * 2048 : wv1 + (size_t)(cl - 4096) * 2048;
      } else {
        const int mi = (ct - 192) >> 5, cl = ((ct - 192) & 31) * 64;
        ld = 2048; c0 = cl;
        if (mi == 0) { src = p.even_w_out; dst = (bf16_t*)(ws + WS_WO0); }
        else { src = p.odd_w_out; dst = (bf16_t*)(ws + WS_WO1); }
        dst += (size_t)cl * 2048;
      }
      transpose_tile(src, ld, c0, kt * 64, dst, smem);
    }
  }
  {
    const int lane = tid & 63;
    const int gw = __builtin_amdgcn_readfirstlane((bid * NTHREADS + tid) >> 6), nw = (G * NTHREADS) >> 6;
    float* scl = (float*)(ws + WS_PEERV);
    float4 nx[8];
    {
      const int r0 = gw < 4 * NEXP ? gw : 0;
      const float* s0 = ((r0 >> 15) ? p.peer_v : p.peer_u) + (size_t)(r0 & 32767) * D_;
#pragma unroll
      for (int i = 0; i < 2; ++i)
#pragma unroll
        for (int j = 0; j < 4; ++j) nx[4 * i + j] = *(const float4*)(s0 + lane * 16 + 1024 * i + 4 * j);
    }
    for (int row = gw; row < 4 * NEXP; row += nw) {
      const int tab = row >> 15, rr = row & 32767;
      unsigned char* dst = (unsigned char*)(ws + (tab ? WS_PEERV8 : WS_PEERU)) + (size_t)(rr >> 14) * NEXP * D_ + (size_t)(rr & (NEXP - 1)) * 128;
      float4 v[8];
      float am = 0.f;
#pragma unroll
      for (int i = 0; i < 8; ++i) v[i] = nx[i];
      {
        const int rn = row + nw < 4 * NEXP ? row + nw : row;
        const float* sn = ((rn >> 15) ? p.peer_v : p.peer_u) + (size_t)(rn & 32767) * D_;
#pragma unroll
        for (int i = 0; i < 2; ++i)
#pragma unroll
          for (int j = 0; j < 4; ++j) nx[4 * i + j] = *(const float4*)(sn + lane * 16 + 1024 * i + 4 * j);
        asm volatile("" ::: "memory");
      }
#pragma unroll
      for (int i = 0; i < 8; ++i) am = fmaxf(am, fmaxf(fmaxf(fabsf(v[i].x), fabsf(v[i].y)), fmaxf(fabsf(v[i].z), fabsf(v[i].w))));
      if (!tab) {
        unsigned char* d4 = (unsigned char*)(ws + WS_PEERU) + (size_t)(rr >> 14) * (8 * NEXP * 128) + (size_t)(rr & (NEXP - 1)) * 128 + (lane & 15) * 8;
        float* sc4 = (float*)(ws + WS_USC4) + (size_t)(rr >> 14) * (8 * NEXP) + (rr & (NEXP - 1));
#pragma unroll
        for (int i = 0; i < 2; ++i) {
          float bm = 0.f;
#pragma unroll
          for (int j = 0; j < 4; ++j) bm = fmaxf(bm, fmaxf(fmaxf(fabsf(v[4 * i + j].x), fabsf(v[4 * i + j].y)), fmaxf(fabsf(v[4 * i + j].z), fabsf(v[4 * i + j].w))));
#pragma unroll
          for (int o = 1; o < 16; o <<= 1) bm = fmaxf(bm, __shfl_xor(bm, o));
          const float sc = bm > 0.f ? 7.5f / bm : 1.f;
          const int slice = 4 * i + (lane >> 4);
          if ((lane & 15) == 0) sc4[(size_t)slice * NEXP] = bm > 0.f ? bm / 7.5f : 1.f;
          unsigned w[2];
#pragma unroll
          for (int gq = 0; gq < 2; ++gq) {
            const float4 a = v[4 * i + 2 * gq], b = v[4 * i + 2 * gq + 1];
            const unsigned lo = pack_i4x4(a.x * sc, a.y * sc, a.z * sc, a.w * sc);
            const unsigned hi = pack_i4x4(b.x * sc, b.y * sc, b.z * sc, b.w * sc);
            w[gq] = lo | (hi << 4);
          }
          *(uint2*)(d4 + (size_t)slice * (NEXP * 128)) = make_uint2(w[0], w[1]);
        }
        continue;
      }
      am = wave_max(am);
      const float sc = am > 0.f ? 127.f / am : 1.f;
      if (lane == 0) scl[row] = am > 0.f ? am / 127.f : 1.f;
#pragma unroll
      for (int i = 0; i < 2; ++i) {
        unsigned w[4];
#pragma unroll
        for (int j = 0; j < 4; ++j) w[j] = pack_i8x4(v[4 * i + j].x * sc, v[4 * i + j].y * sc, v[4 * i + j].z * sc, v[4 * i + j].w * sc);
        *(uint4*)(dst + (size_t)((lane >> 3) + 8 * i) * (NEXP * 128) + (lane & 7) * 16) = make_uint4(w[0], w[1], w[2], w[3]);
      }
    }
  }
  {
    float* sks = (float*)smem;
    float* wqs = (float*)(smem + 33792);
    const int tn = tid >> 4, tk = tid & 15;
    for (int item = bid; item < 2048; item += G) {
      const int layer = item >> 10, hp = (item >> 6) & 15, nt = (item >> 5) & 1, kt = item & 31;
      const float* sk = p.peer_sub_keys + ((size_t)(layer * 2 + (hp & 1)) * 128 + nt * 64) * 128;
      const float* wq = p.peer_w_query + (size_t)layer * 2048 * 2048 + (size_t)(kt * 64) * 2048 + hp * 128;
      __syncthreads();
#pragma unroll
      for (int i = 0; i < 8; ++i) {
        const int idx = tid + 256 * i, row = idx >> 5, c4 = (idx & 31) * 4;
        *(float4*)(sks + row * 132 + c4) = *(const float4*)(sk + (size_t)row * 128 + c4);
        *(float4*)(wqs + row * 132 + c4) = *(const float4*)(wq + (size_t)row * 2048 + c4);
      }
      __syncthreads();
      float acc[4][4];
#pragma unroll
      for (int i = 0; i < 4; ++i)
#pragma unroll
        for (int j = 0; j < 4; ++j) acc[i][j] = 0.f;
#pragma unroll 4
      for (int d = 0; d < 128; d += 4) {
        float4 a[4], b[4];
#pragma unroll
        for (int i = 0; i < 4; ++i) { a[i] = *(const float4*)(sks + (tn + 16 * i) * 132 + d); b[i] = *(const float4*)(wqs + (tk + 16 * i) * 132 + d); }
#pragma unroll
        for (int i = 0; i < 4; ++i)
#pragma unroll
          for (int j = 0; j < 4; ++j) acc[i][j] += a[i].x * b[j].x + a[i].y * b[j].y + a[i].z * b[j].z + a[i].w * b[j].w;
      }
      bf16_t* dst = (bf16_t*)(ws + (layer ? WS_WQ1 : WS_WQ0)) + (size_t)(hp * 128 + nt * 64) * 2048 + kt * 64;
#pragma unroll
      for (int i = 0; i < 4; ++i)
#pragma unroll
        for (int j = 0; j < 4; ++j) dst[(size_t)(tn + 16 * i) * 2048 + tk + 16 * j] = f2bf(acc[i][j]);
    }
    __syncthreads();
  }
  if (bid == G - 1) {
    float* wff = (float*)(ws + WS_WFF);
    for (int e = tid; e < 2048 * 8; e += NTHREADS) wff[e] = p.even_w_in[(size_t)(e >> 3) * 6152 + 3072 + (e & 7)];
    if (tid < 64) {
      const float* l = p.even_diff_lambda;
      float s1 = l[tid] * l[128 + tid] + l[64 + tid] * l[128 + 64 + tid];
      float s2 = l[256 + tid] * l[384 + tid] + l[256 + 64 + tid] * l[384 + 64 + tid];
      s1 = wave_sum(s1); s2 = wave_sum(s2);
      if (tid == 0) ((float*)(ws + WS_MISC))[0] = expf(s1) - expf(s2) + 0.2f;
    }
  }
}

template <bool FF, bool Q8 = false, bool IN16 = false>
DI void phase_norm(const Params& p, const void* __restrict__ xin_, const float* __restrict__ gain,
                   const float* __restrict__ sh, const float* __restrict__ sc  ) {
  const int lane = TID() & 63;
  const int gw = __builtin_amdgcn_readfirstlane((VBID() * NTHREADS + TID()) >> 6), nw = (VGRID() * NTHREADS) >> 6;
  bf16_t* H = (bf16_t*)(p.ws + WS_H);
  for (int t = gw; t < T_; t += nw) {
    const int b = t >> 11;
    float4 v[8];
    float ss = 0.f;
    if (IN16) {
      const bf16_t* xr = (const bf16_t*)xin_ + (size_t)t * D_;
#pragma unroll
      for (int i = 0; i < 8; ++i) { const uint2 w = *(const uint2*)(xr + lane * 4 + 256 * i); v[i] = make_float4(bf_lo(w.x), bf_hi(w.x), bf_lo(w.y), bf_hi(w.y)); }
    } else {
      const float* xr = (const float*)xin_ + (size_t)t * D_;
#pragma unroll
      for (int i = 0; i < 8; ++i) v[i] = *(const float4*)(xr + lane * 4 + 256 * i);
    }
#pragma unroll
    for (int i = 0; i < 8; ++i) ss += v[i].x * v[i].x + v[i].y * v[i].y + v[i].z * v[i].z + v[i].w * v[i].w;
    ss = wave_sum(ss);
    const float rstd = rsqrtf(ss * (1.f / 2048.f) + 1e-6f);
    float ff[8];
    if (FF) {
#pragma unroll
      for (int j = 0; j < 8; ++j) ff[j] = 0.f;
    }
    float am = 0.f;
#pragma unroll
    for (int i = 0; i < 8; ++i) {
      const int c = lane * 4 + 256 * i;
      const float4 g = *(const float4*)(gain + c);
      const float4 s1 = *(const float4*)(sc + (size_t)b * 12288 + c);
      const float4 s0 = *(const float4*)(sh + (size_t)b * 12288 + c);
      float4 h;
      h.x = v[i].x * rstd * g.x * (1.f + s1.x) + s0.x;
      h.y = v[i].y * rstd * g.y * (1.f + s1.y) + s0.y;
      h.z = v[i].z * rstd * g.z * (1.f + s1.z) + s0.z;
      h.w = v[i].w * rstd * g.w * (1.f + s1.w) + s0.w;
      *(uint2*)(H + (size_t)t * D_ + c) = make_uint2(pack_bf2(h.x, h.y), pack_bf2(h.z, h.w));
      if (Q8) { v[i] = h; am = fmaxf(am, fmaxf(fmaxf(fabsf(h.x), fabsf(h.y)), fmaxf(fabsf(h.z), fabsf(h.w)))); }
      if (FF) {
        const float* wff = (const float*)(p.ws + WS_WFF) + c * 8;
        const float hv[4] = {h.x, h.y, h.z, h.w};
#pragma unroll
        for (int e = 0; e < 4; ++e) {
          const float4 w0 = *(const float4*)(wff + e * 8), w1 = *(const float4*)(wff + e * 8 + 4);
          ff[0] += hv[e] * w0.x; ff[1] += hv[e] * w0.y; ff[2] += hv[e] * w0.z; ff[3] += hv[e] * w0.w;
          ff[4] += hv[e] * w1.x; ff[5] += hv[e] * w1.y; ff[6] += hv[e] * w1.z; ff[7] += hv[e] * w1.w;
        }
      }
    }
    if (Q8) {
      am = wave_max(am);
      const float qs = am > 0.f ? 119.f / am : 1.f;
      unsigned char* h8 = (unsigned char*)(p.ws + WS_H8) + (size_t)t * D_ + lane * 4;
#pragma unroll
      for (int i = 0; i < 8; ++i) *(unsigned*)(h8 + 256 * i) = pack_i8x4(v[i].x * qs, v[i].y * qs, v[i].z * qs, v[i].w * qs);
      if (lane == 0) ((float*)(p.ws + WS_HS))[t] = am > 0.f ? am / 119.f : 1.f;
    }
    if (FF) {
#pragma unroll
      for (int j = 0; j < 8; ++j) ff[j] = wave_sum(ff[j]);
      if (lane < 8) {
        float z = ff[0];
#pragma unroll
        for (int j = 1; j < 8; ++j) z = (lane == j) ? ff[j] : z;
        z += p.even_b_forget[lane];
        const float lf = fminf(z, 0.f) - log1pf(__expf(-fabsf(z)));
        ((float*)(p.ws + WS_LOGF))[(size_t)t * 8 + lane] = lf;
      }
    }
  }
}

DI void fox_cumsum(const Params& p) {
  const int lane = TID() & 63;
  const int gw = __builtin_amdgcn_readfirstlane((VBID() * NTHREADS + TID()) >> 6), nw = (VGRID() * NTHREADS) >> 6;
  const float* lf = (const float*)(p.ws + WS_LOGF);
  float* fc = (float*)(p.ws + WS_FCUM);
  for (int it = gw; it < 64; it += nw) {
    const int b = it >> 3, hh = it & 7;
    float v[32];
    float tot = 0.f;
#pragma unroll
    for (int j = 0; j < 32; ++j) { tot += lf[(size_t)(b * S_ + lane * 32 + j) * 8 + hh]; v[j] = tot; }
    float inc = tot;
#pragma unroll
    for (int o = 1; o < 64; o <<= 1) { const float n = __shfl_up(inc, o); if (lane >= o) inc += n; }
    const float base = inc - tot;
#pragma unroll
    for (int j = 0; j < 32; ++j) fc[(size_t)it * S_ + lane * 32 + j] = v[j] + base;
  }
}

namespace pg8 {
#define PG8_LAS __attribute__((address_space(3)))
typedef float f32x4 __attribute__((ext_vector_type(4)));
constexpr int BM = 256, BK = 64, HALF = 128, HTB = HALF * BK * 2  , STAGE_BYTES = 8 * HTB, NXCD = 8, WGM = 8;

__host__ __device__ __forceinline__ int lds_byte(int r, int c) { const int st = (r >> 4) * 2 + (c >> 5), rr = r & 15, cc = c & 31, ob = rr * 64 + cc * 2; return st * 1024 + (ob ^ (((ob >> 9) & 1) << 5)); }
__host__ __device__ __forceinline__ void stage_rc(int b, int& R, int& C) { const int st = b / 1024, sb = b % 1024, swz = sb ^ (((sb >> 9) & 1) << 5); R = (st >> 1) * 16 + swz / 64; C = (st & 1) * 32 + (swz % 64) / 2; }
__host__ __device__ __forceinline__ int perm32(int rho) { const int n = rho >> 4, i = rho & 15; return 8 * (i >> 2) + 4 * n + (i & 3); }

struct Unit { int pm, pn; };
struct Gemm { const bf16_t* A; const bf16_t* Bt; int M, N, K; };

struct StaticOrder {
    int nM, nN, nwg, G, c;
    __host__ __device__ void init(int M, int N, int G_, int c_) { nM = M / BM; nN = N / BM; nwg = nM * nN; G = G_; c = c_; }
    __host__ __device__ bool next(int i, Unit& u) const {
        const long L = (long)i * G + c; if (L >= nwg) return false;
        int wgid = (int)L; { const int q = nwg / NXCD, r = nwg % NXCD, xcd = wgid % NXCD, off = wgid / NXCD; wgid = (xcd < r ? xcd * (q + 1) : r * (q + 1) + (xcd - r) * q) + off; }
        const int nig = WGM * nN, gid = wgid / nig, fm = gid * WGM, gsz = (nM - fm) < WGM ? (nM - fm) : WGM;
        u.pm = fm + ((wgid % nig) % gsz); u.pn = (wgid % nig) / gsz; return true;
    }
    __device__ __forceinline__ void a_ready(const Unit&) const {}
    __device__ __forceinline__ void done(const Unit&) const {}
};

struct EpiF32 {
    static constexpr bool PERM = false, AFTER_DRAIN = false;
    float* C; int ldc; const float* bias;
    __device__ __forceinline__ void operator()(const f32x4 (&acc)[2][2][4][2], const Unit& u, int wr, int wc, int fr, int fq) const {
        const int row0 = u.pm * BM + wr * 64 + fr, col0 = u.pn * BM + wc * 32 + 4 * fq;
        f32x4 bv[2][2];
#pragma unroll
        for (int bj = 0; bj < 2; ++bj)
#pragma unroll
            for (int n = 0; n < 2; ++n) bv[bj][n] = bias ? *(const f32x4*)(bias + col0 + bj * HALF + n * 16) : (f32x4){0.f, 0.f, 0.f, 0.f};
#pragma unroll
        for (int ai = 0; ai < 2; ++ai)
#pragma unroll
            for (int m = 0; m < 4; ++m) { float* rowp = C + (size_t)(row0 + ai * HALF + m * 16) * ldc + col0;
#pragma unroll
                for (int bj = 0; bj < 2; ++bj)
#pragma unroll
                    for (int n = 0; n < 2; ++n) *(f32x4*)(rowp + bj * HALF + n * 16) = acc[ai][bj][m][n] + bv[bj][n]; }
    }
};
struct EpiBf16 {
    static constexpr bool PERM = true, AFTER_DRAIN = false;
    bf16_t* O; int ldc;
    __device__ __forceinline__ void operator()(const f32x4 (&acc)[2][2][4][2], const Unit& u, int wr, int wc, int fr, int fq) const {
        const int row0 = u.pm * BM + wr * 64 + fr, col0 = u.pn * BM + wc * 32 + 8 * fq;
#pragma unroll
        for (int ai = 0; ai < 2; ++ai)
#pragma unroll
            for (int m = 0; m < 4; ++m) { bf16_t* rowp = O + (size_t)(row0 + ai * HALF + m * 16) * ldc + col0;
#pragma unroll
                for (int bj = 0; bj < 2; ++bj) { const f32x4 v0 = acc[ai][bj][m][0], v1 = acc[ai][bj][m][1];
                    u32x4 w; w.x = pack_bf2(v0[0], v0[1]); w.y = pack_bf2(v0[2], v0[3]); w.z = pack_bf2(v1[0], v1[1]); w.w = pack_bf2(v1[2], v1[3]);
                    *(u32x4*)(rowp + bj * HALF) = w; } }
    }
};
struct EpiQkNorm {
    static constexpr bool PERM = true, AFTER_DRAIN = false;
    bf16_t* O; int ldc; const float* gainA; const float* gainB; int gshift; float* red;
    __device__ __forceinline__ void operator()(const f32x4 (&acc)[2][2][4][2], const Unit& u, int wr, int wc, int fr, int fq) const {
        float ss[2][4][2];
#pragma unroll
        for (int ai = 0; ai < 2; ++ai)
#pragma unroll
            for (int m = 0; m < 4; ++m)
#pragma unroll
                for (int bj = 0; bj < 2; ++bj) {
                    const f32x4 v0 = acc[ai][bj][m][0], v1 = acc[ai][bj][m][1];
                    float t = v0[0] * v0[0] + v0[1] * v0[1] + v0[2] * v0[2] + v0[3] * v0[3] + v1[0] * v1[0] + v1[1] * v1[1] + v1[2] * v1[2] + v1[3] * v1[3];
                    t += __shfl_xor(t, 16); t += __shfl_xor(t, 32);
                    ss[ai][m][bj] = t;
                }
        float* myred = red + (wr * 4 + wc) * 256;
        if (fq == 0) {
#pragma unroll
            for (int ai = 0; ai < 2; ++ai)
#pragma unroll
                for (int m = 0; m < 4; ++m)
#pragma unroll
                    for (int bj = 0; bj < 2; ++bj) myred[(ai * 64 + m * 16 + fr) * 2 + bj] = ss[ai][m][bj];
        }
        asm volatile("s_waitcnt lgkmcnt(0)" ::: "memory"); __builtin_amdgcn_s_barrier(); asm volatile("" ::: "memory");
        const int row0 = u.pm * BM + wr * 64 + fr, col0 = u.pn * BM + wc * 32 + 8 * fq;
        const float* rbase = red + (wr * 4) * 256;
#pragma unroll
        for (int bj = 0; bj < 2; ++bj) {
            const int grp = (u.pn * 2 + bj) >> gshift;
            const float* gain = ((grp & 2) ? gainB : gainA) + (grp & 1) * 128 + wc * 32 + 8 * fq;
            const float qs = (grp & 1) ? 1.f : 0.08838834764831845f * LOG2E;
            float4 g0 = *(const float4*)gain, g1 = *(const float4*)(gain + 4);
            g0.x *= qs; g0.y *= qs; g0.z *= qs; g0.w *= qs; g1.x *= qs; g1.y *= qs; g1.z *= qs; g1.w *= qs;
#pragma unroll
            for (int ai = 0; ai < 2; ++ai)
#pragma unroll
                for (int m = 0; m < 4; ++m) {
                    const int ri = (ai * 64 + m * 16 + fr) * 2 + bj;
                    const float tot = rbase[ri] + rbase[256 + ri] + rbase[512 + ri] + rbase[768 + ri];
                    const float rstd = rsqrtf(tot * (1.f / 128.f) + 1e-6f);
                    const f32x4 v0 = acc[ai][bj][m][0], v1 = acc[ai][bj][m][1];
                    u32x4 w;
                    w.x = pack_bf2(v0[0] * rstd * g0.x, v0[1] * rstd * g0.y); w.y = pack_bf2(v0[2] * rstd * g0.z, v0[3] * rstd * g0.w);
                    w.z = pack_bf2(v1[0] * rstd * g1.x, v1[1] * rstd * g1.y); w.w = pack_bf2(v1[2] * rstd * g1.z, v1[3] * rstd * g1.w);
                    *(u32x4*)(O + (size_t)(row0 + ai * HALF + m * 16) * ldc + col0 + bj * HALF) = w;
                }
        }
    }
};
template <bool IN16>
struct EpiRes16 {
    static constexpr bool PERM = true, AFTER_DRAIN = false;
    bf16_t* O; int ldc; const void* xin; const float* gate;
    __device__ __forceinline__ void operator()(const f32x4 (&acc)[2][2][4][2], const Unit& u, int wr, int wc, int fr, int fq) const {
        const int row0 = u.pm * BM + wr * 64 + fr, col0 = u.pn * BM + wc * 32 + 8 * fq;
        const float* gp = gate + (size_t)((u.pm * BM) >> 11) * 12288 + col0;
        f32x4 g0[2], g1[2];
#pragma unroll
        for (int bj = 0; bj < 2; ++bj) { g0[bj] = *(const f32x4*)(gp + bj * HALF); g1[bj] = *(const f32x4*)(gp + bj * HALF + 4); }
#pragma unroll
        for (int ai = 0; ai < 2; ++ai)
#pragma unroll
            for (int m = 0; m < 4; ++m) { const size_t ro = (size_t)(row0 + ai * HALF + m * 16) * ldc + col0;
#pragma unroll
                for (int bj = 0; bj < 2; ++bj) {
                    f32x4 x0, x1;
                    if (IN16) { const u32x4 xw = *(const u32x4*)((const bf16_t*)xin + ro + bj * HALF);
                        x0 = (f32x4){bf_lo(xw.x), bf_hi(xw.x), bf_lo(xw.y), bf_hi(xw.y)}; x1 = (f32x4){bf_lo(xw.z), bf_hi(xw.z), bf_lo(xw.w), bf_hi(xw.w)}; }
                    else { x0 = *(const f32x4*)((const float*)xin + ro + bj * HALF); x1 = *(const f32x4*)((const float*)xin + ro + bj * HALF + 4); }
                    const f32x4 v0 = x0 + g0[bj] * acc[ai][bj][m][0], v1 = x1 + g1[bj] * acc[ai][bj][m][1];
                    u32x4 w; w.x = pack_bf2(v0[0], v0[1]); w.y = pack_bf2(v0[2], v0[3]); w.z = pack_bf2(v1[0], v1[1]); w.w = pack_bf2(v1[2], v1[3]);
                    *(u32x4*)(O + ro + bj * HALF) = w; } }
    }
};
struct EpiRes {
    static constexpr bool PERM = false, AFTER_DRAIN = false;
    float* C; int ldc; const float* xin; const float* gate;
    __device__ __forceinline__ void operator()(const f32x4 (&acc)[2][2][4][2], const Unit& u, int wr, int wc, int fr, int fq) const {
        const int row0 = u.pm * BM + wr * 64 + fr, col0 = u.pn * BM + wc * 32 + 4 * fq;
        const float* gp = gate + (size_t)((u.pm * BM) >> 11) * 12288 + col0;
        f32x4 gv[2][2];
#pragma unroll
        for (int bj = 0; bj < 2; ++bj)
#pragma unroll
            for (int n = 0; n < 2; ++n) gv[bj][n] = *(const f32x4*)(gp + bj * HALF + n * 16);
#pragma unroll
        for (int ai = 0; ai < 2; ++ai)
#pragma unroll
            for (int m = 0; m < 4; ++m) { const size_t ro = (size_t)(row0 + ai * HALF + m * 16) * ldc + col0;
#pragma unroll
                for (int bj = 0; bj < 2; ++bj)
#pragma unroll
                    for (int n = 0; n < 2; ++n) { const f32x4 xv = *(const f32x4*)(xin + ro + bj * HALF + n * 16);
                        *(f32x4*)(C + ro + bj * HALF + n * 16) = xv + gv[bj][n] * acc[ai][bj][m][n]; } }
    }
};

template <class Epi, class Sched, bool STAMP = false>
__device__ __forceinline__ void gemm_phase(PG8_LAS unsigned char* lds, const Gemm g, const Sched& S, const Epi& E, unsigned long long* stamps) {
    const int tid = RTID(), wid = __builtin_amdgcn_readfirstlane(tid >> 6), lane = tid & 63, wr = wid >> 2, wc = wid & 3, fr = lane & 15, fq = lane >> 4;
    const int K = g.K, nt = K / BK;
    int ts_lo = 0, ts_hi = 0, nts = 0; const unsigned long long rt_entry = STAMP ? (unsigned long long)wall_clock64() : 0ull;
#define PG8_STAMP() do { if (STAMP && wid == 0 && nts < 64) { const unsigned long long _c = (unsigned long long)clock64(); \
        ts_lo = (lane == nts) ? (int)(unsigned)_c : ts_lo; ts_hi = (lane == nts) ? (int)(unsigned)(_c >> 32) : ts_hi; ++nts; } } while (0)
    PG8_STAMP();
    unsigned voffA[2], voffB[2];
#pragma unroll
    for (int i = 0; i < 2; ++i) { int R, C; stage_rc(tid * 16 + i * 8192, R, C); const int Rb = Epi::PERM ? ((R & ~31) + perm32(R & 31)) : R;
        voffA[i] = (unsigned)(R * K + C) * 2u; voffB[i] = (unsigned)(Rb * K + C) * 2u; }
    const size_t kstep = (size_t)(BK * 2);
    const size_t hstep = (size_t)HALF * K * 2;
    const size_t tstep = 2 * hstep;
    const unsigned ldsw = (unsigned)wid * 1024u;
    const int aoff = lds_byte(wr * 64 + fr, fq * 8), boff = lds_byte(wc * 32 + fr, fq * 8);
#define PG8_SA(b, h) (((b) * 2 + (h)) * HTB)
#define PG8_SB(b, h) ((4 + (b) * 2 + (h)) * HTB)
#define PG8_STAGE(bufoff, gbase, voff) do { _Pragma("unroll") for (int _i = 0; _i < 2; ++_i) \
        __builtin_amdgcn_global_load_lds((const unsigned*)((const char*)(gbase) + (voff)[_i]), (PG8_LAS unsigned*)(lds + (bufoff) + ldsw + _i * 8192), 16, 0, 0); } while (0)
#define PG8_LDA(dst, b, h) do { _Pragma("unroll") for (int m = 0; m < 4; ++m) _Pragma("unroll") for (int k = 0; k < 2; ++k) dst[m][k] = *(const PG8_LAS bf16x8*)(lds + PG8_SA(b, h) + aoff + m * 2048 + k * 1024); } while (0)
#define PG8_LDB(dst, b, h) do { _Pragma("unroll") for (int n = 0; n < 2; ++n) _Pragma("unroll") for (int k = 0; k < 2; ++k) dst[n][k] = *(const PG8_LAS bf16x8*)(lds + PG8_SB(b, h) + boff + n * 2048 + k * 1024); } while (0)
#define PG8_MMA(ai, bj, At, Bt) do { __builtin_amdgcn_s_setprio(1); _Pragma("unroll") for (int m = 0; m < 4; ++m) _Pragma("unroll") for (int n = 0; n < 2; ++n) _Pragma("unroll") for (int k = 0; k < 2; ++k) \
        acc[ai][bj][m][n] = __builtin_amdgcn_mfma_f32_16x16x32_bf16(Bt[n][k], At[m][k], acc[ai][bj][m][n], 0, 0, 0); __builtin_amdgcn_s_setprio(0); } while (0)
#define PG8_WAIT_V(n) asm volatile("s_waitcnt vmcnt(" #n ")" ::: "memory")
#define PG8_WAIT_L(n) asm volatile("s_waitcnt lgkmcnt(" #n ")" ::: "memory")
#define PG8_BAR __builtin_amdgcn_s_barrier()
#define PG8_SCHED __builtin_amdgcn_sched_barrier(0)
    Unit cur, nxt; int ui = 0;
    if (!S.next(0, cur)) return;
    f32x4 acc[2][2][4][2];
#pragma unroll
    for (int a = 0; a < 2; ++a)
#pragma unroll
        for (int b = 0; b < 2; ++b)
#pragma unroll
            for (int m = 0; m < 4; ++m)
#pragma unroll
                for (int n = 0; n < 2; ++n) acc[a][b][m][n] = (f32x4){0.f, 0.f, 0.f, 0.f};
    bf16x8 At[4][2], B0[2][2], B1[2][2];
    const char* cA = (const char*)g.A + (size_t)cur.pm * tstep; const char* cB = (const char*)g.Bt + (size_t)cur.pn * tstep;
    S.a_ready(cur);
    PG8_STAGE(PG8_SB(0, 0), cB, voffB); PG8_STAGE(PG8_SA(0, 0), cA, voffA); PG8_STAGE(PG8_SB(0, 1), cB + hstep, voffB); PG8_STAGE(PG8_SA(0, 1), cA + hstep, voffA);
    if (wr == 1) PG8_BAR;
    PG8_WAIT_V(4); PG8_BAR;
    PG8_STAGE(PG8_SB(1, 0), cB + kstep, voffB); PG8_STAGE(PG8_SA(1, 0), cA + kstep, voffA); PG8_STAGE(PG8_SB(1, 1), cB + hstep + kstep, voffB);
    PG8_WAIT_V(6); PG8_BAR;
    PG8_STAMP();
    for (;;) {
        const bool has_next = S.next(ui + 1, nxt);
        const char* nA = has_next ? (const char*)g.A + (size_t)nxt.pm * tstep : cA; const char* nB = has_next ? (const char*)g.Bt + (size_t)nxt.pn * tstep : cB;
        for (int t = 0; t < nt; t += 2) {
            const bool last = (t == nt - 2);
            const char* a1 = cA + (size_t)(t + 1) * kstep;
            const char* a2 = last ? nA : cA + (size_t)(t + 2) * kstep; const char* b2 = last ? nB : cB + (size_t)(t + 2) * kstep;
            const char* a3 = a2 + kstep; const char* b3 = b2 + kstep;
            if (last && has_next) S.a_ready(nxt);
            PG8_LDB(B0, 0, 0); PG8_SCHED; PG8_LDA(At, 0, 0); PG8_STAGE(PG8_SA(1, 1), a1 + hstep, voffA);
            PG8_WAIT_L(8); PG8_BAR; PG8_WAIT_L(0); PG8_MMA(0, 0, At, B0); PG8_BAR; PG8_SCHED;
            PG8_LDB(B1, 0, 1); PG8_STAGE(PG8_SB(0, 0), b2, voffB);
            PG8_BAR; PG8_WAIT_L(0); PG8_MMA(0, 1, At, B1); PG8_BAR;
            PG8_LDA(At, 0, 1); PG8_STAGE(PG8_SA(0, 0), a2, voffA);
            PG8_BAR; PG8_WAIT_L(0); PG8_MMA(1, 0, At, B0); PG8_BAR; PG8_SCHED;
            PG8_STAGE(PG8_SB(0, 1), b2 + hstep, voffB);
            PG8_WAIT_V(6); PG8_BAR; PG8_MMA(1, 1, At, B1); PG8_BAR;
            PG8_LDB(B0, 1, 0); PG8_SCHED; PG8_LDA(At, 1, 0); PG8_STAGE(PG8_SA(0, 1), a2 + hstep, voffA);
            PG8_WAIT_L(8); PG8_BAR; PG8_WAIT_L(0); PG8_MMA(0, 0, At, B0); PG8_BAR; PG8_SCHED;
            PG8_LDB(B1, 1, 1); PG8_STAGE(PG8_SB(1, 0), b3, voffB);
            PG8_BAR; PG8_WAIT_L(0); PG8_MMA(0, 1, At, B1); PG8_BAR;
            PG8_LDA(At, 1, 1); PG8_STAGE(PG8_SA(1, 0), a3, voffA);
            PG8_BAR; PG8_WAIT_L(0); PG8_MMA(1, 0, At, B0); PG8_BAR; PG8_SCHED;
            PG8_STAGE(PG8_SB(1, 1), b3 + hstep, voffB);
            PG8_WAIT_V(6); PG8_BAR; PG8_MMA(1, 1, At, B1); PG8_BAR;
        }
        PG8_STAMP();
        if constexpr (!Epi::AFTER_DRAIN) { E(acc, cur, wr, wc, fr, fq); S.done(cur); }
        PG8_STAMP();
        if (!has_next) break;
#pragma unroll
        for (int a = 0; a < 2; ++a)
#pragma unroll
            for (int b = 0; b < 2; ++b)
#pragma unroll
                for (int m = 0; m < 4; ++m)
#pragma unroll
                    for (int n = 0; n < 2; ++n) acc[a][b][m][n] = (f32x4){0.f, 0.f, 0.f, 0.f};
        cur = nxt; cA = nA; cB = nB; ++ui;
    }
    PG8_WAIT_V(0);
    if (wr == 0) PG8_BAR;
    PG8_BAR;
    if constexpr (Epi::AFTER_DRAIN) { E.fused(acc, cur, wr, wc, fr, fq, lds, wid, lane); S.done(cur); }
    PG8_STAMP();
    if (STAMP && wid == 0) { stamps[lane] = lane < nts ? (((unsigned long long)(unsigned)ts_hi << 32) | (unsigned)ts_lo) : 0ull;
        if (lane == 62) stamps[62] = rt_entry; if (lane == 63) stamps[63] = (unsigned long long)wall_clock64(); }
#undef PG8_STAMP
#undef PG8_SA
#undef PG8_SB
#undef PG8_STAGE
#undef PG8_LDA
#undef PG8_LDB
#undef PG8_MMA
#undef PG8_WAIT_V
#undef PG8_WAIT_L
#undef PG8_BAR
#undef PG8_SCHED
}
}

struct AttnPtrs { const bf16_t* Q; int ldq; const bf16_t* K; int ldk; const bf16_t* Vt; int ldv; const float* kbias; };

DI float xhalf_max(float v) {
  const auto r2 = __builtin_amdgcn_permlane32_swap(__float_as_uint(v), __float_as_uint(v), false, false);
  return fmaxf(__uint_as_float(r2[0]), __uint_as_float(r2[1]));
}
DI float xhalf_sum(float v) {
  const auto r2 = __builtin_amdgcn_permlane32_swap(__float_as_uint(v), __float_as_uint(v), false, false);
  return __uint_as_float(r2[0]) + __uint_as_float(r2[1]);
}

template <int MODE, int DVB>
DI void attn_block(const AttnPtrs& a, int q0b, char* smem, const float* tbl, f32x16 (&o)[DVB], float& l_out) {
  constexpr int STG = 16384 + DVB * 4096;
  const int tid = RTID(), lane = tid & 63, wave = __builtin_amdgcn_readfirstlane(tid >> 6);
  const int r = lane & 31, h = lane >> 5;
  const int q0 = q0b + 32 * wave;
  const int krow = tid >> 4, kch = tid & 15;
  const int vrow = tid >> 3, vch = tid & 7;
  const char* Kb = (const char*)a.K;
  const char* Vb = (const char*)a.Vt;
  const unsigned kvo = (unsigned)(krow * a.ldk + kch * 8) * 2u;
  const unsigned vvo = (unsigned)(vrow * a.ldv + vch * 8) * 2u;
  const unsigned kst = (unsigned)(32 * a.ldk) * 2u, vst = (unsigned)(64 * a.ldv) * 2u;
  const int kwo = krow * 256 + ((kch ^ (krow & 15)) << 4);
  const int vwo = 16384 + vrow * 128 + ((vch ^ ((vrow >> 1) & 7)) << 4);
  const int pr = (r & ~12) | ((r & 4) << 1) | ((r & 8) >> 1);
  const int kro = pr * 256, ksw = pr & 15;
  const int vro = 16384 + r * 128, vsw = (r >> 1) & 7;
  bf16x8 qf[8];
#pragma unroll
  for (int s = 0; s < 8; ++s) qf[s] = *(const bf16x8*)(a.Q + (size_t)(q0 + r) * a.ldq + 16 * s + 8 * h);
#pragma unroll
  for (int dt = 0; dt < DVB; ++dt)
#pragma unroll
    for (int e = 0; e < 16; ++e) o[dt][e] = 0.f;
  float m = -1e30f, l = 0.f;
  const int nkt = (q0b + 256) >> 6;
  u32x4 rk[2], rv[DVB / 2];
#pragma unroll
  for (int i = 0; i < 2; ++i) rk[i] = *(const u32x4*)(Kb + (size_t)(i * kst) + kvo);
#pragma unroll
  for (int i = 0; i < DVB / 2; ++i) rv[i] = *(const u32x4*)(Vb + (size_t)(i * vst) + vvo);
#pragma unroll
  for (int i = 0; i < 2; ++i) *(u32x4*)(smem + kwo + i * 8192) = rk[i];
#pragma unroll
  for (int i = 0; i < DVB / 2; ++i) *(u32x4*)(smem + vwo + i * 8192) = rv[i];
  u32x4 rkB[2], rvB[DVB / 2];
  if constexpr (DVB == 4) {
    const int k1 = nkt > 1 ? 64 : 0;
#pragma unroll
    for (int i = 0; i < 2; ++i) rk[i] = *(const u32x4*)(Kb + ((size_t)k1 * (size_t)a.ldk * 2u + i * kst) + kvo);
#pragma unroll
    for (int i = 0; i < DVB / 2; ++i) rv[i] = *(const u32x4*)(Vb + ((size_t)k1 * 2u + i * vst) + vvo);
  }
  __syncthreads();
#define ATT_TILE(KT, RL, RVL, RW, RVW) { const int kt = (KT); \
    const int k0 = kt << 6; \
    char* st = smem + (kt & 1) * STG; \
    { \
      const int kn = (kt + 2 < nkt ? kt + 2 : nkt - 1) << 6;        \
      const size_t kbo = (size_t)kn * (size_t)a.ldk * 2u, vbo = (size_t)kn * 2u; \
_Pragma("unroll") \
      for (int i = 0; i < 2; ++i) RL[i] = *(const u32x4*)(Kb + (kbo + i * kst) + kvo); \
_Pragma("unroll") \
      for (int i = 0; i < DVB / 2; ++i) RVL[i] = *(const u32x4*)(Vb + (vbo + i * vst) + vvo); \
    } \
    asm volatile("" ::: "memory"); \
    __builtin_amdgcn_sched_barrier(0); \
_Pragma("unroll") \
    for (int sub = 0; sub < 2; ++sub) { \
      const int ks0 = k0 + 32 * sub; \
      if (ks0 <= q0) { \
        f32x16 sa; \
_Pragma("unroll") \
        for (int e = 0; e < 16; ++e) sa[e] = 0.f; \
_Pragma("unroll") \
        for (int s = 0; s < 8; ++s) { \
          const bf16x8 kf = *(const bf16x8*)(st + kro + sub * 8192 + (((2 * s + h) ^ ksw) << 4)); \
          sa = MFMA32(kf, qf[s], sa); \
        } \
        float v[16]; \
        if (MODE == 0) { \
_Pragma("unroll") \
          for (int c = 0; c < 2; ++c) { \
            const float4 kb0 = *(const float4*)(a.kbias + ks0 + 16 * c + 8 * h); \
            const float4 kb1 = *(const float4*)(a.kbias + ks0 + 16 * c + 8 * h + 4); \
            v[8 * c + 0] = sa[8 * c + 0] - kb0.x * LOG2E; v[8 * c + 1] = sa[8 * c + 1] - kb0.y * LOG2E; \
            v[8 * c + 2] = sa[8 * c + 2] - kb0.z * LOG2E; v[8 * c + 3] = sa[8 * c + 3] - kb0.w * LOG2E; \
            v[8 * c + 4] = sa[8 * c + 4] - kb1.x * LOG2E; v[8 * c + 5] = sa[8 * c + 5] - kb1.y * LOG2E; \
            v[8 * c + 6] = sa[8 * c + 6] - kb1.z * LOG2E; v[8 * c + 7] = sa[8 * c + 7] - kb1.w * LOG2E; \
          } \
          if (ks0 == q0) { \
_Pragma("unroll") \
            for (int e = 0; e < 16; ++e) if ((e & 7) + 8 * h + 16 * (e >> 3) > r) v[e] = -INFINITY; \
          } \
        } else { \
          const float* tp = tbl + (q0 - ks0) + r + 32 - 8 * h - 23; \
_Pragma("unroll") \
          for (int e = 0; e < 16; ++e) v[e] = sa[e] + tp[23 - ((e & 7) + 16 * (e >> 3))]; \
        } \
        float mx = v[0]; \
_Pragma("unroll") \
        for (int e = 1; e < 16; ++e) mx = fmaxf(mx, v[e]); \
        mx = xhalf_max(mx); \
        if (__ballot(mx > m + 8.f) != 0ull) { \
          const float mn = fmaxf(m, mx); \
          const float alpha = __builtin_amdgcn_exp2f(m - mn); \
          m = mn; \
          l *= alpha; \
_Pragma("unroll") \
          for (int dt = 0; dt < DVB; ++dt) \
_Pragma("unroll") \
            for (int e = 0; e < 16; ++e) o[dt][e] *= alpha; \
        } \
        float ps = 0.f; \
_Pragma("unroll") \
        for (int e = 0; e < 16; ++e) { v[e] = __builtin_amdgcn_exp2f(v[e] - m); ps += v[e]; } \
        l += ps; \
        bf16x8 pb[2]; \
_Pragma("unroll") \
        for (int s = 0; s < 2; ++s) { \
          const u32x4 u = {pack_bf2(v[8 * s + 0], v[8 * s + 1]), pack_bf2(v[8 * s + 2], v[8 * s + 3]), \
                           pack_bf2(v[8 * s + 4], v[8 * s + 5]), pack_bf2(v[8 * s + 6], v[8 * s + 7])}; \
          pb[s] = __builtin_bit_cast(bf16x8, u); \
        } \
_Pragma("unroll") \
        for (int dt = 0; dt < DVB; ++dt) \
_Pragma("unroll") \
          for (int s = 0; s < 2; ++s) { \
            const bf16x8 va = *(const bf16x8*)(st + vro + dt * 4096 + (((4 * sub + 2 * s + h) ^ vsw) << 4)); \
            o[dt] = MFMA32(va, pb[s], o[dt]); \
          } \
      } \
    } \
    __builtin_amdgcn_sched_barrier(0); \
    asm volatile("" ::: "memory"); \
    { \
      char* sn = smem + ((kt + 1) & 1) * STG; \
_Pragma("unroll") \
      for (int i = 0; i < 2; ++i) *(u32x4*)(sn + kwo + i * 8192) = RW[i]; \
_Pragma("unroll") \
      for (int i = 0; i < DVB / 2; ++i) *(u32x4*)(sn + vwo + i * 8192) = RVW[i]; \
    } \
    __syncthreads(); \
  }
  if constexpr (DVB == 4) {
  for (int kt2 = 0; kt2 < nkt; kt2 += 2) {
    ATT_TILE(kt2, rkB, rvB, rk, rv)
    if (kt2 + 1 < nkt) ATT_TILE(kt2 + 1, rk, rv, rkB, rvB)
  }
  } else {
  for (int kt = 0; kt < nkt; ++kt) {
    const int k0 = kt << 6;
    char* st = smem + (kt & 1) * STG;
    {
      const int kn = (kt + 1 < nkt) ? k0 + 64 : k0;
      const size_t kbo = (size_t)kn * (size_t)a.ldk * 2u, vbo = (size_t)kn * 2u;
#pragma unroll
      for (int i = 0; i < 2; ++i) rk[i] = *(const u32x4*)(Kb + (kbo + i * kst) + kvo);
#pragma unroll
      for (int i = 0; i < DVB / 2; ++i) rv[i] = *(const u32x4*)(Vb + (vbo + i * vst) + vvo);
    }
    asm volatile("" ::: "memory");
    __builtin_amdgcn_sched_barrier(0);
#pragma unroll
    for (int sub = 0; sub < 2; ++sub) {
      const int ks0 = k0 + 32 * sub;
      if (ks0 <= q0) {
        f32x16 sa;
#pragma unroll
        for (int e = 0; e < 16; ++e) sa[e] = 0.f;
#pragma unroll
        for (int s = 0; s < 8; ++s) {
          const bf16x8 kf = *(const bf16x8*)(st + kro + sub * 8192 + (((2 * s + h) ^ ksw) << 4));
          sa = MFMA32(kf, qf[s], sa);
        }
        float v[16];
        if (MODE == 0) {
#pragma unroll
          for (int c = 0; c < 2; ++c) {
            const float4 kb0 = *(const float4*)(a.kbias + ks0 + 16 * c + 8 * h);
            const float4 kb1 = *(const float4*)(a.kbias + ks0 + 16 * c + 8 * h + 4);
            v[8 * c + 0] = sa[8 * c + 0] - kb0.x * LOG2E; v[8 * c + 1] = sa[8 * c + 1] - kb0.y * LOG2E;
            v[8 * c + 2] = sa[8 * c + 2] - kb0.z * LOG2E; v[8 * c + 3] = sa[8 * c + 3] - kb0.w * LOG2E;
            v[8 * c + 4] = sa[8 * c + 4] - kb1.x * LOG2E; v[8 * c + 5] = sa[8 * c + 5] - kb1.y * LOG2E;
            v[8 * c + 6] = sa[8 * c + 6] - kb1.z * LOG2E; v[8 * c + 7] = sa[8 * c + 7] - kb1.w * LOG2E;
          }
          if (ks0 == q0) {
#pragma unroll
            for (int e = 0; e < 16; ++e) if ((e & 7) + 8 * h + 16 * (e >> 3) > r) v[e] = -INFINITY;
          }
        } else {
          const float* tp = tbl + (q0 - ks0) + r + 32 - 8 * h - 23;
#pragma unroll
          for (int e = 0; e < 16; ++e) v[e] = sa[e] + tp[23 - ((e & 7) + 16 * (e >> 3))];
        }
        float mx = v[0];
#pragma unroll
        for (int e = 1; e < 16; ++e) mx = fmaxf(mx, v[e]);
        mx = xhalf_max(mx);
        if (__ballot(mx > m + 8.f) != 0ull) {
          const float mn = fmaxf(m, mx);
          const float alpha = __builtin_amdgcn_exp2f(m - mn);
          m = mn;
          l *= alpha;
#pragma unroll
          for (int dt = 0; dt < DVB; ++dt)
#pragma unroll
            for (int e = 0; e < 16; ++e) o[dt][e] *= alpha;
        }
        float ps = 0.f;
#pragma unroll
        for (int e = 0; e < 16; ++e) { v[e] = __builtin_amdgcn_exp2f(v[e] - m); ps += v[e]; }
        l += ps;
        bf16x8 pb[2];
#pragma unroll
        for (int s = 0; s < 2; ++s) {
          const u32x4 u = {pack_bf2(v[8 * s + 0], v[8 * s + 1]), pack_bf2(v[8 * s + 2], v[8 * s + 3]),
                           pack_bf2(v[8 * s + 4], v[8 * s + 5]), pack_bf2(v[8 * s + 6], v[8 * s + 7])};
          pb[s] = __builtin_bit_cast(bf16x8, u);
        }
#pragma unroll
        for (int dt = 0; dt < DVB; ++dt)
#pragma unroll
          for (int s = 0; s < 2; ++s) {
            const bf16x8 va = *(const bf16x8*)(st + vro + dt * 4096 + (((4 * sub + 2 * s + h) ^ vsw) << 4));
            o[dt] = MFMA32(va, pb[s], o[dt]);
          }
      }
    }
    __builtin_amdgcn_sched_barrier(0);
    asm volatile("" ::: "memory");
    {
      char* sn = smem + ((kt + 1) & 1) * STG;
#pragma unroll
      for (int i = 0; i < 2; ++i) *(u32x4*)(sn + kwo + i * 8192) = rk[i];
#pragma unroll
      for (int i = 0; i < DVB / 2; ++i) *(u32x4*)(sn + vwo + i * 8192) = rv[i];
    }
    __syncthreads();
  }
  }
#undef ATT_TILE
  l_out = xhalf_sum(l);
}

DI void attn_store_bf16(const f32x16 (&o)[4], float linv, bf16_t* out_row  , int ldo) {
  const int lane = TID() & 63, r = lane & 31, h = lane >> 5;
  bf16_t* op = out_row + (size_t)r * ldo + 4 * h;
#pragma unroll
  for (int dt = 0; dt < 4; ++dt)
#pragma unroll
    for (int c = 0; c < 4; ++c)
      *(uint2*)(op + 32 * dt + 8 * c) = make_uint2(pack_bf2(o[dt][4 * c] * linv, o[dt][4 * c + 1] * linv),
                                                    pack_bf2(o[dt][4 * c + 2] * linv, o[dt][4 * c + 3] * linv));
}
template <int N, int B0>
DI void attn_store_f32(const f32x16 (&o)[N], float linv, float* out_row, int ldo) {
  const int lane = TID() & 63, r = lane & 31, h = lane >> 5;
  float* op = out_row + (size_t)r * ldo + 4 * h;
#pragma unroll
  for (int dt = 0; dt < 4; ++dt)
#pragma unroll
    for (int c = 0; c < 4; ++c)
      *(float4*)(op + 32 * dt + 8 * c) = make_float4(o[B0 + dt][4 * c] * linv, o[B0 + dt][4 * c + 1] * linv, o[B0 + dt][4 * c + 2] * linv, o[B0 + dt][4 * c + 3] * linv);
}

DI int t5_bucket(int n) {
  if (n < 16) return n;
  int lg = 16 + (int)(logf((float)n / 16.f) / 4.852030263919617f * 16.f);
  return lg < 31 ? lg : 31;
}

DI void phase_attn_even(const Params& p, char* smem) {
  const int tid = RTID(), wave = __builtin_amdgcn_readfirstlane(tid >> 6), bid = blockIdx.x, G = gridDim.x;
  const bf16_t* QK = (const bf16_t*)(p.ws + WS_QK);
  const bf16_t* VT = (const bf16_t*)(p.ws + WS_VT);
  bf16_t* ATT = (bf16_t*)(p.ws + WS_ATT);
  float* PCS = (float*)(p.ws + WS_SC);
  float* tbl = (float*)(smem + 98304);
  int cur_head = -1;
  for (int rnd = 0; rnd * G < 1024; ++rnd) {
    int item = rnd * G + ((rnd & 1) ? G - 1 - bid : bid);
    if (G == 256) {
      const int rc = rnd * 4 + (bid >> 6);
      const int gq = (int)((0x6767455432231010ull >> (4 * rc)) & 15ull), dq = (0x3CC3 >> rc) & 1;
      item = gq * 128 + (dq ? 0 : 64) + (bid & 63);
    }
    if (item >= 1024) break;
    const int g = item >> 7; int rem = item & 127;
    const int qb = 7 - g;
    const int q0b = qb * 256, q0 = q0b + 32 * wave;
    __syncthreads();
    if (rem >= 64) {
      rem -= 64;
      const int b = rem >> 3, hh = rem & 7;
      AttnPtrs a;
      a.Q = QK + (size_t)b * S_ * 4096 + hh * 128; a.ldq = 4096;
      a.K = a.Q + 1024; a.ldk = 4096;
      a.Vt = VT + (size_t)(hh * 128) * T_ + b * S_; a.ldv = T_;
      a.kbias = (const float*)(p.ws + WS_FCUM) + (size_t)(b * 8 + hh) * S_;
      f32x16 o[4]; float l;
      attn_block<0, 4>(a, q0b, smem, nullptr, o, l);
      attn_store_bf16(o, 1.f / l, ATT + (size_t)(b * S_ + q0) * D_ + hh * 128, D_);
    } else {
      const int b = rem >> 3, hh = (rem >> 1) & 3, mm = rem & 1;
      if (hh != cur_head) {
        for (int e = tid; e < 2080; e += RTHREADS) {
          const int dist = e - 32;
          tbl[e] = dist >= 0 ? p.rel_bias[t5_bucket(dist) * 16 + hh] * LOG2E : -INFINITY;
        }
        cur_head = hh;
      }
      AttnPtrs a;
      a.Q = QK + (size_t)b * S_ * 4096 + 2048 + hh * 256 + mm * 128; a.ldq = 4096;
      a.K = a.Q + 1024; a.ldk = 4096;
      a.Vt = VT + (size_t)(1024 + hh * 256) * T_ + b * S_; a.ldv = T_;
      a.kbias = nullptr;
      f32x16 o[8]; float l;
      attn_block<1, 8>(a, q0b, smem, tbl, o, l);
      const float linv = 1.f / l;
      attn_store_f32<8, 0>(o, linv, PCS + (((size_t)(mm * 2 + 0) * T_ + (size_t)(b * S_ + q0)) * 4 + hh) * 128, 512);
      attn_store_f32<8, 4>(o, linv, PCS + (((size_t)(mm * 2 + 1) * T_ + (size_t)(b * S_ + q0)) * 4 + hh) * 128, 512);
    }
  }
}

DI void phase_diff_combine(const Params& p) {
  const int lane = TID() & 63;
  const int gw = __builtin_amdgcn_readfirstlane((VBID() * NTHREADS + TID()) >> 6), nw = (VGRID() * NTHREADS) >> 6;
  const float* PCS = (const float*)(p.ws + WS_SC);
  bf16_t* ATT = (bf16_t*)(p.ws + WS_ATT);
  const float lam = ((const float*)(p.ws + WS_MISC))[0];
  const int half = lane >> 5, dl = (lane & 31) * 4;
  const float4 sg = *(const float4*)(p.even_diff_subln_gain + lane * 4);
  for (int it = gw; it < T_ * 4; it += nw) {
    const float4 a0 = *(const float4*)(PCS + ((size_t)(0 + half) * T_ * 4 + it) * 128 + dl);
    const float4 a1 = *(const float4*)(PCS + ((size_t)(2 + half) * T_ * 4 + it) * 128 + dl);
    float4 v;
    v.x = a0.x - lam * a1.x; v.y = a0.y - lam * a1.y; v.z = a0.z - lam * a1.z; v.w = a0.w - lam * a1.w;
    const float ss = wave_sum(v.x * v.x + v.y * v.y + v.z * v.z + v.w * v.w);
    const float rstd = rsqrtf(ss * (1.f / 256.f) + 1e-6f) * 0.8f;
    const int t = it >> 2, hh = it & 3;
    *(uint2*)(ATT + (size_t)t * D_ + 1024 + hh * 256 + lane * 4) =
        make_uint2(pack_bf2(v.x * rstd * sg.x, v.y * rstd * sg.y), pack_bf2(v.z * rstd * sg.z, v.w * rstd * sg.w));
  }
}

DI void phase_attn_odd(const Params& p, char* smem) {
  const int tid = RTID(), wave = __builtin_amdgcn_readfirstlane(tid >> 6), bid = blockIdx.x, G = gridDim.x;
  const bf16_t* QK = (const bf16_t*)(p.ws + WS_QK);
  const bf16_t* VT = (const bf16_t*)(p.ws + WS_VT);
  bf16_t* ATT = (bf16_t*)(p.ws + WS_ATT);
  float* tbl = (float*)(smem + 98304);
  int cur_head = -1;
  for (int rnd = 0; rnd * G < 1024; ++rnd) {
    const int item = rnd * G + ((rnd & 1) ? G - 1 - bid : bid);
    if (item >= 1024) break;
    const int g = item >> 7, rem = item & 127;
    const int qb = 7 - g, b = rem >> 4, hd = rem & 15;
    __syncthreads();
    if (hd != cur_head) {
      for (int e = tid; e < 2080; e += RTHREADS) {
        const int dist = e - 32;
        float val = -INFINITY;
        if (dist >= 0) {
          int cnt = 0;
          if (dist <= 128) cnt += 1;
          if (dist <= 512 && (dist & 3) == 0) cnt += 1;
          if ((dist & 15) == 0) cnt += 1;
          if (cnt > 0) val = (p.rel_bias[t5_bucket(dist) * 16 + hd] + __logf((float)cnt)) * LOG2E;
        }
        tbl[e] = val;
      }
      cur_head = hd;
    }
    const int q0b = qb * 256, q0 = q0b + 32 * wave;
    AttnPtrs a;
    a.Q = QK + (size_t)b * S_ * 4096 + hd * 128; a.ldq = 4096;
    a.K = a.Q + 2048; a.ldk = 4096;
    a.Vt = VT + (size_t)(hd * 128) * T_ + b * S_; a.ldv = T_;
    a.kbias = nullptr;
    f32x16 o[4]; float l;
    attn_block<1, 4>(a, q0b, smem, tbl, o, l);
    attn_store_bf16(o, 1.f / l, ATT + (size_t)(b * S_ + q0) * D_ + hd * 128, D_);
  }
}

DI float gelu_erf(float x) { return 0.5f * x * (1.f + erff(x * 0.7071067811865476f)); }

DI void ins16(float (&L)[16], float x) {
#pragma unroll
  for (int k = 15; k >= 1; --k) L[k] = __builtin_amdgcn_fmed3f(L[k - 1], L[k], x);
  L[0] = __builtin_amdgcn_fmed3f(__builtin_inff(), L[0], x);
}
DI float f_and_or(float v, unsigned mask, unsigned orv) { return __uint_as_float((__float_as_uint(v) & mask) | orv); }

DI void phase_peer_retrieve(const Params& p, char* smem) {
  const int tid = TID(), lane = tid & 63, wave = __builtin_amdgcn_readfirstlane(tid >> 6);
  const int gw = __builtin_amdgcn_readfirstlane((VBID() * NTHREADS + tid) >> 6), nw = (VGRID() * NTHREADS) >> 6;
  unsigned* wbuf = (unsigned*)(smem + wave * 9216);
  const bf16_t* SC = (const bf16_t*)(p.ws + WS_SC);
  int* IDX = (int*)(p.ws + WS_IDX);
  float* GATE = (float*)(p.ws + WS_GATE);
  const float NINF = -__builtin_inff();
  for (int it = gw; it < T_ / 8; it += nw) {
    const bf16_t* gsrc = SC + (size_t)it * (8 * 2048) + (lane >> 2) * 256 + (lane & 3) * 8;
    unsigned* wdst = wbuf + (lane >> 2) * 20 + (lane & 3) * 4;
    const unsigned* wsrc = wbuf + lane * 20;
    u32x4 stg[4];
#define PR_LOAD(CH) _Pragma("unroll") for (int i = 0; i < 4; ++i) stg[i] = *(const u32x4*)(gsrc + i * (16 * 256) + ((CH) >> 2) * 128 + ((CH) & 3) * 32);
    PR_LOAD(0)
    float A[16], B[16];
#pragma unroll
    for (int hf = 0; hf < 2; ++hf) {
      float L[16];
#pragma unroll
      for (int k = 0; k < 16; ++k) L[k] = NINF;
#pragma unroll 1
      for (int c = 0; c < 4; ++c) {
#pragma unroll
        for (int i = 0; i < 4; ++i) *(u32x4*)(wdst + i * (16 * 20)) = stg[i];
        { const int cn = hf * 4 + c + 1 < 7 ? hf * 4 + c + 1 : 7; PR_LOAD(cn) }
        u32x4 v[4];
#pragma unroll
        for (int k = 0; k < 4; ++k) v[k] = *(const u32x4*)(wsrc + 4 * k);
#pragma unroll
        for (int k = 0; k < 4; ++k)
#pragma unroll
          for (int e = 0; e < 4; ++e) {
            const unsigned w = v[k][e], id0 = (unsigned)(c * 32 + 8 * k + 2 * e);
            ins16(L, __uint_as_float((w << 16) | id0));
            ins16(L, __uint_as_float((w & 0xFFFF0000u) | (id0 + 1u)));
          }
      }
#pragma unroll
      for (int k = 0; k < 16; ++k) { if (hf == 0) A[k] = L[k]; else B[k] = L[k]; }
    }
#undef PR_LOAD
    unsigned* lut = wbuf + lane * 33;
#pragma unroll
    for (int k = 0; k < 16; ++k) {
      const unsigned ua = __float_as_uint(A[k]), ub = __float_as_uint(B[k]);
      lut[k] = (ua & 0x7Fu) << 7; lut[16 + k] = ub & 0x7Fu;
      A[k] = __uint_as_float(ua & 0xFFFFFF80u); B[k] = __uint_as_float(ub & 0xFFFFFF80u);
    }
    float C[16];
#pragma unroll
    for (int k = 0; k < 16; ++k) C[k] = NINF;
#pragma unroll
    for (int i = 0; i < 16; ++i)
#pragma unroll
      for (int j = 0; j < 16; ++j)
        if ((i + 1) * (j + 1) <= 16) ins16(C, f_and_or(A[i] + B[j], 0xFFFFFF00u, (unsigned)(i * 16 + j)));
    float ev[16], es = 0.f;
    int ids[16];
    const float mx = __uint_as_float(__float_as_uint(C[0]) & 0xFFFFFF00u);
#pragma unroll
    for (int k = 0; k < 16; ++k) {
      const unsigned uc = __float_as_uint(C[k]);
      ev[k] = __expf(__uint_as_float(uc & 0xFFFFFF00u) - mx);
      es += ev[k];
      ids[k] = (int)(lut[(uc >> 4) & 15u] + lut[16 + (uc & 15u)]);
    }
    const float inv = 1.f / es;
    int* ip = IDX + (size_t)it * (8 * 128) + lane * 16;
    float* gp = GATE + (size_t)it * (8 * 128) + lane * 16;
#pragma unroll
    for (int q = 0; q < 4; ++q) {
      *(int4*)(ip + 4 * q) = make_int4(ids[4 * q], ids[4 * q + 1], ids[4 * q + 2], ids[4 * q + 3]);
      *(float4*)(gp + 4 * q) = make_float4(ev[4 * q] * inv, ev[4 * q + 1] * inv, ev[4 * q + 2] * inv, ev[4 * q + 3] * inv);
    }
  }
}

DI unsigned peer_ticket_issue(unsigned* cnt) {
  unsigned v = 0;
  if ((TID() & 63) == 0) v = __hip_atomic_fetch_add(cnt, 1u, __ATOMIC_RELAXED, __HIP_MEMORY_SCOPE_AGENT);
  return v;
}
DI float oct_sum(float v) {
  v += __builtin_bit_cast(float, __builtin_amdgcn_update_dpp(0, __builtin_bit_cast(int, v), 0xB1, 0xF, 0xF, true));
  v += __builtin_bit_cast(float, __builtin_amdgcn_update_dpp(0, __builtin_bit_cast(int, v), 0x4E, 0xF, 0xF, true));
  v += __builtin_bit_cast(float, __builtin_amdgcn_update_dpp(0, __builtin_bit_cast(int, v), 0x141, 0xF, 0xF, true));
  return v;
}

DI unsigned swar_add8(unsigned x) { return ((x & 0x7F7F7F7Fu) + 0x08080808u) ^ (x & 0x80808080u); }
DI void phase_peer_dots(const Params& p, int layer, char* smem_all) {
  const int rtid = RTID(), lane = rtid & 63, rwave = __builtin_amdgcn_readfirstlane(rtid >> 6);
  const int g = lane >> 3, j = lane & 7;
  int* lidx_all = (int*)(smem_all + rwave * 8192);
  const unsigned char* H8 = (const unsigned char*)(p.ws + WS_H8);
  const int* IDX = (const int*)(p.ws + WS_IDX);
  float* PD = (float*)(p.ws + WS_PD);
  const unsigned char* PU = (const unsigned char*)(p.ws + WS_PEERU) + (size_t)layer * (8 * NEXP * 128);
  const float* SC4 = (const float*)(p.ws + WS_USC4) + (size_t)layer * (8 * NEXP);
  unsigned* tick = (unsigned*)(p.ws + WS_TICKETS) + (size_t)(layer * 2 + 0) * 16 * 16;
  const int xcc = xcc_id() & 7;
#pragma unroll 1
  for (int so = 0; so < 8; ++so) {
    const int s = (xcc + so) & 7;
    unsigned tv = peer_ticket_issue(tick + s * 16);
    for (;;) {
      const int c = __builtin_amdgcn_readfirstlane((int)tv);
      if (c >= T_ / 16) break;
      tv = peer_ticket_issue(tick + s * 16);
#pragma unroll
      for (int gi = 0; gi < 2; ++gi) {
        const int* ip = IDX + (size_t)(c * 16 + gi * 8 + g) * 128 + 16 * j;
#pragma unroll
        for (int i = 0; i < 4; ++i) *(uint4*)(lidx_all + gi * 1024 + g * 128 + 16 * j + 4 * i) = *(const uint4*)(ip + 4 * i);
      }
#pragma unroll 1
      for (int gi = 0; gi < 2; ++gi) {
      const int t0 = c * 16 + gi * 8;
      const int* lidx = lidx_all + gi * 1024;
      unsigned xl[4], xh[4];
      {
        const unsigned char* hp = H8 + (size_t)(t0 + g) * D_ + s * 256 + 32 * j;
        const u32x4 h0 = *(const u32x4*)hp, h1 = *(const u32x4*)(hp + 16);
        const unsigned d[8] = {h0.x, h0.y, h0.z, h0.w, h1.x, h1.y, h1.z, h1.w};
#pragma unroll
        for (int m = 0; m < 4; ++m) {
          xl[m] = (d[2 * m] & 0x0F0F0F0Fu) | ((d[2 * m + 1] & 0x0F0F0F0Fu) << 4);
          xh[m] = ((swar_add8(d[2 * m]) >> 4) & 0x0F0F0F0Fu) | (swar_add8(d[2 * m + 1]) & 0xF0F0F0F0u);
        }
      }
      const unsigned char* ub = PU + (size_t)s * (NEXP * 128);
      const float* scs = SC4 + (size_t)s * NEXP;
      float* pd = PD + ((size_t)s * T_ + t0 + g) * 128;
      const bool b2_ = (lane & 4) != 0, b1_ = (lane & 2) != 0, b0_ = (lane & 1) != 0;
      u32x4 ra[8], rb[8], rc[8];
      float sa, sb, sc;
#define PD_LOAD(R, S, KB) { _Pragma("unroll") for (int q = 0; q < 8; ++q) { const int id = lidx[g * 128 + (KB) + q]; R[q] = *(const u32x4*)(ub + (unsigned)(id * 128 + 16 * j)); } \
                            S = scs[lidx[g * 128 + (KB) + j]]; }
#define DPPI(X, CTRL) __builtin_amdgcn_update_dpp(0, (X), (CTRL), 0xF, 0xF, true)
#define PD_COMP(R, S, KB)                                                                         \
      {                                                                                           \
        int pp[8];                                                                                \
        _Pragma("unroll") for (int q = 0; q < 8; ++q) {                                           \
          int al = __builtin_amdgcn_sdot8((int)R[q].x, (int)xl[0], 0, false);                     \
          int ah = __builtin_amdgcn_sdot8((int)R[q].x, (int)xh[0], 0, false);                     \
          al = __builtin_amdgcn_sdot8((int)R[q].y, (int)xl[1], al, false);                        \
          ah = __builtin_amdgcn_sdot8((int)R[q].y, (int)xh[1], ah, false);                        \
          al = __builtin_amdgcn_sdot8((int)R[q].z, (int)xl[2], al, false);                        \
          ah = __builtin_amdgcn_sdot8((int)R[q].z, (int)xh[2], ah, false);                        \
          al = __builtin_amdgcn_sdot8((int)R[q].w, (int)xl[3], al, false);                        \
          ah = __builtin_amdgcn_sdot8((int)R[q].w, (int)xh[3], ah, false);                        \
          pp[q] = al + 16 * ah;                                                                   \
        }                                                                                         \
          \
        int q4[4], q2[2];                                                                         \
        _Pragma("unroll") for (int i = 0; i < 4; ++i) {                                           \
          const int keep = b2_ ? pp[4 + i] : pp[i], send = b2_ ? pp[i] : pp[4 + i];               \
          q4[i] = keep + DPPI(send, 0x141);                   \
        }                                                                                         \
        _Pragma("unroll") for (int i = 0; i < 2; ++i) {                                           \
          const int keep = b1_ ? q4[2 + i] : q4[i], send = b1_ ? q4[i] : q4[2 + i];               \
          q2[i] = keep + DPPI(send, 0x4E);                      \
        }                                                                                         \
        {                                                                                         \
          const int keep = b0_ ? q2[1] : q2[0], send = b0_ ? q2[0] : q2[1];                       \
          pd[(KB) + j] = (float)(keep + DPPI(send, 0xB1)) * S;     \
        }                                                                                         \
        __builtin_amdgcn_sched_barrier(0);                                                        \
      }
      PD_LOAD(ra, sa, 0)
      PD_LOAD(rb, sb, 8)
#pragma unroll 1
      for (int kb = 0; kb < 120; kb += 24) {
        PD_LOAD(rc, sc, kb + 16)
        PD_COMP(ra, sa, kb)
        PD_LOAD(ra, sa, kb + 24)
        PD_COMP(rb, sb, kb + 8)
        { const int kl = kb + 32 < 120 ? kb + 32 : 120; PD_LOAD(rb, sb, kl) }
        PD_COMP(rc, sc, kb + 16)
      }
      PD_COMP(ra, sa, 120)
#undef PD_LOAD
#undef PD_COMP
#undef DPPI
      }
    }
  }
}

DI void phase_peer_act(const Params& p, int layer) {
  const int rtid = RTID(), lane = rtid & 63;
  const int gw = __builtin_amdgcn_readfirstlane((int)((blockIdx.x * RTHREADS + rtid) >> 6)), nw = (int)(gridDim.x * RTHREADS) >> 6;
  const float* PD = (const float*)(p.ws + WS_PD);
  const int* IDX = (const int*)(p.ws + WS_IDX);
  const float* GATE = (const float*)(p.ws + WS_GATE);
  const float* HS = (const float*)(p.ws + WS_HS);
  unsigned short* ACTQ = (unsigned short*)(p.ws + WS_ACT);
  float* ACTS = (float*)(p.ws + WS_ACT + 4 * MiB);
  const float* VSC = (const float*)(p.ws + WS_PEERV) + (size_t)(2 + layer) * NEXP;
  for (int t = gw; t < T_; t += nw) {
    const size_t e = (size_t)t * 128 + 2 * lane;
    float2 a = make_float2(0.f, 0.f);
#pragma unroll
    for (int s2 = 0; s2 < 8; ++s2) { const float2 q = *(const float2*)(PD + (size_t)s2 * T_ * 128 + e); a.x += q.x; a.y += q.y; }
    const int2 id = *(const int2*)(IDX + e);
    const float2 gt = *(const float2*)(GATE + e);
    const float hs = HS[t];
    const float v0 = gt.x * gelu_erf(a.x * hs) * VSC[id.x], v1 = gt.y * gelu_erf(a.y * hs) * VSC[id.y];
    const float am = wave_max(fmaxf(fabsf(v0), fabsf(v1)));
    const float qs = am > 0.f ? 127.f / am : 1.f;
    const int q0 = (int)rintf(v0 * qs), q1 = (int)rintf(v1 * qs);
    ACTQ[(size_t)t * 64 + lane] = (unsigned short)((q0 & 255) | ((q1 & 255) << 8));
    if (lane == 0) ACTS[t] = am > 0.f ? am / 127.f : 1.f;
  }
}

DI void phase_peer_values(const Params& p, int layer, const float* gate2, char* smem_all) {
  const int rtid = RTID(), lane = rtid & 63, rwave = __builtin_amdgcn_readfirstlane(rtid >> 6);
  const int g = lane >> 3, j = lane & 7;
  int* lidx_all = (int*)(smem_all + rwave * 16384);
  unsigned* lact_all = (unsigned*)(smem_all + rwave * 16384 + 4096);
  const int* IDX = (const int*)(p.ws + WS_IDX);
  const unsigned* ACTQ = (const unsigned*)(p.ws + WS_ACT);
  const float* ACTS = (const float*)(p.ws + WS_ACT + 4 * MiB);
  const unsigned char* PV = (const unsigned char*)(p.ws + WS_PEERV8) + (size_t)layer * NEXP * D_;
  unsigned* tick = (unsigned*)(p.ws + WS_TICKETS) + (size_t)(layer * 2 + 1) * 16 * 16;
  const int xcc = xcc_id() & 7;
#pragma unroll 1
  for (int so = 0; so < 16; ++so) {
    const int s = ((xcc + (so >> 1)) & 7) + 8 * (so & 1);
    unsigned tv = peer_ticket_issue(tick + s * 16);
    for (;;) {
      const int c = __builtin_amdgcn_readfirstlane((int)tv);
      if (c >= T_ / 16) break;
      tv = peer_ticket_issue(tick + s * 16);
#pragma unroll
      for (int gi = 0; gi < 2; ++gi) {
        const int* ip = IDX + (size_t)(c * 16 + gi * 8 + g) * 128 + 16 * j;
#pragma unroll
        for (int i = 0; i < 4; ++i) *(uint4*)(lidx_all + gi * 2048 + g * 128 + 16 * j + 4 * i) = *(const uint4*)(ip + 4 * i);
        *(uint4*)(lact_all + gi * 2048 + g * 32 + 4 * j) = *(const uint4*)(ACTQ + (size_t)(c * 16 + gi * 8 + g) * 32 + 4 * j);
      }
#pragma unroll 1
      for (int gi = 0; gi < 2; ++gi) {
      const int t0 = c * 16 + gi * 8;
      const int* lidx = lidx_all + gi * 2048;
      const unsigned* lact = lact_all + gi * 2048;
      const unsigned char* vb = PV + (size_t)s * (NEXP * 128);
      int y[16];
#pragma unroll
      for (int i = 0; i < 16; ++i) y[i] = 0;
      u32x4 ra[8], rb[8];
      const int tq = t0 + g;
      bf16_t* rrow = (bf16_t*)(p.ws + WS_R16) + (size_t)tq * D_ + s * 128 + 16 * j;
      float* orow = p.out + (size_t)tq * D_ + s * 128 + 16 * j;
      const float* grow = gate2 + (size_t)(tq >> 11) * 12288 + s * 128 + 16 * j;
      u32x4 ia0 = *(const u32x4*)(lidx + g * 128), ia1 = *(const u32x4*)(lidx + g * 128 + 4);
#define PV_LOAD(R, KBN) { const unsigned ids_[8] = {ia0.x, ia0.y, ia0.z, ia0.w, ia1.x, ia1.y, ia1.z, ia1.w};                         \
        _Pragma("unroll") for (int q = 0; q < 8; ++q) R[q] = *(const u32x4*)(vb + (ids_[q] * 128u + 16u * (unsigned)j));              \
        ia0 = *(const u32x4*)(lidx + g * 128 + (KBN)); ia1 = *(const u32x4*)(lidx + g * 128 + (KBN) + 4); }
#define PV_QUAD(W0, W1, W2, W3, AQ, YB) {                                                                                             \
        const unsigned t0_ = __builtin_amdgcn_perm((W1), (W0), 0x05010400u), t1_ = __builtin_amdgcn_perm((W1), (W0), 0x07030602u);    \
        const unsigned t2_ = __builtin_amdgcn_perm((W3), (W2), 0x05010400u), t3_ = __builtin_amdgcn_perm((W3), (W2), 0x07030602u);    \
        y[(YB) + 0] = __builtin_amdgcn_sdot4((int)__builtin_amdgcn_perm(t2_, t0_, 0x05040100u), (int)(AQ), y[(YB) + 0], false);       \
        y[(YB) + 1] = __builtin_amdgcn_sdot4((int)__builtin_amdgcn_perm(t2_, t0_, 0x07060302u), (int)(AQ), y[(YB) + 1], false);       \
        y[(YB) + 2] = __builtin_amdgcn_sdot4((int)__builtin_amdgcn_perm(t3_, t1_, 0x05040100u), (int)(AQ), y[(YB) + 2], false);       \
        y[(YB) + 3] = __builtin_amdgcn_sdot4((int)__builtin_amdgcn_perm(t3_, t1_, 0x07060302u), (int)(AQ), y[(YB) + 3], false); }
#define PV_COMP(R, KB)                                                                            \
      { const unsigned aq0 = lact[g * 32 + ((KB) >> 2)], aq1 = lact[g * 32 + ((KB) >> 2) + 1];    \
        PV_QUAD(R[0].x, R[1].x, R[2].x, R[3].x, aq0, 0)  PV_QUAD(R[0].y, R[1].y, R[2].y, R[3].y, aq0, 4)   \
        PV_QUAD(R[0].z, R[1].z, R[2].z, R[3].z, aq0, 8)  PV_QUAD(R[0].w, R[1].w, R[2].w, R[3].w, aq0, 12)  \
        __builtin_amdgcn_sched_barrier(0);                                                        \
        PV_QUAD(R[4].x, R[5].x, R[6].x, R[7].x, aq1, 0)  PV_QUAD(R[4].y, R[5].y, R[6].y, R[7].y, aq1, 4)   \
        PV_QUAD(R[4].z, R[5].z, R[6].z, R[7].z, aq1, 8)  PV_QUAD(R[4].w, R[5].w, R[6].w, R[7].w, aq1, 12)  \
        __builtin_amdgcn_sched_barrier(0); }
      PV_LOAD(ra, 8)
#pragma unroll 1
      for (int kb = 0; kb < 128; kb += 16) {
        { const int kn = kb + 16 < 120 ? kb + 16 : 120; PV_LOAD(rb, kn) }
        PV_COMP(ra, kb)
        { const int kn = kb + 24 < 120 ? kb + 24 : 120; PV_LOAD(ra, kn) }
        PV_COMP(rb, kb + 8)
      }
#undef PV_LOAD
#undef PV_COMP
#undef PV_QUAD
      const float as = ACTS[tq];
      const u32x4 r0 = *(const u32x4*)rrow, r1 = *(const u32x4*)(rrow + 8);
      const unsigned rw[8] = {r0.x, r0.y, r0.z, r0.w, r1.x, r1.y, r1.z, r1.w};
      float res[16];
#pragma unroll
      for (int i = 0; i < 4; ++i) {
        float4 g0 = *(const float4*)(grow + 4 * i);
        g0.x *= as; g0.y *= as; g0.z *= as; g0.w *= as;
        res[4 * i + 0] = bf_lo(rw[2 * i]) + g0.x * (float)y[4 * i];     res[4 * i + 1] = bf_hi(rw[2 * i]) + g0.y * (float)y[4 * i + 1];
        res[4 * i + 2] = bf_lo(rw[2 * i + 1]) + g0.z * (float)y[4 * i + 2]; res[4 * i + 3] = bf_hi(rw[2 * i + 1]) + g0.w * (float)y[4 * i + 3];
      }
      if (layer == 0) {
        u32x4 w0, w1;
        w0.x = pack_bf2(res[0], res[1]); w0.y = pack_bf2(res[2], res[3]); w0.z = pack_bf2(res[4], res[5]); w0.w = pack_bf2(res[6], res[7]);
        w1.x = pack_bf2(res[8], res[9]); w1.y = pack_bf2(res[10], res[11]); w1.z = pack_bf2(res[12], res[13]); w1.w = pack_bf2(res[14], res[15]);
        *(u32x4*)rrow = w0; *(u32x4*)(rrow + 8) = w1;
      } else {
#pragma unroll
        for (int i = 0; i < 4; ++i) *(float4*)(orow + 4 * i) = make_float4(res[4 * i], res[4 * i + 1], res[4 * i + 2], res[4 * i + 3]);
      }
      }
    }
  }
}

#define XB_TMO      128
#define XB_XCNT(j)  (256  + 64 * (j))
#define XB_XSUB(j)  (1280 + 64 * (j))
#define XB_XGEN(j)  (2304 + 64 * (j))
#define XB_TOP      3328
#define XB_TOPGEN   3392
#define XCD_BAR_WORDS 3456
#define XB_SPIN_CAP (1u << 22)
#define LAS __attribute__((address_space(3)))
DI unsigned xb_ld(unsigned* p) { return __hip_atomic_load(p, __ATOMIC_RELAXED, __HIP_MEMORY_SCOPE_AGENT); }
DI unsigned xb_add(unsigned* p, unsigned v) { return __hip_atomic_fetch_add(p, v, __ATOMIC_RELAXED, __HIP_MEMORY_SCOPE_AGENT); }
DI unsigned xb_xcc_id() { return (unsigned)__builtin_amdgcn_s_getreg((3 << 11) | 20) & 0xFu; }
#define XB_SPIN(cond, bar) do { unsigned _sp = 0; while (cond) { __builtin_amdgcn_s_sleep(1); \
    if ((++_sp & 255u) == 0u) { if (xb_ld(&(bar)[XB_TMO])) break; if (_sp > XB_SPIN_CAP) { atomicAdd(&(bar)[XB_TMO], 1u); break; } } } } while (0)
struct XcdBarrier { unsigned* bar; unsigned x; volatile LAS unsigned* st; };
DI XcdBarrier xcd_barrier_post(unsigned* bar, volatile LAS unsigned* st) {
  XcdBarrier b; b.bar = bar; b.x = xb_xcc_id(); b.st = st;
  if (threadIdx.x == 0) (void)xb_add(&bar[XB_XCNT(b.x)], 1u);
  return b;
}
DI void xcd_barrier_complete(unsigned* bar, unsigned x, unsigned& nloc, unsigned& nx) {
  const unsigned G = gridDim.x * gridDim.y * gridDim.z;
  unsigned sum, cnt, mine, sp = 0u;
  for (;;) {
    sum = 0u; cnt = 0u; mine = 0u;
#pragma unroll
    for (unsigned j = 0; j < 16; ++j) { const unsigned c = xb_ld(&bar[XB_XCNT(j)]); sum += c; cnt += (c > 0u) ? 1u : 0u; mine = (j == x) ? c : mine; }
    if (sum == G) break;
    __builtin_amdgcn_s_sleep(1);
    if ((++sp & 255u) == 0u) { if (xb_ld(&bar[XB_TMO])) break; if (sp > XB_SPIN_CAP) { atomicAdd(&bar[XB_TMO], 1u); break; } }
  }
  nloc = mine > 0u ? mine : 1u; nx = cnt > 0u ? cnt : 1u;
}
DI void xcd_barrier(const XcdBarrier& b) {
  asm volatile("s_waitcnt vmcnt(0)" ::: "memory");
  __syncthreads();
  if (threadIdx.x == 0) {
    unsigned* bar = b.bar;
    __builtin_amdgcn_s_waitcnt(0);
    unsigned nloc = b.st[0], nx = b.st[1];
    if (nloc == 0u) { xcd_barrier_complete(bar, b.x, nloc, nx); b.st[0] = nloc; b.st[1] = nx; }
    const unsigned old = xb_add(&bar[XB_XSUB(b.x)], 1u);
    const unsigned gen = old / nloc;
    if (old + 1u == (gen + 1u) * nloc) {
      __builtin_amdgcn_fence(__ATOMIC_RELEASE, "agent");
      asm volatile("s_waitcnt vmcnt(0)" ::: "memory");
      const unsigned og = xb_add(&bar[XB_TOP], 1u);
      const unsigned tg = og / nx;
      if (og + 1u == (tg + 1u) * nx) xb_add(&bar[XB_TOPGEN], 1u);
      else XB_SPIN(xb_ld(&bar[XB_TOPGEN]) == tg, bar);
      __builtin_amdgcn_fence(__ATOMIC_ACQUIRE, "agent");
      xb_add(&bar[XB_XGEN(b.x)], 1u);
      asm volatile("s_waitcnt vmcnt(0)" ::: "memory");
    } else {
      XB_SPIN(xb_ld(&bar[XB_XGEN(b.x)]) == gen, bar);
      __builtin_amdgcn_fence(__ATOMIC_ACQUIRE, "agent");
      asm volatile("s_waitcnt vmcnt(0)" ::: "memory");
    }
  }
  __syncthreads();
}

constexpr int N_PHASES = 22;
template <class Epi>
DI void gemm256(char* smem_all, const bf16_t* A, const bf16_t* Bt, int M, int N, int K, const Epi& E) {
  pg8::Gemm g{A, Bt, M, N, K};
  pg8::StaticOrder S; S.init(M, N, (int)gridDim.x, (int)blockIdx.x);
  pg8::gemm_phase<Epi, pg8::StaticOrder, false>((PG8_LAS unsigned char*)smem_all, g, S, E, nullptr);
}
template <int ph>
DI void run_phase(const Params& p_in, char* smem, char* smem_all) {
  Params p = p_in;
  {
    size_t z = 0; asm volatile("" : "+s"(z)); p.ws = p_in.ws + z; p.out = p_in.out + z;
  }
  char* ws = p.ws;
  const float* mod = (const float*)(ws + WS_MOD);
  const bf16_t* H = (const bf16_t*)(ws + WS_H);
  if (ph == 0) { phase_prep(p, smem); return; }
  const int layer = ph >= 12 ? 1 : 0;
  const int lp = ph - (layer ? 12 : 1);
  int sub;
  if (layer == 0) sub = lp < 2 ? lp : lp + 1;
  else sub = lp < 2 ? lp : (lp == 2 ? 3 : lp + 2);
  const float* modl = mod + (size_t)layer * 8 * 12288;
  switch (sub) {
    case 0:
      if (layer == 0) phase_norm<true>(p, p.x, p.norm_gain, modl, modl + 2048);
      else phase_norm<false, false, true>(p, ws + WS_R16, p.norm_gain + 2 * 2048, modl, modl + 2048);
      break;
    case 1: {
      if (layer == 0) fox_cumsum(p);
      pg8::EpiQkNorm eq{(bf16_t*)(ws + WS_QK), 4096, layer ? p.odd_qk_gain : p.even_fox_qk_gain, layer ? p.odd_qk_gain : p.even_diff_qk_gain,
                        layer ? 4 : 3, (float*)(smem_all + 131072)};
      gemm256(smem_all, H, (const bf16_t*)(ws + (layer ? WS_WQK1 : WS_WQK0)), T_, 4096, 2048, eq);
      pg8::EpiBf16 ev{(bf16_t*)(ws + WS_VT), T_};
      gemm256(smem_all, (const bf16_t*)(ws + (layer ? WS_WV1 : WS_WV0)), H, 2048, T_, 2048, ev);
    } break;
    case 3:
      if (layer == 0) phase_attn_even(p, smem_all); else phase_attn_odd(p, smem_all);
      break;
    case 4: phase_diff_combine(p); break;
    case 5: {
      bf16_t* R16 = (bf16_t*)(ws + WS_R16);
      if (layer == 0) { pg8::EpiRes16<false> er{R16, 2048, p.x, modl + 2 * 2048};
        gemm256(smem_all, (const bf16_t*)(ws + WS_ATT), (const bf16_t*)(ws + WS_WO0), T_, 2048, 2048, er); }
      else { pg8::EpiRes16<true> er{R16, 2048, R16, modl + 2 * 2048};
        gemm256(smem_all, (const bf16_t*)(ws + WS_ATT), (const bf16_t*)(ws + WS_WO1), T_, 2048, 2048, er); }
    } break;
    case 6:
      phase_norm<false, true, true>(p, ws + WS_R16, p.norm_gain + (layer * 2 + 1) * 2048, modl + 3 * 2048, modl + 4 * 2048);
      break;
    case 7: {
      pg8::EpiBf16 es{(bf16_t*)(ws + WS_SC), 2048};
      gemm256(smem_all, H, (const bf16_t*)(ws + (layer ? WS_WQ1 : WS_WQ0)), T_, 2048, 2048, es);
    } break;
    case 8: phase_peer_retrieve(p, smem); break;
    case 9: phase_peer_dots(p, layer, smem_all); break;
    case 10: phase_peer_act(p, layer); break;
    case 11: phase_peer_values(p, layer, modl + 5 * 2048, smem_all); break;
  }
}

#if FUSED
template <int PH>
DI void run_all(const Params& p, char* smem, char* smem_all, const XcdBarrier& xb, cg::grid_group& grid) {
  if constexpr (PH < N_PHASES) {
    run_phase<PH>(p, smem, smem_all);
    if constexpr (PH + 1 < N_PHASES) xcd_barrier(xb);
    run_all<PH + 1>(p, smem, smem_all, xb, grid);
  }
}
__global__ void __launch_bounds__(RTHREADS, 2) mega_kernel(Params p) {
  extern __shared__ __attribute__((aligned(16))) char smem_all[];
  char* smem = smem_all + (RTID() >> 8) * HALF_SMEM;
  cg::grid_group grid = cg::this_grid();
  volatile LAS unsigned* xst = (volatile LAS unsigned*)(smem_all + SMEM_BYTES - 16);
  if (threadIdx.x == 0) { xst[0] = 0u; xst[1] = 0u; }
  __syncthreads();
  const XcdBarrier xb = xcd_barrier_post((unsigned*)(p.ws + WS_BAR), xst);
  if (p.ws == nullptr) grid.sync();
  run_all<0>(p, smem, smem_all, xb, grid);
}
#else
template <int PH>
__global__ void __launch_bounds__(RTHREADS, 2) phase_kernel(Params p) {
  extern __shared__ __attribute__((aligned(16))) char smem_all[];
  char* smem = smem_all + (RTID() >> 8) * HALF_SMEM;
  run_phase<PH>(p, smem, smem_all);
}
template <int PH>
static void launch_phases(const Params& p, int grid, hipStream_t stream) {
  if constexpr (PH < N_PHASES) {
    (void)hipFuncSetAttribute((const void*)phase_kernel<PH>, hipFuncAttributeMaxDynamicSharedMemorySize, SMEM_BYTES);
    phase_kernel<PH><<<grid, RTHREADS, SMEM_BYTES, stream>>>(p);
    launch_phases<PH + 1>(p, grid, stream);
  }
}
#endif

extern "C" void kernel_launch(void* const* d_in, const int* in_sizes, int n_in, void* d_out, int out_size, void* d_ws,
                              size_t ws_size, hipStream_t stream) {
  Params p{};
  p.x = (const float*)d_in[0]; p.c = (const float*)d_in[1]; p.rel_bias = (const float*)d_in[2];
  p.norm_gain = (const float*)d_in[3]; p.w_ada = (const float*)d_in[4]; p.b_ada = (const float*)d_in[5];
  p.even_w_in = (const float*)d_in[6]; p.even_b_forget = (const float*)d_in[7]; p.even_fox_qk_gain = (const float*)d_in[8];
  p.even_diff_qk_gain = (const float*)d_in[9]; p.even_diff_lambda = (const float*)d_in[10];
  p.even_diff_subln_gain = (const float*)d_in[11]; p.even_w_out = (const float*)d_in[12];
  p.odd_w_qkv = (const float*)d_in[13]; p.odd_qk_gain = (const float*)d_in[14]; p.odd_w_out = (const float*)d_in[15];
  p.peer_w_query = (const float*)d_in[16]; p.peer_sub_keys = (const float*)d_in[17];
  p.peer_u = (const float*)d_in[18]; p.peer_v = (const float*)d_in[19];
  p.out = (float*)d_out; p.ws = (char*)d_ws;
  if (ws_size < WS_END) { fprintf(stderr, "workspace too small: %zu < %zu\n", ws_size, (size_t)WS_END); return; }
#if FUSED
  static int grid_blocks = 0;
  if (!grid_blocks) {
    int dev = 0, cus = 0, per_cu = 0;
    (void)hipGetDevice(&dev);
    (void)hipDeviceGetAttribute(&cus, hipDeviceAttributeMultiprocessorCount, dev);
    (void)hipFuncSetAttribute((const void*)mega_kernel, hipFuncAttributeMaxDynamicSharedMemorySize, SMEM_BYTES);
    (void)hipOccupancyMaxActiveBlocksPerMultiprocessor(&per_cu, mega_kernel, RTHREADS, SMEM_BYTES);
    if (per_cu > 1) per_cu = 1;
    grid_blocks = cus * per_cu;
  }
  (void)hipMemsetAsync(p.ws + WS_BAR, 0, WS_BAR_BYTES, stream);
  void* args[] = {&p};
  hipError_t e = hipLaunchCooperativeKernel((void*)mega_kernel, dim3(grid_blocks), dim3(RTHREADS), args, SMEM_BYTES, stream);
  if (e != hipSuccess) fprintf(stderr, "cooperative launch failed: %s (grid %d)\n", hipGetErrorString(e), grid_blocks);
#else
  launch_phases<0>(p, 256, stream);
#endif
}
```

```cpp
#include <hip/hip_runtime.h>
#include <hip/hip_cooperative_groups.h>
#include <stdint.h>
#include <stdio.h>
namespace cg = cooperative_groups;

#ifndef FUSED
#define FUSED 1
#endif

#define DI __device__ __forceinline__
typedef unsigned short bf16_t;
typedef __attribute__((ext_vector_type(8))) short bf16x8;
typedef __attribute__((ext_vector_type(4))) short bf16x4;
typedef __attribute__((ext_vector_type(16))) float f32x16;
typedef __attribute__((ext_vector_type(2))) __bf16 bf2_t;
typedef __attribute__((ext_vector_type(2))) float f2_t;
typedef __attribute__((ext_vector_type(4))) unsigned u32x4;
#define MFMA32(a, b, c) __builtin_amdgcn_mfma_f32_32x32x16_bf16((a), (b), (c), 0, 0, 0)

constexpr int T_ = 16384;
constexpr int D_ = 2048;
constexpr int S_ = 2048;
constexpr int NB_ = 8;
constexpr int NEXP = 16384;
constexpr float LOG2E = 1.4426950408889634f;
constexpr int NTHREADS = 256;
constexpr int HALF_SMEM = 75776;
constexpr int RTHREADS = 512;
constexpr int SMEM_BYTES = 2 * HALF_SMEM + 16;

constexpr size_t MiB = 1048576;
constexpr size_t WS_PEERU = 0;
constexpr size_t WS_PEERV8 = WS_PEERU + 64 * MiB;
constexpr size_t WS_PEERV = WS_PEERU + 128 * MiB;
constexpr size_t WS_WQK0 = WS_PEERV + 128 * MiB;
constexpr size_t WS_WV0 = WS_WQK0 + 16 * MiB;
constexpr size_t WS_WQK1 = WS_WV0 + 8 * MiB;
constexpr size_t WS_WV1 = WS_WQK1 + 16 * MiB;
constexpr size_t WS_WO0 = WS_WV1 + 8 * MiB;
constexpr size_t WS_WO1 = WS_WO0 + 8 * MiB;
constexpr size_t WS_WQ0 = WS_WO1 + 8 * MiB;
constexpr size_t WS_WQ1 = WS_WQ0 + 8 * MiB;
constexpr size_t WS_SK = WS_WQ1 + 8 * MiB;
constexpr size_t WS_WFF = WS_SK + 131072;
constexpr size_t WS_MOD = WS_WFF + 65536;
constexpr size_t WS_LOGF = WS_MOD + 786432;
constexpr size_t WS_FCUM = WS_LOGF + 524288;
constexpr size_t WS_MISC = WS_FCUM + 524288;
constexpr size_t WS_H = WS_MISC + 65536;
constexpr size_t WS_QK = WS_H + 64 * MiB;
constexpr size_t WS_VT = WS_QK + 128 * MiB;
constexpr size_t WS_ATT = WS_VT + 64 * MiB;
constexpr size_t WS_SC = WS_ATT + 64 * MiB;
constexpr size_t WS_BAR = WS_SC + 128 * MiB;
constexpr size_t WS_TICKETS = WS_BAR + 16384;
constexpr size_t WS_BAR_BYTES = 16384 + 4096;
constexpr size_t WS_IDX = WS_ATT;
constexpr size_t WS_GATE = WS_ATT + 8 * MiB;
constexpr size_t WS_ACT = WS_ATT + 16 * MiB;
constexpr size_t WS_PD = WS_SC;
constexpr size_t WS_USC4 = WS_PEERV + 1 * MiB;
constexpr size_t WS_H8 = WS_QK;
constexpr size_t WS_HS = WS_QK + 32 * MiB;
constexpr size_t WS_R16 = WS_BAR + 65536;
constexpr size_t WS_H8A = WS_R16 + 64 * MiB;
constexpr size_t WS_WV8 = WS_H8A + 33 * MiB;
constexpr size_t WS_END = WS_WV8 + 9 * MiB;

struct Params {
  const float* x; const float* c; const float* rel_bias; const float* norm_gain; const float* w_ada; const float* b_ada;
  const float* even_w_in; const float* even_b_forget; const float* even_fox_qk_gain; const float* even_diff_qk_gain;
  const float* even_diff_lambda; const float* even_diff_subln_gain; const float* even_w_out;
  const float* odd_w_qkv; const float* odd_qk_gain; const float* odd_w_out;
  const float* peer_w_query; const float* peer_sub_keys; const float* peer_u; const float* peer_v;
  float* out; char* ws;
};

DI unsigned pack_bf2(float a, float b) { f2_t v = {a, b}; return __builtin_bit_cast(unsigned, __builtin_convertvector(v, bf2_t)); }
DI unsigned pack_i8x4(float a, float b, float c, float d) {
  const int ia = (int)rintf(a), ib = (int)rintf(b), ic = (int)rintf(c), id = (int)rintf(d);
  return (unsigned)(ia & 255) | ((unsigned)(ib & 255) << 8) | ((unsigned)(ic & 255) << 16) | ((unsigned)id << 24);
}
DI unsigned q4(float v) { int q = (int)rintf(v); q = q > 7 ? 7 : (q < -7 ? -7 : q); return (unsigned)q & 15u; }
DI unsigned pack_i4x4(float a, float b, float c, float d) { return q4(a) | (q4(b) << 8) | (q4(c) << 16) | (q4(d) << 24); }
DI bf16_t f2bf(float a) { return (bf16_t)(pack_bf2(a, 0.f) & 0xffffu); }
DI float bf_lo(unsigned u) { return __uint_as_float(u << 16); }
DI float bf_hi(unsigned u) { return __uint_as_float(u & 0xffff0000u); }
DI int RTID() { int t = threadIdx.x; asm volatile("" : "+v"(t)); return t; }
DI int TID() { return RTID() & 255; }
DI int VBID() { return __builtin_amdgcn_readfirstlane(blockIdx.x * 2 + (RTID() >> 8)); }
DI int VGRID() { return gridDim.x * 2; }
DI int xcc_id() { return (int)(__builtin_amdgcn_s_getreg((3 << 11) | 20) & 0xFu); }
DI int crow(int reg, int h) { return (reg & 3) + 8 * (reg >> 2) + 4 * h; }
DI float wave_sum(float v) {
#pragma unroll
  for (int o = 32; o >= 1; o >>= 1) v += __shfl_xor(v, o);
  return v;
}
DI float wave_max(float v) {
#pragma unroll
  for (int o = 32; o >= 1; o >>= 1) v = fmaxf(v, __shfl_xor(v, o));
  return v;
}

DI void transpose_tile(const float* __restrict__ src, int ld, int c0, int k0, bf16_t* __restrict__ dst_row0, char* smem) {
  float* tile = (float*)smem;
  const int tid = TID();
  const int ty = tid >> 4, tx = tid & 15;
#pragma unroll
  for (int i = 0; i < 4; ++i) {
    const int k = ty + 16 * i;
    const float4 v = *(const float4*)(src + (size_t)(k0 + k) * ld + c0 + 4 * tx);
    float* t = tile + k * 65 + 4 * tx;
    t[0] = v.x; t[1] = v.y; t[2] = v.z; t[3] = v.w;
  }
  __syncthreads();
  const int cc = tid >> 2, kc = (tid & 3) * 16;
  unsigned pk[8];
#pragma unroll
  for (int j = 0; j < 8; ++j) pk[j] = pack_bf2(tile[(kc + 2 * j) * 65 + cc], tile[(kc + 2 * j + 1) * 65 + cc]);
  uint4* d = (uint4*)(dst_row0 + (size_t)cc * 2048 + k0 + kc);
  d[0] = make_uint4(pk[0], pk[1], pk[2], pk[3]);
  d[1] = make_uint4(pk[4], pk[5], pk[6], pk[7]);
  __syncthreads();
}

DI void phase_prep(const Params& p, char* smem) {
  const int tid = TID(), bid = VBID(), G = VGRID();
  char* ws = p.ws;
  {
    float* cond = (float*)smem;
    bool have_cond = false;
    for (int item = bid; item < 384; item += G) {
      if (!have_cond) {
        for (int e = tid; e < NB_ * D_; e += NTHREADS) {
          const int b = e >> 11, d = e & 2047;
          const float v = p.c[e];
          cond[d * 8 + b] = v / (1.f + __expf(-v));
        }
        have_cond = true;
        __syncthreads();
      }
      const int i = item / 192, n = (item % 192) * 64 + (tid & 63);
      const int w = tid >> 6;
      const float* wp = p.w_ada + (size_t)i * D_ * 12288 + n;
      float acc[8];
#pragma unroll
      for (int b = 0; b < 8; ++b) acc[b] = 0.f;
#pragma unroll 8
      for (int d = w; d < D_; d += 4) {
        const float wv = wp[(size_t)d * 12288];
        const float4 c0 = *(const float4*)(cond + d * 8), c1 = *(const float4*)(cond + d * 8 + 4);
        acc[0] += c0.x * wv; acc[1] += c0.y * wv; acc[2] += c0.z * wv; acc[3] += c0.w * wv;
        acc[4] += c1.x * wv; acc[5] += c1.y * wv; acc[6] += c1.z * wv; acc[7] += c1.w * wv;
      }
      float* red = (float*)(smem + 65536);
#pragma unroll
      for (int b = 0; b < 8; ++b) red[(w * 64 + (tid & 63)) * 8 + b] = acc[b];
      __syncthreads();
      if (tid < 64) {
        float* mod = (float*)(ws + WS_MOD);
#pragma unroll
        for (int b = 0; b < 8; ++b) {
          const float s = red[(0 * 64 + tid) * 8 + b] + red[(1 * 64 + tid) * 8 + b] + red[(2 * 64 + tid) * 8 + b] + red[(3 * 64 + tid) * 8 + b];
          mod[((size_t)i * 8 + b) * 12288 + n] = s + p.b_ada[i * 12288 + n];
        }
      }
      __syncthreads();
    }
    __syncthreads();
  }
  {
    bf16_t* wqk0 = (bf16_t*)(ws + WS_WQK0); bf16_t* wv0 = (bf16_t*)(ws + WS_WV0);
    bf16_t* wqk1 = (bf16_t*)(ws + WS_WQK1); bf16_t* wv1 = (bf16_t*)(ws + WS_WV1);
    for (int item = bid; item < 256 * 32; item += G) {
      const int ct = item >> 5, kt = item & 31;
      const float* src; int ld, c0; bf16_t* dst;
      if (ct < 96) {
        const int seg = ct >> 4, cl = (ct & 15) * 64;
        src = p.even_w_in; ld = 6152;
        c0 = (seg < 3 ? seg * 1024 : 3080 + (seg - 3) * 1024) + cl;
        if (seg == 0) dst = wqk0 + (size_t)cl * 2048;
        else if (seg == 1) dst = wqk0 + (size_t)(1024 + cl) * 2048;
        else if (seg == 2) dst = wv0 + (size_t)cl * 2048;
        else if (seg == 3) dst = wqk0 + (size_t)(2048 + cl) * 2048;
        else if (seg == 4) dst = wqk0 + (size_t)(3072 + cl) * 2048;
        else dst = wv0 + (size_t)(1024 + cl) * 2048;
      } else if (ct < 192) {
        const int cl = (ct - 96) * 64;
        src = p.odd_w_qkv; ld = 6144; c0 = cl;
        dst = cl < 4096 ? wqk1 + (size_t)cl * 2048 : wv1 + (size_t)(cl - 4096) * 2048;
      } else {
        const int mi = (ct - 192) >> 5, cl = ((ct - 192) & 31) * 64;
        ld = 2048; c0 = cl;
        if (mi == 0) { src = p.even_w_out; dst = (bf16_t*)(ws + WS_WO0); }
        else { src = p.odd_w_out; dst = (bf16_t*)(ws + WS_WO1); }
        dst += (size_t)cl * 2048;
      }
      transpose_tile(src, ld, c0, kt * 64, dst, smem);
    }
  }
  {
    const int lane = tid & 63;
    const int gw = __builtin_amdgcn_readfirstlane((bid * NTHREADS + tid) >> 6), nw = (G * NTHREADS) >> 6;
    float* scl = (float*)(ws + WS_PEERV);
    float4 nx[8];
    {
      const int r0 = gw < 4 * NEXP ? gw : 0;
      const float* s0 = ((r0 >> 15) ? p.peer_v : p.peer_u) + (size_t)(r0 & 32767) * D_;
#pragma unroll
      for (int i = 0; i < 2; ++i)
#pragma unroll
        for (int j = 0; j < 4; ++j) nx[4 * i + j] = *(const float4*)(s0 + lane * 16 + 1024 * i + 4 * j);
    }
    for (int row = gw; row < 4 * NEXP; row += nw) {
      const int tab = row >> 15, rr = row & 32767;
      unsigned char* dst = (unsigned char*)(ws + (tab ? WS_PEERV8 : WS_PEERU)) + (size_t)(rr >> 14) * NEXP * D_ + (size_t)(rr & (NEXP - 1)) * 128;
      float4 v[8];
      float am = 0.f;
#pragma unroll
      for (int i = 0; i < 8; ++i) v[i] = nx[i];
      {
        const int rn = row + nw < 4 * NEXP ? row + nw : row;
        const float* sn = ((rn >> 15) ? p.peer_v : p.peer_u) + (size_t)(rn & 32767) * D_;
#pragma unroll
        for (int i = 0; i < 2; ++i)
#pragma unroll
          for (int j = 0; j < 4; ++j) nx[4 * i + j] = *(const float4*)(sn + lane * 16 + 1024 * i + 4 * j);
        asm volatile("" ::: "memory");
      }
#pragma unroll
      for (int i = 0; i < 8; ++i) am = fmaxf(am, fmaxf(fmaxf(fabsf(v[i].x), fabsf(v[i].y)), fmaxf(fabsf(v[i].z), fabsf(v[i].w))));
      if (!tab) {
        unsigned char* d4 = (unsigned char*)(ws + WS_PEERU) + (size_t)(rr >> 14) * (8 * NEXP * 128) + (size_t)(rr & (NEXP - 1)) * 128 + (lane & 15) * 8;
        float* sc4 = (float*)(ws + WS_USC4) + (size_t)(rr >> 14) * (8 * NEXP) + (rr & (NEXP - 1));
#pragma unroll
        for (int i = 0; i < 2; ++i) {
          float bm = 0.f;
#pragma unroll
          for (int j = 0; j < 4; ++j) bm = fmaxf(bm, fmaxf(fmaxf(fabsf(v[4 * i + j].x), fabsf(v[4 * i + j].y)), fmaxf(fabsf(v[4 * i + j].z), fabsf(v[4 * i + j].w))));
#pragma unroll
          for (int o = 1; o < 16; o <<= 1) bm = fmaxf(bm, __shfl_xor(bm, o));
          const float sc = bm > 0.f ? 7.5f / bm : 1.f;
          const int slice = 4 * i + (lane >> 4);
          if ((lane & 15) == 0) sc4[(size_t)slice * NEXP] = bm > 0.f ? bm / 7.5f : 1.f;
          unsigned w[2];
#pragma unroll
          for (int gq = 0; gq < 2; ++gq) {
            const float4 a = v[4 * i + 2 * gq], b = v[4 * i + 2 * gq + 1];
            const unsigned lo = pack_i4x4(a.x * sc, a.y * sc, a.z * sc, a.w * sc);
            const unsigned hi = pack_i4x4(b.x * sc, b.y * sc, b.z * sc, b.w * sc);
            w[gq] = lo | (hi << 4);
          }
          *(uint2*)(d4 + (size_t)slice * (NEXP * 128)) = make_uint2(w[0], w[1]);
        }
        continue;
      }
      am = wave_max(am);
      const float sc = am > 0.f ? 127.f / am : 1.f;
      if (lane == 0) scl[row] = am > 0.f ? am / 127.f : 1.f;
#pragma unroll
      for (int i = 0; i < 2; ++i) {
        unsigned w[4];
#pragma unroll
        for (int j = 0; j < 4; ++j) w[j] = pack_i8x4(v[4 * i + j].x * sc, v[4 * i + j].y * sc, v[4 * i + j].z * sc, v[4 * i + j].w * sc);
        *(uint4*)(dst + (size_t)((lane >> 3) + 8 * i) * (NEXP * 128) + (lane & 7) * 16) = make_uint4(w[0], w[1], w[2], w[3]);
      }
    }
  }
  {
    float* sks = (float*)smem;
    float* wqs = (float*)(smem + 33792);
    const int tn = tid >> 4, tk = tid & 15;
    for (int item = bid; item < 2048; item += G) {
      const int layer = item >> 10, hp = (item >> 6) & 15, nt = (item >> 5) & 1, kt = item & 31;
      const float* sk = p.peer_sub_keys + ((size_t)(layer * 2 + (hp & 1)) * 128 + nt * 64) * 128;
      const float* wq = p.peer_w_query + (size_t)layer * 2048 * 2048 + (size_t)(kt * 64) * 2048 + hp * 128;
      __syncthreads();
#pragma unroll
      for (int i = 0; i < 8; ++i) {
        const int idx = tid + 256 * i, row = idx >> 5, c4 = (idx & 31) * 4;
        *(float4*)(sks + row * 132 + c4) = *(const float4*)(sk + (size_t)row * 128 + c4);
        *(float4*)(wqs + row * 132 + c4) = *(const float4*)(wq + (size_t)row * 2048 + c4);
      }
      __syncthreads();
      float acc[4][4];
#pragma unroll
      for (int i = 0; i < 4; ++i)
#pragma unroll
        for (int j = 0; j < 4; ++j) acc[i][j] = 0.f;
#pragma unroll 4
      for (int d = 0; d < 128; d += 4) {
        float4 a[4], b[4];
#pragma unroll
        for (int i = 0; i < 4; ++i) { a[i] = *(const float4*)(sks + (tn + 16 * i) * 132 + d); b[i] = *(const float4*)(wqs + (tk + 16 * i) * 132 + d); }
#pragma unroll
        for (int i = 0; i < 4; ++i)
#pragma unroll
          for (int j = 0; j < 4; ++j) acc[i][j] += a[i].x * b[j].x + a[i].y * b[j].y + a[i].z * b[j].z + a[i].w * b[j].w;
      }
      bf16_t* dst = (bf16_t*)(ws + (layer ? WS_WQ1 : WS_WQ0)) + (size_t)(hp * 128 + nt * 64) * 2048 + kt * 64;
#pragma unroll
      for (int i = 0; i < 4; ++i)
#pragma unroll
        for (int j = 0; j < 4; ++j) dst[(size_t)(tn + 16 * i) * 2048 + tk + 16 * j] = f2bf(acc[i][j]);
    }
    __syncthreads();
  }
  if (bid == G - 1) {
    float* wff = (float*)(ws + WS_WFF);
    for (int e = tid; e < 2048 * 8; e += NTHREADS) wff[e] = p.even_w_in[(size_t)(e >> 3) * 6152 + 3072 + (e & 7)];
    if (tid < 64) {
      const float* l = p.even_diff_lambda;
      float s1 = l[tid] * l[128 + tid] + l[64 + tid] * l[128 + 64 + tid];
      float s2 = l[256 + tid] * l[384 + tid] + l[256 + 64 + tid] * l[384 + 64 + tid];
      s1 = wave_sum(s1); s2 = wave_sum(s2);
      if (tid == 0) ((float*)(ws + WS_MISC))[0] = expf(s1) - expf(s2) + 0.2f;
    }
  }
}

template <bool FF, int Q8 = 0, bool IN16 = false>
DI void phase_norm(const Params& p, const void* __restrict__ xin_, const float* __restrict__ gain,
                   const float* __restrict__ sh, const float* __restrict__ sc  ) {
  const int lane = TID() & 63;
  const int gw = __builtin_amdgcn_readfirstlane((VBID() * NTHREADS + TID()) >> 6), nw = (VGRID() * NTHREADS) >> 6;
  bf16_t* H = (bf16_t*)(p.ws + WS_H);
  for (int t = gw; t < T_; t += nw) {
    const int b = t >> 11;
    float4 v[8];
    float ss = 0.f;
    if (IN16) {
      const bf16_t* xr = (const bf16_t*)xin_ + (size_t)t * D_;
#pragma unroll
      for (int i = 0; i < 8; ++i) { const uint2 w = *(const uint2*)(xr + lane * 4 + 256 * i); v[i] = make_float4(bf_lo(w.x), bf_hi(w.x), bf_lo(w.y), bf_hi(w.y)); }
    } else {
      const float* xr = (const float*)xin_ + (size_t)t * D_;
#pragma unroll
      for (int i = 0; i < 8; ++i) v[i] = *(const float4*)(xr + lane * 4 + 256 * i);
    }
#pragma unroll
    for (int i = 0; i < 8; ++i) ss += v[i].x * v[i].x + v[i].y * v[i].y + v[i].z * v[i].z + v[i].w * v[i].w;
    ss = wave_sum(ss);
    const float rstd = rsqrtf(ss * (1.f / 2048.f) + 1e-6f);
    float ff[8];
    if (FF) {
#pragma unroll
      for (int j = 0; j < 8; ++j) ff[j] = 0.f;
    }
    float am = 0.f;
#pragma unroll
    for (int i = 0; i < 8; ++i) {
      const int c = lane * 4 + 256 * i;
      const float4 g = *(const float4*)(gain + c);
      const float4 s1 = *(const float4*)(sc + (size_t)b * 12288 + c);
      const float4 s0 = *(const float4*)(sh + (size_t)b * 12288 + c);
      float4 h;
      h.x = v[i].x * rstd * g.x * (1.f + s1.x) + s0.x;
      h.y = v[i].y * rstd * g.y * (1.f + s1.y) + s0.y;
      h.z = v[i].z * rstd * g.z * (1.f + s1.z) + s0.z;
      h.w = v[i].w * rstd * g.w * (1.f + s1.w) + s0.w;
      *(uint2*)(H + (size_t)t * D_ + c) = make_uint2(pack_bf2(h.x, h.y), pack_bf2(h.z, h.w));
      if (Q8) { v[i] = h; am = fmaxf(am, fmaxf(fmaxf(fabsf(h.x), fabsf(h.y)), fmaxf(fabsf(h.z), fabsf(h.w)))); }
      if (FF) {
        const float* wff = (const float*)(p.ws + WS_WFF) + c * 8;
        const float hv[4] = {h.x, h.y, h.z, h.w};
#pragma unroll
        for (int e = 0; e < 4; ++e) {
          const float4 w0 = *(const float4*)(wff + e * 8), w1 = *(const float4*)(wff + e * 8 + 4);
          ff[0] += hv[e] * w0.x; ff[1] += hv[e] * w0.y; ff[2] += hv[e] * w0.z; ff[3] += hv[e] * w0.w;
          ff[4] += hv[e] * w1.x; ff[5] += hv[e] * w1.y; ff[6] += hv[e] * w1.z; ff[7] += hv[e] * w1.w;
        }
      }
    }
    if (Q8) {
      am = wave_max(am);
      const float qs = am > 0.f ? 119.f / am : 1.f;
      unsigned char* h8 = (unsigned char*)(p.ws + (Q8 == 1 ? WS_H8 : WS_H8A)) + (size_t)t * D_ + lane * 4;
#pragma unroll
      for (int i = 0; i < 8; ++i) *(unsigned*)(h8 + 256 * i) = pack_i8x4(v[i].x * qs, v[i].y * qs, v[i].z * qs, v[i].w * qs);
      if (lane == 0) ((float*)(p.ws + (Q8 == 1 ? WS_HS : WS_H8A + 32 * MiB)))[t] = am > 0.f ? am / 119.f : 1.f;
    }
    if (FF) {
#pragma unroll
      for (int j = 0; j < 8; ++j) ff[j] = wave_sum(ff[j]);
      if (lane < 8) {
        float z = ff[0];
#pragma unroll
        for (int j = 1; j < 8; ++j) z = (lane == j) ? ff[j] : z;
        z += p.even_b_forget[lane];
        const float lf = fminf(z, 0.f) - log1pf(__expf(-fabsf(z)));
        ((float*)(p.ws + WS_LOGF))[(size_t)t * 8 + lane] = lf;
      }
    }
  }
}

DI void quant_wv(const Params& p) {
  const int lane = TID() & 63;
  const int gw = __builtin_amdgcn_readfirstlane((VBID() * NTHREADS + TID()) >> 6), nw = (VGRID() * NTHREADS) >> 6;
  for (int row = 2048 + gw; row < 4096; row += nw) {
    const int layer = row >> 11, d = row & 2047;
    const bf16_t* src = (const bf16_t*)(p.ws + (layer ? WS_WV1 : WS_WV0)) + (size_t)d * 2048 + lane * 32;
    u32x4 w[4];
#pragma unroll
    for (int i = 0; i < 4; ++i) w[i] = *(const u32x4*)(src + 8 * i);
    float f[32];
    float am = 0.f;
#pragma unroll
    for (int i = 0; i < 4; ++i)
#pragma unroll
      for (int j = 0; j < 4; ++j) { f[8 * i + 2 * j] = bf_lo(w[i][j]); f[8 * i + 2 * j + 1] = bf_hi(w[i][j]); am = fmaxf(am, fmaxf(fabsf(f[8 * i + 2 * j]), fabsf(f[8 * i + 2 * j + 1]))); }
    am = wave_max(am);
    const float sc = am > 0.f ? 127.f / am : 1.f;
    unsigned q[8];
#pragma unroll
    for (int i = 0; i < 8; ++i) q[i] = pack_i8x4(f[4 * i] * sc, f[4 * i + 1] * sc, f[4 * i + 2] * sc, f[4 * i + 3] * sc);
    unsigned char* dst = (unsigned char*)(p.ws + WS_WV8) + (size_t)row * 2048 + lane * 32;
    *(u32x4*)dst = (u32x4){q[0], q[1], q[2], q[3]};
    *(u32x4*)(dst + 16) = (u32x4){q[4], q[5], q[6], q[7]};
    if (lane == 0) ((float*)(p.ws + WS_WV8 + 8 * MiB))[row] = am > 0.f ? am / 127.f : 1.f;
  }
}

DI void fox_cumsum(const Params& p) {
  const int lane = TID() & 63;
  const int gw = __builtin_amdgcn_readfirstlane((VBID() * NTHREADS + TID()) >> 6), nw = (VGRID() * NTHREADS) >> 6;
  const float* lf = (const float*)(p.ws + WS_LOGF);
  float* fc = (float*)(p.ws + WS_FCUM);
  for (int it = gw; it < 64; it += nw) {
    const int b = it >> 3, hh = it & 7;
    float v[32];
    float tot = 0.f;
#pragma unroll
    for (int j = 0; j < 32; ++j) { tot += lf[(size_t)(b * S_ + lane * 32 + j) * 8 + hh]; v[j] = tot; }
    float inc = tot;
#pragma unroll
    for (int o = 1; o < 64; o <<= 1) { const float n = __shfl_up(inc, o); if (lane >= o) inc += n; }
    const float base = inc - tot;
#pragma unroll
    for (int j = 0; j < 32; ++j) fc[(size_t)it * S_ + lane * 32 + j] = v[j] + base;
  }
}

namespace pg8 {
#define PG8_LAS __attribute__((address_space(3)))
typedef float f32x4 __attribute__((ext_vector_type(4)));
constexpr int BM = 256, BK = 64, HALF = 128, HTB = HALF * BK * 2  , STAGE_BYTES = 8 * HTB, NXCD = 8, WGM = 8;

__host__ __device__ __forceinline__ int lds_byte(int r, int c) { const int st = (r >> 4) * 2 + (c >> 5), rr = r & 15, cc = c & 31, ob = rr * 64 + cc * 2; return st * 1024 + (ob ^ (((ob >> 9) & 1) << 5)); }
__host__ __device__ __forceinline__ void stage_rc(int b, int& R, int& C) { const int st = b / 1024, sb = b % 1024, swz = sb ^ (((sb >> 9) & 1) << 5); R = (st >> 1) * 16 + swz / 64; C = (st & 1) * 32 + (swz % 64) / 2; }
__host__ __device__ __forceinline__ int perm32(int rho) { const int n = rho >> 4, i = rho & 15; return 8 * (i >> 2) + 4 * n + (i & 3); }

struct Unit { int pm, pn; };
struct Gemm { const bf16_t* A; const bf16_t* Bt; int M, N, K; };

struct StaticOrder {
    int nM, nN, nwg, G, c;
    __host__ __device__ void init(int M, int N, int G_, int c_) { nM = M / BM; nN = N / BM; nwg = nM * nN; G = G_; c = c_; }
    __host__ __device__ bool next(int i, Unit& u) const {
        const long L = (long)i * G + c; if (L >= nwg) return false;
        int wgid = (int)L; { const int q = nwg / NXCD, r = nwg % NXCD, xcd = wgid % NXCD, off = wgid / NXCD; wgid = (xcd < r ? xcd * (q + 1) : r * (q + 1) + (xcd - r) * q) + off; }
        const int nig = WGM * nN, gid = wgid / nig, fm = gid * WGM, gsz = (nM - fm) < WGM ? (nM - fm) : WGM;
        u.pm = fm + ((wgid % nig) % gsz); u.pn = (wgid % nig) / gsz; return true;
    }
    __device__ __forceinline__ void a_ready(const Unit&) const {}
    __device__ __forceinline__ void done(const Unit&) const {}
};

struct EpiF32 {
    static constexpr bool PERM = false, AFTER_DRAIN = false, I8 = false;
    float* C; int ldc; const float* bias;
    __device__ __forceinline__ void operator()(const f32x4 (&acc)[2][2][4][2], const Unit& u, int wr, int wc, int fr, int fq) const {
        const int row0 = u.pm * BM + wr * 64 + fr, col0 = u.pn * BM + wc * 32 + 4 * fq;
        f32x4 bv[2][2];
#pragma unroll
        for (int bj = 0; bj < 2; ++bj)
#pragma unroll
            for (int n = 0; n < 2; ++n) bv[bj][n] = bias ? *(const f32x4*)(bias + col0 + bj * HALF + n * 16) : (f32x4){0.f, 0.f, 0.f, 0.f};
#pragma unroll
        for (int ai = 0; ai < 2; ++ai)
#pragma unroll
            for (int m = 0; m < 4; ++m) { float* rowp = C + (size_t)(row0 + ai * HALF + m * 16) * ldc + col0;
#pragma unroll
                for (int bj = 0; bj < 2; ++bj)
#pragma unroll
                    for (int n = 0; n < 2; ++n) *(f32x4*)(rowp + bj * HALF + n * 16) = acc[ai][bj][m][n] + bv[bj][n]; }
    }
};
struct EpiBf16 {
    static constexpr bool PERM = true, AFTER_DRAIN = false, I8 = false;
    bf16_t* O; int ldc;
    __device__ __forceinline__ void operator()(const f32x4 (&acc)[2][2][4][2], const Unit& u, int wr, int wc, int fr, int fq) const {
        const int row0 = u.pm * BM + wr * 64 + fr, col0 = u.pn * BM + wc * 32 + 8 * fq;
#pragma unroll
        for (int ai = 0; ai < 2; ++ai)
#pragma unroll
            for (int m = 0; m < 4; ++m) { bf16_t* rowp = O + (size_t)(row0 + ai * HALF + m * 16) * ldc + col0;
#pragma unroll
                for (int bj = 0; bj < 2; ++bj) { const f32x4 v0 = acc[ai][bj][m][0], v1 = acc[ai][bj][m][1];
                    u32x4 w; w.x = pack_bf2(v0[0], v0[1]); w.y = pack_bf2(v0[2], v0[3]); w.z = pack_bf2(v1[0], v1[1]); w.w = pack_bf2(v1[2], v1[3]);
                    *(u32x4*)(rowp + bj * HALF) = w; } }
    }
};
struct EpiQkNorm {
    static constexpr bool PERM = true, AFTER_DRAIN = false, I8 = false;
    bf16_t* O; int ldc; const float* gainA; const float* gainB; int gshift; float* red;
    __device__ __forceinline__ void operator()(const f32x4 (&acc)[2][2][4][2], const Unit& u, int wr, int wc, int fr, int fq) const {
        float ss[2][4][2];
#pragma unroll
        for (int ai = 0; ai < 2; ++ai)
#pragma unroll
            for (int m = 0; m < 4; ++m)
#pragma unroll
                for (int bj = 0; bj < 2; ++bj) {
                    const f32x4 v0 = acc[ai][bj][m][0], v1 = acc[ai][bj][m][1];
                    float t = v0[0] * v0[0] + v0[1] * v0[1] + v0[2] * v0[2] + v0[3] * v0[3] + v1[0] * v1[0] + v1[1] * v1[1] + v1[2] * v1[2] + v1[3] * v1[3];
                    t += __shfl_xor(t, 16); t += __shfl_xor(t, 32);
                    ss[ai][m][bj] = t;
                }
        float* myred = red + (wr * 4 + wc) * 256;
        if (fq == 0) {
#pragma unroll
            for (int ai = 0; ai < 2; ++ai)
#pragma unroll
                for (int m = 0; m < 4; ++m)
#pragma unroll
                    for (int bj = 0; bj < 2; ++bj) myred[(ai * 64 + m * 16 + fr) * 2 + bj] = ss[ai][m][bj];
        }
        asm volatile("s_waitcnt lgkmcnt(0)" ::: "memory"); __builtin_amdgcn_s_barrier(); asm volatile("" ::: "memory");
        const int row0 = u.pm * BM + wr * 64 + fr, col0 = u.pn * BM + wc * 32 + 8 * fq;
        const float* rbase = red + (wr * 4) * 256;
#pragma unroll
        for (int bj = 0; bj < 2; ++bj) {
            const int grp = (u.pn * 2 + bj) >> gshift;
            const float* gain = ((grp & 2) ? gainB : gainA) + (grp & 1) * 128 + wc * 32 + 8 * fq;
            const float qs = (grp & 1) ? 1.f : 0.08838834764831845f * LOG2E;
            float4 g0 = *(const float4*)gain, g1 = *(const float4*)(gain + 4);
            g0.x *= qs; g0.y *= qs; g0.z *= qs; g0.w *= qs; g1.x *= qs; g1.y *= qs; g1.z *= qs; g1.w *= qs;
#pragma unroll
            for (int ai = 0; ai < 2; ++ai)
#pragma unroll
                for (int m = 0; m < 4; ++m) {
                    const int ri = (ai * 64 + m * 16 + fr) * 2 + bj;
                    const float tot = rbase[ri] + rbase[256 + ri] + rbase[512 + ri] + rbase[768 + ri];
                    const float rstd = rsqrtf(tot * (1.f / 128.f) + 1e-6f);
                    const f32x4 v0 = acc[ai][bj][m][0], v1 = acc[ai][bj][m][1];
                    u32x4 w;
                    w.x = pack_bf2(v0[0] * rstd * g0.x, v0[1] * rstd * g0.y); w.y = pack_bf2(v0[2] * rstd * g0.z, v0[3] * rstd * g0.w);
                    w.z = pack_bf2(v1[0] * rstd * g1.x, v1[1] * rstd * g1.y); w.w = pack_bf2(v1[2] * rstd * g1.z, v1[3] * rstd * g1.w);
                    *(u32x4*)(O + (size_t)(row0 + ai * HALF + m * 16) * ldc + col0 + bj * HALF) = w;
                }
        }
    }
};
struct EpiVt8 {
    static constexpr bool PERM = true, AFTER_DRAIN = false, I8 = true;
    bf16_t* O; int ldc; const float* rscale; const float* cscale;
    __device__ __forceinline__ void operator()(const f32x4 (&acc)[2][2][4][2], const Unit& u, int wr, int wc, int fr, int fq) const {
        typedef int i32x4 __attribute__((ext_vector_type(4)));
        const int row0 = u.pm * BM + wr * 64 + fr, col0 = u.pn * BM + wc * 32 + 8 * fq;
        f32x4 c0[2], c1[2];
#pragma unroll
        for (int bj = 0; bj < 2; ++bj) { c0[bj] = *(const f32x4*)(cscale + col0 + bj * HALF); c1[bj] = *(const f32x4*)(cscale + col0 + bj * HALF + 4); }
#pragma unroll
        for (int ai = 0; ai < 2; ++ai)
#pragma unroll
            for (int m = 0; m < 4; ++m) { const int row = row0 + ai * HALF + m * 16; const float rs = rscale[row]; bf16_t* rowp = O + (size_t)row * ldc + col0;
#pragma unroll
                for (int bj = 0; bj < 2; ++bj) {
                    const i32x4 i0 = __builtin_bit_cast(i32x4, acc[ai][bj][m][0]), i1 = __builtin_bit_cast(i32x4, acc[ai][bj][m][1]);
                    const f32x4 v0 = __builtin_convertvector(i0, f32x4) * c0[bj] * rs, v1 = __builtin_convertvector(i1, f32x4) * c1[bj] * rs;
                    u32x4 w; w.x = pack_bf2(v0[0], v0[1]); w.y = pack_bf2(v0[2], v0[3]); w.z = pack_bf2(v1[0], v1[1]); w.w = pack_bf2(v1[2], v1[3]);
                    *(u32x4*)(rowp + bj * HALF) = w; } }
    }
};
template <bool IN16>
struct EpiRes16 {
    static constexpr bool PERM = true, AFTER_DRAIN = false, I8 = false;
    bf16_t* O; int ldc; const void* xin; const float* gate;
    __device__ __forceinline__ void operator()(const f32x4 (&acc)[2][2][4][2], const Unit& u, int wr, int wc, int fr, int fq) const {
        const int row0 = u.pm * BM + wr * 64 + fr, col0 = u.pn * BM + wc * 32 + 8 * fq;
        const float* gp = gate + (size_t)((u.pm * BM) >> 11) * 12288 + col0;
        f32x4 g0[2], g1[2];
#pragma unroll
        for (int bj = 0; bj < 2; ++bj) { g0[bj] = *(const f32x4*)(gp + bj * HALF); g1[bj] = *(const f32x4*)(gp + bj * HALF + 4); }
#pragma unroll
        for (int ai = 0; ai < 2; ++ai)
#pragma unroll
            for (int m = 0; m < 4; ++m) { const size_t ro = (size_t)(row0 + ai * HALF + m * 16) * ldc + col0;
#pragma unroll
                for (int bj = 0; bj < 2; ++bj) {
                    f32x4 x0, x1;
                    if (IN16) { const u32x4 xw = *(const u32x4*)((const bf16_t*)xin + ro + bj * HALF);
                        x0 = (f32x4){bf_lo(xw.x), bf_hi(xw.x), bf_lo(xw.y), bf_hi(xw.y)}; x1 = (f32x4){bf_lo(xw.z), bf_hi(xw.z), bf_lo(xw.w), bf_hi(xw.w)}; }
                    else { x0 = *(const f32x4*)((const float*)xin + ro + bj * HALF); x1 = *(const f32x4*)((const float*)xin + ro + bj * HALF + 4); }
                    const f32x4 v0 = x0 + g0[bj] * acc[ai][bj][m][0], v1 = x1 + g1[bj] * acc[ai][bj][m][1];
                    u32x4 w; w.x = pack_bf2(v0[0], v0[1]); w.y = pack_bf2(v0[2], v0[3]); w.z = pack_bf2(v1[0], v1[1]); w.w = pack_bf2(v1[2], v1[3]);
                    *(u32x4*)(O + ro + bj * HALF) = w; } }
    }
};
struct EpiRes {
    static constexpr bool PERM = false, AFTER_DRAIN = false, I8 = false;
    float* C; int ldc; const float* xin; const float* gate;
    __device__ __forceinline__ void operator()(const f32x4 (&acc)[2][2][4][2], const Unit& u, int wr, int wc, int fr, int fq) const {
        const int row0 = u.pm * BM + wr * 64 + fr, col0 = u.pn * BM + wc * 32 + 4 * fq;
        const float* gp = gate + (size_t)((u.pm * BM) >> 11) * 12288 + col0;
        f32x4 gv[2][2];
#pragma unroll
        for (int bj = 0; bj < 2; ++bj)
#pragma unroll
            for (int n = 0; n < 2; ++n) gv[bj][n] = *(const f32x4*)(gp + bj * HALF + n * 16);
#pragma unroll
        for (int ai = 0; ai < 2; ++ai)
#pragma unroll
            for (int m = 0; m < 4; ++m) { const size_t ro = (size_t)(row0 + ai * HALF + m * 16) * ldc + col0;
#pragma unroll
                for (int bj = 0; bj < 2; ++bj)
#pragma unroll
                    for (int n = 0; n < 2; ++n) { const f32x4 xv = *(const f32x4*)(xin + ro + bj * HALF + n * 16);
                        *(f32x4*)(C + ro + bj * HALF + n * 16) = xv + gv[bj][n] * acc[ai][bj][m][n]; } }
    }
};

template <bool I8>
__device__ __forceinline__ f32x4 pg8_mma(bf16x8 b, bf16x8 a, f32x4 c) {
    if constexpr (I8) {
        typedef int i32x4 __attribute__((ext_vector_type(4)));
        return __builtin_bit_cast(f32x4, __builtin_amdgcn_mfma_i32_16x16x64_i8(__builtin_bit_cast(i32x4, b), __builtin_bit_cast(i32x4, a), __builtin_bit_cast(i32x4, c), 0, 0, 0));
    } else {
        return __builtin_amdgcn_mfma_f32_16x16x32_bf16(b, a, c, 0, 0, 0);
    }
}
template <class Epi, class Sched, bool STAMP = false>
__device__ __forceinline__ void gemm_phase(PG8_LAS unsigned char* lds, const Gemm g, const Sched& S, const Epi& E, unsigned long long* stamps) {
    const int tid = RTID(), wid = __builtin_amdgcn_readfirstlane(tid >> 6), lane = tid & 63, wr = wid >> 2, wc = wid & 3, fr = lane & 15, fq = lane >> 4;
    const int K = g.K, nt = K / BK;
    int ts_lo = 0, ts_hi = 0, nts = 0; const unsigned long long rt_entry = STAMP ? (unsigned long long)wall_clock64() : 0ull;
#define PG8_STAMP() do { if (STAMP && wid == 0 && nts < 64) { const unsigned long long _c = (unsigned long long)clock64(); \
        ts_lo = (lane == nts) ? (int)(unsigned)_c : ts_lo; ts_hi = (lane == nts) ? (int)(unsigned)(_c >> 32) : ts_hi; ++nts; } } while (0)
    PG8_STAMP();
    unsigned voffA[2], voffB[2];
#pragma unroll
    for (int i = 0; i < 2; ++i) { int R, C; stage_rc(tid * 16 + i * 8192, R, C); const int Rb = Epi::PERM ? ((R & ~31) + perm32(R & 31)) : R;
        voffA[i] = (unsigned)(R * K + C) * 2u; voffB[i] = (unsigned)(Rb * K + C) * 2u; }
    const size_t kstep = (size_t)(BK * 2);
    const size_t hstep = (size_t)HALF * K * 2;
    const size_t tstep = 2 * hstep;
    const unsigned ldsw = (unsigned)wid * 1024u;
    const int aoff = lds_byte(wr * 64 + fr, fq * 8), boff = lds_byte(wc * 32 + fr, fq * 8);
#define PG8_SA(b, h) (((b) * 2 + (h)) * HTB)
#define PG8_SB(b, h) ((4 + (b) * 2 + (h)) * HTB)
#define PG8_STAGE(bufoff, gbase, voff) do { _Pragma("unroll") for (int _i = 0; _i < 2; ++_i) \
        __builtin_amdgcn_global_load_lds((const unsigned*)((const char*)(gbase) + (voff)[_i]), (PG8_LAS unsigned*)(lds + (bufoff) + ldsw + _i * 8192), 16, 0, 0); } while (0)
#define PG8_LDA(dst, b, h) do { _Pragma("unroll") for (int m = 0; m < 4; ++m) _Pragma("unroll") for (int k = 0; k < 2; ++k) dst[m][k] = *(const PG8_LAS bf16x8*)(lds + PG8_SA(b, h) + aoff + m * 2048 + k * 1024); } while (0)
#define PG8_LDB(dst, b, h) do { _Pragma("unroll") for (int n = 0; n < 2; ++n) _Pragma("unroll") for (int k = 0; k < 2; ++k) dst[n][k] = *(const PG8_LAS bf16x8*)(lds + PG8_SB(b, h) + boff + n * 2048 + k * 1024); } while (0)
#define PG8_MMA(ai, bj, At, Bt) do { __builtin_amdgcn_s_setprio(1); _Pragma("unroll") for (int m = 0; m < 4; ++m) _Pragma("unroll") for (int n = 0; n < 2; ++n) _Pragma("unroll") for (int k = 0; k < 2; ++k) \
        acc[ai][bj][m][n] = pg8_mma<Epi::I8>(Bt[n][k], At[m][k], acc[ai][bj][m][n]); __builtin_amdgcn_s_setprio(0); } while (0)
#define PG8_WAIT_V(n) asm volatile("s_waitcnt vmcnt(" #n ")" ::: "memory")
#define PG8_WAIT_L(n) asm volatile("s_waitcnt lgkmcnt(" #n ")" ::: "memory")
#define PG8_BAR __builtin_amdgcn_s_barrier()
#define PG8_SCHED __builtin_amdgcn_sched_barrier(0)
    Unit cur, nxt; int ui = 0;
    if (!S.next(0, cur)) return;
    f32x4 acc[2][2][4][2];
#pragma unroll
    for (int a = 0; a < 2; ++a)
#pragma unroll
        for (int b = 0; b < 2; ++b)
#pragma unroll
            for (int m = 0; m < 4; ++m)
#pragma unroll
                for (int n = 0; n < 2; ++n) acc[a][b][m][n] = (f32x4){0.f, 0.f, 0.f, 0.f};
    bf16x8 At[4][2], B0[2][2], B1[2][2];
    const char* cA = (const char*)g.A + (size_t)cur.pm * tstep; const char* cB = (const char*)g.Bt + (size_t)cur.pn * tstep;
    S.a_ready(cur);
    PG8_STAGE(PG8_SB(0, 0), cB, voffB); PG8_STAGE(PG8_SA(0, 0), cA, voffA); PG8_STAGE(PG8_SB(0, 1), cB + hstep, voffB); PG8_STAGE(PG8_SA(0, 1), cA + hstep, voffA);
    if (wr == 1) PG8_BAR;
    PG8_WAIT_V(4); PG8_BAR;
    PG8_STAGE(PG8_SB(1, 0), cB + kstep, voffB); PG8_STAGE(PG8_SA(1, 0), cA + kstep, voffA); PG8_STAGE(PG8_SB(1, 1), cB + hstep + kstep, voffB);
    PG8_WAIT_V(6); PG8_BAR;
    PG8_STAMP();
    for (;;) {
        const bool has_next = S.next(ui + 1, nxt);
        const char* nA = has_next ? (const char*)g.A + (size_t)nxt.pm * tstep : cA; const char* nB = has_next ? (const char*)g.Bt + (size_t)nxt.pn * tstep : cB;
        for (int t = 0; t < nt; t += 2) {
            const bool last = (t == nt - 2);
            const char* a1 = cA + (size_t)(t + 1) * kstep;
            const char* a2 = last ? nA : cA + (size_t)(t + 2) * kstep; const char* b2 = last ? nB : cB + (size_t)(t + 2) * kstep;
            const char* a3 = a2 + kstep; const char* b3 = b2 + kstep;
            if (last && has_next) S.a_ready(nxt);
            PG8_LDB(B0, 0, 0); PG8_SCHED; PG8_LDA(At, 0, 0); PG8_STAGE(PG8_SA(1, 1), a1 + hstep, voffA);
            PG8_WAIT_L(8); PG8_BAR; PG8_WAIT_L(0); PG8_MMA(0, 0, At, B0); PG8_BAR; PG8_SCHED;
            PG8_LDB(B1, 0, 1); PG8_STAGE(PG8_SB(0, 0), b2, voffB);
            PG8_BAR; PG8_WAIT_L(0); PG8_MMA(0, 1, At, B1); PG8_BAR;
            PG8_LDA(At, 0, 1); PG8_STAGE(PG8_SA(0, 0), a2, voffA);
            PG8_BAR; PG8_WAIT_L(0); PG8_MMA(1, 0, At, B0); PG8_BAR; PG8_SCHED;
            PG8_STAGE(PG8_SB(0, 1), b2 + hstep, voffB);
            PG8_WAIT_V(6); PG8_BAR; PG8_MMA(1, 1, At, B1); PG8_BAR;
            PG8_LDB(B0, 1, 0); PG8_SCHED; PG8_LDA(At, 1, 0); PG8_STAGE(PG8_SA(0, 1), a2 + hstep, voffA);
            PG8_WAIT_L(8); PG8_BAR; PG8_WAIT_L(0); PG8_MMA(0, 0, At, B0); PG8_BAR; PG8_SCHED;
            PG8_LDB(B1, 1, 1); PG8_STAGE(PG8_SB(1, 0), b3, voffB);
            PG8_BAR; PG8_WAIT_L(0); PG8_MMA(0, 1, At, B1); PG8_BAR;
            PG8_LDA(At, 1, 1); PG8_STAGE(PG8_SA(1, 0), a3, voffA);
            PG8_BAR; PG8_WAIT_L(0); PG8_MMA(1, 0, At, B0); PG8_BAR; PG8_SCHED;
            PG8_STAGE(PG8_SB(1, 1), b3 + hstep, voffB);
            PG8_WAIT_V(6); PG8_BAR; PG8_MMA(1, 1, At, B1); PG8_BAR;
        }
        PG8_STAMP();
        if constexpr (!Epi::AFTER_DRAIN) { E(acc, cur, wr, wc, fr, fq); S.done(cur); }
        PG8_STAMP();
        if (!has_next) break;
#pragma unroll
        for (int a = 0; a < 2; ++a)
#pragma unroll
            for (int b = 0; b < 2; ++b)
#pragma unroll
                for (int m = 0; m < 4; ++m)
#pragma unroll
                    for (int n = 0; n < 2; ++n) acc[a][b][m][n] = (f32x4){0.f, 0.f, 0.f, 0.f};
        cur = nxt; cA = nA; cB = nB; ++ui;
    }
    PG8_WAIT_V(0);
    if (wr == 0) PG8_BAR;
    PG8_BAR;
    if constexpr (Epi::AFTER_DRAIN) { E.fused(acc, cur, wr, wc, fr, fq, lds, wid, lane); S.done(cur); }
    PG8_STAMP();
    if (STAMP && wid == 0) { stamps[lane] = lane < nts ? (((unsigned long long)(unsigned)ts_hi << 32) | (unsigned)ts_lo) : 0ull;
        if (lane == 62) stamps[62] = rt_entry; if (lane == 63) stamps[63] = (unsigned long long)wall_clock64(); }
#undef PG8_STAMP
#undef PG8_SA
#undef PG8_SB
#undef PG8_STAGE
#undef PG8_LDA
#undef PG8_LDB
#undef PG8_MMA
#undef PG8_WAIT_V
#undef PG8_WAIT_L
#undef PG8_BAR
#undef PG8_SCHED
}
}

struct AttnPtrs { const bf16_t* Q; int ldq; const bf16_t* K; int ldk; const bf16_t* Vt; int ldv; const float* kbias; };

DI float xhalf_max(float v) {
  const auto r2 = __builtin_amdgcn_permlane32_swap(__float_as_uint(v), __float_as_uint(v), false, false);
  return fmaxf(__uint_as_float(r2[0]), __uint_as_float(r2[1]));
}
DI float xhalf_sum(float v) {
  const auto r2 = __builtin_amdgcn_permlane32_swap(__float_as_uint(v), __float_as_uint(v), false, false);
  return __uint_as_float(r2[0]) + __uint_as_float(r2[1]);
}

template <int MODE, int DVB>
DI void attn_block(const AttnPtrs& a, int q0b, char* smem, const float* tbl, f32x16 (&o)[DVB], float& l_out) {
  constexpr int STG = 16384 + DVB * 4096;
  const int tid = RTID(), lane = tid & 63, wave = __builtin_amdgcn_readfirstlane(tid >> 6);
  const int r = lane & 31, h = lane >> 5;
  const int q0 = q0b + 32 * wave;
  const int krow = tid >> 4, kch = tid & 15;
  const int vrow = tid >> 3, vch = tid & 7;
  const char* Kb = (const char*)a.K;
  const char* Vb = (const char*)a.Vt;
  const unsigned kvo = (unsigned)(krow * a.ldk + kch * 8) * 2u;
  const unsigned vvo = (unsigned)(vrow * a.ldv + vch * 8) * 2u;
  const unsigned kst = (unsigned)(32 * a.ldk) * 2u, vst = (unsigned)(64 * a.ldv) * 2u;
  const int kwo = krow * 256 + ((kch ^ (krow & 15)) << 4);
  const int vwo = 16384 + vrow * 128 + ((vch ^ ((vrow >> 1) & 7)) << 4);
  const int pr = (r & ~12) | ((r & 4) << 1) | ((r & 8) >> 1);
  const int kro = pr * 256, ksw = pr & 15;
  const int vro = 16384 + r * 128, vsw = (r >> 1) & 7;
  bf16x8 qf[8];
#pragma unroll
  for (int s = 0; s < 8; ++s) qf[s] = *(const bf16x8*)(a.Q + (size_t)(q0 + r) * a.ldq + 16 * s + 8 * h);
#pragma unroll
  for (int dt = 0; dt < DVB; ++dt)
#pragma unroll
    for (int e = 0; e < 16; ++e) o[dt][e] = 0.f;
  float m = -1e30f, l = 0.f;
  const int nkt = (q0b + 256) >> 6;
  u32x4 rk[2], rv[DVB / 2];
#pragma unroll
  for (int i = 0; i < 2; ++i) rk[i] = *(const u32x4*)(Kb + (size_t)(i * kst) + kvo);
#pragma unroll
  for (int i = 0; i < DVB / 2; ++i) rv[i] = *(const u32x4*)(Vb + (size_t)(i * vst) + vvo);
#pragma unroll
  for (int i = 0; i < 2; ++i) *(u32x4*)(smem + kwo + i * 8192) = rk[i];
#pragma unroll
  for (int i = 0; i < DVB / 2; ++i) *(u32x4*)(smem + vwo + i * 8192) = rv[i];
  u32x4 rkB[2], rvB[DVB / 2];
  if constexpr (DVB == 4) {
    const int k1 = nkt > 1 ? 64 : 0;
#pragma unroll
    for (int i = 0; i < 2; ++i) rk[i] = *(const u32x4*)(Kb + ((size_t)k1 * (size_t)a.ldk * 2u + i * kst) + kvo);
#pragma unroll
    for (int i = 0; i < DVB / 2; ++i) rv[i] = *(const u32x4*)(Vb + ((size_t)k1 * 2u + i * vst) + vvo);
  }
  __syncthreads();
#define ATT_TILE(KT, RL, RVL, RW, RVW) { const int kt = (KT); \
    const int k0 = kt << 6; \
    char* st = smem + (kt & 1) * STG; \
    { \
      const int kn = (kt + 2 < nkt ? kt + 2 : nkt - 1) << 6;        \
      const size_t kbo = (size_t)kn * (size_t)a.ldk * 2u, vbo = (size_t)kn * 2u; \
_Pragma("unroll") \
      for (int i = 0; i < 2; ++i) RL[i] = *(const u32x4*)(Kb + (kbo + i * kst) + kvo); \
_Pragma("unroll") \
      for (int i = 0; i < DVB / 2; ++i) RVL[i] = *(const u32x4*)(Vb + (vbo + i * vst) + vvo); \
    } \
    asm volatile("" ::: "memory"); \
    __builtin_amdgcn_sched_barrier(0); \
_Pragma("unroll") \
    for (int sub = 0; sub < 2; ++sub) { \
      const int ks0 = k0 + 32 * sub; \
      if (ks0 <= q0) { \
        f32x16 sa; \
_Pragma("unroll") \
        for (int e = 0; e < 16; ++e) sa[e] = 0.f; \
_Pragma("unroll") \
        for (int s = 0; s < 8; ++s) { \
          const bf16x8 kf = *(const bf16x8*)(st + kro + sub * 8192 + (((2 * s + h) ^ ksw) << 4)); \
          sa = MFMA32(kf, qf[s], sa); \
        } \
        float v[16]; \
        if (MODE == 0) { \
_Pragma("unroll") \
          for (int c = 0; c < 2; ++c) { \
            const float4 kb0 = *(const float4*)(a.kbias + ks0 + 16 * c + 8 * h); \
            const float4 kb1 = *(const float4*)(a.kbias + ks0 + 16 * c + 8 * h + 4); \
            v[8 * c + 0] = sa[8 * c + 0] - kb0.x * LOG2E; v[8 * c + 1] = sa[8 * c + 1] - kb0.y * LOG2E; \
            v[8 * c + 2] = sa[8 * c + 2] - kb0.z * LOG2E; v[8 * c + 3] = sa[8 * c + 3] - kb0.w * LOG2E; \
            v[8 * c + 4] = sa[8 * c + 4] - kb1.x * LOG2E; v[8 * c + 5] = sa[8 * c + 5] - kb1.y * LOG2E; \
            v[8 * c + 6] = sa[8 * c + 6] - kb1.z * LOG2E; v[8 * c + 7] = sa[8 * c + 7] - kb1.w * LOG2E; \
          } \
          if (ks0 == q0) { \
_Pragma("unroll") \
            for (int e = 0; e < 16; ++e) if ((e & 7) + 8 * h + 16 * (e >> 3) > r) v[e] = -INFINITY; \
          } \
        } else { \
          const float* tp = tbl + (q0 - ks0) + r + 32 - 8 * h - 23; \
_Pragma("unroll") \
          for (int e = 0; e < 16; ++e) v[e] = sa[e] + tp[23 - ((e & 7) + 16 * (e >> 3))]; \
        } \
        float mx = v[0]; \
_Pragma("unroll") \
        for (int e = 1; e < 16; ++e) mx = fmaxf(mx, v[e]); \
        mx = xhalf_max(mx); \
        if (__ballot(mx > m + 8.f) != 0ull) { \
          const float mn = fmaxf(m, mx); \
          const float alpha = __builtin_amdgcn_exp2f(m - mn); \
          m = mn; \
          l *= alpha; \
_Pragma("unroll") \
          for (int dt = 0; dt < DVB; ++dt) \
_Pragma("unroll") \
            for (int e = 0; e < 16; ++e) o[dt][e] *= alpha; \
        } \
        float ps = 0.f; \
_Pragma("unroll") \
        for (int e = 0; e < 16; ++e) { v[e] = __builtin_amdgcn_exp2f(v[e] - m); ps += v[e]; } \
        l += ps; \
        bf16x8 pb[2]; \
_Pragma("unroll") \
        for (int s = 0; s < 2; ++s) { \
          const u32x4 u = {pack_bf2(v[8 * s + 0], v[8 * s + 1]), pack_bf2(v[8 * s + 2], v[8 * s + 3]), \
                           pack_bf2(v[8 * s + 4], v[8 * s + 5]), pack_bf2(v[8 * s + 6], v[8 * s + 7])}; \
          pb[s] = __builtin_bit_cast(bf16x8, u); \
        } \
_Pragma("unroll") \
        for (int dt = 0; dt < DVB; ++dt) \
_Pragma("unroll") \
          for (int s = 0; s < 2; ++s) { \
            const bf16x8 va = *(const bf16x8*)(st + vro + dt * 4096 + (((4 * sub + 2 * s + h) ^ vsw) << 4)); \
            o[dt] = MFMA32(va, pb[s], o[dt]); \
          } \
      } \
    } \
    __builtin_amdgcn_sched_barrier(0); \
    asm volatile("" ::: "memory"); \
    { \
      char* sn = smem + ((kt + 1) & 1) * STG; \
_Pragma("unroll") \
      for (int i = 0; i < 2; ++i) *(u32x4*)(sn + kwo + i * 8192) = RW[i]; \
_Pragma("unroll") \
      for (int i = 0; i < DVB / 2; ++i) *(u32x4*)(sn + vwo + i * 8192) = RVW[i]; \
    } \
    __syncthreads(); \
  }
  if constexpr (DVB == 4) {
  for (int kt2 = 0; kt2 < nkt; kt2 += 2) {
    ATT_TILE(kt2, rkB, rvB, rk, rv)
    if (kt2 + 1 < nkt) ATT_TILE(kt2 + 1, rk, rv, rkB, rvB)
  }
  } else {
  for (int kt = 0; kt < nkt; ++kt) {
    const int k0 = kt << 6;
    char* st = smem + (kt & 1) * STG;
    {
      const int kn = (kt + 1 < nkt) ? k0 + 64 : k0;
      const size_t kbo = (size_t)kn * (size_t)a.ldk * 2u, vbo = (size_t)kn * 2u;
#pragma unroll
      for (int i = 0; i < 2; ++i) rk[i] = *(const u32x4*)(Kb + (kbo + i * kst) + kvo);
#pragma unroll
      for (int i = 0; i < DVB / 2; ++i) rv[i] = *(const u32x4*)(Vb + (vbo + i * vst) + vvo);
    }
    asm volatile("" ::: "memory");
    __builtin_amdgcn_sched_barrier(0);
#pragma unroll
    for (int sub = 0; sub < 2; ++sub) {
      const int ks0 = k0 + 32 * sub;
      if (ks0 <= q0) {
        f32x16 sa;
#pragma unroll
        for (int e = 0; e < 16; ++e) sa[e] = 0.f;
#pragma unroll
        for (int s = 0; s < 8; ++s) {
          const bf16x8 kf = *(const bf16x8*)(st + kro + sub * 8192 + (((2 * s + h) ^ ksw) << 4));
          sa = MFMA32(kf, qf[s], sa);
        }
        float v[16];
        if (MODE == 0) {
#pragma unroll
          for (int c = 0; c < 2; ++c) {
            const float4 kb0 = *(const float4*)(a.kbias + ks0 + 16 * c + 8 * h);
            const float4 kb1 = *(const float4*)(a.kbias + ks0 + 16 * c + 8 * h + 4);
            v[8 * c + 0] = sa[8 * c + 0] - kb0.x * LOG2E; v[8 * c + 1] = sa[8 * c + 1] - kb0.y * LOG2E;
            v[8 * c + 2] = sa[8 * c + 2] - kb0.z * LOG2E; v[8 * c + 3] = sa[8 * c + 3] - kb0.w * LOG2E;
            v[8 * c + 4] = sa[8 * c + 4] - kb1.x * LOG2E; v[8 * c + 5] = sa[8 * c + 5] - kb1.y * LOG2E;
            v[8 * c + 6] = sa[8 * c + 6] - kb1.z * LOG2E; v[8 * c + 7] = sa[8 * c + 7] - kb1.w * LOG2E;
          }
          if (ks0 == q0) {
#pragma unroll
            for (int e = 0; e < 16; ++e) if ((e & 7) + 8 * h + 16 * (e >> 3) > r) v[e] = -INFINITY;
          }
        } else {
          const float* tp = tbl + (q0 - ks0) + r + 32 - 8 * h - 23;
#pragma unroll
          for (int e = 0; e < 16; ++e) v[e] = sa[e] + tp[23 - ((e & 7) + 16 * (e >> 3))];
        }
        float mx = v[0];
#pragma unroll
        for (int e = 1; e < 16; ++e) mx = fmaxf(mx, v[e]);
        mx = xhalf_max(mx);
        if (__ballot(mx > m + 8.f) != 0ull) {
          const float mn = fmaxf(m, mx);
          const float alpha = __builtin_amdgcn_exp2f(m - mn);
          m = mn;
          l *= alpha;
#pragma unroll
          for (int dt = 0; dt < DVB; ++dt)
#pragma unroll
            for (int e = 0; e < 16; ++e) o[dt][e] *= alpha;
        }
        float ps = 0.f;
#pragma unroll
        for (int e = 0; e < 16; ++e) { v[e] = __builtin_amdgcn_exp2f(v[e] - m); ps += v[e]; }
        l += ps;
        bf16x8 pb[2];
#pragma unroll
        for (int s = 0; s < 2; ++s) {
          const u32x4 u = {pack_bf2(v[8 * s + 0], v[8 * s + 1]), pack_bf2(v[8 * s + 2], v[8 * s + 3]),
                           pack_bf2(v[8 * s + 4], v[8 * s + 5]), pack_bf2(v[8 * s + 6], v[8 * s + 7])};
          pb[s] = __builtin_bit_cast(bf16x8, u);
        }
#pragma unroll
        for (int dt = 0; dt < DVB; ++dt)
#pragma unroll
          for (int s = 0; s < 2; ++s) {
            const bf16x8 va = *(const bf16x8*)(st + vro + dt * 4096 + (((4 * sub + 2 * s + h) ^ vsw) << 4));
            o[dt] = MFMA32(va, pb[s], o[dt]);
          }
      }
    }
    __builtin_amdgcn_sched_barrier(0);
    asm volatile("" ::: "memory");
    {
      char* sn = smem + ((kt + 1) & 1) * STG;
#pragma unroll
      for (int i = 0; i < 2; ++i) *(u32x4*)(sn + kwo + i * 8192) = rk[i];
#pragma unroll
      for (int i = 0; i < DVB / 2; ++i) *(u32x4*)(sn + vwo + i * 8192) = rv[i];
    }
    __syncthreads();
  }
  }
#undef ATT_TILE
  l_out = xhalf_sum(l);
}

DI void attn_store_bf16(const f32x16 (&o)[4], float linv, bf16_t* out_row  , int ldo) {
  const int lane = TID() & 63, r = lane & 31, h = lane >> 5;
  bf16_t* op = out_row + (size_t)r * ldo + 4 * h;
#pragma unroll
  for (int dt = 0; dt < 4; ++dt)
#pragma unroll
    for (int c = 0; c < 4; ++c)
      *(uint2*)(op + 32 * dt + 8 * c) = make_uint2(pack_bf2(o[dt][4 * c] * linv, o[dt][4 * c + 1] * linv),
                                                    pack_bf2(o[dt][4 * c + 2] * linv, o[dt][4 * c + 3] * linv));
}
template <int N, int B0>
DI void attn_store_f32(const f32x16 (&o)[N], float linv, float* out_row, int ldo) {
  const int lane = TID() & 63, r = lane & 31, h = lane >> 5;
  float* op = out_row + (size_t)r * ldo + 4 * h;
#pragma unroll
  for (int dt = 0; dt < 4; ++dt)
#pragma unroll
    for (int c = 0; c < 4; ++c)
      *(float4*)(op + 32 * dt + 8 * c) = make_float4(o[B0 + dt][4 * c] * linv, o[B0 + dt][4 * c + 1] * linv, o[B0 + dt][4 * c + 2] * linv, o[B0 + dt][4 * c + 3] * linv);
}

DI int t5_bucket(int n) {
  if (n < 16) return n;
  int lg = 16 + (int)(logf((float)n / 16.f) / 4.852030263919617f * 16.f);
  return lg < 31 ? lg : 31;
}

DI void phase_attn_even(const Params& p, char* smem) {
  const int tid = RTID(), wave = __builtin_amdgcn_readfirstlane(tid >> 6), bid = blockIdx.x, G = gridDim.x;
  const bf16_t* QK = (const bf16_t*)(p.ws + WS_QK);
  const bf16_t* VT = (const bf16_t*)(p.ws + WS_VT);
  bf16_t* ATT = (bf16_t*)(p.ws + WS_ATT);
  float* PCS = (float*)(p.ws + WS_SC);
  float* tbl = (float*)(smem + 98304);
  int cur_head = -1;
  for (int rnd = 0; rnd * G < 1024; ++rnd) {
    int item = rnd * G + ((rnd & 1) ? G - 1 - bid : bid);
    if (G == 256) {
      const int rc = rnd * 4 + (bid >> 6);
      const int gq = (int)((0x6767455432231010ull >> (4 * rc)) & 15ull), dq = (0x3CC3 >> rc) & 1;
      item = gq * 128 + (dq ? 0 : 64) + (bid & 63);
    }
    if (item >= 1024) break;
    const int g = item >> 7; int rem = item & 127;
    const int qb = 7 - g;
    const int q0b = qb * 256, q0 = q0b + 32 * wave;
    __syncthreads();
    if (rem >= 64) {
      rem -= 64;
      const int b = rem >> 3, hh = rem & 7;
      AttnPtrs a;
      a.Q = QK + (size_t)b * S_ * 4096 + hh * 128; a.ldq = 4096;
      a.K = a.Q + 1024; a.ldk = 4096;
      a.Vt = VT + (size_t)(hh * 128) * T_ + b * S_; a.ldv = T_;
      a.kbias = (const float*)(p.ws + WS_FCUM) + (size_t)(b * 8 + hh) * S_;
      f32x16 o[4]; float l;
      attn_block<0, 4>(a, q0b, smem, nullptr, o, l);
      attn_store_bf16(o, 1.f / l, ATT + (size_t)(b * S_ + q0) * D_ + hh * 128, D_);
    } else {
      const int b = rem >> 3, hh = (rem >> 1) & 3, mm = rem & 1;
      if (hh != cur_head) {
        for (int e = tid; e < 2080; e += RTHREADS) {
          const int dist = e - 32;
          tbl[e] = dist >= 0 ? p.rel_bias[t5_bucket(dist) * 16 + hh] * LOG2E : -INFINITY;
        }
        cur_head = hh;
      }
      AttnPtrs a;
      a.Q = QK + (size_t)b * S_ * 4096 + 2048 + hh * 256 + mm * 128; a.ldq = 4096;
      a.K = a.Q + 1024; a.ldk = 4096;
      a.Vt = VT + (size_t)(1024 + hh * 256) * T_ + b * S_; a.ldv = T_;
      a.kbias = nullptr;
      f32x16 o[8]; float l;
      attn_block<1, 8>(a, q0b, smem, tbl, o, l);
      const float linv = 1.f / l;
      attn_store_f32<8, 0>(o, linv, PCS + (((size_t)(mm * 2 + 0) * T_ + (size_t)(b * S_ + q0)) * 4 + hh) * 128, 512);
      attn_store_f32<8, 4>(o, linv, PCS + (((size_t)(mm * 2 + 1) * T_ + (size_t)(b * S_ + q0)) * 4 + hh) * 128, 512);
    }
  }
}

DI void phase_diff_combine(const Params& p) {
  const int lane = TID() & 63;
  const int gw = __builtin_amdgcn_readfirstlane((VBID() * NTHREADS + TID()) >> 6), nw = (VGRID() * NTHREADS) >> 6;
  const float* PCS = (const float*)(p.ws + WS_SC);
  bf16_t* ATT = (bf16_t*)(p.ws + WS_ATT);
  const float lam = ((const float*)(p.ws + WS_MISC))[0];
  const int half = lane >> 5, dl = (lane & 31) * 4;
  const float4 sg = *(const float4*)(p.even_diff_subln_gain + lane * 4);
  for (int it = gw; it < T_ * 4; it += nw) {
    const float4 a0 = *(const float4*)(PCS + ((size_t)(0 + half) * T_ * 4 + it) * 128 + dl);
    const float4 a1 = *(const float4*)(PCS + ((size_t)(2 + half) * T_ * 4 + it) * 128 + dl);
    float4 v;
    v.x = a0.x - lam * a1.x; v.y = a0.y - lam * a1.y; v.z = a0.z - lam * a1.z; v.w = a0.w - lam * a1.w;
    const float ss = wave_sum(v.x * v.x + v.y * v.y + v.z * v.z + v.w * v.w);
    const float rstd = rsqrtf(ss * (1.f / 256.f) + 1e-6f) * 0.8f;
    const int t = it >> 2, hh = it & 3;
    *(uint2*)(ATT + (size_t)t * D_ + 1024 + hh * 256 + lane * 4) =
        make_uint2(pack_bf2(v.x * rstd * sg.x, v.y * rstd * sg.y), pack_bf2(v.z * rstd * sg.z, v.w * rstd * sg.w));
  }
}

DI void phase_attn_odd(const Params& p, char* smem) {
  const int tid = RTID(), wave = __builtin_amdgcn_readfirstlane(tid >> 6), bid = blockIdx.x, G = gridDim.x;
  const bf16_t* QK = (const bf16_t*)(p.ws + WS_QK);
  const bf16_t* VT = (const bf16_t*)(p.ws + WS_VT);
  bf16_t* ATT = (bf16_t*)(p.ws + WS_ATT);
  float* tbl = (float*)(smem + 98304);
  int cur_head = -1;
  for (int rnd = 0; rnd * G < 1024; ++rnd) {
    const int item = rnd * G + ((rnd & 1) ? G - 1 - bid : bid);
    if (item >= 1024) break;
    const int g = item >> 7, rem = item & 127;
    const int qb = 7 - g, b = rem >> 4, hd = rem & 15;
    __syncthreads();
    if (hd != cur_head) {
      for (int e = tid; e < 2080; e += RTHREADS) {
        const int dist = e - 32;
        float val = -INFINITY;
        if (dist >= 0) {
          int cnt = 0;
          if (dist <= 128) cnt += 1;
          if (dist <= 512 && (dist & 3) == 0) cnt += 1;
          if ((dist & 15) == 0) cnt += 1;
          if (cnt > 0) val = (p.rel_bias[t5_bucket(dist) * 16 + hd] + __logf((float)cnt)) * LOG2E;
        }
        tbl[e] = val;
      }
      cur_head = hd;
    }
    const int q0b = qb * 256, q0 = q0b + 32 * wave;
    AttnPtrs a;
    a.Q = QK + (size_t)b * S_ * 4096 + hd * 128; a.ldq = 4096;
    a.K = a.Q + 2048; a.ldk = 4096;
    a.Vt = VT + (size_t)(hd * 128) * T_ + b * S_; a.ldv = T_;
    a.kbias = nullptr;
    f32x16 o[4]; float l;
    attn_block<1, 4>(a, q0b, smem, tbl, o, l);
    attn_store_bf16(o, 1.f / l, ATT + (size_t)(b * S_ + q0) * D_ + hd * 128, D_);
  }
}

DI float gelu_erf(float x) { return 0.5f * x * (1.f + erff(x * 0.7071067811865476f)); }

DI void ins16(float (&L)[16], float x) {
#pragma unroll
  for (int k = 15; k >= 1; --k) L[k] = __builtin_amdgcn_fmed3f(L[k - 1], L[k], x);
  L[0] = __builtin_amdgcn_fmed3f(__builtin_inff(), L[0], x);
}
DI float f_and_or(float v, unsigned mask, unsigned orv) { return __uint_as_float((__float_as_uint(v) & mask) | orv); }

DI void phase_peer_retrieve(const Params& p, char* smem) {
  const int tid = TID(), lane = tid & 63, wave = __builtin_amdgcn_readfirstlane(tid >> 6);
  const int gw = __builtin_amdgcn_readfirstlane((VBID() * NTHREADS + tid) >> 6), nw = (VGRID() * NTHREADS) >> 6;
  unsigned* wbuf = (unsigned*)(smem + wave * 9216);
  const bf16_t* SC = (const bf16_t*)(p.ws + WS_SC);
  int* IDX = (int*)(p.ws + WS_IDX);
  float* GATE = (float*)(p.ws + WS_GATE);
  const float NINF = -__builtin_inff();
  for (int it = gw; it < T_ / 8; it += nw) {
    const bf16_t* gsrc = SC + (size_t)it * (8 * 2048) + (lane >> 2) * 256 + (lane & 3) * 8;
    unsigned* wdst = wbuf + (lane >> 2) * 20 + (lane & 3) * 4;
    const unsigned* wsrc = wbuf + lane * 20;
    u32x4 stg[4];
#define PR_LOAD(CH) _Pragma("unroll") for (int i = 0; i < 4; ++i) stg[i] = *(const u32x4*)(gsrc + i * (16 * 256) + ((CH) >> 2) * 128 + ((CH) & 3) * 32);
    PR_LOAD(0)
    float A[16], B[16];
#pragma unroll
    for (int hf = 0; hf < 2; ++hf) {
      float L[16];
#pragma unroll
      for (int k = 0; k < 16; ++k) L[k] = NINF;
#pragma unroll 1
      for (int c = 0; c < 4; ++c) {
#pragma unroll
        for (int i = 0; i < 4; ++i) *(u32x4*)(wdst + i * (16 * 20)) = stg[i];
        { const int cn = hf * 4 + c + 1 < 7 ? hf * 4 + c + 1 : 7; PR_LOAD(cn) }
        u32x4 v[4];
#pragma unroll
        for (int k = 0; k < 4; ++k) v[k] = *(const u32x4*)(wsrc + 4 * k);
#pragma unroll
        for (int k = 0; k < 4; ++k)
#pragma unroll
          for (int e = 0; e < 4; ++e) {
            const unsigned w = v[k][e], id0 = (unsigned)(c * 32 + 8 * k + 2 * e);
            ins16(L, __uint_as_float((w << 16) | id0));
            ins16(L, __uint_as_float((w & 0xFFFF0000u) | (id0 + 1u)));
          }
      }
#pragma unroll
      for (int k = 0; k < 16; ++k) { if (hf == 0) A[k] = L[k]; else B[k] = L[k]; }
    }
#undef PR_LOAD
    unsigned* lut = wbuf + lane * 33;
#pragma unroll
    for (int k = 0; k < 16; ++k) {
      const unsigned ua = __float_as_uint(A[k]), ub = __float_as_uint(B[k]);
      lut[k] = (ua & 0x7Fu) << 7; lut[16 + k] = ub & 0x7Fu;
      A[k] = __uint_as_float(ua & 0xFFFFFF80u); B[k] = __uint_as_float(ub & 0xFFFFFF80u);
    }
    float C[16];
#pragma unroll
    for (int k = 0; k < 16; ++k) C[k] = NINF;
#pragma unroll
    for (int i = 0; i < 16; ++i)
#pragma unroll
      for (int j = 0; j < 16; ++j)
        if ((i + 1) * (j + 1) <= 16) ins16(C, f_and_or(A[i] + B[j], 0xFFFFFF00u, (unsigned)(i * 16 + j)));
    float ev[16], es = 0.f;
    int ids[16];
    const float mx = __uint_as_float(__float_as_uint(C[0]) & 0xFFFFFF00u);
#pragma unroll
    for (int k = 0; k < 16; ++k) {
      const unsigned uc = __float_as_uint(C[k]);
      ev[k] = __expf(__uint_as_float(uc & 0xFFFFFF00u) - mx);
      es += ev[k];
      ids[k] = (int)(lut[(uc >> 4) & 15u] + lut[16 + (uc & 15u)]);
    }
    const float inv = 1.f / es;
    int* ip = IDX + (size_t)it * (8 * 128) + lane * 16;
    float* gp = GATE + (size_t)it * (8 * 128) + lane * 16;
#pragma unroll
    for (int q = 0; q < 4; ++q) {
      *(int4*)(ip + 4 * q) = make_int4(ids[4 * q], ids[4 * q + 1], ids[4 * q + 2], ids[4 * q + 3]);
      *(float4*)(gp + 4 * q) = make_float4(ev[4 * q] * inv, ev[4 * q + 1] * inv, ev[4 * q + 2] * inv, ev[4 * q + 3] * inv);
    }
  }
}

DI unsigned peer_ticket_issue(unsigned* cnt) {
  unsigned v = 0;
  if ((TID() & 63) == 0) v = __hip_atomic_fetch_add(cnt, 1u, __ATOMIC_RELAXED, __HIP_MEMORY_SCOPE_AGENT);
  return v;
}
DI float oct_sum(float v) {
  v += __builtin_bit_cast(float, __builtin_amdgcn_update_dpp(0, __builtin_bit_cast(int, v), 0xB1, 0xF, 0xF, true));
  v += __builtin_bit_cast(float, __builtin_amdgcn_update_dpp(0, __builtin_bit_cast(int, v), 0x4E, 0xF, 0xF, true));
  v += __builtin_bit_cast(float, __builtin_amdgcn_update_dpp(0, __builtin_bit_cast(int, v), 0x141, 0xF, 0xF, true));
  return v;
}

DI unsigned swar_add8(unsigned x) { return ((x & 0x7F7F7F7Fu) + 0x08080808u) ^ (x & 0x80808080u); }
DI void phase_peer_dots(const Params& p, int layer, char* smem_all) {
  const int rtid = RTID(), lane = rtid & 63, rwave = __builtin_amdgcn_readfirstlane(rtid >> 6);
  const int g = lane >> 3, j = lane & 7;
  int* lidx_all = (int*)(smem_all + rwave * 8192);
  const unsigned char* H8 = (const unsigned char*)(p.ws + WS_H8);
  const int* IDX = (const int*)(p.ws + WS_IDX);
  float* PD = (float*)(p.ws + WS_PD);
  const unsigned char* PU = (const unsigned char*)(p.ws + WS_PEERU) + (size_t)layer * (8 * NEXP * 128);
  const float* SC4 = (const float*)(p.ws + WS_USC4) + (size_t)layer * (8 * NEXP);
  unsigned* tick = (unsigned*)(p.ws + WS_TICKETS) + (size_t)(layer * 2 + 0) * 16 * 16;
  const int xcc = xcc_id() & 7;
#pragma unroll 1
  for (int so = 0; so < 8; ++so) {
    const int s = (xcc + so) & 7;
    unsigned tv = peer_ticket_issue(tick + s * 16);
    for (;;) {
      const int c = __builtin_amdgcn_readfirstlane((int)tv);
      if (c >= T_ / 16) break;
      tv = peer_ticket_issue(tick + s * 16);
#pragma unroll
      for (int gi = 0; gi < 2; ++gi) {
        const int* ip = IDX + (size_t)(c * 16 + gi * 8 + g) * 128 + 16 * j;
#pragma unroll
        for (int i = 0; i < 4; ++i) *(uint4*)(lidx_all + gi * 1024 + g * 128 + 16 * j + 4 * i) = *(const uint4*)(ip + 4 * i);
      }
#pragma unroll 1
      for (int gi = 0; gi < 2; ++gi) {
      const int t0 = c * 16 + gi * 8;
      const int* lidx = lidx_all + gi * 1024;
      unsigned xl[4], xh[4];
      {
        const unsigned char* hp = H8 + (size_t)(t0 + g) * D_ + s * 256 + 32 * j;
        const u32x4 h0 = *(const u32x4*)hp, h1 = *(const u32x4*)(hp + 16);
        const unsigned d[8] = {h0.x, h0.y, h0.z, h0.w, h1.x, h1.y, h1.z, h1.w};
#pragma unroll
        for (int m = 0; m < 4; ++m) {
          xl[m] = (d[2 * m] & 0x0F0F0F0Fu) | ((d[2 * m + 1] & 0x0F0F0F0Fu) << 4);
          xh[m] = ((swar_add8(d[2 * m]) >> 4) & 0x0F0F0F0Fu) | (swar_add8(d[2 * m + 1]) & 0xF0F0F0F0u);
        }
      }
      const unsigned char* ub = PU + (size_t)s * (NEXP * 128);
      const float* scs = SC4 + (size_t)s * NEXP;
      float* pd = PD + ((size_t)s * T_ + t0 + g) * 128;
      const bool b2_ = (lane & 4) != 0, b1_ = (lane & 2) != 0, b0_ = (lane & 1) != 0;
      u32x4 ra[8], rb[8], rc[8];
      float sa, sb, sc;
#define PD_LOAD(R, S, KB) { _Pragma("unroll") for (int q = 0; q < 8; ++q) { const int id = lidx[g * 128 + (KB) + q]; R[q] = *(const u32x4*)(ub + (unsigned)(id * 128 + 16 * j)); } \
                            S = scs[lidx[g * 128 + (KB) + j]]; }
#define DPPI(X, CTRL) __builtin_amdgcn_update_dpp(0, (X), (CTRL), 0xF, 0xF, true)
#define PD_COMP(R, S, KB)                                                                         \
      {                                                                                           \
        int pp[8];                                                                                \
        _Pragma("unroll") for (int q = 0; q < 8; ++q) {                                           \
          int al = __builtin_amdgcn_sdot8((int)R[q].x, (int)xl[0], 0, false);                     \
          int ah = __builtin_amdgcn_sdot8((int)R[q].x, (int)xh[0], 0, false);                     \
          al = __builtin_amdgcn_sdot8((int)R[q].y, (int)xl[1], al, false);                        \
          ah = __builtin_amdgcn_sdot8((int)R[q].y, (int)xh[1], ah, false);                        \
          al = __builtin_amdgcn_sdot8((int)R[q].z, (int)xl[2], al, false);                        \
          ah = __builtin_amdgcn_sdot8((int)R[q].z, (int)xh[2], ah, false);                        \
          al = __builtin_amdgcn_sdot8((int)R[q].w, (int)xl[3], al, false);                        \
          ah = __builtin_amdgcn_sdot8((int)R[q].w, (int)xh[3], ah, false);                        \
          pp[q] = al + 16 * ah;                                                                   \
        }                                                                                         \
          \
        int q4[4], q2[2];                                                                         \
        _Pragma("unroll") for (int i = 0; i < 4; ++i) {                                           \
          const int keep = b2_ ? pp[4 + i] : pp[i], send = b2_ ? pp[i] : pp[4 + i];               \
          q4[i] = keep + DPPI(send, 0x141);                   \
        }                                                                                         \
        _Pragma("unroll") for (int i = 0; i < 2; ++i) {                                           \
          const int keep = b1_ ? q4[2 + i] : q4[i], send = b1_ ? q4[i] : q4[2 + i];               \
          q2[i] = keep + DPPI(send, 0x4E);                      \
        }                                                                                         \
        {                                                                                         \
          const int keep = b0_ ? q2[1] : q2[0], send = b0_ ? q2[0] : q2[1];                       \
          pd[(KB) + j] = (float)(keep + DPPI(send, 0xB1)) * S;     \
        }                                                                                         \
        __builtin_amdgcn_sched_barrier(0);                                                        \
      }
      PD_LOAD(ra, sa, 0)
      PD_LOAD(rb, sb, 8)
#pragma unroll 1
      for (int kb = 0; kb < 120; kb += 24) {
        PD_LOAD(rc, sc, kb + 16)
        PD_COMP(ra, sa, kb)
        PD_LOAD(ra, sa, kb + 24)
        PD_COMP(rb, sb, kb + 8)
        { const int kl = kb + 32 < 120 ? kb + 32 : 120; PD_LOAD(rb, sb, kl) }
        PD_COMP(rc, sc, kb + 16)
      }
      PD_COMP(ra, sa, 120)
#undef PD_LOAD
#undef PD_COMP
#undef DPPI
      }
    }
  }
}

DI void phase_peer_act(const Params& p, int layer) {
  const int rtid = RTID(), lane = rtid & 63;
  const int gw = __builtin_amdgcn_readfirstlane((int)((blockIdx.x * RTHREADS + rtid) >> 6)), nw = (int)(gridDim.x * RTHREADS) >> 6;
  const float* PD = (const float*)(p.ws + WS_PD);
  const int* IDX = (const int*)(p.ws + WS_IDX);
  const float* GATE = (const float*)(p.ws + WS_GATE);
  const float* HS = (const float*)(p.ws + WS_HS);
  unsigned short* ACTQ = (unsigned short*)(p.ws + WS_ACT);
  float* ACTS = (float*)(p.ws + WS_ACT + 4 * MiB);
  const float* VSC = (const float*)(p.ws + WS_PEERV) + (size_t)(2 + layer) * NEXP;
  for (int t = gw; t < T_; t += nw) {
    const size_t e = (size_t)t * 128 + 2 * lane;
    float2 a = make_float2(0.f, 0.f);
#pragma unroll
    for (int s2 = 0; s2 < 8; ++s2) { const float2 q = *(const float2*)(PD + (size_t)s2 * T_ * 128 + e); a.x += q.x; a.y += q.y; }
    const int2 id = *(const int2*)(IDX + e);
    const float2 gt = *(const float2*)(GATE + e);
    const float hs = HS[t];
    const float v0 = gt.x * gelu_erf(a.x * hs) * VSC[id.x], v1 = gt.y * gelu_erf(a.y * hs) * VSC[id.y];
    const float am = wave_max(fmaxf(fabsf(v0), fabsf(v1)));
    const float qs = am > 0.f ? 127.f / am : 1.f;
    const int q0 = (int)rintf(v0 * qs), q1 = (int)rintf(v1 * qs);
    ACTQ[(size_t)t * 64 + lane] = (unsigned short)((q0 & 255) | ((q1 & 255) << 8));
    if (lane == 0) ACTS[t] = am > 0.f ? am / 127.f : 1.f;
  }
}

DI void phase_peer_values(const Params& p, int layer, const float* gate2, char* smem_all) {
  const int rtid = RTID(), lane = rtid & 63, rwave = __builtin_amdgcn_readfirstlane(rtid >> 6);
  const int g = lane >> 3, j = lane & 7;
  int* lidx_all = (int*)(smem_all + rwave * 16384);
  unsigned* lact_all = (unsigned*)(smem_all + rwave * 16384 + 4096);
  const int* IDX = (const int*)(p.ws + WS_IDX);
  const unsigned* ACTQ = (const unsigned*)(p.ws + WS_ACT);
  const float* ACTS = (const float*)(p.ws + WS_ACT + 4 * MiB);
  const unsigned char* PV = (const unsigned char*)(p.ws + WS_PEERV8) + (size_t)layer * NEXP * D_;
  unsigned* tick = (unsigned*)(p.ws + WS_TICKETS) + (size_t)(layer * 2 + 1) * 16 * 16;
  const int xcc = xcc_id() & 7;
#pragma unroll 1
  for (int so = 0; so < 16; ++so) {
    const int s = ((xcc + (so >> 1)) & 7) + 8 * (so & 1);
    unsigned tv = peer_ticket_issue(tick + s * 16);
    for (;;) {
      const int c = __builtin_amdgcn_readfirstlane((int)tv);
      if (c >= T_ / 16) break;
      tv = peer_ticket_issue(tick + s * 16);
#pragma unroll
      for (int gi = 0; gi < 2; ++gi) {
        const int* ip = IDX + (size_t)(c * 16 + gi * 8 + g) * 128 + 16 * j;
#pragma unroll
        for (int i = 0; i < 4; ++i) *(uint4*)(lidx_all + gi * 2048 + g * 128 + 16 * j + 4 * i) = *(const uint4*)(ip + 4 * i);
        *(uint4*)(lact_all + gi * 2048 + g * 32 + 4 * j) = *(const uint4*)(ACTQ + (size_t)(c * 16 + gi * 8 + g) * 32 + 4 * j);
      }
#pragma unroll 1
      for (int gi = 0; gi < 2; ++gi) {
      const int t0 = c * 16 + gi * 8;
      const int* lidx = lidx_all + gi * 2048;
      const unsigned* lact = lact_all + gi * 2048;
      const unsigned char* vb = PV + (size_t)s * (NEXP * 128);
      int y[16];
#pragma unroll
      for (int i = 0; i < 16; ++i) y[i] = 0;
      u32x4 ra[8], rb[8];
      const int tq = t0 + g;
      bf16_t* rrow = (bf16_t*)(p.ws + WS_R16) + (size_t)tq * D_ + s * 128 + 16 * j;
      float* orow = p.out + (size_t)tq * D_ + s * 128 + 16 * j;
      const float* grow = gate2 + (size_t)(tq >> 11) * 12288 + s * 128 + 16 * j;
      u32x4 ia0 = *(const u32x4*)(lidx + g * 128), ia1 = *(const u32x4*)(lidx + g * 128 + 4);
#define PV_LOAD(R, KBN) { const unsigned ids_[8] = {ia0.x, ia0.y, ia0.z, ia0.w, ia1.x, ia1.y, ia1.z, ia1.w};                         \
        _Pragma("unroll") for (int q = 0; q < 8; ++q) R[q] = *(const u32x4*)(vb + (ids_[q] * 128u + 16u * (unsigned)j));              \
        ia0 = *(const u32x4*)(lidx + g * 128 + (KBN)); ia1 = *(const u32x4*)(lidx + g * 128 + (KBN) + 4); }
#define PV_QUAD(W0, W1, W2, W3, AQ, YB) {                                                                                             \
        const unsigned t0_ = __builtin_amdgcn_perm((W1), (W0), 0x05010400u), t1_ = __builtin_amdgcn_perm((W1), (W0), 0x07030602u);    \
        const unsigned t2_ = __builtin_amdgcn_perm((W3), (W2), 0x05010400u), t3_ = __builtin_amdgcn_perm((W3), (W2), 0x07030602u);    \
        y[(YB) + 0] = __builtin_amdgcn_sdot4((int)__builtin_amdgcn_perm(t2_, t0_, 0x05040100u), (int)(AQ), y[(YB) + 0], false);       \
        y[(YB) + 1] = __builtin_amdgcn_sdot4((int)__builtin_amdgcn_perm(t2_, t0_, 0x07060302u), (int)(AQ), y[(YB) + 1], false);       \
        y[(YB) + 2] = __builtin_amdgcn_sdot4((int)__builtin_amdgcn_perm(t3_, t1_, 0x05040100u), (int)(AQ), y[(YB) + 2], false);       \
        y[(YB) + 3] = __builtin_amdgcn_sdot4((int)__builtin_amdgcn_perm(t3_, t1_, 0x07060302u), (int)(AQ), y[(YB) + 3], false); }
#define PV_COMP(R, KB)                                                                            \
      { const unsigned aq0 = lact[g * 32 + ((KB) >> 2)], aq1 = lact[g * 32 + ((KB) >> 2) + 1];    \
        PV_QUAD(R[0].x, R[1].x, R[2].x, R[3].x, aq0, 0)  PV_QUAD(R[0].y, R[1].y, R[2].y, R[3].y, aq0, 4)   \
        PV_QUAD(R[0].z, R[1].z, R[2].z, R[3].z, aq0, 8)  PV_QUAD(R[0].w, R[1].w, R[2].w, R[3].w, aq0, 12)  \
        __builtin_amdgcn_sched_barrier(0);                                                        \
        PV_QUAD(R[4].x, R[5].x, R[6].x, R[7].x, aq1, 0)  PV_QUAD(R[4].y, R[5].y, R[6].y, R[7].y, aq1, 4)   \
        PV_QUAD(R[4].z, R[5].z, R[6].z, R[7].z, aq1, 8)  PV_QUAD(R[4].w, R[5].w, R[6].w, R[7].w, aq1, 12)  \
        __builtin_amdgcn_sched_barrier(0); }
      PV_LOAD(ra, 8)
#pragma unroll 1
      for (int kb = 0; kb < 128; kb += 16) {
        { const int kn = kb + 16 < 120 ? kb + 16 : 120; PV_LOAD(rb, kn) }
        PV_COMP(ra, kb)
        { const int kn = kb + 24 < 120 ? kb + 24 : 120; PV_LOAD(ra, kn) }
        PV_COMP(rb, kb + 8)
      }
#undef PV_LOAD
#undef PV_COMP
#undef PV_QUAD
      const float as = ACTS[tq];
      const u32x4 r0 = *(const u32x4*)rrow, r1 = *(const u32x4*)(rrow + 8);
      const unsigned rw[8] = {r0.x, r0.y, r0.z, r0.w, r1.x, r1.y, r1.z, r1.w};
      float res[16];
#pragma unroll
      for (int i = 0; i < 4; ++i) {
        float4 g0 = *(const float4*)(grow + 4 * i);
        g0.x *= as; g0.y *= as; g0.z *= as; g0.w *= as;
        res[4 * i + 0] = bf_lo(rw[2 * i]) + g0.x * (float)y[4 * i];     res[4 * i + 1] = bf_hi(rw[2 * i]) + g0.y * (float)y[4 * i + 1];
        res[4 * i + 2] = bf_lo(rw[2 * i + 1]) + g0.z * (float)y[4 * i + 2]; res[4 * i + 3] = bf_hi(rw[2 * i + 1]) + g0.w * (float)y[4 * i + 3];
      }
      if (layer == 0) {
        u32x4 w0, w1;
        w0.x = pack_bf2(res[0], res[1]); w0.y = pack_bf2(res[2], res[3]); w0.z = pack_bf2(res[4], res[5]); w0.w = pack_bf2(res[6], res[7]);
        w1.x = pack_bf2(res[8], res[9]); w1.y = pack_bf2(res[10], res[11]); w1.z = pack_bf2(res[12], res[13]); w1.w = pack_bf2(res[14], res[15]);
        *(u32x4*)rrow = w0; *(u32x4*)(rrow + 8) = w1;
      } else {
#pragma unroll
        for (int i = 0; i < 4; ++i) *(float4*)(orow + 4 * i) = make_float4(res[4 * i], res[4 * i + 1], res[4 * i + 2], res[4 * i + 3]);
      }
      }
    }
  }
}

#define XB_TMO      128
#define XB_XCNT(j)  (256  + 64 * (j))
#define XB_XSUB(j)  (1280 + 64 * (j))
#define XB_XGEN(j)  (2304 + 64 * (j))
#define XB_TOP      3328
#define XB_TOPGEN   3392
#define XCD_BAR_WORDS 3456
#define XB_SPIN_CAP (1u << 22)
#define LAS __attribute__((address_space(3)))
DI unsigned xb_ld(unsigned* p) { return __hip_atomic_load(p, __ATOMIC_RELAXED, __HIP_MEMORY_SCOPE_AGENT); }
DI unsigned xb_add(unsigned* p, unsigned v) { return __hip_atomic_fetch_add(p, v, __ATOMIC_RELAXED, __HIP_MEMORY_SCOPE_AGENT); }
DI unsigned xb_xcc_id() { return (unsigned)__builtin_amdgcn_s_getreg((3 << 11) | 20) & 0xFu; }
#define XB_SPIN(cond, bar) do { unsigned _sp = 0; while (cond) { __builtin_amdgcn_s_sleep(1); \
    if ((++_sp & 255u) == 0u) { if (xb_ld(&(bar)[XB_TMO])) break; if (_sp > XB_SPIN_CAP) { atomicAdd(&(bar)[XB_TMO], 1u); break; } } } } while (0)
struct XcdBarrier { unsigned* bar; unsigned x; volatile LAS unsigned* st; };
DI XcdBarrier xcd_barrier_post(unsigned* bar, volatile LAS unsigned* st) {
  XcdBarrier b; b.bar = bar; b.x = xb_xcc_id(); b.st = st;
  if (threadIdx.x == 0) (void)xb_add(&bar[XB_XCNT(b.x)], 1u);
  return b;
}
DI void xcd_barrier_complete(unsigned* bar, unsigned x, unsigned& nloc, unsigned& nx) {
  const unsigned G = gridDim.x * gridDim.y * gridDim.z;
  unsigned sum, cnt, mine, sp = 0u;
  for (;;) {
    sum = 0u; cnt = 0u; mine = 0u;
#pragma unroll
    for (unsigned j = 0; j < 16; ++j) { const unsigned c = xb_ld(&bar[XB_XCNT(j)]); sum += c; cnt += (c > 0u) ? 1u : 0u; mine = (j == x) ? c : mine; }
    if (sum == G) break;
    __builtin_amdgcn_s_sleep(1);
    if ((++sp & 255u) == 0u) { if (xb_ld(&bar[XB_TMO])) break; if (sp > XB_SPIN_CAP) { atomicAdd(&bar[XB_TMO], 1u); break; } }
  }
  nloc = mine > 0u ? mine : 1u; nx = cnt > 0u ? cnt : 1u;
}
DI void xcd_barrier(const XcdBarrier& b) {
  asm volatile("s_waitcnt vmcnt(0)" ::: "memory");
  __syncthreads();
  if (threadIdx.x == 0) {
    unsigned* bar = b.bar;
    __builtin_amdgcn_s_waitcnt(0);
    unsigned nloc = b.st[0], nx = b.st[1];
    if (nloc == 0u) { xcd_barrier_complete(bar, b.x, nloc, nx); b.st[0] = nloc; b.st[1] = nx; }
    const unsigned old = xb_add(&bar[XB_XSUB(b.x)], 1u);
    const unsigned gen = old / nloc;
    if (old + 1u == (gen + 1u) * nloc) {
      __builtin_amdgcn_fence(__ATOMIC_RELEASE, "agent");
      asm volatile("s_waitcnt vmcnt(0)" ::: "memory");
      const unsigned og = xb_add(&bar[XB_TOP], 1u);
      const unsigned tg = og / nx;
      if (og + 1u == (tg + 1u) * nx) xb_add(&bar[XB_TOPGEN], 1u);
      else XB_SPIN(xb_ld(&bar[XB_TOPGEN]) == tg, bar);
      __builtin_amdgcn_fence(__ATOMIC_ACQUIRE, "agent");
      xb_add(&bar[XB_XGEN(b.x)], 1u);
      asm volatile("s_waitcnt vmcnt(0)" ::: "memory");
    } else {
      XB_SPIN(xb_ld(&bar[XB_XGEN(b.x)]) == gen, bar);
      __builtin_amdgcn_fence(__ATOMIC_ACQUIRE, "agent");
      asm volatile("s_waitcnt vmcnt(0)" ::: "memory");
    }
  }
  __syncthreads();
}

constexpr int N_PHASES = 22;
template <class Epi>
DI void gemm256(char* smem_all, const bf16_t* A, const bf16_t* Bt, int M, int N, int K, const Epi& E) {
  pg8::Gemm g{A, Bt, M, N, K};
  pg8::StaticOrder S; S.init(M, N, (int)gridDim.x, (int)blockIdx.x);
  pg8::gemm_phase<Epi, pg8::StaticOrder, false>((PG8_LAS unsigned char*)smem_all, g, S, E, nullptr);
}
template <int ph>
DI void run_phase(const Params& p_in, char* smem, char* smem_all) {
  Params p = p_in;
  {
    size_t z = 0; asm volatile("" : "+s"(z)); p.ws = p_in.ws + z; p.out = p_in.out + z;
  }
  char* ws = p.ws;
  const float* mod = (const float*)(ws + WS_MOD);
  const bf16_t* H = (const bf16_t*)(ws + WS_H);
  if (ph == 0) { phase_prep(p, smem); return; }
  const int layer = ph >= 12 ? 1 : 0;
  const int lp = ph - (layer ? 12 : 1);
  int sub;
  if (layer == 0) sub = lp < 2 ? lp : lp + 1;
  else sub = lp < 2 ? lp : (lp == 2 ? 3 : lp + 2);
  const float* modl = mod + (size_t)layer * 8 * 12288;
  switch (sub) {
    case 0:
      if (layer == 0) { phase_norm<true>(p, p.x, p.norm_gain, modl, modl + 2048); quant_wv(p); }
      else phase_norm<false, 2, true>(p, ws + WS_R16, p.norm_gain + 2 * 2048, modl, modl + 2048);
      break;
    case 1: {
      if (layer == 0) fox_cumsum(p);
      pg8::EpiQkNorm eq{(bf16_t*)(ws + WS_QK), 4096, layer ? p.odd_qk_gain : p.even_fox_qk_gain, layer ? p.odd_qk_gain : p.even_diff_qk_gain,
                        layer ? 4 : 3, (float*)(smem_all + 131072)};
      gemm256(smem_all, H, (const bf16_t*)(ws + (layer ? WS_WQK1 : WS_WQK0)), T_, 4096, 2048, eq);
      if (layer == 0) {
        pg8::EpiBf16 ev{(bf16_t*)(ws + WS_VT), T_};
        gemm256(smem_all, (const bf16_t*)(ws + WS_WV0), H, 2048, T_, 2048, ev);
      } else {
        pg8::EpiVt8 ev{(bf16_t*)(ws + WS_VT), T_, (const float*)(ws + WS_WV8 + 8 * MiB) + 2048, (const float*)(ws + WS_H8A + 32 * MiB)};
        gemm256(smem_all, (const bf16_t*)(ws + WS_WV8 + (size_t)2048 * 2048), (const bf16_t*)(ws + WS_H8A), 2048, T_, 1024, ev);
      }
    } break;
    case 3:
      if (layer == 0) phase_attn_even(p, smem_all); else phase_attn_odd(p, smem_all);
      break;
    case 4: phase_diff_combine(p); break;
    case 5: {
      bf16_t* R16 = (bf16_t*)(ws + WS_R16);
      if (layer == 0) { pg8::EpiRes16<false> er{R16, 2048, p.x, modl + 2 * 2048};
        gemm256(smem_all, (const bf16_t*)(ws + WS_ATT), (const bf16_t*)(ws + WS_WO0), T_, 2048, 2048, er); }
      else { pg8::EpiRes16<true> er{R16, 2048, R16, modl + 2 * 2048};
        gemm256(smem_all, (const bf16_t*)(ws + WS_ATT), (const bf16_t*)(ws + WS_WO1), T_, 2048, 2048, er); }
    } break;
    case 6:
      phase_norm<false, 1, true>(p, ws + WS_R16, p.norm_gain + (layer * 2 + 1) * 2048, modl + 3 * 2048, modl + 4 * 2048);
      break;
    case 7: {
      pg8::EpiBf16 es{(bf16_t*)(ws + WS_SC), 2048};
      gemm256(smem_all, H, (const bf16_t*)(ws + (layer ? WS_WQ1 : WS_WQ0)), T_, 2048, 2048, es);
    } break;
    case 8: phase_peer_retrieve(p, smem); break;
    case 9: phase_peer_dots(p, layer, smem_all); break;
    case 10: phase_peer_act(p, layer); break;
    case 11: phase_peer_values(p, layer, modl + 5 * 2048, smem_all); break;
  }
}

#if FUSED
template <int PH>
DI void run_all(const Params& p, char* smem, char* smem_all, const XcdBarrier& xb, cg::grid_group& grid) {
  if constexpr (PH < N_PHASES) {
    run_phase<PH>(p, smem, smem_all);
    if constexpr (PH + 1 < N_PHASES) xcd_barrier(xb);
    run_all<PH + 1>(p, smem, smem_all, xb, grid);
  }
}
__global__ void __launch_bounds__(RTHREADS, 2) mega_kernel(Params p) {
  extern __shared__ __attribute__((aligned(16))) char smem_all[];
  char* smem = smem_all + (RTID() >> 8) * HALF_SMEM;
  cg::grid_group grid = cg::this_grid();
  volatile LAS unsigned* xst = (volatile LAS unsigned*)(smem_all + SMEM_BYTES - 16);
  if (threadIdx.x == 0) { xst[0] = 0u; xst[1] = 0u; }
  __syncthreads();
  const XcdBarrier xb = xcd_barrier_post((unsigned*)(p.ws + WS_BAR), xst);
  if (p.ws == nullptr) grid.sync();
  run_all<0>(p, smem, smem_all, xb, grid);
}
#else
template <int PH>
__global__ void __launch_bounds__(RTHREADS, 2) phase_kernel(Params p) {
  extern __shared__ __attribute__((aligned(16))) char smem_all[];
  char* smem = smem_all + (RTID() >> 8) * HALF_SMEM;
  run_phase<PH>(p, smem, smem_all);
}
template <int PH>
static void launch_phases(const Params& p, int grid, hipStream_t stream) {
  if constexpr (PH < N_PHASES) {
    (void)hipFuncSetAttribute((const void*)phase_kernel<PH>, hipFuncAttributeMaxDynamicSharedMemorySize, SMEM_BYTES);
    phase_kernel<PH><<<grid, RTHREADS, SMEM_BYTES, stream>>>(p);
    launch_phases<PH + 1>(p, grid, stream);
  }
}
#endif

extern "C" void kernel_launch(void* const* d_in, const int* in_sizes, int n_in, void* d_out, int out_size, void* d_ws,
                              size_t ws_size, hipStream_t stream) {
  Params p{};
  p.x = (const float*)d_in[0]; p.c = (const float*)d_in[1]; p.rel_bias = (const float*)d_in[2];
  p.norm_gain = (const float*)d_in[3]; p.w_ada = (const float*)d_in[4]; p.b_ada = (const float*)d_in[5];
  p.even_w_in = (const float*)d_in[6]; p.even_b_forget = (const float*)d_in[7]; p.even_fox_qk_gain = (const float*)d_in[8];
  p.even_diff_qk_gain = (const float*)d_in[9]; p.even_diff_lambda = (const float*)d_in[10];
  p.even_diff_subln_gain = (const float*)d_in[11]; p.even_w_out = (const float*)d_in[12];
  p.odd_w_qkv = (const float*)d_in[13]; p.odd_qk_gain = (const float*)d_in[14]; p.odd_w_out = (const float*)d_in[15];
  p.peer_w_query = (const float*)d_in[16]; p.peer_sub_keys = (const float*)d_in[17];
  p.peer_u = (const float*)d_in[18]; p.peer_v = (const float*)d_in[19];
  p.out = (float*)d_out; p.ws = (char*)d_ws;
  if (ws_size < WS_END) { fprintf(stderr, "workspace too small: %zu < %zu\n", ws_size, (size_t)WS_END); return; }
#if FUSED
  static int grid_blocks = 0;
  if (!grid_blocks) {
    int dev = 0, cus = 0, per_cu = 0;
    (void)hipGetDevice(&dev);
    (void)hipDeviceGetAttribute(&cus, hipDeviceAttributeMultiprocessorCount, dev);
    (void)hipFuncSetAttribute((const void*)mega_kernel, hipFuncAttributeMaxDynamicSharedMemorySize, SMEM_BYTES);
    (void)hipOccupancyMaxActiveBlocksPerMultiprocessor(&per_cu, mega_kernel, RTHREADS, SMEM_BYTES);
    if (per_cu > 1) per_cu = 1;
    grid_blocks = cus * per_cu;
  }
  (void)hipMemsetAsync(p.ws + WS_BAR, 0, WS_BAR_BYTES, stream);
  void* args[] = {&p};
  hipError_t e = hipLaunchCooperativeKernel((void*)mega_kernel, dim3(grid_blocks), dim3(RTHREADS), args, SMEM_BYTES, stream);
  if (e != hipSuccess) fprintf(stderr, "cooperative launch failed: %s (grid %d)\n", hipGetErrorString(e), grid_blocks);
#else
  launch_phases<0>(p, 256, stream);
#endif
}
```

```cpp
#include <hip/hip_runtime.h>
#include <hip/hip_cooperative_groups.h>
#include <stdint.h>
#include <stdio.h>
namespace cg = cooperative_groups;

#ifndef FUSED
#define FUSED 1
#endif

#define DI __device__ __forceinline__
typedef unsigned short bf16_t;
typedef __attribute__((ext_vector_type(8))) short bf16x8;
typedef __attribute__((ext_vector_type(4))) short bf16x4;
typedef __attribute__((ext_vector_type(16))) float f32x16;
typedef __attribute__((ext_vector_type(2))) __bf16 bf2_t;
typedef __attribute__((ext_vector_type(2))) float f2_t;
typedef __attribute__((ext_vector_type(4))) unsigned u32x4;
#define MFMA32(a, b, c) __builtin_amdgcn_mfma_f32_32x32x16_bf16((a), (b), (c), 0, 0, 0)

constexpr int T_ = 16384;
constexpr int D_ = 2048;
constexpr int S_ = 2048;
constexpr int NB_ = 8;
constexpr int NEXP = 16384;
constexpr float LOG2E = 1.4426950408889634f;
constexpr int NTHREADS = 256;
constexpr int HALF_SMEM = 75776;
constexpr int RTHREADS = 512;
constexpr int SMEM_BYTES = 2 * HALF_SMEM + 16;

constexpr size_t MiB = 1048576;
constexpr size_t WS_PEERU = 0;
constexpr size_t WS_PEERV8 = WS_PEERU + 64 * MiB;
constexpr size_t WS_PEERV = WS_PEERU + 128 * MiB;
constexpr size_t WS_WQK0 = WS_PEERV + 128 * MiB;
constexpr size_t WS_WV0 = WS_WQK0 + 16 * MiB;
constexpr size_t WS_WQK1 = WS_WV0 + 8 * MiB;
constexpr size_t WS_WV1 = WS_WQK1 + 16 * MiB;
constexpr size_t WS_WO0 = WS_WV1 + 8 * MiB;
constexpr size_t WS_WO1 = WS_WO0 + 8 * MiB;
constexpr size_t WS_WQ0 = WS_WO1 + 8 * MiB;
constexpr size_t WS_WQ1 = WS_WQ0 + 8 * MiB;
constexpr size_t WS_SK = WS_WQ1 + 8 * MiB;
constexpr size_t WS_WFF = WS_SK + 131072;
constexpr size_t WS_MOD = WS_WFF + 65536;
constexpr size_t WS_LOGF = WS_MOD + 786432;
constexpr size_t WS_FCUM = WS_LOGF + 524288;
constexpr size_t WS_MISC = WS_FCUM + 524288;
constexpr size_t WS_H = WS_MISC + 65536;
constexpr size_t WS_QK = WS_H + 64 * MiB;
constexpr size_t WS_VT = WS_QK + 128 * MiB;
constexpr size_t WS_ATT = WS_VT + 64 * MiB;
constexpr size_t WS_SC = WS_ATT + 64 * MiB;
constexpr size_t WS_BAR = WS_SC + 128 * MiB;
constexpr size_t WS_TICKETS = WS_BAR + 16384;
constexpr size_t WS_BAR_BYTES = 16384 + 4096;
constexpr size_t WS_IDX = WS_ATT;
constexpr size_t WS_GATE = WS_ATT + 8 * MiB;
constexpr size_t WS_ACT = WS_ATT + 16 * MiB;
constexpr size_t WS_PD = WS_SC;
constexpr size_t WS_USC4 = WS_PEERV + 1 * MiB;
constexpr size_t WS_H8 = WS_QK;
constexpr size_t WS_HS = WS_QK + 32 * MiB;
constexpr size_t WS_R16 = WS_BAR + 65536;
constexpr size_t WS_H8A = WS_R16 + 64 * MiB;
constexpr size_t WS_W8 = WS_H8A + 33 * MiB;
constexpr size_t WS_END = WS_W8 + 25 * MiB;

struct Params {
  const float* x; const float* c; const float* rel_bias; const float* norm_gain; const float* w_ada; const float* b_ada;
  const float* even_w_in; const float* even_b_forget; const float* even_fox_qk_gain; const float* even_diff_qk_gain;
  const float* even_diff_lambda; const float* even_diff_subln_gain; const float* even_w_out;
  const float* odd_w_qkv; const float* odd_qk_gain; const float* odd_w_out;
  const float* peer_w_query; const float* peer_sub_keys; const float* peer_u; const float* peer_v;
  float* out; char* ws;
};

DI unsigned pack_bf2(float a, float b) { f2_t v = {a, b}; return __builtin_bit_cast(unsigned, __builtin_convertvector(v, bf2_t)); }
DI unsigned pack_i8x4(float a, float b, float c, float d) {
  const int ia = (int)rintf(a), ib = (int)rintf(b), ic = (int)rintf(c), id = (int)rintf(d);
  return (unsigned)(ia & 255) | ((unsigned)(ib & 255) << 8) | ((unsigned)(ic & 255) << 16) | ((unsigned)id << 24);
}
DI unsigned q4(float v) { int q = (int)rintf(v); q = q > 7 ? 7 : (q < -7 ? -7 : q); return (unsigned)q & 15u; }
DI unsigned pack_i4x4(float a, float b, float c, float d) { return q4(a) | (q4(b) << 8) | (q4(c) << 16) | (q4(d) << 24); }
DI bf16_t f2bf(float a) { return (bf16_t)(pack_bf2(a, 0.f) & 0xffffu); }
DI float bf_lo(unsigned u) { return __uint_as_float(u << 16); }
DI float bf_hi(unsigned u) { return __uint_as_float(u & 0xffff0000u); }
DI int RTID() { int t = threadIdx.x; asm volatile("" : "+v"(t)); return t; }
DI int TID() { return RTID() & 255; }
DI int VBID() { return __builtin_amdgcn_readfirstlane(blockIdx.x * 2 + (RTID() >> 8)); }
DI int VGRID() { return gridDim.x * 2; }
DI int xcc_id() { return (int)(__builtin_amdgcn_s_getreg((3 << 11) | 20) & 0xFu); }
DI int crow(int reg, int h) { return (reg & 3) + 8 * (reg >> 2) + 4 * h; }
DI float wave_sum(float v) {
#pragma unroll
  for (int o = 32; o >= 1; o >>= 1) v += __shfl_xor(v, o);
  return v;
}
DI float wave_max(float v) {
#pragma unroll
  for (int o = 32; o >= 1; o >>= 1) v = fmaxf(v, __shfl_xor(v, o));
  return v;
}

DI void transpose_tile(const float* __restrict__ src, int ld, int c0, int k0, bf16_t* __restrict__ dst_row0, char* smem) {
  float* tile = (float*)smem;
  const int tid = TID();
  const int ty = tid >> 4, tx = tid & 15;
#pragma unroll
  for (int i = 0; i < 4; ++i) {
    const int k = ty + 16 * i;
    const float4 v = *(const float4*)(src + (size_t)(k0 + k) * ld + c0 + 4 * tx);
    float* t = tile + k * 65 + 4 * tx;
    t[0] = v.x; t[1] = v.y; t[2] = v.z; t[3] = v.w;
  }
  __syncthreads();
  const int cc = tid >> 2, kc = (tid & 3) * 16;
  unsigned pk[8];
#pragma unroll
  for (int j = 0; j < 8; ++j) pk[j] = pack_bf2(tile[(kc + 2 * j) * 65 + cc], tile[(kc + 2 * j + 1) * 65 + cc]);
  uint4* d = (uint4*)(dst_row0 + (size_t)cc * 2048 + k0 + kc);
  d[0] = make_uint4(pk[0], pk[1], pk[2], pk[3]);
  d[1] = make_uint4(pk[4], pk[5], pk[6], pk[7]);
  __syncthreads();
}

DI void phase_prep(const Params& p, char* smem) {
  const int tid = TID(), bid = VBID(), G = VGRID();
  char* ws = p.ws;
  {
    float* cond = (float*)smem;
    bool have_cond = false;
    for (int item = bid; item < 384; item += G) {
      if (!have_cond) {
        for (int e = tid; e < NB_ * D_; e += NTHREADS) {
          const int b = e >> 11, d = e & 2047;
          const float v = p.c[e];
          cond[d * 8 + b] = v / (1.f + __expf(-v));
        }
        have_cond = true;
        __syncthreads();
      }
      const int i = item / 192, n = (item % 192) * 64 + (tid & 63);
      const int w = tid >> 6;
      const float* wp = p.w_ada + (size_t)i * D_ * 12288 + n;
      float acc[8];
#pragma unroll
      for (int b = 0; b < 8; ++b) acc[b] = 0.f;
#pragma unroll 8
      for (int d = w; d < D_; d += 4) {
        const float wv = wp[(size_t)d * 12288];
        const float4 c0 = *(const float4*)(cond + d * 8), c1 = *(const float4*)(cond + d * 8 + 4);
        acc[0] += c0.x * wv; acc[1] += c0.y * wv; acc[2] += c0.z * wv; acc[3] += c0.w * wv;
        acc[4] += c1.x * wv; acc[5] += c1.y * wv; acc[6] += c1.z * wv; acc[7] += c1.w * wv;
      }
      float* red = (float*)(smem + 65536);
#pragma unroll
      for (int b = 0; b < 8; ++b) red[(w * 64 + (tid & 63)) * 8 + b] = acc[b];
      __syncthreads();
      if (tid < 64) {
        float* mod = (float*)(ws + WS_MOD);
#pragma unroll
        for (int b = 0; b < 8; ++b) {
          const float s = red[(0 * 64 + tid) * 8 + b] + red[(1 * 64 + tid) * 8 + b] + red[(2 * 64 + tid) * 8 + b] + red[(3 * 64 + tid) * 8 + b];
          mod[((size_t)i * 8 + b) * 12288 + n] = s + p.b_ada[i * 12288 + n];
        }
      }
      __syncthreads();
    }
    __syncthreads();
  }
  {
    bf16_t* wqk0 = (bf16_t*)(ws + WS_WQK0); bf16_t* wv0 = (bf16_t*)(ws + WS_WV0);
    bf16_t* wqk1 = (bf16_t*)(ws + WS_WQK1); bf16_t* wv1 = (bf16_t*)(ws + WS_WV1);
    for (int item = bid; item < 256 * 32; item += G) {
      const int ct = item >> 5, kt = item & 31;
      const float* src; int ld, c0; bf16_t* dst;
      if (ct < 96) {
        const int seg = ct >> 4, cl = (ct & 15) * 64;
        src = p.even_w_in; ld = 6152;
        c0 = (seg < 3 ? seg * 1024 : 3080 + (seg - 3) * 1024) + cl;
        if (seg == 0) dst = wqk0 + (size_t)cl * 2048;
        else if (seg == 1) dst = wqk0 + (size_t)(1024 + cl) * 2048;
        else if (seg == 2) dst = wv0 + (size_t)cl * 2048;
        else if (seg == 3) dst = wqk0 + (size_t)(2048 + cl) * 2048;
        else if (seg == 4) dst = wqk0 + (size_t)(3072 + cl) * 2048;
        else dst = wv0 + (size_t)(1024 + cl) * 2048;
      } else if (ct < 192) {
        const int cl = (ct - 96) * 64;
        src = p.odd_w_qkv; ld = 6144; c0 = cl;
        dst = cl < 4096 ? wqk1 + (size_t)cl * 2048 : wv1 + (size_t)(cl - 4096) * 2048;
      } else {
        const int mi = (ct - 192) >> 5, cl = ((ct - 192) & 31) * 64;
        ld = 2048; c0 = cl;
        if (mi == 0) { src = p.even_w_out; dst = (bf16_t*)(ws + WS_WO0); }
        else { src = p.odd_w_out; dst = (bf16_t*)(ws + WS_WO1); }
        dst += (size_t)cl * 2048;
      }
      transpose_tile(src, ld, c0, kt * 64, dst, smem);
    }
  }
  {
    const int lane = tid & 63;
    const int gw = __builtin_amdgcn_readfirstlane((bid * NTHREADS + tid) >> 6), nw = (G * NTHREADS) >> 6;
    float* scl = (float*)(ws + WS_PEERV);
    float4 nx[8];
    {
      const int r0 = gw < 4 * NEXP ? gw : 0;
      const float* s0 = ((r0 >> 15) ? p.peer_v : p.peer_u) + (size_t)(r0 & 32767) * D_;
#pragma unroll
      for (int i = 0; i < 2; ++i)
#pragma unroll
        for (int j = 0; j < 4; ++j) nx[4 * i + j] = *(const float4*)(s0 + lane * 16 + 1024 * i + 4 * j);
    }
    for (int row = gw; row < 4 * NEXP; row += nw) {
      const int tab = row >> 15, rr = row & 32767;
      unsigned char* dst = (unsigned char*)(ws + (tab ? WS_PEERV8 : WS_PEERU)) + (size_t)(rr >> 14) * NEXP * D_ + (size_t)(rr & (NEXP - 1)) * 128;
      float4 v[8];
      float am = 0.f;
#pragma unroll
      for (int i = 0; i < 8; ++i) v[i] = nx[i];
      {
        const int rn = row + nw < 4 * NEXP ? row + nw : row;
        const float* sn = ((rn >> 15) ? p.peer_v : p.peer_u) + (size_t)(rn & 32767) * D_;
#pragma unroll
        for (int i = 0; i < 2; ++i)
#pragma unroll
          for (int j = 0; j < 4; ++j) nx[4 * i + j] = *(const float4*)(sn + lane * 16 + 1024 * i + 4 * j);
        asm volatile("" ::: "memory");
      }
#pragma unroll
      for (int i = 0; i < 8; ++i) am = fmaxf(am, fmaxf(fmaxf(fabsf(v[i].x), fabsf(v[i].y)), fmaxf(fabsf(v[i].z), fabsf(v[i].w))));
      if (!tab) {
        unsigned char* d4 = (unsigned char*)(ws + WS_PEERU) + (size_t)(rr >> 14) * (8 * NEXP * 128) + (size_t)(rr & (NEXP - 1)) * 128 + (lane & 15) * 8;
        float* sc4 = (float*)(ws + WS_USC4) + (size_t)(rr >> 14) * (8 * NEXP) + (rr & (NEXP - 1));
#pragma unroll
        for (int i = 0; i < 2; ++i) {
          float bm = 0.f;
#pragma unroll
          for (int j = 0; j < 4; ++j) bm = fmaxf(bm, fmaxf(fmaxf(fabsf(v[4 * i + j].x), fabsf(v[4 * i + j].y)), fmaxf(fabsf(v[4 * i + j].z), fabsf(v[4 * i + j].w))));
#pragma unroll
          for (int o = 1; o < 16; o <<= 1) bm = fmaxf(bm, __shfl_xor(bm, o));
          const float sc = bm > 0.f ? 7.5f / bm : 1.f;
          const int slice = 4 * i + (lane >> 4);
          if ((lane & 15) == 0) sc4[(size_t)slice * NEXP] = bm > 0.f ? bm / 7.5f : 1.f;
          unsigned w[2];
#pragma unroll
          for (int gq = 0; gq < 2; ++gq) {
            const float4 a = v[4 * i + 2 * gq], b = v[4 * i + 2 * gq + 1];
            const unsigned lo = pack_i4x4(a.x * sc, a.y * sc, a.z * sc, a.w * sc);
            const unsigned hi = pack_i4x4(b.x * sc, b.y * sc, b.z * sc, b.w * sc);
            w[gq] = lo | (hi << 4);
          }
          *(uint2*)(d4 + (size_t)slice * (NEXP * 128)) = make_uint2(w[0], w[1]);
        }
        continue;
      }
      am = wave_max(am);
      const float sc = am > 0.f ? 127.f / am : 1.f;
      if (lane == 0) scl[row] = am > 0.f ? am / 127.f : 1.f;
#pragma unroll
      for (int i = 0; i < 2; ++i) {
        unsigned w[4];
#pragma unroll
        for (int j = 0; j < 4; ++j) w[j] = pack_i8x4(v[4 * i + j].x * sc, v[4 * i + j].y * sc, v[4 * i + j].z * sc, v[4 * i + j].w * sc);
        *(uint4*)(dst + (size_t)((lane >> 3) + 8 * i) * (NEXP * 128) + (lane & 7) * 16) = make_uint4(w[0], w[1], w[2], w[3]);
      }
    }
  }
  {
    float* sks = (float*)smem;
    float* wqs = (float*)(smem + 33792);
    const int tn = tid >> 4, tk = tid & 15;
    for (int item = bid; item < 2048; item += G) {
      const int layer = item >> 10, hp = (item >> 6) & 15, nt = (item >> 5) & 1, kt = item & 31;
      const float* sk = p.peer_sub_keys + ((size_t)(layer * 2 + (hp & 1)) * 128 + nt * 64) * 128;
      const float* wq = p.peer_w_query + (size_t)layer * 2048 * 2048 + (size_t)(kt * 64) * 2048 + hp * 128;
      __syncthreads();
#pragma unroll
      for (int i = 0; i < 8; ++i) {
        const int idx = tid + 256 * i, row = idx >> 5, c4 = (idx & 31) * 4;
        *(float4*)(sks + row * 132 + c4) = *(const float4*)(sk + (size_t)row * 128 + c4);
        *(float4*)(wqs + row * 132 + c4) = *(const float4*)(wq + (size_t)row * 2048 + c4);
      }
      __syncthreads();
      float acc[4][4];
#pragma unroll
      for (int i = 0; i < 4; ++i)
#pragma unroll
        for (int j = 0; j < 4; ++j) acc[i][j] = 0.f;
#pragma unroll 4
      for (int d = 0; d < 128; d += 4) {
        float4 a[4], b[4];
#pragma unroll
        for (int i = 0; i < 4; ++i) { a[i] = *(const float4*)(sks + (tn + 16 * i) * 132 + d); b[i] = *(const float4*)(wqs + (tk + 16 * i) * 132 + d); }
#pragma unroll
        for (int i = 0; i < 4; ++i)
#pragma unroll
          for (int j = 0; j < 4; ++j) acc[i][j] += a[i].x * b[j].x + a[i].y * b[j].y + a[i].z * b[j].z + a[i].w * b[j].w;
      }
      bf16_t* dst = (bf16_t*)(ws + (layer ? WS_WQ1 : WS_WQ0)) + (size_t)(hp * 128 + nt * 64) * 2048 + kt * 64;
#pragma unroll
      for (int i = 0; i < 4; ++i)
#pragma unroll
        for (int j = 0; j < 4; ++j) dst[(size_t)(tn + 16 * i) * 2048 + tk + 16 * j] = f2bf(acc[i][j]);
    }
    __syncthreads();
  }
  if (bid == G - 1) {
    float* wff = (float*)(ws + WS_WFF);
    for (int e = tid; e < 2048 * 8; e += NTHREADS) wff[e] = p.even_w_in[(size_t)(e >> 3) * 6152 + 3072 + (e & 7)];
    if (tid < 64) {
      const float* l = p.even_diff_lambda;
      float s1 = l[tid] * l[128 + tid] + l[64 + tid] * l[128 + 64 + tid];
      float s2 = l[256 + tid] * l[384 + tid] + l[256 + 64 + tid] * l[384 + 64 + tid];
      s1 = wave_sum(s1); s2 = wave_sum(s2);
      if (tid == 0) ((float*)(ws + WS_MISC))[0] = expf(s1) - expf(s2) + 0.2f;
    }
  }
}

template <bool FF, int Q8 = 0, bool IN16 = false>
DI void phase_norm(const Params& p, const void* __restrict__ xin_, const float* __restrict__ gain,
                   const float* __restrict__ sh, const float* __restrict__ sc  ) {
  const int lane = TID() & 63;
  const int gw = __builtin_amdgcn_readfirstlane((VBID() * NTHREADS + TID()) >> 6), nw = (VGRID() * NTHREADS) >> 6;
  bf16_t* H = (bf16_t*)(p.ws + WS_H);
  for (int t = gw; t < T_; t += nw) {
    const int b = t >> 11;
    float4 v[8];
    float ss = 0.f;
    if (IN16) {
      const bf16_t* xr = (const bf16_t*)xin_ + (size_t)t * D_;
#pragma unroll
      for (int i = 0; i < 8; ++i) { const uint2 w = *(const uint2*)(xr + lane * 4 + 256 * i); v[i] = make_float4(bf_lo(w.x), bf_hi(w.x), bf_lo(w.y), bf_hi(w.y)); }
    } else {
      const float* xr = (const float*)xin_ + (size_t)t * D_;
#pragma unroll
      for (int i = 0; i < 8; ++i) v[i] = *(const float4*)(xr + lane * 4 + 256 * i);
    }
#pragma unroll
    for (int i = 0; i < 8; ++i) ss += v[i].x * v[i].x + v[i].y * v[i].y + v[i].z * v[i].z + v[i].w * v[i].w;
    ss = wave_sum(ss);
    const float rstd = rsqrtf(ss * (1.f / 2048.f) + 1e-6f);
    float ff[8];
    if (FF) {
#pragma unroll
      for (int j = 0; j < 8; ++j) ff[j] = 0.f;
    }
    float am = 0.f;
#pragma unroll
    for (int i = 0; i < 8; ++i) {
      const int c = lane * 4 + 256 * i;
      const float4 g = *(const float4*)(gain + c);
      const float4 s1 = *(const float4*)(sc + (size_t)b * 12288 + c);
      const float4 s0 = *(const float4*)(sh + (size_t)b * 12288 + c);
      float4 h;
      h.x = v[i].x * rstd * g.x * (1.f + s1.x) + s0.x;
      h.y = v[i].y * rstd * g.y * (1.f + s1.y) + s0.y;
      h.z = v[i].z * rstd * g.z * (1.f + s1.z) + s0.z;
      h.w = v[i].w * rstd * g.w * (1.f + s1.w) + s0.w;
      *(uint2*)(H + (size_t)t * D_ + c) = make_uint2(pack_bf2(h.x, h.y), pack_bf2(h.z, h.w));
      if (Q8) { v[i] = h; am = fmaxf(am, fmaxf(fmaxf(fabsf(h.x), fabsf(h.y)), fmaxf(fabsf(h.z), fabsf(h.w)))); }
      if (FF) {
        const float* wff = (const float*)(p.ws + WS_WFF) + c * 8;
        const float hv[4] = {h.x, h.y, h.z, h.w};
#pragma unroll
        for (int e = 0; e < 4; ++e) {
          const float4 w0 = *(const float4*)(wff + e * 8), w1 = *(const float4*)(wff + e * 8 + 4);
          ff[0] += hv[e] * w0.x; ff[1] += hv[e] * w0.y; ff[2] += hv[e] * w0.z; ff[3] += hv[e] * w0.w;
          ff[4] += hv[e] * w1.x; ff[5] += hv[e] * w1.y; ff[6] += hv[e] * w1.z; ff[7] += hv[e] * w1.w;
        }
      }
    }
    if (Q8) {
      am = wave_max(am);
      const float qs = am > 0.f ? 119.f / am : 1.f;
      unsigned char* h8 = (unsigned char*)(p.ws + (Q8 == 1 ? WS_H8 : WS_H8A)) + (size_t)t * D_ + lane * 4;
#pragma unroll
      for (int i = 0; i < 8; ++i) *(unsigned*)(h8 + 256 * i) = pack_i8x4(v[i].x * qs, v[i].y * qs, v[i].z * qs, v[i].w * qs);
      if (lane == 0) ((float*)(p.ws + (Q8 == 1 ? WS_HS : WS_H8A + 32 * MiB)))[t] = am > 0.f ? am / 119.f : 1.f;
    }
    if (FF) {
#pragma unroll
      for (int j = 0; j < 8; ++j) ff[j] = wave_sum(ff[j]);
      if (lane < 8) {
        float z = ff[0];
#pragma unroll
        for (int j = 1; j < 8; ++j) z = (lane == j) ? ff[j] : z;
        z += p.even_b_forget[lane];
        const float lf = fminf(z, 0.f) - log1pf(__expf(-fabsf(z)));
        ((float*)(p.ws + WS_LOGF))[(size_t)t * 8 + lane] = lf;
      }
    }
  }
}

DI void quant_w8(const Params& p) {
  const int lane = TID() & 63;
  const int gw = __builtin_amdgcn_readfirstlane((VBID() * NTHREADS + TID()) >> 6), nw = (VGRID() * NTHREADS) >> 6;
  for (int row = gw; row < 12288; row += nw) {
    const int layer = row >= 6144 ? 1 : 0, rl = row - layer * 6144;
    const size_t sbase = rl < 4096 ? (layer ? WS_WQK1 : WS_WQK0) : (layer ? WS_WV1 : WS_WV0);
    const bf16_t* src = (const bf16_t*)(p.ws + sbase) + (size_t)(rl < 4096 ? rl : rl - 4096) * 2048 + lane * 32;
    u32x4 w[4];
#pragma unroll
    for (int i = 0; i < 4; ++i) w[i] = *(const u32x4*)(src + 8 * i);
    float f[32];
    float am = 0.f;
#pragma unroll
    for (int i = 0; i < 4; ++i)
#pragma unroll
      for (int j = 0; j < 4; ++j) { f[8 * i + 2 * j] = bf_lo(w[i][j]); f[8 * i + 2 * j + 1] = bf_hi(w[i][j]); am = fmaxf(am, fmaxf(fabsf(f[8 * i + 2 * j]), fabsf(f[8 * i + 2 * j + 1]))); }
    am = wave_max(am);
    const float sc = am > 0.f ? 127.f / am : 1.f;
    unsigned q[8];
#pragma unroll
    for (int i = 0; i < 8; ++i) q[i] = pack_i8x4(f[4 * i] * sc, f[4 * i + 1] * sc, f[4 * i + 2] * sc, f[4 * i + 3] * sc);
    unsigned char* dst = (unsigned char*)(p.ws + WS_W8) + (size_t)row * 2048 + lane * 32;
    *(u32x4*)dst = (u32x4){q[0], q[1], q[2], q[3]};
    *(u32x4*)(dst + 16) = (u32x4){q[4], q[5], q[6], q[7]};
    if (lane == 0) ((float*)(p.ws + WS_W8 + 24 * MiB))[row] = am > 0.f ? am / 127.f : 1.f;
  }
}

DI void forget_logits(const Params& p) {
  const int lane = TID() & 63;
  const int gw = __builtin_amdgcn_readfirstlane((VBID() * NTHREADS + TID()) >> 6), nw = (VGRID() * NTHREADS) >> 6;
  const bf16_t* H = (const bf16_t*)(p.ws + WS_H);
  for (int t = gw; t < T_; t += nw) {
    float ff[8];
#pragma unroll
    for (int j = 0; j < 8; ++j) ff[j] = 0.f;
#pragma unroll 2
    for (int i = 0; i < 8; ++i) {
      const int c = lane * 4 + 256 * i;
      const uint2 hw = *(const uint2*)(H + (size_t)t * D_ + c);
      const float hv[4] = {bf_lo(hw.x), bf_hi(hw.x), bf_lo(hw.y), bf_hi(hw.y)};
      const float* wff = (const float*)(p.ws + WS_WFF) + c * 8;
#pragma unroll
      for (int e = 0; e < 4; ++e) {
        const float4 w0 = *(const float4*)(wff + e * 8), w1 = *(const float4*)(wff + e * 8 + 4);
        ff[0] += hv[e] * w0.x; ff[1] += hv[e] * w0.y; ff[2] += hv[e] * w0.z; ff[3] += hv[e] * w0.w;
        ff[4] += hv[e] * w1.x; ff[5] += hv[e] * w1.y; ff[6] += hv[e] * w1.z; ff[7] += hv[e] * w1.w;
      }
    }
#pragma unroll
    for (int j = 0; j < 8; ++j) ff[j] = wave_sum(ff[j]);
    if (lane < 8) {
      float z = ff[0];
#pragma unroll
      for (int j = 1; j < 8; ++j) z = (lane == j) ? ff[j] : z;
      z += p.even_b_forget[lane];
      const float lf = fminf(z, 0.f) - log1pf(__expf(-fabsf(z)));
      ((float*)(p.ws + WS_LOGF))[(size_t)t * 8 + lane] = lf;
    }
  }
}

DI void fox_cumsum(const Params& p) {
  const int lane = TID() & 63;
  const int gw = __builtin_amdgcn_readfirstlane((VBID() * NTHREADS + TID()) >> 6), nw = (VGRID() * NTHREADS) >> 6;
  const float* lf = (const float*)(p.ws + WS_LOGF);
  float* fc = (float*)(p.ws + WS_FCUM);
  for (int it = gw; it < 64; it += nw) {
    const int b = it >> 3, hh = it & 7;
    float v[32];
    float tot = 0.f;
#pragma unroll
    for (int j = 0; j < 32; ++j) { tot += lf[(size_t)(b * S_ + lane * 32 + j) * 8 + hh]; v[j] = tot; }
    float inc = tot;
#pragma unroll
    for (int o = 1; o < 64; o <<= 1) { const float n = __shfl_up(inc, o); if (lane >= o) inc += n; }
    const float base = inc - tot;
#pragma unroll
    for (int j = 0; j < 32; ++j) fc[(size_t)it * S_ + lane * 32 + j] = v[j] + base;
  }
}

namespace pg8 {
#define PG8_LAS __attribute__((address_space(3)))
typedef float f32x4 __attribute__((ext_vector_type(4)));
constexpr int BM = 256, BK = 64, HALF = 128, HTB = HALF * BK * 2  , STAGE_BYTES = 8 * HTB, NXCD = 8, WGM = 8;

__host__ __device__ __forceinline__ int lds_byte(int r, int c) { const int st = (r >> 4) * 2 + (c >> 5), rr = r & 15, cc = c & 31, ob = rr * 64 + cc * 2; return st * 1024 + (ob ^ (((ob >> 9) & 1) << 5)); }
__host__ __device__ __forceinline__ void stage_rc(int b, int& R, int& C) { const int st = b / 1024, sb = b % 1024, swz = sb ^ (((sb >> 9) & 1) << 5); R = (st >> 1) * 16 + swz / 64; C = (st & 1) * 32 + (swz % 64) / 2; }
__host__ __device__ __forceinline__ int perm32(int rho) { const int n = rho >> 4, i = rho & 15; return 8 * (i >> 2) + 4 * n + (i & 3); }

struct Unit { int pm, pn; };
struct Gemm { const bf16_t* A; const bf16_t* Bt; int M, N, K; };

struct StaticOrder {
    int nM, nN, nwg, G, c;
    __host__ __device__ void init(int M, int N, int G_, int c_) { nM = M / BM; nN = N / BM; nwg = nM * nN; G = G_; c = c_; }
    __host__ __device__ bool next(int i, Unit& u) const {
        const long L = (long)i * G + c; if (L >= nwg) return false;
        int wgid = (int)L; { const int q = nwg / NXCD, r = nwg % NXCD, xcd = wgid % NXCD, off = wgid / NXCD; wgid = (xcd < r ? xcd * (q + 1) : r * (q + 1) + (xcd - r) * q) + off; }
        const int nig = WGM * nN, gid = wgid / nig, fm = gid * WGM, gsz = (nM - fm) < WGM ? (nM - fm) : WGM;
        u.pm = fm + ((wgid % nig) % gsz); u.pn = (wgid % nig) / gsz; return true;
    }
    __device__ __forceinline__ void a_ready(const Unit&) const {}
    __device__ __forceinline__ void done(const Unit&) const {}
};

struct EpiF32 {
    static constexpr bool PERM = false, AFTER_DRAIN = false, I8 = false;
    float* C; int ldc; const float* bias;
    __device__ __forceinline__ void operator()(const f32x4 (&acc)[2][2][4][2], const Unit& u, int wr, int wc, int fr, int fq) const {
        const int row0 = u.pm * BM + wr * 64 + fr, col0 = u.pn * BM + wc * 32 + 4 * fq;
        f32x4 bv[2][2];
#pragma unroll
        for (int bj = 0; bj < 2; ++bj)
#pragma unroll
            for (int n = 0; n < 2; ++n) bv[bj][n] = bias ? *(const f32x4*)(bias + col0 + bj * HALF + n * 16) : (f32x4){0.f, 0.f, 0.f, 0.f};
#pragma unroll
        for (int ai = 0; ai < 2; ++ai)
#pragma unroll
            for (int m = 0; m < 4; ++m) { float* rowp = C + (size_t)(row0 + ai * HALF + m * 16) * ldc + col0;
#pragma unroll
                for (int bj = 0; bj < 2; ++bj)
#pragma unroll
                    for (int n = 0; n < 2; ++n) *(f32x4*)(rowp + bj * HALF + n * 16) = acc[ai][bj][m][n] + bv[bj][n]; }
    }
};
struct EpiBf16 {
    static constexpr bool PERM = true, AFTER_DRAIN = false, I8 = false;
    bf16_t* O; int ldc;
    __device__ __forceinline__ void operator()(const f32x4 (&acc)[2][2][4][2], const Unit& u, int wr, int wc, int fr, int fq) const {
        const int row0 = u.pm * BM + wr * 64 + fr, col0 = u.pn * BM + wc * 32 + 8 * fq;
#pragma unroll
        for (int ai = 0; ai < 2; ++ai)
#pragma unroll
            for (int m = 0; m < 4; ++m) { bf16_t* rowp = O + (size_t)(row0 + ai * HALF + m * 16) * ldc + col0;
#pragma unroll
                for (int bj = 0; bj < 2; ++bj) { const f32x4 v0 = acc[ai][bj][m][0], v1 = acc[ai][bj][m][1];
                    u32x4 w; w.x = pack_bf2(v0[0], v0[1]); w.y = pack_bf2(v0[2], v0[3]); w.z = pack_bf2(v1[0], v1[1]); w.w = pack_bf2(v1[2], v1[3]);
                    *(u32x4*)(rowp + bj * HALF) = w; } }
    }
};
struct EpiQkNorm {
    static constexpr bool PERM = true, AFTER_DRAIN = false, I8 = true;
    bf16_t* O; int ldc; const float* gainA; const float* gainB; int gshift; float* red;
    const float* wsc; const float* hsc;
    __device__ __forceinline__ void operator()(const f32x4 (&acc)[2][2][4][2], const Unit& u, int wr, int wc, int fr, int fq) const {
        typedef int i32x4 __attribute__((ext_vector_type(4)));
        f32x4 cs[2][2]; float hs[2][4];
        {
            const int c0_ = u.pn * BM + wc * 32 + 8 * fq, r0_ = u.pm * BM + wr * 64 + fr;
#pragma unroll
            for (int bj = 0; bj < 2; ++bj) { cs[bj][0] = *(const f32x4*)(wsc + c0_ + bj * HALF); cs[bj][1] = *(const f32x4*)(wsc + c0_ + bj * HALF + 4); }
#pragma unroll
            for (int ai = 0; ai < 2; ++ai)
#pragma unroll
                for (int m = 0; m < 4; ++m) hs[ai][m] = hsc[r0_ + ai * HALF + m * 16];
        }
#define QKN_VAL(ai, bj, m, n) (__builtin_convertvector(__builtin_bit_cast(i32x4, acc[ai][bj][m][n]), f32x4) * cs[bj][n] * hs[ai][m])
        float ss[2][4][2];
#pragma unroll
        for (int ai = 0; ai < 2; ++ai)
#pragma unroll
            for (int m = 0; m < 4; ++m)
#pragma unroll
                for (int bj = 0; bj < 2; ++bj) {
                    const f32x4 v0 = QKN_VAL(ai, bj, m, 0), v1 = QKN_VAL(ai, bj, m, 1);
                    float t = v0[0] * v0[0] + v0[1] * v0[1] + v0[2] * v0[2] + v0[3] * v0[3] + v1[0] * v1[0] + v1[1] * v1[1] + v1[2] * v1[2] + v1[3] * v1[3];
                    t += __shfl_xor(t, 16); t += __shfl_xor(t, 32);
                    ss[ai][m][bj] = t;
                }
        float* myred = red + (wr * 4 + wc) * 256;
        if (fq == 0) {
#pragma unroll
            for (int ai = 0; ai < 2; ++ai)
#pragma unroll
                for (int m = 0; m < 4; ++m)
#pragma unroll
                    for (int bj = 0; bj < 2; ++bj) myred[(ai * 64 + m * 16 + fr) * 2 + bj] = ss[ai][m][bj];
        }
        asm volatile("s_waitcnt lgkmcnt(0)" ::: "memory"); __builtin_amdgcn_s_barrier(); asm volatile("" ::: "memory");
        const int row0 = u.pm * BM + wr * 64 + fr, col0 = u.pn * BM + wc * 32 + 8 * fq;
        const float* rbase = red + (wr * 4) * 256;
#pragma unroll
        for (int bj = 0; bj < 2; ++bj) {
            const int grp = (u.pn * 2 + bj) >> gshift;
            const float* gain = ((grp & 2) ? gainB : gainA) + (grp & 1) * 128 + wc * 32 + 8 * fq;
            const float qs = (grp & 1) ? 1.f : 0.08838834764831845f * LOG2E;
            float4 g0 = *(const float4*)gain, g1 = *(const float4*)(gain + 4);
            g0.x *= qs; g0.y *= qs; g0.z *= qs; g0.w *= qs; g1.x *= qs; g1.y *= qs; g1.z *= qs; g1.w *= qs;
#pragma unroll
            for (int ai = 0; ai < 2; ++ai)
#pragma unroll
                for (int m = 0; m < 4; ++m) {
                    const int ri = (ai * 64 + m * 16 + fr) * 2 + bj;
                    const float tot = rbase[ri] + rbase[256 + ri] + rbase[512 + ri] + rbase[768 + ri];
                    const float rstd = rsqrtf(tot * (1.f / 128.f) + 1e-6f);
                    const f32x4 v0 = QKN_VAL(ai, bj, m, 0), v1 = QKN_VAL(ai, bj, m, 1);
                    u32x4 w;
                    w.x = pack_bf2(v0[0] * rstd * g0.x, v0[1] * rstd * g0.y); w.y = pack_bf2(v0[2] * rstd * g0.z, v0[3] * rstd * g0.w);
                    w.z = pack_bf2(v1[0] * rstd * g1.x, v1[1] * rstd * g1.y); w.w = pack_bf2(v1[2] * rstd * g1.z, v1[3] * rstd * g1.w);
                    *(u32x4*)(O + (size_t)(row0 + ai * HALF + m * 16) * ldc + col0 + bj * HALF) = w;
                }
        }
#undef QKN_VAL
    }
};
struct EpiVt8 {
    static constexpr bool PERM = true, AFTER_DRAIN = false, I8 = true;
    bf16_t* O; int ldc; const float* rscale; const float* cscale;
    __device__ __forceinline__ void operator()(const f32x4 (&acc)[2][2][4][2], const Unit& u, int wr, int wc, int fr, int fq) const {
        typedef int i32x4 __attribute__((ext_vector_type(4)));
        const int row0 = u.pm * BM + wr * 64 + fr, col0 = u.pn * BM + wc * 32 + 8 * fq;
        f32x4 c0[2], c1[2];
#pragma unroll
        for (int bj = 0; bj < 2; ++bj) { c0[bj] = *(const f32x4*)(cscale + col0 + bj * HALF); c1[bj] = *(const f32x4*)(cscale + col0 + bj * HALF + 4); }
#pragma unroll
        for (int ai = 0; ai < 2; ++ai)
#pragma unroll
            for (int m = 0; m < 4; ++m) { const int row = row0 + ai * HALF + m * 16; const float rs = rscale[row]; bf16_t* rowp = O + (size_t)row * ldc + col0;
#pragma unroll
                for (int bj = 0; bj < 2; ++bj) {
                    const i32x4 i0 = __builtin_bit_cast(i32x4, acc[ai][bj][m][0]), i1 = __builtin_bit_cast(i32x4, acc[ai][bj][m][1]);
                    const f32x4 v0 = __builtin_convertvector(i0, f32x4) * c0[bj] * rs, v1 = __builtin_convertvector(i1, f32x4) * c1[bj] * rs;
                    u32x4 w; w.x = pack_bf2(v0[0], v0[1]); w.y = pack_bf2(v0[2], v0[3]); w.z = pack_bf2(v1[0], v1[1]); w.w = pack_bf2(v1[2], v1[3]);
                    *(u32x4*)(rowp + bj * HALF) = w; } }
    }
};
template <bool IN16>
struct EpiRes16 {
    static constexpr bool PERM = true, AFTER_DRAIN = false, I8 = false;
    bf16_t* O; int ldc; const void* xin; const float* gate;
    __device__ __forceinline__ void operator()(const f32x4 (&acc)[2][2][4][2], const Unit& u, int wr, int wc, int fr, int fq) const {
        const int row0 = u.pm * BM + wr * 64 + fr, col0 = u.pn * BM + wc * 32 + 8 * fq;
        const float* gp = gate + (size_t)((u.pm * BM) >> 11) * 12288 + col0;
        f32x4 g0[2], g1[2];
#pragma unroll
        for (int bj = 0; bj < 2; ++bj) { g0[bj] = *(const f32x4*)(gp + bj * HALF); g1[bj] = *(const f32x4*)(gp + bj * HALF + 4); }
#pragma unroll
        for (int ai = 0; ai < 2; ++ai)
#pragma unroll
            for (int m = 0; m < 4; ++m) { const size_t ro = (size_t)(row0 + ai * HALF + m * 16) * ldc + col0;
#pragma unroll
                for (int bj = 0; bj < 2; ++bj) {
                    f32x4 x0, x1;
                    if (IN16) { const u32x4 xw = *(const u32x4*)((const bf16_t*)xin + ro + bj * HALF);
                        x0 = (f32x4){bf_lo(xw.x), bf_hi(xw.x), bf_lo(xw.y), bf_hi(xw.y)}; x1 = (f32x4){bf_lo(xw.z), bf_hi(xw.z), bf_lo(xw.w), bf_hi(xw.w)}; }
                    else { x0 = *(const f32x4*)((const float*)xin + ro + bj * HALF); x1 = *(const f32x4*)((const float*)xin + ro + bj * HALF + 4); }
                    const f32x4 v0 = x0 + g0[bj] * acc[ai][bj][m][0], v1 = x1 + g1[bj] * acc[ai][bj][m][1];
                    u32x4 w; w.x = pack_bf2(v0[0], v0[1]); w.y = pack_bf2(v0[2], v0[3]); w.z = pack_bf2(v1[0], v1[1]); w.w = pack_bf2(v1[2], v1[3]);
                    *(u32x4*)(O + ro + bj * HALF) = w; } }
    }
};
struct EpiRes {
    static constexpr bool PERM = false, AFTER_DRAIN = false, I8 = false;
    float* C; int ldc; const float* xin; const float* gate;
    __device__ __forceinline__ void operator()(const f32x4 (&acc)[2][2][4][2], const Unit& u, int wr, int wc, int fr, int fq) const {
        const int row0 = u.pm * BM + wr * 64 + fr, col0 = u.pn * BM + wc * 32 + 4 * fq;
        const float* gp = gate + (size_t)((u.pm * BM) >> 11) * 12288 + col0;
        f32x4 gv[2][2];
#pragma unroll
        for (int bj = 0; bj < 2; ++bj)
#pragma unroll
            for (int n = 0; n < 2; ++n) gv[bj][n] = *(const f32x4*)(gp + bj * HALF + n * 16);
#pragma unroll
        for (int ai = 0; ai < 2; ++ai)
#pragma unroll
            for (int m = 0; m < 4; ++m) { const size_t ro = (size_t)(row0 + ai * HALF + m * 16) * ldc + col0;
#pragma unroll
                for (int bj = 0; bj < 2; ++bj)
#pragma unroll
                    for (int n = 0; n < 2; ++n) { const f32x4 xv = *(const f32x4*)(xin + ro + bj * HALF + n * 16);
                        *(f32x4*)(C + ro + bj * HALF + n * 16) = xv + gv[bj][n] * acc[ai][bj][m][n]; } }
    }
};

template <bool I8>
__device__ __forceinline__ f32x4 pg8_mma(bf16x8 b, bf16x8 a, f32x4 c) {
    if constexpr (I8) {
        typedef int i32x4 __attribute__((ext_vector_type(4)));
        return __builtin_bit_cast(f32x4, __builtin_amdgcn_mfma_i32_16x16x64_i8(__builtin_bit_cast(i32x4, b), __builtin_bit_cast(i32x4, a), __builtin_bit_cast(i32x4, c), 0, 0, 0));
    } else {
        return __builtin_amdgcn_mfma_f32_16x16x32_bf16(b, a, c, 0, 0, 0);
    }
}
template <class Epi, class Sched, bool STAMP = false>
__device__ __forceinline__ void gemm_phase(PG8_LAS unsigned char* lds, const Gemm g, const Sched& S, const Epi& E, unsigned long long* stamps) {
    const int tid = RTID(), wid = __builtin_amdgcn_readfirstlane(tid >> 6), lane = tid & 63, wr = wid >> 2, wc = wid & 3, fr = lane & 15, fq = lane >> 4;
    const int K = g.K, nt = K / BK;
    int ts_lo = 0, ts_hi = 0, nts = 0; const unsigned long long rt_entry = STAMP ? (unsigned long long)wall_clock64() : 0ull;
#define PG8_STAMP() do { if (STAMP && wid == 0 && nts < 64) { const unsigned long long _c = (unsigned long long)clock64(); \
        ts_lo = (lane == nts) ? (int)(unsigned)_c : ts_lo; ts_hi = (lane == nts) ? (int)(unsigned)(_c >> 32) : ts_hi; ++nts; } } while (0)
    PG8_STAMP();
    unsigned voffA[2], voffB[2];
#pragma unroll
    for (int i = 0; i < 2; ++i) { int R, C; stage_rc(tid * 16 + i * 8192, R, C); const int Rb = Epi::PERM ? ((R & ~31) + perm32(R & 31)) : R;
        voffA[i] = (unsigned)(R * K + C) * 2u; voffB[i] = (unsigned)(Rb * K + C) * 2u; }
    const size_t kstep = (size_t)(BK * 2);
    const size_t hstep = (size_t)HALF * K * 2;
    const size_t tstep = 2 * hstep;
    const unsigned ldsw = (unsigned)wid * 1024u;
    const int aoff = lds_byte(wr * 64 + fr, fq * 8), boff = lds_byte(wc * 32 + fr, fq * 8);
#define PG8_SA(b, h) (((b) * 2 + (h)) * HTB)
#define PG8_SB(b, h) ((4 + (b) * 2 + (h)) * HTB)
#define PG8_STAGE(bufoff, gbase, voff) do { _Pragma("unroll") for (int _i = 0; _i < 2; ++_i) \
        __builtin_amdgcn_global_load_lds((const unsigned*)((const char*)(gbase) + (voff)[_i]), (PG8_LAS unsigned*)(lds + (bufoff) + ldsw + _i * 8192), 16, 0, 0); } while (0)
#define PG8_LDA(dst, b, h) do { _Pragma("unroll") for (int m = 0; m < 4; ++m) _Pragma("unroll") for (int k = 0; k < 2; ++k) dst[m][k] = *(const PG8_LAS bf16x8*)(lds + PG8_SA(b, h) + aoff + m * 2048 + k * 1024); } while (0)
#define PG8_LDB(dst, b, h) do { _Pragma("unroll") for (int n = 0; n < 2; ++n) _Pragma("unroll") for (int k = 0; k < 2; ++k) dst[n][k] = *(const PG8_LAS bf16x8*)(lds + PG8_SB(b, h) + boff + n * 2048 + k * 1024); } while (0)
#define PG8_MMA(ai, bj, At, Bt) do { __builtin_amdgcn_s_setprio(1); _Pragma("unroll") for (int m = 0; m < 4; ++m) _Pragma("unroll") for (int n = 0; n < 2; ++n) _Pragma("unroll") for (int k = 0; k < 2; ++k) \
        acc[ai][bj][m][n] = pg8_mma<Epi::I8>(Bt[n][k], At[m][k], acc[ai][bj][m][n]); __builtin_amdgcn_s_setprio(0); } while (0)
#define PG8_WAIT_V(n) asm volatile("s_waitcnt vmcnt(" #n ")" ::: "memory")
#define PG8_WAIT_L(n) asm volatile("s_waitcnt lgkmcnt(" #n ")" ::: "memory")
#define PG8_BAR __builtin_amdgcn_s_barrier()
#define PG8_SCHED __builtin_amdgcn_sched_barrier(0)
    Unit cur, nxt; int ui = 0;
    if (!S.next(0, cur)) return;
    f32x4 acc[2][2][4][2];
#pragma unroll
    for (int a = 0; a < 2; ++a)
#pragma unroll
        for (int b = 0; b < 2; ++b)
#pragma unroll
            for (int m = 0; m < 4; ++m)
#pragma unroll
                for (int n = 0; n < 2; ++n) acc[a][b][m][n] = (f32x4){0.f, 0.f, 0.f, 0.f};
    bf16x8 At[4][2], B0[2][2], B1[2][2];
    const char* cA = (const char*)g.A + (size_t)cur.pm * tstep; const char* cB = (const char*)g.Bt + (size_t)cur.pn * tstep;
    S.a_ready(cur);
    PG8_STAGE(PG8_SB(0, 0), cB, voffB); PG8_STAGE(PG8_SA(0, 0), cA, voffA); PG8_STAGE(PG8_SB(0, 1), cB + hstep, voffB); PG8_STAGE(PG8_SA(0, 1), cA + hstep, voffA);
    if (wr == 1) PG8_BAR;
    PG8_WAIT_V(4); PG8_BAR;
    PG8_STAGE(PG8_SB(1, 0), cB + kstep, voffB); PG8_STAGE(PG8_SA(1, 0), cA + kstep, voffA); PG8_STAGE(PG8_SB(1, 1), cB + hstep + kstep, voffB);
    PG8_WAIT_V(6); PG8_BAR;
    PG8_STAMP();
    for (;;) {
        const bool has_next = S.next(ui + 1, nxt);
        const char* nA = has_next ? (const char*)g.A + (size_t)nxt.pm * tstep : cA; const char* nB = has_next ? (const char*)g.Bt + (size_t)nxt.pn * tstep : cB;
        for (int t = 0; t < nt; t += 2) {
            const bool last = (t == nt - 2);
            const char* a1 = cA + (size_t)(t + 1) * kstep;
            const char* a2 = last ? nA : cA + (size_t)(t + 2) * kstep; const char* b2 = last ? nB : cB + (size_t)(t + 2) * kstep;
            const char* a3 = a2 + kstep; const char* b3 = b2 + kstep;
            if (last && has_next) S.a_ready(nxt);
            PG8_LDB(B0, 0, 0); PG8_SCHED; PG8_LDA(At, 0, 0); PG8_STAGE(PG8_SA(1, 1), a1 + hstep, voffA);
            PG8_WAIT_L(8); PG8_BAR; PG8_WAIT_L(0); PG8_MMA(0, 0, At, B0); PG8_BAR; PG8_SCHED;
            PG8_LDB(B1, 0, 1); PG8_STAGE(PG8_SB(0, 0), b2, voffB);
            PG8_BAR; PG8_WAIT_L(0); PG8_MMA(0, 1, At, B1); PG8_BAR;
            PG8_LDA(At, 0, 1); PG8_STAGE(PG8_SA(0, 0), a2, voffA);
            PG8_BAR; PG8_WAIT_L(0); PG8_MMA(1, 0, At, B0); PG8_BAR; PG8_SCHED;
            PG8_STAGE(PG8_SB(0, 1), b2 + hstep, voffB);
            PG8_WAIT_V(6); PG8_BAR; PG8_MMA(1, 1, At, B1); PG8_BAR;
            PG8_LDB(B0, 1, 0); PG8_SCHED; PG8_LDA(At, 1, 0); PG8_STAGE(PG8_SA(0, 1), a2 + hstep, voffA);
            PG8_WAIT_L(8); PG8_BAR; PG8_WAIT_L(0); PG8_MMA(0, 0, At, B0); PG8_BAR; PG8_SCHED;
            PG8_LDB(B1, 1, 1); PG8_STAGE(PG8_SB(1, 0), b3, voffB);
            PG8_BAR; PG8_WAIT_L(0); PG8_MMA(0, 1, At, B1); PG8_BAR;
            PG8_LDA(At, 1, 1); PG8_STAGE(PG8_SA(1, 0), a3, voffA);
            PG8_BAR; PG8_WAIT_L(0); PG8_MMA(1, 0, At, B0); PG8_BAR; PG8_SCHED;
            PG8_STAGE(PG8_SB(1, 1), b3 + hstep, voffB);
            PG8_WAIT_V(6); PG8_BAR; PG8_MMA(1, 1, At, B1); PG8_BAR;
        }
        PG8_STAMP();
        if constexpr (!Epi::AFTER_DRAIN) { E(acc, cur, wr, wc, fr, fq); S.done(cur); }
        PG8_STAMP();
        if (!has_next) break;
#pragma unroll
        for (int a = 0; a < 2; ++a)
#pragma unroll
            for (int b = 0; b < 2; ++b)
#pragma unroll
                for (int m = 0; m < 4; ++m)
#pragma unroll
                    for (int n = 0; n < 2; ++n) acc[a][b][m][n] = (f32x4){0.f, 0.f, 0.f, 0.f};
        cur = nxt; cA = nA; cB = nB; ++ui;
    }
    PG8_WAIT_V(0);
    if (wr == 0) PG8_BAR;
    PG8_BAR;
    if constexpr (Epi::AFTER_DRAIN) { E.fused(acc, cur, wr, wc, fr, fq, lds, wid, lane); S.done(cur); }
    PG8_STAMP();
    if (STAMP && wid == 0) { stamps[lane] = lane < nts ? (((unsigned long long)(unsigned)ts_hi << 32) | (unsigned)ts_lo) : 0ull;
        if (lane == 62) stamps[62] = rt_entry; if (lane == 63) stamps[63] = (unsigned long long)wall_clock64(); }
#undef PG8_STAMP
#undef PG8_SA
#undef PG8_SB
#undef PG8_STAGE
#undef PG8_LDA
#undef PG8_LDB
#undef PG8_MMA
#undef PG8_WAIT_V
#undef PG8_WAIT_L
#undef PG8_BAR
#undef PG8_SCHED
}
}

struct AttnPtrs { const bf16_t* Q; int ldq; const bf16_t* K; int ldk; const bf16_t* Vt; int ldv; const float* kbias; };

DI float xhalf_max(float v) {
  const auto r2 = __builtin_amdgcn_permlane32_swap(__float_as_uint(v), __float_as_uint(v), false, false);
  return fmaxf(__uint_as_float(r2[0]), __uint_as_float(r2[1]));
}
DI float xhalf_sum(float v) {
  const auto r2 = __builtin_amdgcn_permlane32_swap(__float_as_uint(v), __float_as_uint(v), false, false);
  return __uint_as_float(r2[0]) + __uint_as_float(r2[1]);
}

template <int MODE, int DVB>
DI void attn_block(const AttnPtrs& a, int q0b, char* smem, const float* tbl, f32x16 (&o)[DVB], float& l_out) {
  constexpr int STG = 16384 + DVB * 4096;
  const int tid = RTID(), lane = tid & 63, wave = __builtin_amdgcn_readfirstlane(tid >> 6);
  const int r = lane & 31, h = lane >> 5;
  const int q0 = q0b + 32 * wave;
  const int krow = tid >> 4, kch = tid & 15;
  const int vrow = tid >> 3, vch = tid & 7;
  const char* Kb = (const char*)a.K;
  const char* Vb = (const char*)a.Vt;
  const unsigned kvo = (unsigned)(krow * a.ldk + kch * 8) * 2u;
  const unsigned vvo = (unsigned)(vrow * a.ldv + vch * 8) * 2u;
  const unsigned kst = (unsigned)(32 * a.ldk) * 2u, vst = (unsigned)(64 * a.ldv) * 2u;
  const int kwo = krow * 256 + ((kch ^ (krow & 15)) << 4);
  const int vwo = 16384 + vrow * 128 + ((vch ^ ((vrow >> 1) & 7)) << 4);
  const int pr = (r & ~12) | ((r & 4) << 1) | ((r & 8) >> 1);
  const int kro = pr * 256, ksw = pr & 15;
  const int vro = 16384 + r * 128, vsw = (r >> 1) & 7;
  bf16x8 qf[8];
#pragma unroll
  for (int s = 0; s < 8; ++s) qf[s] = *(const bf16x8*)(a.Q + (size_t)(q0 + r) * a.ldq + 16 * s + 8 * h);
#pragma unroll
  for (int dt = 0; dt < DVB; ++dt)
#pragma unroll
    for (int e = 0; e < 16; ++e) o[dt][e] = 0.f;
  float m = -1e30f, l = 0.f;
  const int nkt = (q0b + 256) >> 6;
  u32x4 rk[2], rv[DVB / 2];
#pragma unroll
  for (int i = 0; i < 2; ++i) rk[i] = *(const u32x4*)(Kb + (size_t)(i * kst) + kvo);
#pragma unroll
  for (int i = 0; i < DVB / 2; ++i) rv[i] = *(const u32x4*)(Vb + (size_t)(i * vst) + vvo);
#pragma unroll
  for (int i = 0; i < 2; ++i) *(u32x4*)(smem + kwo + i * 8192) = rk[i];
#pragma unroll
  for (int i = 0; i < DVB / 2; ++i) *(u32x4*)(smem + vwo + i * 8192) = rv[i];
  u32x4 rkB[2], rvB[DVB / 2];
  if constexpr (DVB == 4) {
    const int k1 = nkt > 1 ? 64 : 0;
#pragma unroll
    for (int i = 0; i < 2; ++i) rk[i] = *(const u32x4*)(Kb + ((size_t)k1 * (size_t)a.ldk * 2u + i * kst) + kvo);
#pragma unroll
    for (int i = 0; i < DVB / 2; ++i) rv[i] = *(const u32x4*)(Vb + ((size_t)k1 * 2u + i * vst) + vvo);
  }
  __syncthreads();
#define ATT_TILE(KT, RL, RVL, RW, RVW) { const int kt = (KT); \
    const int k0 = kt << 6; \
    char* st = smem + (kt & 1) * STG; \
    { \
      const int kn = (kt + 2 < nkt ? kt + 2 : nkt - 1) << 6;        \
      const size_t kbo = (size_t)kn * (size_t)a.ldk * 2u, vbo = (size_t)kn * 2u; \
_Pragma("unroll") \
      for (int i = 0; i < 2; ++i) RL[i] = *(const u32x4*)(Kb + (kbo + i * kst) + kvo); \
_Pragma("unroll") \
      for (int i = 0; i < DVB / 2; ++i) RVL[i] = *(const u32x4*)(Vb + (vbo + i * vst) + vvo); \
    } \
    asm volatile("" ::: "memory"); \
    __builtin_amdgcn_sched_barrier(0); \
_Pragma("unroll") \
    for (int sub = 0; sub < 2; ++sub) { \
      const int ks0 = k0 + 32 * sub; \
      if (ks0 <= q0) { \
        f32x16 sa; \
_Pragma("unroll") \
        for (int e = 0; e < 16; ++e) sa[e] = 0.f; \
_Pragma("unroll") \
        for (int s = 0; s < 8; ++s) { \
          const bf16x8 kf = *(const bf16x8*)(st + kro + sub * 8192 + (((2 * s + h) ^ ksw) << 4)); \
          sa = MFMA32(kf, qf[s], sa); \
        } \
        float v[16]; \
        if (MODE == 0) { \
_Pragma("unroll") \
          for (int c = 0; c < 2; ++c) { \
            const float4 kb0 = *(const float4*)(a.kbias + ks0 + 16 * c + 8 * h); \
            const float4 kb1 = *(const float4*)(a.kbias + ks0 + 16 * c + 8 * h + 4); \
            v[8 * c + 0] = sa[8 * c + 0] - kb0.x * LOG2E; v[8 * c + 1] = sa[8 * c + 1] - kb0.y * LOG2E; \
            v[8 * c + 2] = sa[8 * c + 2] - kb0.z * LOG2E; v[8 * c + 3] = sa[8 * c + 3] - kb0.w * LOG2E; \
            v[8 * c + 4] = sa[8 * c + 4] - kb1.x * LOG2E; v[8 * c + 5] = sa[8 * c + 5] - kb1.y * LOG2E; \
            v[8 * c + 6] = sa[8 * c + 6] - kb1.z * LOG2E; v[8 * c + 7] = sa[8 * c + 7] - kb1.w * LOG2E; \
          } \
          if (ks0 == q0) { \
_Pragma("unroll") \
            for (int e = 0; e < 16; ++e) if ((e & 7) + 8 * h + 16 * (e >> 3) > r) v[e] = -INFINITY; \
          } \
        } else { \
          const float* tp = tbl + (q0 - ks0) + r + 32 - 8 * h - 23; \
_Pragma("unroll") \
          for (int e = 0; e < 16; ++e) v[e] = sa[e] + tp[23 - ((e & 7) + 16 * (e >> 3))]; \
        } \
        float mx = v[0]; \
_Pragma("unroll") \
        for (int e = 1; e < 16; ++e) mx = fmaxf(mx, v[e]); \
        mx = xhalf_max(mx); \
        if (__ballot(mx > m + 8.f) != 0ull) { \
          const float mn = fmaxf(m, mx); \
          const float alpha = __builtin_amdgcn_exp2f(m - mn); \
          m = mn; \
          l *= alpha; \
_Pragma("unroll") \
          for (int dt = 0; dt < DVB; ++dt) \
_Pragma("unroll") \
            for (int e = 0; e < 16; ++e) o[dt][e] *= alpha; \
        } \
        float ps = 0.f; \
_Pragma("unroll") \
        for (int e = 0; e < 16; ++e) { v[e] = __builtin_amdgcn_exp2f(v[e] - m); ps += v[e]; } \
        l += ps; \
        bf16x8 pb[2]; \
_Pragma("unroll") \
        for (int s = 0; s < 2; ++s) { \
          const u32x4 u = {pack_bf2(v[8 * s + 0], v[8 * s + 1]), pack_bf2(v[8 * s + 2], v[8 * s + 3]), \
                           pack_bf2(v[8 * s + 4], v[8 * s + 5]), pack_bf2(v[8 * s + 6], v[8 * s + 7])}; \
          pb[s] = __builtin_bit_cast(bf16x8, u); \
        } \
_Pragma("unroll") \
        for (int dt = 0; dt < DVB; ++dt) \
_Pragma("unroll") \
          for (int s = 0; s < 2; ++s) { \
            const bf16x8 va = *(const bf16x8*)(st + vro + dt * 4096 + (((4 * sub + 2 * s + h) ^ vsw) << 4)); \
            o[dt] = MFMA32(va, pb[s], o[dt]); \
          } \
      } \
    } \
    __builtin_amdgcn_sched_barrier(0); \
    asm volatile("" ::: "memory"); \
    { \
      char* sn = smem + ((kt + 1) & 1) * STG; \
_Pragma("unroll") \
      for (int i = 0; i < 2; ++i) *(u32x4*)(sn + kwo + i * 8192) = RW[i]; \
_Pragma("unroll") \
      for (int i = 0; i < DVB / 2; ++i) *(u32x4*)(sn + vwo + i * 8192) = RVW[i]; \
    } \
    __syncthreads(); \
  }
  if constexpr (DVB == 4) {
  for (int kt2 = 0; kt2 < nkt; kt2 += 2) {
    ATT_TILE(kt2, rkB, rvB, rk, rv)
    if (kt2 + 1 < nkt) ATT_TILE(kt2 + 1, rk, rv, rkB, rvB)
  }
  } else {
  for (int kt = 0; kt < nkt; ++kt) {
    const int k0 = kt << 6;
    char* st = smem + (kt & 1) * STG;
    {
      const int kn = (kt + 1 < nkt) ? k0 + 64 : k0;
      const size_t kbo = (size_t)kn * (size_t)a.ldk * 2u, vbo = (size_t)kn * 2u;
#pragma unroll
      for (int i = 0; i < 2; ++i) rk[i] = *(const u32x4*)(Kb + (kbo + i * kst) + kvo);
#pragma unroll
      for (int i = 0; i < DVB / 2; ++i) rv[i] = *(const u32x4*)(Vb + (vbo + i * vst) + vvo);
    }
    asm volatile("" ::: "memory");
    __builtin_amdgcn_sched_barrier(0);
#pragma unroll
    for (int sub = 0; sub < 2; ++sub) {
      const int ks0 = k0 + 32 * sub;
      if (ks0 <= q0) {
        f32x16 sa;
#pragma unroll
        for (int e = 0; e < 16; ++e) sa[e] = 0.f;
#pragma unroll
        for (int s = 0; s < 8; ++s) {
          const bf16x8 kf = *(const bf16x8*)(st + kro + sub * 8192 + (((2 * s + h) ^ ksw) << 4));
          sa = MFMA32(kf, qf[s], sa);
        }
        float v[16];
        if (MODE == 0) {
#pragma unroll
          for (int c = 0; c < 2; ++c) {
            const float4 kb0 = *(const float4*)(a.kbias + ks0 + 16 * c + 8 * h);
            const float4 kb1 = *(const float4*)(a.kbias + ks0 + 16 * c + 8 * h + 4);
            v[8 * c + 0] = sa[8 * c + 0] - kb0.x * LOG2E; v[8 * c + 1] = sa[8 * c + 1] - kb0.y * LOG2E;
            v[8 * c + 2] = sa[8 * c + 2] - kb0.z * LOG2E; v[8 * c + 3] = sa[8 * c + 3] - kb0.w * LOG2E;
            v[8 * c + 4] = sa[8 * c + 4] - kb1.x * LOG2E; v[8 * c + 5] = sa[8 * c + 5] - kb1.y * LOG2E;
            v[8 * c + 6] = sa[8 * c + 6] - kb1.z * LOG2E; v[8 * c + 7] = sa[8 * c + 7] - kb1.w * LOG2E;
          }
          if (ks0 == q0) {
#pragma unroll
            for (int e = 0; e < 16; ++e) if ((e & 7) + 8 * h + 16 * (e >> 3) > r) v[e] = -INFINITY;
          }
        } else {
          const float* tp = tbl + (q0 - ks0) + r + 32 - 8 * h - 23;
#pragma unroll
          for (int e = 0; e < 16; ++e) v[e] = sa[e] + tp[23 - ((e & 7) + 16 * (e >> 3))];
        }
        float mx = v[0];
#pragma unroll
        for (int e = 1; e < 16; ++e) mx = fmaxf(mx, v[e]);
        mx = xhalf_max(mx);
        if (__ballot(mx > m + 8.f) != 0ull) {
          const float mn = fmaxf(m, mx);
          const float alpha = __builtin_amdgcn_exp2f(m - mn);
          m = mn;
          l *= alpha;
#pragma unroll
          for (int dt = 0; dt < DVB; ++dt)
#pragma unroll
            for (int e = 0; e < 16; ++e) o[dt][e] *= alpha;
        }
        float ps = 0.f;
#pragma unroll
        for (int e = 0; e < 16; ++e) { v[e] = __builtin_amdgcn_exp2f(v[e] - m); ps += v[e]; }
        l += ps;
        bf16x8 pb[2];
#pragma unroll
        for (int s = 0; s < 2; ++s) {
          const u32x4 u = {pack_bf2(v[8 * s + 0], v[8 * s + 1]), pack_bf2(v[8 * s + 2], v[8 * s + 3]),
                           pack_bf2(v[8 * s + 4], v[8 * s + 5]), pack_bf2(v[8 * s + 6], v[8 * s + 7])};
          pb[s] = __builtin_bit_cast(bf16x8, u);
        }
#pragma unroll
        for (int dt = 0; dt < DVB; ++dt)
#pragma unroll
          for (int s = 0; s < 2; ++s) {
            const bf16x8 va = *(const bf16x8*)(st + vro + dt * 4096 + (((4 * sub + 2 * s + h) ^ vsw) << 4));
            o[dt] = MFMA32(va, pb[s], o[dt]);
          }
      }
    }
    __builtin_amdgcn_sched_barrier(0);
    asm volatile("" ::: "memory");
    {
      char* sn = smem + ((kt + 1) & 1) * STG;
#pragma unroll
      for (int i = 0; i < 2; ++i) *(u32x4*)(sn + kwo + i * 8192) = rk[i];
#pragma unroll
      for (int i = 0; i < DVB / 2; ++i) *(u32x4*)(sn + vwo + i * 8192) = rv[i];
    }
    __syncthreads();
  }
  }
#undef ATT_TILE
  l_out = xhalf_sum(l);
}

DI void attn_store_bf16(const f32x16 (&o)[4], float linv, bf16_t* out_row  , int ldo) {
  const int lane = TID() & 63, r = lane & 31, h = lane >> 5;
  bf16_t* op = out_row + (size_t)r * ldo + 4 * h;
#pragma unroll
  for (int dt = 0; dt < 4; ++dt)
#pragma unroll
    for (int c = 0; c < 4; ++c)
      *(uint2*)(op + 32 * dt + 8 * c) = make_uint2(pack_bf2(o[dt][4 * c] * linv, o[dt][4 * c + 1] * linv),
                                                    pack_bf2(o[dt][4 * c + 2] * linv, o[dt][4 * c + 3] * linv));
}
template <int N, int B0>
DI void attn_store_f32(const f32x16 (&o)[N], float linv, float* out_row, int ldo) {
  const int lane = TID() & 63, r = lane & 31, h = lane >> 5;
  float* op = out_row + (size_t)r * ldo + 4 * h;
#pragma unroll
  for (int dt = 0; dt < 4; ++dt)
#pragma unroll
    for (int c = 0; c < 4; ++c)
      *(float4*)(op + 32 * dt + 8 * c) = make_float4(o[B0 + dt][4 * c] * linv, o[B0 + dt][4 * c + 1] * linv, o[B0 + dt][4 * c + 2] * linv, o[B0 + dt][4 * c + 3] * linv);
}

DI int t5_bucket(int n) {
  if (n < 16) return n;
  int lg = 16 + (int)(logf((float)n / 16.f) / 4.852030263919617f * 16.f);
  return lg < 31 ? lg : 31;
}

DI void phase_attn_even(const Params& p, char* smem) {
  const int tid = RTID(), wave = __builtin_amdgcn_readfirstlane(tid >> 6), bid = blockIdx.x, G = gridDim.x;
  const bf16_t* QK = (const bf16_t*)(p.ws + WS_QK);
  const bf16_t* VT = (const bf16_t*)(p.ws + WS_VT);
  bf16_t* ATT = (bf16_t*)(p.ws + WS_ATT);
  float* PCS = (float*)(p.ws + WS_SC);
  float* tbl = (float*)(smem + 98304);
  int cur_head = -1;
  for (int rnd = 0; rnd * G < 1024; ++rnd) {
    int item = rnd * G + ((rnd & 1) ? G - 1 - bid : bid);
    if (G == 256) {
      const int rc = rnd * 4 + (bid >> 6);
      const int gq = (int)((0x6767455432231010ull >> (4 * rc)) & 15ull), dq = (0x3CC3 >> rc) & 1;
      item = gq * 128 + (dq ? 0 : 64) + (bid & 63);
    }
    if (item >= 1024) break;
    const int g = item >> 7; int rem = item & 127;
    const int qb = 7 - g;
    const int q0b = qb * 256, q0 = q0b + 32 * wave;
    __syncthreads();
    if (rem >= 64) {
      rem -= 64;
      const int b = rem >> 3, hh = rem & 7;
      AttnPtrs a;
      a.Q = QK + (size_t)b * S_ * 4096 + hh * 128; a.ldq = 4096;
      a.K = a.Q + 1024; a.ldk = 4096;
      a.Vt = VT + (size_t)(hh * 128) * T_ + b * S_; a.ldv = T_;
      a.kbias = (const float*)(p.ws + WS_FCUM) + (size_t)(b * 8 + hh) * S_;
      f32x16 o[4]; float l;
      attn_block<0, 4>(a, q0b, smem, nullptr, o, l);
      attn_store_bf16(o, 1.f / l, ATT + (size_t)(b * S_ + q0) * D_ + hh * 128, D_);
    } else {
      const int b = rem >> 3, hh = (rem >> 1) & 3, mm = rem & 1;
      if (hh != cur_head) {
        for (int e = tid; e < 2080; e += RTHREADS) {
          const int dist = e - 32;
          tbl[e] = dist >= 0 ? p.rel_bias[t5_bucket(dist) * 16 + hh] * LOG2E : -INFINITY;
        }
        cur_head = hh;
      }
      AttnPtrs a;
      a.Q = QK + (size_t)b * S_ * 4096 + 2048 + hh * 256 + mm * 128; a.ldq = 4096;
      a.K = a.Q + 1024; a.ldk = 4096;
      a.Vt = VT + (size_t)(1024 + hh * 256) * T_ + b * S_; a.ldv = T_;
      a.kbias = nullptr;
      f32x16 o[8]; float l;
      attn_block<1, 8>(a, q0b, smem, tbl, o, l);
      const float linv = 1.f / l;
      attn_store_f32<8, 0>(o, linv, PCS + (((size_t)(mm * 2 + 0) * T_ + (size_t)(b * S_ + q0)) * 4 + hh) * 128, 512);
      attn_store_f32<8, 4>(o, linv, PCS + (((size_t)(mm * 2 + 1) * T_ + (size_t)(b * S_ + q0)) * 4 + hh) * 128, 512);
    }
  }
}

DI void phase_diff_combine(const Params& p) {
  const int lane = TID() & 63;
  const int gw = __builtin_amdgcn_readfirstlane((VBID() * NTHREADS + TID()) >> 6), nw = (VGRID() * NTHREADS) >> 6;
  const float* PCS = (const float*)(p.ws + WS_SC);
  bf16_t* ATT = (bf16_t*)(p.ws + WS_ATT);
  const float lam = ((const float*)(p.ws + WS_MISC))[0];
  const int half = lane >> 5, dl = (lane & 31) * 4;
  const float4 sg = *(const float4*)(p.even_diff_subln_gain + lane * 4);
  for (int it = gw; it < T_ * 4; it += nw) {
    const float4 a0 = *(const float4*)(PCS + ((size_t)(0 + half) * T_ * 4 + it) * 128 + dl);
    const float4 a1 = *(const float4*)(PCS + ((size_t)(2 + half) * T_ * 4 + it) * 128 + dl);
    float4 v;
    v.x = a0.x - lam * a1.x; v.y = a0.y - lam * a1.y; v.z = a0.z - lam * a1.z; v.w = a0.w - lam * a1.w;
    const float ss = wave_sum(v.x * v.x + v.y * v.y + v.z * v.z + v.w * v.w);
    const float rstd = rsqrtf(ss * (1.f / 256.f) + 1e-6f) * 0.8f;
    const int t = it >> 2, hh = it & 3;
    *(uint2*)(ATT + (size_t)t * D_ + 1024 + hh * 256 + lane * 4) =
        make_uint2(pack_bf2(v.x * rstd * sg.x, v.y * rstd * sg.y), pack_bf2(v.z * rstd * sg.z, v.w * rstd * sg.w));
  }
}

DI void phase_attn_odd(const Params& p, char* smem) {
  const int tid = RTID(), wave = __builtin_amdgcn_readfirstlane(tid >> 6), bid = blockIdx.x, G = gridDim.x;
  const bf16_t* QK = (const bf16_t*)(p.ws + WS_QK);
  const bf16_t* VT = (const bf16_t*)(p.ws + WS_VT);
  bf16_t* ATT = (bf16_t*)(p.ws + WS_ATT);
  float* tbl = (float*)(smem + 98304);
  int cur_head = -1;
  for (int rnd = 0; rnd * G < 1024; ++rnd) {
    const int item = rnd * G + ((rnd & 1) ? G - 1 - bid : bid);
    if (item >= 1024) break;
    const int g = item >> 7, rem = item & 127;
    const int qb = 7 - g, b = rem >> 4, hd = rem & 15;
    __syncthreads();
    if (hd != cur_head) {
      for (int e = tid; e < 2080; e += RTHREADS) {
        const int dist = e - 32;
        float val = -INFINITY;
        if (dist >= 0) {
          int cnt = 0;
          if (dist <= 128) cnt += 1;
          if (dist <= 512 && (dist & 3) == 0) cnt += 1;
          if ((dist & 15) == 0) cnt += 1;
          if (cnt > 0) val = (p.rel_bias[t5_bucket(dist) * 16 + hd] + __logf((float)cnt)) * LOG2E;
        }
        tbl[e] = val;
      }
      cur_head = hd;
    }
    const int q0b = qb * 256, q0 = q0b + 32 * wave;
    AttnPtrs a;
    a.Q = QK + (size_t)b * S_ * 4096 + hd * 128; a.ldq = 4096;
    a.K = a.Q + 2048; a.ldk = 4096;
    a.Vt = VT + (size_t)(hd * 128) * T_ + b * S_; a.ldv = T_;
    a.kbias = nullptr;
    f32x16 o[4]; float l;
    attn_block<1, 4>(a, q0b, smem, tbl, o, l);
    attn_store_bf16(o, 1.f / l, ATT + (size_t)(b * S_ + q0) * D_ + hd * 128, D_);
  }
}

DI float gelu_erf(float x) { return 0.5f * x * (1.f + erff(x * 0.7071067811865476f)); }

DI void ins16(float (&L)[16], float x) {
#pragma unroll
  for (int k = 15; k >= 1; --k) L[k] = __builtin_amdgcn_fmed3f(L[k - 1], L[k], x);
  L[0] = __builtin_amdgcn_fmed3f(__builtin_inff(), L[0], x);
}
DI float f_and_or(float v, unsigned mask, unsigned orv) { return __uint_as_float((__float_as_uint(v) & mask) | orv); }

DI void phase_peer_retrieve(const Params& p, char* smem) {
  const int tid = TID(), lane = tid & 63, wave = __builtin_amdgcn_readfirstlane(tid >> 6);
  const int gw = __builtin_amdgcn_readfirstlane((VBID() * NTHREADS + tid) >> 6), nw = (VGRID() * NTHREADS) >> 6;
  unsigned* wbuf = (unsigned*)(smem + wave * 9216);
  const bf16_t* SC = (const bf16_t*)(p.ws + WS_SC);
  int* IDX = (int*)(p.ws + WS_IDX);
  float* GATE = (float*)(p.ws + WS_GATE);
  const float NINF = -__builtin_inff();
  for (int it = gw; it < T_ / 8; it += nw) {
    const bf16_t* gsrc = SC + (size_t)it * (8 * 2048) + (lane >> 2) * 256 + (lane & 3) * 8;
    unsigned* wdst = wbuf + (lane >> 2) * 20 + (lane & 3) * 4;
    const unsigned* wsrc = wbuf + lane * 20;
    u32x4 stg[4];
#define PR_LOAD(CH) _Pragma("unroll") for (int i = 0; i < 4; ++i) stg[i] = *(const u32x4*)(gsrc + i * (16 * 256) + ((CH) >> 2) * 128 + ((CH) & 3) * 32);
    PR_LOAD(0)
    float A[16], B[16];
#pragma unroll
    for (int hf = 0; hf < 2; ++hf) {
      float L[16];
#pragma unroll
      for (int k = 0; k < 16; ++k) L[k] = NINF;
#pragma unroll 1
      for (int c = 0; c < 4; ++c) {
#pragma unroll
        for (int i = 0; i < 4; ++i) *(u32x4*)(wdst + i * (16 * 20)) = stg[i];
        { const int cn = hf * 4 + c + 1 < 7 ? hf * 4 + c + 1 : 7; PR_LOAD(cn) }
        u32x4 v[4];
#pragma unroll
        for (int k = 0; k < 4; ++k) v[k] = *(const u32x4*)(wsrc + 4 * k);
#pragma unroll
        for (int k = 0; k < 4; ++k)
#pragma unroll
          for (int e = 0; e < 4; ++e) {
            const unsigned w = v[k][e], id0 = (unsigned)(c * 32 + 8 * k + 2 * e);
            ins16(L, __uint_as_float((w << 16) | id0));
            ins16(L, __uint_as_float((w & 0xFFFF0000u) | (id0 + 1u)));
          }
      }
#pragma unroll
      for (int k = 0; k < 16; ++k) { if (hf == 0) A[k] = L[k]; else B[k] = L[k]; }
    }
#undef PR_LOAD
    unsigned* lut = wbuf + lane * 33;
#pragma unroll
    for (int k = 0; k < 16; ++k) {
      const unsigned ua = __float_as_uint(A[k]), ub = __float_as_uint(B[k]);
      lut[k] = (ua & 0x7Fu) << 7; lut[16 + k] = ub & 0x7Fu;
      A[k] = __uint_as_float(ua & 0xFFFFFF80u); B[k] = __uint_as_float(ub & 0xFFFFFF80u);
    }
    float C[16];
#pragma unroll
    for (int k = 0; k < 16; ++k) C[k] = NINF;
#pragma unroll
    for (int i = 0; i < 16; ++i)
#pragma unroll
      for (int j = 0; j < 16; ++j)
        if ((i + 1) * (j + 1) <= 16) ins16(C, f_and_or(A[i] + B[j], 0xFFFFFF00u, (unsigned)(i * 16 + j)));
    float ev[16], es = 0.f;
    int ids[16];
    const float mx = __uint_as_float(__float_as_uint(C[0]) & 0xFFFFFF00u);
#pragma unroll
    for (int k = 0; k < 16; ++k) {
      const unsigned uc = __float_as_uint(C[k]);
      ev[k] = __expf(__uint_as_float(uc & 0xFFFFFF00u) - mx);
      es += ev[k];
      ids[k] = (int)(lut[(uc >> 4) & 15u] + lut[16 + (uc & 15u)]);
    }
    const float inv = 1.f / es;
    int* ip = IDX + (size_t)it * (8 * 128) + lane * 16;
    float* gp = GATE + (size_t)it * (8 * 128) + lane * 16;
#pragma unroll
    for (int q = 0; q < 4; ++q) {
      *(int4*)(ip + 4 * q) = make_int4(ids[4 * q], ids[4 * q + 1], ids[4 * q + 2], ids[4 * q + 3]);
      *(float4*)(gp + 4 * q) = make_float4(ev[4 * q] * inv, ev[4 * q + 1] * inv, ev[4 * q + 2] * inv, ev[4 * q + 3] * inv);
    }
  }
}

DI unsigned peer_ticket_issue(unsigned* cnt) {
  unsigned v = 0;
  if ((TID() & 63) == 0) v = __hip_atomic_fetch_add(cnt, 1u, __ATOMIC_RELAXED, __HIP_MEMORY_SCOPE_AGENT);
  return v;
}
DI float oct_sum(float v) {
  v += __builtin_bit_cast(float, __builtin_amdgcn_update_dpp(0, __builtin_bit_cast(int, v), 0xB1, 0xF, 0xF, true));
  v += __builtin_bit_cast(float, __builtin_amdgcn_update_dpp(0, __builtin_bit_cast(int, v), 0x4E, 0xF, 0xF, true));
  v += __builtin_bit_cast(float, __builtin_amdgcn_update_dpp(0, __builtin_bit_cast(int, v), 0x141, 0xF, 0xF, true));
  return v;
}

DI unsigned swar_add8(unsigned x) { return ((x & 0x7F7F7F7Fu) + 0x08080808u) ^ (x & 0x80808080u); }
DI void phase_peer_dots(const Params& p, int layer, char* smem_all) {
  const int rtid = RTID(), lane = rtid & 63, rwave = __builtin_amdgcn_readfirstlane(rtid >> 6);
  const int g = lane >> 3, j = lane & 7;
  int* lidx_all = (int*)(smem_all + rwave * 8192);
  const unsigned char* H8 = (const unsigned char*)(p.ws + WS_H8);
  const int* IDX = (const int*)(p.ws + WS_IDX);
  float* PD = (float*)(p.ws + WS_PD);
  const unsigned char* PU = (const unsigned char*)(p.ws + WS_PEERU) + (size_t)layer * (8 * NEXP * 128);
  const float* SC4 = (const float*)(p.ws + WS_USC4) + (size_t)layer * (8 * NEXP);
  unsigned* tick = (unsigned*)(p.ws + WS_TICKETS) + (size_t)(layer * 2 + 0) * 16 * 16;
  const int xcc = xcc_id() & 7;
#pragma unroll 1
  for (int so = 0; so < 8; ++so) {
    const int s = (xcc + so) & 7;
    unsigned tv = peer_ticket_issue(tick + s * 16);
    for (;;) {
      const int c = __builtin_amdgcn_readfirstlane((int)tv);
      if (c >= T_ / 16) break;
      tv = peer_ticket_issue(tick + s * 16);
#pragma unroll
      for (int gi = 0; gi < 2; ++gi) {
        const int* ip = IDX + (size_t)(c * 16 + gi * 8 + g) * 128 + 16 * j;
#pragma unroll
        for (int i = 0; i < 4; ++i) *(uint4*)(lidx_all + gi * 1024 + g * 128 + 16 * j + 4 * i) = *(const uint4*)(ip + 4 * i);
      }
#pragma unroll 1
      for (int gi = 0; gi < 2; ++gi) {
      const int t0 = c * 16 + gi * 8;
      const int* lidx = lidx_all + gi * 1024;
      unsigned xl[4], xh[4];
      {
        const unsigned char* hp = H8 + (size_t)(t0 + g) * D_ + s * 256 + 32 * j;
        const u32x4 h0 = *(const u32x4*)hp, h1 = *(const u32x4*)(hp + 16);
        const unsigned d[8] = {h0.x, h0.y, h0.z, h0.w, h1.x, h1.y, h1.z, h1.w};
#pragma unroll
        for (int m = 0; m < 4; ++m) {
          xl[m] = (d[2 * m] & 0x0F0F0F0Fu) | ((d[2 * m + 1] & 0x0F0F0F0Fu) << 4);
          xh[m] = ((swar_add8(d[2 * m]) >> 4) & 0x0F0F0F0Fu) | (swar_add8(d[2 * m + 1]) & 0xF0F0F0F0u);
        }
      }
      const unsigned char* ub = PU + (size_t)s * (NEXP * 128);
      const float* scs = SC4 + (size_t)s * NEXP;
      float* pd = PD + ((size_t)s * T_ + t0 + g) * 128;
      const bool b2_ = (lane & 4) != 0, b1_ = (lane & 2) != 0, b0_ = (lane & 1) != 0;
      u32x4 ra[8], rb[8], rc[8];
      float sa, sb, sc;
#define PD_LOAD(R, S, KB) { _Pragma("unroll") for (int q = 0; q < 8; ++q) { const int id = lidx[g * 128 + (KB) + q]; R[q] = *(const u32x4*)(ub + (unsigned)(id * 128 + 16 * j)); } \
                            S = scs[lidx[g * 128 + (KB) + j]]; }
#define DPPI(X, CTRL) __builtin_amdgcn_update_dpp(0, (X), (CTRL), 0xF, 0xF, true)
#define PD_COMP(R, S, KB)                                                                         \
      {                                                                                           \
        int pp[8];                                                                                \
        _Pragma("unroll") for (int q = 0; q < 8; ++q) {                                           \
          int al = __builtin_amdgcn_sdot8((int)R[q].x, (int)xl[0], 0, false);                     \
          int ah = __builtin_amdgcn_sdot8((int)R[q].x, (int)xh[0], 0, false);                     \
          al = __builtin_amdgcn_sdot8((int)R[q].y, (int)xl[1], al, false);                        \
          ah = __builtin_amdgcn_sdot8((int)R[q].y, (int)xh[1], ah, false);                        \
          al = __builtin_amdgcn_sdot8((int)R[q].z, (int)xl[2], al, false);                        \
          ah = __builtin_amdgcn_sdot8((int)R[q].z, (int)xh[2], ah, false);                        \
          al = __builtin_amdgcn_sdot8((int)R[q].w, (int)xl[3], al, false);                        \
          ah = __builtin_amdgcn_sdot8((int)R[q].w, (int)xh[3], ah, false);                        \
          pp[q] = al + 16 * ah;                                                                   \
        }                                                                                         \
          \
        int q4[4], q2[2];                                                                         \
        _Pragma("unroll") for (int i = 0; i < 4; ++i) {                                           \
          const int keep = b2_ ? pp[4 + i] : pp[i], send = b2_ ? pp[i] : pp[4 + i];               \
          q4[i] = keep + DPPI(send, 0x141);                   \
        }                                                                                         \
        _Pragma("unroll") for (int i = 0; i < 2; ++i) {                                           \
          const int keep = b1_ ? q4[2 + i] : q4[i], send = b1_ ? q4[i] : q4[2 + i];               \
          q2[i] = keep + DPPI(send, 0x4E);                      \
        }                                                                                         \
        {                                                                                         \
          const int keep = b0_ ? q2[1] : q2[0], send = b0_ ? q2[0] : q2[1];                       \
          pd[(KB) + j] = (float)(keep + DPPI(send, 0xB1)) * S;     \
        }                                                                                         \
        __builtin_amdgcn_sched_barrier(0);                                                        \
      }
      PD_LOAD(ra, sa, 0)
      PD_LOAD(rb, sb, 8)
#pragma unroll 1
      for (int kb = 0; kb < 120; kb += 24) {
        PD_LOAD(rc, sc, kb + 16)
        PD_COMP(ra, sa, kb)
        PD_LOAD(ra, sa, kb + 24)
        PD_COMP(rb, sb, kb + 8)
        { const int kl = kb + 32 < 120 ? kb + 32 : 120; PD_LOAD(rb, sb, kl) }
        PD_COMP(rc, sc, kb + 16)
      }
      PD_COMP(ra, sa, 120)
#undef PD_LOAD
#undef PD_COMP
#undef DPPI
      }
    }
  }
}

DI void phase_peer_act(const Params& p, int layer) {
  const int rtid = RTID(), lane = rtid & 63;
  const int gw = __builtin_amdgcn_readfirstlane((int)((blockIdx.x * RTHREADS + rtid) >> 6)), nw = (int)(gridDim.x * RTHREADS) >> 6;
  const float* PD = (const float*)(p.ws + WS_PD);
  const int* IDX = (const int*)(p.ws + WS_IDX);
  const float* GATE = (const float*)(p.ws + WS_GATE);
  const float* HS = (const float*)(p.ws + WS_HS);
  unsigned short* ACTQ = (unsigned short*)(p.ws + WS_ACT);
  float* ACTS = (float*)(p.ws + WS_ACT + 4 * MiB);
  const float* VSC = (const float*)(p.ws + WS_PEERV) + (size_t)(2 + layer) * NEXP;
  for (int t = gw; t < T_; t += nw) {
    const size_t e = (size_t)t * 128 + 2 * lane;
    float2 a = make_float2(0.f, 0.f);
#pragma unroll
    for (int s2 = 0; s2 < 8; ++s2) { const float2 q = *(const float2*)(PD + (size_t)s2 * T_ * 128 + e); a.x += q.x; a.y += q.y; }
    const int2 id = *(const int2*)(IDX + e);
    const float2 gt = *(const float2*)(GATE + e);
    const float hs = HS[t];
    const float v0 = gt.x * gelu_erf(a.x * hs) * VSC[id.x], v1 = gt.y * gelu_erf(a.y * hs) * VSC[id.y];
    const float am = wave_max(fmaxf(fabsf(v0), fabsf(v1)));
    const float qs = am > 0.f ? 127.f / am : 1.f;
    const int q0 = (int)rintf(v0 * qs), q1 = (int)rintf(v1 * qs);
    ACTQ[(size_t)t * 64 + lane] = (unsigned short)((q0 & 255) | ((q1 & 255) << 8));
    if (lane == 0) ACTS[t] = am > 0.f ? am / 127.f : 1.f;
  }
}

DI void phase_peer_values(const Params& p, int layer, const float* gate2, char* smem_all) {
  const int rtid = RTID(), lane = rtid & 63, rwave = __builtin_amdgcn_readfirstlane(rtid >> 6);
  const int g = lane >> 3, j = lane & 7;
  int* lidx_all = (int*)(smem_all + rwave * 16384);
  unsigned* lact_all = (unsigned*)(smem_all + rwave * 16384 + 4096);
  const int* IDX = (const int*)(p.ws + WS_IDX);
  const unsigned* ACTQ = (const unsigned*)(p.ws + WS_ACT);
  const float* ACTS = (const float*)(p.ws + WS_ACT + 4 * MiB);
  const unsigned char* PV = (const unsigned char*)(p.ws + WS_PEERV8) + (size_t)layer * NEXP * D_;
  unsigned* tick = (unsigned*)(p.ws + WS_TICKETS) + (size_t)(layer * 2 + 1) * 16 * 16;
  const int xcc = xcc_id() & 7;
#pragma unroll 1
  for (int so = 0; so < 16; ++so) {
    const int s = ((xcc + (so >> 1)) & 7) + 8 * (so & 1);
    unsigned tv = peer_ticket_issue(tick + s * 16);
    for (;;) {
      const int c = __builtin_amdgcn_readfirstlane((int)tv);
      if (c >= T_ / 16) break;
      tv = peer_ticket_issue(tick + s * 16);
#pragma unroll
      for (int gi = 0; gi < 2; ++gi) {
        const int* ip = IDX + (size_t)(c * 16 + gi * 8 + g) * 128 + 16 * j;
#pragma unroll
        for (int i = 0; i < 4; ++i) *(uint4*)(lidx_all + gi * 2048 + g * 128 + 16 * j + 4 * i) = *(const uint4*)(ip + 4 * i);
        *(uint4*)(lact_all + gi * 2048 + g * 32 + 4 * j) = *(const uint4*)(ACTQ + (size_t)(c * 16 + gi * 8 + g) * 32 + 4 * j);
      }
#pragma unroll 1
      for (int gi = 0; gi < 2; ++gi) {
      const int t0 = c * 16 + gi * 8;
      const int* lidx = lidx_all + gi * 2048;
      const unsigned* lact = lact_all + gi * 2048;
      const unsigned char* vb = PV + (size_t)s * (NEXP * 128);
      int y[16];
#pragma unroll
      for (int i = 0; i < 16; ++i) y[i] = 0;
      u32x4 ra[8], rb[8];
      const int tq = t0 + g;
      bf16_t* rrow = (bf16_t*)(p.ws + WS_R16) + (size_t)tq * D_ + s * 128 + 16 * j;
      float* orow = p.out + (size_t)tq * D_ + s * 128 + 16 * j;
      const float* grow = gate2 + (size_t)(tq >> 11) * 12288 + s * 128 + 16 * j;
      u32x4 ia0 = *(const u32x4*)(lidx + g * 128), ia1 = *(const u32x4*)(lidx + g * 128 + 4);
#define PV_LOAD(R, KBN) { const unsigned ids_[8] = {ia0.x, ia0.y, ia0.z, ia0.w, ia1.x, ia1.y, ia1.z, ia1.w};                         \
        _Pragma("unroll") for (int q = 0; q < 8; ++q) R[q] = *(const u32x4*)(vb + (ids_[q] * 128u + 16u * (unsigned)j));              \
        ia0 = *(const u32x4*)(lidx + g * 128 + (KBN)); ia1 = *(const u32x4*)(lidx + g * 128 + (KBN) + 4); }
#define PV_QUAD(W0, W1, W2, W3, AQ, YB) {                                                                                             \
        const unsigned t0_ = __builtin_amdgcn_perm((W1), (W0), 0x05010400u), t1_ = __builtin_amdgcn_perm((W1), (W0), 0x07030602u);    \
        const unsigned t2_ = __builtin_amdgcn_perm((W3), (W2), 0x05010400u), t3_ = __builtin_amdgcn_perm((W3), (W2), 0x07030602u);    \
        y[(YB) + 0] = __builtin_amdgcn_sdot4((int)__builtin_amdgcn_perm(t2_, t0_, 0x05040100u), (int)(AQ), y[(YB) + 0], false);       \
        y[(YB) + 1] = __builtin_amdgcn_sdot4((int)__builtin_amdgcn_perm(t2_, t0_, 0x07060302u), (int)(AQ), y[(YB) + 1], false);       \
        y[(YB) + 2] = __builtin_amdgcn_sdot4((int)__builtin_amdgcn_perm(t3_, t1_, 0x05040100u), (int)(AQ), y[(YB) + 2], false);       \
        y[(YB) + 3] = __builtin_amdgcn_sdot4((int)__builtin_amdgcn_perm(t3_, t1_, 0x07060302u), (int)(AQ), y[(YB) + 3], false); }
#define PV_COMP(R, KB)                                                                            \
      { const unsigned aq0 = lact[g * 32 + ((KB) >> 2)], aq1 = lact[g * 32 + ((KB) >> 2) + 1];    \
        PV_QUAD(R[0].x, R[1].x, R[2].x, R[3].x, aq0, 0)  PV_QUAD(R[0].y, R[1].y, R[2].y, R[3].y, aq0, 4)   \
        PV_QUAD(R[0].z, R[1].z, R[2].z, R[3].z, aq0, 8)  PV_QUAD(R[0].w, R[1].w, R[2].w, R[3].w, aq0, 12)  \
        __builtin_amdgcn_sched_barrier(0);                                                        \
        PV_QUAD(R[4].x, R[5].x, R[6].x, R[7].x, aq1, 0)  PV_QUAD(R[4].y, R[5].y, R[6].y, R[7].y, aq1, 4)   \
        PV_QUAD(R[4].z, R[5].z, R[6].z, R[7].z, aq1, 8)  PV_QUAD(R[4].w, R[5].w, R[6].w, R[7].w, aq1, 12)  \
        __builtin_amdgcn_sched_barrier(0); }
      PV_LOAD(ra, 8)
#pragma unroll 1
      for (int kb = 0; kb < 128; kb += 16) {
        { const int kn = kb + 16 < 120 ? kb + 16 : 120; PV_LOAD(rb, kn) }
        PV_COMP(ra, kb)
        { const int kn = kb + 24 < 120 ? kb + 24 : 120; PV_LOAD(ra, kn) }
        PV_COMP(rb, kb + 8)
      }
#undef PV_LOAD
#undef PV_COMP
#undef PV_QUAD
      const float as = ACTS[tq];
      const u32x4 r0 = *(const u32x4*)rrow, r1 = *(const u32x4*)(rrow + 8);
      const unsigned rw[8] = {r0.x, r0.y, r0.z, r0.w, r1.x, r1.y, r1.z, r1.w};
      float res[16];
#pragma unroll
      for (int i = 0; i < 4; ++i) {
        float4 g0 = *(const float4*)(grow + 4 * i);
        g0.x *= as; g0.y *= as; g0.z *= as; g0.w *= as;
        res[4 * i + 0] = bf_lo(rw[2 * i]) + g0.x * (float)y[4 * i];     res[4 * i + 1] = bf_hi(rw[2 * i]) + g0.y * (float)y[4 * i + 1];
        res[4 * i + 2] = bf_lo(rw[2 * i + 1]) + g0.z * (float)y[4 * i + 2]; res[4 * i + 3] = bf_hi(rw[2 * i + 1]) + g0.w * (float)y[4 * i + 3];
      }
      if (layer == 0) {
        u32x4 w0, w1;
        w0.x = pack_bf2(res[0], res[1]); w0.y = pack_bf2(res[2], res[3]); w0.z = pack_bf2(res[4], res[5]); w0.w = pack_bf2(res[6], res[7]);
        w1.x = pack_bf2(res[8], res[9]); w1.y = pack_bf2(res[10], res[11]); w1.z = pack_bf2(res[12], res[13]); w1.w = pack_bf2(res[14], res[15]);
        *(u32x4*)rrow = w0; *(u32x4*)(rrow + 8) = w1;
      } else {
#pragma unroll
        for (int i = 0; i < 4; ++i) *(float4*)(orow + 4 * i) = make_float4(res[4 * i], res[4 * i + 1], res[4 * i + 2], res[4 * i + 3]);
      }
      }
    }
  }
}

#define XB_TMO      128
#define XB_XCNT(j)  (256  + 64 * (j))
#define XB_XSUB(j)  (1280 + 64 * (j))
#define XB_XGEN(j)  (2304 + 64 * (j))
#define XB_TOP      3328
#define XB_TOPGEN   3392
#define XCD_BAR_WORDS 3456
#define XB_SPIN_CAP (1u << 22)
#define LAS __attribute__((address_space(3)))
DI unsigned xb_ld(unsigned* p) { return __hip_atomic_load(p, __ATOMIC_RELAXED, __HIP_MEMORY_SCOPE_AGENT); }
DI unsigned xb_add(unsigned* p, unsigned v) { return __hip_atomic_fetch_add(p, v, __ATOMIC_RELAXED, __HIP_MEMORY_SCOPE_AGENT); }
DI unsigned xb_xcc_id() { return (unsigned)__builtin_amdgcn_s_getreg((3 << 11) | 20) & 0xFu; }
#define XB_SPIN(cond, bar) do { unsigned _sp = 0; while (cond) { __builtin_amdgcn_s_sleep(1); \
    if ((++_sp & 255u) == 0u) { if (xb_ld(&(bar)[XB_TMO])) break; if (_sp > XB_SPIN_CAP) { atomicAdd(&(bar)[XB_TMO], 1u); break; } } } } while (0)
struct XcdBarrier { unsigned* bar; unsigned x; volatile LAS unsigned* st; };
DI XcdBarrier xcd_barrier_post(unsigned* bar, volatile LAS unsigned* st) {
  XcdBarrier b; b.bar = bar; b.x = xb_xcc_id(); b.st = st;
  if (threadIdx.x == 0) (void)xb_add(&bar[XB_XCNT(b.x)], 1u);
  return b;
}
DI void xcd_barrier_complete(unsigned* bar, unsigned x, unsigned& nloc, unsigned& nx) {
  const unsigned G = gridDim.x * gridDim.y * gridDim.z;
  unsigned sum, cnt, mine, sp = 0u;
  for (;;) {
    sum = 0u; cnt = 0u; mine = 0u;
#pragma unroll
    for (unsigned j = 0; j < 16; ++j) { const unsigned c = xb_ld(&bar[XB_XCNT(j)]); sum += c; cnt += (c > 0u) ? 1u : 0u; mine = (j == x) ? c : mine; }
    if (sum == G) break;
    __builtin_amdgcn_s_sleep(1);
    if ((++sp & 255u) == 0u) { if (xb_ld(&bar[XB_TMO])) break; if (sp > XB_SPIN_CAP) { atomicAdd(&bar[XB_TMO], 1u); break; } }
  }
  nloc = mine > 0u ? mine : 1u; nx = cnt > 0u ? cnt : 1u;
}
DI void xcd_barrier(const XcdBarrier& b) {
  asm volatile("s_waitcnt vmcnt(0)" ::: "memory");
  __syncthreads();
  if (threadIdx.x == 0) {
    unsigned* bar = b.bar;
    __builtin_amdgcn_s_waitcnt(0);
    unsigned nloc = b.st[0], nx = b.st[1];
    if (nloc == 0u) { xcd_barrier_complete(bar, b.x, nloc, nx); b.st[0] = nloc; b.st[1] = nx; }
    const unsigned old = xb_add(&bar[XB_XSUB(b.x)], 1u);
    const unsigned gen = old / nloc;
    if (old + 1u == (gen + 1u) * nloc) {
      __builtin_amdgcn_fence(__ATOMIC_RELEASE, "agent");
      asm volatile("s_waitcnt vmcnt(0)" ::: "memory");
      const unsigned og = xb_add(&bar[XB_TOP], 1u);
      const unsigned tg = og / nx;
      if (og + 1u == (tg + 1u) * nx) xb_add(&bar[XB_TOPGEN], 1u);
      else XB_SPIN(xb_ld(&bar[XB_TOPGEN]) == tg, bar);
      __builtin_amdgcn_fence(__ATOMIC_ACQUIRE, "agent");
      xb_add(&bar[XB_XGEN(b.x)], 1u);
      asm volatile("s_waitcnt vmcnt(0)" ::: "memory");
    } else {
      XB_SPIN(xb_ld(&bar[XB_XGEN(b.x)]) == gen, bar);
      __builtin_amdgcn_fence(__ATOMIC_ACQUIRE, "agent");
      asm volatile("s_waitcnt vmcnt(0)" ::: "memory");
    }
  }
  __syncthreads();
}

constexpr int N_PHASES = 22;
template <class Epi>
DI void gemm256(char* smem_all, const bf16_t* A, const bf16_t* Bt, int M, int N, int K, const Epi& E) {
  pg8::Gemm g{A, Bt, M, N, K};
  pg8::StaticOrder S; S.init(M, N, (int)gridDim.x, (int)blockIdx.x);
  pg8::gemm_phase<Epi, pg8::StaticOrder, false>((PG8_LAS unsigned char*)smem_all, g, S, E, nullptr);
}
template <int ph>
DI void run_phase(const Params& p_in, char* smem, char* smem_all) {
  Params p = p_in;
  {
    size_t z = 0; asm volatile("" : "+s"(z)); p.ws = p_in.ws + z; p.out = p_in.out + z;
  }
  char* ws = p.ws;
  const float* mod = (const float*)(ws + WS_MOD);
  const bf16_t* H = (const bf16_t*)(ws + WS_H);
  if (ph == 0) { phase_prep(p, smem); return; }
  const int layer = ph >= 12 ? 1 : 0;
  const int lp = ph - (layer ? 12 : 1);
  int sub;
  if (layer == 0) sub = lp < 2 ? lp : lp + 1;
  else sub = lp < 2 ? lp : (lp == 2 ? 3 : lp + 2);
  const float* modl = mod + (size_t)layer * 8 * 12288;
  switch (sub) {
    case 0:
      if (layer == 0) { phase_norm<false, 2>(p, p.x, p.norm_gain, modl, modl + 2048); forget_logits(p); quant_w8(p); }
      else phase_norm<false, 2, true>(p, ws + WS_R16, p.norm_gain + 2 * 2048, modl, modl + 2048);
      break;
    case 1: {
      if (layer == 0) fox_cumsum(p);
      const bf16_t* H8A = (const bf16_t*)(ws + WS_H8A);
      const float* hsc = (const float*)(ws + WS_H8A + 32 * MiB);
      const bf16_t* W8 = (const bf16_t*)(ws + WS_W8) + (size_t)layer * 6144 * 1024;
      const float* wsc = (const float*)(ws + WS_W8 + 24 * MiB) + layer * 6144;
      pg8::EpiQkNorm eq{(bf16_t*)(ws + WS_QK), 4096, layer ? p.odd_qk_gain : p.even_fox_qk_gain, layer ? p.odd_qk_gain : p.even_diff_qk_gain,
                        layer ? 4 : 3, (float*)(smem_all + 131072), wsc, hsc};
      gemm256(smem_all, H8A, W8, T_, 4096, 1024, eq);
      pg8::EpiVt8 ev{(bf16_t*)(ws + WS_VT), T_, wsc + 4096, hsc};
      gemm256(smem_all, W8 + (size_t)4096 * 1024, H8A, 2048, T_, 1024, ev);
    } break;
    case 3:
      if (layer == 0) phase_attn_even(p, smem_all); else phase_attn_odd(p, smem_all);
      break;
    case 4: phase_diff_combine(p); break;
    case 5: {
      bf16_t* R16 = (bf16_t*)(ws + WS_R16);
      if (layer == 0) { pg8::EpiRes16<false> er{R16, 2048, p.x, modl + 2 * 2048};
        gemm256(smem_all, (const bf16_t*)(ws + WS_ATT), (const bf16_t*)(ws + WS_WO0), T_, 2048, 2048, er); }
      else { pg8::EpiRes16<true> er{R16, 2048, R16, modl + 2 * 2048};
        gemm256(smem_all, (const bf16_t*)(ws + WS_ATT), (const bf16_t*)(ws + WS_WO1), T_, 2048, 2048, er); }
    } break;
    case 6:
      phase_norm<false, 1, true>(p, ws + WS_R16, p.norm_gain + (layer * 2 + 1) * 2048, modl + 3 * 2048, modl + 4 * 2048);
      break;
    case 7: {
      pg8::EpiBf16 es{(bf16_t*)(ws + WS_SC), 2048};
      gemm256(smem_all, H, (const bf16_t*)(ws + (layer ? WS_WQ1 : WS_WQ0)), T_, 2048, 2048, es);
    } break;
    case 8: phase_peer_retrieve(p, smem); break;
    case 9: phase_peer_dots(p, layer, smem_all); break;
    case 10: phase_peer_act(p, layer); break;
    case 11: phase_peer_values(p, layer, modl + 5 * 2048, smem_all); break;
  }
}

#if FUSED
template <int PH>
DI void run_all(const Params& p, char* smem, char* smem_all, const XcdBarrier& xb, cg::grid_group& grid) {
  if constexpr (PH < N_PHASES) {
    run_phase<PH>(p, smem, smem_all);
    if constexpr (PH + 1 < N_PHASES) xcd_barrier(xb);
    run_all<PH + 1>(p, smem, smem_all, xb, grid);
  }
}
__global__ void __launch_bounds__(RTHREADS, 2) mega_kernel(Params p) {
  extern __shared__ __attribute__((aligned(16))) char smem_all[];
  char* smem = smem_all + (RTID() >> 8) * HALF_SMEM;
  cg::grid_group grid = cg::this_grid();
  volatile LAS unsigned* xst = (volatile LAS unsigned*)(smem_all + SMEM_BYTES - 16);
  if (threadIdx.x == 0) { xst[0] = 0u; xst[1] = 0u; }
  __syncthreads();
  const XcdBarrier xb = xcd_barrier_post((unsigned*)(p.ws + WS_BAR), xst);
  if (p.ws == nullptr) grid.sync();
  run_all<0>(p, smem, smem_all, xb, grid);
}
#else
template <int PH>
__global__ void __launch_bounds__(RTHREADS, 2) phase_kernel(Params p) {
  extern __shared__ __attribute__((aligned(16))) char smem_all[];
  char* smem = smem_all + (RTID() >> 8) * HALF_SMEM;
  run_phase<PH>(p, smem, smem_all);
}
template <int PH>
static void launch_phases(const Params& p, int grid, hipStream_t stream) {
  if constexpr (PH < N_PHASES) {
    (void)hipFuncSetAttribute((const void*)phase_kernel<PH>, hipFuncAttributeMaxDynamicSharedMemorySize, SMEM_BYTES);
    phase_kernel<PH><<<grid, RTHREADS, SMEM_BYTES, stream>>>(p);
    launch_phases<PH + 1>(p, grid, stream);
  }
}
#endif

extern "C" void kernel_launch(void* const* d_in, const int* in_sizes, int n_in, void* d_out, int out_size, void* d_ws,
                              size_t ws_size, hipStream_t stream) {
  Params p{};
  p.x = (const float*)d_in[0]; p.c = (const float*)d_in[1]; p.rel_bias = (const float*)d_in[2];
  p.norm_gain = (const float*)d_in[3]; p.w_ada = (const float*)d_in[4]; p.b_ada = (const float*)d_in[5];
  p.even_w_in = (const float*)d_in[6]; p.even_b_forget = (const float*)d_in[7]; p.even_fox_qk_gain = (const float*)d_in[8];
  p.even_diff_qk_gain = (const float*)d_in[9]; p.even_diff_lambda = (const float*)d_in[10];
  p.even_diff_subln_gain = (const float*)d_in[11]; p.even_w_out = (const float*)d_in[12];
  p.odd_w_qkv = (const float*)d_in[13]; p.odd_qk_gain = (const float*)d_in[14]; p.odd_w_out = (const float*)d_in[15];
  p.peer_w_query = (const float*)d_in[16]; p.peer_sub_keys = (const float*)d_in[17];
  p.peer_u = (const float*)d_in[18]; p.peer_v = (const float*)d_in[19];
  p.out = (float*)d_out; p.ws = (char*)d_ws;
  if (ws_size < WS_END) { fprintf(stderr, "workspace too small: %zu < %zu\n", ws_size, (size_t)WS_END); return; }
#if FUSED
  static int grid_blocks = 0;
  if (!grid_blocks) {
    int dev = 0, cus = 0, per_cu = 0;
    (void)hipGetDevice(&dev);
    (void)hipDeviceGetAttribute(&cus, hipDeviceAttributeMultiprocessorCount, dev);
    (void)hipFuncSetAttribute((const void*)mega_kernel, hipFuncAttributeMaxDynamicSharedMemorySize, SMEM_BYTES);
    (void)hipOccupancyMaxActiveBlocksPerMultiprocessor(&per_cu, mega_kernel, RTHREADS, SMEM_BYTES);
    if (per_cu > 1) per_cu = 1;
    grid_blocks = cus * per_cu;
  }
  (void)hipMemsetAsync(p.ws + WS_BAR, 0, WS_BAR_BYTES, stream);
  void* args[] = {&p};
  hipError_t e = hipLaunchCooperativeKernel((void*)mega_kernel, dim3(grid_blocks), dim3(RTHREADS), args, SMEM_BYTES, stream);
  if (e != hipSuccess) fprintf(stderr, "cooperative launch failed: %s (grid %d)\n", hipGetErrorString(e), grid_blocks);
#else
  launch_phases<0>(p, 256, stream);
#endif
}
```

```cpp
#include <hip/hip_runtime.h>
#include <hip/hip_cooperative_groups.h>
#include <stdint.h>
#include <stdio.h>
namespace cg = cooperative_groups;

#ifndef FUSED
#define FUSED 1
#endif

#define DI __device__ __forceinline__
typedef unsigned short bf16_t;
typedef __attribute__((ext_vector_type(8))) short bf16x8;
typedef __attribute__((ext_vector_type(4))) short bf16x4;
typedef __attribute__((ext_vector_type(16))) float f32x16;
typedef __attribute__((ext_vector_type(2))) __bf16 bf2_t;
typedef __attribute__((ext_vector_type(2))) float f2_t;
typedef __attribute__((ext_vector_type(4))) unsigned u32x4;
#define MFMA32(a, b, c) __builtin_amdgcn_mfma_f32_32x32x16_bf16((a), (b), (c), 0, 0, 0)

constexpr int T_ = 16384;
constexpr int D_ = 2048;
constexpr int S_ = 2048;
constexpr int NB_ = 8;
constexpr int NEXP = 16384;
constexpr float LOG2E = 1.4426950408889634f;
constexpr int NTHREADS = 256;
constexpr int HALF_SMEM = 75776;
constexpr int RTHREADS = 512;
constexpr int SMEM_BYTES = 2 * HALF_SMEM + 16;

constexpr size_t MiB = 1048576;
constexpr size_t WS_PEERU = 0;
constexpr size_t WS_PEERV8 = WS_PEERU + 64 * MiB;
constexpr size_t WS_PEERV = WS_PEERU + 128 * MiB;
constexpr size_t WS_WQK0 = WS_PEERV + 128 * MiB;
constexpr size_t WS_WV0 = WS_WQK0 + 16 * MiB;
constexpr size_t WS_WQK1 = WS_WV0 + 8 * MiB;
constexpr size_t WS_WV1 = WS_WQK1 + 16 * MiB;
constexpr size_t WS_WO0 = WS_WV1 + 8 * MiB;
constexpr size_t WS_WO1 = WS_WO0 + 8 * MiB;
constexpr size_t WS_WQ0 = WS_WO1 + 8 * MiB;
constexpr size_t WS_WQ1 = WS_WQ0 + 8 * MiB;
constexpr size_t WS_SK = WS_WQ1 + 8 * MiB;
constexpr size_t WS_WFF = WS_SK + 131072;
constexpr size_t WS_MOD = WS_WFF + 65536;
constexpr size_t WS_LOGF = WS_MOD + 786432;
constexpr size_t WS_FCUM = WS_LOGF + 524288;
constexpr size_t WS_MISC = WS_FCUM + 524288;
constexpr size_t WS_H = WS_MISC + 65536;
constexpr size_t WS_QK = WS_H + 64 * MiB;
constexpr size_t WS_VT = WS_QK + 128 * MiB;
constexpr size_t WS_ATT = WS_VT + 64 * MiB;
constexpr size_t WS_SC = WS_ATT + 64 * MiB;
constexpr size_t WS_BAR = WS_SC + 128 * MiB;
constexpr size_t WS_TICKETS = WS_BAR + 16384;
constexpr size_t WS_BAR_BYTES = 16384 + 4096;
constexpr size_t WS_IDX = WS_ATT;
constexpr size_t WS_GATE = WS_ATT + 8 * MiB;
constexpr size_t WS_ACT = WS_ATT + 16 * MiB;
constexpr size_t WS_PD = WS_SC;
constexpr size_t WS_USC4 = WS_PEERV + 1 * MiB;
constexpr size_t WS_H8 = WS_QK;
constexpr size_t WS_HS = WS_QK + 32 * MiB;
constexpr size_t WS_R16 = WS_BAR + 65536;
constexpr size_t WS_H8A = WS_R16 + 64 * MiB;
constexpr size_t WS_W8 = WS_H8A + 33 * MiB;
constexpr size_t WS_END = WS_W8 + 25 * MiB;

struct Params {
  const float* x; const float* c; const float* rel_bias; const float* norm_gain; const float* w_ada; const float* b_ada;
  const float* even_w_in; const float* even_b_forget; const float* even_fox_qk_gain; const float* even_diff_qk_gain;
  const float* even_diff_lambda; const float* even_diff_subln_gain; const float* even_w_out;
  const float* odd_w_qkv; const float* odd_qk_gain; const float* odd_w_out;
  const float* peer_w_query; const float* peer_sub_keys; const float* peer_u; const float* peer_v;
  float* out; char* ws;
};

DI unsigned pack_bf2(float a, float b) { f2_t v = {a, b}; return __builtin_bit_cast(unsigned, __builtin_convertvector(v, bf2_t)); }
DI unsigned pack_i8x4(float a, float b, float c, float d) {
  const int ia = (int)rintf(a), ib = (int)rintf(b), ic = (int)rintf(c), id = (int)rintf(d);
  return (unsigned)(ia & 255) | ((unsigned)(ib & 255) << 8) | ((unsigned)(ic & 255) << 16) | ((unsigned)id << 24);
}
DI unsigned q4(float v) { int q = (int)rintf(v); q = q > 7 ? 7 : (q < -7 ? -7 : q); return (unsigned)q & 15u; }
DI unsigned pack_i4x4(float a, float b, float c, float d) { return q4(a) | (q4(b) << 8) | (q4(c) << 16) | (q4(d) << 24); }
DI bf16_t f2bf(float a) { return (bf16_t)(pack_bf2(a, 0.f) & 0xffffu); }
DI float bf_lo(unsigned u) { return __uint_as_float(u << 16); }
DI float bf_hi(unsigned u) { return __uint_as_float(u & 0xffff0000u); }
DI int RTID() { int t = threadIdx.x; asm volatile("" : "+v"(t)); return t; }
DI int TID() { return RTID() & 255; }
DI int VBID() { return __builtin_amdgcn_readfirstlane(blockIdx.x * 2 + (RTID() >> 8)); }
DI int VGRID() { return gridDim.x * 2; }
DI int xcc_id() { return (int)(__builtin_amdgcn_s_getreg((3 << 11) | 20) & 0xFu); }
DI int crow(int reg, int h) { return (reg & 3) + 8 * (reg >> 2) + 4 * h; }
DI float wave_sum(float v) {
#pragma unroll
  for (int o = 32; o >= 1; o >>= 1) v += __shfl_xor(v, o);
  return v;
}
DI float wave_max(float v) {
#pragma unroll
  for (int o = 32; o >= 1; o >>= 1) v = fmaxf(v, __shfl_xor(v, o));
  return v;
}

DI void transpose_tile(const float* __restrict__ src, int ld, int c0, int k0, bf16_t* __restrict__ dst_row0, char* smem) {
  float* tile = (float*)smem;
  const int tid = TID();
  const int ty = tid >> 4, tx = tid & 15;
#pragma unroll
  for (int i = 0; i < 4; ++i) {
    const int k = ty + 16 * i;
    const float4 v = *(const float4*)(src + (size_t)(k0 + k) * ld + c0 + 4 * tx);
    float* t = tile + k * 65 + 4 * tx;
    t[0] = v.x; t[1] = v.y; t[2] = v.z; t[3] = v.w;
  }
  __syncthreads();
  const int cc = tid >> 2, kc = (tid & 3) * 16;
  unsigned pk[8];
#pragma unroll
  for (int j = 0; j < 8; ++j) pk[j] = pack_bf2(tile[(kc + 2 * j) * 65 + cc], tile[(kc + 2 * j + 1) * 65 + cc]);
  uint4* d = (uint4*)(dst_row0 + (size_t)cc * 2048 + k0 + kc);
  d[0] = make_uint4(pk[0], pk[1], pk[2], pk[3]);
  d[1] = make_uint4(pk[4], pk[5], pk[6], pk[7]);
  __syncthreads();
}

DI void phase_prep(const Params& p, char* smem) {
  const int tid = TID(), bid = VBID(), G = VGRID();
  char* ws = p.ws;
  {
    float* cond = (float*)smem;
    bool have_cond = false;
    for (int item = bid; item < 384; item += G) {
      if (!have_cond) {
        for (int e = tid; e < NB_ * D_; e += NTHREADS) {
          const int b = e >> 11, d = e & 2047;
          const float v = p.c[e];
          cond[d * 8 + b] = v / (1.f + __expf(-v));
        }
        have_cond = true;
        __syncthreads();
      }
      const int i = item / 192, n = (item % 192) * 64 + (tid & 63);
      const int w = tid >> 6;
      const float* wp = p.w_ada + (size_t)i * D_ * 12288 + n;
      float acc[8];
#pragma unroll
      for (int b = 0; b < 8; ++b) acc[b] = 0.f;
#pragma unroll 8
      for (int d = w; d < D_; d += 4) {
        const float wv = wp[(size_t)d * 12288];
        const float4 c0 = *(const float4*)(cond + d * 8), c1 = *(const float4*)(cond + d * 8 + 4);
        acc[0] += c0.x * wv; acc[1] += c0.y * wv; acc[2] += c0.z * wv; acc[3] += c0.w * wv;
        acc[4] += c1.x * wv; acc[5] += c1.y * wv; acc[6] += c1.z * wv; acc[7] += c1.w * wv;
      }
      float* red = (float*)(smem + 65536);
#pragma unroll
      for (int b = 0; b < 8; ++b) red[(w * 64 + (tid & 63)) * 8 + b] = acc[b];
      __syncthreads();
      if (tid < 64) {
        float* mod = (float*)(ws + WS_MOD);
#pragma unroll
        for (int b = 0; b < 8; ++b) {
          const float s = red[(0 * 64 + tid) * 8 + b] + red[(1 * 64 + tid) * 8 + b] + red[(2 * 64 + tid) * 8 + b] + red[(3 * 64 + tid) * 8 + b];
          mod[((size_t)i * 8 + b) * 12288 + n] = s + p.b_ada[i * 12288 + n];
        }
      }
      __syncthreads();
    }
    __syncthreads();
  }
  {
    bf16_t* wqk0 = (bf16_t*)(ws + WS_WQK0); bf16_t* wv0 = (bf16_t*)(ws + WS_WV0);
    bf16_t* wqk1 = (bf16_t*)(ws + WS_WQK1); bf16_t* wv1 = (bf16_t*)(ws + WS_WV1);
    for (int item = bid; item < 256 * 32; item += G) {
      const int ct = item >> 5, kt = item & 31;
      const float* src; int ld, c0; bf16_t* dst;
      if (ct < 96) {
        const int seg = ct >> 4, cl = (ct & 15) * 64;
        src = p.even_w_in; ld = 6152;
        c0 = (seg < 3 ? seg * 1024 : 3080 + (seg - 3) * 1024) + cl;
        if (seg == 0) dst = wqk0 + (size_t)cl * 2048;
        else if (seg == 1) dst = wqk0 + (size_t)(1024 + cl) * 2048;
        else if (seg == 2) dst = wv0 + (size_t)cl * 2048;
        else if (seg == 3) dst = wqk0 + (size_t)(2048 + cl) * 2048;
        else if (seg == 4) dst = wqk0 + (size_t)(3072 + cl) * 2048;
        else dst = wv0 + (size_t)(1024 + cl) * 2048;
      } else if (ct < 192) {
        const int cl = (ct - 96) * 64;
        src = p.odd_w_qkv; ld = 6144; c0 = cl;
        dst = cl < 4096 ? wqk1 + (size_t)cl * 2048 : wv1 + (size_t)(cl - 4096) * 2048;
      } else {
        const int mi = (ct - 192) >> 5, cl = ((ct - 192) & 31) * 64;
        ld = 2048; c0 = cl;
        if (mi == 0) { src = p.even_w_out; dst = (bf16_t*)(ws + WS_WO0); }
        else { src = p.odd_w_out; dst = (bf16_t*)(ws + WS_WO1); }
        dst += (size_t)cl * 2048;
      }
      transpose_tile(src, ld, c0, kt * 64, dst, smem);
    }
  }
  {
    const int lane = tid & 63;
    const int gw = __builtin_amdgcn_readfirstlane((bid * NTHREADS + tid) >> 6), nw = (G * NTHREADS) >> 6;
    float* scl = (float*)(ws + WS_PEERV);
    float4 nx[8];
    {
      const int r0 = gw < 4 * NEXP ? gw : 0;
      const float* s0 = ((r0 >> 15) ? p.peer_v : p.peer_u) + (size_t)(r0 & 32767) * D_;
#pragma unroll
      for (int i = 0; i < 2; ++i)
#pragma unroll
        for (int j = 0; j < 4; ++j) nx[4 * i + j] = *(const float4*)(s0 + lane * 16 + 1024 * i + 4 * j);
    }
    for (int row = gw; row < 4 * NEXP; row += nw) {
      const int tab = row >> 15, rr = row & 32767;
      unsigned char* dst = (unsigned char*)(ws + (tab ? WS_PEERV8 : WS_PEERU)) + (size_t)(rr >> 14) * NEXP * D_ + (size_t)(rr & (NEXP - 1)) * 128;
      float4 v[8];
      float am = 0.f;
#pragma unroll
      for (int i = 0; i < 8; ++i) v[i] = nx[i];
      {
        const int rn = row + nw < 4 * NEXP ? row + nw : row;
        const float* sn = ((rn >> 15) ? p.peer_v : p.peer_u) + (size_t)(rn & 32767) * D_;
#pragma unroll
        for (int i = 0; i < 2; ++i)
#pragma unroll
          for (int j = 0; j < 4; ++j) nx[4 * i + j] = *(const float4*)(sn + lane * 16 + 1024 * i + 4 * j);
        asm volatile("" ::: "memory");
      }
#pragma unroll
      for (int i = 0; i < 8; ++i) am = fmaxf(am, fmaxf(fmaxf(fabsf(v[i].x), fabsf(v[i].y)), fmaxf(fabsf(v[i].z), fabsf(v[i].w))));
      if (!tab) {
        unsigned char* d4 = (unsigned char*)(ws + WS_PEERU) + (size_t)(rr >> 14) * (8 * NEXP * 128) + (size_t)(rr & (NEXP - 1)) * 128 + (lane & 15) * 8;
        float* sc4 = (float*)(ws + WS_USC4) + (size_t)(rr >> 14) * (8 * NEXP) + (rr & (NEXP - 1));
#pragma unroll
        for (int i = 0; i < 2; ++i) {
          float bm = 0.f;
#pragma unroll
          for (int j = 0; j < 4; ++j) bm = fmaxf(bm, fmaxf(fmaxf(fabsf(v[4 * i + j].x), fabsf(v[4 * i + j].y)), fmaxf(fabsf(v[4 * i + j].z), fabsf(v[4 * i + j].w))));
#pragma unroll
          for (int o = 1; o < 16; o <<= 1) bm = fmaxf(bm, __shfl_xor(bm, o));
          const float sc = bm > 0.f ? 7.5f / bm : 1.f;
          const int slice = 4 * i + (lane >> 4);
          if ((lane & 15) == 0) sc4[(size_t)slice * NEXP] = bm > 0.f ? bm / 7.5f : 1.f;
          unsigned w[2];
#pragma unroll
          for (int gq = 0; gq < 2; ++gq) {
            const float4 a = v[4 * i + 2 * gq], b = v[4 * i + 2 * gq + 1];
            const unsigned lo = pack_i4x4(a.x * sc, a.y * sc, a.z * sc, a.w * sc);
            const unsigned hi = pack_i4x4(b.x * sc, b.y * sc, b.z * sc, b.w * sc);
            w[gq] = lo | (hi << 4);
          }
          *(uint2*)(d4 + (size_t)slice * (NEXP * 128)) = make_uint2(w[0], w[1]);
        }
        continue;
      }
      am = wave_max(am);
      const float sc = am > 0.f ? 127.f / am : 1.f;
      if (lane == 0) scl[row] = am > 0.f ? am / 127.f : 1.f;
#pragma unroll
      for (int i = 0; i < 2; ++i) {
        unsigned w[4];
#pragma unroll
        for (int j = 0; j < 4; ++j) w[j] = pack_i8x4(v[4 * i + j].x * sc, v[4 * i + j].y * sc, v[4 * i + j].z * sc, v[4 * i + j].w * sc);
        *(uint4*)(dst + (size_t)((lane >> 3) + 8 * i) * (NEXP * 128) + (lane & 7) * 16) = make_uint4(w[0], w[1], w[2], w[3]);
      }
    }
  }
  {
    float* sks = (float*)smem;
    float* wqs = (float*)(smem + 33792);
    const int tn = tid >> 4, tk = tid & 15;
    for (int item = bid; item < 2048; item += G) {
      const int layer = item >> 10, hp = (item >> 6) & 15, nt = (item >> 5) & 1, kt = item & 31;
      const float* sk = p.peer_sub_keys + ((size_t)(layer * 2 + (hp & 1)) * 128 + nt * 64) * 128;
      const float* wq = p.peer_w_query + (size_t)layer * 2048 * 2048 + (size_t)(kt * 64) * 2048 + hp * 128;
      __syncthreads();
#pragma unroll
      for (int i = 0; i < 8; ++i) {
        const int idx = tid + 256 * i, row = idx >> 5, c4 = (idx & 31) * 4;
        *(float4*)(sks + row * 132 + c4) = *(const float4*)(sk + (size_t)row * 128 + c4);
        *(float4*)(wqs + row * 132 + c4) = *(const float4*)(wq + (size_t)row * 2048 + c4);
      }
      __syncthreads();
      float acc[4][4];
#pragma unroll
      for (int i = 0; i < 4; ++i)
#pragma unroll
        for (int j = 0; j < 4; ++j) acc[i][j] = 0.f;
#pragma unroll 4
      for (int d = 0; d < 128; d += 4) {
        float4 a[4], b[4];
#pragma unroll
        for (int i = 0; i < 4; ++i) { a[i] = *(const float4*)(sks + (tn + 16 * i) * 132 + d); b[i] = *(const float4*)(wqs + (tk + 16 * i) * 132 + d); }
#pragma unroll
        for (int i = 0; i < 4; ++i)
#pragma unroll
          for (int j = 0; j < 4; ++j) acc[i][j] += a[i].x * b[j].x + a[i].y * b[j].y + a[i].z * b[j].z + a[i].w * b[j].w;
      }
      bf16_t* dst = (bf16_t*)(ws + (layer ? WS_WQ1 : WS_WQ0)) + (size_t)(hp * 128 + nt * 64) * 2048 + kt * 64;
#pragma unroll
      for (int i = 0; i < 4; ++i)
#pragma unroll
        for (int j = 0; j < 4; ++j) dst[(size_t)(tn + 16 * i) * 2048 + tk + 16 * j] = f2bf(acc[i][j]);
    }
    __syncthreads();
  }
  if (bid == G - 1) {
    float* wff = (float*)(ws + WS_WFF);
    for (int e = tid; e < 2048 * 8; e += NTHREADS) wff[e] = p.even_w_in[(size_t)(e >> 3) * 6152 + 3072 + (e & 7)];
    if (tid < 64) {
      const float* l = p.even_diff_lambda;
      float s1 = l[tid] * l[128 + tid] + l[64 + tid] * l[128 + 64 + tid];
      float s2 = l[256 + tid] * l[384 + tid] + l[256 + 64 + tid] * l[384 + 64 + tid];
      s1 = wave_sum(s1); s2 = wave_sum(s2);
      if (tid == 0) ((float*)(ws + WS_MISC))[0] = expf(s1) - expf(s2) + 0.2f;
    }
  }
}

template <bool FF, int Q8 = 0, bool IN16 = false, bool WH = true>
DI void phase_norm(const Params& p, const void* __restrict__ xin_, const float* __restrict__ gain,
                   const float* __restrict__ sh, const float* __restrict__ sc  ) {
  const int lane = TID() & 63;
  const int gw = __builtin_amdgcn_readfirstlane((VBID() * NTHREADS + TID()) >> 6), nw = (VGRID() * NTHREADS) >> 6;
  bf16_t* H = (bf16_t*)(p.ws + WS_H);
  for (int t = gw; t < T_; t += nw) {
    const int b = t >> 11;
    float4 v[8];
    float ss = 0.f;
    if (IN16) {
      const bf16_t* xr = (const bf16_t*)xin_ + (size_t)t * D_;
#pragma unroll
      for (int i = 0; i < 8; ++i) { const uint2 w = *(const uint2*)(xr + lane * 4 + 256 * i); v[i] = make_float4(bf_lo(w.x), bf_hi(w.x), bf_lo(w.y), bf_hi(w.y)); }
    } else {
      const float* xr = (const float*)xin_ + (size_t)t * D_;
#pragma unroll
      for (int i = 0; i < 8; ++i) v[i] = *(const float4*)(xr + lane * 4 + 256 * i);
    }
#pragma unroll
    for (int i = 0; i < 8; ++i) ss += v[i].x * v[i].x + v[i].y * v[i].y + v[i].z * v[i].z + v[i].w * v[i].w;
    ss = wave_sum(ss);
    const float rstd = rsqrtf(ss * (1.f / 2048.f) + 1e-6f);
    float ff[8];
    if (FF) {
#pragma unroll
      for (int j = 0; j < 8; ++j) ff[j] = 0.f;
    }
    float am = 0.f;
#pragma unroll
    for (int i = 0; i < 8; ++i) {
      const int c = lane * 4 + 256 * i;
      const float4 g = *(const float4*)(gain + c);
      const float4 s1 = *(const float4*)(sc + (size_t)b * 12288 + c);
      const float4 s0 = *(const float4*)(sh + (size_t)b * 12288 + c);
      float4 h;
      h.x = v[i].x * rstd * g.x * (1.f + s1.x) + s0.x;
      h.y = v[i].y * rstd * g.y * (1.f + s1.y) + s0.y;
      h.z = v[i].z * rstd * g.z * (1.f + s1.z) + s0.z;
      h.w = v[i].w * rstd * g.w * (1.f + s1.w) + s0.w;
      if (WH) *(uint2*)(H + (size_t)t * D_ + c) = make_uint2(pack_bf2(h.x, h.y), pack_bf2(h.z, h.w));
      if (Q8) { v[i] = h; am = fmaxf(am, fmaxf(fmaxf(fabsf(h.x), fabsf(h.y)), fmaxf(fabsf(h.z), fabsf(h.w)))); }
      if (FF) {
        const float* wff = (const float*)(p.ws + WS_WFF) + c * 8;
        const float hv[4] = {h.x, h.y, h.z, h.w};
#pragma unroll
        for (int e = 0; e < 4; ++e) {
          const float4 w0 = *(const float4*)(wff + e * 8), w1 = *(const float4*)(wff + e * 8 + 4);
          ff[0] += hv[e] * w0.x; ff[1] += hv[e] * w0.y; ff[2] += hv[e] * w0.z; ff[3] += hv[e] * w0.w;
          ff[4] += hv[e] * w1.x; ff[5] += hv[e] * w1.y; ff[6] += hv[e] * w1.z; ff[7] += hv[e] * w1.w;
        }
      }
    }
    if (Q8) {
      am = wave_max(am);
      const float qs = am > 0.f ? 119.f / am : 1.f;
      unsigned char* h8 = (unsigned char*)(p.ws + (Q8 == 1 ? WS_H8 : WS_H8A)) + (size_t)t * D_ + lane * 4;
#pragma unroll
      for (int i = 0; i < 8; ++i) *(unsigned*)(h8 + 256 * i) = pack_i8x4(v[i].x * qs, v[i].y * qs, v[i].z * qs, v[i].w * qs);
      if (lane == 0) ((float*)(p.ws + (Q8 == 1 ? WS_HS : WS_H8A + 32 * MiB)))[t] = am > 0.f ? am / 119.f : 1.f;
    }
    if (FF) {
#pragma unroll
      for (int j = 0; j < 8; ++j) ff[j] = wave_sum(ff[j]);
      if (lane < 8) {
        float z = ff[0];
#pragma unroll
        for (int j = 1; j < 8; ++j) z = (lane == j) ? ff[j] : z;
        z += p.even_b_forget[lane];
        const float lf = fminf(z, 0.f) - log1pf(__expf(-fabsf(z)));
        ((float*)(p.ws + WS_LOGF))[(size_t)t * 8 + lane] = lf;
      }
    }
  }
}

DI void quant_w8(const Params& p) {
  const int lane = TID() & 63;
  const int gw = __builtin_amdgcn_readfirstlane((VBID() * NTHREADS + TID()) >> 6), nw = (VGRID() * NTHREADS) >> 6;
  for (int row = gw; row < 12288; row += nw) {
    const int layer = row >= 6144 ? 1 : 0, rl = row - layer * 6144;
    const size_t sbase = rl < 4096 ? (layer ? WS_WQK1 : WS_WQK0) : (layer ? WS_WV1 : WS_WV0);
    const bf16_t* src = (const bf16_t*)(p.ws + sbase) + (size_t)(rl < 4096 ? rl : rl - 4096) * 2048 + lane * 32;
    u32x4 w[4];
#pragma unroll
    for (int i = 0; i < 4; ++i) w[i] = *(const u32x4*)(src + 8 * i);
    float f[32];
    float am = 0.f;
#pragma unroll
    for (int i = 0; i < 4; ++i)
#pragma unroll
      for (int j = 0; j < 4; ++j) { f[8 * i + 2 * j] = bf_lo(w[i][j]); f[8 * i + 2 * j + 1] = bf_hi(w[i][j]); am = fmaxf(am, fmaxf(fabsf(f[8 * i + 2 * j]), fabsf(f[8 * i + 2 * j + 1]))); }
    am = wave_max(am);
    const float sc = am > 0.f ? 127.f / am : 1.f;
    unsigned q[8];
#pragma unroll
    for (int i = 0; i < 8; ++i) q[i] = pack_i8x4(f[4 * i] * sc, f[4 * i + 1] * sc, f[4 * i + 2] * sc, f[4 * i + 3] * sc);
    unsigned char* dst = (unsigned char*)(p.ws + WS_W8) + (size_t)row * 2048 + lane * 32;
    *(u32x4*)dst = (u32x4){q[0], q[1], q[2], q[3]};
    *(u32x4*)(dst + 16) = (u32x4){q[4], q[5], q[6], q[7]};
    if (lane == 0) ((float*)(p.ws + WS_W8 + 24 * MiB))[row] = am > 0.f ? am / 127.f : 1.f;
  }
}

DI void forget_logits(const Params& p) {
  const int lane = TID() & 63;
  const int gw = __builtin_amdgcn_readfirstlane((VBID() * NTHREADS + TID()) >> 6), nw = (VGRID() * NTHREADS) >> 6;
  const bf16_t* H = (const bf16_t*)(p.ws + WS_H);
  for (int t = gw; t < T_; t += nw) {
    float ff[8];
#pragma unroll
    for (int j = 0; j < 8; ++j) ff[j] = 0.f;
#pragma unroll 2
    for (int i = 0; i < 8; ++i) {
      const int c = lane * 4 + 256 * i;
      const uint2 hw = *(const uint2*)(H + (size_t)t * D_ + c);
      const float hv[4] = {bf_lo(hw.x), bf_hi(hw.x), bf_lo(hw.y), bf_hi(hw.y)};
      const float* wff = (const float*)(p.ws + WS_WFF) + c * 8;
#pragma unroll
      for (int e = 0; e < 4; ++e) {
        const float4 w0 = *(const float4*)(wff + e * 8), w1 = *(const float4*)(wff + e * 8 + 4);
        ff[0] += hv[e] * w0.x; ff[1] += hv[e] * w0.y; ff[2] += hv[e] * w0.z; ff[3] += hv[e] * w0.w;
        ff[4] += hv[e] * w1.x; ff[5] += hv[e] * w1.y; ff[6] += hv[e] * w1.z; ff[7] += hv[e] * w1.w;
      }
    }
#pragma unroll
    for (int j = 0; j < 8; ++j) ff[j] = wave_sum(ff[j]);
    if (lane < 8) {
      float z = ff[0];
#pragma unroll
      for (int j = 1; j < 8; ++j) z = (lane == j) ? ff[j] : z;
      z += p.even_b_forget[lane];
      const float lf = fminf(z, 0.f) - log1pf(__expf(-fabsf(z)));
      ((float*)(p.ws + WS_LOGF))[(size_t)t * 8 + lane] = lf;
    }
  }
}

DI void fox_cumsum(const Params& p) {
  const int lane = TID() & 63;
  const int gw = __builtin_amdgcn_readfirstlane((VBID() * NTHREADS + TID()) >> 6), nw = (VGRID() * NTHREADS) >> 6;
  const float* lf = (const float*)(p.ws + WS_LOGF);
  float* fc = (float*)(p.ws + WS_FCUM);
  for (int it = gw; it < 64; it += nw) {
    const int b = it >> 3, hh = it & 7;
    float v[32];
    float tot = 0.f;
#pragma unroll
    for (int j = 0; j < 32; ++j) { tot += lf[(size_t)(b * S_ + lane * 32 + j) * 8 + hh]; v[j] = tot; }
    float inc = tot;
#pragma unroll
    for (int o = 1; o < 64; o <<= 1) { const float n = __shfl_up(inc, o); if (lane >= o) inc += n; }
    const float base = inc - tot;
#pragma unroll
    for (int j = 0; j < 32; ++j) fc[(size_t)it * S_ + lane * 32 + j] = v[j] + base;
  }
}

namespace pg8 {
#define PG8_LAS __attribute__((address_space(3)))
typedef float f32x4 __attribute__((ext_vector_type(4)));
constexpr int BM = 256, BK = 64, HALF = 128, HTB = HALF * BK * 2  , STAGE_BYTES = 8 * HTB, NXCD = 8, WGM = 8;

__host__ __device__ __forceinline__ int lds_byte(int r, int c) { const int st = (r >> 4) * 2 + (c >> 5), rr = r & 15, cc = c & 31, ob = rr * 64 + cc * 2; return st * 1024 + (ob ^ (((ob >> 9) & 1) << 5)); }
__host__ __device__ __forceinline__ void stage_rc(int b, int& R, int& C) { const int st = b / 1024, sb = b % 1024, swz = sb ^ (((sb >> 9) & 1) << 5); R = (st >> 1) * 16 + swz / 64; C = (st & 1) * 32 + (swz % 64) / 2; }
__host__ __device__ __forceinline__ int perm32(int rho) { const int n = rho >> 4, i = rho & 15; return 8 * (i >> 2) + 4 * n + (i & 3); }

struct Unit { int pm, pn; };
struct Gemm { const bf16_t* A; const bf16_t* Bt; int M, N, K; };

struct StaticOrder {
    int nM, nN, nwg, G, c;
    __host__ __device__ void init(int M, int N, int G_, int c_) { nM = M / BM; nN = N / BM; nwg = nM * nN; G = G_; c = c_; }
    __host__ __device__ bool next(int i, Unit& u) const {
        const long L = (long)i * G + c; if (L >= nwg) return false;
        int wgid = (int)L; { const int q = nwg / NXCD, r = nwg % NXCD, xcd = wgid % NXCD, off = wgid / NXCD; wgid = (xcd < r ? xcd * (q + 1) : r * (q + 1) + (xcd - r) * q) + off; }
        const int nig = WGM * nN, gid = wgid / nig, fm = gid * WGM, gsz = (nM - fm) < WGM ? (nM - fm) : WGM;
        u.pm = fm + ((wgid % nig) % gsz); u.pn = (wgid % nig) / gsz; return true;
    }
    __device__ __forceinline__ void a_ready(const Unit&) const {}
    __device__ __forceinline__ void done(const Unit&) const {}
};

struct EpiF32 {
    static constexpr bool PERM = false, AFTER_DRAIN = false, I8 = false;
    float* C; int ldc; const float* bias;
    __device__ __forceinline__ void operator()(const f32x4 (&acc)[2][2][4][2], const Unit& u, int wr, int wc, int fr, int fq) const {
        const int row0 = u.pm * BM + wr * 64 + fr, col0 = u.pn * BM + wc * 32 + 4 * fq;
        f32x4 bv[2][2];
#pragma unroll
        for (int bj = 0; bj < 2; ++bj)
#pragma unroll
            for (int n = 0; n < 2; ++n) bv[bj][n] = bias ? *(const f32x4*)(bias + col0 + bj * HALF + n * 16) : (f32x4){0.f, 0.f, 0.f, 0.f};
#pragma unroll
        for (int ai = 0; ai < 2; ++ai)
#pragma unroll
            for (int m = 0; m < 4; ++m) { float* rowp = C + (size_t)(row0 + ai * HALF + m * 16) * ldc + col0;
#pragma unroll
                for (int bj = 0; bj < 2; ++bj)
#pragma unroll
                    for (int n = 0; n < 2; ++n) *(f32x4*)(rowp + bj * HALF + n * 16) = acc[ai][bj][m][n] + bv[bj][n]; }
    }
};
struct EpiBf16 {
    static constexpr bool PERM = true, AFTER_DRAIN = false, I8 = false;
    bf16_t* O; int ldc;
    __device__ __forceinline__ void operator()(const f32x4 (&acc)[2][2][4][2], const Unit& u, int wr, int wc, int fr, int fq) const {
        const int row0 = u.pm * BM + wr * 64 + fr, col0 = u.pn * BM + wc * 32 + 8 * fq;
#pragma unroll
        for (int ai = 0; ai < 2; ++ai)
#pragma unroll
            for (int m = 0; m < 4; ++m) { bf16_t* rowp = O + (size_t)(row0 + ai * HALF + m * 16) * ldc + col0;
#pragma unroll
                for (int bj = 0; bj < 2; ++bj) { const f32x4 v0 = acc[ai][bj][m][0], v1 = acc[ai][bj][m][1];
                    u32x4 w; w.x = pack_bf2(v0[0], v0[1]); w.y = pack_bf2(v0[2], v0[3]); w.z = pack_bf2(v1[0], v1[1]); w.w = pack_bf2(v1[2], v1[3]);
                    *(u32x4*)(rowp + bj * HALF) = w; } }
    }
};
struct EpiQkNorm {
    static constexpr bool PERM = true, AFTER_DRAIN = false, I8 = true;
    bf16_t* O; int ldc; const float* gainA; const float* gainB; int gshift; float* red;
    const float* wsc; const float* hsc;
    __device__ __forceinline__ void operator()(const f32x4 (&acc)[2][2][4][2], const Unit& u, int wr, int wc, int fr, int fq) const {
        typedef int i32x4 __attribute__((ext_vector_type(4)));
        f32x4 cs[2][2]; float hs[2][4];
        {
            const int c0_ = u.pn * BM + wc * 32 + 8 * fq, r0_ = u.pm * BM + wr * 64 + fr;
#pragma unroll
            for (int bj = 0; bj < 2; ++bj) { cs[bj][0] = *(const f32x4*)(wsc + c0_ + bj * HALF); cs[bj][1] = *(const f32x4*)(wsc + c0_ + bj * HALF + 4); }
#pragma unroll
            for (int ai = 0; ai < 2; ++ai)
#pragma unroll
                for (int m = 0; m < 4; ++m) hs[ai][m] = hsc[r0_ + ai * HALF + m * 16];
        }
#define QKN_VAL(ai, bj, m, n) (__builtin_convertvector(__builtin_bit_cast(i32x4, acc[ai][bj][m][n]), f32x4) * cs[bj][n] * hs[ai][m])
        float ss[2][4][2];
#pragma unroll
        for (int ai = 0; ai < 2; ++ai)
#pragma unroll
            for (int m = 0; m < 4; ++m)
#pragma unroll
                for (int bj = 0; bj < 2; ++bj) {
                    const f32x4 v0 = QKN_VAL(ai, bj, m, 0), v1 = QKN_VAL(ai, bj, m, 1);
                    float t = v0[0] * v0[0] + v0[1] * v0[1] + v0[2] * v0[2] + v0[3] * v0[3] + v1[0] * v1[0] + v1[1] * v1[1] + v1[2] * v1[2] + v1[3] * v1[3];
                    t += __shfl_xor(t, 16); t += __shfl_xor(t, 32);
                    ss[ai][m][bj] = t;
                }
        float* myred = red + (wr * 4 + wc) * 256;
        if (fq == 0) {
#pragma unroll
            for (int ai = 0; ai < 2; ++ai)
#pragma unroll
                for (int m = 0; m < 4; ++m)
#pragma unroll
                    for (int bj = 0; bj < 2; ++bj) myred[(ai * 64 + m * 16 + fr) * 2 + bj] = ss[ai][m][bj];
        }
        asm volatile("s_waitcnt lgkmcnt(0)" ::: "memory"); __builtin_amdgcn_s_barrier(); asm volatile("" ::: "memory");
        const int row0 = u.pm * BM + wr * 64 + fr, col0 = u.pn * BM + wc * 32 + 8 * fq;
        const float* rbase = red + (wr * 4) * 256;
#pragma unroll
        for (int bj = 0; bj < 2; ++bj) {
            const int grp = (u.pn * 2 + bj) >> gshift;
            const float* gain = ((grp & 2) ? gainB : gainA) + (grp & 1) * 128 + wc * 32 + 8 * fq;
            const float qs = (grp & 1) ? 1.f : 0.08838834764831845f * LOG2E;
            float4 g0 = *(const float4*)gain, g1 = *(const float4*)(gain + 4);
            g0.x *= qs; g0.y *= qs; g0.z *= qs; g0.w *= qs; g1.x *= qs; g1.y *= qs; g1.z *= qs; g1.w *= qs;
#pragma unroll
            for (int ai = 0; ai < 2; ++ai)
#pragma unroll
                for (int m = 0; m < 4; ++m) {
                    const int ri = (ai * 64 + m * 16 + fr) * 2 + bj;
                    const float tot = rbase[ri] + rbase[256 + ri] + rbase[512 + ri] + rbase[768 + ri];
                    const float rstd = rsqrtf(tot * (1.f / 128.f) + 1e-6f);
                    const f32x4 v0 = QKN_VAL(ai, bj, m, 0), v1 = QKN_VAL(ai, bj, m, 1);
                    u32x4 w;
                    w.x = pack_bf2(v0[0] * rstd * g0.x, v0[1] * rstd * g0.y); w.y = pack_bf2(v0[2] * rstd * g0.z, v0[3] * rstd * g0.w);
                    w.z = pack_bf2(v1[0] * rstd * g1.x, v1[1] * rstd * g1.y); w.w = pack_bf2(v1[2] * rstd * g1.z, v1[3] * rstd * g1.w);
                    *(u32x4*)(O + (size_t)(row0 + ai * HALF + m * 16) * ldc + col0 + bj * HALF) = w;
                }
        }
#undef QKN_VAL
    }
};
struct EpiVt8 {
    static constexpr bool PERM = true, AFTER_DRAIN = false, I8 = true;
    bf16_t* O; int ldc; const float* rscale; const float* cscale;
    __device__ __forceinline__ void operator()(const f32x4 (&acc)[2][2][4][2], const Unit& u, int wr, int wc, int fr, int fq) const {
        typedef int i32x4 __attribute__((ext_vector_type(4)));
        const int row0 = u.pm * BM + wr * 64 + fr, col0 = u.pn * BM + wc * 32 + 8 * fq;
        f32x4 c0[2], c1[2];
#pragma unroll
        for (int bj = 0; bj < 2; ++bj) { c0[bj] = *(const f32x4*)(cscale + col0 + bj * HALF); c1[bj] = *(const f32x4*)(cscale + col0 + bj * HALF + 4); }
#pragma unroll
        for (int ai = 0; ai < 2; ++ai)
#pragma unroll
            for (int m = 0; m < 4; ++m) { const int row = row0 + ai * HALF + m * 16; const float rs = rscale[row]; bf16_t* rowp = O + (size_t)row * ldc + col0;
#pragma unroll
                for (int bj = 0; bj < 2; ++bj) {
                    const i32x4 i0 = __builtin_bit_cast(i32x4, acc[ai][bj][m][0]), i1 = __builtin_bit_cast(i32x4, acc[ai][bj][m][1]);
                    const f32x4 v0 = __builtin_convertvector(i0, f32x4) * c0[bj] * rs, v1 = __builtin_convertvector(i1, f32x4) * c1[bj] * rs;
                    u32x4 w; w.x = pack_bf2(v0[0], v0[1]); w.y = pack_bf2(v0[2], v0[3]); w.z = pack_bf2(v1[0], v1[1]); w.w = pack_bf2(v1[2], v1[3]);
                    *(u32x4*)(rowp + bj * HALF) = w; } }
    }
};
template <bool IN16>
struct EpiRes16 {
    static constexpr bool PERM = true, AFTER_DRAIN = false, I8 = false;
    bf16_t* O; int ldc; const void* xin; const float* gate;
    __device__ __forceinline__ void operator()(const f32x4 (&acc)[2][2][4][2], const Unit& u, int wr, int wc, int fr, int fq) const {
        const int row0 = u.pm * BM + wr * 64 + fr, col0 = u.pn * BM + wc * 32 + 8 * fq;
        const float* gp = gate + (size_t)((u.pm * BM) >> 11) * 12288 + col0;
        f32x4 g0[2], g1[2];
#pragma unroll
        for (int bj = 0; bj < 2; ++bj) { g0[bj] = *(const f32x4*)(gp + bj * HALF); g1[bj] = *(const f32x4*)(gp + bj * HALF + 4); }
#pragma unroll
        for (int ai = 0; ai < 2; ++ai)
#pragma unroll
            for (int m = 0; m < 4; ++m) { const size_t ro = (size_t)(row0 + ai * HALF + m * 16) * ldc + col0;
#pragma unroll
                for (int bj = 0; bj < 2; ++bj) {
                    f32x4 x0, x1;
                    if (IN16) { const u32x4 xw = *(const u32x4*)((const bf16_t*)xin + ro + bj * HALF);
                        x0 = (f32x4){bf_lo(xw.x), bf_hi(xw.x), bf_lo(xw.y), bf_hi(xw.y)}; x1 = (f32x4){bf_lo(xw.z), bf_hi(xw.z), bf_lo(xw.w), bf_hi(xw.w)}; }
                    else { x0 = *(const f32x4*)((const float*)xin + ro + bj * HALF); x1 = *(const f32x4*)((const float*)xin + ro + bj * HALF + 4); }
                    const f32x4 v0 = x0 + g0[bj] * acc[ai][bj][m][0], v1 = x1 + g1[bj] * acc[ai][bj][m][1];
                    u32x4 w; w.x = pack_bf2(v0[0], v0[1]); w.y = pack_bf2(v0[2], v0[3]); w.z = pack_bf2(v1[0], v1[1]); w.w = pack_bf2(v1[2], v1[3]);
                    *(u32x4*)(O + ro + bj * HALF) = w; } }
    }
};
struct EpiRes {
    static constexpr bool PERM = false, AFTER_DRAIN = false, I8 = false;
    float* C; int ldc; const float* xin; const float* gate;
    __device__ __forceinline__ void operator()(const f32x4 (&acc)[2][2][4][2], const Unit& u, int wr, int wc, int fr, int fq) const {
        const int row0 = u.pm * BM + wr * 64 + fr, col0 = u.pn * BM + wc * 32 + 4 * fq;
        const float* gp = gate + (size_t)((u.pm * BM) >> 11) * 12288 + col0;
        f32x4 gv[2][2];
#pragma unroll
        for (int bj = 0; bj < 2; ++bj)
#pragma unroll
            for (int n = 0; n < 2; ++n) gv[bj][n] = *(const f32x4*)(gp + bj * HALF + n * 16);
#pragma unroll
        for (int ai = 0; ai < 2; ++ai)
#pragma unroll
            for (int m = 0; m < 4; ++m) { const size_t ro = (size_t)(row0 + ai * HALF + m * 16) * ldc + col0;
#pragma unroll
                for (int bj = 0; bj < 2; ++bj)
#pragma unroll
                    for (int n = 0; n < 2; ++n) { const f32x4 xv = *(const f32x4*)(xin + ro + bj * HALF + n * 16);
                        *(f32x4*)(C + ro + bj * HALF + n * 16) = xv + gv[bj][n] * acc[ai][bj][m][n]; } }
    }
};

template <bool I8>
__device__ __forceinline__ f32x4 pg8_mma(bf16x8 b, bf16x8 a, f32x4 c) {
    if constexpr (I8) {
        typedef int i32x4 __attribute__((ext_vector_type(4)));
        return __builtin_bit_cast(f32x4, __builtin_amdgcn_mfma_i32_16x16x64_i8(__builtin_bit_cast(i32x4, b), __builtin_bit_cast(i32x4, a), __builtin_bit_cast(i32x4, c), 0, 0, 0));
    } else {
        return __builtin_amdgcn_mfma_f32_16x16x32_bf16(b, a, c, 0, 0, 0);
    }
}
template <class Epi, class Sched, bool STAMP = false>
__device__ __forceinline__ void gemm_phase(PG8_LAS unsigned char* lds, const Gemm g, const Sched& S, const Epi& E, unsigned long long* stamps) {
    const int tid = RTID(), wid = __builtin_amdgcn_readfirstlane(tid >> 6), lane = tid & 63, wr = wid >> 2, wc = wid & 3, fr = lane & 15, fq = lane >> 4;
    const int K = g.K, nt = K / BK;
    int ts_lo = 0, ts_hi = 0, nts = 0; const unsigned long long rt_entry = STAMP ? (unsigned long long)wall_clock64() : 0ull;
#define PG8_STAMP() do { if (STAMP && wid == 0 && nts < 64) { const unsigned long long _c = (unsigned long long)clock64(); \
        ts_lo = (lane == nts) ? (int)(unsigned)_c : ts_lo; ts_hi = (lane == nts) ? (int)(unsigned)(_c >> 32) : ts_hi; ++nts; } } while (0)
    PG8_STAMP();
    unsigned voffA[2], voffB[2];
#pragma unroll
    for (int i = 0; i < 2; ++i) { int R, C; stage_rc(tid * 16 + i * 8192, R, C); const int Rb = Epi::PERM ? ((R & ~31) + perm32(R & 31)) : R;
        voffA[i] = (unsigned)(R * K + C) * 2u; voffB[i] = (unsigned)(Rb * K + C) * 2u; }
    const size_t kstep = (size_t)(BK * 2);
    const size_t hstep = (size_t)HALF * K * 2;
    const size_t tstep = 2 * hstep;
    const unsigned ldsw = (unsigned)wid * 1024u;
    const int aoff = lds_byte(wr * 64 + fr, fq * 8), boff = lds_byte(wc * 32 + fr, fq * 8);
#define PG8_SA(b, h) (((b) * 2 + (h)) * HTB)
#define PG8_SB(b, h) ((4 + (b) * 2 + (h)) * HTB)
#define PG8_STAGE(bufoff, gbase, voff) do { _Pragma("unroll") for (int _i = 0; _i < 2; ++_i) \
        __builtin_amdgcn_global_load_lds((const unsigned*)((const char*)(gbase) + (voff)[_i]), (PG8_LAS unsigned*)(lds + (bufoff) + ldsw + _i * 8192), 16, 0, 0); } while (0)
#define PG8_LDA(dst, b, h) do { _Pragma("unroll") for (int m = 0; m < 4; ++m) _Pragma("unroll") for (int k = 0; k < 2; ++k) dst[m][k] = *(const PG8_LAS bf16x8*)(lds + PG8_SA(b, h) + aoff + m * 2048 + k * 1024); } while (0)
#define PG8_LDB(dst, b, h) do { _Pragma("unroll") for (int n = 0; n < 2; ++n) _Pragma("unroll") for (int k = 0; k < 2; ++k) dst[n][k] = *(const PG8_LAS bf16x8*)(lds + PG8_SB(b, h) + boff + n * 2048 + k * 1024); } while (0)
#define PG8_MMA(ai, bj, At, Bt) do { __builtin_amdgcn_s_setprio(1); _Pragma("unroll") for (int m = 0; m < 4; ++m) _Pragma("unroll") for (int n = 0; n < 2; ++n) _Pragma("unroll") for (int k = 0; k < 2; ++k) \
        acc[ai][bj][m][n] = pg8_mma<Epi::I8>(Bt[n][k], At[m][k], acc[ai][bj][m][n]); __builtin_amdgcn_s_setprio(0); } while (0)
#define PG8_WAIT_V(n) asm volatile("s_waitcnt vmcnt(" #n ")" ::: "memory")
#define PG8_WAIT_L(n) asm volatile("s_waitcnt lgkmcnt(" #n ")" ::: "memory")
#define PG8_BAR __builtin_amdgcn_s_barrier()
#define PG8_SCHED __builtin_amdgcn_sched_barrier(0)
    Unit cur, nxt; int ui = 0;
    if (!S.next(0, cur)) return;
    f32x4 acc[2][2][4][2];
#pragma unroll
    for (int a = 0; a < 2; ++a)
#pragma unroll
        for (int b = 0; b < 2; ++b)
#pragma unroll
            for (int m = 0; m < 4; ++m)
#pragma unroll
                for (int n = 0; n < 2; ++n) acc[a][b][m][n] = (f32x4){0.f, 0.f, 0.f, 0.f};
    bf16x8 At[4][2], B0[2][2], B1[2][2];
    const char* cA = (const char*)g.A + (size_t)cur.pm * tstep; const char* cB = (const char*)g.Bt + (size_t)cur.pn * tstep;
    S.a_ready(cur);
    PG8_STAGE(PG8_SB(0, 0), cB, voffB); PG8_STAGE(PG8_SA(0, 0), cA, voffA); PG8_STAGE(PG8_SB(0, 1), cB + hstep, voffB); PG8_STAGE(PG8_SA(0, 1), cA + hstep, voffA);
    if (wr == 1) PG8_BAR;
    PG8_WAIT_V(4); PG8_BAR;
    PG8_STAGE(PG8_SB(1, 0), cB + kstep, voffB); PG8_STAGE(PG8_SA(1, 0), cA + kstep, voffA); PG8_STAGE(PG8_SB(1, 1), cB + hstep + kstep, voffB);
    PG8_WAIT_V(6); PG8_BAR;
    PG8_STAMP();
    for (;;) {
        const bool has_next = S.next(ui + 1, nxt);
        const char* nA = has_next ? (const char*)g.A + (size_t)nxt.pm * tstep : cA; const char* nB = has_next ? (const char*)g.Bt + (size_t)nxt.pn * tstep : cB;
        for (int t = 0; t < nt; t += 2) {
            const bool last = (t == nt - 2);
            const char* a1 = cA + (size_t)(t + 1) * kstep;
            const char* a2 = last ? nA : cA + (size_t)(t + 2) * kstep; const char* b2 = last ? nB : cB + (size_t)(t + 2) * kstep;
            const char* a3 = a2 + kstep; const char* b3 = b2 + kstep;
            if (last && has_next) S.a_ready(nxt);
            PG8_LDB(B0, 0, 0); PG8_SCHED; PG8_LDA(At, 0, 0); PG8_STAGE(PG8_SA(1, 1), a1 + hstep, voffA);
            PG8_WAIT_L(8); PG8_BAR; PG8_WAIT_L(0); PG8_MMA(0, 0, At, B0); PG8_BAR; PG8_SCHED;
            PG8_LDB(B1, 0, 1); PG8_STAGE(PG8_SB(0, 0), b2, voffB);
            PG8_BAR; PG8_WAIT_L(0); PG8_MMA(0, 1, At, B1); PG8_BAR;
            PG8_LDA(At, 0, 1); PG8_STAGE(PG8_SA(0, 0), a2, voffA);
            PG8_BAR; PG8_WAIT_L(0); PG8_MMA(1, 0, At, B0); PG8_BAR; PG8_SCHED;
            PG8_STAGE(PG8_SB(0, 1), b2 + hstep, voffB);
            PG8_WAIT_V(6); PG8_BAR; PG8_MMA(1, 1, At, B1); PG8_BAR;
            PG8_LDB(B0, 1, 0); PG8_SCHED; PG8_LDA(At, 1, 0); PG8_STAGE(PG8_SA(0, 1), a2 + hstep, voffA);
            PG8_WAIT_L(8); PG8_BAR; PG8_WAIT_L(0); PG8_MMA(0, 0, At, B0); PG8_BAR; PG8_SCHED;
            PG8_LDB(B1, 1, 1); PG8_STAGE(PG8_SB(1, 0), b3, voffB);
            PG8_BAR; PG8_WAIT_L(0); PG8_MMA(0, 1, At, B1); PG8_BAR;
            PG8_LDA(At, 1, 1); PG8_STAGE(PG8_SA(1, 0), a3, voffA);
            PG8_BAR; PG8_WAIT_L(0); PG8_MMA(1, 0, At, B0); PG8_BAR; PG8_SCHED;
            PG8_STAGE(PG8_SB(1, 1), b3 + hstep, voffB);
            PG8_WAIT_V(6); PG8_BAR; PG8_MMA(1, 1, At, B1); PG8_BAR;
        }
        PG8_STAMP();
        if constexpr (!Epi::AFTER_DRAIN) { E(acc, cur, wr, wc, fr, fq); S.done(cur); }
        PG8_STAMP();
        if (!has_next) break;
#pragma unroll
        for (int a = 0; a < 2; ++a)
#pragma unroll
            for (int b = 0; b < 2; ++b)
#pragma unroll
                for (int m = 0; m < 4; ++m)
#pragma unroll
                    for (int n = 0; n < 2; ++n) acc[a][b][m][n] = (f32x4){0.f, 0.f, 0.f, 0.f};
        cur = nxt; cA = nA; cB = nB; ++ui;
    }
    PG8_WAIT_V(0);
    if (wr == 0) PG8_BAR;
    PG8_BAR;
    if constexpr (Epi::AFTER_DRAIN) { E.fused(acc, cur, wr, wc, fr, fq, lds, wid, lane); S.done(cur); }
    PG8_STAMP();
    if (STAMP && wid == 0) { stamps[lane] = lane < nts ? (((unsigned long long)(unsigned)ts_hi << 32) | (unsigned)ts_lo) : 0ull;
        if (lane == 62) stamps[62] = rt_entry; if (lane == 63) stamps[63] = (unsigned long long)wall_clock64(); }
#undef PG8_STAMP
#undef PG8_SA
#undef PG8_SB
#undef PG8_STAGE
#undef PG8_LDA
#undef PG8_LDB
#undef PG8_MMA
#undef PG8_WAIT_V
#undef PG8_WAIT_L
#undef PG8_BAR
#undef PG8_SCHED
}
}

struct AttnPtrs { const bf16_t* Q; int ldq; const bf16_t* K; int ldk; const bf16_t* Vt; int ldv; const float* kbias; };

DI float xhalf_max(float v) {
  const auto r2 = __builtin_amdgcn_permlane32_swap(__float_as_uint(v), __float_as_uint(v), false, false);
  return fmaxf(__uint_as_float(r2[0]), __uint_as_float(r2[1]));
}
DI float xhalf_sum(float v) {
  const auto r2 = __builtin_amdgcn_permlane32_swap(__float_as_uint(v), __float_as_uint(v), false, false);
  return __uint_as_float(r2[0]) + __uint_as_float(r2[1]);
}

template <int MODE, int DVB>
DI void attn_block(const AttnPtrs& a, int q0b, char* smem, const float* tbl, f32x16 (&o)[DVB], float& l_out) {
  constexpr int STG = 16384 + DVB * 4096;
  const int tid = RTID(), lane = tid & 63, wave = __builtin_amdgcn_readfirstlane(tid >> 6);
  const int r = lane & 31, h = lane >> 5;
  const int q0 = q0b + 32 * wave;
  const int krow = tid >> 4, kch = tid & 15;
  const int vrow = tid >> 3, vch = tid & 7;
  const char* Kb = (const char*)a.K;
  const char* Vb = (const char*)a.Vt;
  const unsigned kvo = (unsigned)(krow * a.ldk + kch * 8) * 2u;
  const unsigned vvo = (unsigned)(vrow * a.ldv + vch * 8) * 2u;
  const unsigned kst = (unsigned)(32 * a.ldk) * 2u, vst = (unsigned)(64 * a.ldv) * 2u;
  const int kwo = krow * 256 + ((kch ^ (krow & 15)) << 4);
  const int vwo = 16384 + vrow * 128 + ((vch ^ ((vrow >> 1) & 7)) << 4);
  const int pr = (r & ~12) | ((r & 4) << 1) | ((r & 8) >> 1);
  const int kro = pr * 256, ksw = pr & 15;
  const int vro = 16384 + r * 128, vsw = (r >> 1) & 7;
  bf16x8 qf[8];
#pragma unroll
  for (int s = 0; s < 8; ++s) qf[s] = *(const bf16x8*)(a.Q + (size_t)(q0 + r) * a.ldq + 16 * s + 8 * h);
#pragma unroll
  for (int dt = 0; dt < DVB; ++dt)
#pragma unroll
    for (int e = 0; e < 16; ++e) o[dt][e] = 0.f;
  float m = -1e30f, l = 0.f;
  const int nkt = (q0b + 256) >> 6;
  u32x4 rk[2], rv[DVB / 2];
#pragma unroll
  for (int i = 0; i < 2; ++i) rk[i] = *(const u32x4*)(Kb + (size_t)(i * kst) + kvo);
#pragma unroll
  for (int i = 0; i < DVB / 2; ++i) rv[i] = *(const u32x4*)(Vb + (size_t)(i * vst) + vvo);
#pragma unroll
  for (int i = 0; i < 2; ++i) *(u32x4*)(smem + kwo + i * 8192) = rk[i];
#pragma unroll
  for (int i = 0; i < DVB / 2; ++i) *(u32x4*)(smem + vwo + i * 8192) = rv[i];
  u32x4 rkB[2], rvB[DVB / 2];
  if constexpr (DVB == 4) {
    const int k1 = nkt > 1 ? 64 : 0;
#pragma unroll
    for (int i = 0; i < 2; ++i) rk[i] = *(const u32x4*)(Kb + ((size_t)k1 * (size_t)a.ldk * 2u + i * kst) + kvo);
#pragma unroll
    for (int i = 0; i < DVB / 2; ++i) rv[i] = *(const u32x4*)(Vb + ((size_t)k1 * 2u + i * vst) + vvo);
  }
  __syncthreads();
#define ATT_TILE(KT, RL, RVL, RW, RVW) { const int kt = (KT); \
    const int k0 = kt << 6; \
    char* st = smem + (kt & 1) * STG; \
    { \
      const int kn = (kt + 2 < nkt ? kt + 2 : nkt - 1) << 6;        \
      const size_t kbo = (size_t)kn * (size_t)a.ldk * 2u, vbo = (size_t)kn * 2u; \
_Pragma("unroll") \
      for (int i = 0; i < 2; ++i) RL[i] = *(const u32x4*)(Kb + (kbo + i * kst) + kvo); \
_Pragma("unroll") \
      for (int i = 0; i < DVB / 2; ++i) RVL[i] = *(const u32x4*)(Vb + (vbo + i * vst) + vvo); \
    } \
    asm volatile("" ::: "memory"); \
    __builtin_amdgcn_sched_barrier(0); \
_Pragma("unroll") \
    for (int sub = 0; sub < 2; ++sub) { \
      const int ks0 = k0 + 32 * sub; \
      if (ks0 <= q0) { \
        f32x16 sa; \
_Pragma("unroll") \
        for (int e = 0; e < 16; ++e) sa[e] = 0.f; \
_Pragma("unroll") \
        for (int s = 0; s < 8; ++s) { \
          const bf16x8 kf = *(const bf16x8*)(st + kro + sub * 8192 + (((2 * s + h) ^ ksw) << 4)); \
          sa = MFMA32(kf, qf[s], sa); \
        } \
        float v[16]; \
        if (MODE == 0) { \
_Pragma("unroll") \
          for (int c = 0; c < 2; ++c) { \
            const float4 kb0 = *(const float4*)(a.kbias + ks0 + 16 * c + 8 * h); \
            const float4 kb1 = *(const float4*)(a.kbias + ks0 + 16 * c + 8 * h + 4); \
            v[8 * c + 0] = sa[8 * c + 0] - kb0.x * LOG2E; v[8 * c + 1] = sa[8 * c + 1] - kb0.y * LOG2E; \
            v[8 * c + 2] = sa[8 * c + 2] - kb0.z * LOG2E; v[8 * c + 3] = sa[8 * c + 3] - kb0.w * LOG2E; \
            v[8 * c + 4] = sa[8 * c + 4] - kb1.x * LOG2E; v[8 * c + 5] = sa[8 * c + 5] - kb1.y * LOG2E; \
            v[8 * c + 6] = sa[8 * c + 6] - kb1.z * LOG2E; v[8 * c + 7] = sa[8 * c + 7] - kb1.w * LOG2E; \
          } \
          if (ks0 == q0) { \
_Pragma("unroll") \
            for (int e = 0; e < 16; ++e) if ((e & 7) + 8 * h + 16 * (e >> 3) > r) v[e] = -INFINITY; \
          } \
        } else { \
          const float* tp = tbl + (q0 - ks0) + r + 32 - 8 * h - 23; \
_Pragma("unroll") \
          for (int e = 0; e < 16; ++e) v[e] = sa[e] + tp[23 - ((e & 7) + 16 * (e >> 3))]; \
        } \
        float mx = v[0]; \
_Pragma("unroll") \
        for (int e = 1; e < 16; ++e) mx = fmaxf(mx, v[e]); \
        mx = xhalf_max(mx); \
        if (__ballot(mx > m + 8.f) != 0ull) { \
          const float mn = fmaxf(m, mx); \
          const float alpha = __builtin_amdgcn_exp2f(m - mn); \
          m = mn; \
          l *= alpha; \
_Pragma("unroll") \
          for (int dt = 0; dt < DVB; ++dt) \
_Pragma("unroll") \
            for (int e = 0; e < 16; ++e) o[dt][e] *= alpha; \
        } \
        float ps = 0.f; \
_Pragma("unroll") \
        for (int e = 0; e < 16; ++e) { v[e] = __builtin_amdgcn_exp2f(v[e] - m); ps += v[e]; } \
        l += ps; \
        bf16x8 pb[2]; \
_Pragma("unroll") \
        for (int s = 0; s < 2; ++s) { \
          const u32x4 u = {pack_bf2(v[8 * s + 0], v[8 * s + 1]), pack_bf2(v[8 * s + 2], v[8 * s + 3]), \
                           pack_bf2(v[8 * s + 4], v[8 * s + 5]), pack_bf2(v[8 * s + 6], v[8 * s + 7])}; \
          pb[s] = __builtin_bit_cast(bf16x8, u); \
        } \
_Pragma("unroll") \
        for (int dt = 0; dt < DVB; ++dt) \
_Pragma("unroll") \
          for (int s = 0; s < 2; ++s) { \
            const bf16x8 va = *(const bf16x8*)(st + vro + dt * 4096 + (((4 * sub + 2 * s + h) ^ vsw) << 4)); \
            o[dt] = MFMA32(va, pb[s], o[dt]); \
          } \
      } \
    } \
    __builtin_amdgcn_sched_barrier(0); \
    asm volatile("" ::: "memory"); \
    { \
      char* sn = smem + ((kt + 1) & 1) * STG; \
_Pragma("unroll") \
      for (int i = 0; i < 2; ++i) *(u32x4*)(sn + kwo + i * 8192) = RW[i]; \
_Pragma("unroll") \
      for (int i = 0; i < DVB / 2; ++i) *(u32x4*)(sn + vwo + i * 8192) = RVW[i]; \
    } \
    __syncthreads(); \
  }
  if constexpr (DVB == 4) {
  for (int kt2 = 0; kt2 < nkt; kt2 += 2) {
    ATT_TILE(kt2, rkB, rvB, rk, rv)
    if (kt2 + 1 < nkt) ATT_TILE(kt2 + 1, rk, rv, rkB, rvB)
  }
  } else {
  for (int kt = 0; kt < nkt; ++kt) {
    const int k0 = kt << 6;
    char* st = smem + (kt & 1) * STG;
    {
      const int kn = (kt + 1 < nkt) ? k0 + 64 : k0;
      const size_t kbo = (size_t)kn * (size_t)a.ldk * 2u, vbo = (size_t)kn * 2u;
#pragma unroll
      for (int i = 0; i < 2; ++i) rk[i] = *(const u32x4*)(Kb + (kbo + i * kst) + kvo);
#pragma unroll
      for (int i = 0; i < DVB / 2; ++i) rv[i] = *(const u32x4*)(Vb + (vbo + i * vst) + vvo);
    }
    asm volatile("" ::: "memory");
    __builtin_amdgcn_sched_barrier(0);
#pragma unroll
    for (int sub = 0; sub < 2; ++sub) {
      const int ks0 = k0 + 32 * sub;
      if (ks0 <= q0) {
        f32x16 sa;
#pragma unroll
        for (int e = 0; e < 16; ++e) sa[e] = 0.f;
#pragma unroll
        for (int s = 0; s < 8; ++s) {
          const bf16x8 kf = *(const bf16x8*)(st + kro + sub * 8192 + (((2 * s + h) ^ ksw) << 4));
          sa = MFMA32(kf, qf[s], sa);
        }
        float v[16];
        if (MODE == 0) {
#pragma unroll
          for (int c = 0; c < 2; ++c) {
            const float4 kb0 = *(const float4*)(a.kbias + ks0 + 16 * c + 8 * h);
            const float4 kb1 = *(const float4*)(a.kbias + ks0 + 16 * c + 8 * h + 4);
            v[8 * c + 0] = sa[8 * c + 0] - kb0.x * LOG2E; v[8 * c + 1] = sa[8 * c + 1] - kb0.y * LOG2E;
            v[8 * c + 2] = sa[8 * c + 2] - kb0.z * LOG2E; v[8 * c + 3] = sa[8 * c + 3] - kb0.w * LOG2E;
            v[8 * c + 4] = sa[8 * c + 4] - kb1.x * LOG2E; v[8 * c + 5] = sa[8 * c + 5] - kb1.y * LOG2E;
            v[8 * c + 6] = sa[8 * c + 6] - kb1.z * LOG2E; v[8 * c + 7] = sa[8 * c + 7] - kb1.w * LOG2E;
          }
          if (ks0 == q0) {
#pragma unroll
            for (int e = 0; e < 16; ++e) if ((e & 7) + 8 * h + 16 * (e >> 3) > r) v[e] = -INFINITY;
          }
        } else {
          const float* tp = tbl + (q0 - ks0) + r + 32 - 8 * h - 23;
#pragma unroll
          for (int e = 0; e < 16; ++e) v[e] = sa[e] + tp[23 - ((e & 7) + 16 * (e >> 3))];
        }
        float mx = v[0];
#pragma unroll
        for (int e = 1; e < 16; ++e) mx = fmaxf(mx, v[e]);
        mx = xhalf_max(mx);
        if (__ballot(mx > m + 8.f) != 0ull) {
          const float mn = fmaxf(m, mx);
          const float alpha = __builtin_amdgcn_exp2f(m - mn);
          m = mn;
          l *= alpha;
#pragma unroll
          for (int dt = 0; dt < DVB; ++dt)
#pragma unroll
            for (int e = 0; e < 16; ++e) o[dt][e] *= alpha;
        }
        float ps = 0.f;
#pragma unroll
        for (int e = 0; e < 16; ++e) { v[e] = __builtin_amdgcn_exp2f(v[e] - m); ps += v[e]; }
        l += ps;
        bf16x8 pb[2];
#pragma unroll
        for (int s = 0; s < 2; ++s) {
          const u32x4 u = {pack_bf2(v[8 * s + 0], v[8 * s + 1]), pack_bf2(v[8 * s + 2], v[8 * s + 3]),
                           pack_bf2(v[8 * s + 4], v[8 * s + 5]), pack_bf2(v[8 * s + 6], v[8 * s + 7])};
          pb[s] = __builtin_bit_cast(bf16x8, u);
        }
#pragma unroll
        for (int dt = 0; dt < DVB; ++dt)
#pragma unroll
          for (int s = 0; s < 2; ++s) {
            const bf16x8 va = *(const bf16x8*)(st + vro + dt * 4096 + (((4 * sub + 2 * s + h) ^ vsw) << 4));
            o[dt] = MFMA32(va, pb[s], o[dt]);
          }
      }
    }
    __builtin_amdgcn_sched_barrier(0);
    asm volatile("" ::: "memory");
    {
      char* sn = smem + ((kt + 1) & 1) * STG;
#pragma unroll
      for (int i = 0; i < 2; ++i) *(u32x4*)(sn + kwo + i * 8192) = rk[i];
#pragma unroll
      for (int i = 0; i < DVB / 2; ++i) *(u32x4*)(sn + vwo + i * 8192) = rv[i];
    }
    __syncthreads();
  }
  }
#undef ATT_TILE
  l_out = xhalf_sum(l);
}

template <int N = 4, int B0 = 0>
DI void attn_store_bf16(const f32x16 (&o)[N], float linv, bf16_t* out_row  , int ldo) {
  const int lane = TID() & 63, r = lane & 31, h = lane >> 5;
  bf16_t* op = out_row + (size_t)r * ldo + 4 * h;
#pragma unroll
  for (int dt = 0; dt < 4; ++dt)
#pragma unroll
    for (int c = 0; c < 4; ++c)
      *(uint2*)(op + 32 * dt + 8 * c) = make_uint2(pack_bf2(o[B0 + dt][4 * c] * linv, o[B0 + dt][4 * c + 1] * linv),
                                                    pack_bf2(o[B0 + dt][4 * c + 2] * linv, o[B0 + dt][4 * c + 3] * linv));
}
template <int N, int B0>
DI void attn_store_f32(const f32x16 (&o)[N], float linv, float* out_row, int ldo) {
  const int lane = TID() & 63, r = lane & 31, h = lane >> 5;
  float* op = out_row + (size_t)r * ldo + 4 * h;
#pragma unroll
  for (int dt = 0; dt < 4; ++dt)
#pragma unroll
    for (int c = 0; c < 4; ++c)
      *(float4*)(op + 32 * dt + 8 * c) = make_float4(o[B0 + dt][4 * c] * linv, o[B0 + dt][4 * c + 1] * linv, o[B0 + dt][4 * c + 2] * linv, o[B0 + dt][4 * c + 3] * linv);
}

DI int t5_bucket(int n) {
  if (n < 16) return n;
  int lg = 16 + (int)(logf((float)n / 16.f) / 4.852030263919617f * 16.f);
  return lg < 31 ? lg : 31;
}

DI void phase_attn_even(const Params& p, char* smem) {
  const int tid = RTID(), wave = __builtin_amdgcn_readfirstlane(tid >> 6), bid = blockIdx.x, G = gridDim.x;
  const bf16_t* QK = (const bf16_t*)(p.ws + WS_QK);
  const bf16_t* VT = (const bf16_t*)(p.ws + WS_VT);
  bf16_t* ATT = (bf16_t*)(p.ws + WS_ATT);
  bf16_t* PCS = (bf16_t*)(p.ws + WS_SC);
  float* tbl = (float*)(smem + 98304);
  int cur_head = -1;
  for (int rnd = 0; rnd * G < 1024; ++rnd) {
    int item = rnd * G + ((rnd & 1) ? G - 1 - bid : bid);
    if (G == 256) {
      const int rc = rnd * 4 + (bid >> 6);
      const int gq = (int)((0x6767455432231010ull >> (4 * rc)) & 15ull), dq = (0x3CC3 >> rc) & 1;
      item = gq * 128 + (dq ? 0 : 64) + (bid & 63);
    }
    if (item >= 1024) break;
    const int g = item >> 7; int rem = item & 127;
    const int qb = 7 - g;
    const int q0b = qb * 256, q0 = q0b + 32 * wave;
    __syncthreads();
    if (rem >= 64) {
      rem -= 64;
      const int b = rem >> 3, hh = rem & 7;
      AttnPtrs a;
      a.Q = QK + (size_t)b * S_ * 4096 + hh * 128; a.ldq = 4096;
      a.K = a.Q + 1024; a.ldk = 4096;
      a.Vt = VT + (size_t)(hh * 128) * T_ + b * S_; a.ldv = T_;
      a.kbias = (const float*)(p.ws + WS_FCUM) + (size_t)(b * 8 + hh) * S_;
      f32x16 o[4]; float l;
      attn_block<0, 4>(a, q0b, smem, nullptr, o, l);
      attn_store_bf16(o, 1.f / l, ATT + (size_t)(b * S_ + q0) * D_ + hh * 128, D_);
    } else {
      const int b = rem >> 3, hh = (rem >> 1) & 3, mm = rem & 1;
      if (hh != cur_head) {
        for (int e = tid; e < 2080; e += RTHREADS) {
          const int dist = e - 32;
          tbl[e] = dist >= 0 ? p.rel_bias[t5_bucket(dist) * 16 + hh] * LOG2E : -INFINITY;
        }
        cur_head = hh;
      }
      AttnPtrs a;
      a.Q = QK + (size_t)b * S_ * 4096 + 2048 + hh * 256 + mm * 128; a.ldq = 4096;
      a.K = a.Q + 1024; a.ldk = 4096;
      a.Vt = VT + (size_t)(1024 + hh * 256) * T_ + b * S_; a.ldv = T_;
      a.kbias = nullptr;
      f32x16 o[8]; float l;
      attn_block<1, 8>(a, q0b, smem, tbl, o, l);
      const float linv = 1.f / l;
      attn_store_bf16<8, 0>(o, linv, PCS + (((size_t)(mm * 2 + 0) * T_ + (size_t)(b * S_ + q0)) * 4 + hh) * 128, 512);
      attn_store_bf16<8, 4>(o, linv, PCS + (((size_t)(mm * 2 + 1) * T_ + (size_t)(b * S_ + q0)) * 4 + hh) * 128, 512);
    }
  }
}

DI void phase_diff_combine(const Params& p) {
  const int lane = TID() & 63;
  const int gw = __builtin_amdgcn_readfirstlane((VBID() * NTHREADS + TID()) >> 6), nw = (VGRID() * NTHREADS) >> 6;
  const bf16_t* PCS = (const bf16_t*)(p.ws + WS_SC);
  bf16_t* ATT = (bf16_t*)(p.ws + WS_ATT);
  const float lam = ((const float*)(p.ws + WS_MISC))[0];
  const int half = lane >> 5, dl = (lane & 31) * 4;
  const float4 sg = *(const float4*)(p.even_diff_subln_gain + lane * 4);
  for (int it = gw; it < T_ * 4; it += nw) {
    const uint2 a0 = *(const uint2*)(PCS + ((size_t)(0 + half) * T_ * 4 + it) * 128 + dl);
    const uint2 a1 = *(const uint2*)(PCS + ((size_t)(2 + half) * T_ * 4 + it) * 128 + dl);
    float4 v;
    v.x = bf_lo(a0.x) - lam * bf_lo(a1.x); v.y = bf_hi(a0.x) - lam * bf_hi(a1.x); v.z = bf_lo(a0.y) - lam * bf_lo(a1.y); v.w = bf_hi(a0.y) - lam * bf_hi(a1.y);
    const float ss = wave_sum(v.x * v.x + v.y * v.y + v.z * v.z + v.w * v.w);
    const float rstd = rsqrtf(ss * (1.f / 256.f) + 1e-6f) * 0.8f;
    const int t = it >> 2, hh = it & 3;
    *(uint2*)(ATT + (size_t)t * D_ + 1024 + hh * 256 + lane * 4) =
        make_uint2(pack_bf2(v.x * rstd * sg.x, v.y * rstd * sg.y), pack_bf2(v.z * rstd * sg.z, v.w * rstd * sg.w));
  }
}

DI void phase_attn_odd(const Params& p, char* smem) {
  const int tid = RTID(), wave = __builtin_amdgcn_readfirstlane(tid >> 6), bid = blockIdx.x, G = gridDim.x;
  const bf16_t* QK = (const bf16_t*)(p.ws + WS_QK);
  const bf16_t* VT = (const bf16_t*)(p.ws + WS_VT);
  bf16_t* ATT = (bf16_t*)(p.ws + WS_ATT);
  float* tbl = (float*)(smem + 98304);
  int cur_head = -1;
  for (int rnd = 0; rnd * G < 1024; ++rnd) {
    const int item = rnd * G + ((rnd & 1) ? G - 1 - bid : bid);
    if (item >= 1024) break;
    const int g = item >> 7, rem = item & 127;
    const int qb = 7 - g, b = rem >> 4, hd = rem & 15;
    __syncthreads();
    if (hd != cur_head) {
      for (int e = tid; e < 2080; e += RTHREADS) {
        const int dist = e - 32;
        float val = -INFINITY;
        if (dist >= 0) {
          int cnt = 0;
          if (dist <= 128) cnt += 1;
          if (dist <= 512 && (dist & 3) == 0) cnt += 1;
          if ((dist & 15) == 0) cnt += 1;
          if (cnt > 0) val = (p.rel_bias[t5_bucket(dist) * 16 + hd] + __logf((float)cnt)) * LOG2E;
        }
        tbl[e] = val;
      }
      cur_head = hd;
    }
    const int q0b = qb * 256, q0 = q0b + 32 * wave;
    AttnPtrs a;
    a.Q = QK + (size_t)b * S_ * 4096 + hd * 128; a.ldq = 4096;
    a.K = a.Q + 2048; a.ldk = 4096;
    a.Vt = VT + (size_t)(hd * 128) * T_ + b * S_; a.ldv = T_;
    a.kbias = nullptr;
    f32x16 o[4]; float l;
    attn_block<1, 4>(a, q0b, smem, tbl, o, l);
    attn_store_bf16(o, 1.f / l, ATT + (size_t)(b * S_ + q0) * D_ + hd * 128, D_);
  }
}

DI float gelu_erf(float x) { return 0.5f * x * (1.f + erff(x * 0.7071067811865476f)); }

DI void ins16(float (&L)[16], float x) {
#pragma unroll
  for (int k = 15; k >= 1; --k) L[k] = __builtin_amdgcn_fmed3f(L[k - 1], L[k], x);
  L[0] = __builtin_amdgcn_fmed3f(__builtin_inff(), L[0], x);
}
DI float f_and_or(float v, unsigned mask, unsigned orv) { return __uint_as_float((__float_as_uint(v) & mask) | orv); }

DI void phase_peer_retrieve(const Params& p, char* smem) {
  const int tid = TID(), lane = tid & 63, wave = __builtin_amdgcn_readfirstlane(tid >> 6);
  const int gw = __builtin_amdgcn_readfirstlane((VBID() * NTHREADS + tid) >> 6), nw = (VGRID() * NTHREADS) >> 6;
  unsigned* wbuf = (unsigned*)(smem + wave * 9216);
  const bf16_t* SC = (const bf16_t*)(p.ws + WS_SC);
  int* IDX = (int*)(p.ws + WS_IDX);
  float* GATE = (float*)(p.ws + WS_GATE);
  const float NINF = -__builtin_inff();
  for (int it = gw; it < T_ / 8; it += nw) {
    const bf16_t* gsrc = SC + (size_t)it * (8 * 2048) + (lane >> 2) * 256 + (lane & 3) * 8;
    unsigned* wdst = wbuf + (lane >> 2) * 20 + (lane & 3) * 4;
    const unsigned* wsrc = wbuf + lane * 20;
    u32x4 stg[4];
#define PR_LOAD(CH) _Pragma("unroll") for (int i = 0; i < 4; ++i) stg[i] = *(const u32x4*)(gsrc + i * (16 * 256) + ((CH) >> 2) * 128 + ((CH) & 3) * 32);
    PR_LOAD(0)
    float A[16], B[16];
#pragma unroll
    for (int hf = 0; hf < 2; ++hf) {
      float L[16];
#pragma unroll
      for (int k = 0; k < 16; ++k) L[k] = NINF;
#pragma unroll 1
      for (int c = 0; c < 4; ++c) {
#pragma unroll
        for (int i = 0; i < 4; ++i) *(u32x4*)(wdst + i * (16 * 20)) = stg[i];
        { const int cn = hf * 4 + c + 1 < 7 ? hf * 4 + c + 1 : 7; PR_LOAD(cn) }
        u32x4 v[4];
#pragma unroll
        for (int k = 0; k < 4; ++k) v[k] = *(const u32x4*)(wsrc + 4 * k);
#pragma unroll
        for (int k = 0; k < 4; ++k)
#pragma unroll
          for (int e = 0; e < 4; ++e) {
            const unsigned w = v[k][e], id0 = (unsigned)(c * 32 + 8 * k + 2 * e);
            ins16(L, __uint_as_float((w << 16) | id0));
            ins16(L, __uint_as_float((w & 0xFFFF0000u) | (id0 + 1u)));
          }
      }
#pragma unroll
      for (int k = 0; k < 16; ++k) { if (hf == 0) A[k] = L[k]; else B[k] = L[k]; }
    }
#undef PR_LOAD
    unsigned* lut = wbuf + lane * 33;
#pragma unroll
    for (int k = 0; k < 16; ++k) {
      const unsigned ua = __float_as_uint(A[k]), ub = __float_as_uint(B[k]);
      lut[k] = (ua & 0x7Fu) << 7; lut[16 + k] = ub & 0x7Fu;
      A[k] = __uint_as_float(ua & 0xFFFFFF80u); B[k] = __uint_as_float(ub & 0xFFFFFF80u);
    }
    float C[16];
#pragma unroll
    for (int k = 0; k < 16; ++k) C[k] = NINF;
#pragma unroll
    for (int i = 0; i < 16; ++i)
#pragma unroll
      for (int j = 0; j < 16; ++j)
        if ((i + 1) * (j + 1) <= 16) ins16(C, f_and_or(A[i] + B[j], 0xFFFFFF00u, (unsigned)(i * 16 + j)));
    float ev[16], es = 0.f;
    int ids[16];
    const float mx = __uint_as_float(__float_as_uint(C[0]) & 0xFFFFFF00u);
#pragma unroll
    for (int k = 0; k < 16; ++k) {
      const unsigned uc = __float_as_uint(C[k]);
      ev[k] = __expf(__uint_as_float(uc & 0xFFFFFF00u) - mx);
      es += ev[k];
      ids[k] = (int)(lut[(uc >> 4) & 15u] + lut[16 + (uc & 15u)]);
    }
    const float inv = 1.f / es;
    int* ip = IDX + (size_t)it * (8 * 128) + lane * 16;
    float* gp = GATE + (size_t)it * (8 * 128) + lane * 16;
#pragma unroll
    for (int q = 0; q < 4; ++q) {
      *(int4*)(ip + 4 * q) = make_int4(ids[4 * q], ids[4 * q + 1], ids[4 * q + 2], ids[4 * q + 3]);
      *(float4*)(gp + 4 * q) = make_float4(ev[4 * q] * inv, ev[4 * q + 1] * inv, ev[4 * q + 2] * inv, ev[4 * q + 3] * inv);
    }
  }
}

DI unsigned peer_ticket_issue(unsigned* cnt) {
  unsigned v = 0;
  if ((TID() & 63) == 0) v = __hip_atomic_fetch_add(cnt, 1u, __ATOMIC_RELAXED, __HIP_MEMORY_SCOPE_AGENT);
  return v;
}
DI float oct_sum(float v) {
  v += __builtin_bit_cast(float, __builtin_amdgcn_update_dpp(0, __builtin_bit_cast(int, v), 0xB1, 0xF, 0xF, true));
  v += __builtin_bit_cast(float, __builtin_amdgcn_update_dpp(0, __builtin_bit_cast(int, v), 0x4E, 0xF, 0xF, true));
  v += __builtin_bit_cast(float, __builtin_amdgcn_update_dpp(0, __builtin_bit_cast(int, v), 0x141, 0xF, 0xF, true));
  return v;
}

DI unsigned swar_add8(unsigned x) { return ((x & 0x7F7F7F7Fu) + 0x08080808u) ^ (x & 0x80808080u); }
DI void phase_peer_dots(const Params& p, int layer, char* smem_all) {
  const int rtid = RTID(), lane = rtid & 63, rwave = __builtin_amdgcn_readfirstlane(rtid >> 6);
  const int g = lane >> 3, j = lane & 7;
  int* lidx_all = (int*)(smem_all + rwave * 8192);
  const unsigned char* H8 = (const unsigned char*)(p.ws + WS_H8);
  const int* IDX = (const int*)(p.ws + WS_IDX);
  float* PD = (float*)(p.ws + WS_PD);
  const unsigned char* PU = (const unsigned char*)(p.ws + WS_PEERU) + (size_t)layer * (8 * NEXP * 128);
  const float* SC4 = (const float*)(p.ws + WS_USC4) + (size_t)layer * (8 * NEXP);
  unsigned* tick = (unsigned*)(p.ws + WS_TICKETS) + (size_t)(layer * 2 + 0) * 16 * 16;
  const int xcc = xcc_id() & 7;
#pragma unroll 1
  for (int so = 0; so < 8; ++so) {
    const int s = (xcc + so) & 7;
    unsigned tv = peer_ticket_issue(tick + s * 16);
    for (;;) {
      const int c = __builtin_amdgcn_readfirstlane((int)tv);
      if (c >= T_ / 16) break;
      tv = peer_ticket_issue(tick + s * 16);
#pragma unroll
      for (int gi = 0; gi < 2; ++gi) {
        const int* ip = IDX + (size_t)(c * 16 + gi * 8 + g) * 128 + 16 * j;
#pragma unroll
        for (int i = 0; i < 4; ++i) *(uint4*)(lidx_all + gi * 1024 + g * 128 + 16 * j + 4 * i) = *(const uint4*)(ip + 4 * i);
      }
#pragma unroll 1
      for (int gi = 0; gi < 2; ++gi) {
      const int t0 = c * 16 + gi * 8;
      const int* lidx = lidx_all + gi * 1024;
      unsigned xl[4], xh[4];
      {
        const unsigned char* hp = H8 + (size_t)(t0 + g) * D_ + s * 256 + 32 * j;
        const u32x4 h0 = *(const u32x4*)hp, h1 = *(const u32x4*)(hp + 16);
        const unsigned d[8] = {h0.x, h0.y, h0.z, h0.w, h1.x, h1.y, h1.z, h1.w};
#pragma unroll
        for (int m = 0; m < 4; ++m) {
          xl[m] = (d[2 * m] & 0x0F0F0F0Fu) | ((d[2 * m + 1] & 0x0F0F0F0Fu) << 4);
          xh[m] = ((swar_add8(d[2 * m]) >> 4) & 0x0F0F0F0Fu) | (swar_add8(d[2 * m + 1]) & 0xF0F0F0F0u);
        }
      }
      const unsigned char* ub = PU + (size_t)s * (NEXP * 128);
      const float* scs = SC4 + (size_t)s * NEXP;
      float* pd = PD + ((size_t)s * T_ + t0 + g) * 128;
      const bool b2_ = (lane & 4) != 0, b1_ = (lane & 2) != 0, b0_ = (lane & 1) != 0;
      u32x4 ra[8], rb[8], rc[8];
      float sa, sb, sc;
#define PD_LOAD(R, S, KB) { _Pragma("unroll") for (int q = 0; q < 8; ++q) { const int id = lidx[g * 128 + (KB) + q]; R[q] = *(const u32x4*)(ub + (unsigned)(id * 128 + 16 * j)); } \
                            S = scs[lidx[g * 128 + (KB) + j]]; }
#define DPPI(X, CTRL) __builtin_amdgcn_update_dpp(0, (X), (CTRL), 0xF, 0xF, true)
#define PD_COMP(R, S, KB)                                                                         \
      {                                                                                           \
        int pp[8];                                                                                \
        _Pragma("unroll") for (int q = 0; q < 8; ++q) {                                           \
          int al = __builtin_amdgcn_sdot8((int)R[q].x, (int)xl[0], 0, false);                     \
          int ah = __builtin_amdgcn_sdot8((int)R[q].x, (int)xh[0], 0, false);                     \
          al = __builtin_amdgcn_sdot8((int)R[q].y, (int)xl[1], al, false);                        \
          ah = __builtin_amdgcn_sdot8((int)R[q].y, (int)xh[1], ah, false);                        \
          al = __builtin_amdgcn_sdot8((int)R[q].z, (int)xl[2], al, false);                        \
          ah = __builtin_amdgcn_sdot8((int)R[q].z, (int)xh[2], ah, false);                        \
          al = __builtin_amdgcn_sdot8((int)R[q].w, (int)xl[3], al, false);                        \
          ah = __builtin_amdgcn_sdot8((int)R[q].w, (int)xh[3], ah, false);                        \
          pp[q] = al + 16 * ah;                                                                   \
        }                                                                                         \
          \
        int q4[4], q2[2];                                                                         \
        _Pragma("unroll") for (int i = 0; i < 4; ++i) {                                           \
          const int keep = b2_ ? pp[4 + i] : pp[i], send = b2_ ? pp[i] : pp[4 + i];               \
          q4[i] = keep + DPPI(send, 0x141);                   \
        }                                                                                         \
        _Pragma("unroll") for (int i = 0; i < 2; ++i) {                                           \
          const int keep = b1_ ? q4[2 + i] : q4[i], send = b1_ ? q4[i] : q4[2 + i];               \
          q2[i] = keep + DPPI(send, 0x4E);                      \
        }                                                                                         \
        {                                                                                         \
          const int keep = b0_ ? q2[1] : q2[0], send = b0_ ? q2[0] : q2[1];                       \
          pd[(KB) + j] = (float)(keep + DPPI(send, 0xB1)) * S;     \
        }                                                                                         \
        __builtin_amdgcn_sched_barrier(0);                                                        \
      }
      PD_LOAD(ra, sa, 0)
      PD_LOAD(rb, sb, 8)
#pragma unroll 1
      for (int kb = 0; kb < 120; kb += 24) {
        PD_LOAD(rc, sc, kb + 16)
        PD_COMP(ra, sa, kb)
        PD_LOAD(ra, sa, kb + 24)
        PD_COMP(rb, sb, kb + 8)
        { const int kl = kb + 32 < 120 ? kb + 32 : 120; PD_LOAD(rb, sb, kl) }
        PD_COMP(rc, sc, kb + 16)
      }
      PD_COMP(ra, sa, 120)
#undef PD_LOAD
#undef PD_COMP
#undef DPPI
      }
    }
  }
}

DI void phase_peer_act(const Params& p, int layer) {
  const int rtid = RTID(), lane = rtid & 63;
  const int gw = __builtin_amdgcn_readfirstlane((int)((blockIdx.x * RTHREADS + rtid) >> 6)), nw = (int)(gridDim.x * RTHREADS) >> 6;
  const float* PD = (const float*)(p.ws + WS_PD);
  const int* IDX = (const int*)(p.ws + WS_IDX);
  const float* GATE = (const float*)(p.ws + WS_GATE);
  const float* HS = (const float*)(p.ws + WS_HS);
  unsigned short* ACTQ = (unsigned short*)(p.ws + WS_ACT);
  float* ACTS = (float*)(p.ws + WS_ACT + 4 * MiB);
  const float* VSC = (const float*)(p.ws + WS_PEERV) + (size_t)(2 + layer) * NEXP;
  for (int t = gw; t < T_; t += nw) {
    const size_t e = (size_t)t * 128 + 2 * lane;
    float2 a = make_float2(0.f, 0.f);
#pragma unroll
    for (int s2 = 0; s2 < 8; ++s2) { const float2 q = *(const float2*)(PD + (size_t)s2 * T_ * 128 + e); a.x += q.x; a.y += q.y; }
    const int2 id = *(const int2*)(IDX + e);
    const float2 gt = *(const float2*)(GATE + e);
    const float hs = HS[t];
    const float v0 = gt.x * gelu_erf(a.x * hs) * VSC[id.x], v1 = gt.y * gelu_erf(a.y * hs) * VSC[id.y];
    const float am = wave_max(fmaxf(fabsf(v0), fabsf(v1)));
    const float qs = am > 0.f ? 127.f / am : 1.f;
    const int q0 = (int)rintf(v0 * qs), q1 = (int)rintf(v1 * qs);
    ACTQ[(size_t)t * 64 + lane] = (unsigned short)((q0 & 255) | ((q1 & 255) << 8));
    if (lane == 0) ACTS[t] = am > 0.f ? am / 127.f : 1.f;
  }
}

DI void phase_peer_values(const Params& p, int layer, const float* gate2, char* smem_all) {
  const int rtid = RTID(), lane = rtid & 63, rwave = __builtin_amdgcn_readfirstlane(rtid >> 6);
  const int g = lane >> 3, j = lane & 7;
  int* lidx_all = (int*)(smem_all + rwave * 16384);
  unsigned* lact_all = (unsigned*)(smem_all + rwave * 16384 + 4096);
  const int* IDX = (const int*)(p.ws + WS_IDX);
  const unsigned* ACTQ = (const unsigned*)(p.ws + WS_ACT);
  const float* ACTS = (const float*)(p.ws + WS_ACT + 4 * MiB);
  const unsigned char* PV = (const unsigned char*)(p.ws + WS_PEERV8) + (size_t)layer * NEXP * D_;
  unsigned* tick = (unsigned*)(p.ws + WS_TICKETS) + (size_t)(layer * 2 + 1) * 16 * 16;
  const int xcc = xcc_id() & 7;
#pragma unroll 1
  for (int so = 0; so < 16; ++so) {
    const int s = ((xcc + (so >> 1)) & 7) + 8 * (so & 1);
    unsigned tv = peer_ticket_issue(tick + s * 16);
    for (;;) {
      const int c = __builtin_amdgcn_readfirstlane((int)tv);
      if (c >= T_ / 16) break;
      tv = peer_ticket_issue(tick + s * 16);
#pragma unroll
      for (int gi = 0; gi < 2; ++gi) {
        const int* ip = IDX + (size_t)(c * 16 + gi * 8 + g) * 128 + 16 * j;
#pragma unroll
        for (int i = 0; i < 4; ++i) *(uint4*)(lidx_all + gi * 2048 + g * 128 + 16 * j + 4 * i) = *(const uint4*)(ip + 4 * i);
        *(uint4*)(lact_all + gi * 2048 + g * 32 + 4 * j) = *(const uint4*)(ACTQ + (size_t)(c * 16 + gi * 8 + g) * 32 + 4 * j);
      }
#pragma unroll 1
      for (int gi = 0; gi < 2; ++gi) {
      const int t0 = c * 16 + gi * 8;
      const int* lidx = lidx_all + gi * 2048;
      const unsigned* lact = lact_all + gi * 2048;
      const unsigned char* vb = PV + (size_t)s * (NEXP * 128);
      int y[16];
#pragma unroll
      for (int i = 0; i < 16; ++i) y[i] = 0;
      u32x4 ra[8], rb[8];
      const int tq = t0 + g;
      bf16_t* rrow = (bf16_t*)(p.ws + WS_R16) + (size_t)tq * D_ + s * 128 + 16 * j;
      float* orow = p.out + (size_t)tq * D_ + s * 128 + 16 * j;
      const float* grow = gate2 + (size_t)(tq >> 11) * 12288 + s * 128 + 16 * j;
      u32x4 ia0 = *(const u32x4*)(lidx + g * 128), ia1 = *(const u32x4*)(lidx + g * 128 + 4);
#define PV_LOAD(R, KBN) { const unsigned ids_[8] = {ia0.x, ia0.y, ia0.z, ia0.w, ia1.x, ia1.y, ia1.z, ia1.w};                         \
        _Pragma("unroll") for (int q = 0; q < 8; ++q) R[q] = *(const u32x4*)(vb + (ids_[q] * 128u + 16u * (unsigned)j));              \
        ia0 = *(const u32x4*)(lidx + g * 128 + (KBN)); ia1 = *(const u32x4*)(lidx + g * 128 + (KBN) + 4); }
#define PV_QUAD(W0, W1, W2, W3, AQ, YB) {                                                                                             \
        const unsigned t0_ = __builtin_amdgcn_perm((W1), (W0), 0x05010400u), t1_ = __builtin_amdgcn_perm((W1), (W0), 0x07030602u);    \
        const unsigned t2_ = __builtin_amdgcn_perm((W3), (W2), 0x05010400u), t3_ = __builtin_amdgcn_perm((W3), (W2), 0x07030602u);    \
        y[(YB) + 0] = __builtin_amdgcn_sdot4((int)__builtin_amdgcn_perm(t2_, t0_, 0x05040100u), (int)(AQ), y[(YB) + 0], false);       \
        y[(YB) + 1] = __builtin_amdgcn_sdot4((int)__builtin_amdgcn_perm(t2_, t0_, 0x07060302u), (int)(AQ), y[(YB) + 1], false);       \
        y[(YB) + 2] = __builtin_amdgcn_sdot4((int)__builtin_amdgcn_perm(t3_, t1_, 0x05040100u), (int)(AQ), y[(YB) + 2], false);       \
        y[(YB) + 3] = __builtin_amdgcn_sdot4((int)__builtin_amdgcn_perm(t3_, t1_, 0x07060302u), (int)(AQ), y[(YB) + 3], false); }
#define PV_COMP(R, KB)                                                                            \
      { const unsigned aq0 = lact[g * 32 + ((KB) >> 2)], aq1 = lact[g * 32 + ((KB) >> 2) + 1];    \
        PV_QUAD(R[0].x, R[1].x, R[2].x, R[3].x, aq0, 0)  PV_QUAD(R[0].y, R[1].y, R[2].y, R[3].y, aq0, 4)   \
        PV_QUAD(R[0].z, R[1].z, R[2].z, R[3].z, aq0, 8)  PV_QUAD(R[0].w, R[1].w, R[2].w, R[3].w, aq0, 12)  \
        __builtin_amdgcn_sched_barrier(0);                                                        \
        PV_QUAD(R[4].x, R[5].x, R[6].x, R[7].x, aq1, 0)  PV_QUAD(R[4].y, R[5].y, R[6].y, R[7].y, aq1, 4)   \
        PV_QUAD(R[4].z, R[5].z, R[6].z, R[7].z, aq1, 8)  PV_QUAD(R[4].w, R[5].w, R[6].w, R[7].w, aq1, 12)  \
        __builtin_amdgcn_sched_barrier(0); }
      PV_LOAD(ra, 8)
#pragma unroll 1
      for (int kb = 0; kb < 128; kb += 16) {
        { const int kn = kb + 16 < 120 ? kb + 16 : 120; PV_LOAD(rb, kn) }
        PV_COMP(ra, kb)
        { const int kn = kb + 24 < 120 ? kb + 24 : 120; PV_LOAD(ra, kn) }
        PV_COMP(rb, kb + 8)
      }
#undef PV_LOAD
#undef PV_COMP
#undef PV_QUAD
      const float as = ACTS[tq];
      const u32x4 r0 = *(const u32x4*)rrow, r1 = *(const u32x4*)(rrow + 8);
      const unsigned rw[8] = {r0.x, r0.y, r0.z, r0.w, r1.x, r1.y, r1.z, r1.w};
      float res[16];
#pragma unroll
      for (int i = 0; i < 4; ++i) {
        float4 g0 = *(const float4*)(grow + 4 * i);
        g0.x *= as; g0.y *= as; g0.z *= as; g0.w *= as;
        res[4 * i + 0] = bf_lo(rw[2 * i]) + g0.x * (float)y[4 * i];     res[4 * i + 1] = bf_hi(rw[2 * i]) + g0.y * (float)y[4 * i + 1];
        res[4 * i + 2] = bf_lo(rw[2 * i + 1]) + g0.z * (float)y[4 * i + 2]; res[4 * i + 3] = bf_hi(rw[2 * i + 1]) + g0.w * (float)y[4 * i + 3];
      }
      if (layer == 0) {
        u32x4 w0, w1;
        w0.x = pack_bf2(res[0], res[1]); w0.y = pack_bf2(res[2], res[3]); w0.z = pack_bf2(res[4], res[5]); w0.w = pack_bf2(res[6], res[7]);
        w1.x = pack_bf2(res[8], res[9]); w1.y = pack_bf2(res[10], res[11]); w1.z = pack_bf2(res[12], res[13]); w1.w = pack_bf2(res[14], res[15]);
        *(u32x4*)rrow = w0; *(u32x4*)(rrow + 8) = w1;
      } else {
#pragma unroll
        for (int i = 0; i < 4; ++i) *(float4*)(orow + 4 * i) = make_float4(res[4 * i], res[4 * i + 1], res[4 * i + 2], res[4 * i + 3]);
      }
      }
    }
  }
}

#define XB_TMO      128
#define XB_XCNT(j)  (256  + 64 * (j))
#define XB_XSUB(j)  (1280 + 64 * (j))
#define XB_XGEN(j)  (2304 + 64 * (j))
#define XB_TOP      3328
#define XB_TOPGEN   3392
#define XCD_BAR_WORDS 3456
#define XB_SPIN_CAP (1u << 22)
#define LAS __attribute__((address_space(3)))
DI unsigned xb_ld(unsigned* p) { return __hip_atomic_load(p, __ATOMIC_RELAXED, __HIP_MEMORY_SCOPE_AGENT); }
DI unsigned xb_add(unsigned* p, unsigned v) { return __hip_atomic_fetch_add(p, v, __ATOMIC_RELAXED, __HIP_MEMORY_SCOPE_AGENT); }
DI unsigned xb_xcc_id() { return (unsigned)__builtin_amdgcn_s_getreg((3 << 11) | 20) & 0xFu; }
#define XB_SPIN(cond, bar) do { unsigned _sp = 0; while (cond) { __builtin_amdgcn_s_sleep(1); \
    if ((++_sp & 255u) == 0u) { if (xb_ld(&(bar)[XB_TMO])) break; if (_sp > XB_SPIN_CAP) { atomicAdd(&(bar)[XB_TMO], 1u); break; } } } } while (0)
struct XcdBarrier { unsigned* bar; unsigned x; volatile LAS unsigned* st; };
DI XcdBarrier xcd_barrier_post(unsigned* bar, volatile LAS unsigned* st) {
  XcdBarrier b; b.bar = bar; b.x = xb_xcc_id(); b.st = st;
  if (threadIdx.x == 0) (void)xb_add(&bar[XB_XCNT(b.x)], 1u);
  return b;
}
DI void xcd_barrier_complete(unsigned* bar, unsigned x, unsigned& nloc, unsigned& nx) {
  const unsigned G = gridDim.x * gridDim.y * gridDim.z;
  unsigned sum, cnt, mine, sp = 0u;
  for (;;) {
    sum = 0u; cnt = 0u; mine = 0u;
#pragma unroll
    for (unsigned j = 0; j < 16; ++j) { const unsigned c = xb_ld(&bar[XB_XCNT(j)]); sum += c; cnt += (c > 0u) ? 1u : 0u; mine = (j == x) ? c : mine; }
    if (sum == G) break;
    __builtin_amdgcn_s_sleep(1);
    if ((++sp & 255u) == 0u) { if (xb_ld(&bar[XB_TMO])) break; if (sp > XB_SPIN_CAP) { atomicAdd(&bar[XB_TMO], 1u); break; } }
  }
  nloc = mine > 0u ? mine : 1u; nx = cnt > 0u ? cnt : 1u;
}
DI void xcd_barrier(const XcdBarrier& b) {
  asm volatile("s_waitcnt vmcnt(0)" ::: "memory");
  __syncthreads();
  if (threadIdx.x == 0) {
    unsigned* bar = b.bar;
    __builtin_amdgcn_s_waitcnt(0);
    unsigned nloc = b.st[0], nx = b.st[1];
    if (nloc == 0u) { xcd_barrier_complete(bar, b.x, nloc, nx); b.st[0] = nloc; b.st[1] = nx; }
    const unsigned old = xb_add(&bar[XB_XSUB(b.x)], 1u);
    const unsigned gen = old / nloc;
    if (old + 1u == (gen + 1u) * nloc) {
      __builtin_amdgcn_fence(__ATOMIC_RELEASE, "agent");
      asm volatile("s_waitcnt vmcnt(0)" ::: "memory");
      const unsigned og = xb_add(&bar[XB_TOP], 1u);
      const unsigned tg = og / nx;
      if (og + 1u == (tg + 1u) * nx) xb_add(&bar[XB_TOPGEN], 1u);
      else XB_SPIN(xb_ld(&bar[XB_TOPGEN]) == tg, bar);
      __builtin_amdgcn_fence(__ATOMIC_ACQUIRE, "agent");
      xb_add(&bar[XB_XGEN(b.x)], 1u);
      asm volatile("s_waitcnt vmcnt(0)" ::: "memory");
    } else {
      XB_SPIN(xb_ld(&bar[XB_XGEN(b.x)]) == gen, bar);
      __builtin_amdgcn_fence(__ATOMIC_ACQUIRE, "agent");
      asm volatile("s_waitcnt vmcnt(0)" ::: "memory");
    }
  }
  __syncthreads();
}

constexpr int N_PHASES = 22;
template <class Epi>
DI void gemm256(char* smem_all, const bf16_t* A, const bf16_t* Bt, int M, int N, int K, const Epi& E) {
  pg8::Gemm g{A, Bt, M, N, K};
  pg8::StaticOrder S; S.init(M, N, (int)gridDim.x, (int)blockIdx.x);
  pg8::gemm_phase<Epi, pg8::StaticOrder, false>((PG8_LAS unsigned char*)smem_all, g, S, E, nullptr);
}
template <int ph>
DI void run_phase(const Params& p_in, char* smem, char* smem_all) {
  Params p = p_in;
  {
    size_t z = 0; asm volatile("" : "+s"(z)); p.ws = p_in.ws + z; p.out = p_in.out + z;
  }
  char* ws = p.ws;
  const float* mod = (const float*)(ws + WS_MOD);
  const bf16_t* H = (const bf16_t*)(ws + WS_H);
  if (ph == 0) { phase_prep(p, smem); return; }
  const int layer = ph >= 12 ? 1 : 0;
  const int lp = ph - (layer ? 12 : 1);
  int sub;
  if (layer == 0) sub = lp < 2 ? lp : lp + 1;
  else sub = lp < 2 ? lp : (lp == 2 ? 3 : lp + 2);
  const float* modl = mod + (size_t)layer * 8 * 12288;
  switch (sub) {
    case 0:
      if (layer == 0) { phase_norm<false, 2>(p, p.x, p.norm_gain, modl, modl + 2048); forget_logits(p); quant_w8(p); }
      else phase_norm<false, 2, true, false>(p, ws + WS_R16, p.norm_gain + 2 * 2048, modl, modl + 2048);
      break;
    case 1: {
      if (layer == 0) fox_cumsum(p);
      const bf16_t* H8A = (const bf16_t*)(ws + WS_H8A);
      const float* hsc = (const float*)(ws + WS_H8A + 32 * MiB);
      const bf16_t* W8 = (const bf16_t*)(ws + WS_W8) + (size_t)layer * 6144 * 1024;
      const float* wsc = (const float*)(ws + WS_W8 + 24 * MiB) + layer * 6144;
      pg8::EpiQkNorm eq{(bf16_t*)(ws + WS_QK), 4096, layer ? p.odd_qk_gain : p.even_fox_qk_gain, layer ? p.odd_qk_gain : p.even_diff_qk_gain,
                        layer ? 4 : 3, (float*)(smem_all + 131072), wsc, hsc};
      gemm256(smem_all, H8A, W8, T_, 4096, 1024, eq);
      pg8::EpiVt8 ev{(bf16_t*)(ws + WS_VT), T_, wsc + 4096, hsc};
      gemm256(smem_all, W8 + (size_t)4096 * 1024, H8A, 2048, T_, 1024, ev);
    } break;
    case 3:
      if (layer == 0) phase_attn_even(p, smem_all); else phase_attn_odd(p, smem_all);
      break;
    case 4: phase_diff_combine(p); break;
    case 5: {
      bf16_t* R16 = (bf16_t*)(ws + WS_R16);
      if (layer == 0) { pg8::EpiRes16<false> er{R16, 2048, p.x, modl + 2 * 2048};
        gemm256(smem_all, (const bf16_t*)(ws + WS_ATT), (const bf16_t*)(ws + WS_WO0), T_, 2048, 2048, er); }
      else { pg8::EpiRes16<true> er{R16, 2048, R16, modl + 2 * 2048};
        gemm256(smem_all, (const bf16_t*)(ws + WS_ATT), (const bf16_t*)(ws + WS_WO1), T_, 2048, 2048, er); }
    } break;
    case 6:
      phase_norm<false, 1, true>(p, ws + WS_R16, p.norm_gain + (layer * 2 + 1) * 2048, modl + 3 * 2048, modl + 4 * 2048);
      break;
    case 7: {
      pg8::EpiBf16 es{(bf16_t*)(ws + WS_SC), 2048};
      gemm256(smem_all, H, (const bf16_t*)(ws + (layer ? WS_WQ1 : WS_WQ0)), T_, 2048, 2048, es);
    } break;
    case 8: phase_peer_retrieve(p, smem); break;
    case 9: phase_peer_dots(p, layer, smem_all); break;
    case 10: phase_peer_act(p, layer); break;
    case 11: phase_peer_values(p, layer, modl + 5 * 2048, smem_all); break;
  }
}

#if FUSED
template <int PH>
DI void run_all(const Params& p, char* smem, char* smem_all, const XcdBarrier& xb, cg::grid_group& grid) {
  if constexpr (PH < N_PHASES) {
    run_phase<PH>(p, smem, smem_all);
    if constexpr (PH + 1 < N_PHASES) xcd_barrier(xb);
    run_all<PH + 1>(p, smem, smem_all, xb, grid);
  }
}
__global__ void __launch_bounds__(RTHREADS, 2) mega_kernel(Params p) {
  extern __shared__ __attribute__((aligned(16))) char smem_all[];
  char* smem = smem_all + (RTID() >> 8) * HALF_SMEM;
  cg::grid_group grid = cg::this_grid();
  volatile LAS unsigned* xst = (volatile LAS unsigned*)(smem_all + SMEM_BYTES - 16);
  if (threadIdx.x == 0) { xst[0] = 0u; xst[1] = 0u; }
  __syncthreads();
  const XcdBarrier xb = xcd_barrier_post((unsigned*)(p.ws + WS_BAR), xst);
  if (p.ws == nullptr) grid.sync();
  run_all<0>(p, smem, smem_all, xb, grid);
}
#else
template <int PH>
__global__ void __launch_bounds__(RTHREADS, 2) phase_kernel(Params p) {
  extern __shared__ __attribute__((aligned(16))) char smem_all[];
  char* smem = smem_all + (RTID() >> 8) * HALF_SMEM;
  run_phase<PH>(p, smem, smem_all);
}
template <int PH>
static void launch_phases(const Params& p, int grid, hipStream_t stream) {
  if constexpr (PH < N_PHASES) {
    (void)hipFuncSetAttribute((const void*)phase_kernel<PH>, hipFuncAttributeMaxDynamicSharedMemorySize, SMEM_BYTES);
    phase_kernel<PH><<<grid, RTHREADS, SMEM_BYTES, stream>>>(p);
    launch_phases<PH + 1>(p, grid, stream);
  }
}
#endif

extern "C" void kernel_launch(void* const* d_in, const int* in_sizes, int n_in, void* d_out, int out_size, void* d_ws,
                              size_t ws_size, hipStream_t stream) {
  Params p{};
  p.x = (const float*)d_in[0]; p.c = (const float*)d_in[1]; p.rel_bias = (const float*)d_in[2];
  p.norm_gain = (const float*)d_in[3]; p.w_ada = (const float*)d_in[4]; p.b_ada = (const float*)d_in[5];
  p.even_w_in = (const float*)d_in[6]; p.even_b_forget = (const float*)d_in[7]; p.even_fox_qk_gain = (const float*)d_in[8];
  p.even_diff_qk_gain = (const float*)d_in[9]; p.even_diff_lambda = (const float*)d_in[10];
  p.even_diff_subln_gain = (const float*)d_in[11]; p.even_w_out = (const float*)d_in[12];
  p.odd_w_qkv = (const float*)d_in[13]; p.odd_qk_gain = (const float*)d_in[14]; p.odd_w_out = (const float*)d_in[15];
  p.peer_w_query = (const float*)d_in[16]; p.peer_sub_keys = (const float*)d_in[17];
  p.peer_u = (const float*)d_in[18]; p.peer_v = (const float*)d_in[19];
  p.out = (float*)d_out; p.ws = (char*)d_ws;
  if (ws_size < WS_END) { fprintf(stderr, "workspace too small: %zu < %zu\n", ws_size, (size_t)WS_END); return; }
#if FUSED
  static int grid_blocks = 0;
  if (!grid_blocks) {
    int dev = 0, cus = 0, per_cu = 0;
    (void)hipGetDevice(&dev);
    (void)hipDeviceGetAttribute(&cus, hipDeviceAttributeMultiprocessorCount, dev);
    (void)hipFuncSetAttribute((const void*)mega_kernel, hipFuncAttributeMaxDynamicSharedMemorySize, SMEM_BYTES);
    (void)hipOccupancyMaxActiveBlocksPerMultiprocessor(&per_cu, mega_kernel, RTHREADS, SMEM_BYTES);
    if (per_cu > 1) per_cu = 1;
    grid_blocks = cus * per_cu;
  }
  (void)hipMemsetAsync(p.ws + WS_BAR, 0, WS_BAR_BYTES, stream);
  void* args[] = {&p};
  hipError_t e = hipLaunchCooperativeKernel((void*)mega_kernel, dim3(grid_blocks), dim3(RTHREADS), args, SMEM_BYTES, stream);
  if (e != hipSuccess) fprintf(stderr, "cooperative launch failed: %s (grid %d)\n", hipGetErrorString(e), grid_blocks);
#else
  launch_phases<0>(p, 256, stream);
#endif
}
```

```cpp
#include <hip/hip_runtime.h>
#include <hip/hip_cooperative_groups.h>
#include <stdint.h>
#include <stdio.h>
namespace cg = cooperative_groups;

#ifndef FUSED
#define FUSED 1
#endif

#define DI __device__ __forceinline__
typedef unsigned short bf16_t;
typedef __attribute__((ext_vector_type(8))) short bf16x8;
typedef __attribute__((ext_vector_type(4))) short bf16x4;
typedef __attribute__((ext_vector_type(16))) float f32x16;
typedef __attribute__((ext_vector_type(2))) __bf16 bf2_t;
typedef __attribute__((ext_vector_type(2))) float f2_t;
typedef __attribute__((ext_vector_type(4))) unsigned u32x4;
#define MFMA32(a, b, c) __builtin_amdgcn_mfma_f32_32x32x16_bf16((a), (b), (c), 0, 0, 0)

constexpr int T_ = 16384;
constexpr int D_ = 2048;
constexpr int S_ = 2048;
constexpr int NB_ = 8;
constexpr int NEXP = 16384;
constexpr float LOG2E = 1.4426950408889634f;
constexpr int NTHREADS = 256;
constexpr int HALF_SMEM = 75776;
constexpr int RTHREADS = 512;
constexpr int SMEM_BYTES = 2 * HALF_SMEM + 16;

constexpr size_t MiB = 1048576;
constexpr size_t WS_PEERU = 0;
constexpr size_t WS_PEERV8 = WS_PEERU + 64 * MiB;
constexpr size_t WS_PEERV = WS_PEERU + 128 * MiB;
constexpr size_t WS_WQK0 = WS_PEERV + 128 * MiB;
constexpr size_t WS_WV0 = WS_WQK0 + 16 * MiB;
constexpr size_t WS_WQK1 = WS_WV0 + 8 * MiB;
constexpr size_t WS_WV1 = WS_WQK1 + 16 * MiB;
constexpr size_t WS_WO0 = WS_WV1 + 8 * MiB;
constexpr size_t WS_WO1 = WS_WO0 + 8 * MiB;
constexpr size_t WS_WQ0 = WS_WO1 + 8 * MiB;
constexpr size_t WS_WQ1 = WS_WQ0 + 8 * MiB;
constexpr size_t WS_SK = WS_WQ1 + 8 * MiB;
constexpr size_t WS_WFF = WS_SK + 131072;
constexpr size_t WS_MOD = WS_WFF + 65536;
constexpr size_t WS_LOGF = WS_MOD + 786432;
constexpr size_t WS_FCUM = WS_LOGF + 524288;
constexpr size_t WS_MISC = WS_FCUM + 524288;
constexpr size_t WS_H = WS_MISC + 65536;
constexpr size_t WS_QK = WS_H + 64 * MiB;
constexpr size_t WS_VT = WS_QK + 128 * MiB;
constexpr size_t WS_ATT = WS_VT + 64 * MiB;
constexpr size_t WS_SC = WS_ATT + 64 * MiB;
constexpr size_t WS_BAR = WS_SC + 128 * MiB;
constexpr size_t WS_TICKETS = WS_BAR + 16384;
constexpr size_t WS_BAR_BYTES = 16384 + 4096;
constexpr size_t WS_IDX = WS_ATT;
constexpr size_t WS_GATE = WS_ATT + 8 * MiB;
constexpr size_t WS_ACT = WS_ATT + 16 * MiB;
constexpr size_t WS_PD = WS_SC;
constexpr size_t WS_USC4 = WS_PEERV + 1 * MiB;
constexpr size_t WS_H8 = WS_QK;
constexpr size_t WS_HS = WS_QK + 32 * MiB;
constexpr size_t WS_R16 = WS_BAR + 65536;
constexpr size_t WS_H8A = WS_R16 + 64 * MiB;
constexpr size_t WS_W8 = WS_H8A + 33 * MiB;
constexpr size_t WS_ATT8 = WS_W8 + 33 * MiB;
constexpr size_t WS_END = WS_ATT8 + 33 * MiB;

struct Params {
  const float* x; const float* c; const float* rel_bias; const float* norm_gain; const float* w_ada; const float* b_ada;
  const float* even_w_in; const float* even_b_forget; const float* even_fox_qk_gain; const float* even_diff_qk_gain;
  const float* even_diff_lambda; const float* even_diff_subln_gain; const float* even_w_out;
  const float* odd_w_qkv; const float* odd_qk_gain; const float* odd_w_out;
  const float* peer_w_query; const float* peer_sub_keys; const float* peer_u; const float* peer_v;
  float* out; char* ws;
};

DI unsigned pack_bf2(float a, float b) { f2_t v = {a, b}; return __builtin_bit_cast(unsigned, __builtin_convertvector(v, bf2_t)); }
DI unsigned pack_i8x4(float a, float b, float c, float d) {
  const int ia = (int)rintf(a), ib = (int)rintf(b), ic = (int)rintf(c), id = (int)rintf(d);
  return (unsigned)(ia & 255) | ((unsigned)(ib & 255) << 8) | ((unsigned)(ic & 255) << 16) | ((unsigned)id << 24);
}
DI unsigned q4(float v) { int q = (int)rintf(v); q = q > 7 ? 7 : (q < -7 ? -7 : q); return (unsigned)q & 15u; }
DI unsigned pack_i4x4(float a, float b, float c, float d) { return q4(a) | (q4(b) << 8) | (q4(c) << 16) | (q4(d) << 24); }
DI bf16_t f2bf(float a) { return (bf16_t)(pack_bf2(a, 0.f) & 0xffffu); }
DI float bf_lo(unsigned u) { return __uint_as_float(u << 16); }
DI float bf_hi(unsigned u) { return __uint_as_float(u & 0xffff0000u); }
DI int RTID() { int t = threadIdx.x; asm volatile("" : "+v"(t)); return t; }
DI int TID() { return RTID() & 255; }
DI int VBID() { return __builtin_amdgcn_readfirstlane(blockIdx.x * 2 + (RTID() >> 8)); }
DI int VGRID() { return gridDim.x * 2; }
DI int xcc_id() { return (int)(__builtin_amdgcn_s_getreg((3 << 11) | 20) & 0xFu); }
DI int crow(int reg, int h) { return (reg & 3) + 8 * (reg >> 2) + 4 * h; }
DI float wave_sum(float v) {
#pragma unroll
  for (int o = 32; o >= 1; o >>= 1) v += __shfl_xor(v, o);
  return v;
}
DI float wave_max(float v) {
#pragma unroll
  for (int o = 32; o >= 1; o >>= 1) v = fmaxf(v, __shfl_xor(v, o));
  return v;
}

DI void transpose_tile(const float* __restrict__ src, int ld, int c0, int k0, bf16_t* __restrict__ dst_row0, char* smem) {
  float* tile = (float*)smem;
  const int tid = TID();
  const int ty = tid >> 4, tx = tid & 15;
#pragma unroll
  for (int i = 0; i < 4; ++i) {
    const int k = ty + 16 * i;
    const float4 v = *(const float4*)(src + (size_t)(k0 + k) * ld + c0 + 4 * tx);
    float* t = tile + k * 65 + 4 * tx;
    t[0] = v.x; t[1] = v.y; t[2] = v.z; t[3] = v.w;
  }
  __syncthreads();
  const int cc = tid >> 2, kc = (tid & 3) * 16;
  unsigned pk[8];
#pragma unroll
  for (int j = 0; j < 8; ++j) pk[j] = pack_bf2(tile[(kc + 2 * j) * 65 + cc], tile[(kc + 2 * j + 1) * 65 + cc]);
  uint4* d = (uint4*)(dst_row0 + (size_t)cc * 2048 + k0 + kc);
  d[0] = make_uint4(pk[0], pk[1], pk[2], pk[3]);
  d[1] = make_uint4(pk[4], pk[5], pk[6], pk[7]);
  __syncthreads();
}

DI void phase_prep(const Params& p, char* smem) {
  const int tid = TID(), bid = VBID(), G = VGRID();
  char* ws = p.ws;
  {
    float* cond = (float*)smem;
    bool have_cond = false;
    for (int item = bid; item < 384; item += G) {
      if (!have_cond) {
        for (int e = tid; e < NB_ * D_; e += NTHREADS) {
          const int b = e >> 11, d = e & 2047;
          const float v = p.c[e];
          cond[d * 8 + b] = v / (1.f + __expf(-v));
        }
        have_cond = true;
        __syncthreads();
      }
      const int i = item / 192, n = (item % 192) * 64 + (tid & 63);
      const int w = tid >> 6;
      const float* wp = p.w_ada + (size_t)i * D_ * 12288 + n;
      float acc[8];
#pragma unroll
      for (int b = 0; b < 8; ++b) acc[b] = 0.f;
#pragma unroll 8
      for (int d = w; d < D_; d += 4) {
        const float wv = wp[(size_t)d * 12288];
        const float4 c0 = *(const float4*)(cond + d * 8), c1 = *(const float4*)(cond + d * 8 + 4);
        acc[0] += c0.x * wv; acc[1] += c0.y * wv; acc[2] += c0.z * wv; acc[3] += c0.w * wv;
        acc[4] += c1.x * wv; acc[5] += c1.y * wv; acc[6] += c1.z * wv; acc[7] += c1.w * wv;
      }
      float* red = (float*)(smem + 65536);
#pragma unroll
      for (int b = 0; b < 8; ++b) red[(w * 64 + (tid & 63)) * 8 + b] = acc[b];
      __syncthreads();
      if (tid < 64) {
        float* mod = (float*)(ws + WS_MOD);
#pragma unroll
        for (int b = 0; b < 8; ++b) {
          const float s = red[(0 * 64 + tid) * 8 + b] + red[(1 * 64 + tid) * 8 + b] + red[(2 * 64 + tid) * 8 + b] + red[(3 * 64 + tid) * 8 + b];
          mod[((size_t)i * 8 + b) * 12288 + n] = s + p.b_ada[i * 12288 + n];
        }
      }
      __syncthreads();
    }
    __syncthreads();
  }
  {
    bf16_t* wqk0 = (bf16_t*)(ws + WS_WQK0); bf16_t* wv0 = (bf16_t*)(ws + WS_WV0);
    bf16_t* wqk1 = (bf16_t*)(ws + WS_WQK1); bf16_t* wv1 = (bf16_t*)(ws + WS_WV1);
    for (int item = bid; item < 256 * 32; item += G) {
      const int ct = item >> 5, kt = item & 31;
      const float* src; int ld, c0; bf16_t* dst;
      if (ct < 96) {
        const int seg = ct >> 4, cl = (ct & 15) * 64;
        src = p.even_w_in; ld = 6152;
        c0 = (seg < 3 ? seg * 1024 : 3080 + (seg - 3) * 1024) + cl;
        if (seg == 0) dst = wqk0 + (size_t)cl * 2048;
        else if (seg == 1) dst = wqk0 + (size_t)(1024 + cl) * 2048;
        else if (seg == 2) dst = wv0 + (size_t)cl * 2048;
        else if (seg == 3) dst = wqk0 + (size_t)(2048 + cl) * 2048;
        else if (seg == 4) dst = wqk0 + (size_t)(3072 + cl) * 2048;
        else dst = wv0 + (size_t)(1024 + cl) * 2048;
      } else if (ct < 192) {
        const int cl = (ct - 96) * 64;
        src = p.odd_w_qkv; ld = 6144; c0 = cl;
        dst = cl < 4096 ? wqk1 + (size_t)cl * 2048 : wv1 + (size_t)(cl - 4096) * 2048;
      } else {
        const int mi = (ct - 192) >> 5, cl = ((ct - 192) & 31) * 64;
        ld = 2048; c0 = cl;
        if (mi == 0) { src = p.even_w_out; dst = (bf16_t*)(ws + WS_WO0); }
        else { src = p.odd_w_out; dst = (bf16_t*)(ws + WS_WO1); }
        dst += (size_t)cl * 2048;
      }
      transpose_tile(src, ld, c0, kt * 64, dst, smem);
    }
  }
  {
    const int lane = tid & 63;
    const int gw = __builtin_amdgcn_readfirstlane((bid * NTHREADS + tid) >> 6), nw = (G * NTHREADS) >> 6;
    float* scl = (float*)(ws + WS_PEERV);
    float4 nx[8];
    {
      const int r0 = gw < 4 * NEXP ? gw : 0;
      const float* s0 = ((r0 >> 15) ? p.peer_v : p.peer_u) + (size_t)(r0 & 32767) * D_;
#pragma unroll
      for (int i = 0; i < 2; ++i)
#pragma unroll
        for (int j = 0; j < 4; ++j) nx[4 * i + j] = *(const float4*)(s0 + lane * 16 + 1024 * i + 4 * j);
    }
    for (int row = gw; row < 4 * NEXP; row += nw) {
      const int tab = row >> 15, rr = row & 32767;
      unsigned char* dst = (unsigned char*)(ws + (tab ? WS_PEERV8 : WS_PEERU)) + (size_t)(rr >> 14) * NEXP * D_ + (size_t)(rr & (NEXP - 1)) * 128;
      float4 v[8];
      float am = 0.f;
#pragma unroll
      for (int i = 0; i < 8; ++i) v[i] = nx[i];
      {
        const int rn = row + nw < 4 * NEXP ? row + nw : row;
        const float* sn = ((rn >> 15) ? p.peer_v : p.peer_u) + (size_t)(rn & 32767) * D_;
#pragma unroll
        for (int i = 0; i < 2; ++i)
#pragma unroll
          for (int j = 0; j < 4; ++j) nx[4 * i + j] = *(const float4*)(sn + lane * 16 + 1024 * i + 4 * j);
        asm volatile("" ::: "memory");
      }
#pragma unroll
      for (int i = 0; i < 8; ++i) am = fmaxf(am, fmaxf(fmaxf(fabsf(v[i].x), fabsf(v[i].y)), fmaxf(fabsf(v[i].z), fabsf(v[i].w))));
      if (!tab) {
        unsigned char* d4 = (unsigned char*)(ws + WS_PEERU) + (size_t)(rr >> 14) * (8 * NEXP * 128) + (size_t)(rr & (NEXP - 1)) * 128 + (lane & 15) * 8;
        float* sc4 = (float*)(ws + WS_USC4) + (size_t)(rr >> 14) * (8 * NEXP) + (rr & (NEXP - 1));
#pragma unroll
        for (int i = 0; i < 2; ++i) {
          float bm = 0.f;
#pragma unroll
          for (int j = 0; j < 4; ++j) bm = fmaxf(bm, fmaxf(fmaxf(fabsf(v[4 * i + j].x), fabsf(v[4 * i + j].y)), fmaxf(fabsf(v[4 * i + j].z), fabsf(v[4 * i + j].w))));
#pragma unroll
          for (int o = 1; o < 16; o <<= 1) bm = fmaxf(bm, __shfl_xor(bm, o));
          const float sc = bm > 0.f ? 7.5f / bm : 1.f;
          const int slice = 4 * i + (lane >> 4);
          if ((lane & 15) == 0) sc4[(size_t)slice * NEXP] = bm > 0.f ? bm / 7.5f : 1.f;
          unsigned w[2];
#pragma unroll
          for (int gq = 0; gq < 2; ++gq) {
            const float4 a = v[4 * i + 2 * gq], b = v[4 * i + 2 * gq + 1];
            const unsigned lo = pack_i4x4(a.x * sc, a.y * sc, a.z * sc, a.w * sc);
            const unsigned hi = pack_i4x4(b.x * sc, b.y * sc, b.z * sc, b.w * sc);
            w[gq] = lo | (hi << 4);
          }
          *(uint2*)(d4 + (size_t)slice * (NEXP * 128)) = make_uint2(w[0], w[1]);
        }
        continue;
      }
      am = wave_max(am);
      const float sc = am > 0.f ? 127.f / am : 1.f;
      if (lane == 0) scl[row] = am > 0.f ? am / 127.f : 1.f;
#pragma unroll
      for (int i = 0; i < 2; ++i) {
        unsigned w[4];
#pragma unroll
        for (int j = 0; j < 4; ++j) w[j] = pack_i8x4(v[4 * i + j].x * sc, v[4 * i + j].y * sc, v[4 * i + j].z * sc, v[4 * i + j].w * sc);
        *(uint4*)(dst + (size_t)((lane >> 3) + 8 * i) * (NEXP * 128) + (lane & 7) * 16) = make_uint4(w[0], w[1], w[2], w[3]);
      }
    }
  }
  {
    float* sks = (float*)smem;
    float* wqs = (float*)(smem + 33792);
    const int tn = tid >> 4, tk = tid & 15;
    for (int item = bid; item < 2048; item += G) {
      const int layer = item >> 10, hp = (item >> 6) & 15, nt = (item >> 5) & 1, kt = item & 31;
      const float* sk = p.peer_sub_keys + ((size_t)(layer * 2 + (hp & 1)) * 128 + nt * 64) * 128;
      const float* wq = p.peer_w_query + (size_t)layer * 2048 * 2048 + (size_t)(kt * 64) * 2048 + hp * 128;
      __syncthreads();
#pragma unroll
      for (int i = 0; i < 8; ++i) {
        const int idx = tid + 256 * i, row = idx >> 5, c4 = (idx & 31) * 4;
        *(float4*)(sks + row * 132 + c4) = *(const float4*)(sk + (size_t)row * 128 + c4);
        *(float4*)(wqs + row * 132 + c4) = *(const float4*)(wq + (size_t)row * 2048 + c4);
      }
      __syncthreads();
      float acc[4][4];
#pragma unroll
      for (int i = 0; i < 4; ++i)
#pragma unroll
        for (int j = 0; j < 4; ++j) acc[i][j] = 0.f;
#pragma unroll 4
      for (int d = 0; d < 128; d += 4) {
        float4 a[4], b[4];
#pragma unroll
        for (int i = 0; i < 4; ++i) { a[i] = *(const float4*)(sks + (tn + 16 * i) * 132 + d); b[i] = *(const float4*)(wqs + (tk + 16 * i) * 132 + d); }
#pragma unroll
        for (int i = 0; i < 4; ++i)
#pragma unroll
          for (int j = 0; j < 4; ++j) acc[i][j] += a[i].x * b[j].x + a[i].y * b[j].y + a[i].z * b[j].z + a[i].w * b[j].w;
      }
      bf16_t* dst = (bf16_t*)(ws + (layer ? WS_WQ1 : WS_WQ0)) + (size_t)(hp * 128 + nt * 64) * 2048 + kt * 64;
#pragma unroll
      for (int i = 0; i < 4; ++i)
#pragma unroll
        for (int j = 0; j < 4; ++j) dst[(size_t)(tn + 16 * i) * 2048 + tk + 16 * j] = f2bf(acc[i][j]);
    }
    __syncthreads();
  }
  if (bid == G - 1) {
    float* wff = (float*)(ws + WS_WFF);
    for (int e = tid; e < 2048 * 8; e += NTHREADS) wff[e] = p.even_w_in[(size_t)(e >> 3) * 6152 + 3072 + (e & 7)];
    if (tid < 64) {
      const float* l = p.even_diff_lambda;
      float s1 = l[tid] * l[128 + tid] + l[64 + tid] * l[128 + 64 + tid];
      float s2 = l[256 + tid] * l[384 + tid] + l[256 + 64 + tid] * l[384 + 64 + tid];
      s1 = wave_sum(s1); s2 = wave_sum(s2);
      if (tid == 0) ((float*)(ws + WS_MISC))[0] = expf(s1) - expf(s2) + 0.2f;
    }
  }
}

template <bool FF, int Q8 = 0, bool IN16 = false, bool WH = true>
DI void phase_norm(const Params& p, const void* __restrict__ xin_, const float* __restrict__ gain,
                   const float* __restrict__ sh, const float* __restrict__ sc  ) {
  const int lane = TID() & 63;
  const int gw = __builtin_amdgcn_readfirstlane((VBID() * NTHREADS + TID()) >> 6), nw = (VGRID() * NTHREADS) >> 6;
  bf16_t* H = (bf16_t*)(p.ws + WS_H);
  for (int t = gw; t < T_; t += nw) {
    const int b = t >> 11;
    float4 v[8];
    float ss = 0.f;
    if (IN16) {
      const bf16_t* xr = (const bf16_t*)xin_ + (size_t)t * D_;
#pragma unroll
      for (int i = 0; i < 8; ++i) { const uint2 w = *(const uint2*)(xr + lane * 4 + 256 * i); v[i] = make_float4(bf_lo(w.x), bf_hi(w.x), bf_lo(w.y), bf_hi(w.y)); }
    } else {
      const float* xr = (const float*)xin_ + (size_t)t * D_;
#pragma unroll
      for (int i = 0; i < 8; ++i) v[i] = *(const float4*)(xr + lane * 4 + 256 * i);
    }
#pragma unroll
    for (int i = 0; i < 8; ++i) ss += v[i].x * v[i].x + v[i].y * v[i].y + v[i].z * v[i].z + v[i].w * v[i].w;
    ss = wave_sum(ss);
    const float rstd = rsqrtf(ss * (1.f / 2048.f) + 1e-6f);
    float ff[8];
    if (FF) {
#pragma unroll
      for (int j = 0; j < 8; ++j) ff[j] = 0.f;
    }
    float am = 0.f;
#pragma unroll
    for (int i = 0; i < 8; ++i) {
      const int c = lane * 4 + 256 * i;
      const float4 g = *(const float4*)(gain + c);
      const float4 s1 = *(const float4*)(sc + (size_t)b * 12288 + c);
      const float4 s0 = *(const float4*)(sh + (size_t)b * 12288 + c);
      float4 h;
      h.x = v[i].x * rstd * g.x * (1.f + s1.x) + s0.x;
      h.y = v[i].y * rstd * g.y * (1.f + s1.y) + s0.y;
      h.z = v[i].z * rstd * g.z * (1.f + s1.z) + s0.z;
      h.w = v[i].w * rstd * g.w * (1.f + s1.w) + s0.w;
      if (WH) *(uint2*)(H + (size_t)t * D_ + c) = make_uint2(pack_bf2(h.x, h.y), pack_bf2(h.z, h.w));
      if (Q8) { v[i] = h; am = fmaxf(am, fmaxf(fmaxf(fabsf(h.x), fabsf(h.y)), fmaxf(fabsf(h.z), fabsf(h.w)))); }
      if (FF) {
        const float* wff = (const float*)(p.ws + WS_WFF) + c * 8;
        const float hv[4] = {h.x, h.y, h.z, h.w};
#pragma unroll
        for (int e = 0; e < 4; ++e) {
          const float4 w0 = *(const float4*)(wff + e * 8), w1 = *(const float4*)(wff + e * 8 + 4);
          ff[0] += hv[e] * w0.x; ff[1] += hv[e] * w0.y; ff[2] += hv[e] * w0.z; ff[3] += hv[e] * w0.w;
          ff[4] += hv[e] * w1.x; ff[5] += hv[e] * w1.y; ff[6] += hv[e] * w1.z; ff[7] += hv[e] * w1.w;
        }
      }
    }
    if (Q8) {
      am = wave_max(am);
      const float qs = am > 0.f ? 119.f / am : 1.f;
      unsigned char* h8 = (unsigned char*)(p.ws + (Q8 == 1 ? WS_H8 : WS_H8A)) + (size_t)t * D_ + lane * 4;
#pragma unroll
      for (int i = 0; i < 8; ++i) *(unsigned*)(h8 + 256 * i) = pack_i8x4(v[i].x * qs, v[i].y * qs, v[i].z * qs, v[i].w * qs);
      if (lane == 0) ((float*)(p.ws + (Q8 == 1 ? WS_HS : WS_H8A + 32 * MiB)))[t] = am > 0.f ? am / 119.f : 1.f;
    }
    if (FF) {
#pragma unroll
      for (int j = 0; j < 8; ++j) ff[j] = wave_sum(ff[j]);
      if (lane < 8) {
        float z = ff[0];
#pragma unroll
        for (int j = 1; j < 8; ++j) z = (lane == j) ? ff[j] : z;
        z += p.even_b_forget[lane];
        const float lf = fminf(z, 0.f) - log1pf(__expf(-fabsf(z)));
        ((float*)(p.ws + WS_LOGF))[(size_t)t * 8 + lane] = lf;
      }
    }
  }
}

DI void quant_w8(const Params& p) {
  const int lane = TID() & 63;
  const int gw = __builtin_amdgcn_readfirstlane((VBID() * NTHREADS + TID()) >> 6), nw = (VGRID() * NTHREADS) >> 6;
  for (int row = gw; row < 16384; row += nw) {
    size_t sbase; int sr;
    if (row < 12288) { const int layer = row >= 6144 ? 1 : 0, rl = row - layer * 6144;
      sbase = rl < 4096 ? (layer ? WS_WQK1 : WS_WQK0) : (layer ? WS_WV1 : WS_WV0); sr = rl < 4096 ? rl : rl - 4096; }
    else { sbase = row < 14336 ? WS_WO0 : WS_WO1; sr = (row - 12288) & 2047; }
    const bf16_t* src = (const bf16_t*)(p.ws + sbase) + (size_t)sr * 2048 + lane * 32;
    u32x4 w[4];
#pragma unroll
    for (int i = 0; i < 4; ++i) w[i] = *(const u32x4*)(src + 8 * i);
    float f[32];
    float am = 0.f;
#pragma unroll
    for (int i = 0; i < 4; ++i)
#pragma unroll
      for (int j = 0; j < 4; ++j) { f[8 * i + 2 * j] = bf_lo(w[i][j]); f[8 * i + 2 * j + 1] = bf_hi(w[i][j]); am = fmaxf(am, fmaxf(fabsf(f[8 * i + 2 * j]), fabsf(f[8 * i + 2 * j + 1]))); }
    am = wave_max(am);
    const float sc = am > 0.f ? 127.f / am : 1.f;
    unsigned q[8];
#pragma unroll
    for (int i = 0; i < 8; ++i) q[i] = pack_i8x4(f[4 * i] * sc, f[4 * i + 1] * sc, f[4 * i + 2] * sc, f[4 * i + 3] * sc);
    unsigned char* dst = (unsigned char*)(p.ws + WS_W8) + (size_t)row * 2048 + lane * 32;
    *(u32x4*)dst = (u32x4){q[0], q[1], q[2], q[3]};
    *(u32x4*)(dst + 16) = (u32x4){q[4], q[5], q[6], q[7]};
    if (lane == 0) ((float*)(p.ws + WS_W8 + 32 * MiB))[row] = am > 0.f ? am / 127.f : 1.f;
  }
}

DI void forget_logits(const Params& p) {
  const int lane = TID() & 63;
  const int gw = __builtin_amdgcn_readfirstlane((VBID() * NTHREADS + TID()) >> 6), nw = (VGRID() * NTHREADS) >> 6;
  const bf16_t* H = (const bf16_t*)(p.ws + WS_H);
  for (int t = gw; t < T_; t += nw) {
    float ff[8];
#pragma unroll
    for (int j = 0; j < 8; ++j) ff[j] = 0.f;
#pragma unroll 2
    for (int i = 0; i < 8; ++i) {
      const int c = lane * 4 + 256 * i;
      const uint2 hw = *(const uint2*)(H + (size_t)t * D_ + c);
      const float hv[4] = {bf_lo(hw.x), bf_hi(hw.x), bf_lo(hw.y), bf_hi(hw.y)};
      const float* wff = (const float*)(p.ws + WS_WFF) + c * 8;
#pragma unroll
      for (int e = 0; e < 4; ++e) {
        const float4 w0 = *(const float4*)(wff + e * 8), w1 = *(const float4*)(wff + e * 8 + 4);
        ff[0] += hv[e] * w0.x; ff[1] += hv[e] * w0.y; ff[2] += hv[e] * w0.z; ff[3] += hv[e] * w0.w;
        ff[4] += hv[e] * w1.x; ff[5] += hv[e] * w1.y; ff[6] += hv[e] * w1.z; ff[7] += hv[e] * w1.w;
      }
    }
#pragma unroll
    for (int j = 0; j < 8; ++j) ff[j] = wave_sum(ff[j]);
    if (lane < 8) {
      float z = ff[0];
#pragma unroll
      for (int j = 1; j < 8; ++j) z = (lane == j) ? ff[j] : z;
      z += p.even_b_forget[lane];
      const float lf = fminf(z, 0.f) - log1pf(__expf(-fabsf(z)));
      ((float*)(p.ws + WS_LOGF))[(size_t)t * 8 + lane] = lf;
    }
  }
}

DI void fox_cumsum(const Params& p) {
  const int lane = TID() & 63;
  const int gw = __builtin_amdgcn_readfirstlane((VBID() * NTHREADS + TID()) >> 6), nw = (VGRID() * NTHREADS) >> 6;
  const float* lf = (const float*)(p.ws + WS_LOGF);
  float* fc = (float*)(p.ws + WS_FCUM);
  for (int it = gw; it < 64; it += nw) {
    const int b = it >> 3, hh = it & 7;
    float v[32];
    float tot = 0.f;
#pragma unroll
    for (int j = 0; j < 32; ++j) { tot += lf[(size_t)(b * S_ + lane * 32 + j) * 8 + hh]; v[j] = tot; }
    float inc = tot;
#pragma unroll
    for (int o = 1; o < 64; o <<= 1) { const float n = __shfl_up(inc, o); if (lane >= o) inc += n; }
    const float base = inc - tot;
#pragma unroll
    for (int j = 0; j < 32; ++j) fc[(size_t)it * S_ + lane * 32 + j] = v[j] + base;
  }
}

namespace pg8 {
#define PG8_LAS __attribute__((address_space(3)))
typedef float f32x4 __attribute__((ext_vector_type(4)));
constexpr int BM = 256, BK = 64, HALF = 128, HTB = HALF * BK * 2  , STAGE_BYTES = 8 * HTB, NXCD = 8, WGM = 8;

__host__ __device__ __forceinline__ int lds_byte(int r, int c) { const int st = (r >> 4) * 2 + (c >> 5), rr = r & 15, cc = c & 31, ob = rr * 64 + cc * 2; return st * 1024 + (ob ^ (((ob >> 9) & 1) << 5)); }
__host__ __device__ __forceinline__ void stage_rc(int b, int& R, int& C) { const int st = b / 1024, sb = b % 1024, swz = sb ^ (((sb >> 9) & 1) << 5); R = (st >> 1) * 16 + swz / 64; C = (st & 1) * 32 + (swz % 64) / 2; }
__host__ __device__ __forceinline__ int perm32(int rho) { const int n = rho >> 4, i = rho & 15; return 8 * (i >> 2) + 4 * n + (i & 3); }

struct Unit { int pm, pn; };
struct Gemm { const bf16_t* A; const bf16_t* Bt; int M, N, K; };

struct StaticOrder {
    int nM, nN, nwg, G, c;
    __host__ __device__ void init(int M, int N, int G_, int c_) { nM = M / BM; nN = N / BM; nwg = nM * nN; G = G_; c = c_; }
    __host__ __device__ bool next(int i, Unit& u) const {
        const long L = (long)i * G + c; if (L >= nwg) return false;
        int wgid = (int)L; { const int q = nwg / NXCD, r = nwg % NXCD, xcd = wgid % NXCD, off = wgid / NXCD; wgid = (xcd < r ? xcd * (q + 1) : r * (q + 1) + (xcd - r) * q) + off; }
        const int nig = WGM * nN, gid = wgid / nig, fm = gid * WGM, gsz = (nM - fm) < WGM ? (nM - fm) : WGM;
        u.pm = fm + ((wgid % nig) % gsz); u.pn = (wgid % nig) / gsz; return true;
    }
    __device__ __forceinline__ void a_ready(const Unit&) const {}
    __device__ __forceinline__ void done(const Unit&) const {}
};

struct EpiF32 {
    static constexpr bool PERM = false, AFTER_DRAIN = false, I8 = false;
    float* C; int ldc; const float* bias;
    __device__ __forceinline__ void operator()(const f32x4 (&acc)[2][2][4][2], const Unit& u, int wr, int wc, int fr, int fq) const {
        const int row0 = u.pm * BM + wr * 64 + fr, col0 = u.pn * BM + wc * 32 + 4 * fq;
        f32x4 bv[2][2];
#pragma unroll
        for (int bj = 0; bj < 2; ++bj)
#pragma unroll
            for (int n = 0; n < 2; ++n) bv[bj][n] = bias ? *(const f32x4*)(bias + col0 + bj * HALF + n * 16) : (f32x4){0.f, 0.f, 0.f, 0.f};
#pragma unroll
        for (int ai = 0; ai < 2; ++ai)
#pragma unroll
            for (int m = 0; m < 4; ++m) { float* rowp = C + (size_t)(row0 + ai * HALF + m * 16) * ldc + col0;
#pragma unroll
                for (int bj = 0; bj < 2; ++bj)
#pragma unroll
                    for (int n = 0; n < 2; ++n) *(f32x4*)(rowp + bj * HALF + n * 16) = acc[ai][bj][m][n] + bv[bj][n]; }
    }
};
struct EpiBf16 {
    static constexpr bool PERM = true, AFTER_DRAIN = false, I8 = false;
    bf16_t* O; int ldc;
    __device__ __forceinline__ void operator()(const f32x4 (&acc)[2][2][4][2], const Unit& u, int wr, int wc, int fr, int fq) const {
        const int row0 = u.pm * BM + wr * 64 + fr, col0 = u.pn * BM + wc * 32 + 8 * fq;
#pragma unroll
        for (int ai = 0; ai < 2; ++ai)
#pragma unroll
            for (int m = 0; m < 4; ++m) { bf16_t* rowp = O + (size_t)(row0 + ai * HALF + m * 16) * ldc + col0;
#pragma unroll
                for (int bj = 0; bj < 2; ++bj) { const f32x4 v0 = acc[ai][bj][m][0], v1 = acc[ai][bj][m][1];
                    u32x4 w; w.x = pack_bf2(v0[0], v0[1]); w.y = pack_bf2(v0[2], v0[3]); w.z = pack_bf2(v1[0], v1[1]); w.w = pack_bf2(v1[2], v1[3]);
                    *(u32x4*)(rowp + bj * HALF) = w; } }
    }
};
struct EpiQkNorm {
    static constexpr bool PERM = true, AFTER_DRAIN = false, I8 = true;
    bf16_t* O; int ldc; const float* gainA; const float* gainB; int gshift; float* red;
    const float* wsc; const float* hsc;
    __device__ __forceinline__ void operator()(const f32x4 (&acc)[2][2][4][2], const Unit& u, int wr, int wc, int fr, int fq) const {
        typedef int i32x4 __attribute__((ext_vector_type(4)));
        f32x4 cs[2][2]; float hs[2][4];
        {
            const int c0_ = u.pn * BM + wc * 32 + 8 * fq, r0_ = u.pm * BM + wr * 64 + fr;
#pragma unroll
            for (int bj = 0; bj < 2; ++bj) { cs[bj][0] = *(const f32x4*)(wsc + c0_ + bj * HALF); cs[bj][1] = *(const f32x4*)(wsc + c0_ + bj * HALF + 4); }
#pragma unroll
            for (int ai = 0; ai < 2; ++ai)
#pragma unroll
                for (int m = 0; m < 4; ++m) hs[ai][m] = hsc[r0_ + ai * HALF + m * 16];
        }
#define QKN_VAL(ai, bj, m, n) (__builtin_convertvector(__builtin_bit_cast(i32x4, acc[ai][bj][m][n]), f32x4) * cs[bj][n] * hs[ai][m])
        float ss[2][4][2];
#pragma unroll
        for (int ai = 0; ai < 2; ++ai)
#pragma unroll
            for (int m = 0; m < 4; ++m)
#pragma unroll
                for (int bj = 0; bj < 2; ++bj) {
                    const f32x4 v0 = QKN_VAL(ai, bj, m, 0), v1 = QKN_VAL(ai, bj, m, 1);
                    float t = v0[0] * v0[0] + v0[1] * v0[1] + v0[2] * v0[2] + v0[3] * v0[3] + v1[0] * v1[0] + v1[1] * v1[1] + v1[2] * v1[2] + v1[3] * v1[3];
                    t += __shfl_xor(t, 16); t += __shfl_xor(t, 32);
                    ss[ai][m][bj] = t;
                }
        float* myred = red + (wr * 4 + wc) * 256;
        if (fq == 0) {
#pragma unroll
            for (int ai = 0; ai < 2; ++ai)
#pragma unroll
                for (int m = 0; m < 4; ++m)
#pragma unroll
                    for (int bj = 0; bj < 2; ++bj) myred[(ai * 64 + m * 16 + fr) * 2 + bj] = ss[ai][m][bj];
        }
        asm volatile("s_waitcnt lgkmcnt(0)" ::: "memory"); __builtin_amdgcn_s_barrier(); asm volatile("" ::: "memory");
        const int row0 = u.pm * BM + wr * 64 + fr, col0 = u.pn * BM + wc * 32 + 8 * fq;
        const float* rbase = red + (wr * 4) * 256;
#pragma unroll
        for (int bj = 0; bj < 2; ++bj) {
            const int grp = (u.pn * 2 + bj) >> gshift;
            const float* gain = ((grp & 2) ? gainB : gainA) + (grp & 1) * 128 + wc * 32 + 8 * fq;
            const float qs = (grp & 1) ? 1.f : 0.08838834764831845f * LOG2E;
            float4 g0 = *(const float4*)gain, g1 = *(const float4*)(gain + 4);
            g0.x *= qs; g0.y *= qs; g0.z *= qs; g0.w *= qs; g1.x *= qs; g1.y *= qs; g1.z *= qs; g1.w *= qs;
#pragma unroll
            for (int ai = 0; ai < 2; ++ai)
#pragma unroll
                for (int m = 0; m < 4; ++m) {
                    const int ri = (ai * 64 + m * 16 + fr) * 2 + bj;
                    const float tot = rbase[ri] + rbase[256 + ri] + rbase[512 + ri] + rbase[768 + ri];
                    const float rstd = rsqrtf(tot * (1.f / 128.f) + 1e-6f);
                    const f32x4 v0 = QKN_VAL(ai, bj, m, 0), v1 = QKN_VAL(ai, bj, m, 1);
                    u32x4 w;
                    w.x = pack_bf2(v0[0] * rstd * g0.x, v0[1] * rstd * g0.y); w.y = pack_bf2(v0[2] * rstd * g0.z, v0[3] * rstd * g0.w);
                    w.z = pack_bf2(v1[0] * rstd * g1.x, v1[1] * rstd * g1.y); w.w = pack_bf2(v1[2] * rstd * g1.z, v1[3] * rstd * g1.w);
                    *(u32x4*)(O + (size_t)(row0 + ai * HALF + m * 16) * ldc + col0 + bj * HALF) = w;
                }
        }
#undef QKN_VAL
    }
};
struct EpiVt8 {
    static constexpr bool PERM = true, AFTER_DRAIN = false, I8 = true;
    bf16_t* O; int ldc; const float* rscale; const float* cscale;
    __device__ __forceinline__ void operator()(const f32x4 (&acc)[2][2][4][2], const Unit& u, int wr, int wc, int fr, int fq) const {
        typedef int i32x4 __attribute__((ext_vector_type(4)));
        const int row0 = u.pm * BM + wr * 64 + fr, col0 = u.pn * BM + wc * 32 + 8 * fq;
        f32x4 c0[2], c1[2];
#pragma unroll
        for (int bj = 0; bj < 2; ++bj) { c0[bj] = *(const f32x4*)(cscale + col0 + bj * HALF); c1[bj] = *(const f32x4*)(cscale + col0 + bj * HALF + 4); }
#pragma unroll
        for (int ai = 0; ai < 2; ++ai)
#pragma unroll
            for (int m = 0; m < 4; ++m) { const int row = row0 + ai * HALF + m * 16; const float rs = rscale[row]; bf16_t* rowp = O + (size_t)row * ldc + col0;
#pragma unroll
                for (int bj = 0; bj < 2; ++bj) {
                    const i32x4 i0 = __builtin_bit_cast(i32x4, acc[ai][bj][m][0]), i1 = __builtin_bit_cast(i32x4, acc[ai][bj][m][1]);
                    const f32x4 v0 = __builtin_convertvector(i0, f32x4) * c0[bj] * rs, v1 = __builtin_convertvector(i1, f32x4) * c1[bj] * rs;
                    u32x4 w; w.x = pack_bf2(v0[0], v0[1]); w.y = pack_bf2(v0[2], v0[3]); w.z = pack_bf2(v1[0], v1[1]); w.w = pack_bf2(v1[2], v1[3]);
                    *(u32x4*)(rowp + bj * HALF) = w; } }
    }
};
template <bool IN16>
struct EpiRes16 {
    static constexpr bool PERM = true, AFTER_DRAIN = false, I8 = true;
    bf16_t* O; int ldc; const void* xin; const float* gate; const float* rsc; const float* csc;
    __device__ __forceinline__ void operator()(const f32x4 (&acc)[2][2][4][2], const Unit& u, int wr, int wc, int fr, int fq) const {
        typedef int i32x4 __attribute__((ext_vector_type(4)));
        const int row0 = u.pm * BM + wr * 64 + fr, col0 = u.pn * BM + wc * 32 + 8 * fq;
        const float* gp = gate + (size_t)((u.pm * BM) >> 11) * 12288 + col0;
        f32x4 g0[2], g1[2];
#pragma unroll
        for (int bj = 0; bj < 2; ++bj) { g0[bj] = *(const f32x4*)(gp + bj * HALF) * *(const f32x4*)(csc + col0 + bj * HALF); g1[bj] = *(const f32x4*)(gp + bj * HALF + 4) * *(const f32x4*)(csc + col0 + bj * HALF + 4); }
#pragma unroll
        for (int ai = 0; ai < 2; ++ai)
#pragma unroll
            for (int m = 0; m < 4; ++m) { const size_t ro = (size_t)(row0 + ai * HALF + m * 16) * ldc + col0; const float rs = rsc[row0 + ai * HALF + m * 16];
#pragma unroll
                for (int bj = 0; bj < 2; ++bj) {
                    f32x4 x0, x1;
                    if (IN16) { const u32x4 xw = *(const u32x4*)((const bf16_t*)xin + ro + bj * HALF);
                        x0 = (f32x4){bf_lo(xw.x), bf_hi(xw.x), bf_lo(xw.y), bf_hi(xw.y)}; x1 = (f32x4){bf_lo(xw.z), bf_hi(xw.z), bf_lo(xw.w), bf_hi(xw.w)}; }
                    else { x0 = *(const f32x4*)((const float*)xin + ro + bj * HALF); x1 = *(const f32x4*)((const float*)xin + ro + bj * HALF + 4); }
                    const f32x4 v0 = x0 + g0[bj] * (__builtin_convertvector(__builtin_bit_cast(i32x4, acc[ai][bj][m][0]), f32x4) * rs), v1 = x1 + g1[bj] * (__builtin_convertvector(__builtin_bit_cast(i32x4, acc[ai][bj][m][1]), f32x4) * rs);
                    u32x4 w; w.x = pack_bf2(v0[0], v0[1]); w.y = pack_bf2(v0[2], v0[3]); w.z = pack_bf2(v1[0], v1[1]); w.w = pack_bf2(v1[2], v1[3]);
                    *(u32x4*)(O + ro + bj * HALF) = w; } }
    }
};
struct EpiRes {
    static constexpr bool PERM = false, AFTER_DRAIN = false, I8 = false;
    float* C; int ldc; const float* xin; const float* gate;
    __device__ __forceinline__ void operator()(const f32x4 (&acc)[2][2][4][2], const Unit& u, int wr, int wc, int fr, int fq) const {
        const int row0 = u.pm * BM + wr * 64 + fr, col0 = u.pn * BM + wc * 32 + 4 * fq;
        const float* gp = gate + (size_t)((u.pm * BM) >> 11) * 12288 + col0;
        f32x4 gv[2][2];
#pragma unroll
        for (int bj = 0; bj < 2; ++bj)
#pragma unroll
            for (int n = 0; n < 2; ++n) gv[bj][n] = *(const f32x4*)(gp + bj * HALF + n * 16);
#pragma unroll
        for (int ai = 0; ai < 2; ++ai)
#pragma unroll
            for (int m = 0; m < 4; ++m) { const size_t ro = (size_t)(row0 + ai * HALF + m * 16) * ldc + col0;
#pragma unroll
                for (int bj = 0; bj < 2; ++bj)
#pragma unroll
                    for (int n = 0; n < 2; ++n) { const f32x4 xv = *(const f32x4*)(xin + ro + bj * HALF + n * 16);
                        *(f32x4*)(C + ro + bj * HALF + n * 16) = xv + gv[bj][n] * acc[ai][bj][m][n]; } }
    }
};

template <bool I8>
__device__ __forceinline__ f32x4 pg8_mma(bf16x8 b, bf16x8 a, f32x4 c) {
    if constexpr (I8) {
        typedef int i32x4 __attribute__((ext_vector_type(4)));
        return __builtin_bit_cast(f32x4, __builtin_amdgcn_mfma_i32_16x16x64_i8(__builtin_bit_cast(i32x4, b), __builtin_bit_cast(i32x4, a), __builtin_bit_cast(i32x4, c), 0, 0, 0));
    } else {
        return __builtin_amdgcn_mfma_f32_16x16x32_bf16(b, a, c, 0, 0, 0);
    }
}
template <class Epi, class Sched, bool STAMP = false>
__device__ __forceinline__ void gemm_phase(PG8_LAS unsigned char* lds, const Gemm g, const Sched& S, const Epi& E, unsigned long long* stamps) {
    const int tid = RTID(), wid = __builtin_amdgcn_readfirstlane(tid >> 6), lane = tid & 63, wr = wid >> 2, wc = wid & 3, fr = lane & 15, fq = lane >> 4;
    const int K = g.K, nt = K / BK;
    int ts_lo = 0, ts_hi = 0, nts = 0; const unsigned long long rt_entry = STAMP ? (unsigned long long)wall_clock64() : 0ull;
#define PG8_STAMP() do { if (STAMP && wid == 0 && nts < 64) { const unsigned long long _c = (unsigned long long)clock64(); \
        ts_lo = (lane == nts) ? (int)(unsigned)_c : ts_lo; ts_hi = (lane == nts) ? (int)(unsigned)(_c >> 32) : ts_hi; ++nts; } } while (0)
    PG8_STAMP();
    unsigned voffA[2], voffB[2];
#pragma unroll
    for (int i = 0; i < 2; ++i) { int R, C; stage_rc(tid * 16 + i * 8192, R, C); const int Rb = Epi::PERM ? ((R & ~31) + perm32(R & 31)) : R;
        voffA[i] = (unsigned)(R * K + C) * 2u; voffB[i] = (unsigned)(Rb * K + C) * 2u; }
    const size_t kstep = (size_t)(BK * 2);
    const size_t hstep = (size_t)HALF * K * 2;
    const size_t tstep = 2 * hstep;
    const unsigned ldsw = (unsigned)wid * 1024u;
    const int aoff = lds_byte(wr * 64 + fr, fq * 8), boff = lds_byte(wc * 32 + fr, fq * 8);
#define PG8_SA(b, h) (((b) * 2 + (h)) * HTB)
#define PG8_SB(b, h) ((4 + (b) * 2 + (h)) * HTB)
#define PG8_STAGE(bufoff, gbase, voff) do { _Pragma("unroll") for (int _i = 0; _i < 2; ++_i) \
        __builtin_amdgcn_global_load_lds((const unsigned*)((const char*)(gbase) + (voff)[_i]), (PG8_LAS unsigned*)(lds + (bufoff) + ldsw + _i * 8192), 16, 0, 0); } while (0)
#define PG8_LDA(dst, b, h) do { _Pragma("unroll") for (int m = 0; m < 4; ++m) _Pragma("unroll") for (int k = 0; k < 2; ++k) dst[m][k] = *(const PG8_LAS bf16x8*)(lds + PG8_SA(b, h) + aoff + m * 2048 + k * 1024); } while (0)
#define PG8_LDB(dst, b, h) do { _Pragma("unroll") for (int n = 0; n < 2; ++n) _Pragma("unroll") for (int k = 0; k < 2; ++k) dst[n][k] = *(const PG8_LAS bf16x8*)(lds + PG8_SB(b, h) + boff + n * 2048 + k * 1024); } while (0)
#define PG8_MMA(ai, bj, At, Bt) do { __builtin_amdgcn_s_setprio(1); _Pragma("unroll") for (int m = 0; m < 4; ++m) _Pragma("unroll") for (int n = 0; n < 2; ++n) _Pragma("unroll") for (int k = 0; k < 2; ++k) \
        acc[ai][bj][m][n] = pg8_mma<Epi::I8>(Bt[n][k], At[m][k], acc[ai][bj][m][n]); __builtin_amdgcn_s_setprio(0); } while (0)
#define PG8_WAIT_V(n) asm volatile("s_waitcnt vmcnt(" #n ")" ::: "memory")
#define PG8_WAIT_L(n) asm volatile("s_waitcnt lgkmcnt(" #n ")" ::: "memory")
#define PG8_BAR __builtin_amdgcn_s_barrier()
#define PG8_SCHED __builtin_amdgcn_sched_barrier(0)
    Unit cur, nxt; int ui = 0;
    if (!S.next(0, cur)) return;
    f32x4 acc[2][2][4][2];
#pragma unroll
    for (int a = 0; a < 2; ++a)
#pragma unroll
        for (int b = 0; b < 2; ++b)
#pragma unroll
            for (int m = 0; m < 4; ++m)
#pragma unroll
                for (int n = 0; n < 2; ++n) acc[a][b][m][n] = (f32x4){0.f, 0.f, 0.f, 0.f};
    bf16x8 At[4][2], B0[2][2], B1[2][2];
    const char* cA = (const char*)g.A + (size_t)cur.pm * tstep; const char* cB = (const char*)g.Bt + (size_t)cur.pn * tstep;
    S.a_ready(cur);
    PG8_STAGE(PG8_SB(0, 0), cB, voffB); PG8_STAGE(PG8_SA(0, 0), cA, voffA); PG8_STAGE(PG8_SB(0, 1), cB + hstep, voffB); PG8_STAGE(PG8_SA(0, 1), cA + hstep, voffA);
    if (wr == 1) PG8_BAR;
    PG8_WAIT_V(4); PG8_BAR;
    PG8_STAGE(PG8_SB(1, 0), cB + kstep, voffB); PG8_STAGE(PG8_SA(1, 0), cA + kstep, voffA); PG8_STAGE(PG8_SB(1, 1), cB + hstep + kstep, voffB);
    PG8_WAIT_V(6); PG8_BAR;
    PG8_STAMP();
    for (;;) {
        const bool has_next = S.next(ui + 1, nxt);
        const char* nA = has_next ? (const char*)g.A + (size_t)nxt.pm * tstep : cA; const char* nB = has_next ? (const char*)g.Bt + (size_t)nxt.pn * tstep : cB;
        for (int t = 0; t < nt; t += 2) {
            const bool last = (t == nt - 2);
            const char* a1 = cA + (size_t)(t + 1) * kstep;
            const char* a2 = last ? nA : cA + (size_t)(t + 2) * kstep; const char* b2 = last ? nB : cB + (size_t)(t + 2) * kstep;
            const char* a3 = a2 + kstep; const char* b3 = b2 + kstep;
            if (last && has_next) S.a_ready(nxt);
            PG8_LDB(B0, 0, 0); PG8_SCHED; PG8_LDA(At, 0, 0); PG8_STAGE(PG8_SA(1, 1), a1 + hstep, voffA);
            PG8_WAIT_L(8); PG8_BAR; PG8_WAIT_L(0); PG8_MMA(0, 0, At, B0); PG8_BAR; PG8_SCHED;
            PG8_LDB(B1, 0, 1); PG8_STAGE(PG8_SB(0, 0), b2, voffB);
            PG8_BAR; PG8_WAIT_L(0); PG8_MMA(0, 1, At, B1); PG8_BAR;
            PG8_LDA(At, 0, 1); PG8_STAGE(PG8_SA(0, 0), a2, voffA);
            PG8_BAR; PG8_WAIT_L(0); PG8_MMA(1, 0, At, B0); PG8_BAR; PG8_SCHED;
            PG8_STAGE(PG8_SB(0, 1), b2 + hstep, voffB);
            PG8_WAIT_V(6); PG8_BAR; PG8_MMA(1, 1, At, B1); PG8_BAR;
            PG8_LDB(B0, 1, 0); PG8_SCHED; PG8_LDA(At, 1, 0); PG8_STAGE(PG8_SA(0, 1), a2 + hstep, voffA);
            PG8_WAIT_L(8); PG8_BAR; PG8_WAIT_L(0); PG8_MMA(0, 0, At, B0); PG8_BAR; PG8_SCHED;
            PG8_LDB(B1, 1, 1); PG8_STAGE(PG8_SB(1, 0), b3, voffB);
            PG8_BAR; PG8_WAIT_L(0); PG8_MMA(0, 1, At, B1); PG8_BAR;
            PG8_LDA(At, 1, 1); PG8_STAGE(PG8_SA(1, 0), a3, voffA);
            PG8_BAR; PG8_WAIT_L(0); PG8_MMA(1, 0, At, B0); PG8_BAR; PG8_SCHED;
            PG8_STAGE(PG8_SB(1, 1), b3 + hstep, voffB);
            PG8_WAIT_V(6); PG8_BAR; PG8_MMA(1, 1, At, B1); PG8_BAR;
        }
        PG8_STAMP();
        if constexpr (!Epi::AFTER_DRAIN) { E(acc, cur, wr, wc, fr, fq); S.done(cur); }
        PG8_STAMP();
        if (!has_next) break;
#pragma unroll
        for (int a = 0; a < 2; ++a)
#pragma unroll
            for (int b = 0; b < 2; ++b)
#pragma unroll
                for (int m = 0; m < 4; ++m)
#pragma unroll
                    for (int n = 0; n < 2; ++n) acc[a][b][m][n] = (f32x4){0.f, 0.f, 0.f, 0.f};
        cur = nxt; cA = nA; cB = nB; ++ui;
    }
    PG8_WAIT_V(0);
    if (wr == 0) PG8_BAR;
    PG8_BAR;
    if constexpr (Epi::AFTER_DRAIN) { E.fused(acc, cur, wr, wc, fr, fq, lds, wid, lane); S.done(cur); }
    PG8_STAMP();
    if (STAMP && wid == 0) { stamps[lane] = lane < nts ? (((unsigned long long)(unsigned)ts_hi << 32) | (unsigned)ts_lo) : 0ull;
        if (lane == 62) stamps[62] = rt_entry; if (lane == 63) stamps[63] = (unsigned long long)wall_clock64(); }
#undef PG8_STAMP
#undef PG8_SA
#undef PG8_SB
#undef PG8_STAGE
#undef PG8_LDA
#undef PG8_LDB
#undef PG8_MMA
#undef PG8_WAIT_V
#undef PG8_WAIT_L
#undef PG8_BAR
#undef PG8_SCHED
}
}

struct AttnPtrs { const bf16_t* Q; int ldq; const bf16_t* K; int ldk; const bf16_t* Vt; int ldv; const float* kbias; };

DI float xhalf_max(float v) {
  const auto r2 = __builtin_amdgcn_permlane32_swap(__float_as_uint(v), __float_as_uint(v), false, false);
  return fmaxf(__uint_as_float(r2[0]), __uint_as_float(r2[1]));
}
DI float xhalf_sum(float v) {
  const auto r2 = __builtin_amdgcn_permlane32_swap(__float_as_uint(v), __float_as_uint(v), false, false);
  return __uint_as_float(r2[0]) + __uint_as_float(r2[1]);
}

template <int MODE, int DVB>
DI void attn_block(const AttnPtrs& a, int q0b, char* smem, const float* tbl, f32x16 (&o)[DVB], float& l_out) {
  constexpr int STG = 16384 + DVB * 4096;
  const int tid = RTID(), lane = tid & 63, wave = __builtin_amdgcn_readfirstlane(tid >> 6);
  const int r = lane & 31, h = lane >> 5;
  const int q0 = q0b + 32 * wave;
  const int krow = tid >> 4, kch = tid & 15;
  const int vrow = tid >> 3, vch = tid & 7;
  const char* Kb = (const char*)a.K;
  const char* Vb = (const char*)a.Vt;
  const unsigned kvo = (unsigned)(krow * a.ldk + kch * 8) * 2u;
  const unsigned vvo = (unsigned)(vrow * a.ldv + vch * 8) * 2u;
  const unsigned kst = (unsigned)(32 * a.ldk) * 2u, vst = (unsigned)(64 * a.ldv) * 2u;
  const int kwo = krow * 256 + ((kch ^ (krow & 15)) << 4);
  const int vwo = 16384 + vrow * 128 + ((vch ^ ((vrow >> 1) & 7)) << 4);
  const int pr = (r & ~12) | ((r & 4) << 1) | ((r & 8) >> 1);
  const int kro = pr * 256, ksw = pr & 15;
  const int vro = 16384 + r * 128, vsw = (r >> 1) & 7;
  bf16x8 qf[8];
#pragma unroll
  for (int s = 0; s < 8; ++s) qf[s] = *(const bf16x8*)(a.Q + (size_t)(q0 + r) * a.ldq + 16 * s + 8 * h);
#pragma unroll
  for (int dt = 0; dt < DVB; ++dt)
#pragma unroll
    for (int e = 0; e < 16; ++e) o[dt][e] = 0.f;
  float m = -1e30f, l = 0.f;
  const int nkt = (q0b + 256) >> 6;
  u32x4 rk[2], rv[DVB / 2];
#pragma unroll
  for (int i = 0; i < 2; ++i) rk[i] = *(const u32x4*)(Kb + (size_t)(i * kst) + kvo);
#pragma unroll
  for (int i = 0; i < DVB / 2; ++i) rv[i] = *(const u32x4*)(Vb + (size_t)(i * vst) + vvo);
#pragma unroll
  for (int i = 0; i < 2; ++i) *(u32x4*)(smem + kwo + i * 8192) = rk[i];
#pragma unroll
  for (int i = 0; i < DVB / 2; ++i) *(u32x4*)(smem + vwo + i * 8192) = rv[i];
  u32x4 rkB[2], rvB[DVB / 2];
  if constexpr (DVB == 4) {
    const int k1 = nkt > 1 ? 64 : 0;
#pragma unroll
    for (int i = 0; i < 2; ++i) rk[i] = *(const u32x4*)(Kb + ((size_t)k1 * (size_t)a.ldk * 2u + i * kst) + kvo);
#pragma unroll
    for (int i = 0; i < DVB / 2; ++i) rv[i] = *(const u32x4*)(Vb + ((size_t)k1 * 2u + i * vst) + vvo);
  }
  __syncthreads();
#define ATT_TILE(KT, RL, RVL, RW, RVW) { const int kt = (KT); \
    const int k0 = kt << 6; \
    char* st = smem + (kt & 1) * STG; \
    { \
      const int kn = (kt + 2 < nkt ? kt + 2 : nkt - 1) << 6;        \
      const size_t kbo = (size_t)kn * (size_t)a.ldk * 2u, vbo = (size_t)kn * 2u; \
_Pragma("unroll") \
      for (int i = 0; i < 2; ++i) RL[i] = *(const u32x4*)(Kb + (kbo + i * kst) + kvo); \
_Pragma("unroll") \
      for (int i = 0; i < DVB / 2; ++i) RVL[i] = *(const u32x4*)(Vb + (vbo + i * vst) + vvo); \
    } \
    asm volatile("" ::: "memory"); \
    __builtin_amdgcn_sched_barrier(0); \
_Pragma("unroll") \
    for (int sub = 0; sub < 2; ++sub) { \
      const int ks0 = k0 + 32 * sub; \
      if (ks0 <= q0) { \
        f32x16 sa; \
_Pragma("unroll") \
        for (int e = 0; e < 16; ++e) sa[e] = 0.f; \
_Pragma("unroll") \
        for (int s = 0; s < 8; ++s) { \
          const bf16x8 kf = *(const bf16x8*)(st + kro + sub * 8192 + (((2 * s + h) ^ ksw) << 4)); \
          sa = MFMA32(kf, qf[s], sa); \
        } \
        float v[16]; \
        if (MODE == 0) { \
_Pragma("unroll") \
          for (int c = 0; c < 2; ++c) { \
            const float4 kb0 = *(const float4*)(a.kbias + ks0 + 16 * c + 8 * h); \
            const float4 kb1 = *(const float4*)(a.kbias + ks0 + 16 * c + 8 * h + 4); \
            v[8 * c + 0] = sa[8 * c + 0] - kb0.x * LOG2E; v[8 * c + 1] = sa[8 * c + 1] - kb0.y * LOG2E; \
            v[8 * c + 2] = sa[8 * c + 2] - kb0.z * LOG2E; v[8 * c + 3] = sa[8 * c + 3] - kb0.w * LOG2E; \
            v[8 * c + 4] = sa[8 * c + 4] - kb1.x * LOG2E; v[8 * c + 5] = sa[8 * c + 5] - kb1.y * LOG2E; \
            v[8 * c + 6] = sa[8 * c + 6] - kb1.z * LOG2E; v[8 * c + 7] = sa[8 * c + 7] - kb1.w * LOG2E; \
          } \
          if (ks0 == q0) { \
_Pragma("unroll") \
            for (int e = 0; e < 16; ++e) if ((e & 7) + 8 * h + 16 * (e >> 3) > r) v[e] = -INFINITY; \
          } \
        } else { \
          const float* tp = tbl + (q0 - ks0) + r + 32 - 8 * h - 23; \
_Pragma("unroll") \
          for (int e = 0; e < 16; ++e) v[e] = sa[e] + tp[23 - ((e & 7) + 16 * (e >> 3))]; \
        } \
        float mx = v[0]; \
_Pragma("unroll") \
        for (int e = 1; e < 16; ++e) mx = fmaxf(mx, v[e]); \
        mx = xhalf_max(mx); \
        if (__ballot(mx > m + 8.f) != 0ull) { \
          const float mn = fmaxf(m, mx); \
          const float alpha = __builtin_amdgcn_exp2f(m - mn); \
          m = mn; \
          l *= alpha; \
_Pragma("unroll") \
          for (int dt = 0; dt < DVB; ++dt) \
_Pragma("unroll") \
            for (int e = 0; e < 16; ++e) o[dt][e] *= alpha; \
        } \
        float ps = 0.f; \
_Pragma("unroll") \
        for (int e = 0; e < 16; ++e) { v[e] = __builtin_amdgcn_exp2f(v[e] - m); ps += v[e]; } \
        l += ps; \
        bf16x8 pb[2]; \
_Pragma("unroll") \
        for (int s = 0; s < 2; ++s) { \
          const u32x4 u = {pack_bf2(v[8 * s + 0], v[8 * s + 1]), pack_bf2(v[8 * s + 2], v[8 * s + 3]), \
                           pack_bf2(v[8 * s + 4], v[8 * s + 5]), pack_bf2(v[8 * s + 6], v[8 * s + 7])}; \
          pb[s] = __builtin_bit_cast(bf16x8, u); \
        } \
_Pragma("unroll") \
        for (int dt = 0; dt < DVB; ++dt) \
_Pragma("unroll") \
          for (int s = 0; s < 2; ++s) { \
            const bf16x8 va = *(const bf16x8*)(st + vro + dt * 4096 + (((4 * sub + 2 * s + h) ^ vsw) << 4)); \
            o[dt] = MFMA32(va, pb[s], o[dt]); \
          } \
      } \
    } \
    __builtin_amdgcn_sched_barrier(0); \
    asm volatile("" ::: "memory"); \
    { \
      char* sn = smem + ((kt + 1) & 1) * STG; \
_Pragma("unroll") \
      for (int i = 0; i < 2; ++i) *(u32x4*)(sn + kwo + i * 8192) = RW[i]; \
_Pragma("unroll") \
      for (int i = 0; i < DVB / 2; ++i) *(u32x4*)(sn + vwo + i * 8192) = RVW[i]; \
    } \
    __syncthreads(); \
  }
  if constexpr (DVB == 4) {
  for (int kt2 = 0; kt2 < nkt; kt2 += 2) {
    ATT_TILE(kt2, rkB, rvB, rk, rv)
    if (kt2 + 1 < nkt) ATT_TILE(kt2 + 1, rk, rv, rkB, rvB)
  }
  } else {
  for (int kt = 0; kt < nkt; ++kt) {
    const int k0 = kt << 6;
    char* st = smem + (kt & 1) * STG;
    {
      const int kn = (kt + 1 < nkt) ? k0 + 64 : k0;
      const size_t kbo = (size_t)kn * (size_t)a.ldk * 2u, vbo = (size_t)kn * 2u;
#pragma unroll
      for (int i = 0; i < 2; ++i) rk[i] = *(const u32x4*)(Kb + (kbo + i * kst) + kvo);
#pragma unroll
      for (int i = 0; i < DVB / 2; ++i) rv[i] = *(const u32x4*)(Vb + (vbo + i * vst) + vvo);
    }
    asm volatile("" ::: "memory");
    __builtin_amdgcn_sched_barrier(0);
#pragma unroll
    for (int sub = 0; sub < 2; ++sub) {
      const int ks0 = k0 + 32 * sub;
      if (ks0 <= q0) {
        f32x16 sa;
#pragma unroll
        for (int e = 0; e < 16; ++e) sa[e] = 0.f;
#pragma unroll
        for (int s = 0; s < 8; ++s) {
          const bf16x8 kf = *(const bf16x8*)(st + kro + sub * 8192 + (((2 * s + h) ^ ksw) << 4));
          sa = MFMA32(kf, qf[s], sa);
        }
        float v[16];
        if (MODE == 0) {
#pragma unroll
          for (int c = 0; c < 2; ++c) {
            const float4 kb0 = *(const float4*)(a.kbias + ks0 + 16 * c + 8 * h);
            const float4 kb1 = *(const float4*)(a.kbias + ks0 + 16 * c + 8 * h + 4);
            v[8 * c + 0] = sa[8 * c + 0] - kb0.x * LOG2E; v[8 * c + 1] = sa[8 * c + 1] - kb0.y * LOG2E;
            v[8 * c + 2] = sa[8 * c + 2] - kb0.z * LOG2E; v[8 * c + 3] = sa[8 * c + 3] - kb0.w * LOG2E;
            v[8 * c + 4] = sa[8 * c + 4] - kb1.x * LOG2E; v[8 * c + 5] = sa[8 * c + 5] - kb1.y * LOG2E;
            v[8 * c + 6] = sa[8 * c + 6] - kb1.z * LOG2E; v[8 * c + 7] = sa[8 * c + 7] - kb1.w * LOG2E;
          }
          if (ks0 == q0) {
#pragma unroll
            for (int e = 0; e < 16; ++e) if ((e & 7) + 8 * h + 16 * (e >> 3) > r) v[e] = -INFINITY;
          }
        } else {
          const float* tp = tbl + (q0 - ks0) + r + 32 - 8 * h - 23;
#pragma unroll
          for (int e = 0; e < 16; ++e) v[e] = sa[e] + tp[23 - ((e & 7) + 16 * (e >> 3))];
        }
        float mx = v[0];
#pragma unroll
        for (int e = 1; e < 16; ++e) mx = fmaxf(mx, v[e]);
        mx = xhalf_max(mx);
        if (__ballot(mx > m + 8.f) != 0ull) {
          const float mn = fmaxf(m, mx);
          const float alpha = __builtin_amdgcn_exp2f(m - mn);
          m = mn;
          l *= alpha;
#pragma unroll
          for (int dt = 0; dt < DVB; ++dt)
#pragma unroll
            for (int e = 0; e < 16; ++e) o[dt][e] *= alpha;
        }
        float ps = 0.f;
#pragma unroll
        for (int e = 0; e < 16; ++e) { v[e] = __builtin_amdgcn_exp2f(v[e] - m); ps += v[e]; }
        l += ps;
        bf16x8 pb[2];
#pragma unroll
        for (int s = 0; s < 2; ++s) {
          const u32x4 u = {pack_bf2(v[8 * s + 0], v[8 * s + 1]), pack_bf2(v[8 * s + 2], v[8 * s + 3]),
                           pack_bf2(v[8 * s + 4], v[8 * s + 5]), pack_bf2(v[8 * s + 6], v[8 * s + 7])};
          pb[s] = __builtin_bit_cast(bf16x8, u);
        }
#pragma unroll
        for (int dt = 0; dt < DVB; ++dt)
#pragma unroll
          for (int s = 0; s < 2; ++s) {
            const bf16x8 va = *(const bf16x8*)(st + vro + dt * 4096 + (((4 * sub + 2 * s + h) ^ vsw) << 4));
            o[dt] = MFMA32(va, pb[s], o[dt]);
          }
      }
    }
    __builtin_amdgcn_sched_barrier(0);
    asm volatile("" ::: "memory");
    {
      char* sn = smem + ((kt + 1) & 1) * STG;
#pragma unroll
      for (int i = 0; i < 2; ++i) *(u32x4*)(sn + kwo + i * 8192) = rk[i];
#pragma unroll
      for (int i = 0; i < DVB / 2; ++i) *(u32x4*)(sn + vwo + i * 8192) = rv[i];
    }
    __syncthreads();
  }
  }
#undef ATT_TILE
  l_out = xhalf_sum(l);
}

template <int N = 4, int B0 = 0>
DI void attn_store_bf16(const f32x16 (&o)[N], float linv, bf16_t* out_row  , int ldo) {
  const int lane = TID() & 63, r = lane & 31, h = lane >> 5;
  bf16_t* op = out_row + (size_t)r * ldo + 4 * h;
#pragma unroll
  for (int dt = 0; dt < 4; ++dt)
#pragma unroll
    for (int c = 0; c < 4; ++c)
      *(uint2*)(op + 32 * dt + 8 * c) = make_uint2(pack_bf2(o[B0 + dt][4 * c] * linv, o[B0 + dt][4 * c + 1] * linv),
                                                    pack_bf2(o[B0 + dt][4 * c + 2] * linv, o[B0 + dt][4 * c + 3] * linv));
}
template <int N, int B0>
DI void attn_store_f32(const f32x16 (&o)[N], float linv, float* out_row, int ldo) {
  const int lane = TID() & 63, r = lane & 31, h = lane >> 5;
  float* op = out_row + (size_t)r * ldo + 4 * h;
#pragma unroll
  for (int dt = 0; dt < 4; ++dt)
#pragma unroll
    for (int c = 0; c < 4; ++c)
      *(float4*)(op + 32 * dt + 8 * c) = make_float4(o[B0 + dt][4 * c] * linv, o[B0 + dt][4 * c + 1] * linv, o[B0 + dt][4 * c + 2] * linv, o[B0 + dt][4 * c + 3] * linv);
}

DI int t5_bucket(int n) {
  if (n < 16) return n;
  int lg = 16 + (int)(logf((float)n / 16.f) / 4.852030263919617f * 16.f);
  return lg < 31 ? lg : 31;
}

DI void phase_attn_even(const Params& p, char* smem) {
  const int tid = RTID(), wave = __builtin_amdgcn_readfirstlane(tid >> 6), bid = blockIdx.x, G = gridDim.x;
  const bf16_t* QK = (const bf16_t*)(p.ws + WS_QK);
  const bf16_t* VT = (const bf16_t*)(p.ws + WS_VT);
  bf16_t* ATT = (bf16_t*)(p.ws + WS_ATT);
  bf16_t* PCS = (bf16_t*)(p.ws + WS_SC);
  float* tbl = (float*)(smem + 98304);
  int cur_head = -1;
  for (int rnd = 0; rnd * G < 1024; ++rnd) {
    int item = rnd * G + ((rnd & 1) ? G - 1 - bid : bid);
    if (G == 256) {
      const int rc = rnd * 4 + (bid >> 6);
      const int gq = (int)((0x6767455432231010ull >> (4 * rc)) & 15ull), dq = (0x3CC3 >> rc) & 1;
      item = gq * 128 + (dq ? 0 : 64) + (bid & 63);
    }
    if (item >= 1024) break;
    const int g = item >> 7; int rem = item & 127;
    const int qb = 7 - g;
    const int q0b = qb * 256, q0 = q0b + 32 * wave;
    __syncthreads();
    if (rem >= 64) {
      rem -= 64;
      const int b = rem >> 3, hh = rem & 7;
      AttnPtrs a;
      a.Q = QK + (size_t)b * S_ * 4096 + hh * 128; a.ldq = 4096;
      a.K = a.Q + 1024; a.ldk = 4096;
      a.Vt = VT + (size_t)(hh * 128) * T_ + b * S_; a.ldv = T_;
      a.kbias = (const float*)(p.ws + WS_FCUM) + (size_t)(b * 8 + hh) * S_;
      f32x16 o[4]; float l;
      attn_block<0, 4>(a, q0b, smem, nullptr, o, l);
      attn_store_bf16(o, 1.f / l, ATT + (size_t)(b * S_ + q0) * D_ + hh * 128, D_);
    } else {
      const int b = rem >> 3, hh = (rem >> 1) & 3, mm = rem & 1;
      if (hh != cur_head) {
        for (int e = tid; e < 2080; e += RTHREADS) {
          const int dist = e - 32;
          tbl[e] = dist >= 0 ? p.rel_bias[t5_bucket(dist) * 16 + hh] * LOG2E : -INFINITY;
        }
        cur_head = hh;
      }
      AttnPtrs a;
      a.Q = QK + (size_t)b * S_ * 4096 + 2048 + hh * 256 + mm * 128; a.ldq = 4096;
      a.K = a.Q + 1024; a.ldk = 4096;
      a.Vt = VT + (size_t)(1024 + hh * 256) * T_ + b * S_; a.ldv = T_;
      a.kbias = nullptr;
      f32x16 o[8]; float l;
      attn_block<1, 8>(a, q0b, smem, tbl, o, l);
      const float linv = 1.f / l;
      attn_store_bf16<8, 0>(o, linv, PCS + (((size_t)(mm * 2 + 0) * T_ + (size_t)(b * S_ + q0)) * 4 + hh) * 128, 512);
      attn_store_bf16<8, 4>(o, linv, PCS + (((size_t)(mm * 2 + 1) * T_ + (size_t)(b * S_ + q0)) * 4 + hh) * 128, 512);
    }
  }
}

DI void phase_diff_combine(const Params& p) {
  const int lane = TID() & 63;
  const int gw = __builtin_amdgcn_readfirstlane((VBID() * NTHREADS + TID()) >> 6), nw = (VGRID() * NTHREADS) >> 6;
  const bf16_t* PCS = (const bf16_t*)(p.ws + WS_SC);
  const bf16_t* ATT = (const bf16_t*)(p.ws + WS_ATT);
  unsigned char* A8 = (unsigned char*)(p.ws + WS_ATT8);
  float* A8S = (float*)(p.ws + WS_ATT8 + 32 * MiB);
  const float lam = ((const float*)(p.ws + WS_MISC))[0];
  const int hh = lane >> 4, seg = lane & 15, half = seg >> 3, off = (seg & 7) * 16;
  float sg[16];
#pragma unroll
  for (int i = 0; i < 4; ++i) { const float4 g = *(const float4*)(p.even_diff_subln_gain + seg * 16 + 4 * i); sg[4 * i] = g.x; sg[4 * i + 1] = g.y; sg[4 * i + 2] = g.z; sg[4 * i + 3] = g.w; }
  for (int t = gw; t < T_; t += nw) {
    const bf16_t* p0 = PCS + (((size_t)(0 + half) * T_ + t) * 4 + hh) * 128 + off;
    const bf16_t* p1 = PCS + (((size_t)(2 + half) * T_ + t) * 4 + hh) * 128 + off;
    const u32x4 a0 = *(const u32x4*)p0, a1 = *(const u32x4*)(p0 + 8), b0 = *(const u32x4*)p1, b1 = *(const u32x4*)(p1 + 8);
    const u32x4 f0 = *(const u32x4*)(ATT + (size_t)t * D_ + lane * 16), f1 = *(const u32x4*)(ATT + (size_t)t * D_ + lane * 16 + 8);
    float v[16], f[16];
    float ss = 0.f;
#pragma unroll
    for (int i = 0; i < 4; ++i) {
      v[2 * i] = bf_lo(a0[i]) - lam * bf_lo(b0[i]); v[2 * i + 1] = bf_hi(a0[i]) - lam * bf_hi(b0[i]);
      v[8 + 2 * i] = bf_lo(a1[i]) - lam * bf_lo(b1[i]); v[8 + 2 * i + 1] = bf_hi(a1[i]) - lam * bf_hi(b1[i]);
      f[2 * i] = bf_lo(f0[i]); f[2 * i + 1] = bf_hi(f0[i]); f[8 + 2 * i] = bf_lo(f1[i]); f[8 + 2 * i + 1] = bf_hi(f1[i]);
    }
#pragma unroll
    for (int i = 0; i < 16; ++i) ss += v[i] * v[i];
#pragma unroll
    for (int o = 1; o < 16; o <<= 1) ss += __shfl_xor(ss, o);
    const float rstd = rsqrtf(ss * (1.f / 256.f) + 1e-6f) * 0.8f;
    float am = 0.f;
#pragma unroll
    for (int i = 0; i < 16; ++i) { v[i] = v[i] * rstd * sg[i]; am = fmaxf(am, fmaxf(fabsf(v[i]), fabsf(f[i]))); }
    am = wave_max(am);
    const float qs = am > 0.f ? 127.f / am : 1.f;
    u32x4 qf, qd;
#pragma unroll
    for (int i = 0; i < 4; ++i) { qf[i] = pack_i8x4(f[4 * i] * qs, f[4 * i + 1] * qs, f[4 * i + 2] * qs, f[4 * i + 3] * qs); qd[i] = pack_i8x4(v[4 * i] * qs, v[4 * i + 1] * qs, v[4 * i + 2] * qs, v[4 * i + 3] * qs); }
    *(u32x4*)(A8 + (size_t)t * D_ + lane * 16) = qf;
    *(u32x4*)(A8 + (size_t)t * D_ + 1024 + lane * 16) = qd;
    if (lane == 0) A8S[t] = am > 0.f ? am / 127.f : 1.f;
  }
}

DI void quant_att(const Params& p) {
  const int lane = TID() & 63;
  const int gw = __builtin_amdgcn_readfirstlane((VBID() * NTHREADS + TID()) >> 6), nw = (VGRID() * NTHREADS) >> 6;
  const bf16_t* ATT = (const bf16_t*)(p.ws + WS_ATT);
  unsigned char* A8 = (unsigned char*)(p.ws + WS_ATT8);
  float* A8S = (float*)(p.ws + WS_ATT8 + 32 * MiB);
  for (int t = gw; t < T_; t += nw) {
    const bf16_t* src = ATT + (size_t)t * D_ + lane * 32;
    u32x4 w[4];
#pragma unroll
    for (int i = 0; i < 4; ++i) w[i] = *(const u32x4*)(src + 8 * i);
    float f[32];
    float am = 0.f;
#pragma unroll
    for (int i = 0; i < 4; ++i)
#pragma unroll
      for (int j = 0; j < 4; ++j) { f[8 * i + 2 * j] = bf_lo(w[i][j]); f[8 * i + 2 * j + 1] = bf_hi(w[i][j]); am = fmaxf(am, fmaxf(fabsf(f[8 * i + 2 * j]), fabsf(f[8 * i + 2 * j + 1]))); }
    am = wave_max(am);
    const float qs = am > 0.f ? 127.f / am : 1.f;
    u32x4 q0, q1;
#pragma unroll
    for (int i = 0; i < 4; ++i) { q0[i] = pack_i8x4(f[4 * i] * qs, f[4 * i + 1] * qs, f[4 * i + 2] * qs, f[4 * i + 3] * qs); q1[i] = pack_i8x4(f[16 + 4 * i] * qs, f[16 + 4 * i + 1] * qs, f[16 + 4 * i + 2] * qs, f[16 + 4 * i + 3] * qs); }
    unsigned char* dst = A8 + (size_t)t * D_ + lane * 32;
    *(u32x4*)dst = q0; *(u32x4*)(dst + 16) = q1;
    if (lane == 0) A8S[t] = am > 0.f ? am / 127.f : 1.f;
  }
}

DI void phase_attn_odd(const Params& p, char* smem) {
  const int tid = RTID(), wave = __builtin_amdgcn_readfirstlane(tid >> 6), bid = blockIdx.x, G = gridDim.x;
  const bf16_t* QK = (const bf16_t*)(p.ws + WS_QK);
  const bf16_t* VT = (const bf16_t*)(p.ws + WS_VT);
  bf16_t* ATT = (bf16_t*)(p.ws + WS_ATT);
  float* tbl = (float*)(smem + 98304);
  int cur_head = -1;
  for (int rnd = 0; rnd * G < 1024; ++rnd) {
    const int item = rnd * G + ((rnd & 1) ? G - 1 - bid : bid);
    if (item >= 1024) break;
    const int g = item >> 7, rem = item & 127;
    const int qb = 7 - g, b = rem >> 4, hd = rem & 15;
    __syncthreads();
    if (hd != cur_head) {
      for (int e = tid; e < 2080; e += RTHREADS) {
        const int dist = e - 32;
        float val = -INFINITY;
        if (dist >= 0) {
          int cnt = 0;
          if (dist <= 128) cnt += 1;
          if (dist <= 512 && (dist & 3) == 0) cnt += 1;
          if ((dist & 15) == 0) cnt += 1;
          if (cnt > 0) val = (p.rel_bias[t5_bucket(dist) * 16 + hd] + __logf((float)cnt)) * LOG2E;
        }
        tbl[e] = val;
      }
      cur_head = hd;
    }
    const int q0b = qb * 256, q0 = q0b + 32 * wave;
    AttnPtrs a;
    a.Q = QK + (size_t)b * S_ * 4096 + hd * 128; a.ldq = 4096;
    a.K = a.Q + 2048; a.ldk = 4096;
    a.Vt = VT + (size_t)(hd * 128) * T_ + b * S_; a.ldv = T_;
    a.kbias = nullptr;
    f32x16 o[4]; float l;
    attn_block<1, 4>(a, q0b, smem, tbl, o, l);
    attn_store_bf16(o, 1.f / l, ATT + (size_t)(b * S_ + q0) * D_ + hd * 128, D_);
  }
}

DI float gelu_erf(float x) { return 0.5f * x * (1.f + erff(x * 0.7071067811865476f)); }

DI void ins16(float (&L)[16], float x) {
#pragma unroll
  for (int k = 15; k >= 1; --k) L[k] = __builtin_amdgcn_fmed3f(L[k - 1], L[k], x);
  L[0] = __builtin_amdgcn_fmed3f(__builtin_inff(), L[0], x);
}
DI float f_and_or(float v, unsigned mask, unsigned orv) { return __uint_as_float((__float_as_uint(v) & mask) | orv); }

DI void phase_peer_retrieve(const Params& p, char* smem) {
  const int tid = TID(), lane = tid & 63, wave = __builtin_amdgcn_readfirstlane(tid >> 6);
  const int gw = __builtin_amdgcn_readfirstlane((VBID() * NTHREADS + tid) >> 6), nw = (VGRID() * NTHREADS) >> 6;
  unsigned* wbuf = (unsigned*)(smem + wave * 9216);
  const bf16_t* SC = (const bf16_t*)(p.ws + WS_SC);
  int* IDX = (int*)(p.ws + WS_IDX);
  float* GATE = (float*)(p.ws + WS_GATE);
  const float NINF = -__builtin_inff();
  for (int it = gw; it < T_ / 8; it += nw) {
    const bf16_t* gsrc = SC + (size_t)it * (8 * 2048) + (lane >> 2) * 256 + (lane & 3) * 8;
    unsigned* wdst = wbuf + (lane >> 2) * 20 + (lane & 3) * 4;
    const unsigned* wsrc = wbuf + lane * 20;
    u32x4 stg[4];
#define PR_LOAD(CH) _Pragma("unroll") for (int i = 0; i < 4; ++i) stg[i] = *(const u32x4*)(gsrc + i * (16 * 256) + ((CH) >> 2) * 128 + ((CH) & 3) * 32);
    PR_LOAD(0)
    float A[16], B[16];
#pragma unroll
    for (int hf = 0; hf < 2; ++hf) {
      float L[16];
#pragma unroll
      for (int k = 0; k < 16; ++k) L[k] = NINF;
#pragma unroll 1
      for (int c = 0; c < 4; ++c) {
#pragma unroll
        for (int i = 0; i < 4; ++i) *(u32x4*)(wdst + i * (16 * 20)) = stg[i];
        { const int cn = hf * 4 + c + 1 < 7 ? hf * 4 + c + 1 : 7; PR_LOAD(cn) }
        u32x4 v[4];
#pragma unroll
        for (int k = 0; k < 4; ++k) v[k] = *(const u32x4*)(wsrc + 4 * k);
#pragma unroll
        for (int k = 0; k < 4; ++k)
#pragma unroll
          for (int e = 0; e < 4; ++e) {
            const unsigned w = v[k][e], id0 = (unsigned)(c * 32 + 8 * k + 2 * e);
            ins16(L, __uint_as_float((w << 16) | id0));
            ins16(L, __uint_as_float((w & 0xFFFF0000u) | (id0 + 1u)));
          }
      }
#pragma unroll
      for (int k = 0; k < 16; ++k) { if (hf == 0) A[k] = L[k]; else B[k] = L[k]; }
    }
#undef PR_LOAD
    unsigned* lut = wbuf + lane * 33;
#pragma unroll
    for (int k = 0; k < 16; ++k) {
      const unsigned ua = __float_as_uint(A[k]), ub = __float_as_uint(B[k]);
      lut[k] = (ua & 0x7Fu) << 7; lut[16 + k] = ub & 0x7Fu;
      A[k] = __uint_as_float(ua & 0xFFFFFF80u); B[k] = __uint_as_float(ub & 0xFFFFFF80u);
    }
    float C[16];
#pragma unroll
    for (int k = 0; k < 16; ++k) C[k] = NINF;
#pragma unroll
    for (int i = 0; i < 16; ++i)
#pragma unroll
      for (int j = 0; j < 16; ++j)
        if ((i + 1) * (j + 1) <= 16) ins16(C, f_and_or(A[i] + B[j], 0xFFFFFF00u, (unsigned)(i * 16 + j)));
    float ev[16], es = 0.f;
    int ids[16];
    const float mx = __uint_as_float(__float_as_uint(C[0]) & 0xFFFFFF00u);
#pragma unroll
    for (int k = 0; k < 16; ++k) {
      const unsigned uc = __float_as_uint(C[k]);
      ev[k] = __expf(__uint_as_float(uc & 0xFFFFFF00u) - mx);
      es += ev[k];
      ids[k] = (int)(lut[(uc >> 4) & 15u] + lut[16 + (uc & 15u)]);
    }
    const float inv = 1.f / es;
    int* ip = IDX + (size_t)it * (8 * 128) + lane * 16;
    float* gp = GATE + (size_t)it * (8 * 128) + lane * 16;
#pragma unroll
    for (int q = 0; q < 4; ++q) {
      *(int4*)(ip + 4 * q) = make_int4(ids[4 * q], ids[4 * q + 1], ids[4 * q + 2], ids[4 * q + 3]);
      *(float4*)(gp + 4 * q) = make_float4(ev[4 * q] * inv, ev[4 * q + 1] * inv, ev[4 * q + 2] * inv, ev[4 * q + 3] * inv);
    }
  }
}

DI unsigned peer_ticket_issue(unsigned* cnt) {
  unsigned v = 0;
  if ((TID() & 63) == 0) v = __hip_atomic_fetch_add(cnt, 1u, __ATOMIC_RELAXED, __HIP_MEMORY_SCOPE_AGENT);
  return v;
}
DI float oct_sum(float v) {
  v += __builtin_bit_cast(float, __builtin_amdgcn_update_dpp(0, __builtin_bit_cast(int, v), 0xB1, 0xF, 0xF, true));
  v += __builtin_bit_cast(float, __builtin_amdgcn_update_dpp(0, __builtin_bit_cast(int, v), 0x4E, 0xF, 0xF, true));
  v += __builtin_bit_cast(float, __builtin_amdgcn_update_dpp(0, __builtin_bit_cast(int, v), 0x141, 0xF, 0xF, true));
  return v;
}

DI unsigned swar_add8(unsigned x) { return ((x & 0x7F7F7F7Fu) + 0x08080808u) ^ (x & 0x80808080u); }
DI void phase_peer_dots(const Params& p, int layer, char* smem_all) {
  const int rtid = RTID(), lane = rtid & 63, rwave = __builtin_amdgcn_readfirstlane(rtid >> 6);
  const int g = lane >> 3, j = lane & 7;
  int* lidx_all = (int*)(smem_all + rwave * 8192);
  const unsigned char* H8 = (const unsigned char*)(p.ws + WS_H8);
  const int* IDX = (const int*)(p.ws + WS_IDX);
  float* PD = (float*)(p.ws + WS_PD);
  const unsigned char* PU = (const unsigned char*)(p.ws + WS_PEERU) + (size_t)layer * (8 * NEXP * 128);
  const float* SC4 = (const float*)(p.ws + WS_USC4) + (size_t)layer * (8 * NEXP);
  unsigned* tick = (unsigned*)(p.ws + WS_TICKETS) + (size_t)(layer * 2 + 0) * 16 * 16;
  const int xcc = xcc_id() & 7;
#pragma unroll 1
  for (int so = 0; so < 8; ++so) {
    const int s = (xcc + so) & 7;
    unsigned tv = peer_ticket_issue(tick + s * 16);
    for (;;) {
      const int c = __builtin_amdgcn_readfirstlane((int)tv);
      if (c >= T_ / 16) break;
      tv = peer_ticket_issue(tick + s * 16);
#pragma unroll
      for (int gi = 0; gi < 2; ++gi) {
        const int* ip = IDX + (size_t)(c * 16 + gi * 8 + g) * 128 + 16 * j;
#pragma unroll
        for (int i = 0; i < 4; ++i) *(uint4*)(lidx_all + gi * 1024 + g * 128 + 16 * j + 4 * i) = *(const uint4*)(ip + 4 * i);
      }
#pragma unroll 1
      for (int gi = 0; gi < 2; ++gi) {
      const int t0 = c * 16 + gi * 8;
      const int* lidx = lidx_all + gi * 1024;
      unsigned xl[4], xh[4];
      {
        const unsigned char* hp = H8 + (size_t)(t0 + g) * D_ + s * 256 + 32 * j;
        const u32x4 h0 = *(const u32x4*)hp, h1 = *(const u32x4*)(hp + 16);
        const unsigned d[8] = {h0.x, h0.y, h0.z, h0.w, h1.x, h1.y, h1.z, h1.w};
#pragma unroll
        for (int m = 0; m < 4; ++m) {
          xl[m] = (d[2 * m] & 0x0F0F0F0Fu) | ((d[2 * m + 1] & 0x0F0F0F0Fu) << 4);
          xh[m] = ((swar_add8(d[2 * m]) >> 4) & 0x0F0F0F0Fu) | (swar_add8(d[2 * m + 1]) & 0xF0F0F0F0u);
        }
      }
      const unsigned char* ub = PU + (size_t)s * (NEXP * 128);
      const float* scs = SC4 + (size_t)s * NEXP;
      float* pd = PD + ((size_t)s * T_ + t0 + g) * 128;
      const bool b2_ = (lane & 4) != 0, b1_ = (lane & 2) != 0, b0_ = (lane & 1) != 0;
      u32x4 ra[8], rb[8], rc[8];
      float sa, sb, sc;
#define PD_LOAD(R, S, KB) { _Pragma("unroll") for (int q = 0; q < 8; ++q) { const int id = lidx[g * 128 + (KB) + q]; R[q] = *(const u32x4*)(ub + (unsigned)(id * 128 + 16 * j)); } \
                            S = scs[lidx[g * 128 + (KB) + j]]; }
#define DPPI(X, CTRL) __builtin_amdgcn_update_dpp(0, (X), (CTRL), 0xF, 0xF, true)
#define PD_COMP(R, S, KB)                                                                         \
      {                                                                                           \
        int pp[8];                                                                                \
        _Pragma("unroll") for (int q = 0; q < 8; ++q) {                                           \
          int al = __builtin_amdgcn_sdot8((int)R[q].x, (int)xl[0], 0, false);                     \
          int ah = __builtin_amdgcn_sdot8((int)R[q].x, (int)xh[0], 0, false);                     \
          al = __builtin_amdgcn_sdot8((int)R[q].y, (int)xl[1], al, false);                        \
          ah = __builtin_amdgcn_sdot8((int)R[q].y, (int)xh[1], ah, false);                        \
          al = __builtin_amdgcn_sdot8((int)R[q].z, (int)xl[2], al, false);                        \
          ah = __builtin_amdgcn_sdot8((int)R[q].z, (int)xh[2], ah, false);                        \
          al = __builtin_amdgcn_sdot8((int)R[q].w, (int)xl[3], al, false);                        \
          ah = __builtin_amdgcn_sdot8((int)R[q].w, (int)xh[3], ah, false);                        \
          pp[q] = al + 16 * ah;                                                                   \
        }                                                                                         \
          \
        int q4[4], q2[2];                                                                         \
        _Pragma("unroll") for (int i = 0; i < 4; ++i) {                                           \
          const int keep = b2_ ? pp[4 + i] : pp[i], send = b2_ ? pp[i] : pp[4 + i];               \
          q4[i] = keep + DPPI(send, 0x141);                   \
        }                                                                                         \
        _Pragma("unroll") for (int i = 0; i < 2; ++i) {                                           \
          const int keep = b1_ ? q4[2 + i] : q4[i], send = b1_ ? q4[i] : q4[2 + i];               \
          q2[i] = keep + DPPI(send, 0x4E);                      \
        }                                                                                         \
        {                                                                                         \
          const int keep = b0_ ? q2[1] : q2[0], send = b0_ ? q2[0] : q2[1];                       \
          pd[(KB) + j] = (float)(keep + DPPI(send, 0xB1)) * S;     \
        }                                                                                         \
        __builtin_amdgcn_sched_barrier(0);                                                        \
      }
      PD_LOAD(ra, sa, 0)
      PD_LOAD(rb, sb, 8)
#pragma unroll 1
      for (int kb = 0; kb < 120; kb += 24) {
        PD_LOAD(rc, sc, kb + 16)
        PD_COMP(ra, sa, kb)
        PD_LOAD(ra, sa, kb + 24)
        PD_COMP(rb, sb, kb + 8)
        { const int kl = kb + 32 < 120 ? kb + 32 : 120; PD_LOAD(rb, sb, kl) }
        PD_COMP(rc, sc, kb + 16)
      }
      PD_COMP(ra, sa, 120)
#undef PD_LOAD
#undef PD_COMP
#undef DPPI
      }
    }
  }
}

DI void phase_peer_act(const Params& p, int layer) {
  const int rtid = RTID(), lane = rtid & 63;
  const int gw = __builtin_amdgcn_readfirstlane((int)((blockIdx.x * RTHREADS + rtid) >> 6)), nw = (int)(gridDim.x * RTHREADS) >> 6;
  const float* PD = (const float*)(p.ws + WS_PD);
  const int* IDX = (const int*)(p.ws + WS_IDX);
  const float* GATE = (const float*)(p.ws + WS_GATE);
  const float* HS = (const float*)(p.ws + WS_HS);
  unsigned short* ACTQ = (unsigned short*)(p.ws + WS_ACT);
  float* ACTS = (float*)(p.ws + WS_ACT + 4 * MiB);
  const float* VSC = (const float*)(p.ws + WS_PEERV) + (size_t)(2 + layer) * NEXP;
  for (int t = gw; t < T_; t += nw) {
    const size_t e = (size_t)t * 128 + 2 * lane;
    float2 a = make_float2(0.f, 0.f);
#pragma unroll
    for (int s2 = 0; s2 < 8; ++s2) { const float2 q = *(const float2*)(PD + (size_t)s2 * T_ * 128 + e); a.x += q.x; a.y += q.y; }
    const int2 id = *(const int2*)(IDX + e);
    const float2 gt = *(const float2*)(GATE + e);
    const float hs = HS[t];
    const float v0 = gt.x * gelu_erf(a.x * hs) * VSC[id.x], v1 = gt.y * gelu_erf(a.y * hs) * VSC[id.y];
    const float am = wave_max(fmaxf(fabsf(v0), fabsf(v1)));
    const float qs = am > 0.f ? 127.f / am : 1.f;
    const int q0 = (int)rintf(v0 * qs), q1 = (int)rintf(v1 * qs);
    ACTQ[(size_t)t * 64 + lane] = (unsigned short)((q0 & 255) | ((q1 & 255) << 8));
    if (lane == 0) ACTS[t] = am > 0.f ? am / 127.f : 1.f;
  }
}

DI void phase_peer_values(const Params& p, int layer, const float* gate2, char* smem_all) {
  const int rtid = RTID(), lane = rtid & 63, rwave = __builtin_amdgcn_readfirstlane(rtid >> 6);
  const int g = lane >> 3, j = lane & 7;
  int* lidx_all = (int*)(smem_all + rwave * 16384);
  unsigned* lact_all = (unsigned*)(smem_all + rwave * 16384 + 4096);
  const int* IDX = (const int*)(p.ws + WS_IDX);
  const unsigned* ACTQ = (const unsigned*)(p.ws + WS_ACT);
  const float* ACTS = (const float*)(p.ws + WS_ACT + 4 * MiB);
  const unsigned char* PV = (const unsigned char*)(p.ws + WS_PEERV8) + (size_t)layer * NEXP * D_;
  unsigned* tick = (unsigned*)(p.ws + WS_TICKETS) + (size_t)(layer * 2 + 1) * 16 * 16;
  const int xcc = xcc_id() & 7;
#pragma unroll 1
  for (int so = 0; so < 16; ++so) {
    const int s = ((xcc + (so >> 1)) & 7) + 8 * (so & 1);
    unsigned tv = peer_ticket_issue(tick + s * 16);
    for (;;) {
      const int c = __builtin_amdgcn_readfirstlane((int)tv);
      if (c >= T_ / 16) break;
      tv = peer_ticket_issue(tick + s * 16);
#pragma unroll
      for (int gi = 0; gi < 2; ++gi) {
        const int* ip = IDX + (size_t)(c * 16 + gi * 8 + g) * 128 + 16 * j;
#pragma unroll
        for (int i = 0; i < 4; ++i) *(uint4*)(lidx_all + gi * 2048 + g * 128 + 16 * j + 4 * i) = *(const uint4*)(ip + 4 * i);
        *(uint4*)(lact_all + gi * 2048 + g * 32 + 4 * j) = *(const uint4*)(ACTQ + (size_t)(c * 16 + gi * 8 + g) * 32 + 4 * j);
      }
#pragma unroll 1
      for (int gi = 0; gi < 2; ++gi) {
      const int t0 = c * 16 + gi * 8;
      const int* lidx = lidx_all + gi * 2048;
      const unsigned* lact = lact_all + gi * 2048;
      const unsigned char* vb = PV + (size_t)s * (NEXP * 128);
      int y[16];
#pragma unroll
      for (int i = 0; i < 16; ++i) y[i] = 0;
      u32x4 ra[8], rb[8];
      const int tq = t0 + g;
      bf16_t* rrow = (bf16_t*)(p.ws + WS_R16) + (size_t)tq * D_ + s * 128 + 16 * j;
      float* orow = p.out + (size_t)tq * D_ + s * 128 + 16 * j;
      const float* grow = gate2 + (size_t)(tq >> 11) * 12288 + s * 128 + 16 * j;
      u32x4 ia0 = *(const u32x4*)(lidx + g * 128), ia1 = *(const u32x4*)(lidx + g * 128 + 4);
#define PV_LOAD(R, KBN) { const unsigned ids_[8] = {ia0.x, ia0.y, ia0.z, ia0.w, ia1.x, ia1.y, ia1.z, ia1.w};                         \
        _Pragma("unroll") for (int q = 0; q < 8; ++q) R[q] = *(const u32x4*)(vb + (ids_[q] * 128u + 16u * (unsigned)j));              \
        ia0 = *(const u32x4*)(lidx + g * 128 + (KBN)); ia1 = *(const u32x4*)(lidx + g * 128 + (KBN) + 4); }
#define PV_QUAD(W0, W1, W2, W3, AQ, YB) {                                                                                             \
        const unsigned t0_ = __builtin_amdgcn_perm((W1), (W0), 0x05010400u), t1_ = __builtin_amdgcn_perm((W1), (W0), 0x07030602u);    \
        const unsigned t2_ = __builtin_amdgcn_perm((W3), (W2), 0x05010400u), t3_ = __builtin_amdgcn_perm((W3), (W2), 0x07030602u);    \
        y[(YB) + 0] = __builtin_amdgcn_sdot4((int)__builtin_amdgcn_perm(t2_, t0_, 0x05040100u), (int)(AQ), y[(YB) + 0], false);       \
        y[(YB) + 1] = __builtin_amdgcn_sdot4((int)__builtin_amdgcn_perm(t2_, t0_, 0x07060302u), (int)(AQ), y[(YB) + 1], false);       \
        y[(YB) + 2] = __builtin_amdgcn_sdot4((int)__builtin_amdgcn_perm(t3_, t1_, 0x05040100u), (int)(AQ), y[(YB) + 2], false);       \
        y[(YB) + 3] = __builtin_amdgcn_sdot4((int)__builtin_amdgcn_perm(t3_, t1_, 0x07060302u), (int)(AQ), y[(YB) + 3], false); }
#define PV_COMP(R, KB)                                                                            \
      { const unsigned aq0 = lact[g * 32 + ((KB) >> 2)], aq1 = lact[g * 32 + ((KB) >> 2) + 1];    \
        PV_QUAD(R[0].x, R[1].x, R[2].x, R[3].x, aq0, 0)  PV_QUAD(R[0].y, R[1].y, R[2].y, R[3].y, aq0, 4)   \
        PV_QUAD(R[0].z, R[1].z, R[2].z, R[3].z, aq0, 8)  PV_QUAD(R[0].w, R[1].w, R[2].w, R[3].w, aq0, 12)  \
        __builtin_amdgcn_sched_barrier(0);                                                        \
        PV_QUAD(R[4].x, R[5].x, R[6].x, R[7].x, aq1, 0)  PV_QUAD(R[4].y, R[5].y, R[6].y, R[7].y, aq1, 4)   \
        PV_QUAD(R[4].z, R[5].z, R[6].z, R[7].z, aq1, 8)  PV_QUAD(R[4].w, R[5].w, R[6].w, R[7].w, aq1, 12)  \
        __builtin_amdgcn_sched_barrier(0); }
      PV_LOAD(ra, 8)
#pragma unroll 1
      for (int kb = 0; kb < 128; kb += 16) {
        { const int kn = kb + 16 < 120 ? kb + 16 : 120; PV_LOAD(rb, kn) }
        PV_COMP(ra, kb)
        { const int kn = kb + 24 < 120 ? kb + 24 : 120; PV_LOAD(ra, kn) }
        PV_COMP(rb, kb + 8)
      }
#undef PV_LOAD
#undef PV_COMP
#undef PV_QUAD
      const float as = ACTS[tq];
      const u32x4 r0 = *(const u32x4*)rrow, r1 = *(const u32x4*)(rrow + 8);
      const unsigned rw[8] = {r0.x, r0.y, r0.z, r0.w, r1.x, r1.y, r1.z, r1.w};
      float res[16];
#pragma unroll
      for (int i = 0; i < 4; ++i) {
        float4 g0 = *(const float4*)(grow + 4 * i);
        g0.x *= as; g0.y *= as; g0.z *= as; g0.w *= as;
        res[4 * i + 0] = bf_lo(rw[2 * i]) + g0.x * (float)y[4 * i];     res[4 * i + 1] = bf_hi(rw[2 * i]) + g0.y * (float)y[4 * i + 1];
        res[4 * i + 2] = bf_lo(rw[2 * i + 1]) + g0.z * (float)y[4 * i + 2]; res[4 * i + 3] = bf_hi(rw[2 * i + 1]) + g0.w * (float)y[4 * i + 3];
      }
      if (layer == 0) {
        u32x4 w0, w1;
        w0.x = pack_bf2(res[0], res[1]); w0.y = pack_bf2(res[2], res[3]); w0.z = pack_bf2(res[4], res[5]); w0.w = pack_bf2(res[6], res[7]);
        w1.x = pack_bf2(res[8], res[9]); w1.y = pack_bf2(res[10], res[11]); w1.z = pack_bf2(res[12], res[13]); w1.w = pack_bf2(res[14], res[15]);
        *(u32x4*)rrow = w0; *(u32x4*)(rrow + 8) = w1;
      } else {
#pragma unroll
        for (int i = 0; i < 4; ++i) *(float4*)(orow + 4 * i) = make_float4(res[4 * i], res[4 * i + 1], res[4 * i + 2], res[4 * i + 3]);
      }
      }
    }
  }
}

#define XB_TMO      128
#define XB_XCNT(j)  (256  + 64 * (j))
#define XB_XSUB(j)  (1280 + 64 * (j))
#define XB_XGEN(j)  (2304 + 64 * (j))
#define XB_TOP      3328
#define XB_TOPGEN   3392
#define XCD_BAR_WORDS 3456
#define XB_SPIN_CAP (1u << 22)
#define LAS __attribute__((address_space(3)))
DI unsigned xb_ld(unsigned* p) { return __hip_atomic_load(p, __ATOMIC_RELAXED, __HIP_MEMORY_SCOPE_AGENT); }
DI unsigned xb_add(unsigned* p, unsigned v) { return __hip_atomic_fetch_add(p, v, __ATOMIC_RELAXED, __HIP_MEMORY_SCOPE_AGENT); }
DI unsigned xb_xcc_id() { return (unsigned)__builtin_amdgcn_s_getreg((3 << 11) | 20) & 0xFu; }
#define XB_SPIN(cond, bar) do { unsigned _sp = 0; while (cond) { __builtin_amdgcn_s_sleep(1); \
    if ((++_sp & 255u) == 0u) { if (xb_ld(&(bar)[XB_TMO])) break; if (_sp > XB_SPIN_CAP) { atomicAdd(&(bar)[XB_TMO], 1u); break; } } } } while (0)
struct XcdBarrier { unsigned* bar; unsigned x; volatile LAS unsigned* st; };
DI XcdBarrier xcd_barrier_post(unsigned* bar, volatile LAS unsigned* st) {
  XcdBarrier b; b.bar = bar; b.x = xb_xcc_id(); b.st = st;
  if (threadIdx.x == 0) (void)xb_add(&bar[XB_XCNT(b.x)], 1u);
  return b;
}
DI void xcd_barrier_complete(unsigned* bar, unsigned x, unsigned& nloc, unsigned& nx) {
  const unsigned G = gridDim.x * gridDim.y * gridDim.z;
  unsigned sum, cnt, mine, sp = 0u;
  for (;;) {
    sum = 0u; cnt = 0u; mine = 0u;
#pragma unroll
    for (unsigned j = 0; j < 16; ++j) { const unsigned c = xb_ld(&bar[XB_XCNT(j)]); sum += c; cnt += (c > 0u) ? 1u : 0u; mine = (j == x) ? c : mine; }
    if (sum == G) break;
    __builtin_amdgcn_s_sleep(1);
    if ((++sp & 255u) == 0u) { if (xb_ld(&bar[XB_TMO])) break; if (sp > XB_SPIN_CAP) { atomicAdd(&bar[XB_TMO], 1u); break; } }
  }
  nloc = mine > 0u ? mine : 1u; nx = cnt > 0u ? cnt : 1u;
}
DI void xcd_barrier(const XcdBarrier& b) {
  asm volatile("s_waitcnt vmcnt(0)" ::: "memory");
  __syncthreads();
  if (threadIdx.x == 0) {
    unsigned* bar = b.bar;
    __builtin_amdgcn_s_waitcnt(0);
    unsigned nloc = b.st[0], nx = b.st[1];
    if (nloc == 0u) { xcd_barrier_complete(bar, b.x, nloc, nx); b.st[0] = nloc; b.st[1] = nx; }
    const unsigned old = xb_add(&bar[XB_XSUB(b.x)], 1u);
    const unsigned gen = old / nloc;
    if (old + 1u == (gen + 1u) * nloc) {
      __builtin_amdgcn_fence(__ATOMIC_RELEASE, "agent");
      asm volatile("s_waitcnt vmcnt(0)" ::: "memory");
      const unsigned og = xb_add(&bar[XB_TOP], 1u);
      const unsigned tg = og / nx;
      if (og + 1u == (tg + 1u) * nx) xb_add(&bar[XB_TOPGEN], 1u);
      else XB_SPIN(xb_ld(&bar[XB_TOPGEN]) == tg, bar);
      __builtin_amdgcn_fence(__ATOMIC_ACQUIRE, "agent");
      xb_add(&bar[XB_XGEN(b.x)], 1u);
      asm volatile("s_waitcnt vmcnt(0)" ::: "memory");
    } else {
      XB_SPIN(xb_ld(&bar[XB_XGEN(b.x)]) == gen, bar);
      __builtin_amdgcn_fence(__ATOMIC_ACQUIRE, "agent");
      asm volatile("s_waitcnt vmcnt(0)" ::: "memory");
    }
  }
  __syncthreads();
}

constexpr int N_PHASES = 23;
template <class Epi>
DI void gemm256(char* smem_all, const bf16_t* A, const bf16_t* Bt, int M, int N, int K, const Epi& E) {
  pg8::Gemm g{A, Bt, M, N, K};
  pg8::StaticOrder S; S.init(M, N, (int)gridDim.x, (int)blockIdx.x);
  pg8::gemm_phase<Epi, pg8::StaticOrder, false>((PG8_LAS unsigned char*)smem_all, g, S, E, nullptr);
}
template <int ph>
DI void run_phase(const Params& p_in, char* smem, char* smem_all) {
  Params p = p_in;
  {
    size_t z = 0; asm volatile("" : "+s"(z)); p.ws = p_in.ws + z; p.out = p_in.out + z;
  }
  char* ws = p.ws;
  const float* mod = (const float*)(ws + WS_MOD);
  const bf16_t* H = (const bf16_t*)(ws + WS_H);
  if (ph == 0) { phase_prep(p, smem); return; }
  const int layer = ph >= 12 ? 1 : 0;
  const int lp = ph - (layer ? 12 : 1);
  int sub;
  sub = lp < 2 ? lp : lp + 1;
  const float* modl = mod + (size_t)layer * 8 * 12288;
  switch (sub) {
    case 0:
      if (layer == 0) { phase_norm<false, 2>(p, p.x, p.norm_gain, modl, modl + 2048); forget_logits(p); quant_w8(p); }
      else phase_norm<false, 2, true, false>(p, ws + WS_R16, p.norm_gain + 2 * 2048, modl, modl + 2048);
      break;
    case 1: {
      if (layer == 0) fox_cumsum(p);
      const bf16_t* H8A = (const bf16_t*)(ws + WS_H8A);
      const float* hsc = (const float*)(ws + WS_H8A + 32 * MiB);
      const bf16_t* W8 = (const bf16_t*)(ws + WS_W8) + (size_t)layer * 6144 * 1024;
      const float* wsc = (const float*)(ws + WS_W8 + 32 * MiB) + layer * 6144;
      pg8::EpiQkNorm eq{(bf16_t*)(ws + WS_QK), 4096, layer ? p.odd_qk_gain : p.even_fox_qk_gain, layer ? p.odd_qk_gain : p.even_diff_qk_gain,
                        layer ? 4 : 3, (float*)(smem_all + 131072), wsc, hsc};
      gemm256(smem_all, H8A, W8, T_, 4096, 1024, eq);
      pg8::EpiVt8 ev{(bf16_t*)(ws + WS_VT), T_, wsc + 4096, hsc};
      gemm256(smem_all, W8 + (size_t)4096 * 1024, H8A, 2048, T_, 1024, ev);
    } break;
    case 3:
      if (layer == 0) phase_attn_even(p, smem_all); else phase_attn_odd(p, smem_all);
      break;
    case 4: if (layer == 0) phase_diff_combine(p); else quant_att(p); break;
    case 5: {
      bf16_t* R16 = (bf16_t*)(ws + WS_R16);
      const bf16_t* A8 = (const bf16_t*)(ws + WS_ATT8);
      const float* a8s = (const float*)(ws + WS_ATT8 + 32 * MiB);
      const bf16_t* Wo8 = (const bf16_t*)(ws + WS_W8) + (size_t)(12288 + layer * 2048) * 1024;
      const float* wos = (const float*)(ws + WS_W8 + 32 * MiB) + 12288 + layer * 2048;
      if (layer == 0) { pg8::EpiRes16<false> er{R16, 2048, p.x, modl + 2 * 2048, a8s, wos};
        gemm256(smem_all, A8, Wo8, T_, 2048, 1024, er); }
      else { pg8::EpiRes16<true> er{R16, 2048, R16, modl + 2 * 2048, a8s, wos};
        gemm256(smem_all, A8, Wo8, T_, 2048, 1024, er); }
    } break;
    case 6:
      phase_norm<false, 1, true>(p, ws + WS_R16, p.norm_gain + (layer * 2 + 1) * 2048, modl + 3 * 2048, modl + 4 * 2048);
      break;
    case 7: {
      pg8::EpiBf16 es{(bf16_t*)(ws + WS_SC), 2048};
      gemm256(smem_all, H, (const bf16_t*)(ws + (layer ? WS_WQ1 : WS_WQ0)), T_, 2048, 2048, es);
    } break;
    case 8: phase_peer_retrieve(p, smem); break;
    case 9: phase_peer_dots(p, layer, smem_all); break;
    case 10: phase_peer_act(p, layer); break;
    case 11: phase_peer_values(p, layer, modl + 5 * 2048, smem_all); break;
  }
}

#if FUSED
template <int PH>
DI void run_all(const Params& p, char* smem, char* smem_all, const XcdBarrier& xb, cg::grid_group& grid) {
  if constexpr (PH < N_PHASES) {
    run_phase<PH>(p, smem, smem_all);
    if constexpr (PH + 1 < N_PHASES) xcd_barrier(xb);
    run_all<PH + 1>(p, smem, smem_all, xb, grid);
  }
}
__global__ void __launch_bounds__(RTHREADS, 2) mega_kernel(Params p) {
  extern __shared__ __attribute__((aligned(16))) char smem_all[];
  char* smem = smem_all + (RTID() >> 8) * HALF_SMEM;
  cg::grid_group grid = cg::this_grid();
  volatile LAS unsigned* xst = (volatile LAS unsigned*)(smem_all + SMEM_BYTES - 16);
  if (threadIdx.x == 0) { xst[0] = 0u; xst[1] = 0u; }
  __syncthreads();
  const XcdBarrier xb = xcd_barrier_post((unsigned*)(p.ws + WS_BAR), xst);
  if (p.ws == nullptr) grid.sync();
  run_all<0>(p, smem, smem_all, xb, grid);
}
#else
template <int PH>
__global__ void __launch_bounds__(RTHREADS, 2) phase_kernel(Params p) {
  extern __shared__ __attribute__((aligned(16))) char smem_all[];
  char* smem = smem_all + (RTID() >> 8) * HALF_SMEM;
  run_phase<PH>(p, smem, smem_all);
}
template <int PH>
static void launch_phases(const Params& p, int grid, hipStream_t stream) {
  if constexpr (PH < N_PHASES) {
    (void)hipFuncSetAttribute((const void*)phase_kernel<PH>, hipFuncAttributeMaxDynamicSharedMemorySize, SMEM_BYTES);
    phase_kernel<PH><<<grid, RTHREADS, SMEM_BYTES, stream>>>(p);
    launch_phases<PH + 1>(p, grid, stream);
  }
}
#endif

extern "C" void kernel_launch(void* const* d_in, const int* in_sizes, int n_in, void* d_out, int out_size, void* d_ws,
                              size_t ws_size, hipStream_t stream) {
  Params p{};
  p.x = (const float*)d_in[0]; p.c = (const float*)d_in[1]; p.rel_bias = (const float*)d_in[2];
  p.norm_gain = (const float*)d_in[3]; p.w_ada = (const float*)d_in[4]; p.b_ada = (const float*)d_in[5];
  p.even_w_in = (const float*)d_in[6]; p.even_b_forget = (const float*)d_in[7]; p.even_fox_qk_gain = (const float*)d_in[8];
  p.even_diff_qk_gain = (const float*)d_in[9]; p.even_diff_lambda = (const float*)d_in[10];
  p.even_diff_subln_gain = (const float*)d_in[11]; p.even_w_out = (const float*)d_in[12];
  p.odd_w_qkv = (const float*)d_in[13]; p.odd_qk_gain = (const float*)d_in[14]; p.odd_w_out = (const float*)d_in[15];
  p.peer_w_query = (const float*)d_in[16]; p.peer_sub_keys = (const float*)d_in[17];
  p.peer_u = (const float*)d_in[18]; p.peer_v = (const float*)d_in[19];
  p.out = (float*)d_out; p.ws = (char*)d_ws;
  if (ws_size < WS_END) { fprintf(stderr, "workspace too small: %zu < %zu\n", ws_size, (size_t)WS_END); return; }
#if FUSED
  static int grid_blocks = 0;
  if (!grid_blocks) {
    int dev = 0, cus = 0, per_cu = 0;
    (void)hipGetDevice(&dev);
    (void)hipDeviceGetAttribute(&cus, hipDeviceAttributeMultiprocessorCount, dev);
    (void)hipFuncSetAttribute((const void*)mega_kernel, hipFuncAttributeMaxDynamicSharedMemorySize, SMEM_BYTES);
    (void)hipOccupancyMaxActiveBlocksPerMultiprocessor(&per_cu, mega_kernel, RTHREADS, SMEM_BYTES);
    if (per_cu > 1) per_cu = 1;
    grid_blocks = cus * per_cu;
  }
  (void)hipMemsetAsync(p.ws + WS_BAR, 0, WS_BAR_BYTES, stream);
  void* args[] = {&p};
  hipError_t e = hipLaunchCooperativeKernel((void*)mega_kernel, dim3(grid_blocks), dim3(RTHREADS), args, SMEM_BYTES, stream);
  if (e != hipSuccess) fprintf(stderr, "cooperative launch failed: %s (grid %d)\n", hipGetErrorString(e), grid_blocks);
#else
  launch_phases<0>(p, 256, stream);
#endif
}
```

```cpp
#include <hip/hip_runtime.h>
#include <hip/hip_cooperative_groups.h>
#include <stdint.h>
#include <stdio.h>
namespace cg = cooperative_groups;

#ifndef FUSED
#define FUSED 1
#endif

#define DI __device__ __forceinline__
typedef unsigned short bf16_t;
typedef __attribute__((ext_vector_type(8))) short bf16x8;
typedef __attribute__((ext_vector_type(4))) short bf16x4;
typedef __attribute__((ext_vector_type(16))) float f32x16;
typedef __attribute__((ext_vector_type(2))) __bf16 bf2_t;
typedef __attribute__((ext_vector_type(2))) float f2_t;
typedef __attribute__((ext_vector_type(4))) unsigned u32x4;
#define MFMA32(a, b, c) __builtin_amdgcn_mfma_f32_32x32x16_bf16((a), (b), (c), 0, 0, 0)

constexpr int T_ = 16384;
constexpr int D_ = 2048;
constexpr int S_ = 2048;
constexpr int NB_ = 8;
constexpr int NEXP = 16384;
constexpr float LOG2E = 1.4426950408889634f;
constexpr int NTHREADS = 256;
constexpr int HALF_SMEM = 75776;
constexpr int RTHREADS = 512;
constexpr int SMEM_BYTES = 2 * HALF_SMEM + 16;

constexpr size_t MiB = 1048576;
constexpr size_t WS_PEERU = 0;
constexpr size_t WS_PEERV8 = WS_PEERU + 64 * MiB;
constexpr size_t WS_PEERV = WS_PEERU + 128 * MiB;
constexpr size_t WS_WQK0 = WS_PEERV + 128 * MiB;
constexpr size_t WS_WV0 = WS_WQK0 + 16 * MiB;
constexpr size_t WS_WQK1 = WS_WV0 + 8 * MiB;
constexpr size_t WS_WV1 = WS_WQK1 + 16 * MiB;
constexpr size_t WS_WO0 = WS_WV1 + 8 * MiB;
constexpr size_t WS_WO1 = WS_WO0 + 8 * MiB;
constexpr size_t WS_WQ0 = WS_WO1 + 8 * MiB;
constexpr size_t WS_WQ1 = WS_WQ0 + 8 * MiB;
constexpr size_t WS_SK = WS_WQ1 + 8 * MiB;
constexpr size_t WS_WFF = WS_SK + 131072;
constexpr size_t WS_MOD = WS_WFF + 65536;
constexpr size_t WS_LOGF = WS_MOD + 786432;
constexpr size_t WS_FCUM = WS_LOGF + 524288;
constexpr size_t WS_MISC = WS_FCUM + 524288;
constexpr size_t WS_H = WS_MISC + 65536;
constexpr size_t WS_QK = WS_H + 64 * MiB;
constexpr size_t WS_VT = WS_QK + 128 * MiB;
constexpr size_t WS_ATT = WS_VT + 64 * MiB;
constexpr size_t WS_SC = WS_ATT + 64 * MiB;
constexpr size_t WS_BAR = WS_SC + 128 * MiB;
constexpr size_t WS_TICKETS = WS_BAR + 16384;
constexpr size_t WS_BAR_BYTES = 16384 + 4096;
constexpr size_t WS_IDX = WS_ATT;
constexpr size_t WS_GATE = WS_ATT + 8 * MiB;
constexpr size_t WS_ACT = WS_ATT + 16 * MiB;
constexpr size_t WS_PD = WS_SC;
constexpr size_t WS_USC4 = WS_PEERV + 1 * MiB;
constexpr size_t WS_H8 = WS_QK;
constexpr size_t WS_HS = WS_QK + 32 * MiB;
constexpr size_t WS_R16 = WS_BAR + 65536;
constexpr size_t WS_H8A = WS_R16 + 64 * MiB;
constexpr size_t WS_W8 = WS_H8A + 33 * MiB;
constexpr size_t WS_ATT8 = WS_W8 + 33 * MiB;
constexpr size_t WS_END = WS_ATT8 + 33 * MiB;

struct Params {
  const float* x; const float* c; const float* rel_bias; const float* norm_gain; const float* w_ada; const float* b_ada;
  const float* even_w_in; const float* even_b_forget; const float* even_fox_qk_gain; const float* even_diff_qk_gain;
  const float* even_diff_lambda; const float* even_diff_subln_gain; const float* even_w_out;
  const float* odd_w_qkv; const float* odd_qk_gain; const float* odd_w_out;
  const float* peer_w_query; const float* peer_sub_keys; const float* peer_u; const float* peer_v;
  float* out; char* ws;
};

DI unsigned pack_bf2(float a, float b) { f2_t v = {a, b}; return __builtin_bit_cast(unsigned, __builtin_convertvector(v, bf2_t)); }
DI unsigned pack_i8x4(float a, float b, float c, float d) {
  const int ia = (int)rintf(a), ib = (int)rintf(b), ic = (int)rintf(c), id = (int)rintf(d);
  return (unsigned)(ia & 255) | ((unsigned)(ib & 255) << 8) | ((unsigned)(ic & 255) << 16) | ((unsigned)id << 24);
}
DI unsigned q4(float v) { int q = (int)rintf(v); q = q > 7 ? 7 : (q < -7 ? -7 : q); return (unsigned)q & 15u; }
DI unsigned pack_i4x4(float a, float b, float c, float d) { return q4(a) | (q4(b) << 8) | (q4(c) << 16) | (q4(d) << 24); }
DI bf16_t f2bf(float a) { return (bf16_t)(pack_bf2(a, 0.f) & 0xffffu); }
DI float bf_lo(unsigned u) { return __uint_as_float(u << 16); }
DI float bf_hi(unsigned u) { return __uint_as_float(u & 0xffff0000u); }
DI int RTID() { int t = threadIdx.x; asm volatile("" : "+v"(t)); return t; }
DI int TID() { return RTID() & 255; }
DI int VBID() { return __builtin_amdgcn_readfirstlane(blockIdx.x * 2 + (RTID() >> 8)); }
DI int VGRID() { return gridDim.x * 2; }
DI int xcc_id() { return (int)(__builtin_amdgcn_s_getreg((3 << 11) | 20) & 0xFu); }
DI int crow(int reg, int h) { return (reg & 3) + 8 * (reg >> 2) + 4 * h; }
template <int CTRL> DI float dppf(float x) { return __builtin_bit_cast(float, __builtin_amdgcn_mov_dpp(__builtin_bit_cast(int, x), CTRL, 0xf, 0xf, true)); }
DI float row16_sum(float v) { v += dppf<0xB1>(v); v += dppf<0x4E>(v); v += dppf<0x141>(v); v += dppf<0x128>(v); return v; }
DI float row16_max(float v) { v = fmaxf(v, dppf<0xB1>(v)); v = fmaxf(v, dppf<0x4E>(v)); v = fmaxf(v, dppf<0x141>(v)); v = fmaxf(v, dppf<0x128>(v)); return v; }
DI float wave_sum(float v) {
  v = row16_sum(v);
  const auto s = __builtin_amdgcn_permlane16_swap(__float_as_uint(v), __float_as_uint(v), false, false);
  v = __uint_as_float(s[0]) + __uint_as_float(s[1]);
  const auto t = __builtin_amdgcn_permlane32_swap(__float_as_uint(v), __float_as_uint(v), false, false);
  return __uint_as_float(t[0]) + __uint_as_float(t[1]);
}
DI float wave_max(float v) {
  v = row16_max(v);
  const auto s = __builtin_amdgcn_permlane16_swap(__float_as_uint(v), __float_as_uint(v), false, false);
  v = fmaxf(__uint_as_float(s[0]), __uint_as_float(s[1]));
  const auto t = __builtin_amdgcn_permlane32_swap(__float_as_uint(v), __float_as_uint(v), false, false);
  return fmaxf(__uint_as_float(t[0]), __uint_as_float(t[1]));
}

DI void transpose_tile(const float* __restrict__ src, int ld, int c0, int k0, bf16_t* __restrict__ dst_row0, char* smem) {
  float* tile = (float*)smem;
  const int tid = TID();
  const int ty = tid >> 4, tx = tid & 15;
#pragma unroll
  for (int i = 0; i < 4; ++i) {
    const int k = ty + 16 * i;
    const float4 v = *(const float4*)(src + (size_t)(k0 + k) * ld + c0 + 4 * tx);
    float* t = tile + k * 65 + 4 * tx;
    t[0] = v.x; t[1] = v.y; t[2] = v.z; t[3] = v.w;
  }
  __syncthreads();
  const int cc = tid >> 2, kc = (tid & 3) * 16;
  unsigned pk[8];
#pragma unroll
  for (int j = 0; j < 8; ++j) pk[j] = pack_bf2(tile[(kc + 2 * j) * 65 + cc], tile[(kc + 2 * j + 1) * 65 + cc]);
  uint4* d = (uint4*)(dst_row0 + (size_t)cc * 2048 + k0 + kc);
  d[0] = make_uint4(pk[0], pk[1], pk[2], pk[3]);
  d[1] = make_uint4(pk[4], pk[5], pk[6], pk[7]);
  __syncthreads();
}

DI void phase_prep(const Params& p, char* smem) {
  const int tid = TID(), bid = VBID(), G = VGRID();
  char* ws = p.ws;
  {
    float* cond = (float*)smem;
    bool have_cond = false;
    for (int item = bid; item < 384; item += G) {
      if (!have_cond) {
        for (int e = tid; e < NB_ * D_; e += NTHREADS) {
          const int b = e >> 11, d = e & 2047;
          const float v = p.c[e];
          cond[d * 8 + b] = v / (1.f + __expf(-v));
        }
        have_cond = true;
        __syncthreads();
      }
      const int i = item / 192, n = (item % 192) * 64 + (tid & 63);
      const int w = tid >> 6;
      const float* wp = p.w_ada + (size_t)i * D_ * 12288 + n;
      float acc[8];
#pragma unroll
      for (int b = 0; b < 8; ++b) acc[b] = 0.f;
#pragma unroll 8
      for (int d = w; d < D_; d += 4) {
        const float wv = wp[(size_t)d * 12288];
        const float4 c0 = *(const float4*)(cond + d * 8), c1 = *(const float4*)(cond + d * 8 + 4);
        acc[0] += c0.x * wv; acc[1] += c0.y * wv; acc[2] += c0.z * wv; acc[3] += c0.w * wv;
        acc[4] += c1.x * wv; acc[5] += c1.y * wv; acc[6] += c1.z * wv; acc[7] += c1.w * wv;
      }
      float* red = (float*)(smem + 65536);
#pragma unroll
      for (int b = 0; b < 8; ++b) red[(w * 64 + (tid & 63)) * 8 + b] = acc[b];
      __syncthreads();
      if (tid < 64) {
        float* mod = (float*)(ws + WS_MOD);
#pragma unroll
        for (int b = 0; b < 8; ++b) {
          const float s = red[(0 * 64 + tid) * 8 + b] + red[(1 * 64 + tid) * 8 + b] + red[(2 * 64 + tid) * 8 + b] + red[(3 * 64 + tid) * 8 + b];
          mod[((size_t)i * 8 + b) * 12288 + n] = s + p.b_ada[i * 12288 + n];
        }
      }
      __syncthreads();
    }
    __syncthreads();
  }
  {
    bf16_t* wqk0 = (bf16_t*)(ws + WS_WQK0); bf16_t* wv0 = (bf16_t*)(ws + WS_WV0);
    bf16_t* wqk1 = (bf16_t*)(ws + WS_WQK1); bf16_t* wv1 = (bf16_t*)(ws + WS_WV1);
    for (int item = bid; item < 256 * 32; item += G) {
      const int ct = item >> 5, kt = item & 31;
      const float* src; int ld, c0; bf16_t* dst;
      if (ct < 96) {
        const int seg = ct >> 4, cl = (ct & 15) * 64;
        src = p.even_w_in; ld = 6152;
        c0 = (seg < 3 ? seg * 1024 : 3080 + (seg - 3) * 1024) + cl;
        if (seg == 0) dst = wqk0 + (size_t)cl * 2048;
        else if (seg == 1) dst = wqk0 + (size_t)(1024 + cl) * 2048;
        else if (seg == 2) dst = wv0 + (size_t)cl * 2048;
        else if (seg == 3) dst = wqk0 + (size_t)(2048 + cl) * 2048;
        else if (seg == 4) dst = wqk0 + (size_t)(3072 + cl) * 2048;
        else dst = wv0 + (size_t)(1024 + cl) * 2048;
      } else if (ct < 192) {
        const int cl = (ct - 96) * 64;
        src = p.odd_w_qkv; ld = 6144; c0 = cl;
        dst = cl < 4096 ? wqk1 + (size_t)cl * 2048 : wv1 + (size_t)(cl - 4096) * 2048;
      } else {
        const int mi = (ct - 192) >> 5, cl = ((ct - 192) & 31) * 64;
        ld = 2048; c0 = cl;
        if (mi == 0) { src = p.even_w_out; dst = (bf16_t*)(ws + WS_WO0); }
        else { src = p.odd_w_out; dst = (bf16_t*)(ws + WS_WO1); }
        dst += (size_t)cl * 2048;
      }
      transpose_tile(src, ld, c0, kt * 64, dst, smem);
    }
  }
  {
    const int lane = tid & 63;
    const int gw = __builtin_amdgcn_readfirstlane((bid * NTHREADS + tid) >> 6), nw = (G * NTHREADS) >> 6;
    float* scl = (float*)(ws + WS_PEERV);
    float4 nx[8];
    {
      const int r0 = gw < 4 * NEXP ? gw : 0;
      const float* s0 = ((r0 >> 15) ? p.peer_v : p.peer_u) + (size_t)(r0 & 32767) * D_;
#pragma unroll
      for (int i = 0; i < 2; ++i)
#pragma unroll
        for (int j = 0; j < 4; ++j) nx[4 * i + j] = *(const float4*)(s0 + lane * 16 + 1024 * i + 4 * j);
    }
    for (int row = gw; row < 4 * NEXP; row += nw) {
      const int tab = row >> 15, rr = row & 32767;
      unsigned char* dst = (unsigned char*)(ws + (tab ? WS_PEERV8 : WS_PEERU)) + (size_t)(rr >> 14) * NEXP * D_ + (size_t)(rr & (NEXP - 1)) * 128;
      float4 v[8];
      float am = 0.f;
#pragma unroll
      for (int i = 0; i < 8; ++i) v[i] = nx[i];
      {
        const int rn = row + nw < 4 * NEXP ? row + nw : row;
        const float* sn = ((rn >> 15) ? p.peer_v : p.peer_u) + (size_t)(rn & 32767) * D_;
#pragma unroll
        for (int i = 0; i < 2; ++i)
#pragma unroll
          for (int j = 0; j < 4; ++j) nx[4 * i + j] = *(const float4*)(sn + lane * 16 + 1024 * i + 4 * j);
        asm volatile("" ::: "memory");
      }
#pragma unroll
      for (int i = 0; i < 8; ++i) am = fmaxf(am, fmaxf(fmaxf(fabsf(v[i].x), fabsf(v[i].y)), fmaxf(fabsf(v[i].z), fabsf(v[i].w))));
      if (!tab) {
        unsigned char* d4 = (unsigned char*)(ws + WS_PEERU) + (size_t)(rr >> 14) * (8 * NEXP * 128) + (size_t)(rr & (NEXP - 1)) * 128 + (lane & 15) * 8;
        float* sc4 = (float*)(ws + WS_USC4) + (size_t)(rr >> 14) * (8 * NEXP) + (size_t)(rr & (NEXP - 1)) * 8;
#pragma unroll
        for (int i = 0; i < 2; ++i) {
          float bm = 0.f;
#pragma unroll
          for (int j = 0; j < 4; ++j) bm = fmaxf(bm, fmaxf(fmaxf(fabsf(v[4 * i + j].x), fabsf(v[4 * i + j].y)), fmaxf(fabsf(v[4 * i + j].z), fabsf(v[4 * i + j].w))));
          bm = row16_max(bm);
          const float sc = bm > 0.f ? 7.5f / bm : 1.f;
          const int slice = 4 * i + (lane >> 4);
          if ((lane & 15) == 0) sc4[slice] = bm > 0.f ? bm / 7.5f : 1.f;
          unsigned w[2];
#pragma unroll
          for (int gq = 0; gq < 2; ++gq) {
            const float4 a = v[4 * i + 2 * gq], b = v[4 * i + 2 * gq + 1];
            const unsigned lo = pack_i4x4(a.x * sc, a.y * sc, a.z * sc, a.w * sc);
            const unsigned hi = pack_i4x4(b.x * sc, b.y * sc, b.z * sc, b.w * sc);
            w[gq] = lo | (hi << 4);
          }
          *(uint2*)(d4 + (size_t)slice * (NEXP * 128)) = make_uint2(w[0], w[1]);
        }
        continue;
      }
      am = wave_max(am);
      const float sc = am > 0.f ? 127.f / am : 1.f;
      if (lane == 0) scl[row] = am > 0.f ? am / 127.f : 1.f;
#pragma unroll
      for (int i = 0; i < 2; ++i) {
        unsigned w[4];
#pragma unroll
        for (int j = 0; j < 4; ++j) w[j] = pack_i8x4(v[4 * i + j].x * sc, v[4 * i + j].y * sc, v[4 * i + j].z * sc, v[4 * i + j].w * sc);
        *(uint4*)(dst + (size_t)((lane >> 3) + 8 * i) * (NEXP * 128) + (lane & 7) * 16) = make_uint4(w[0], w[1], w[2], w[3]);
      }
    }
  }
  {
    const int lane = tid & 63, r = lane & 31, h = lane >> 5;
    const int gw = __builtin_amdgcn_readfirstlane((bid * NTHREADS + tid) >> 6), nw = (G * NTHREADS) >> 6;
    for (int item = gw; item < 2048; item += nw) {
      const int layer = item >> 10, hp = (item >> 6) & 15, kb = item & 63;
      const float* wq = p.peer_w_query + (size_t)layer * 2048 * 2048 + (size_t)(kb * 32 + r) * 2048 + hp * 128 + 8 * h;
      const float* sk = p.peer_sub_keys + (size_t)((layer * 2 + (hp & 1)) * 128) * 128 + 8 * h;
      bf16_t* dst = (bf16_t*)(ws + (layer ? WS_WQ1 : WS_WQ0)) + (size_t)(hp * 128) * 2048 + kb * 32 + 4 * h;
      bf16x8 ah[8], al[8];
#define B2_SPLIT(PTR, HI, LO) { const float4 x0_ = *(const float4*)(PTR), x1_ = *(const float4*)((PTR) + 4);                                  \
        const float xs_[8] = {x0_.x, x0_.y, x0_.z, x0_.w, x1_.x, x1_.y, x1_.z, x1_.w};                                                        \
        unsigned hw_[4], lw_[4];                                                                                                              \
        _Pragma("unroll") for (int q_ = 0; q_ < 4; ++q_) { hw_[q_] = pack_bf2(xs_[2 * q_], xs_[2 * q_ + 1]);                                  \
          lw_[q_] = pack_bf2(xs_[2 * q_] - bf_lo(hw_[q_]), xs_[2 * q_ + 1] - bf_hi(hw_[q_])); }                                               \
        HI = __builtin_bit_cast(bf16x8, (u32x4){hw_[0], hw_[1], hw_[2], hw_[3]}); LO = __builtin_bit_cast(bf16x8, (u32x4){lw_[0], lw_[1], lw_[2], lw_[3]}); }
#pragma unroll
      for (int s2 = 0; s2 < 8; ++s2) B2_SPLIT(wq + 16 * s2, ah[s2], al[s2])
#pragma unroll 1
      for (int nb = 0; nb < 4; ++nb) {
        f32x16 acc;
#pragma unroll
        for (int e = 0; e < 16; ++e) acc[e] = 0.f;
        const float* skr = sk + (size_t)(nb * 32 + r) * 128;
#pragma unroll
        for (int s2 = 0; s2 < 8; ++s2) {
          bf16x8 bh, bl;
          B2_SPLIT(skr + 16 * s2, bh, bl)
          acc = MFMA32(ah[s2], bh, acc); acc = MFMA32(ah[s2], bl, acc); acc = MFMA32(al[s2], bh, acc);
        }
        bf16_t* drow = dst + (size_t)(nb * 32 + r) * 2048;
#pragma unroll
        for (int c4 = 0; c4 < 4; ++c4) *(uint2*)(drow + 8 * c4) = make_uint2(pack_bf2(acc[4 * c4], acc[4 * c4 + 1]), pack_bf2(acc[4 * c4 + 2], acc[4 * c4 + 3]));
      }
#undef B2_SPLIT
    }
  }
  if (bid == G - 1) {
    float* wff = (float*)(ws + WS_WFF);
    for (int e = tid; e < 2048 * 8; e += NTHREADS) wff[e] = p.even_w_in[(size_t)(e >> 3) * 6152 + 3072 + (e & 7)];
    if (tid < 64) {
      const float* l = p.even_diff_lambda;
      float s1 = l[tid] * l[128 + tid] + l[64 + tid] * l[128 + 64 + tid];
      float s2 = l[256 + tid] * l[384 + tid] + l[256 + 64 + tid] * l[384 + 64 + tid];
      s1 = wave_sum(s1); s2 = wave_sum(s2);
      if (tid == 0) ((float*)(ws + WS_MISC))[0] = expf(s1) - expf(s2) + 0.2f;
    }
  }
}

template <bool FF, int Q8 = 0, bool IN16 = false, bool WH = true>
DI void phase_norm(const Params& p, const void* __restrict__ xin_, const float* __restrict__ gain,
                   const float* __restrict__ sh, const float* __restrict__ sc  ) {
  const int lane = TID() & 63;
  const int gw = __builtin_amdgcn_readfirstlane((VBID() * NTHREADS + TID()) >> 6), nw = (VGRID() * NTHREADS) >> 6;
  bf16_t* H = (bf16_t*)(p.ws + WS_H);
  const bool sweep = nw == 2048;
  const int rpw = (T_ + nw - 1) / nw, tbeg = sweep ? (gw >> 8) * 2048 + (gw & 255) : gw * rpw, tstep = sweep ? 256 : 1;
  const int tend = sweep ? (gw >> 8) * 2048 + 2048 : (tbeg + rpw < T_ ? tbeg + rpw : T_);
  int b = -1;
  float4 ma[8], mb[8];
  for (int t = tbeg; t < tend; t += tstep) {
    if ((t >> 11) != b) {
      b = t >> 11;
#pragma unroll
      for (int i = 0; i < 8; ++i) {
        const int c = lane * 4 + 256 * i;
        const float4 g = *(const float4*)(gain + c);
        const float4 s1 = *(const float4*)(sc + (size_t)b * 12288 + c);
        mb[i] = *(const float4*)(sh + (size_t)b * 12288 + c);
        ma[i] = make_float4(g.x * (1.f + s1.x), g.y * (1.f + s1.y), g.z * (1.f + s1.z), g.w * (1.f + s1.w));
      }
    }
    float4 v[8];
    float ss = 0.f;
    if (IN16) {
      const bf16_t* xr = (const bf16_t*)xin_ + (size_t)t * D_;
#pragma unroll
      for (int i = 0; i < 8; ++i) { const uint2 w = *(const uint2*)(xr + lane * 4 + 256 * i); v[i] = make_float4(bf_lo(w.x), bf_hi(w.x), bf_lo(w.y), bf_hi(w.y)); }
    } else {
      const float* xr = (const float*)xin_ + (size_t)t * D_;
#pragma unroll
      for (int i = 0; i < 8; ++i) v[i] = *(const float4*)(xr + lane * 4 + 256 * i);
    }
#pragma unroll
    for (int i = 0; i < 8; ++i) ss += v[i].x * v[i].x + v[i].y * v[i].y + v[i].z * v[i].z + v[i].w * v[i].w;
    ss = wave_sum(ss);
    const float rstd = rsqrtf(ss * (1.f / 2048.f) + 1e-6f);
    float ff[8];
    if (FF) {
#pragma unroll
      for (int j = 0; j < 8; ++j) ff[j] = 0.f;
    }
    float am = 0.f;
#pragma unroll
    for (int i = 0; i < 8; ++i) {
      const int c = lane * 4 + 256 * i;
      float4 h;
      h.x = v[i].x * rstd * ma[i].x + mb[i].x;
      h.y = v[i].y * rstd * ma[i].y + mb[i].y;
      h.z = v[i].z * rstd * ma[i].z + mb[i].z;
      h.w = v[i].w * rstd * ma[i].w + mb[i].w;
      if (WH) *(uint2*)(H + (size_t)t * D_ + c) = make_uint2(pack_bf2(h.x, h.y), pack_bf2(h.z, h.w));
      if (Q8) { v[i] = h; am = fmaxf(am, fmaxf(fmaxf(fabsf(h.x), fabsf(h.y)), fmaxf(fabsf(h.z), fabsf(h.w)))); }
      if (FF) {
        const float* wff = (const float*)(p.ws + WS_WFF) + c * 8;
        const float hv[4] = {h.x, h.y, h.z, h.w};
#pragma unroll
        for (int e = 0; e < 4; ++e) {
          const float4 w0 = *(const float4*)(wff + e * 8), w1 = *(const float4*)(wff + e * 8 + 4);
          ff[0] += hv[e] * w0.x; ff[1] += hv[e] * w0.y; ff[2] += hv[e] * w0.z; ff[3] += hv[e] * w0.w;
          ff[4] += hv[e] * w1.x; ff[5] += hv[e] * w1.y; ff[6] += hv[e] * w1.z; ff[7] += hv[e] * w1.w;
        }
      }
    }
    if (Q8) {
      am = wave_max(am);
      const float qs = am > 0.f ? 119.f / am : 1.f;
      unsigned char* h8 = (unsigned char*)(p.ws + (Q8 == 1 ? WS_H8 : WS_H8A)) + (size_t)t * D_ + lane * 4;
#pragma unroll
      for (int i = 0; i < 8; ++i) *(unsigned*)(h8 + 256 * i) = pack_i8x4(v[i].x * qs, v[i].y * qs, v[i].z * qs, v[i].w * qs);
      if (lane < 8) ((float*)(p.ws + (Q8 == 1 ? WS_HS : WS_H8A + 32 * MiB)))[t] = am > 0.f ? am / 119.f : 1.f;
    }
    if (FF) {
#pragma unroll
      for (int j = 0; j < 8; ++j) ff[j] = wave_sum(ff[j]);
      if (lane < 8) {
        float z = ff[0];
#pragma unroll
        for (int j = 1; j < 8; ++j) z = (lane == j) ? ff[j] : z;
        z += p.even_b_forget[lane];
        const float lf = fminf(z, 0.f) - log1pf(__expf(-fabsf(z)));
        ((float*)(p.ws + WS_LOGF))[(size_t)t * 8 + lane] = lf;
      }
    }
  }
}

DI void quant_w8(const Params& p) {
  const int lane = TID() & 63;
  const int gw = __builtin_amdgcn_readfirstlane((VBID() * NTHREADS + TID()) >> 6), nw = (VGRID() * NTHREADS) >> 6;
  for (int row = gw; row < 16384; row += nw) {
    size_t sbase; int sr;
    if (row < 12288) { const int layer = row >= 6144 ? 1 : 0, rl = row - layer * 6144;
      sbase = rl < 4096 ? (layer ? WS_WQK1 : WS_WQK0) : (layer ? WS_WV1 : WS_WV0); sr = rl < 4096 ? rl : rl - 4096; }
    else { sbase = row < 14336 ? WS_WO0 : WS_WO1; sr = (row - 12288) & 2047; }
    const bf16_t* src = (const bf16_t*)(p.ws + sbase) + (size_t)sr * 2048 + lane * 32;
    u32x4 w[4];
#pragma unroll
    for (int i = 0; i < 4; ++i) w[i] = *(const u32x4*)(src + 8 * i);
    float f[32];
    float am = 0.f;
#pragma unroll
    for (int i = 0; i < 4; ++i)
#pragma unroll
      for (int j = 0; j < 4; ++j) { f[8 * i + 2 * j] = bf_lo(w[i][j]); f[8 * i + 2 * j + 1] = bf_hi(w[i][j]); am = fmaxf(am, fmaxf(fabsf(f[8 * i + 2 * j]), fabsf(f[8 * i + 2 * j + 1]))); }
    am = wave_max(am);
    const float sc = am > 0.f ? 127.f / am : 1.f;
    unsigned q[8];
#pragma unroll
    for (int i = 0; i < 8; ++i) q[i] = pack_i8x4(f[4 * i] * sc, f[4 * i + 1] * sc, f[4 * i + 2] * sc, f[4 * i + 3] * sc);
    unsigned char* dst = (unsigned char*)(p.ws + WS_W8) + (size_t)row * 2048 + lane * 32;
    *(u32x4*)dst = (u32x4){q[0], q[1], q[2], q[3]};
    *(u32x4*)(dst + 16) = (u32x4){q[4], q[5], q[6], q[7]};
    if (lane == 0) ((float*)(p.ws + WS_W8 + 32 * MiB))[row] = am > 0.f ? am / 127.f : 1.f;
  }
}

DI void forget_logits(const Params& p, char* smem) {
  const int lane = TID() & 63;
  const int gw = __builtin_amdgcn_readfirstlane((VBID() * NTHREADS + TID()) >> 6), nw = (VGRID() * NTHREADS) >> 6;
  const unsigned char* H8 = (const unsigned char*)(p.ws + WS_H8A);
  const float* HSA = (const float*)(p.ws + WS_H8A + 32 * MiB);
  float* wl = (float*)smem;
  {
    const float* wg = (const float*)(p.ws + WS_WFF);
    for (int e = TID(); e < 2048 * 8; e += NTHREADS) wl[(e & 7) * 2048 + (e >> 3)] = wg[e];
    __syncthreads();
  }
  const bool sweep = nw == 2048;
  const int rpw = (T_ + nw - 1) / nw, tbeg = sweep ? (gw >> 8) * 2048 + (gw & 255) : gw * rpw, tstep = sweep ? 256 : 1;
  const int tend = sweep ? (gw >> 8) * 2048 + 2048 : (tbeg + rpw < T_ ? tbeg + rpw : T_);
  for (int t = tbeg; t < tend; t += tstep) {
    float ff[8];
#pragma unroll
    for (int j = 0; j < 8; ++j) ff[j] = 0.f;
#pragma unroll 2
    for (int i = 0; i < 8; ++i) {
      const int c = lane * 4 + 256 * i;
      const unsigned hq = *(const unsigned*)(H8 + (size_t)t * D_ + c);
      const float hv[4] = {(float)(int)(signed char)(hq & 255u), (float)(int)(signed char)((hq >> 8) & 255u), (float)(int)(signed char)((hq >> 16) & 255u), (float)((int)hq >> 24)};
#pragma unroll
      for (int o = 0; o < 8; ++o) {
        const float4 w = *(const float4*)(wl + o * 2048 + c);
        ff[o] += hv[0] * w.x + hv[1] * w.y + hv[2] * w.z + hv[3] * w.w;
      }
    }
#pragma unroll
    for (int j = 0; j < 8; ++j) ff[j] = wave_sum(ff[j]);
    if (lane < 8) {
      float z = ff[0];
#pragma unroll
      for (int j = 1; j < 8; ++j) z = (lane == j) ? ff[j] : z;
      z = z * HSA[t] + p.even_b_forget[lane];
      const float lf = fminf(z, 0.f) - log1pf(__expf(-fabsf(z)));
      ((float*)(p.ws + WS_LOGF))[(size_t)t * 8 + lane] = lf;
    }
  }
  __syncthreads();
}

DI void fox_cumsum(const Params& p) {
  const int lane = TID() & 63;
  const int gw = __builtin_amdgcn_readfirstlane((VBID() * NTHREADS + TID()) >> 6), nw = (VGRID() * NTHREADS) >> 6;
  const float* lf = (const float*)(p.ws + WS_LOGF);
  float* fc = (float*)(p.ws + WS_FCUM);
  for (int it = gw; it < 64; it += nw) {
    const int b = it >> 3, hh = it & 7;
    float v[32];
    float tot = 0.f;
#pragma unroll
    for (int j = 0; j < 32; ++j) { tot += lf[(size_t)(b * S_ + lane * 32 + j) * 8 + hh]; v[j] = tot; }
    float inc = tot;
#pragma unroll
    for (int o = 1; o < 64; o <<= 1) { const float n = __shfl_up(inc, o); if (lane >= o) inc += n; }
    const float base = inc - tot;
#pragma unroll
    for (int j = 0; j < 32; ++j) fc[(size_t)it * S_ + lane * 32 + j] = v[j] + base;
  }
}

namespace pg8 {
#define PG8_LAS __attribute__((address_space(3)))
typedef float f32x4 __attribute__((ext_vector_type(4)));
constexpr int BM = 256, BK = 64, HALF = 128, HTB = HALF * BK * 2  , STAGE_BYTES = 8 * HTB, NXCD = 8, WGM = 8;

__host__ __device__ __forceinline__ int lds_byte(int r, int c) { const int st = (r >> 4) * 2 + (c >> 5), rr = r & 15, cc = c & 31, ob = rr * 64 + cc * 2; return st * 1024 + (ob ^ (((ob >> 9) & 1) << 5)); }
__host__ __device__ __forceinline__ void stage_rc(int b, int& R, int& C) { const int st = b / 1024, sb = b % 1024, swz = sb ^ (((sb >> 9) & 1) << 5); R = (st >> 1) * 16 + swz / 64; C = (st & 1) * 32 + (swz % 64) / 2; }
__host__ __device__ __forceinline__ int perm32(int rho) { const int n = rho >> 4, i = rho & 15; return 8 * (i >> 2) + 4 * n + (i & 3); }

struct Unit { int pm, pn; };
struct Gemm { const bf16_t* A; const bf16_t* Bt; int M, N, K; };

struct StaticOrder {
    int nM, nN, nwg, G, c;
    __host__ __device__ void init(int M, int N, int G_, int c_) { nM = M / BM; nN = N / BM; nwg = nM * nN; G = G_; c = c_; }
    __host__ __device__ bool next(int i, Unit& u) const {
        const long L = (long)i * G + c; if (L >= nwg) return false;
        int wgid = (int)L; { const int q = nwg / NXCD, r = nwg % NXCD, xcd = wgid % NXCD, off = wgid / NXCD; wgid = (xcd < r ? xcd * (q + 1) : r * (q + 1) + (xcd - r) * q) + off; }
        const int nig = WGM * nN, gid = wgid / nig, fm = gid * WGM, gsz = (nM - fm) < WGM ? (nM - fm) : WGM;
        u.pm = fm + ((wgid % nig) % gsz); u.pn = (wgid % nig) / gsz; return true;
    }
    __device__ __forceinline__ void a_ready(const Unit&) const {}
    __device__ __forceinline__ void done(const Unit&) const {}
};

struct EpiF32 {
    static constexpr bool PERM = false, AFTER_DRAIN = false, I8 = false;
    float* C; int ldc; const float* bias;
    __device__ __forceinline__ void operator()(const f32x4 (&acc)[2][2][4][2], const Unit& u, int wr, int wc, int fr, int fq) const {
        const int row0 = u.pm * BM + wr * 64 + fr, col0 = u.pn * BM + wc * 32 + 4 * fq;
        f32x4 bv[2][2];
#pragma unroll
        for (int bj = 0; bj < 2; ++bj)
#pragma unroll
            for (int n = 0; n < 2; ++n) bv[bj][n] = bias ? *(const f32x4*)(bias + col0 + bj * HALF + n * 16) : (f32x4){0.f, 0.f, 0.f, 0.f};
#pragma unroll
        for (int ai = 0; ai < 2; ++ai)
#pragma unroll
            for (int m = 0; m < 4; ++m) { float* rowp = C + (size_t)(row0 + ai * HALF + m * 16) * ldc + col0;
#pragma unroll
                for (int bj = 0; bj < 2; ++bj)
#pragma unroll
                    for (int n = 0; n < 2; ++n) *(f32x4*)(rowp + bj * HALF + n * 16) = acc[ai][bj][m][n] + bv[bj][n]; }
    }
};
struct EpiBf16 {
    static constexpr bool PERM = true, AFTER_DRAIN = false, I8 = false;
    bf16_t* O; int ldc;
    __device__ __forceinline__ void operator()(const f32x4 (&acc)[2][2][4][2], const Unit& u, int wr, int wc, int fr, int fq) const {
        const int row0 = u.pm * BM + wr * 64 + fr, col0 = u.pn * BM + wc * 32 + 8 * fq;
#pragma unroll
        for (int ai = 0; ai < 2; ++ai)
#pragma unroll
            for (int m = 0; m < 4; ++m) { bf16_t* rowp = O + (size_t)(row0 + ai * HALF + m * 16) * ldc + col0;
#pragma unroll
                for (int bj = 0; bj < 2; ++bj) { const f32x4 v0 = acc[ai][bj][m][0], v1 = acc[ai][bj][m][1];
                    u32x4 w; w.x = pack_bf2(v0[0], v0[1]); w.y = pack_bf2(v0[2], v0[3]); w.z = pack_bf2(v1[0], v1[1]); w.w = pack_bf2(v1[2], v1[3]);
                    *(u32x4*)(rowp + bj * HALF) = w; } }
    }
};
struct EpiQkNorm {
    static constexpr bool PERM = true, AFTER_DRAIN = false, I8 = true;
    bf16_t* O; int ldc; const float* gainA; const float* gainB; int gshift; float* red;
    const float* wsc; const float* hsc;
    __device__ __forceinline__ void operator()(const f32x4 (&acc)[2][2][4][2], const Unit& u, int wr, int wc, int fr, int fq) const {
        typedef int i32x4 __attribute__((ext_vector_type(4)));
        f32x4 cs[2][2]; float hs[2][4];
        {
            const int c0_ = u.pn * BM + wc * 32 + 8 * fq, r0_ = u.pm * BM + wr * 64 + fr;
#pragma unroll
            for (int bj = 0; bj < 2; ++bj) { cs[bj][0] = *(const f32x4*)(wsc + c0_ + bj * HALF); cs[bj][1] = *(const f32x4*)(wsc + c0_ + bj * HALF + 4); }
#pragma unroll
            for (int ai = 0; ai < 2; ++ai)
#pragma unroll
                for (int m = 0; m < 4; ++m) hs[ai][m] = hsc[r0_ + ai * HALF + m * 16];
        }
#define QKN_VAL(ai, bj, m, n) (__builtin_convertvector(__builtin_bit_cast(i32x4, acc[ai][bj][m][n]), f32x4) * cs[bj][n] * hs[ai][m])
        float ss[2][4][2];
#pragma unroll
        for (int ai = 0; ai < 2; ++ai)
#pragma unroll
            for (int m = 0; m < 4; ++m)
#pragma unroll
                for (int bj = 0; bj < 2; ++bj) {
                    const f32x4 v0 = QKN_VAL(ai, bj, m, 0), v1 = QKN_VAL(ai, bj, m, 1);
                    float t = v0[0] * v0[0] + v0[1] * v0[1] + v0[2] * v0[2] + v0[3] * v0[3] + v1[0] * v1[0] + v1[1] * v1[1] + v1[2] * v1[2] + v1[3] * v1[3];
                    { const auto s16 = __builtin_amdgcn_permlane16_swap(__float_as_uint(t), __float_as_uint(t), false, false); t = __uint_as_float(s16[0]) + __uint_as_float(s16[1]);
                      const auto s32 = __builtin_amdgcn_permlane32_swap(__float_as_uint(t), __float_as_uint(t), false, false); t = __uint_as_float(s32[0]) + __uint_as_float(s32[1]); }
                    ss[ai][m][bj] = t;
                }
        float* myred = red + (wr * 4 + wc) * 256;
        if (fq == 0) {
#pragma unroll
            for (int ai = 0; ai < 2; ++ai)
#pragma unroll
                for (int m = 0; m < 4; ++m)
#pragma unroll
                    for (int bj = 0; bj < 2; ++bj) myred[(ai * 64 + m * 16 + fr) * 2 + bj] = ss[ai][m][bj];
        }
        asm volatile("s_waitcnt lgkmcnt(0)" ::: "memory"); __builtin_amdgcn_s_barrier(); asm volatile("" ::: "memory");
        const int row0 = u.pm * BM + wr * 64 + fr, col0 = u.pn * BM + wc * 32 + 8 * fq;
        const float* rbase = red + (wr * 4) * 256;
#pragma unroll
        for (int bj = 0; bj < 2; ++bj) {
            const int grp = (u.pn * 2 + bj) >> gshift;
            const float* gain = ((grp & 2) ? gainB : gainA) + (grp & 1) * 128 + wc * 32 + 8 * fq;
            const float qs = (grp & 1) ? 1.f : 0.08838834764831845f * LOG2E;
            float4 g0 = *(const float4*)gain, g1 = *(const float4*)(gain + 4);
            g0.x *= qs; g0.y *= qs; g0.z *= qs; g0.w *= qs; g1.x *= qs; g1.y *= qs; g1.z *= qs; g1.w *= qs;
#pragma unroll
            for (int ai = 0; ai < 2; ++ai)
#pragma unroll
                for (int m = 0; m < 4; ++m) {
                    const int ri = (ai * 64 + m * 16 + fr) * 2 + bj;
                    const float tot = rbase[ri] + rbase[256 + ri] + rbase[512 + ri] + rbase[768 + ri];
                    const float rstd = rsqrtf(tot * (1.f / 128.f) + 1e-6f);
                    const f32x4 v0 = QKN_VAL(ai, bj, m, 0), v1 = QKN_VAL(ai, bj, m, 1);
                    u32x4 w;
                    w.x = pack_bf2(v0[0] * rstd * g0.x, v0[1] * rstd * g0.y); w.y = pack_bf2(v0[2] * rstd * g0.z, v0[3] * rstd * g0.w);
                    w.z = pack_bf2(v1[0] * rstd * g1.x, v1[1] * rstd * g1.y); w.w = pack_bf2(v1[2] * rstd * g1.z, v1[3] * rstd * g1.w);
                    *(u32x4*)(O + (size_t)(row0 + ai * HALF + m * 16) * ldc + col0 + bj * HALF) = w;
                }
        }
#undef QKN_VAL
    }
};
struct EpiVt8 {
    static constexpr bool PERM = true, AFTER_DRAIN = false, I8 = true;
    bf16_t* O; int ldc; const float* rscale; const float* cscale;
    __device__ __forceinline__ void operator()(const f32x4 (&acc)[2][2][4][2], const Unit& u, int wr, int wc, int fr, int fq) const {
        typedef int i32x4 __attribute__((ext_vector_type(4)));
        const int row0 = u.pm * BM + wr * 64 + fr, col0 = u.pn * BM + wc * 32 + 8 * fq;
        f32x4 c0[2], c1[2];
#pragma unroll
        for (int bj = 0; bj < 2; ++bj) { c0[bj] = *(const f32x4*)(cscale + col0 + bj * HALF); c1[bj] = *(const f32x4*)(cscale + col0 + bj * HALF + 4); }
#pragma unroll
        for (int ai = 0; ai < 2; ++ai)
#pragma unroll
            for (int m = 0; m < 4; ++m) { const int row = row0 + ai * HALF + m * 16; const float rs = rscale[row]; bf16_t* rowp = O + (size_t)row * ldc + col0;
#pragma unroll
                for (int bj = 0; bj < 2; ++bj) {
                    const i32x4 i0 = __builtin_bit_cast(i32x4, acc[ai][bj][m][0]), i1 = __builtin_bit_cast(i32x4, acc[ai][bj][m][1]);
                    const f32x4 v0 = __builtin_convertvector(i0, f32x4) * c0[bj] * rs, v1 = __builtin_convertvector(i1, f32x4) * c1[bj] * rs;
                    u32x4 w; w.x = pack_bf2(v0[0], v0[1]); w.y = pack_bf2(v0[2], v0[3]); w.z = pack_bf2(v1[0], v1[1]); w.w = pack_bf2(v1[2], v1[3]);
                    *(u32x4*)(rowp + bj * HALF) = w; } }
    }
};
template <bool IN16>
struct EpiRes16 {
    static constexpr bool PERM = true, AFTER_DRAIN = false, I8 = true;
    bf16_t* O; int ldc; const void* xin; const float* gate; const float* rsc; const float* csc;
    __device__ __forceinline__ void operator()(const f32x4 (&acc)[2][2][4][2], const Unit& u, int wr, int wc, int fr, int fq) const {
        typedef int i32x4 __attribute__((ext_vector_type(4)));
        const int row0 = u.pm * BM + wr * 64 + fr, col0 = u.pn * BM + wc * 32 + 8 * fq;
        const float* gp = gate + (size_t)((u.pm * BM) >> 11) * 12288 + col0;
        f32x4 g0[2], g1[2];
#pragma unroll
        for (int bj = 0; bj < 2; ++bj) { g0[bj] = *(const f32x4*)(gp + bj * HALF) * *(const f32x4*)(csc + col0 + bj * HALF); g1[bj] = *(const f32x4*)(gp + bj * HALF + 4) * *(const f32x4*)(csc + col0 + bj * HALF + 4); }
#pragma unroll
        for (int ai = 0; ai < 2; ++ai)
#pragma unroll
            for (int m = 0; m < 4; ++m) { const size_t ro = (size_t)(row0 + ai * HALF + m * 16) * ldc + col0; const float rs = rsc[row0 + ai * HALF + m * 16];
#pragma unroll
                for (int bj = 0; bj < 2; ++bj) {
                    f32x4 x0, x1;
                    if (IN16) { const u32x4 xw = *(const u32x4*)((const bf16_t*)xin + ro + bj * HALF);
                        x0 = (f32x4){bf_lo(xw.x), bf_hi(xw.x), bf_lo(xw.y), bf_hi(xw.y)}; x1 = (f32x4){bf_lo(xw.z), bf_hi(xw.z), bf_lo(xw.w), bf_hi(xw.w)}; }
                    else { x0 = *(const f32x4*)((const float*)xin + ro + bj * HALF); x1 = *(const f32x4*)((const float*)xin + ro + bj * HALF + 4); }
                    const f32x4 v0 = x0 + g0[bj] * (__builtin_convertvector(__builtin_bit_cast(i32x4, acc[ai][bj][m][0]), f32x4) * rs), v1 = x1 + g1[bj] * (__builtin_convertvector(__builtin_bit_cast(i32x4, acc[ai][bj][m][1]), f32x4) * rs);
                    u32x4 w; w.x = pack_bf2(v0[0], v0[1]); w.y = pack_bf2(v0[2], v0[3]); w.z = pack_bf2(v1[0], v1[1]); w.w = pack_bf2(v1[2], v1[3]);
                    *(u32x4*)(O + ro + bj * HALF) = w; } }
    }
};
struct EpiRes {
    static constexpr bool PERM = false, AFTER_DRAIN = false, I8 = false;
    float* C; int ldc; const float* xin; const float* gate;
    __device__ __forceinline__ void operator()(const f32x4 (&acc)[2][2][4][2], const Unit& u, int wr, int wc, int fr, int fq) const {
        const int row0 = u.pm * BM + wr * 64 + fr, col0 = u.pn * BM + wc * 32 + 4 * fq;
        const float* gp = gate + (size_t)((u.pm * BM) >> 11) * 12288 + col0;
        f32x4 gv[2][2];
#pragma unroll
        for (int bj = 0; bj < 2; ++bj)
#pragma unroll
            for (int n = 0; n < 2; ++n) gv[bj][n] = *(const f32x4*)(gp + bj * HALF + n * 16);
#pragma unroll
        for (int ai = 0; ai < 2; ++ai)
#pragma unroll
            for (int m = 0; m < 4; ++m) { const size_t ro = (size_t)(row0 + ai * HALF + m * 16) * ldc + col0;
#pragma unroll
                for (int bj = 0; bj < 2; ++bj)
#pragma unroll
                    for (int n = 0; n < 2; ++n) { const f32x4 xv = *(const f32x4*)(xin + ro + bj * HALF + n * 16);
                        *(f32x4*)(C + ro + bj * HALF + n * 16) = xv + gv[bj][n] * acc[ai][bj][m][n]; } }
    }
};

template <bool I8>
__device__ __forceinline__ f32x4 pg8_mma(bf16x8 b, bf16x8 a, f32x4 c) {
    if constexpr (I8) {
        typedef int i32x4 __attribute__((ext_vector_type(4)));
        return __builtin_bit_cast(f32x4, __builtin_amdgcn_mfma_i32_16x16x64_i8(__builtin_bit_cast(i32x4, b), __builtin_bit_cast(i32x4, a), __builtin_bit_cast(i32x4, c), 0, 0, 0));
    } else {
        return __builtin_amdgcn_mfma_f32_16x16x32_bf16(b, a, c, 0, 0, 0);
    }
}
template <class Epi, class Sched, bool STAMP = false>
__device__ __forceinline__ void gemm_phase(PG8_LAS unsigned char* lds, const Gemm g, const Sched& S, const Epi& E, unsigned long long* stamps) {
    const int tid = RTID(), wid = __builtin_amdgcn_readfirstlane(tid >> 6), lane = tid & 63, wr = wid >> 2, wc = wid & 3, fr = lane & 15, fq = lane >> 4;
    const int K = g.K, nt = K / BK;
    int ts_lo = 0, ts_hi = 0, nts = 0; const unsigned long long rt_entry = STAMP ? (unsigned long long)wall_clock64() : 0ull;
#define PG8_STAMP() do { if (STAMP && wid == 0 && nts < 64) { const unsigned long long _c = (unsigned long long)clock64(); \
        ts_lo = (lane == nts) ? (int)(unsigned)_c : ts_lo; ts_hi = (lane == nts) ? (int)(unsigned)(_c >> 32) : ts_hi; ++nts; } } while (0)
    PG8_STAMP();
    unsigned voffA[2], voffB[2];
#pragma unroll
    for (int i = 0; i < 2; ++i) { int R, C; stage_rc(tid * 16 + i * 8192, R, C); const int Rb = Epi::PERM ? ((R & ~31) + perm32(R & 31)) : R;
        voffA[i] = (unsigned)(R * K + C) * 2u; voffB[i] = (unsigned)(Rb * K + C) * 2u; }
    const size_t kstep = (size_t)(BK * 2);
    const size_t hstep = (size_t)HALF * K * 2;
    const size_t tstep = 2 * hstep;
    const unsigned ldsw = (unsigned)wid * 1024u;
    const int aoff = lds_byte(wr * 64 + fr, fq * 8), boff = lds_byte(wc * 32 + fr, fq * 8);
#define PG8_SA(b, h) (((b) * 2 + (h)) * HTB)
#define PG8_SB(b, h) ((4 + (b) * 2 + (h)) * HTB)
#define PG8_STAGE(bufoff, gbase, voff) do { _Pragma("unroll") for (int _i = 0; _i < 2; ++_i) \
        __builtin_amdgcn_global_load_lds((const unsigned*)((const char*)(gbase) + (voff)[_i]), (PG8_LAS unsigned*)(lds + (bufoff) + ldsw + _i * 8192), 16, 0, 0); } while (0)
#define PG8_LDA(dst, b, h) do { _Pragma("unroll") for (int m = 0; m < 4; ++m) _Pragma("unroll") for (int k = 0; k < 2; ++k) dst[m][k] = *(const PG8_LAS bf16x8*)(lds + PG8_SA(b, h) + aoff + m * 2048 + k * 1024); } while (0)
#define PG8_LDB(dst, b, h) do { _Pragma("unroll") for (int n = 0; n < 2; ++n) _Pragma("unroll") for (int k = 0; k < 2; ++k) dst[n][k] = *(const PG8_LAS bf16x8*)(lds + PG8_SB(b, h) + boff + n * 2048 + k * 1024); } while (0)
#define PG8_MMA(ai, bj, At, Bt) do { __builtin_amdgcn_s_setprio(1); _Pragma("unroll") for (int m = 0; m < 4; ++m) _Pragma("unroll") for (int n = 0; n < 2; ++n) _Pragma("unroll") for (int k = 0; k < 2; ++k) \
        acc[ai][bj][m][n] = pg8_mma<Epi::I8>(Bt[n][k], At[m][k], acc[ai][bj][m][n]); __builtin_amdgcn_s_setprio(0); } while (0)
#define PG8_WAIT_V(n) asm volatile("s_waitcnt vmcnt(" #n ")" ::: "memory")
#define PG8_WAIT_L(n) asm volatile("s_waitcnt lgkmcnt(" #n ")" ::: "memory")
#define PG8_BAR __builtin_amdgcn_s_barrier()
#define PG8_SCHED __builtin_amdgcn_sched_barrier(0)
    Unit cur, nxt; int ui = 0;
    if (!S.next(0, cur)) return;
    f32x4 acc[2][2][4][2];
#pragma unroll
    for (int a = 0; a < 2; ++a)
#pragma unroll
        for (int b = 0; b < 2; ++b)
#pragma unroll
            for (int m = 0; m < 4; ++m)
#pragma unroll
                for (int n = 0; n < 2; ++n) acc[a][b][m][n] = (f32x4){0.f, 0.f, 0.f, 0.f};
    bf16x8 At[4][2], B0[2][2], B1[2][2];
    const char* cA = (const char*)g.A + (size_t)cur.pm * tstep; const char* cB = (const char*)g.Bt + (size_t)cur.pn * tstep;
    S.a_ready(cur);
    PG8_STAGE(PG8_SB(0, 0), cB, voffB); PG8_STAGE(PG8_SA(0, 0), cA, voffA); PG8_STAGE(PG8_SB(0, 1), cB + hstep, voffB); PG8_STAGE(PG8_SA(0, 1), cA + hstep, voffA);
    if (wr == 1) PG8_BAR;
    PG8_WAIT_V(4); PG8_BAR;
    PG8_STAGE(PG8_SB(1, 0), cB + kstep, voffB); PG8_STAGE(PG8_SA(1, 0), cA + kstep, voffA); PG8_STAGE(PG8_SB(1, 1), cB + hstep + kstep, voffB);
    PG8_WAIT_V(6); PG8_BAR;
    PG8_STAMP();
    for (;;) {
        const bool has_next = S.next(ui + 1, nxt);
        const char* nA = has_next ? (const char*)g.A + (size_t)nxt.pm * tstep : cA; const char* nB = has_next ? (const char*)g.Bt + (size_t)nxt.pn * tstep : cB;
        for (int t = 0; t < nt; t += 2) {
            const bool last = (t == nt - 2);
            const char* a1 = cA + (size_t)(t + 1) * kstep;
            const char* a2 = last ? nA : cA + (size_t)(t + 2) * kstep; const char* b2 = last ? nB : cB + (size_t)(t + 2) * kstep;
            const char* a3 = a2 + kstep; const char* b3 = b2 + kstep;
            if (last && has_next) S.a_ready(nxt);
            PG8_LDB(B0, 0, 0); PG8_SCHED; PG8_LDA(At, 0, 0); PG8_STAGE(PG8_SA(1, 1), a1 + hstep, voffA);
            PG8_WAIT_L(8); PG8_BAR; PG8_WAIT_L(0); PG8_MMA(0, 0, At, B0); PG8_BAR; PG8_SCHED;
            PG8_LDB(B1, 0, 1); PG8_STAGE(PG8_SB(0, 0), b2, voffB);
            PG8_BAR; PG8_WAIT_L(0); PG8_MMA(0, 1, At, B1); PG8_BAR;
            PG8_LDA(At, 0, 1); PG8_STAGE(PG8_SA(0, 0), a2, voffA);
            PG8_BAR; PG8_WAIT_L(0); PG8_MMA(1, 0, At, B0); PG8_BAR; PG8_SCHED;
            PG8_STAGE(PG8_SB(0, 1), b2 + hstep, voffB);
            PG8_WAIT_V(6); PG8_BAR; PG8_MMA(1, 1, At, B1); PG8_BAR;
            PG8_LDB(B0, 1, 0); PG8_SCHED; PG8_LDA(At, 1, 0); PG8_STAGE(PG8_SA(0, 1), a2 + hstep, voffA);
            PG8_WAIT_L(8); PG8_BAR; PG8_WAIT_L(0); PG8_MMA(0, 0, At, B0); PG8_BAR; PG8_SCHED;
            PG8_LDB(B1, 1, 1); PG8_STAGE(PG8_SB(1, 0), b3, voffB);
            PG8_BAR; PG8_WAIT_L(0); PG8_MMA(0, 1, At, B1); PG8_BAR;
            PG8_LDA(At, 1, 1); PG8_STAGE(PG8_SA(1, 0), a3, voffA);
            PG8_BAR; PG8_WAIT_L(0); PG8_MMA(1, 0, At, B0); PG8_BAR; PG8_SCHED;
            PG8_STAGE(PG8_SB(1, 1), b3 + hstep, voffB);
            PG8_WAIT_V(6); PG8_BAR; PG8_MMA(1, 1, At, B1); PG8_BAR;
        }
        PG8_STAMP();
        if constexpr (!Epi::AFTER_DRAIN) { E(acc, cur, wr, wc, fr, fq); S.done(cur); }
        PG8_STAMP();
        if (!has_next) break;
#pragma unroll
        for (int a = 0; a < 2; ++a)
#pragma unroll
            for (int b = 0; b < 2; ++b)
#pragma unroll
                for (int m = 0; m < 4; ++m)
#pragma unroll
                    for (int n = 0; n < 2; ++n) acc[a][b][m][n] = (f32x4){0.f, 0.f, 0.f, 0.f};
        cur = nxt; cA = nA; cB = nB; ++ui;
    }
    PG8_WAIT_V(0);
    if (wr == 0) PG8_BAR;
    PG8_BAR;
    if constexpr (Epi::AFTER_DRAIN) { E.fused(acc, cur, wr, wc, fr, fq, lds, wid, lane); S.done(cur); }
    PG8_STAMP();
    if (STAMP && wid == 0) { stamps[lane] = lane < nts ? (((unsigned long long)(unsigned)ts_hi << 32) | (unsigned)ts_lo) : 0ull;
        if (lane == 62) stamps[62] = rt_entry; if (lane == 63) stamps[63] = (unsigned long long)wall_clock64(); }
#undef PG8_STAMP
#undef PG8_SA
#undef PG8_SB
#undef PG8_STAGE
#undef PG8_LDA
#undef PG8_LDB
#undef PG8_MMA
#undef PG8_WAIT_V
#undef PG8_WAIT_L
#undef PG8_BAR
#undef PG8_SCHED
}
}

struct AttnPtrs { const bf16_t* Q; int ldq; const bf16_t* K; int ldk; const bf16_t* Vt; int ldv; const float* kbias; };

DI float xhalf_max(float v) {
  const auto r2 = __builtin_amdgcn_permlane32_swap(__float_as_uint(v), __float_as_uint(v), false, false);
  return fmaxf(__uint_as_float(r2[0]), __uint_as_float(r2[1]));
}
DI float xhalf_sum(float v) {
  const auto r2 = __builtin_amdgcn_permlane32_swap(__float_as_uint(v), __float_as_uint(v), false, false);
  return __uint_as_float(r2[0]) + __uint_as_float(r2[1]);
}

template <int MODE, int DVB>
DI void attn_block(const AttnPtrs& a, int q0b, char* smem, const float* tbl, f32x16 (&o)[DVB], float& l_out) {
  constexpr int STG = 16384 + DVB * 4096;
  const int tid = RTID(), lane = tid & 63, wave = __builtin_amdgcn_readfirstlane(tid >> 6);
  const int r = lane & 31, h = lane >> 5;
  const int q0 = q0b + 32 * wave;
  const int krow = tid >> 4, kch = tid & 15;
  const int vrow = tid >> 3, vch = tid & 7;
  const char* Kb = (const char*)a.K;
  const char* Vb = (const char*)a.Vt;
  const unsigned kvo = (unsigned)(krow * a.ldk + kch * 8) * 2u;
  const unsigned vvo = (unsigned)(vrow * a.ldv + vch * 8) * 2u;
  const unsigned kst = (unsigned)(32 * a.ldk) * 2u, vst = (unsigned)(64 * a.ldv) * 2u;
  const int kwo = krow * 256 + ((kch ^ (krow & 15)) << 4);
  const int vwo = 16384 + vrow * 128 + ((vch ^ ((vrow >> 1) & 7)) << 4);
  const int pr = (r & ~12) | ((r & 4) << 1) | ((r & 8) >> 1);
  const int kro = pr * 256, ksw = pr & 15;
  const int vro = 16384 + r * 128, vsw = (r >> 1) & 7;
  bf16x8 qf[8];
#pragma unroll
  for (int s = 0; s < 8; ++s) qf[s] = *(const bf16x8*)(a.Q + (size_t)(q0 + r) * a.ldq + 16 * s + 8 * h);
#pragma unroll
  for (int dt = 0; dt < DVB; ++dt)
#pragma unroll
    for (int e = 0; e < 16; ++e) o[dt][e] = 0.f;
  float m = -1e30f, l = 0.f;
  const int nkt = (q0b + 256) >> 6;
  u32x4 rk[2], rv[DVB / 2];
#pragma unroll
  for (int i = 0; i < 2; ++i) rk[i] = *(const u32x4*)(Kb + (size_t)(i * kst) + kvo);
#pragma unroll
  for (int i = 0; i < DVB / 2; ++i) rv[i] = *(const u32x4*)(Vb + (size_t)(i * vst) + vvo);
#pragma unroll
  for (int i = 0; i < 2; ++i) *(u32x4*)(smem + kwo + i * 8192) = rk[i];
#pragma unroll
  for (int i = 0; i < DVB / 2; ++i) *(u32x4*)(smem + vwo + i * 8192) = rv[i];
  u32x4 rkB[2], rvB[DVB / 2];
  if constexpr (DVB == 4) {
    const int k1 = nkt > 1 ? 64 : 0;
#pragma unroll
    for (int i = 0; i < 2; ++i) rk[i] = *(const u32x4*)(Kb + ((size_t)k1 * (size_t)a.ldk * 2u + i * kst) + kvo);
#pragma unroll
    for (int i = 0; i < DVB / 2; ++i) rv[i] = *(const u32x4*)(Vb + ((size_t)k1 * 2u + i * vst) + vvo);
  }
  __syncthreads();
#define ATT_TILE(KT, RL, RVL, RW, RVW) { const int kt = (KT); \
    const int k0 = kt << 6; \
    char* st = smem + (kt & 1) * STG; \
    { \
      const int kn = (kt + 2 < nkt ? kt + 2 : nkt - 1) << 6;        \
      const size_t kbo = (size_t)kn * (size_t)a.ldk * 2u, vbo = (size_t)kn * 2u; \
_Pragma("unroll") \
      for (int i = 0; i < 2; ++i) RL[i] = *(const u32x4*)(Kb + (kbo + i * kst) + kvo); \
_Pragma("unroll") \
      for (int i = 0; i < DVB / 2; ++i) RVL[i] = *(const u32x4*)(Vb + (vbo + i * vst) + vvo); \
    } \
    asm volatile("" ::: "memory"); \
    __builtin_amdgcn_sched_barrier(0); \
_Pragma("unroll") \
    for (int sub = 0; sub < 2; ++sub) { \
      const int ks0 = k0 + 32 * sub; \
      if (ks0 <= q0) { \
        f32x16 sa; \
_Pragma("unroll") \
        for (int e = 0; e < 16; ++e) sa[e] = 0.f; \
_Pragma("unroll") \
        for (int s = 0; s < 8; ++s) { \
          const bf16x8 kf = *(const bf16x8*)(st + kro + sub * 8192 + (((2 * s + h) ^ ksw) << 4)); \
          sa = MFMA32(kf, qf[s], sa); \
        } \
        float v[16]; \
        if (MODE == 0) { \
_Pragma("unroll") \
          for (int c = 0; c < 2; ++c) { \
            const float4 kb0 = *(const float4*)(a.kbias + ks0 + 16 * c + 8 * h); \
            const float4 kb1 = *(const float4*)(a.kbias + ks0 + 16 * c + 8 * h + 4); \
            v[8 * c + 0] = sa[8 * c + 0] - kb0.x * LOG2E; v[8 * c + 1] = sa[8 * c + 1] - kb0.y * LOG2E; \
            v[8 * c + 2] = sa[8 * c + 2] - kb0.z * LOG2E; v[8 * c + 3] = sa[8 * c + 3] - kb0.w * LOG2E; \
            v[8 * c + 4] = sa[8 * c + 4] - kb1.x * LOG2E; v[8 * c + 5] = sa[8 * c + 5] - kb1.y * LOG2E; \
            v[8 * c + 6] = sa[8 * c + 6] - kb1.z * LOG2E; v[8 * c + 7] = sa[8 * c + 7] - kb1.w * LOG2E; \
          } \
          if (ks0 == q0) { \
_Pragma("unroll") \
            for (int e = 0; e < 16; ++e) if ((e & 7) + 8 * h + 16 * (e >> 3) > r) v[e] = -INFINITY; \
          } \
        } else { \
          const float* tp = tbl + (q0 - ks0) + r + 32 - 8 * h - 23; \
_Pragma("unroll") \
          for (int e = 0; e < 16; ++e) v[e] = sa[e] + tp[23 - ((e & 7) + 16 * (e >> 3))]; \
        } \
        float mx = v[0]; \
_Pragma("unroll") \
        for (int e = 1; e < 16; ++e) mx = fmaxf(mx, v[e]); \
        mx = xhalf_max(mx); \
        if (__ballot(mx > m + 8.f) != 0ull) { \
          const float mn = fmaxf(m, mx); \
          const float alpha = __builtin_amdgcn_exp2f(m - mn); \
          m = mn; \
          l *= alpha; \
_Pragma("unroll") \
          for (int dt = 0; dt < DVB; ++dt) \
_Pragma("unroll") \
            for (int e = 0; e < 16; ++e) o[dt][e] *= alpha; \
        } \
        float ps = 0.f; \
_Pragma("unroll") \
        for (int e = 0; e < 16; ++e) { v[e] = __builtin_amdgcn_exp2f(v[e] - m); ps += v[e]; } \
        l += ps; \
        bf16x8 pb[2]; \
_Pragma("unroll") \
        for (int s = 0; s < 2; ++s) { \
          const u32x4 u = {pack_bf2(v[8 * s + 0], v[8 * s + 1]), pack_bf2(v[8 * s + 2], v[8 * s + 3]), \
                           pack_bf2(v[8 * s + 4], v[8 * s + 5]), pack_bf2(v[8 * s + 6], v[8 * s + 7])}; \
          pb[s] = __builtin_bit_cast(bf16x8, u); \
        } \
_Pragma("unroll") \
        for (int dt = 0; dt < DVB; ++dt) \
_Pragma("unroll") \
          for (int s = 0; s < 2; ++s) { \
            const bf16x8 va = *(const bf16x8*)(st + vro + dt * 4096 + (((4 * sub + 2 * s + h) ^ vsw) << 4)); \
            o[dt] = MFMA32(va, pb[s], o[dt]); \
          } \
      } \
    } \
    __builtin_amdgcn_sched_barrier(0); \
    asm volatile("" ::: "memory"); \
    { \
      char* sn = smem + ((kt + 1) & 1) * STG; \
_Pragma("unroll") \
      for (int i = 0; i < 2; ++i) *(u32x4*)(sn + kwo + i * 8192) = RW[i]; \
_Pragma("unroll") \
      for (int i = 0; i < DVB / 2; ++i) *(u32x4*)(sn + vwo + i * 8192) = RVW[i]; \
    } \
    __syncthreads(); \
  }
  if constexpr (DVB == 4) {
  for (int kt2 = 0; kt2 < nkt; kt2 += 2) {
    ATT_TILE(kt2, rkB, rvB, rk, rv)
    if (kt2 + 1 < nkt) ATT_TILE(kt2 + 1, rk, rv, rkB, rvB)
  }
  } else {
  for (int kt = 0; kt < nkt; ++kt) {
    const int k0 = kt << 6;
    char* st = smem + (kt & 1) * STG;
    {
      const int kn = (kt + 1 < nkt) ? k0 + 64 : k0;
      const size_t kbo = (size_t)kn * (size_t)a.ldk * 2u, vbo = (size_t)kn * 2u;
#pragma unroll
      for (int i = 0; i < 2; ++i) rk[i] = *(const u32x4*)(Kb + (kbo + i * kst) + kvo);
#pragma unroll
      for (int i = 0; i < DVB / 2; ++i) rv[i] = *(const u32x4*)(Vb + (vbo + i * vst) + vvo);
    }
    asm volatile("" ::: "memory");
    __builtin_amdgcn_sched_barrier(0);
#pragma unroll
    for (int sub = 0; sub < 2; ++sub) {
      const int ks0 = k0 + 32 * sub;
      if (ks0 <= q0) {
        f32x16 sa;
#pragma unroll
        for (int e = 0; e < 16; ++e) sa[e] = 0.f;
#pragma unroll
        for (int s = 0; s < 8; ++s) {
          const bf16x8 kf = *(const bf16x8*)(st + kro + sub * 8192 + (((2 * s + h) ^ ksw) << 4));
          sa = MFMA32(kf, qf[s], sa);
        }
        float v[16];
        if (MODE == 0) {
#pragma unroll
          for (int c = 0; c < 2; ++c) {
            const float4 kb0 = *(const float4*)(a.kbias + ks0 + 16 * c + 8 * h);
            const float4 kb1 = *(const float4*)(a.kbias + ks0 + 16 * c + 8 * h + 4);
            v[8 * c + 0] = sa[8 * c + 0] - kb0.x * LOG2E; v[8 * c + 1] = sa[8 * c + 1] - kb0.y * LOG2E;
            v[8 * c + 2] = sa[8 * c + 2] - kb0.z * LOG2E; v[8 * c + 3] = sa[8 * c + 3] - kb0.w * LOG2E;
            v[8 * c + 4] = sa[8 * c + 4] - kb1.x * LOG2E; v[8 * c + 5] = sa[8 * c + 5] - kb1.y * LOG2E;
            v[8 * c + 6] = sa[8 * c + 6] - kb1.z * LOG2E; v[8 * c + 7] = sa[8 * c + 7] - kb1.w * LOG2E;
          }
          if (ks0 == q0) {
#pragma unroll
            for (int e = 0; e < 16; ++e) if ((e & 7) + 8 * h + 16 * (e >> 3) > r) v[e] = -INFINITY;
          }
        } else {
          const float* tp = tbl + (q0 - ks0) + r + 32 - 8 * h - 23;
#pragma unroll
          for (int e = 0; e < 16; ++e) v[e] = sa[e] + tp[23 - ((e & 7) + 16 * (e >> 3))];
        }
        float mx = v[0];
#pragma unroll
        for (int e = 1; e < 16; ++e) mx = fmaxf(mx, v[e]);
        mx = xhalf_max(mx);
        if (__ballot(mx > m + 8.f) != 0ull) {
          const float mn = fmaxf(m, mx);
          const float alpha = __builtin_amdgcn_exp2f(m - mn);
          m = mn;
          l *= alpha;
#pragma unroll
          for (int dt = 0; dt < DVB; ++dt)
#pragma unroll
            for (int e = 0; e < 16; ++e) o[dt][e] *= alpha;
        }
        float ps = 0.f;
#pragma unroll
        for (int e = 0; e < 16; ++e) { v[e] = __builtin_amdgcn_exp2f(v[e] - m); ps += v[e]; }
        l += ps;
        bf16x8 pb[2];
#pragma unroll
        for (int s = 0; s < 2; ++s) {
          const u32x4 u = {pack_bf2(v[8 * s + 0], v[8 * s + 1]), pack_bf2(v[8 * s + 2], v[8 * s + 3]),
                           pack_bf2(v[8 * s + 4], v[8 * s + 5]), pack_bf2(v[8 * s + 6], v[8 * s + 7])};
          pb[s] = __builtin_bit_cast(bf16x8, u);
        }
#pragma unroll
        for (int dt = 0; dt < DVB; ++dt)
#pragma unroll
          for (int s = 0; s < 2; ++s) {
            const bf16x8 va = *(const bf16x8*)(st + vro + dt * 4096 + (((4 * sub + 2 * s + h) ^ vsw) << 4));
            o[dt] = MFMA32(va, pb[s], o[dt]);
          }
      }
    }
    __builtin_amdgcn_sched_barrier(0);
    asm volatile("" ::: "memory");
    {
      char* sn = smem + ((kt + 1) & 1) * STG;
#pragma unroll
      for (int i = 0; i < 2; ++i) *(u32x4*)(sn + kwo + i * 8192) = rk[i];
#pragma unroll
      for (int i = 0; i < DVB / 2; ++i) *(u32x4*)(sn + vwo + i * 8192) = rv[i];
    }
    __syncthreads();
  }
  }
#undef ATT_TILE
  l_out = xhalf_sum(l);
}

template <int N = 4, int B0 = 0>
DI void attn_store_bf16(const f32x16 (&o)[N], float linv, bf16_t* out_row  , int ldo) {
  const int lane = TID() & 63, r = lane & 31, h = lane >> 5;
  bf16_t* op = out_row + (size_t)r * ldo + 4 * h;
#pragma unroll
  for (int dt = 0; dt < 4; ++dt)
#pragma unroll
    for (int c = 0; c < 4; ++c)
      *(uint2*)(op + 32 * dt + 8 * c) = make_uint2(pack_bf2(o[B0 + dt][4 * c] * linv, o[B0 + dt][4 * c + 1] * linv),
                                                    pack_bf2(o[B0 + dt][4 * c + 2] * linv, o[B0 + dt][4 * c + 3] * linv));
}
template <int N, int B0>
DI void attn_store_f32(const f32x16 (&o)[N], float linv, float* out_row, int ldo) {
  const int lane = TID() & 63, r = lane & 31, h = lane >> 5;
  float* op = out_row + (size_t)r * ldo + 4 * h;
#pragma unroll
  for (int dt = 0; dt < 4; ++dt)
#pragma unroll
    for (int c = 0; c < 4; ++c)
      *(float4*)(op + 32 * dt + 8 * c) = make_float4(o[B0 + dt][4 * c] * linv, o[B0 + dt][4 * c + 1] * linv, o[B0 + dt][4 * c + 2] * linv, o[B0 + dt][4 * c + 3] * linv);
}

DI int t5_bucket(int n) {
  if (n < 16) return n;
  int lg = 16 + (int)(logf((float)n / 16.f) / 4.852030263919617f * 16.f);
  return lg < 31 ? lg : 31;
}

DI void phase_attn_even(const Params& p, char* smem) {
  const int tid = RTID(), wave = __builtin_amdgcn_readfirstlane(tid >> 6), bid = blockIdx.x, G = gridDim.x;
  const bf16_t* QK = (const bf16_t*)(p.ws + WS_QK);
  const bf16_t* VT = (const bf16_t*)(p.ws + WS_VT);
  bf16_t* ATT = (bf16_t*)(p.ws + WS_ATT);
  bf16_t* PCS = (bf16_t*)(p.ws + WS_SC);
  float* tbl = (float*)(smem + 98304);
  int cur_head = -1;
  for (int rnd = 0; rnd * G < 1024; ++rnd) {
    int item = rnd * G + ((rnd & 1) ? G - 1 - bid : bid);
    if (G == 256) {
      const int rc = rnd * 4 + (bid >> 6);
      const int gq = (int)((0x6767455432231010ull >> (4 * rc)) & 15ull), dq = (0x3CC3 >> rc) & 1;
      item = gq * 128 + (dq ? 0 : 64) + (bid & 63);
    }
    if (item >= 1024) break;
    const int g = item >> 7; int rem = item & 127;
    const int qb = 7 - g;
    const int q0b = qb * 256, q0 = q0b + 32 * wave;
    __syncthreads();
    if (rem >= 64) {
      rem -= 64;
      const int b = rem >> 3, hh = rem & 7;
      AttnPtrs a;
      a.Q = QK + (size_t)b * S_ * 4096 + hh * 128; a.ldq = 4096;
      a.K = a.Q + 1024; a.ldk = 4096;
      a.Vt = VT + (size_t)(hh * 128) * T_ + b * S_; a.ldv = T_;
      a.kbias = (const float*)(p.ws + WS_FCUM) + (size_t)(b * 8 + hh) * S_;
      f32x16 o[4]; float l;
      attn_block<0, 4>(a, q0b, smem, nullptr, o, l);
      attn_store_bf16(o, 1.f / l, ATT + (size_t)(b * S_ + q0) * D_ + hh * 128, D_);
    } else {
      const int b = rem >> 3, hh = (rem >> 1) & 3, mm = rem & 1;
      if (hh != cur_head) {
        for (int e = tid; e < 2080; e += RTHREADS) {
          const int dist = e - 32;
          tbl[e] = dist >= 0 ? p.rel_bias[t5_bucket(dist) * 16 + hh] * LOG2E : -INFINITY;
        }
        cur_head = hh;
      }
      AttnPtrs a;
      a.Q = QK + (size_t)b * S_ * 4096 + 2048 + hh * 256 + mm * 128; a.ldq = 4096;
      a.K = a.Q + 1024; a.ldk = 4096;
      a.Vt = VT + (size_t)(1024 + hh * 256) * T_ + b * S_; a.ldv = T_;
      a.kbias = nullptr;
      f32x16 o[8]; float l;
      attn_block<1, 8>(a, q0b, smem, tbl, o, l);
      const float linv = 1.f / l;
      attn_store_bf16<8, 0>(o, linv, PCS + (((size_t)(mm * 2 + 0) * T_ + (size_t)(b * S_ + q0)) * 4 + hh) * 128, 512);
      attn_store_bf16<8, 4>(o, linv, PCS + (((size_t)(mm * 2 + 1) * T_ + (size_t)(b * S_ + q0)) * 4 + hh) * 128, 512);
    }
  }
}

DI void phase_diff_combine(const Params& p) {
  const int lane = TID() & 63;
  const int gw = __builtin_amdgcn_readfirstlane((VBID() * NTHREADS + TID()) >> 6), nw = (VGRID() * NTHREADS) >> 6;
  const bf16_t* PCS = (const bf16_t*)(p.ws + WS_SC);
  const bf16_t* ATT = (const bf16_t*)(p.ws + WS_ATT);
  unsigned char* A8 = (unsigned char*)(p.ws + WS_ATT8);
  float* A8S = (float*)(p.ws + WS_ATT8 + 32 * MiB);
  const float lam = ((const float*)(p.ws + WS_MISC))[0];
  const int hh = lane >> 4, seg = lane & 15, half = seg >> 3, off = (seg & 7) * 16;
  float sg[16];
#pragma unroll
  for (int i = 0; i < 4; ++i) { const float4 g = *(const float4*)(p.even_diff_subln_gain + seg * 16 + 4 * i); sg[4 * i] = g.x; sg[4 * i + 1] = g.y; sg[4 * i + 2] = g.z; sg[4 * i + 3] = g.w; }
  for (int t = gw; t < T_; t += nw) {
    const bf16_t* p0 = PCS + (((size_t)(0 + half) * T_ + t) * 4 + hh) * 128 + off;
    const bf16_t* p1 = PCS + (((size_t)(2 + half) * T_ + t) * 4 + hh) * 128 + off;
    const u32x4 a0 = *(const u32x4*)p0, a1 = *(const u32x4*)(p0 + 8), b0 = *(const u32x4*)p1, b1 = *(const u32x4*)(p1 + 8);
    const u32x4 f0 = *(const u32x4*)(ATT + (size_t)t * D_ + lane * 16), f1 = *(const u32x4*)(ATT + (size_t)t * D_ + lane * 16 + 8);
    float v[16], f[16];
    float ss = 0.f;
#pragma unroll
    for (int i = 0; i < 4; ++i) {
      v[2 * i] = bf_lo(a0[i]) - lam * bf_lo(b0[i]); v[2 * i + 1] = bf_hi(a0[i]) - lam * bf_hi(b0[i]);
      v[8 + 2 * i] = bf_lo(a1[i]) - lam * bf_lo(b1[i]); v[8 + 2 * i + 1] = bf_hi(a1[i]) - lam * bf_hi(b1[i]);
      f[2 * i] = bf_lo(f0[i]); f[2 * i + 1] = bf_hi(f0[i]); f[8 + 2 * i] = bf_lo(f1[i]); f[8 + 2 * i + 1] = bf_hi(f1[i]);
    }
#pragma unroll
    for (int i = 0; i < 16; ++i) ss += v[i] * v[i];
    ss = row16_sum(ss);
    const float rstd = rsqrtf(ss * (1.f / 256.f) + 1e-6f) * 0.8f;
    float am = 0.f;
#pragma unroll
    for (int i = 0; i < 16; ++i) { v[i] = v[i] * rstd * sg[i]; am = fmaxf(am, fmaxf(fabsf(v[i]), fabsf(f[i]))); }
    am = wave_max(am);
    const float qs = am > 0.f ? 127.f / am : 1.f;
    u32x4 qf, qd;
#pragma unroll
    for (int i = 0; i < 4; ++i) { qf[i] = pack_i8x4(f[4 * i] * qs, f[4 * i + 1] * qs, f[4 * i + 2] * qs, f[4 * i + 3] * qs); qd[i] = pack_i8x4(v[4 * i] * qs, v[4 * i + 1] * qs, v[4 * i + 2] * qs, v[4 * i + 3] * qs); }
    *(u32x4*)(A8 + (size_t)t * D_ + lane * 16) = qf;
    *(u32x4*)(A8 + (size_t)t * D_ + 1024 + lane * 16) = qd;
    if (lane == 0) A8S[t] = am > 0.f ? am / 127.f : 1.f;
  }
}

DI void quant_att(const Params& p) {
  const int lane = TID() & 63;
  const int gw = __builtin_amdgcn_readfirstlane((VBID() * NTHREADS + TID()) >> 6), nw = (VGRID() * NTHREADS) >> 6;
  const bf16_t* ATT = (const bf16_t*)(p.ws + WS_ATT);
  unsigned char* A8 = (unsigned char*)(p.ws + WS_ATT8);
  float* A8S = (float*)(p.ws + WS_ATT8 + 32 * MiB);
  for (int t = gw; t < T_; t += nw) {
    const bf16_t* src = ATT + (size_t)t * D_ + lane * 32;
    u32x4 w[4];
#pragma unroll
    for (int i = 0; i < 4; ++i) w[i] = *(const u32x4*)(src + 8 * i);
    float f[32];
    float am = 0.f;
#pragma unroll
    for (int i = 0; i < 4; ++i)
#pragma unroll
      for (int j = 0; j < 4; ++j) { f[8 * i + 2 * j] = bf_lo(w[i][j]); f[8 * i + 2 * j + 1] = bf_hi(w[i][j]); am = fmaxf(am, fmaxf(fabsf(f[8 * i + 2 * j]), fabsf(f[8 * i + 2 * j + 1]))); }
    am = wave_max(am);
    const float qs = am > 0.f ? 127.f / am : 1.f;
    u32x4 q0, q1;
#pragma unroll
    for (int i = 0; i < 4; ++i) { q0[i] = pack_i8x4(f[4 * i] * qs, f[4 * i + 1] * qs, f[4 * i + 2] * qs, f[4 * i + 3] * qs); q1[i] = pack_i8x4(f[16 + 4 * i] * qs, f[16 + 4 * i + 1] * qs, f[16 + 4 * i + 2] * qs, f[16 + 4 * i + 3] * qs); }
    unsigned char* dst = A8 + (size_t)t * D_ + lane * 32;
    *(u32x4*)dst = q0; *(u32x4*)(dst + 16) = q1;
    if (lane == 0) A8S[t] = am > 0.f ? am / 127.f : 1.f;
  }
}

DI void phase_attn_odd(const Params& p, char* smem) {
  const int tid = RTID(), wave = __builtin_amdgcn_readfirstlane(tid >> 6), bid = blockIdx.x, G = gridDim.x;
  const bf16_t* QK = (const bf16_t*)(p.ws + WS_QK);
  const bf16_t* VT = (const bf16_t*)(p.ws + WS_VT);
  bf16_t* ATT = (bf16_t*)(p.ws + WS_ATT);
  float* tbl = (float*)(smem + 98304);
  int cur_head = -1;
  for (int rnd = 0; rnd * G < 1024; ++rnd) {
    const int item = rnd * G + ((rnd & 1) ? G - 1 - bid : bid);
    if (item >= 1024) break;
    const int g = item >> 7, rem = item & 127;
    const int qb = 7 - g, b = rem >> 4, hd = rem & 15;
    __syncthreads();
    if (hd != cur_head) {
      for (int e = tid; e < 2080; e += RTHREADS) {
        const int dist = e - 32;
        float val = -INFINITY;
        if (dist >= 0) {
          int cnt = 0;
          if (dist <= 128) cnt += 1;
          if (dist <= 512 && (dist & 3) == 0) cnt += 1;
          if ((dist & 15) == 0) cnt += 1;
          if (cnt > 0) val = (p.rel_bias[t5_bucket(dist) * 16 + hd] + __logf((float)cnt)) * LOG2E;
        }
        tbl[e] = val;
      }
      cur_head = hd;
    }
    const int q0b = qb * 256, q0 = q0b + 32 * wave;
    AttnPtrs a;
    a.Q = QK + (size_t)b * S_ * 4096 + hd * 128; a.ldq = 4096;
    a.K = a.Q + 2048; a.ldk = 4096;
    a.Vt = VT + (size_t)(hd * 128) * T_ + b * S_; a.ldv = T_;
    a.kbias = nullptr;
    f32x16 o[4]; float l;
    attn_block<1, 4>(a, q0b, smem, tbl, o, l);
    attn_store_bf16(o, 1.f / l, ATT + (size_t)(b * S_ + q0) * D_ + hd * 128, D_);
  }
}

DI float gelu_erf(float x) { return 0.5f * x * (1.f + erff(x * 0.7071067811865476f)); }

DI void ins16(float (&L)[16], float x) {
#pragma unroll
  for (int k = 15; k >= 1; --k) L[k] = __builtin_amdgcn_fmed3f(L[k - 1], L[k], x);
  L[0] = __builtin_amdgcn_fmed3f(__builtin_inff(), L[0], x);
}
DI float f_and_or(float v, unsigned mask, unsigned orv) { return __uint_as_float((__float_as_uint(v) & mask) | orv); }

DI void phase_peer_retrieve(const Params& p, char* smem) {
  const int tid = TID(), lane = tid & 63, wave = __builtin_amdgcn_readfirstlane(tid >> 6);
  const int gw = __builtin_amdgcn_readfirstlane((VBID() * NTHREADS + tid) >> 6), nw = (VGRID() * NTHREADS) >> 6;
  unsigned* wbuf = (unsigned*)(smem + wave * 9216);
  const bf16_t* SC = (const bf16_t*)(p.ws + WS_SC);
  unsigned short* IDX = (unsigned short*)(p.ws + WS_IDX);
  float* GATE = (float*)(p.ws + WS_GATE);
  const float NINF = -__builtin_inff();
  for (int it = gw; it < T_ / 8; it += nw) {
    const bf16_t* gsrc = SC + (size_t)it * (8 * 2048) + (lane >> 2) * 256 + (lane & 3) * 8;
    unsigned* wdst = wbuf + (lane >> 2) * 20 + (lane & 3) * 4;
    const unsigned* wsrc = wbuf + lane * 20;
    u32x4 stg[4];
#define PR_LOAD(CH) _Pragma("unroll") for (int i = 0; i < 4; ++i) stg[i] = *(const u32x4*)(gsrc + i * (16 * 256) + ((CH) >> 2) * 128 + ((CH) & 3) * 32);
    PR_LOAD(0)
    float A[16], B[16];
#pragma unroll
    for (int hf = 0; hf < 2; ++hf) {
      float L[16];
#pragma unroll
      for (int k = 0; k < 16; ++k) L[k] = NINF;
#pragma unroll 1
      for (int c = 0; c < 4; ++c) {
#pragma unroll
        for (int i = 0; i < 4; ++i) *(u32x4*)(wdst + i * (16 * 20)) = stg[i];
        { const int cn = hf * 4 + c + 1 < 7 ? hf * 4 + c + 1 : 7; PR_LOAD(cn) }
        u32x4 v[4];
#pragma unroll
        for (int k = 0; k < 4; ++k) v[k] = *(const u32x4*)(wsrc + 4 * k);
#pragma unroll
        for (int k = 0; k < 4; ++k)
#pragma unroll
          for (int e = 0; e < 4; ++e) {
            const unsigned w = v[k][e], id0 = (unsigned)(c * 32 + 8 * k + 2 * e);
            ins16(L, __uint_as_float((w << 16) | id0));
            ins16(L, __uint_as_float((w & 0xFFFF0000u) | (id0 + 1u)));
          }
      }
#pragma unroll
      for (int k = 0; k < 16; ++k) { if (hf == 0) A[k] = L[k]; else B[k] = L[k]; }
    }
#undef PR_LOAD
    unsigned* lut = wbuf + lane * 33;
#pragma unroll
    for (int k = 0; k < 16; ++k) {
      const unsigned ua = __float_as_uint(A[k]), ub = __float_as_uint(B[k]);
      lut[k] = (ua & 0x7Fu) << 7; lut[16 + k] = ub & 0x7Fu;
      A[k] = __uint_as_float(ua & 0xFFFFFF80u); B[k] = __uint_as_float(ub & 0xFFFFFF80u);
    }
    float C[16];
#pragma unroll
    for (int k = 0; k < 16; ++k) C[k] = NINF;
#pragma unroll
    for (int i = 0; i < 16; ++i)
#pragma unroll
      for (int j = 0; j < 16; ++j)
        if ((i + 1) * (j + 1) <= 16) ins16(C, f_and_or(A[i] + B[j], 0xFFFFFF00u, (unsigned)(i * 16 + j)));
    float ev[16], es = 0.f;
    int ids[16];
    const float mx = __uint_as_float(__float_as_uint(C[0]) & 0xFFFFFF00u);
#pragma unroll
    for (int k = 0; k < 16; ++k) {
      const unsigned uc = __float_as_uint(C[k]);
      ev[k] = __expf(__uint_as_float(uc & 0xFFFFFF00u) - mx);
      es += ev[k];
      ids[k] = (int)(lut[(uc >> 4) & 15u] + lut[16 + (uc & 15u)]);
    }
    const float inv = 1.f / es;
    unsigned short* ip = IDX + (size_t)it * (8 * 128) + lane * 16;
    float* gp = GATE + (size_t)it * (8 * 128) + lane * 16;
#pragma unroll
    for (int q = 0; q < 2; ++q)
      *(u32x4*)(ip + 8 * q) = (u32x4){(unsigned)ids[8 * q] | ((unsigned)ids[8 * q + 1] << 16), (unsigned)ids[8 * q + 2] | ((unsigned)ids[8 * q + 3] << 16),
                                      (unsigned)ids[8 * q + 4] | ((unsigned)ids[8 * q + 5] << 16), (unsigned)ids[8 * q + 6] | ((unsigned)ids[8 * q + 7] << 16)};
#pragma unroll
    for (int q = 0; q < 4; ++q)
      *(float4*)(gp + 4 * q) = make_float4(ev[4 * q] * inv, ev[4 * q + 1] * inv, ev[4 * q + 2] * inv, ev[4 * q + 3] * inv);
  }
}

DI unsigned peer_ticket_issue(unsigned* cnt) {
  unsigned v = 0;
  if ((TID() & 63) == 0) v = __hip_atomic_fetch_add(cnt, 1u, __ATOMIC_RELAXED, __HIP_MEMORY_SCOPE_AGENT);
  return v;
}
DI float oct_sum(float v) {
  v += __builtin_bit_cast(float, __builtin_amdgcn_update_dpp(0, __builtin_bit_cast(int, v), 0xB1, 0xF, 0xF, true));
  v += __builtin_bit_cast(float, __builtin_amdgcn_update_dpp(0, __builtin_bit_cast(int, v), 0x4E, 0xF, 0xF, true));
  v += __builtin_bit_cast(float, __builtin_amdgcn_update_dpp(0, __builtin_bit_cast(int, v), 0x141, 0xF, 0xF, true));
  return v;
}

DI unsigned swar_add8(unsigned x) { return ((x & 0x7F7F7F7Fu) + 0x08080808u) ^ (x & 0x80808080u); }
DI void phase_peer_dots(const Params& p, int layer, char* smem_all) {
  const int rtid = RTID(), lane = rtid & 63, rwave = __builtin_amdgcn_readfirstlane(rtid >> 6);
  const int g = lane >> 3, j = lane & 7;
  float* lpd = (float*)(smem_all + 73728 + rwave * 4096);
  int* lidx_all = (int*)(smem_all + rwave * 8704);
  const unsigned char* H8 = (const unsigned char*)(p.ws + WS_H8);
  const unsigned short* IDX = (const unsigned short*)(p.ws + WS_IDX);
  bf16_t* PD = (bf16_t*)(p.ws + WS_PD);
  const unsigned char* PU = (const unsigned char*)(p.ws + WS_PEERU) + (size_t)layer * (8 * NEXP * 128);
  unsigned* tick = (unsigned*)(p.ws + WS_TICKETS) + (size_t)(layer * 2 + 0) * 16 * 16;
  const int xcc = xcc_id() & 7;
#pragma unroll 1
  for (int so = 0; so < 8; ++so) {
    const int s = (xcc + so) & 7;
    unsigned tv = peer_ticket_issue(tick + s * 16);
    for (;;) {
      const int c = __builtin_amdgcn_readfirstlane((int)tv);
      if (c >= T_ / 16) break;
      tv = peer_ticket_issue(tick + s * 16);
#pragma unroll
      for (int gi = 0; gi < 2; ++gi) {
        const unsigned short* ip = IDX + (size_t)(c * 16 + gi * 8 + g) * 128 + 16 * j;
        const u32x4 i0 = *(const u32x4*)ip, i1 = *(const u32x4*)(ip + 8);
        const unsigned iw[8] = {i0.x, i0.y, i0.z, i0.w, i1.x, i1.y, i1.z, i1.w};
#pragma unroll
        for (int i = 0; i < 4; ++i) *(uint4*)(lidx_all + gi * 1056 + g * 132 + 16 * j + 4 * i) = make_uint4(iw[2 * i] & 0xFFFFu, iw[2 * i] >> 16, iw[2 * i + 1] & 0xFFFFu, iw[2 * i + 1] >> 16);
      }
#pragma unroll 1
      for (int gi = 0; gi < 2; ++gi) {
      const int t0 = c * 16 + gi * 8;
      const int* lidx = lidx_all + gi * 1056;
      unsigned xl[4], xh[4];
      {
        const unsigned char* hp = H8 + (size_t)(t0 + g) * D_ + s * 256 + 32 * j;
        const u32x4 h0 = *(const u32x4*)hp, h1 = *(const u32x4*)(hp + 16);
        const unsigned d[8] = {h0.x, h0.y, h0.z, h0.w, h1.x, h1.y, h1.z, h1.w};
#pragma unroll
        for (int m = 0; m < 4; ++m) {
          xl[m] = (d[2 * m] & 0x0F0F0F0Fu) | ((d[2 * m + 1] & 0x0F0F0F0Fu) << 4);
          xh[m] = ((swar_add8(d[2 * m]) >> 4) & 0x0F0F0F0Fu) | (swar_add8(d[2 * m + 1]) & 0xF0F0F0F0u);
        }
      }
      const unsigned char* ub = PU + (size_t)s * (NEXP * 128);
      bf16_t* pd = PD + ((size_t)s * T_ + t0 + g) * 128;
      const bool b2_ = (lane & 4) != 0, b1_ = (lane & 2) != 0, b0_ = (lane & 1) != 0;
      u32x4 ra[8], rb[8], rc[8];
      float sa = 0.f, sb = 0.f, sc = 0.f;
#define PD_LOAD(R, S, KB) { _Pragma("unroll") for (int q = 0; q < 8; ++q) { const int id = lidx[g * 132 + (KB) + q]; R[q] = *(const u32x4*)(ub + (unsigned)(id * 128 + 16 * j)); } \
                            (void)S; }
#define DPPI(X, CTRL) __builtin_amdgcn_update_dpp(0, (X), (CTRL), 0xF, 0xF, true)
#define PD_COMP(R, S, KB)                                                                         \
      {                                                                                           \
        int pp[8];                                                                                \
        _Pragma("unroll") for (int q = 0; q < 8; ++q) {                                           \
          int al = __builtin_amdgcn_sdot8((int)R[q].x, (int)xl[0], 0, false);                     \
          int ah = __builtin_amdgcn_sdot8((int)R[q].x, (int)xh[0], 0, false);                     \
          al = __builtin_amdgcn_sdot8((int)R[q].y, (int)xl[1], al, false);                        \
          ah = __builtin_amdgcn_sdot8((int)R[q].y, (int)xh[1], ah, false);                        \
          al = __builtin_amdgcn_sdot8((int)R[q].z, (int)xl[2], al, false);                        \
          ah = __builtin_amdgcn_sdot8((int)R[q].z, (int)xh[2], ah, false);                        \
          al = __builtin_amdgcn_sdot8((int)R[q].w, (int)xl[3], al, false);                        \
          ah = __builtin_amdgcn_sdot8((int)R[q].w, (int)xh[3], ah, false);                        \
          pp[q] = al + 16 * ah;                                                                   \
        }                                                                                         \
          \
        int q4[4], q2[2];                                                                         \
        _Pragma("unroll") for (int i = 0; i < 4; ++i) {                                           \
          const int keep = b2_ ? pp[4 + i] : pp[i], send = b2_ ? pp[i] : pp[4 + i];               \
          q4[i] = keep + DPPI(send, 0x141);                   \
        }                                                                                         \
        _Pragma("unroll") for (int i = 0; i < 2; ++i) {                                           \
          const int keep = b1_ ? q4[2 + i] : q4[i], send = b1_ ? q4[i] : q4[2 + i];               \
          q2[i] = keep + DPPI(send, 0x4E);                      \
        }                                                                                         \
        {                                                                                         \
          const int keep = b0_ ? q2[1] : q2[0], send = b0_ ? q2[0] : q2[1];                       \
          lpd[g * 128 + (KB) + j] = (float)(keep + DPPI(send, 0xB1));     \
        }                                                                                         \
        __builtin_amdgcn_sched_barrier(0);                                                        \
      }
      PD_LOAD(ra, sa, 0)
      PD_LOAD(rb, sb, 8)
#pragma unroll 1
      for (int kb = 0; kb < 120; kb += 24) {
        PD_LOAD(rc, sc, kb + 16)
        PD_COMP(ra, sa, kb)
        PD_LOAD(ra, sa, kb + 24)
        PD_COMP(rb, sb, kb + 8)
        { const int kl = kb + 32 < 120 ? kb + 32 : 120; PD_LOAD(rb, sb, kl) }
        PD_COMP(rc, sc, kb + 16)
      }
      PD_COMP(ra, sa, 120)
#undef PD_LOAD
#undef PD_COMP
#undef DPPI
      {
        const float4 f0 = *(const float4*)(lpd + g * 128 + 16 * j), f1 = *(const float4*)(lpd + g * 128 + 16 * j + 4);
        const float4 f2 = *(const float4*)(lpd + g * 128 + 16 * j + 8), f3 = *(const float4*)(lpd + g * 128 + 16 * j + 12);
        *(u32x4*)(pd + 16 * j) = (u32x4){pack_bf2(f0.x, f0.y), pack_bf2(f0.z, f0.w), pack_bf2(f1.x, f1.y), pack_bf2(f1.z, f1.w)};
        *(u32x4*)(pd + 16 * j + 8) = (u32x4){pack_bf2(f2.x, f2.y), pack_bf2(f2.z, f2.w), pack_bf2(f3.x, f3.y), pack_bf2(f3.z, f3.w)};
      }
      }
    }
  }
}

DI void phase_peer_act(const Params& p, int layer) {
  const int rtid = RTID(), lane = rtid & 63;
  const int gw = __builtin_amdgcn_readfirstlane((int)((blockIdx.x * RTHREADS + rtid) >> 6)), nw = (int)(gridDim.x * RTHREADS) >> 6;
  const bf16_t* PD = (const bf16_t*)(p.ws + WS_PD);
  const unsigned short* IDX = (const unsigned short*)(p.ws + WS_IDX);
  const float* GATE = (const float*)(p.ws + WS_GATE);
  const float* HS = (const float*)(p.ws + WS_HS);
  unsigned short* ACTQ = (unsigned short*)(p.ws + WS_ACT);
  float* ACTS = (float*)(p.ws + WS_ACT + 4 * MiB);
  const float* VSC = (const float*)(p.ws + WS_PEERV) + (size_t)(2 + layer) * NEXP;
  const float* USC = (const float*)(p.ws + WS_USC4) + (size_t)layer * (8 * NEXP);
  for (int t = gw; t < T_; t += nw) {
    const size_t e = (size_t)t * 128 + 2 * lane;
    int2 id; { const unsigned iw = *(const unsigned*)(IDX + e); id.x = (int)(iw & 0xFFFFu); id.y = (int)(iw >> 16); }
    float sx[8], sy[8];
    {
      const float4 x0 = *(const float4*)(USC + (size_t)id.x * 8), x1 = *(const float4*)(USC + (size_t)id.x * 8 + 4);
      const float4 y0 = *(const float4*)(USC + (size_t)id.y * 8), y1 = *(const float4*)(USC + (size_t)id.y * 8 + 4);
      sx[0] = x0.x; sx[1] = x0.y; sx[2] = x0.z; sx[3] = x0.w; sx[4] = x1.x; sx[5] = x1.y; sx[6] = x1.z; sx[7] = x1.w;
      sy[0] = y0.x; sy[1] = y0.y; sy[2] = y0.z; sy[3] = y0.w; sy[4] = y1.x; sy[5] = y1.y; sy[6] = y1.z; sy[7] = y1.w;
    }
    float2 a = make_float2(0.f, 0.f);
#pragma unroll
    for (int s2 = 0; s2 < 8; ++s2) { const unsigned q = *(const unsigned*)(PD + (size_t)s2 * T_ * 128 + e); a.x += bf_lo(q) * sx[s2]; a.y += bf_hi(q) * sy[s2]; }
    const float2 gt = *(const float2*)(GATE + e);
    const float hs = HS[t];
    const float v0 = gt.x * gelu_erf(a.x * hs) * VSC[id.x], v1 = gt.y * gelu_erf(a.y * hs) * VSC[id.y];
    const float am = wave_max(fmaxf(fabsf(v0), fabsf(v1)));
    const float qs = am > 0.f ? 127.f / am : 1.f;
    const int q0 = (int)rintf(v0 * qs), q1 = (int)rintf(v1 * qs);
    ACTQ[(size_t)t * 64 + lane] = (unsigned short)((q0 & 255) | ((q1 & 255) << 8));
    if (lane == 0) ACTS[t] = am > 0.f ? am / 127.f : 1.f;
  }
}

DI void phase_peer_values(const Params& p, int layer, const float* gate2, char* smem_all) {
  const int rtid = RTID(), lane = rtid & 63, rwave = __builtin_amdgcn_readfirstlane(rtid >> 6);
  const int g = lane >> 3, j = lane & 7;
  int* lidx_all = (int*)(smem_all + rwave * 16384);
  unsigned* lact_all = (unsigned*)(smem_all + rwave * 16384 + 4352);
  const unsigned short* IDX = (const unsigned short*)(p.ws + WS_IDX);
  const unsigned* ACTQ = (const unsigned*)(p.ws + WS_ACT);
  const float* ACTS = (const float*)(p.ws + WS_ACT + 4 * MiB);
  const unsigned char* PV = (const unsigned char*)(p.ws + WS_PEERV8) + (size_t)layer * NEXP * D_;
  unsigned* tick = (unsigned*)(p.ws + WS_TICKETS) + (size_t)(layer * 2 + 1) * 16 * 16;
  const int xcc = xcc_id() & 7;
#pragma unroll 1
  for (int so = 0; so < 16; ++so) {
    const int s = ((xcc + (so >> 1)) & 7) + 8 * (so & 1);
    unsigned tv = peer_ticket_issue(tick + s * 16);
    for (;;) {
      const int c = __builtin_amdgcn_readfirstlane((int)tv);
      if (c >= T_ / 16) break;
      tv = peer_ticket_issue(tick + s * 16);
#pragma unroll
      for (int gi = 0; gi < 2; ++gi) {
        const unsigned short* ip = IDX + (size_t)(c * 16 + gi * 8 + g) * 128 + 16 * j;
        const u32x4 i0 = *(const u32x4*)ip, i1 = *(const u32x4*)(ip + 8);
        const unsigned iw[8] = {i0.x, i0.y, i0.z, i0.w, i1.x, i1.y, i1.z, i1.w};
#pragma unroll
        for (int i = 0; i < 4; ++i) *(uint4*)(lidx_all + gi * 2048 + g * 132 + 16 * j + 4 * i) = make_uint4(iw[2 * i] & 0xFFFFu, iw[2 * i] >> 16, iw[2 * i + 1] & 0xFFFFu, iw[2 * i + 1] >> 16);
        *(uint4*)(lact_all + gi * 2048 + g * 36 + 4 * j) = *(const uint4*)(ACTQ + (size_t)(c * 16 + gi * 8 + g) * 32 + 4 * j);
      }
#pragma unroll 1
      for (int gi = 0; gi < 2; ++gi) {
      const int t0 = c * 16 + gi * 8;
      const int* lidx = lidx_all + gi * 2048;
      const unsigned* lact = lact_all + gi * 2048;
      const unsigned char* vb = PV + (size_t)s * (NEXP * 128);
      int y[16];
#pragma unroll
      for (int i = 0; i < 16; ++i) y[i] = 0;
      u32x4 ra[8], rb[8];
      const int tq = t0 + g;
      bf16_t* rrow = (bf16_t*)(p.ws + WS_R16) + (size_t)tq * D_ + s * 128 + 16 * j;
      float* orow = p.out + (size_t)tq * D_ + s * 128 + 16 * j;
      const float* grow = gate2 + (size_t)(tq >> 11) * 12288 + s * 128 + 16 * j;
      u32x4 ia0 = *(const u32x4*)(lidx + g * 132), ia1 = *(const u32x4*)(lidx + g * 132 + 4);
#define PV_LOAD(R, KBN) { const unsigned ids_[8] = {ia0.x, ia0.y, ia0.z, ia0.w, ia1.x, ia1.y, ia1.z, ia1.w};                         \
        _Pragma("unroll") for (int q = 0; q < 8; ++q) R[q] = *(const u32x4*)(vb + (ids_[q] * 128u + 16u * (unsigned)j));              \
        ia0 = *(const u32x4*)(lidx + g * 132 + (KBN)); ia1 = *(const u32x4*)(lidx + g * 132 + (KBN) + 4); }
#define PV_QUAD(W0, W1, W2, W3, AQ, YB) {                                                                                             \
        const unsigned t0_ = __builtin_amdgcn_perm((W1), (W0), 0x05010400u), t1_ = __builtin_amdgcn_perm((W1), (W0), 0x07030602u);    \
        const unsigned t2_ = __builtin_amdgcn_perm((W3), (W2), 0x05010400u), t3_ = __builtin_amdgcn_perm((W3), (W2), 0x07030602u);    \
        y[(YB) + 0] = __builtin_amdgcn_sdot4((int)__builtin_amdgcn_perm(t2_, t0_, 0x05040100u), (int)(AQ), y[(YB) + 0], false);       \
        y[(YB) + 1] = __builtin_amdgcn_sdot4((int)__builtin_amdgcn_perm(t2_, t0_, 0x07060302u), (int)(AQ), y[(YB) + 1], false);       \
        y[(YB) + 2] = __builtin_amdgcn_sdot4((int)__builtin_amdgcn_perm(t3_, t1_, 0x05040100u), (int)(AQ), y[(YB) + 2], false);       \
        y[(YB) + 3] = __builtin_amdgcn_sdot4((int)__builtin_amdgcn_perm(t3_, t1_, 0x07060302u), (int)(AQ), y[(YB) + 3], false); }
#define PV_COMP(R, KB)                                                                            \
      { const unsigned aq0 = lact[g * 36 + ((KB) >> 2)], aq1 = lact[g * 36 + ((KB) >> 2) + 1];    \
        PV_QUAD(R[0].x, R[1].x, R[2].x, R[3].x, aq0, 0)  PV_QUAD(R[0].y, R[1].y, R[2].y, R[3].y, aq0, 4)   \
        PV_QUAD(R[0].z, R[1].z, R[2].z, R[3].z, aq0, 8)  PV_QUAD(R[0].w, R[1].w, R[2].w, R[3].w, aq0, 12)  \
        __builtin_amdgcn_sched_barrier(0);                                                        \
        PV_QUAD(R[4].x, R[5].x, R[6].x, R[7].x, aq1, 0)  PV_QUAD(R[4].y, R[5].y, R[6].y, R[7].y, aq1, 4)   \
        PV_QUAD(R[4].z, R[5].z, R[6].z, R[7].z, aq1, 8)  PV_QUAD(R[4].w, R[5].w, R[6].w, R[7].w, aq1, 12)  \
        __builtin_amdgcn_sched_barrier(0); }
      PV_LOAD(ra, 8)
#pragma unroll 1
      for (int kb = 0; kb < 128; kb += 16) {
        { const int kn = kb + 16 < 120 ? kb + 16 : 120; PV_LOAD(rb, kn) }
        PV_COMP(ra, kb)
        { const int kn = kb + 24 < 120 ? kb + 24 : 120; PV_LOAD(ra, kn) }
        PV_COMP(rb, kb + 8)
      }
#undef PV_LOAD
#undef PV_COMP
#undef PV_QUAD
      const float as = ACTS[tq];
      const u32x4 r0 = *(const u32x4*)rrow, r1 = *(const u32x4*)(rrow + 8);
      const unsigned rw[8] = {r0.x, r0.y, r0.z, r0.w, r1.x, r1.y, r1.z, r1.w};
      float res[16];
#pragma unroll
      for (int i = 0; i < 4; ++i) {
        float4 g0 = *(const float4*)(grow + 4 * i);
        g0.x *= as; g0.y *= as; g0.z *= as; g0.w *= as;
        res[4 * i + 0] = bf_lo(rw[2 * i]) + g0.x * (float)y[4 * i];     res[4 * i + 1] = bf_hi(rw[2 * i]) + g0.y * (float)y[4 * i + 1];
        res[4 * i + 2] = bf_lo(rw[2 * i + 1]) + g0.z * (float)y[4 * i + 2]; res[4 * i + 3] = bf_hi(rw[2 * i + 1]) + g0.w * (float)y[4 * i + 3];
      }
      if (layer == 0) {
        u32x4 w0, w1;
        w0.x = pack_bf2(res[0], res[1]); w0.y = pack_bf2(res[2], res[3]); w0.z = pack_bf2(res[4], res[5]); w0.w = pack_bf2(res[6], res[7]);
        w1.x = pack_bf2(res[8], res[9]); w1.y = pack_bf2(res[10], res[11]); w1.z = pack_bf2(res[12], res[13]); w1.w = pack_bf2(res[14], res[15]);
        *(u32x4*)rrow = w0; *(u32x4*)(rrow + 8) = w1;
      } else {
#pragma unroll
        for (int i = 0; i < 4; ++i) *(float4*)(orow + 4 * i) = make_float4(res[4 * i], res[4 * i + 1], res[4 * i + 2], res[4 * i + 3]);
      }
      }
    }
  }
}

#define XB_TMO      128
#define XB_XCNT(j)  (256  + 64 * (j))
#define XB_XSUB(j)  (1280 + 64 * (j))
#define XB_XGEN(j)  (2304 + 64 * (j))
#define XB_TOP      3328
#define XB_TOPGEN   3392
#define XCD_BAR_WORDS 3456
#define XB_SPIN_CAP (1u << 22)
#define LAS __attribute__((address_space(3)))
DI unsigned xb_ld(unsigned* p) { return __hip_atomic_load(p, __ATOMIC_RELAXED, __HIP_MEMORY_SCOPE_AGENT); }
DI unsigned xb_add(unsigned* p, unsigned v) { return __hip_atomic_fetch_add(p, v, __ATOMIC_RELAXED, __HIP_MEMORY_SCOPE_AGENT); }
DI unsigned xb_xcc_id() { return (unsigned)__builtin_amdgcn_s_getreg((3 << 11) | 20) & 0xFu; }
#define XB_SPIN(cond, bar) do { unsigned _sp = 0; while (cond) { __builtin_amdgcn_s_sleep(1); \
    if ((++_sp & 255u) == 0u) { if (xb_ld(&(bar)[XB_TMO])) break; if (_sp > XB_SPIN_CAP) { atomicAdd(&(bar)[XB_TMO], 1u); break; } } } } while (0)
struct XcdBarrier { unsigned* bar; unsigned x; volatile LAS unsigned* st; };
DI XcdBarrier xcd_barrier_post(unsigned* bar, volatile LAS unsigned* st) {
  XcdBarrier b; b.bar = bar; b.x = xb_xcc_id(); b.st = st;
  if (threadIdx.x == 0) (void)xb_add(&bar[XB_XCNT(b.x)], 1u);
  return b;
}
DI void xcd_barrier_complete(unsigned* bar, unsigned x, unsigned& nloc, unsigned& nx) {
  const unsigned G = gridDim.x * gridDim.y * gridDim.z;
  unsigned sum, cnt, mine, sp = 0u;
  for (;;) {
    sum = 0u; cnt = 0u; mine = 0u;
#pragma unroll
    for (unsigned j = 0; j < 16; ++j) { const unsigned c = xb_ld(&bar[XB_XCNT(j)]); sum += c; cnt += (c > 0u) ? 1u : 0u; mine = (j == x) ? c : mine; }
    if (sum == G) break;
    __builtin_amdgcn_s_sleep(1);
    if ((++sp & 255u) == 0u) { if (xb_ld(&bar[XB_TMO])) break; if (sp > XB_SPIN_CAP) { atomicAdd(&bar[XB_TMO], 1u); break; } }
  }
  nloc = mine > 0u ? mine : 1u; nx = cnt > 0u ? cnt : 1u;
}
DI void xcd_barrier(const XcdBarrier& b) {
  asm volatile("s_waitcnt vmcnt(0)" ::: "memory");
  __syncthreads();
  if (threadIdx.x == 0) {
    unsigned* bar = b.bar;
    __builtin_amdgcn_s_waitcnt(0);
    unsigned nloc = b.st[0], nx = b.st[1];
    if (nloc == 0u) { xcd_barrier_complete(bar, b.x, nloc, nx); b.st[0] = nloc; b.st[1] = nx; }
    const unsigned old = xb_add(&bar[XB_XSUB(b.x)], 1u);
    const unsigned gen = old / nloc;
    if (old + 1u == (gen + 1u) * nloc) {
      __builtin_amdgcn_fence(__ATOMIC_RELEASE, "agent");
      asm volatile("s_waitcnt vmcnt(0)" ::: "memory");
      const unsigned og = xb_add(&bar[XB_TOP], 1u);
      const unsigned tg = og / nx;
      if (og + 1u == (tg + 1u) * nx) xb_add(&bar[XB_TOPGEN], 1u);
      else XB_SPIN(xb_ld(&bar[XB_TOPGEN]) == tg, bar);
      __builtin_amdgcn_fence(__ATOMIC_ACQUIRE, "agent");
      xb_add(&bar[XB_XGEN(b.x)], 1u);
      asm volatile("s_waitcnt vmcnt(0)" ::: "memory");
    } else {
      XB_SPIN(xb_ld(&bar[XB_XGEN(b.x)]) == gen, bar);
      __builtin_amdgcn_fence(__ATOMIC_ACQUIRE, "agent");
      asm volatile("s_waitcnt vmcnt(0)" ::: "memory");
    }
  }
  __syncthreads();
}

constexpr int N_PHASES = 23;
template <class Epi>
DI void gemm256(char* smem_all, const bf16_t* A, const bf16_t* Bt, int M, int N, int K, const Epi& E) {
  pg8::Gemm g{A, Bt, M, N, K};
  pg8::StaticOrder S; S.init(M, N, (int)gridDim.x, (int)blockIdx.x);
  pg8::gemm_phase<Epi, pg8::StaticOrder, false>((PG8_LAS unsigned char*)smem_all, g, S, E, nullptr);
}
template <int ph>
DI void run_phase(const Params& p_in, char* smem, char* smem_all) {
  Params p = p_in;
  {
    size_t z = 0; asm volatile("" : "+s"(z)); p.ws = p_in.ws + z; p.out = p_in.out + z;
  }
  char* ws = p.ws;
  const float* mod = (const float*)(ws + WS_MOD);
  const bf16_t* H = (const bf16_t*)(ws + WS_H);
  if (ph == 0) { phase_prep(p, smem); return; }
  const int layer = ph >= 12 ? 1 : 0;
  const int lp = ph - (layer ? 12 : 1);
  int sub;
  sub = lp < 2 ? lp : lp + 1;
  const float* modl = mod + (size_t)layer * 8 * 12288;
  switch (sub) {
    case 0:
      if (layer == 0) { phase_norm<false, 2, false, false>(p, p.x, p.norm_gain, modl, modl + 2048); forget_logits(p, smem); quant_w8(p); }
      else phase_norm<false, 2, true, false>(p, ws + WS_R16, p.norm_gain + 2 * 2048, modl, modl + 2048);
      break;
    case 1: {
      if (layer == 0) fox_cumsum(p);
      const bf16_t* H8A = (const bf16_t*)(ws + WS_H8A);
      const float* hsc = (const float*)(ws + WS_H8A + 32 * MiB);
      const bf16_t* W8 = (const bf16_t*)(ws + WS_W8) + (size_t)layer * 6144 * 1024;
      const float* wsc = (const float*)(ws + WS_W8 + 32 * MiB) + layer * 6144;
      pg8::EpiQkNorm eq{(bf16_t*)(ws + WS_QK), 4096, layer ? p.odd_qk_gain : p.even_fox_qk_gain, layer ? p.odd_qk_gain : p.even_diff_qk_gain,
                        layer ? 4 : 3, (float*)(smem_all + 131072), wsc, hsc};
      gemm256(smem_all, H8A, W8, T_, 4096, 1024, eq);
      pg8::EpiVt8 ev{(bf16_t*)(ws + WS_VT), T_, wsc + 4096, hsc};
      gemm256(smem_all, W8 + (size_t)4096 * 1024, H8A, 2048, T_, 1024, ev);
    } break;
    case 3:
      if (layer == 0) phase_attn_even(p, smem_all); else phase_attn_odd(p, smem_all);
      break;
    case 4: if (layer == 0) phase_diff_combine(p); else quant_att(p); break;
    case 5: {
      bf16_t* R16 = (bf16_t*)(ws + WS_R16);
      const bf16_t* A8 = (const bf16_t*)(ws + WS_ATT8);
      const float* a8s = (const float*)(ws + WS_ATT8 + 32 * MiB);
      const bf16_t* Wo8 = (const bf16_t*)(ws + WS_W8) + (size_t)(12288 + layer * 2048) * 1024;
      const float* wos = (const float*)(ws + WS_W8 + 32 * MiB) + 12288 + layer * 2048;
      if (layer == 0) { pg8::EpiRes16<false> er{R16, 2048, p.x, modl + 2 * 2048, a8s, wos};
        gemm256(smem_all, A8, Wo8, T_, 2048, 1024, er); }
      else { pg8::EpiRes16<true> er{R16, 2048, R16, modl + 2 * 2048, a8s, wos};
        gemm256(smem_all, A8, Wo8, T_, 2048, 1024, er); }
    } break;
    case 6:
      phase_norm<false, 1, true>(p, ws + WS_R16, p.norm_gain + (layer * 2 + 1) * 2048, modl + 3 * 2048, modl + 4 * 2048);
      break;
    case 7: {
      pg8::EpiBf16 es{(bf16_t*)(ws + WS_SC), 2048};
      gemm256(smem_all, H, (const bf16_t*)(ws + (layer ? WS_WQ1 : WS_WQ0)), T_, 2048, 2048, es);
    } break;
    case 8: phase_peer_retrieve(p, smem); break;
    case 9: phase_peer_dots(p, layer, smem_all); break;
    case 10: phase_peer_act(p, layer); break;
    case 11: phase_peer_values(p, layer, modl + 5 * 2048, smem_all); break;
  }
}

#if FUSED
template <int PH>
DI void run_all(const Params& p, char* smem, char* smem_all, const XcdBarrier& xb, cg::grid_group& grid) {
  if constexpr (PH < N_PHASES) {
    run_phase<PH>(p, smem, smem_all);
    if constexpr (PH + 1 < N_PHASES) xcd_barrier(xb);
    run_all<PH + 1>(p, smem, smem_all, xb, grid);
  }
}
__global__ void __launch_bounds__(RTHREADS, 2) mega_kernel(Params p) {
  extern __shared__ __attribute__((aligned(16))) char smem_all[];
  char* smem = smem_all + (RTID() >> 8) * HALF_SMEM;
  cg::grid_group grid = cg::this_grid();
  volatile LAS unsigned* xst = (volatile LAS unsigned*)(smem_all + SMEM_BYTES - 16);
  if (threadIdx.x == 0) { xst[0] = 0u; xst[1] = 0u; }
  __syncthreads();
  const XcdBarrier xb = xcd_barrier_post((unsigned*)(p.ws + WS_BAR), xst);
  if (p.ws == nullptr) grid.sync();
  run_all<0>(p, smem, smem_all, xb, grid);
}
#else
template <int PH>
__global__ void __launch_bounds__(RTHREADS, 2) phase_kernel(Params p) {
  extern __shared__ __attribute__((aligned(16))) char smem_all[];
  char* smem = smem_all + (RTID() >> 8) * HALF_SMEM;
  run_phase<PH>(p, smem, smem_all);
}
template <int PH>
static void launch_phases(const Params& p, int grid, hipStream_t stream) {
  if constexpr (PH < N_PHASES) {
    (void)hipFuncSetAttribute((const void*)phase_kernel<PH>, hipFuncAttributeMaxDynamicSharedMemorySize, SMEM_BYTES);
    phase_kernel<PH><<<grid, RTHREADS, SMEM_BYTES, stream>>>(p);
    launch_phases<PH + 1>(p, grid, stream);
  }
}
#endif

extern "C" void kernel_launch(void* const* d_in, const int* in_sizes, int n_in, void* d_out, int out_size, void* d_ws,
                              size_t ws_size, hipStream_t stream) {
  Params p{};
  p.x = (const float*)d_in[0]; p.c = (const float*)d_in[1]; p.rel_bias = (const float*)d_in[2];
  p.norm_gain = (const float*)d_in[3]; p.w_ada = (const float*)d_in[4]; p.b_ada = (const float*)d_in[5];
  p.even_w_in = (const float*)d_in[6]; p.even_b_forget = (const float*)d_in[7]; p.even_fox_qk_gain = (const float*)d_in[8];
  p.even_diff_qk_gain = (const float*)d_in[9]; p.even_diff_lambda = (const float*)d_in[10];
  p.even_diff_subln_gain = (const float*)d_in[11]; p.even_w_out = (const float*)d_in[12];
  p.odd_w_qkv = (const float*)d_in[13]; p.odd_qk_gain = (const float*)d_in[14]; p.odd_w_out = (const float*)d_in[15];
  p.peer_w_query = (const float*)d_in[16]; p.peer_sub_keys = (const float*)d_in[17];
  p.peer_u = (const float*)d_in[18]; p.peer_v = (const float*)d_in[19];
  p.out = (float*)d_out; p.ws = (char*)d_ws;
  if (ws_size < WS_END) { fprintf(stderr, "workspace too small: %zu < %zu\n", ws_size, (size_t)WS_END); return; }
#if FUSED
  static int grid_blocks = 0;
  if (!grid_blocks) {
    int dev = 0, cus = 0, per_cu = 0;
    (void)hipGetDevice(&dev);
    (void)hipDeviceGetAttribute(&cus, hipDeviceAttributeMultiprocessorCount, dev);
    (void)hipFuncSetAttribute((const void*)mega_kernel, hipFuncAttributeMaxDynamicSharedMemorySize, SMEM_BYTES);
    (void)hipOccupancyMaxActiveBlocksPerMultiprocessor(&per_cu, mega_kernel, RTHREADS, SMEM_BYTES);
    if (per_cu > 1) per_cu = 1;
    grid_blocks = cus * per_cu;
  }
  (void)hipMemsetAsync(p.ws + WS_BAR, 0, WS_BAR_BYTES, stream);
  void* args[] = {&p};
  hipError_t e = hipLaunchCooperativeKernel((void*)mega_kernel, dim3(grid_blocks), dim3(RTHREADS), args, SMEM_BYTES, stream);
  if (e != hipSuccess) fprintf(stderr, "cooperative launch failed: %s (grid %d)\n", hipGetErrorString(e), grid_blocks);
#else
  launch_phases<0>(p, 256, stream);
#endif
}
```
